# Optimizing an MI355X kernel written in HIP

```python
import math
import jax, jax.numpy as jnp
from jax import lax
import numpy as np

D_MODEL = 1024
BATCH = 2
SEQ = 8192
DEPTH = 2

Q_BLOCK = 128
NEG_INF = -1e30
FORCE_SEL = 1e9
EPS = 1e-6

NSA_HEADS = 8
NSA_KV_GROUPS = 2
NSA_HPG = NSA_HEADS // NSA_KV_GROUPS
NSA_HEAD_DIM = 64
CMP_LEN = 32
CMP_STRIDE = 16
CMP_RATIO = CMP_LEN // CMP_STRIDE
CMP_HIDDEN = 128
SLC_BLOCK = 64
SLC_RATIO = SLC_BLOCK // CMP_STRIDE
SLC_TOPK = 16
SLC_LOCAL = 2
WINDOW = 512

MLA_HEADS = 8
MLA_Q_RANK = 256
MLA_KV_RANK = 128
MLA_NOPE_DIM = 64
MLA_ROPE_DIM = 32
MLA_QK_DIM = MLA_NOPE_DIM + MLA_ROPE_DIM
MLA_V_DIM = 64
ROPE_THETA = 10000.0

FOX_HEADS = 8
FOX_HEAD_DIM = 64

REL_BUCKETS = 32
REL_MAX_DIST = 128

N_BRANCHES = 3
N_GROUPS = 4
EXPERTS_PER_GROUP = 8
N_EXPERTS = N_GROUPS * EXPERTS_PER_GROUP
TOP_K_IN_GROUP = 2
EXPERT_DIM = 256
MOE_CHUNK = 128

NSA_Q_W = NSA_HEADS * NSA_HEAD_DIM
NSA_KV_W = 3 * 2 * NSA_KV_GROUPS * NSA_HEAD_DIM
NSA_G_W = 3 * NSA_HEADS
FOX_QKV_W = 3 * FOX_HEADS * FOX_HEAD_DIM
MERGE_W = N_BRANCHES * D_MODEL
IN_SPLITS = (NSA_Q_W, NSA_KV_W, NSA_G_W, MLA_Q_RANK, MLA_KV_RANK, MLA_ROPE_DIM, FOX_QKV_W, FOX_HEADS, MERGE_W)
D_IN = sum(IN_SPLITS)

kernel_name = "hybrid_nsa_mla_fox_hmoe"


def rmsnorm(x, g):
    xf = x.astype(jnp.float32)
    y = xf * lax.rsqrt(jnp.mean(xf * xf, axis=-1, keepdims=True) + EPS)
    return (y * g.astype(jnp.float32)).astype(x.dtype)


def rel_bucket(dist):
    n = jnp.maximum(dist, 0)
    max_exact = REL_BUCKETS // 2
    log_ratio = jnp.log(jnp.maximum(n, 1).astype(jnp.float32) / max_exact) / math.log(REL_MAX_DIST / max_exact)
    large = max_exact + (log_ratio * (REL_BUCKETS - max_exact)).astype(jnp.int32)
    return jnp.where(n < max_exact, n, jnp.minimum(large, REL_BUCKETS - 1))


def rope(x, pos):
    half = x.shape[-1] // 2
    inv_freq = ROPE_THETA ** (-jnp.arange(half, dtype=jnp.float32) / half)
    ang = pos.astype(jnp.float32)[..., None] * inv_freq
    ang = ang.reshape(ang.shape[:2] + (1,) * (x.ndim - 3) + (half,))
    cos, sin = jnp.cos(ang), jnp.sin(ang)
    x1 = x[..., :half].astype(jnp.float32)
    x2 = x[..., half:].astype(jnp.float32)
    return jnp.concatenate([x1 * cos - x2 * sin, x1 * sin + x2 * cos], axis=-1).astype(x.dtype)


def compress_blocks(raw, pe, w1, b1, w2):
    B, T, G, dh = raw.shape
    n_sub = T // CMP_STRIDE
    sub = raw.reshape(B, n_sub, CMP_STRIDE, G, dh)
    blocks = jnp.concatenate([sub[:, r:n_sub - CMP_RATIO + 1 + r] for r in range(CMP_RATIO)], axis=2)
    blocks = blocks + pe[None, None, :, None, :]
    flat = blocks.transpose(0, 1, 3, 2, 4).reshape(B, n_sub - CMP_RATIO + 1, G, CMP_LEN * dh)
    return jax.nn.gelu(flat @ w1 + b1) @ w2


def causal_block_attention(q, k, v, scale, cum_log_f=None):
    B, T, H, _ = q.shape
    kpos = jnp.arange(T)
    cum_k = None if cum_log_f is None else cum_log_f.transpose(0, 2, 1)[:, :, None, :]

    def one_block(qb):
        t0 = qb * Q_BLOCK
        qpos = t0 + jnp.arange(Q_BLOCK)
        q_blk = lax.dynamic_slice_in_dim(q, t0, Q_BLOCK, axis=1)
        s = jnp.einsum('bqhd,bkhd->bhqk', q_blk, k, preferred_element_type=jnp.float32) * scale
        if cum_log_f is not None:
            cum_q = lax.dynamic_slice_in_dim(cum_log_f, t0, Q_BLOCK, axis=1).transpose(0, 2, 1)[..., None]
            s = s + cum_q - cum_k
        s = jnp.where(kpos[None, :] <= qpos[:, None], s, NEG_INF)
        p = jax.nn.softmax(s, axis=-1).astype(v.dtype)
        return jnp.einsum('bhqk,bkhd->bqhd', p, v)

    out = lax.map(one_block, jnp.arange(T // Q_BLOCK))
    return out.transpose(1, 0, 2, 3, 4).reshape(B, T, H, v.shape[-1])


def nsa_attention(q, kc_raw, vc_raw, ks, vs, kw, vw, gate_logits, rel_bias, pe,
                  ck_w1, ck_b1, ck_w2, cv_w1, cv_b1, cv_w2):
    B, T, H, dh = q.shape
    G, HPG = NSA_KV_GROUPS, NSA_HPG
    scale = dh ** -0.5
    kc = compress_blocks(kc_raw, pe, ck_w1, ck_b1, ck_w2)
    vc = compress_blocks(vc_raw, pe, cv_w1, cv_b1, cv_w2)
    n_cmp = kc.shape[1]
    cmp_end = jnp.arange(n_cmp) * CMP_STRIDE + CMP_LEN - 1
    n_slc = T // SLC_BLOCK
    ks_blk = ks.reshape(B, n_slc, SLC_BLOCK, G, dh).transpose(0, 3, 1, 2, 4)
    vs_blk = vs.reshape(B, n_slc, SLC_BLOCK, G, dh).transpose(0, 3, 1, 2, 4)
    topk = min(SLC_TOPK, n_slc)
    max_start = SLC_RATIO + CMP_RATIO - 2
    right_pad = max(0, max_start + SLC_RATIO * (n_slc - 1) + 1 - n_cmp)
    kw_pad = jnp.pad(kw, ((0, 0), (WINDOW, 0), (0, 0), (0, 0)))
    vw_pad = jnp.pad(vw, ((0, 0), (WINDOW, 0), (0, 0), (0, 0)))
    gates = jax.nn.sigmoid(gate_logits.astype(jnp.float32))
    tab_g = rel_bias.reshape(REL_BUCKETS, G, HPG)
    n_win = WINDOW + Q_BLOCK

    def one_block(qb):
        t0 = qb * Q_BLOCK
        tq = t0 + jnp.arange(Q_BLOCK)
        qg = lax.dynamic_slice_in_dim(q, t0, Q_BLOCK, axis=1).reshape(B, Q_BLOCK, G, HPG, dh)

        dist_c = tq[:, None] - cmp_end[None, :]
        ok_c = dist_c >= 0
        bias_c = rel_bias[rel_bucket(dist_c)].reshape(Q_BLOCK, n_cmp, G, HPG).transpose(2, 3, 0, 1)
        s_c = jnp.einsum('bqghd,bngd->bghqn', qg, kc, preferred_element_type=jnp.float32) * scale + bias_c
        s_c = jnp.where(ok_c, s_c, NEG_INF)
        p_c = jnp.where(ok_c, jax.nn.softmax(s_c, axis=-1), 0.0)
        o_c = jnp.einsum('bghqn,bngd->bqghd', p_c.astype(vc.dtype), vc)

        imp = jnp.pad(p_c.sum(axis=2), ((0, 0), (0, 0), (0, 0), (0, right_pad)))
        p_slc = jnp.zeros(imp.shape[:3] + (n_slc,), jnp.float32)
        for m in range(SLC_RATIO):
            for n in range(CMP_RATIO):
                st = m + n
                p_slc = p_slc + lax.slice_in_dim(imp, st, st + SLC_RATIO * (n_slc - 1) + 1, stride=SLC_RATIO, axis=3)
        blk_cur = tq // SLC_BLOCK
        j = jnp.arange(n_slc)
        causal_b = j[None, :] <= blk_cur[:, None]
        forced = (j[None, :] == 0) | (causal_b & (j[None, :] > blk_cur[:, None] - SLC_LOCAL))
        score = jnp.where(causal_b, jnp.where(forced, FORCE_SEL, p_slc), NEG_INF)
        _, idx = lax.top_k(score, topk)
        sel_ok = idx <= blk_cur[None, None, :, None]
        flat_idx = idx.reshape(B, G, Q_BLOCK * topk)[..., None, None]
        k_sel = jnp.take_along_axis(ks_blk, flat_idx, axis=2).reshape(B, G, Q_BLOCK, topk * SLC_BLOCK, dh)
        v_sel = jnp.take_along_axis(vs_blk, flat_idx, axis=2).reshape(B, G, Q_BLOCK, topk * SLC_BLOCK, dh)
        kpos_s = idx[..., None] * SLC_BLOCK + jnp.arange(SLC_BLOCK)
        ok_s = ((kpos_s <= tq[None, None, :, None, None]) & sel_ok[..., None]).reshape(B, G, Q_BLOCK, -1)
        dist_s = tq[None, None, :, None] - kpos_s.reshape(B, G, Q_BLOCK, -1)
        bias_s = jax.vmap(lambda tb, bk: tb[bk], in_axes=(1, 1), out_axes=1)(tab_g, rel_bucket(dist_s))
        bias_s = bias_s.transpose(0, 1, 4, 2, 3)
        s_s = jnp.einsum('bqghd,bgqkd->bghqk', qg, k_sel, preferred_element_type=jnp.float32) * scale + bias_s
        s_s = jnp.where(ok_s[:, :, None], s_s, NEG_INF)
        p_s = jax.nn.softmax(s_s, axis=-1).astype(v_sel.dtype)
        o_s = jnp.einsum('bghqk,bgqkd->bqghd', p_s, v_sel)

        k_win = lax.dynamic_slice_in_dim(kw_pad, t0, n_win, axis=1)
        v_win = lax.dynamic_slice_in_dim(vw_pad, t0, n_win, axis=1)
        kpos_w = t0 - WINDOW + jnp.arange(n_win)
        dist_w = tq[:, None] - kpos_w[None, :]
        ok_w = (dist_w >= 0) & (dist_w < WINDOW) & (kpos_w[None, :] >= 0)
        bias_w = rel_bias[rel_bucket(dist_w)].reshape(Q_BLOCK, n_win, G, HPG).transpose(2, 3, 0, 1)
        s_w = jnp.einsum('bqghd,bkgd->bghqk', qg, k_win, preferred_element_type=jnp.float32) * scale + bias_w
        s_w = jnp.where(ok_w, s_w, NEG_INF)
        p_w = jax.nn.softmax(s_w, axis=-1).astype(v_win.dtype)
        o_w = jnp.einsum('bghqk,bkgd->bqghd', p_w, v_win)

        g = lax.dynamic_slice_in_dim(gates, t0, Q_BLOCK, axis=1).reshape(B, Q_BLOCK, G, HPG, 3)
        out = g[..., 0:1] * o_c + g[..., 1:2] * o_s + g[..., 2:3] * o_w
        return out.reshape(B, Q_BLOCK, H * dh).astype(q.dtype)

    out = lax.map(one_block, jnp.arange(T // Q_BLOCK))
    return out.transpose(1, 0, 2, 3).reshape(B, T, H * dh)


def hier_moe(h, w_grp, b_grp, w_router, b_router, w_gate, w_up, w_down):
    B, T, D = h.shape
    tok = h.reshape(-1, MOE_CHUNK, D)

    def chunk(t):
        grp_p = jax.nn.softmax((t @ w_grp).astype(jnp.float32) + b_grp.astype(jnp.float32), axis=-1)
        grp_top, g_idx = lax.top_k(grp_p, 1)
        e_logit = ((t @ w_router).astype(jnp.float32) + b_router.astype(jnp.float32)).reshape(-1, N_GROUPS, EXPERTS_PER_GROUP)
        e_logit = jnp.take_along_axis(e_logit, g_idx[:, :, None], axis=1)[:, 0]
        e_p = jax.nn.softmax(e_logit, axis=-1)
        e_top, e_idx = lax.top_k(e_p, TOP_K_IN_GROUP)
        wts = grp_top * e_top / jnp.sum(e_top, axis=-1, keepdims=True)
        eid = g_idx * EXPERTS_PER_GROUP + e_idx
        combine = jnp.sum(jax.nn.one_hot(eid, N_EXPERTS, dtype=jnp.float32) * wts[..., None], axis=1)
        a = jnp.einsum('cd,edf->cef', t, w_gate)
        u = jnp.einsum('cd,edf->cef', t, w_up)
        hid = (jax.nn.silu(a) * u * combine[..., None]).astype(t.dtype)
        return jnp.einsum('cef,efd->cd', hid, w_down)

    return lax.map(chunk, tok).reshape(B, T, D)


def setup_inputs(seed: int = 0) -> dict:
    key = jax.random.key(seed)
    ks = jax.random.split(key, 48)
    counter = [0]

    def nk():
        counter[0] += 1
        return ks[counter[0] - 1]

    def nrm(shape, scale):
        return jax.random.normal(nk(), shape, jnp.float32) * scale

    def gain(shape):
        return 1.0 + nrm(shape, 0.02)

    L, D = DEPTH, D_MODEL
    cmp_in = CMP_LEN * NSA_HEAD_DIM
    x = nrm((BATCH, SEQ, D), 1.0)
    offset = jax.random.randint(nk(), (BATCH, 1), 0, 1024, dtype=jnp.int32)
    positions = offset + jnp.arange(SEQ, dtype=jnp.int32)[None, :]
    return {
        "x": x,
        "positions": positions,
        "rel_bias": nrm((REL_BUCKETS, NSA_HEADS), 0.5),
        "norm_attn": gain((L, D)),
        "w_in": nrm((L, D, D_IN), D ** -0.5),
        "b_merge": nrm((L, MERGE_W), 0.1),
        "cmp_pe": nrm((L, CMP_LEN, NSA_HEAD_DIM), 0.1),
        "cmp_k_w1": nrm((L, cmp_in, CMP_HIDDEN), cmp_in ** -0.5),
        "cmp_k_b1": nrm((L, CMP_HIDDEN), 0.02),
        "cmp_k_w2": nrm((L, CMP_HIDDEN, NSA_HEAD_DIM), CMP_HIDDEN ** -0.5),
        "cmp_v_w1": nrm((L, cmp_in, CMP_HIDDEN), cmp_in ** -0.5),
        "cmp_v_b1": nrm((L, CMP_HIDDEN), 0.02),
        "cmp_v_w2": nrm((L, CMP_HIDDEN, NSA_HEAD_DIM), CMP_HIDDEN ** -0.5),
        "mla_q_norm": gain((L, MLA_Q_RANK)),
        "mla_kv_norm": gain((L, MLA_KV_RANK)),
        "mla_w_uq": nrm((L, MLA_Q_RANK, MLA_HEADS * MLA_QK_DIM), MLA_Q_RANK ** -0.5),
        "mla_w_uk": nrm((L, MLA_KV_RANK, MLA_HEADS * MLA_NOPE_DIM), MLA_KV_RANK ** -0.5),
        "mla_w_uv": nrm((L, MLA_KV_RANK, MLA_HEADS * MLA_V_DIM), MLA_KV_RANK ** -0.5),
        "fox_b_f": jax.random.uniform(nk(), (L, FOX_HEADS), jnp.float32, 1.0, 4.0),
        "w_o_nsa": nrm((L, NSA_HEADS * NSA_HEAD_DIM, D), (NSA_HEADS * NSA_HEAD_DIM) ** -0.5),
        "w_o_mla": nrm((L, MLA_HEADS * MLA_V_DIM, D), (MLA_HEADS * MLA_V_DIM) ** -0.5),
        "w_o_fox": nrm((L, FOX_HEADS * FOX_HEAD_DIM, D), (FOX_HEADS * FOX_HEAD_DIM) ** -0.5),
        "w_out": nrm((L, D, D), D ** -0.5),
        "norm_ffn": gain((L, D)),
        "moe_w_grp": nrm((L, D, N_GROUPS), D ** -0.5),
        "moe_b_grp": nrm((L, N_GROUPS), 0.01),
        "moe_w_router": nrm((L, D, N_EXPERTS), D ** -0.5),
        "moe_b_router": nrm((L, N_EXPERTS), 0.01),
        "moe_w_gate": nrm((L, N_EXPERTS, D, EXPERT_DIM), D ** -0.5),
        "moe_w_up": nrm((L, N_EXPERTS, D, EXPERT_DIM), D ** -0.5),
        "moe_w_down": nrm((L, N_EXPERTS, EXPERT_DIM, D), EXPERT_DIM ** -0.5),
        "norm_final": gain((D,)),
    }


def reference(x, positions, rel_bias, norm_attn, w_in, b_merge, cmp_pe, cmp_k_w1, cmp_k_b1, cmp_k_w2,
              cmp_v_w1, cmp_v_b1, cmp_v_w2, mla_q_norm, mla_kv_norm, mla_w_uq, mla_w_uk, mla_w_uv, fox_b_f,
              w_o_nsa, w_o_mla, w_o_fox, w_out, norm_ffn, moe_w_grp, moe_b_grp, moe_w_router, moe_b_router,
              moe_w_gate, moe_w_up, moe_w_down, norm_final):
    B, T, D = x.shape
    split_points = [int(c) for c in np.cumsum(IN_SPLITS)[:-1]]
    for l in range(DEPTH):
        h = rmsnorm(x, norm_attn[l])
        proj = h @ w_in[l]
        nsa_q, nsa_kv, nsa_g, mla_cq, mla_ckv, mla_kr, fox_qkv, fox_f, merge_logits = jnp.split(proj, split_points, axis=-1)

        q_a = nsa_q.reshape(B, T, NSA_HEADS, NSA_HEAD_DIM)
        kv_a = nsa_kv.reshape(B, T, 3, 2, NSA_KV_GROUPS, NSA_HEAD_DIM)
        out_a = nsa_attention(q_a, kv_a[:, :, 0, 0], kv_a[:, :, 0, 1], kv_a[:, :, 1, 0], kv_a[:, :, 1, 1],
                              kv_a[:, :, 2, 0], kv_a[:, :, 2, 1], nsa_g.reshape(B, T, NSA_HEADS, 3), rel_bias,
                              cmp_pe[l], cmp_k_w1[l], cmp_k_b1[l], cmp_k_w2[l], cmp_v_w1[l], cmp_v_b1[l], cmp_v_w2[l])

        c_q = rmsnorm(mla_cq, mla_q_norm[l])
        q_b = (c_q @ mla_w_uq[l]).reshape(B, T, MLA_HEADS, MLA_QK_DIM)
        q_b = jnp.concatenate([q_b[..., :MLA_NOPE_DIM], rope(q_b[..., MLA_NOPE_DIM:], positions)], axis=-1)
        c_kv = rmsnorm(mla_ckv, mla_kv_norm[l])
        k_nope = (c_kv @ mla_w_uk[l]).reshape(B, T, MLA_HEADS, MLA_NOPE_DIM)
        v_b = (c_kv @ mla_w_uv[l]).reshape(B, T, MLA_HEADS, MLA_V_DIM)
        k_rope = rope(mla_kr, positions)
        k_b = jnp.concatenate([k_nope, jnp.broadcast_to(k_rope[:, :, None, :], (B, T, MLA_HEADS, MLA_ROPE_DIM))], axis=-1)
        out_b = causal_block_attention(q_b, k_b, v_b, MLA_QK_DIM ** -0.5).reshape(B, T, MLA_HEADS * MLA_V_DIM)

        qkv_c = fox_qkv.reshape(B, T, 3, FOX_HEADS, FOX_HEAD_DIM)
        log_f = jax.nn.log_sigmoid(fox_f.astype(jnp.float32) + fox_b_f[l].astype(jnp.float32))
        cum_log_f = jnp.cumsum(log_f, axis=1)
        out_c = causal_block_attention(qkv_c[:, :, 0], qkv_c[:, :, 1], qkv_c[:, :, 2], FOX_HEAD_DIM ** -0.5,
                                       cum_log_f).reshape(B, T, FOX_HEADS * FOX_HEAD_DIM)

        gates = jax.nn.sigmoid((merge_logits + b_merge[l]).astype(jnp.float32)).reshape(B, T, N_BRANCHES, D)
        mixed = (gates[:, :, 0] * (out_a @ w_o_nsa[l]) + gates[:, :, 1] * (out_b @ w_o_mla[l])
                 + gates[:, :, 2] * (out_c @ w_o_fox[l]))
        x = x + mixed.astype(x.dtype) @ w_out[l]

        x = x + hier_moe(rmsnorm(x, norm_ffn[l]), moe_w_grp[l], moe_b_grp[l], moe_w_router[l], moe_b_router[l],
                         moe_w_gate[l], moe_w_up[l], moe_w_down[l])
    return rmsnorm(x, norm_final)
```

```cpp
#include <hip/hip_runtime.h>
#include <stdint.h>
#include <cstdio>

#ifndef MK_ONE_LAUNCH
#define MK_ONE_LAUNCH 1
#endif

#define LAS __attribute__((address_space(3)))
typedef unsigned short bf16_t;
typedef short bf16x8 __attribute__((ext_vector_type(8)));
typedef float f32x4 __attribute__((ext_vector_type(4)));
typedef float f32x16 __attribute__((ext_vector_type(16)));
typedef unsigned u32x4 __attribute__((ext_vector_type(4)));
typedef unsigned u32x2 __attribute__((ext_vector_type(2)));

constexpr int NB = 2, T = 8192, D = 1024, M = NB * T, NL = 2;
constexpr int DIN = 6336;
constexpr int P1W = 3328;
constexpr int C_NQ = 0, C_NKV = 512, C_CQ = 1280, C_CKV = 1536, C_KR = 1664, C_NG = 1696, C_FF = 1720, C_FQKV = 1728;
constexpr int NEXP = 32, EDIM = 256;
constexpr float EPS = 1e-6f;
constexpr int NTHREADS = 512, NWAVES = 8;
constexpr int LDS_BYTES = 147456;
constexpr int MOE_MAXROWS = 40960;

constexpr size_t MiB = 1u << 20;
constexpr size_t WS_CTL = 0;
constexpr size_t CTL_BYTES = 1 * MiB;
constexpr int CW_BAR = 4096;
constexpr int CW_QUEUE = 16384;
constexpr int CW_MOECNT = 32768;
constexpr size_t CTL_LTOK = 512 * 1024;
constexpr size_t WS_WINT = 1 * MiB;
constexpr size_t WS_WMT = 14 * MiB;
constexpr size_t WS_WUQT = 26 * MiB;
constexpr size_t WS_WUKVT = 27 * MiB;
constexpr size_t WS_WOT = 28 * MiB;
constexpr size_t WS_WOUTT = 34 * MiB;
constexpr size_t WS_WC1T = 38 * MiB;
constexpr size_t WS_ROPE = 42 * MiB;
constexpr size_t WS_TAB = 44 * MiB;
constexpr size_t WS_XA = 45 * MiB;
constexpr size_t PB = 109 * MiB;
constexpr size_t WS_P1 = PB;
constexpr size_t WS_QB = PB + 104 * MiB;
constexpr size_t WS_KVB = PB + 128 * MiB;
constexpr size_t WS_OUTA = PB + 160 * MiB;
constexpr size_t WS_OUTB = PB + 176 * MiB;
constexpr size_t WS_OUTC = PB + 192 * MiB;
constexpr size_t WS_H0 = PB + 176 * MiB;
constexpr size_t WS_SM = PB + 208 * MiB;
constexpr size_t WS_RSTD = WS_SM;
constexpr size_t WS_KR = WS_SM + 256 * 1024;
constexpr size_t WS_LF = WS_SM + 1280 * 1024;
constexpr size_t WS_CUM = WS_SM + 1792 * 1024;
constexpr size_t WS_HC = WS_SM + 2304 * 1024;
constexpr size_t WS_KC = WS_SM + 3328 * 1024;
constexpr size_t WS_VC = WS_SM + 3584 * 1024;
constexpr size_t WS_REC = WS_SM + 3840 * 1024;
constexpr size_t WS_LTOK = WS_SM + 4352 * 1024;
constexpr size_t WS_LW = WS_SM + 4608 * 1024;
constexpr size_t WS_LSLOT = WS_SM + 4864 * 1024;
constexpr size_t WS_END = PB + 216 * MiB;
constexpr size_t WS_HG = PB;
constexpr size_t WS_GATES = PB + 32 * MiB;
constexpr size_t WS_MIXED = PB + 128 * MiB;
constexpr size_t WS_H2 = PB;
constexpr size_t WS_WGU = PB + 32 * MiB;
constexpr size_t WS_WDT = PB + 64 * MiB;
constexpr size_t WS_HID = PB + 80 * MiB;
constexpr size_t WS_Y = PB + 100 * MiB;
static_assert(WS_Y + 64 * MiB <= WS_H0, "Y must not overlap H0");
static_assert(WS_END <= 332 * MiB, "workspace budget");

__device__ __forceinline__ float bf2f(bf16_t v) { return __uint_as_float((unsigned)v << 16); }
__device__ __forceinline__ unsigned f2bf(float f) { unsigned u = __float_as_uint(f); return (u + 0x7fffu + ((u >> 16) & 1u)) >> 16; }
__device__ __forceinline__ unsigned pk2(float lo, float hi) { return f2bf(lo) | (f2bf(hi) << 16); }
template <int CTRL> __device__ __forceinline__ float dpp_f(float v) { return __int_as_float(__builtin_amdgcn_update_dpp(0, __float_as_int(v), CTRL, 0xf, 0xf, true)); }
__device__ __forceinline__ float wave_sum(float v) {
    v += dpp_f<0xB1>(v); v += dpp_f<0x4E>(v); v += dpp_f<0x141>(v); v += dpp_f<0x140>(v);
    const float a = __int_as_float(__builtin_amdgcn_readlane(__float_as_int(v), 0)), b = __int_as_float(__builtin_amdgcn_readlane(__float_as_int(v), 16));
    const float c2 = __int_as_float(__builtin_amdgcn_readlane(__float_as_int(v), 32)), d = __int_as_float(__builtin_amdgcn_readlane(__float_as_int(v), 48));
    return (a + b) + (c2 + d);
}
__device__ __forceinline__ float wave_max(float v) {
    v = fmaxf(v, dpp_f<0xB1>(v)); v = fmaxf(v, dpp_f<0x4E>(v)); v = fmaxf(v, dpp_f<0x141>(v)); v = fmaxf(v, dpp_f<0x140>(v));
    const float a = __int_as_float(__builtin_amdgcn_readlane(__float_as_int(v), 0)), b = __int_as_float(__builtin_amdgcn_readlane(__float_as_int(v), 16));
    const float c2 = __int_as_float(__builtin_amdgcn_readlane(__float_as_int(v), 32)), d = __int_as_float(__builtin_amdgcn_readlane(__float_as_int(v), 48));
    return fmaxf(fmaxf(a, b), fmaxf(c2, d));
}
__device__ __forceinline__ float sigmoidf_(float x) { return 1.f / (1.f + __expf(-x)); }
__device__ __forceinline__ float gelu_tanh(float x) { const float u = 0.7978845608028654f * (x + 0.044715f * x * x * x); const float th = 1.f - 2.f / (1.f + __expf(2.f * u)); return 0.5f * x * (1.f + th); }
#define LDS_WAIT() asm volatile("s_waitcnt lgkmcnt(0)" ::: "memory")

#define XB_TMO      128
#define XB_XCNT(j)  (256  + 64 * (j))
#define XB_XSUB(j)  (1280 + 64 * (j))
#define XB_XGEN(j)  (2304 + 64 * (j))
#define XB_TOP      3328
#define XB_TOPGEN   3392
#define XCD_BAR_WORDS 3456
#define XB_SPIN_CAP (1u << 18)

__device__ __forceinline__ unsigned xb_ld(unsigned* p)              { return __hip_atomic_load(p, __ATOMIC_RELAXED, __HIP_MEMORY_SCOPE_AGENT); }
__device__ __forceinline__ unsigned xb_add(unsigned* p, unsigned v) { return __hip_atomic_fetch_add(p, v, __ATOMIC_RELAXED, __HIP_MEMORY_SCOPE_AGENT); }
__device__ __forceinline__ unsigned xb_xcc_id() { return (unsigned)__builtin_amdgcn_s_getreg((3 << 11) | 20) & 0xFu; }
#define XB_SPIN(cond, bar) do { unsigned _sp = 0; while (cond) { __builtin_amdgcn_s_sleep(1); \
    if ((++_sp & 255u) == 0u) { if (xb_ld(&(bar)[XB_TMO])) break; if (_sp > XB_SPIN_CAP) { atomicAdd(&(bar)[XB_TMO], 1u); break; } } } } while (0)

struct XcdBarrier { unsigned* bar; unsigned x; volatile LAS unsigned* st; };

__device__ __forceinline__ XcdBarrier xcd_barrier_post(unsigned* bar, volatile LAS unsigned* st) {
    XcdBarrier b; b.bar = bar; b.x = xb_xcc_id(); b.st = st;
    if (threadIdx.x == 0) (void)xb_add(&bar[XB_XCNT(b.x)], 1u);
    return b;
}
__device__ __forceinline__ void xcd_barrier_complete(unsigned* bar, unsigned x, unsigned& nloc, unsigned& nx) {
    const unsigned G = gridDim.x * gridDim.y * gridDim.z;
    unsigned sum, cnt, mine, sp = 0u;
    for (;;) {
        sum = 0u; cnt = 0u; mine = 0u;
#pragma unroll
        for (unsigned j = 0; j < 16; ++j) { const unsigned c = xb_ld(&bar[XB_XCNT(j)]); sum += c; cnt += (c > 0u) ? 1u : 0u; mine = (j == x) ? c : mine; }
        if (sum == G) break;
        __builtin_amdgcn_s_sleep(1);
        if ((++sp & 255u) == 0u) { if (xb_ld(&bar[XB_TMO])) break; if (sp > XB_SPIN_CAP) { atomicAdd(&bar[XB_TMO], 1u); break; } }
    }
    nloc = mine > 0u ? mine : 1u; nx = cnt > 0u ? cnt : 1u;
}
__device__ __forceinline__ void xcd_barrier(const XcdBarrier& b) {
    asm volatile("s_waitcnt vmcnt(0)" ::: "memory");
    __syncthreads();
    if (threadIdx.x == 0) {
        unsigned* bar = b.bar;
        __builtin_amdgcn_s_waitcnt(0);
        unsigned nloc = b.st[0], nx = b.st[1];
        if (nloc == 0u) { xcd_barrier_complete(bar, b.x, nloc, nx); b.st[0] = nloc; b.st[1] = nx; }
        const unsigned old = xb_add(&bar[XB_XSUB(b.x)], 1u);
        const unsigned gen = old / nloc;
        if (old + 1u == (gen + 1u) * nloc) {
            __builtin_amdgcn_fence(__ATOMIC_RELEASE, "agent");
            asm volatile("s_waitcnt vmcnt(0)" ::: "memory");
            const unsigned og = xb_add(&bar[XB_TOP], 1u);
            const unsigned tg = og / nx;
            if (og + 1u == (tg + 1u) * nx) xb_add(&bar[XB_TOPGEN], 1u);
            else XB_SPIN(xb_ld(&bar[XB_TOPGEN]) == tg, bar);
            __builtin_amdgcn_fence(__ATOMIC_ACQUIRE, "agent");
            xb_add(&bar[XB_XGEN(b.x)], 1u);
            asm volatile("s_waitcnt vmcnt(0)" ::: "memory");
        } else {
            XB_SPIN(xb_ld(&bar[XB_XGEN(b.x)]) == gen, bar);
            __builtin_amdgcn_fence(__ATOMIC_ACQUIRE, "agent");
            asm volatile("s_waitcnt vmcnt(0)" ::: "memory");
        }
    }
    __syncthreads();
}

namespace pg8 {
constexpr int BM = 256, BK = 64, HALF = 128, HTB = HALF * BK * 2, STAGE_BYTES = 8 * HTB;
__host__ __device__ __forceinline__ int lds_byte(int r, int c) { const int st = (r >> 4) * 2 + (c >> 5), rr = r & 15, cc = c & 31, ob = rr * 64 + cc * 2; return st * 1024 + (ob ^ (((ob >> 9) & 1) << 5)); }
__host__ __device__ __forceinline__ void stage_rc(int b, int& R, int& C) { const int st = b / 1024, sb = b % 1024, swz = sb ^ (((sb >> 9) & 1) << 5); R = (st >> 1) * 16 + swz / 64; C = (st & 1) * 32 + (swz % 64) / 2; }

struct Unit { int pm, pn; const char* A; const char* B; int aux; };
struct Cfg { unsigned lda; unsigned kstepA; unsigned ldb; int nt; const int* rowidx; };

struct DenseOrder {
    int nM, nN, nwg, G, c; const char* A; const char* B; size_t tstepA, tstepB;
    __device__ void init(int nM_, int nN_, int G_, int c_, const void* A_, size_t tstepA_, const void* B_, size_t tstepB_) { nM = nM_; nN = nN_; nwg = nM * nN; G = G_; c = c_; A = (const char*)A_; B = (const char*)B_; tstepA = tstepA_; tstepB = tstepB_; }
    __device__ bool next(int i, Unit& u) const {
        const long Lq = (long)i * G + c; if (Lq >= nwg) return false;
        int wgid = (int)Lq; { const int q = nwg / 8, r = nwg % 8, xcd = wgid % 8, off = wgid / 8; wgid = (xcd < r ? xcd * (q + 1) : r * (q + 1) + (xcd - r) * q) + off; }
        const int nig = 8 * nN, gid = wgid / nig, fm = gid * 8, gsz = (nM - fm) < 8 ? (nM - fm) : 8;
        u.pm = fm + ((wgid % nig) % gsz); u.pn = (wgid % nig) / gsz; u.A = A + (size_t)u.pm * tstepA; u.B = B + (size_t)u.pn * tstepB; u.aux = 0; return true;
    }
};

#define PG8_EPI_ROWCOL(row, col) const int row = u.pm * 256 + ai * 128 + wr * 64 + m * 16 + fr; const int col = u.pn * 256 + bj * 128 + wc * 32 + n * 16 + fq * 4;

template <bool INDEXED, class Epi, class Sched>
__device__ __forceinline__ void gemm_phase(LAS unsigned char* lds, const Cfg g, const Sched& S, const Epi& E) {
    int tid_ = threadIdx.x; asm volatile("" : "+v"(tid_));
    const int tid = tid_, wid = __builtin_amdgcn_readfirstlane(tid >> 6), lane = tid & 63, wr = wid >> 2, wc = wid & 3, fr = lane & 15, fq = lane >> 4;
    const int nt = g.nt;
    int Rs[2], Cs[2]; unsigned voffB[2];
#pragma unroll
    for (int i = 0; i < 2; ++i) { stage_rc(tid * 16 + i * 8192, Rs[i], Cs[i]); voffB[i] = (unsigned)Rs[i] * g.ldb + (unsigned)Cs[i] * 2u; }
    const size_t kstepA = g.kstepA, kstepB = (size_t)(BK * 2);
    const size_t hstepB = (size_t)HALF * g.ldb;
    const unsigned ldsw = (unsigned)wid * 1024u;
    const int aoff = lds_byte(wr * 64 + fr, fq * 8), boff = lds_byte(wc * 32 + fr, fq * 8);
#define PG8_SA(b, h) (((b) * 2 + (h)) * HTB)
#define PG8_SB(b, h) ((4 + (b) * 2 + (h)) * HTB)
#define PG8_STAGE2(bufoff, gbase, v0, v1) do { const char* gb_ = (const char*)(gbase); asm volatile("" : "+s"(gb_)); \
        __builtin_amdgcn_global_load_lds((const unsigned*)(gb_ + (v0)), (LAS unsigned*)(lds + (bufoff) + ldsw), 16, 0, 0); \
        __builtin_amdgcn_global_load_lds((const unsigned*)(gb_ + (v1)), (LAS unsigned*)(lds + (bufoff) + ldsw + 8192), 16, 0, 0); } while (0)
#define PG8_STAGEB(bufoff, gbase) PG8_STAGE2(bufoff, gbase, voffB[0], voffB[1])
#define PG8_LDA(dst, b, h) do { _Pragma("unroll") for (int m = 0; m < 4; ++m) _Pragma("unroll") for (int k = 0; k < 2; ++k) dst[m][k] = *(const LAS bf16x8*)(lds + PG8_SA(b, h) + aoff + m * 2048 + k * 1024); } while (0)
#define PG8_LDB(dst, b, h) do { _Pragma("unroll") for (int n = 0; n < 2; ++n) _Pragma("unroll") for (int k = 0; k < 2; ++k) dst[n][k] = *(const LAS bf16x8*)(lds + PG8_SB(b, h) + boff + n * 2048 + k * 1024); } while (0)
#define PG8_MMA(ai, bj, At, Bt) do { __builtin_amdgcn_s_setprio(1); _Pragma("unroll") for (int m = 0; m < 4; ++m) _Pragma("unroll") for (int n = 0; n < 2; ++n) _Pragma("unroll") for (int k = 0; k < 2; ++k) \
        acc[ai][bj][m][n] = __builtin_amdgcn_mfma_f32_16x16x32_bf16(Bt[n][k], At[m][k], acc[ai][bj][m][n], 0, 0, 0); __builtin_amdgcn_s_setprio(0); } while (0)
#define PG8_WAIT_V(n) asm volatile("s_waitcnt vmcnt(" #n ")" ::: "memory")
#define PG8_WAIT_L(n) asm volatile("s_waitcnt lgkmcnt(" #n ")" ::: "memory")
#define PG8_BAR __builtin_amdgcn_s_barrier()
#define PG8_SCHED __builtin_amdgcn_sched_barrier(0)
    Unit cur, nxt; int ui = 0;
    if (!S.next(0, cur)) return;
    unsigned vAc[2][2], vAn[2][2];
#define PG8_SETVA(v, U) do { _Pragma("unroll") for (int h_ = 0; h_ < 2; ++h_) _Pragma("unroll") for (int i_ = 0; i_ < 2; ++i_) { \
        if constexpr (INDEXED) { const int r_ = g.rowidx[(U).aux + h_ * HALF + Rs[i_]]; v[h_][i_] = (unsigned)r_ * g.lda + (unsigned)Cs[i_] * 2u; } \
        else v[h_][i_] = (unsigned)(h_ * HALF + Rs[i_]) * g.lda + (unsigned)Cs[i_] * 2u; } } while (0)
    PG8_SETVA(vAc, cur);
    f32x4 acc[2][2][4][2];
#pragma unroll
    for (int a = 0; a < 2; ++a)
#pragma unroll
        for (int b = 0; b < 2; ++b)
#pragma unroll
            for (int m = 0; m < 4; ++m)
#pragma unroll
                for (int n = 0; n < 2; ++n) acc[a][b][m][n] = (f32x4){0.f, 0.f, 0.f, 0.f};
    bf16x8 At[4][2], B0[2][2], B1[2][2];
    const char* cA = cur.A; const char* cB = cur.B;
    PG8_STAGEB(PG8_SB(0, 0), cB); PG8_STAGEB(PG8_SB(0, 1), cB + hstepB); PG8_STAGE2(PG8_SA(0, 0), cA, vAc[0][0], vAc[0][1]); PG8_STAGE2(PG8_SA(0, 1), cA, vAc[1][0], vAc[1][1]);
    if (wr == 1) PG8_BAR;
    PG8_WAIT_V(2); PG8_BAR;
    PG8_STAGEB(PG8_SB(1, 0), cB + kstepB); PG8_STAGE2(PG8_SA(1, 0), cA + kstepA, vAc[0][0], vAc[0][1]); PG8_STAGEB(PG8_SB(1, 1), cB + hstepB + kstepB);
    PG8_WAIT_V(6); PG8_BAR;
    for (;;) {
        const bool has_next = S.next(ui + 1, nxt);
        const char* nA = has_next ? nxt.A : cA; const char* nB = has_next ? nxt.B : cB;
        if (has_next) { PG8_SETVA(vAn, nxt); } else {
#pragma unroll
            for (int h_ = 0; h_ < 2; ++h_)
#pragma unroll
                for (int i_ = 0; i_ < 2; ++i_) vAn[h_][i_] = vAc[h_][i_]; }
        for (int t = 0; t < nt; t += 2) {
            const bool last = (t == nt - 2);
            const char* a1 = cA + (size_t)(t + 1) * kstepA;
            const char* a2 = last ? nA : cA + (size_t)(t + 2) * kstepA; const char* b2 = last ? nB : cB + (size_t)(t + 2) * kstepB;
            const char* a3 = a2 + kstepA; const char* b3 = b2 + kstepB;
            const unsigned w00 = last ? vAn[0][0] : vAc[0][0], w01 = last ? vAn[0][1] : vAc[0][1], w10 = last ? vAn[1][0] : vAc[1][0], w11 = last ? vAn[1][1] : vAc[1][1];
            PG8_LDB(B0, 0, 0); PG8_LDB(B1, 0, 1); PG8_SCHED; PG8_LDA(At, 0, 0); PG8_STAGE2(PG8_SA(1, 1), a1, vAc[1][0], vAc[1][1]);
            PG8_WAIT_V(8); PG8_WAIT_L(0); PG8_BAR; PG8_MMA(0, 0, At, B0); PG8_MMA(0, 1, At, B1); PG8_BAR; PG8_SCHED;
            PG8_LDA(At, 0, 1); PG8_STAGEB(PG8_SB(0, 0), b2); PG8_STAGEB(PG8_SB(0, 1), b2 + hstepB); PG8_STAGE2(PG8_SA(0, 0), a2, w00, w01);
            PG8_WAIT_V(8); PG8_WAIT_L(0); PG8_BAR; PG8_MMA(1, 0, At, B0); PG8_MMA(1, 1, At, B1); PG8_BAR; PG8_SCHED;
            PG8_LDB(B0, 1, 0); PG8_LDB(B1, 1, 1); PG8_SCHED; PG8_LDA(At, 1, 0); PG8_STAGE2(PG8_SA(0, 1), a2, w10, w11);
            PG8_WAIT_V(8); PG8_WAIT_L(0); PG8_BAR; PG8_MMA(0, 0, At, B0); PG8_MMA(0, 1, At, B1); PG8_BAR; PG8_SCHED;
            PG8_LDA(At, 1, 1); PG8_STAGEB(PG8_SB(1, 0), b3); PG8_STAGEB(PG8_SB(1, 1), b3 + hstepB); PG8_STAGE2(PG8_SA(1, 0), a3, w00, w01);
            PG8_WAIT_V(8); PG8_WAIT_L(0); PG8_BAR; PG8_MMA(1, 0, At, B0); PG8_MMA(1, 1, At, B1); PG8_BAR; PG8_SCHED;
        }
        E(acc, cur, wr, wc, fr, fq);
        if (!has_next) break;
#pragma unroll
        for (int a = 0; a < 2; ++a)
#pragma unroll
            for (int b = 0; b < 2; ++b)
#pragma unroll
                for (int m = 0; m < 4; ++m)
#pragma unroll
                    for (int n = 0; n < 2; ++n) acc[a][b][m][n] = (f32x4){0.f, 0.f, 0.f, 0.f};
        cur = nxt; cA = nA; cB = nB; ++ui;
#pragma unroll
        for (int h_ = 0; h_ < 2; ++h_)
#pragma unroll
            for (int i_ = 0; i_ < 2; ++i_) vAc[h_][i_] = vAn[h_][i_];
    }
    PG8_WAIT_V(0);
    if (wr == 0) PG8_BAR;
    PG8_BAR;
#undef PG8_SA
#undef PG8_SB
#undef PG8_STAGE2
#undef PG8_STAGEB
#undef PG8_LDA
#undef PG8_LDB
#undef PG8_MMA
#undef PG8_WAIT_V
#undef PG8_WAIT_L
#undef PG8_BAR
#undef PG8_SCHED
#undef PG8_SETVA
}
}

constexpr int LDS_MISC = 131072;
constexpr int LDS_MOETAB = LDS_MISC + 64;
constexpr int LDS_INTAB = LDS_MISC + 512;
struct Ctx {
    float* out; unsigned char* ws;
    LAS unsigned char* lds;
    int tid, lane, wave, G, bid;
    __device__ __forceinline__ const void* inp(int i) const { const LAS unsigned* p = (const LAS unsigned*)(lds + LDS_INTAB) + 2 * i;
        const unsigned lo = (unsigned)__builtin_amdgcn_readfirstlane((int)p[0]), hi = (unsigned)__builtin_amdgcn_readfirstlane((int)p[1]); return (const void*)(((unsigned long long)hi << 32) | lo); }
    __device__ __forceinline__ const float* x() const { return (const float*)inp(0); }
    __device__ __forceinline__ const int* pos() const { return (const int*)inp(1); }
    __device__ __forceinline__ const float* rel_bias() const { return (const float*)inp(2); }
    __device__ __forceinline__ const float* norm_attn() const { return (const float*)inp(3); }
    __device__ __forceinline__ const float* w_in() const { return (const float*)inp(4); }
    __device__ __forceinline__ const float* b_merge() const { return (const float*)inp(5); }
    __device__ __forceinline__ const float* cmp_pe() const { return (const float*)inp(6); }
    __device__ __forceinline__ const float* cmp_k_w1() const { return (const float*)inp(7); }
    __device__ __forceinline__ const float* cmp_k_b1() const { return (const float*)inp(8); }
    __device__ __forceinline__ const float* cmp_k_w2() const { return (const float*)inp(9); }
    __device__ __forceinline__ const float* cmp_v_w1() const { return (const float*)inp(10); }
    __device__ __forceinline__ const float* cmp_v_b1() const { return (const float*)inp(11); }
    __device__ __forceinline__ const float* cmp_v_w2() const { return (const float*)inp(12); }
    __device__ __forceinline__ const float* mla_q_norm() const { return (const float*)inp(13); }
    __device__ __forceinline__ const float* mla_kv_norm() const { return (const float*)inp(14); }
    __device__ __forceinline__ const float* mla_w_uq() const { return (const float*)inp(15); }
    __device__ __forceinline__ const float* mla_w_uk() const { return (const float*)inp(16); }
    __device__ __forceinline__ const float* mla_w_uv() const { return (const float*)inp(17); }
    __device__ __forceinline__ const float* fox_b_f() const { return (const float*)inp(18); }
    __device__ __forceinline__ const float* w_o_nsa() const { return (const float*)inp(19); }
    __device__ __forceinline__ const float* w_o_mla() const { return (const float*)inp(20); }
    __device__ __forceinline__ const float* w_o_fox() const { return (const float*)inp(21); }
    __device__ __forceinline__ const float* w_out() const { return (const float*)inp(22); }
    __device__ __forceinline__ const float* norm_ffn() const { return (const float*)inp(23); }
    __device__ __forceinline__ const float* moe_w_grp() const { return (const float*)inp(24); }
    __device__ __forceinline__ const float* moe_b_grp() const { return (const float*)inp(25); }
    __device__ __forceinline__ const float* moe_w_router() const { return (const float*)inp(26); }
    __device__ __forceinline__ const float* moe_b_router() const { return (const float*)inp(27); }
    __device__ __forceinline__ const float* moe_w_gate() const { return (const float*)inp(28); }
    __device__ __forceinline__ const float* moe_w_up() const { return (const float*)inp(29); }
    __device__ __forceinline__ const float* moe_w_down() const { return (const float*)inp(30); }
    __device__ __forceinline__ const float* norm_final() const { return (const float*)inp(31); }
};
#define WSP(T_, off) ((T_*)(c.ws + (off)))
__device__ __forceinline__ void relaunder(Ctx& c) { int t = threadIdx.x; asm volatile("" : "+v"(t)); c.tid = t; c.lane = t & 63; c.wave = __builtin_amdgcn_readfirstlane(t >> 6);
    unsigned char* w = c.ws; asm volatile("" : "+s"(w)); c.ws = w; }

template <class Map>
__device__ __forceinline__ void transpose_item(const float* W, int ldw, int K, bf16_t* WT, const float* rowscale, Map srcmap, int nblk, LAS float* scr, int item, int lane) {
    const int kb = item / nblk, nb = item % nblk, k0 = 64 * kb, n0 = 32 * nb;
    const int sc = srcmap(n0 + (lane & 31));
#pragma unroll 8
    for (int i = 0; i < 32; ++i) { const int kk = 2 * i + (lane >> 5); float v = 0.f; if (sc >= 0) { v = W[(size_t)(k0 + kk) * ldw + sc]; if (rowscale) v *= rowscale[k0 + kk]; } scr[kk * 33 + (lane & 31)] = v; }
    LDS_WAIT(); asm volatile("" ::: "memory");
    const int cc = lane & 7;
#pragma unroll
    for (int j = 0; j < 4; ++j) { const int n = (lane >> 3) + 8 * j; const LAS float* s = scr + (8 * cc) * 33 + n;
        u32x4 o; o.x = pk2(s[0 * 33], s[1 * 33]); o.y = pk2(s[2 * 33], s[3 * 33]); o.z = pk2(s[4 * 33], s[5 * 33]); o.w = pk2(s[6 * 33], s[7 * 33]);
        *(u32x4*)(WT + (size_t)(n0 + n) * K + k0 + 8 * cc) = o; }
    LDS_WAIT(); asm volatile("" ::: "memory");
}
struct MapId { int off; __device__ int operator()(int n) const { return n + off; } };
struct MapInproj { __device__ int operator()(int n) const { if (n < 1280) return n; if (n < 1696) return n + 24; if (n < 1720) return n - 416; if (n < 1728) return n + 1536; if (n < 3264) return n - 8; return -1; } };
struct MapUq { __device__ int operator()(int n) const { if (n < 512) return (n >> 6) * 96 + (n & 63); const int r = n - 512; return (r >> 5) * 96 + 64 + (r & 31); } };
struct MapPad128 { __device__ int operator()(int n) const { return n < 128 ? n : -1; } };
struct MapGU { __device__ int operator()(int n) const { return (n >> 8) * 128 + (n & 127); } };

__device__ __forceinline__ int rel_bucket_dev(int n) {
    if (n < 16) return n;
    const float lr = __logf((float)n / 16.f) / 2.0794415416798357f;
    int large = 16 + (int)(lr * 16.f);
    return large < 31 ? large : 31;
}

__device__ __forceinline__ void phase_prologue(const Ctx& c) {
    LAS float* scr = (LAS float*)(c.lds + c.wave * 16384);
    const int gw = c.bid * NWAVES + c.wave, NGW = c.G * NWAVES;
    constexpr int I_WIN = 16 * (P1W / 32), I_WM = 16 * 96, I_UQ = 4 * 24, I_UK = 2 * 16, I_UV = 2 * 16, I_WO = 8 * 32, I_WOUT = 16 * 32, I_C1 = 32 * 8;
    constexpr int PER_L = I_WIN + I_WM + I_UQ + I_UK + I_UV + 3 * I_WO + I_WOUT + 2 * I_C1;
    for (int it = gw; it < NL * PER_L; it += NGW) {
        const int l = it / PER_L; int r = it % PER_L;
        if (r < I_WIN) { transpose_item(c.w_in() + (size_t)l * D * DIN, DIN, D, WSP(bf16_t, WS_WINT) + (size_t)l * P1W * D, c.norm_attn() + l * D, MapInproj{}, P1W / 32, scr, r, c.lane); continue; } r -= I_WIN;
        if (r < I_WM) { transpose_item(c.w_in() + (size_t)l * D * DIN, DIN, D, WSP(bf16_t, WS_WMT) + (size_t)l * 3072 * D, c.norm_attn() + l * D, MapId{3264}, 96, scr, r, c.lane); continue; } r -= I_WM;
        if (r < I_UQ) { transpose_item(c.mla_w_uq() + (size_t)l * 256 * 768, 768, 256, WSP(bf16_t, WS_WUQT) + (size_t)l * 768 * 256, c.mla_q_norm() + l * 256, MapUq{}, 24, scr, r, c.lane); continue; } r -= I_UQ;
        if (r < I_UK) { transpose_item(c.mla_w_uk() + (size_t)l * 128 * 512, 512, 128, WSP(bf16_t, WS_WUKVT) + (size_t)l * 1024 * 128, c.mla_kv_norm() + l * 128, MapId{0}, 16, scr, r, c.lane); continue; } r -= I_UK;
        if (r < I_UV) { transpose_item(c.mla_w_uv() + (size_t)l * 128 * 512, 512, 128, WSP(bf16_t, WS_WUKVT) + (size_t)l * 1024 * 128 + 512 * 128, c.mla_kv_norm() + l * 128, MapId{0}, 16, scr, r, c.lane); continue; } r -= I_UV;
        if (r < I_WO) { transpose_item(c.w_o_nsa() + (size_t)l * 512 * 1024, 1024, 512, WSP(bf16_t, WS_WOT) + ((size_t)l * 3 + 0) * 1024 * 512, nullptr, MapId{0}, 32, scr, r, c.lane); continue; } r -= I_WO;
        if (r < I_WO) { transpose_item(c.w_o_mla() + (size_t)l * 512 * 1024, 1024, 512, WSP(bf16_t, WS_WOT) + ((size_t)l * 3 + 1) * 1024 * 512, nullptr, MapId{0}, 32, scr, r, c.lane); continue; } r -= I_WO;
        if (r < I_WO) { transpose_item(c.w_o_fox() + (size_t)l * 512 * 1024, 1024, 512, WSP(bf16_t, WS_WOT) + ((size_t)l * 3 + 2) * 1024 * 512, nullptr, MapId{0}, 32, scr, r, c.lane); continue; } r -= I_WO;
        if (r < I_WOUT) { transpose_item(c.w_out() + (size_t)l * D * D, D, D, WSP(bf16_t, WS_WOUTT) + (size_t)l * D * D, nullptr, MapId{0}, 32, scr, r, c.lane); continue; } r -= I_WOUT;
        { const int kv = r / I_C1; const float* w = (kv == 0 ? c.cmp_k_w1() : c.cmp_v_w1()) + (size_t)l * 2048 * 128;
          transpose_item(w, 128, 2048, WSP(bf16_t, WS_WC1T) + ((size_t)l * 2 + kv) * 256 * 2048, nullptr, MapPad128{}, 8, scr, r % I_C1, c.lane); }
    }
    { float* rc = WSP(float, WS_ROPE); float* rs = rc + (size_t)M * 16;
      for (int i = c.bid * NTHREADS + c.tid; i < M * 16; i += c.G * NTHREADS) { const int m = i >> 4, j = i & 15;
          const float inv = exp2f(-(float)j * 0.8304820237218407f);   const float ang = (float)c.pos()[m] * inv; double rev = (double)ang * 0.15915494309189535; rev -= floor(rev); const float fr_ = (float)rev; rc[i] = __builtin_amdgcn_cosf(fr_); rs[i] = __builtin_amdgcn_sinf(fr_); } }
    float* tab = WSP(float, WS_TAB);
    if (c.bid == 0) {
        const int l = c.tid >> 8, kv = (c.tid >> 7) & 1, j = c.tid & 127;
        const float* w1 = (kv == 0 ? c.cmp_k_w1() : c.cmp_v_w1()) + (size_t)l * 2048 * 128; const float* b1 = (kv == 0 ? c.cmp_k_b1() : c.cmp_v_b1()) + l * 128; const float* pe = c.cmp_pe() + l * 2048;
        float s = b1[j]; for (int k = 0; k < 2048; ++k) s += pe[k] * w1[(size_t)k * 128 + j];
        tab[c.tid] = s;
    }
    if (c.bid == 1 % c.G) {
        for (int i = c.tid; i < 8 * 129; i += NTHREADS) { const int h = i / 129, d = i % 129; tab[512 + h * 132 + d] = c.rel_bias()[rel_bucket_dev(d) * 8 + h]; }
    }
}

__device__ __forceinline__ void phase_norm(const Ctx& c, const float* src, const bf16_t* y0, const bf16_t* y1, float* rout, bf16_t* hout) {
    const int gw = c.bid * NWAVES + c.wave, NGW = c.G * NWAVES;
    for (int m = gw; m < M; m += NGW) {
        const f32x4* xr = (const f32x4*)(src + (size_t)m * D) + c.lane;
        f32x4 v[4]; float s = 0.f;
#pragma unroll
        for (int j = 0; j < 4; ++j) { v[j] = xr[64 * j];
            if (y0) { const u32x2 a = *((const u32x2*)(y0 + (size_t)m * D) + c.lane + 64 * j); const u32x2 b = *((const u32x2*)(y1 + (size_t)m * D) + c.lane + 64 * j);
                v[j].x += __uint_as_float(a.x << 16) + __uint_as_float(b.x << 16); v[j].y += __uint_as_float(a.x & 0xffff0000u) + __uint_as_float(b.x & 0xffff0000u);
                v[j].z += __uint_as_float(a.y << 16) + __uint_as_float(b.y << 16); v[j].w += __uint_as_float(a.y & 0xffff0000u) + __uint_as_float(b.y & 0xffff0000u); }
            s += (v[j].x * v[j].x + v[j].y * v[j].y) + (v[j].z * v[j].z + v[j].w * v[j].w); }
        const float rstd = rsqrtf(wave_sum(s) * (1.f / D) + EPS);
        if (rout) { f32x4* ro = (f32x4*)(rout + (size_t)m * D) + c.lane;
#pragma unroll
            for (int j = 0; j < 4; ++j) ro[64 * j] = v[j]; }
        u32x2* o8 = (u32x2*)(hout + (size_t)m * D) + c.lane;
#pragma unroll
        for (int j = 0; j < 4; ++j) { u32x2 w; w.x = pk2(v[j].x * rstd, v[j].y * rstd); w.y = pk2(v[j].z * rstd, v[j].w * rstd); o8[64 * j] = w; }
    }
}
__device__ __forceinline__ void phase_final(const Ctx& c) {
    const int gw = c.bid * NWAVES + c.wave, NGW = c.G * NWAVES;
    const float* src = WSP(float, WS_XA); const bf16_t* y0 = WSP(bf16_t, WS_Y); const bf16_t* y1 = y0 + (size_t)M * D;
    for (int m = gw; m < M; m += NGW) {
        const f32x4* xr = (const f32x4*)(src + (size_t)m * D) + c.lane;
        f32x4 v[4]; float s = 0.f;
#pragma unroll
        for (int j = 0; j < 4; ++j) { v[j] = xr[64 * j];
            const u32x2 a = *((const u32x2*)(y0 + (size_t)m * D) + c.lane + 64 * j); const u32x2 b = *((const u32x2*)(y1 + (size_t)m * D) + c.lane + 64 * j);
            v[j].x += __uint_as_float(a.x << 16) + __uint_as_float(b.x << 16); v[j].y += __uint_as_float(a.x & 0xffff0000u) + __uint_as_float(b.x & 0xffff0000u);
            v[j].z += __uint_as_float(a.y << 16) + __uint_as_float(b.y << 16); v[j].w += __uint_as_float(a.y & 0xffff0000u) + __uint_as_float(b.y & 0xffff0000u);
            s += (v[j].x * v[j].x + v[j].y * v[j].y) + (v[j].z * v[j].z + v[j].w * v[j].w); }
        const float rstd = rsqrtf(wave_sum(s) * (1.f / D) + EPS);
        f32x4* ro = (f32x4*)(c.out + (size_t)m * D) + c.lane;
#pragma unroll
        for (int j = 0; j < 4; ++j) { const f32x4 g = *((const f32x4*)c.norm_final() + c.lane + 64 * j); ro[64 * j] = v[j] * rstd * g; }
    }
}

__device__ __forceinline__ void phase_prep(const Ctx& c, int l) {
    const int gw = c.bid * NWAVES + c.wave, NGW = c.G * NWAVES;
    const bf16_t* P1 = WSP(bf16_t, WS_P1); float* rstd = WSP(float, WS_RSTD); bf16_t* KR = WSP(bf16_t, WS_KR); float* LF = WSP(float, WS_LF);
    const float* rc = WSP(float, WS_ROPE); const float* rs = rc + (size_t)M * 16;
    for (int m = gw; m < M; m += NGW) {
        const bf16_t* row = P1 + (size_t)m * P1W;
        const u32x2 a = *((const u32x2*)(row + C_CQ) + c.lane);
        float q0 = __uint_as_float(a.x << 16), q1 = __uint_as_float(a.x & 0xffff0000u), q2 = __uint_as_float(a.y << 16), q3 = __uint_as_float(a.y & 0xffff0000u);
        const float sq = wave_sum(q0 * q0 + q1 * q1 + q2 * q2 + q3 * q3);
        const unsigned b = *((const unsigned*)(row + C_CKV) + c.lane);
        float k0 = __uint_as_float(b << 16), k1 = __uint_as_float(b & 0xffff0000u);
        const float sk = wave_sum(k0 * k0 + k1 * k1);
        if (c.lane == 0) { rstd[2 * m] = rsqrtf(sq * (1.f / 256.f) + EPS); rstd[2 * m + 1] = rsqrtf(sk * (1.f / 128.f) + EPS); }
        if (c.lane < 16) { const float x1 = bf2f(row[C_KR + c.lane]), x2 = bf2f(row[C_KR + 16 + c.lane]); const float cs = rc[m * 16 + c.lane], sn = rs[m * 16 + c.lane];
            KR[m * 32 + c.lane] = (bf16_t)f2bf(x1 * cs - x2 * sn); KR[m * 32 + 16 + c.lane] = (bf16_t)f2bf(x1 * sn + x2 * cs); }
        if (c.lane < 8) { const float f = bf2f(row[C_FF + c.lane]) + c.fox_b_f()[l * 8 + c.lane];
            const float ls = fminf(f, 0.f) - __logf(1.f + __expf(-fabsf(f)));
            const int bb = m / T, t = m % T; LF[((size_t)bb * 8 + c.lane) * T + t] = ls; }
    }
}
__device__ __forceinline__ void phase_cum(const Ctx& c) {
    LAS float* sh = (LAS float*)c.lds;
    for (int s = c.bid; s < NB * 8; s += c.G) {
        const float* lf = WSP(float, WS_LF) + (size_t)s * T; float* cum = WSP(float, WS_CUM) + (size_t)s * T;
        float v[16]; float tot = 0.f;
#pragma unroll
        for (int j = 0; j < 16; ++j) { v[j] = lf[c.tid * 16 + j]; tot += v[j]; }
        sh[c.tid] = tot; __syncthreads();
        if (c.tid == 0) { float run = 0.f; for (int i = 0; i < NTHREADS; ++i) { const float t_ = sh[i]; sh[i] = run; run += t_; } }
        __syncthreads();
        float run = sh[c.tid];
#pragma unroll
        for (int j = 0; j < 16; ++j) { run += v[j]; cum[c.tid * 16 + j] = run; }
        __syncthreads();
    }
}
__device__ __forceinline__ void phase_cmp2_ropeq(const Ctx& c, int l) {
    const bf16_t* HC = WSP(bf16_t, WS_HC);
    for (int i = c.bid * NTHREADS + c.tid; i < 2 * 2048 * 64; i += c.G * NTHREADS) {
        const int kv = i / (2048 * 64), row = (i / 64) % 2048, d = i % 64;
        const float* w2 = (kv == 0 ? c.cmp_k_w2() : c.cmp_v_w2()) + (size_t)l * 128 * 64;
        const bf16_t* h = HC + ((size_t)kv * 2048 + row) * 128; float s = 0.f;
        for (int j = 0; j < 128; ++j) s += bf2f(h[j]) * w2[j * 64 + d];
        (kv == 0 ? WSP(bf16_t, WS_KC) : WSP(bf16_t, WS_VC))[(size_t)row * 64 + d] = (bf16_t)f2bf(s);
    }
    bf16_t* QB = WSP(bf16_t, WS_QB); const float* rc = WSP(float, WS_ROPE); const float* rs = rc + (size_t)M * 16;
    for (int i = c.bid * NTHREADS + c.tid; i < M * 128; i += c.G * NTHREADS) {
        const int m = i >> 7, h = (i >> 4) & 7, j = i & 15;
        bf16_t* p = QB + (size_t)m * 768 + 512 + h * 32; const float x1 = bf2f(p[j]), x2 = bf2f(p[16 + j]); const float cs = rc[m * 16 + j], sn = rs[m * 16 + j];
        p[j] = (bf16_t)f2bf(x1 * cs - x2 * sn); p[16 + j] = (bf16_t)f2bf(x1 * sn + x2 * cs);
    }
}

typedef float f32x2_t __attribute__((ext_vector_type(2))); typedef __bf16 bf16x2_t __attribute__((ext_vector_type(2)));
__device__ __forceinline__ unsigned cvtpk(float lo, float hi) { f32x2_t v = {lo, hi}; bf16x2_t b = __builtin_convertvector(v, bf16x2_t); return __builtin_bit_cast(unsigned, b); }
__device__ __forceinline__ u32x2 pk4(f32x4 v) { u32x2 w; w.x = cvtpk(v.x, v.y); w.y = cvtpk(v.z, v.w); return w; }
__device__ __forceinline__ f32x4 unpk4(u32x2 a) { f32x4 r; r.x = __uint_as_float(a.x << 16); r.y = __uint_as_float(a.x & 0xffff0000u); r.z = __uint_as_float(a.y << 16); r.w = __uint_as_float(a.y & 0xffff0000u); return r; }
#define EPI_ARGS const f32x4 (&acc)[2][2][4][2], const pg8::Unit& u, int wr, int wc, int fr, int fq
#define EPI_LOOP _Pragma("unroll") for (int ai = 0; ai < 2; ++ai) _Pragma("unroll") for (int m = 0; m < 4; ++m) _Pragma("unroll") for (int bj = 0; bj < 2; ++bj) _Pragma("unroll") for (int n = 0; n < 2; ++n)

struct EpiStoreBf16 { bf16_t* O; int ldc; const float* rowscale; int rs_stride;
    __device__ __forceinline__ void operator()(EPI_ARGS) const {
        EPI_LOOP { PG8_EPI_ROWCOL(row, col); f32x4 v = acc[ai][bj][m][n]; if (rowscale) v = v * rowscale[(size_t)row * rs_stride]; *(u32x2*)(O + (size_t)row * ldc + col) = pk4(v); } } };
struct EpiGates { bf16_t* O; const float* bias;
    __device__ __forceinline__ void operator()(EPI_ARGS) const {
        EPI_LOOP { PG8_EPI_ROWCOL(row, col); f32x4 v = acc[ai][bj][m][n] + *(const f32x4*)(bias + col);
            v.x = sigmoidf_(v.x); v.y = sigmoidf_(v.y); v.z = sigmoidf_(v.z); v.w = sigmoidf_(v.w); *(u32x2*)(O + (size_t)row * 3072 + col) = pk4(v); } } };
struct EpiCmp1 { bf16_t* HC; const float* bc1;
    __device__ __forceinline__ void operator()(EPI_ARGS) const {
        const int kv = u.pm >> 3, bg = (u.pm >> 1) & 3, half = u.pm & 1;
#pragma unroll
        for (int ai = 0; ai < 2; ++ai)
#pragma unroll
            for (int m = 0; m < 4; ++m)
#pragma unroll
                for (int n = 0; n < 2; ++n) { const int i = half * 256 + ai * 128 + wr * 64 + m * 16 + fr, cc = wc * 32 + n * 16 + fq * 4;
                    f32x4 v = acc[ai][0][m][n] + *(const f32x4*)(bc1 + kv * 128 + cc);
                    v.x = gelu_tanh(v.x); v.y = gelu_tanh(v.y); v.z = gelu_tanh(v.z); v.w = gelu_tanh(v.w);
                    *(u32x2*)(HC + ((size_t)kv * 2048 + bg * 512 + i) * 128 + cc) = pk4(v); } } };
struct EpiOutproj { bf16_t* MIX; const bf16_t* GATES; int br;
    __device__ __forceinline__ void operator()(EPI_ARGS) const {
        EPI_LOOP { PG8_EPI_ROWCOL(row, col); const f32x4 g = unpk4(*(const u32x2*)(GATES + (size_t)row * 3072 + br * 1024 + col)); f32x4 v = acc[ai][bj][m][n] * g;
            u32x2* p = (u32x2*)(MIX + (size_t)row * 1024 + col); if (br > 0) v = v + unpk4(*p); *p = pk4(v); } } };
struct EpiWout { const float* R; float* XA;
    __device__ __forceinline__ void operator()(EPI_ARGS) const {
        EPI_LOOP { PG8_EPI_ROWCOL(row, col); const f32x4 r = *(const f32x4*)(R + (size_t)row * 1024 + col); *(f32x4*)(XA + (size_t)row * 1024 + col) = r + acc[ai][bj][m][n]; } } };
struct EpiMoe1 { bf16_t* HID; const float* LW;
    __device__ __forceinline__ void operator()(EPI_ARGS) const {
#pragma unroll
        for (int ai = 0; ai < 2; ++ai)
#pragma unroll
            for (int m = 0; m < 4; ++m) { const unsigned pos = (unsigned)(u.aux + ai * 128 + wr * 64 + m * 16 + fr); const float w = LW[pos];
#pragma unroll
                for (int n = 0; n < 2; ++n) { const f32x4 g = acc[ai][0][m][n], up = acc[ai][1][m][n]; f32x4 h;
                    h.x = g.x * sigmoidf_(g.x) * up.x * w; h.y = g.y * sigmoidf_(g.y) * up.y * w; h.z = g.z * sigmoidf_(g.z) * up.z * w; h.w = g.w * sigmoidf_(g.w) * up.w * w;
                    *(u32x2*)(HID + pos * 256u + (unsigned)(u.pn * 128 + wc * 32 + n * 16 + fq * 4)) = pk4(h); }
                asm volatile("" ::: "memory"); } } };
struct EpiMoe2 { bf16_t* Y; const unsigned* LDST;
    __device__ __forceinline__ void operator()(EPI_ARGS) const {
#pragma unroll
        for (int ai = 0; ai < 2; ++ai)
#pragma unroll
            for (int m = 0; m < 4; ++m) { const unsigned pos = (unsigned)(u.aux + ai * 128 + wr * 64 + m * 16 + fr); const unsigned d0 = LDST[pos];
                if (d0 != 0xFFFFFFFFu) { const unsigned off = d0 + (unsigned)(u.pn * 256 + wc * 32 + fq * 4);
#pragma unroll
                    for (int bj = 0; bj < 2; ++bj)
#pragma unroll
                        for (int n = 0; n < 2; ++n) *(u32x2*)(Y + off + bj * 128 + n * 16) = pk4(acc[ai][bj][m][n]); }
                asm volatile("" ::: "memory"); } } };

struct CmpOrder { int G, c; const char* P1; const char* W;
    __device__ bool next(int i, pg8::Unit& u) const { const int L_ = i * G + c; if (L_ >= 16) return false; const int kv = L_ >> 3, b = (L_ >> 2) & 1, g = (L_ >> 1) & 1, half = L_ & 1;
        u.pm = L_; u.pn = 0; u.aux = 0; u.A = P1 + ((size_t)(b * T + 16 * 256 * half) * P1W + C_NKV + (kv * 2 + g) * 64) * 2; u.B = W + (size_t)kv * 256 * 2048 * 2; return true; } };
struct MoeOrder { int G, c, nN; const LAS int* tab; const char* A; size_t a_rowbytes; const char* W; size_t w_expert, w_tile;
    __device__ bool next(int i, pg8::Unit& u) const { const int L_ = i * G + c; const int NT = __builtin_amdgcn_readfirstlane(tab[32]); if (L_ >= NT * nN) return false; const int rt = L_ / nN, pn = L_ % nN;
        int e = 0; while (__builtin_amdgcn_readfirstlane(tab[e + 1]) <= rt) ++e;
        const int off_e = __builtin_amdgcn_readfirstlane(tab[33 + e]), ts_e = __builtin_amdgcn_readfirstlane(tab[e]), cnt_e = __builtin_amdgcn_readfirstlane(tab[66 + e]);
        const int pos0 = off_e + 256 * (rt - ts_e); u.pn = pn; u.aux = pos0; u.pm = off_e + cnt_e;
        u.A = A + (size_t)pos0 * a_rowbytes; u.B = W + (size_t)e * w_expert + (size_t)pn * w_tile; return true; } };
__device__ __forceinline__ void moe_tables(const Ctx& c, int l, LAS int* tab) {
    if (c.tid == 0) { const unsigned* cnt = WSP(unsigned, WS_CTL) + CW_MOECNT + l * 64; int ts = 0, off = 0;
        for (int e = 0; e < 32; ++e) { const int n = (int)cnt[e]; tab[e] = ts; tab[33 + e] = off; tab[66 + e] = n; const int nt_ = (n + 255) >> 8; ts += nt_; off += nt_ * 256; }
        tab[32] = ts; tab[65] = off; }
    __syncthreads();
}

__device__ __forceinline__ void phase_router(const Ctx& c, int l) {
    const int gw = c.bid * NWAVES + c.wave, NGW = c.G * NWAVES;
    const float* XA = WSP(float, WS_XA); bf16_t* H2 = WSP(bf16_t, WS_H2); int* REC = WSP(int, WS_REC); unsigned* cnt = WSP(unsigned, WS_CTL) + CW_MOECNT + l * 64;
    const float* g2 = c.norm_ffn() + l * D; const float* wg = c.moe_w_grp() + (size_t)l * D * 4; const float* wr_ = c.moe_w_router() + (size_t)l * D * 32;
    for (int m = gw; m < M; m += NGW) {
        const f32x4* xr = (const f32x4*)(XA + (size_t)m * D) + c.lane;
        f32x4 v[4]; float s = 0.f;
#pragma unroll
        for (int j = 0; j < 4; ++j) { v[j] = xr[64 * j]; s += (v[j].x * v[j].x + v[j].y * v[j].y) + (v[j].z * v[j].z + v[j].w * v[j].w); }
        const float rstd = rsqrtf(wave_sum(s) * (1.f / D) + EPS);
        u32x2* o8 = (u32x2*)(H2 + (size_t)m * D) + c.lane;
        float lg[36];
#pragma unroll
        for (int o = 0; o < 36; ++o) lg[o] = 0.f;
#pragma unroll
        for (int j = 0; j < 4; ++j) { v[j] = v[j] * rstd; o8[64 * j] = pk4(v[j]);
            const f32x4 gg = *((const f32x4*)g2 + c.lane + 64 * j); const f32x4 tv = v[j] * gg;
#pragma unroll
            for (int e = 0; e < 4; ++e) { const int k = 4 * c.lane + 256 * j + e; const float te = tv[e];
                const f32x4 a = *(const f32x4*)(wg + (size_t)k * 4);
#pragma unroll
                for (int o = 0; o < 4; ++o) lg[o] += te * a[o];
#pragma unroll
                for (int q = 0; q < 8; ++q) { const f32x4 w4 = *(const f32x4*)(wr_ + (size_t)k * 32 + 4 * q);
#pragma unroll
                    for (int o = 0; o < 4; ++o) lg[4 + 4 * q + o] += te * w4[o]; } } }
#pragma unroll
        for (int o = 0; o < 36; ++o) lg[o] = wave_sum(lg[o]);
        float gl[4];
#pragma unroll
        for (int o = 0; o < 4; ++o) gl[o] = lg[o] + c.moe_b_grp()[l * 4 + o];
        int gi = 0; float gm = gl[0];
#pragma unroll
        for (int o = 1; o < 4; ++o) if (gl[o] > gm) { gm = gl[o]; gi = o; }
        float gs = 0.f;
#pragma unroll
        for (int o = 0; o < 4; ++o) gs += __expf(gl[o] - gm);
        const float grp_top = 1.f / gs;
        float el[8];
#pragma unroll
        for (int q = 0; q < 8; ++q) { const float a0 = lg[4 + q], a1 = lg[12 + q], a2 = lg[20 + q], a3 = lg[28 + q]; el[q] = (gi == 0 ? a0 : gi == 1 ? a1 : gi == 2 ? a2 : a3) + c.moe_b_router()[l * 32 + gi * 8 + q]; }
        int i1 = 0; float m1 = el[0];
#pragma unroll
        for (int q = 1; q < 8; ++q) if (el[q] > m1) { m1 = el[q]; i1 = q; }
        int i2 = -1; float m2 = -3.0e38f;
#pragma unroll
        for (int q = 0; q < 8; ++q) if (q != i1 && el[q] > m2) { m2 = el[q]; i2 = q; }
        const float e2 = __expf(m2 - m1); const float w1 = grp_top / (1.f + e2), w2 = grp_top * e2 / (1.f + e2);
        if (c.lane == 0) { const int ea = gi * 8 + i1, eb = gi * 8 + i2; const int ra = (int)atomicAdd(cnt + ea, 1u), rb = (int)atomicAdd(cnt + eb, 1u);
            int* r = REC + (size_t)m * 8; r[0] = ea; r[1] = eb; r[2] = ra; r[3] = rb; r[4] = __float_as_int(w1); r[5] = __float_as_int(w2); }
    }
}
__device__ __forceinline__ void phase_place(const Ctx& c, int l) {
    LAS int* tab = (LAS int*)(c.lds + LDS_MOETAB);
    moe_tables(c, l, tab);
    int* LTOK = WSP(int, WS_LTOK); float* LW = WSP(float, WS_LW); unsigned* LDST = WSP(unsigned, WS_LSLOT); const int* REC = WSP(int, WS_REC);
    for (int m = c.bid * NTHREADS + c.tid; m < M; m += c.G * NTHREADS) { const int* r = REC + (size_t)m * 8;
        const int pa = tab[33 + r[0]] + r[2], pb = tab[33 + r[1]] + r[3];
        LTOK[pa] = m; LDST[pa] = (unsigned)m * 1024u; LW[pa] = __int_as_float(r[4]); LTOK[pb] = m; LDST[pb] = ((unsigned)M + (unsigned)m) * 1024u; LW[pb] = __int_as_float(r[5]); }
    for (int e = c.bid; e < 32; e += c.G) { const int lo = tab[33 + e] + tab[66 + e], hi2 = tab[33 + e + 1];
        for (int p = lo + c.tid; p < hi2; p += NTHREADS) { LTOK[p] = 0; LDST[p] = 0xFFFFFFFFu; LW[p] = 0.f; } }
    LAS float* scr = (LAS float*)(c.lds + c.wave * 16384);
    const int gw = c.bid * NWAVES + c.wave, NGW = c.G * NWAVES;
    constexpr int I_GU = 16 * 16, I_DN = 4 * 32;
    for (int it = gw; it < 32 * (I_GU + I_DN); it += NGW) { const int e = it / (I_GU + I_DN); int r = it % (I_GU + I_DN);
        if (r < I_GU) { const int nb = r % 16; const bool up = ((nb * 32) & 255) >= 128;
            const float* w = (up ? c.moe_w_up() : c.moe_w_gate()) + ((size_t)l * 32 + e) * D * 256;
            transpose_item(w, 256, D, WSP(bf16_t, WS_WGU) + (size_t)e * 512 * D, c.norm_ffn() + l * D, MapGU{}, 16, scr, r, c.lane); }
        else { r -= I_GU; transpose_item(c.moe_w_down() + ((size_t)l * 32 + e) * 256 * D, D, 256, WSP(bf16_t, WS_WDT) + (size_t)e * D * 256, nullptr, MapId{0}, 32, scr, r, c.lane); } }
}

template <int N> __device__ __forceinline__ float dotn(const float* q, const bf16_t* k) {
    float s = 0.f;
#pragma unroll
    for (int c8 = 0; c8 < N / 8; ++c8) { const u32x4 w = *(const u32x4*)(k + 8 * c8);
        s += q[8 * c8 + 0] * __uint_as_float(w.x << 16) + q[8 * c8 + 1] * __uint_as_float(w.x & 0xffff0000u) + q[8 * c8 + 2] * __uint_as_float(w.y << 16) + q[8 * c8 + 3] * __uint_as_float(w.y & 0xffff0000u)
           + q[8 * c8 + 4] * __uint_as_float(w.z << 16) + q[8 * c8 + 5] * __uint_as_float(w.z & 0xffff0000u) + q[8 * c8 + 6] * __uint_as_float(w.w << 16) + q[8 * c8 + 7] * __uint_as_float(w.w & 0xffff0000u); }
    return s;
}
__device__ __forceinline__ void axpy64(float* o, float p, const bf16_t* v) {
#pragma unroll
    for (int c8 = 0; c8 < 8; ++c8) { const u32x4 w = *(const u32x4*)(v + 8 * c8);
        o[8 * c8 + 0] += p * __uint_as_float(w.x << 16); o[8 * c8 + 1] += p * __uint_as_float(w.x & 0xffff0000u); o[8 * c8 + 2] += p * __uint_as_float(w.y << 16); o[8 * c8 + 3] += p * __uint_as_float(w.y & 0xffff0000u);
        o[8 * c8 + 4] += p * __uint_as_float(w.z << 16); o[8 * c8 + 5] += p * __uint_as_float(w.z & 0xffff0000u); o[8 * c8 + 6] += p * __uint_as_float(w.w << 16); o[8 * c8 + 7] += p * __uint_as_float(w.w & 0xffff0000u); }
}
#define ONLINE(sc) do { const float mn_ = fmaxf(mrun, (sc)); lrun = lrun * __expf(mrun - mn_) + __expf((sc) - mn_); mrun = mn_; } while (0)
#define MERGE_ML() const float Mx = wave_max(mrun); const float Ls = wave_sum(mrun == -INFINITY ? 0.f : lrun * __expf(mrun - Mx))
__device__ __forceinline__ void store_o64(float* o, bf16_t* dst, int lane) {
    float r = 0.f;
#pragma unroll
    for (int d = 0; d < 64; ++d) { const float s = wave_sum(o[d]); r = (lane == d) ? s : r; }
    dst[lane] = (bf16_t)f2bf(r);
}

__device__ __forceinline__ void phase_att_fox_naive(const Ctx& c) {
    const int gw = c.bid * NWAVES + c.wave, NGW = c.G * NWAVES;
    const bf16_t* P1 = WSP(bf16_t, WS_P1); bf16_t* OUT = WSP(bf16_t, WS_OUTC);
    for (int item = gw; item < M * 8; item += NGW) {
        const int m = item >> 3, h = item & 7, b = m / T, t = m % T;
        float q[64], o[64];
#pragma unroll
        for (int d = 0; d < 64; ++d) { q[d] = bf2f(P1[(size_t)m * P1W + C_FQKV + h * 64 + d]); o[d] = 0.f; }
        const float* cum = WSP(float, WS_CUM) + ((size_t)b * 8 + h) * T; const float ct = cum[t];
        const bf16_t* Kb = P1 + (size_t)b * T * P1W + C_FQKV + 512 + h * 64; const bf16_t* Vb = Kb + 512;
        float mrun = -INFINITY, lrun = 0.f;
        for (int s = c.lane; s <= t; s += 64) { const float sc = dotn<64>(q, Kb + (size_t)s * P1W) * 0.125f + (ct - cum[s]); ONLINE(sc); }
        MERGE_ML();
        const float inv = 1.f / Ls;
        for (int s = c.lane; s <= t; s += 64) { const float sc = dotn<64>(q, Kb + (size_t)s * P1W) * 0.125f + (ct - cum[s]); axpy64(o, __expf(sc - Mx) * inv, Vb + (size_t)s * P1W); }
        store_o64(o, OUT + (size_t)m * 512 + h * 64, c.lane);
    }
}
__device__ __forceinline__ void phase_att_mla_naive(const Ctx& c) {
    const int gw = c.bid * NWAVES + c.wave, NGW = c.G * NWAVES;
    const bf16_t* QB = WSP(bf16_t, WS_QB); const bf16_t* KVB = WSP(bf16_t, WS_KVB); const bf16_t* KR = WSP(bf16_t, WS_KR); bf16_t* OUT = WSP(bf16_t, WS_OUTB);
    const float scale = 0.10206207261596575f;
    for (int item = gw; item < M * 8; item += NGW) {
        const int m = item >> 3, h = item & 7, b = m / T, t = m % T;
        float q[96], o[64];
#pragma unroll
        for (int d = 0; d < 64; ++d) { q[d] = bf2f(QB[(size_t)m * 768 + h * 64 + d]); o[d] = 0.f; }
#pragma unroll
        for (int d = 0; d < 32; ++d) q[64 + d] = bf2f(QB[(size_t)m * 768 + 512 + h * 32 + d]);
        const bf16_t* Kb = KVB + (size_t)b * T * 1024 + h * 64; const bf16_t* Vb = Kb + 512; const bf16_t* Rb = KR + (size_t)b * T * 32;
        float mrun = -INFINITY, lrun = 0.f;
        for (int s = c.lane; s <= t; s += 64) { const float sc = (dotn<64>(q, Kb + (size_t)s * 1024) + dotn<32>(q + 64, Rb + (size_t)s * 32)) * scale; ONLINE(sc); }
        MERGE_ML();
        const float inv = 1.f / Ls;
        for (int s = c.lane; s <= t; s += 64) { const float sc = (dotn<64>(q, Kb + (size_t)s * 1024) + dotn<32>(q + 64, Rb + (size_t)s * 32)) * scale; axpy64(o, __expf(sc - Mx) * inv, Vb + (size_t)s * 1024); }
        store_o64(o, OUT + (size_t)m * 512 + h * 64, c.lane);
    }
}
__device__ __forceinline__ void phase_att_nsa_naive(const Ctx& c) {
    LAS float* pc = (LAS float*)c.lds;
    LAS float* scw = (LAS float*)(c.lds + 16384) + c.wave * 128;
    const int half = c.wave >> 2, hp = c.wave & 3;
    const bf16_t* P1 = WSP(bf16_t, WS_P1); bf16_t* OUT = WSP(bf16_t, WS_OUTA); const float* tab = WSP(float, WS_TAB);
    for (int it0 = c.bid * 2; it0 < M * 2; it0 += c.G * 2) {
        const int item = it0 + half, m = item >> 1, g = item & 1, b = m / T, t = m % T, h = g * 4 + hp;
        float q[64], o[64];
#pragma unroll
        for (int d = 0; d < 64; ++d) { q[d] = bf2f(P1[(size_t)m * P1W + C_NQ + h * 64 + d]); o[d] = 0.f; }
        const float gc = sigmoidf_(bf2f(P1[(size_t)m * P1W + C_NG + h * 3 + 0])), gs = sigmoidf_(bf2f(P1[(size_t)m * P1W + C_NG + h * 3 + 1])), gwn = sigmoidf_(bf2f(P1[(size_t)m * P1W + C_NG + h * 3 + 2]));
        const float* lut = tab + 512 + h * 132;
        LAS float* pcw = pc + (half * 4 + hp) * 512;
        { const int n_ok = t >= 31 ? ((t - 31) >> 4) + 1 : 0;
          const bf16_t* KCb = WSP(bf16_t, WS_KC) + (size_t)(b * 2 + g) * 512 * 64; const bf16_t* VCb = WSP(bf16_t, WS_VC) + (size_t)(b * 2 + g) * 512 * 64;
          float mrun = -INFINITY, lrun = 0.f;
          for (int i = c.lane; i < n_ok; i += 64) { int dist = t - (16 * i + 31); dist = dist > 128 ? 128 : dist; const float sc = dotn<64>(q, KCb + (size_t)i * 64) * 0.125f + lut[dist]; ONLINE(sc); }
          MERGE_ML();
          const float inv = n_ok > 0 ? 1.f / Ls : 0.f;
          for (int i = c.lane; i < 512; i += 64) { float p = 0.f;
              if (i < n_ok) { int dist = t - (16 * i + 31); dist = dist > 128 ? 128 : dist; const float sc = dotn<64>(q, KCb + (size_t)i * 64) * 0.125f + lut[dist]; p = __expf(sc - Mx) * inv; axpy64(o, p * gc, VCb + (size_t)i * 64); }
              pcw[i] = p; } }
        __syncthreads();
        const int blk = t >> 6;
        { const LAS float* p0 = pc + (half * 4) * 512;
#pragma unroll
          for (int jj = 0; jj < 2; ++jj) { const int j = c.lane + 64 * jj; float imp[5];
#pragma unroll
              for (int e = 0; e < 5; ++e) { const int i = 4 * j + e; imp[e] = (i < 511) ? (p0[i] + p0[512 + i]) + (p0[1024 + i] + p0[1536 + i]) : 0.f; }
              const float ps = imp[0] + 2.f * imp[1] + 2.f * imp[2] + 2.f * imp[3] + imp[4];
              const bool forced = (j == 0) || (j <= blk && j > blk - 2);
              scw[j] = (j <= blk) ? (forced ? 1e9f : ps) : -1e30f; } }
        __syncthreads();
        unsigned long long selmask[2];
#pragma unroll
        for (int jj = 0; jj < 2; ++jj) { const int j = c.lane + 64 * jj; const float sj = scw[j]; int rank = 0;
            for (int k = 0; k < 128; ++k) { const float sk = scw[k]; rank += (sk > sj || (sk == sj && k < j)) ? 1 : 0; }
            selmask[jj] = __ballot(rank < 16 && j <= blk); }
        { const bf16_t* KS = P1 + (size_t)b * T * P1W + C_NKV + ((1 * 2 + 0) * 2 + g) * 64; const bf16_t* VS = P1 + (size_t)b * T * P1W + C_NKV + ((1 * 2 + 1) * 2 + g) * 64;
          float mrun = -INFINITY, lrun = 0.f;
#pragma unroll
          for (int jj = 0; jj < 2; ++jj) { unsigned long long mk = selmask[jj];
              while (mk) { const int j = __builtin_ctzll(mk) + 64 * jj; mk &= mk - 1; const int s = j * 64 + c.lane;
                  if (s <= t) { int dist = t - s; dist = dist > 128 ? 128 : dist; const float sc = dotn<64>(q, KS + (size_t)s * P1W) * 0.125f + lut[dist]; ONLINE(sc); } } }
          MERGE_ML();
          const float inv = gs / Ls;
#pragma unroll
          for (int jj = 0; jj < 2; ++jj) { unsigned long long mk = selmask[jj];
              while (mk) { const int j = __builtin_ctzll(mk) + 64 * jj; mk &= mk - 1; const int s = j * 64 + c.lane;
                  if (s <= t) { int dist = t - s; dist = dist > 128 ? 128 : dist; const float sc = dotn<64>(q, KS + (size_t)s * P1W) * 0.125f + lut[dist]; axpy64(o, __expf(sc - Mx) * inv, VS + (size_t)s * P1W); } } } }
        { const bf16_t* KW = P1 + (size_t)b * T * P1W + C_NKV + ((2 * 2 + 0) * 2 + g) * 64; const bf16_t* VW = P1 + (size_t)b * T * P1W + C_NKV + ((2 * 2 + 1) * 2 + g) * 64;
          const int s0 = t - 511 > 0 ? t - 511 : 0;
          float mrun = -INFINITY, lrun = 0.f;
          for (int s = s0 + c.lane; s <= t; s += 64) { int dist = t - s; dist = dist > 128 ? 128 : dist; const float sc = dotn<64>(q, KW + (size_t)s * P1W) * 0.125f + lut[dist]; ONLINE(sc); }
          MERGE_ML();
          const float inv = gwn / Ls;
          for (int s = s0 + c.lane; s <= t; s += 64) { int dist = t - s; dist = dist > 128 ? 128 : dist; const float sc = dotn<64>(q, KW + (size_t)s * P1W) * 0.125f + lut[dist]; axpy64(o, __expf(sc - Mx) * inv, VW + (size_t)s * P1W); } }
        store_o64(o, OUT + (size_t)m * 512 + h * 64, c.lane);
        __syncthreads();
    }
}

struct Args { const void* in[32]; float* out; unsigned char* ws; int l_lo, l_hi; };
constexpr int PH_PER_LAYER = 15, K_FINAL = 1 + PH_PER_LAYER;
template <int KIND>
__global__ void __launch_bounds__(NTHREADS, 2) fwd_kernel(Args a) {
    extern __shared__ __attribute__((aligned(16))) unsigned char lds_raw[];
    Ctx c;
    c.out = a.out; c.ws = a.ws; c.lds = (LAS unsigned char*)lds_raw;
    c.tid = threadIdx.x; c.lane = c.tid & 63; c.wave = __builtin_amdgcn_readfirstlane(c.tid >> 6); c.G = gridDim.x; c.bid = blockIdx.x;
    if (c.tid < 4) ((LAS unsigned*)(c.lds + LDS_MISC))[c.tid] = 0u;
    if (c.tid < 32) { const unsigned long long pv = (unsigned long long)a.in[c.tid]; ((LAS unsigned*)(c.lds + LDS_INTAB))[2 * c.tid] = (unsigned)pv; ((LAS unsigned*)(c.lds + LDS_INTAB))[2 * c.tid + 1] = (unsigned)(pv >> 32); }
    __syncthreads();
    XcdBarrier bar; bar.bar = WSP(unsigned, WS_CTL) + CW_BAR; bar.x = 0; bar.st = nullptr;
    if constexpr (KIND < 0) bar = xcd_barrier_post(WSP(unsigned, WS_CTL) + CW_BAR, (volatile LAS unsigned*)(c.lds + LDS_MISC));
#define IN(k) ((KIND < 0 || KIND == (k)) && (relaunder(c), true))
#define SEAM(k) do { if constexpr (KIND < 0) { unsigned* bb_ = bar.bar; asm volatile("" : "+s"(bb_)); bar.bar = bb_; xcd_barrier(bar); } } while (0)
    LAS unsigned char* ring = c.lds;

    if (IN(0)) { phase_prologue(c); } SEAM(0);
    for (int l = a.l_lo; l < a.l_hi; ++l) {
        constexpr int pb = 1;
        const float* resid = (l == 0) ? c.x() : WSP(float, WS_XA);
        if (IN(pb + 0)) { if (l == 0) phase_norm(c, c.x(), nullptr, nullptr, nullptr, WSP(bf16_t, WS_H0));
                          else phase_norm(c, WSP(float, WS_XA), WSP(bf16_t, WS_Y), WSP(bf16_t, WS_Y) + (size_t)M * D, WSP(float, WS_XA), WSP(bf16_t, WS_H0)); } SEAM(pb + 0);
        if (IN(pb + 1)) { pg8::Cfg g{(unsigned)(D * 2), 128u, (unsigned)(D * 2), D / 64, nullptr}; pg8::DenseOrder S; S.init(M / 256, P1W / 256, c.G, c.bid, WSP(bf16_t, WS_H0), (size_t)256 * D * 2, WSP(bf16_t, WS_WINT) + (size_t)l * P1W * D, (size_t)256 * D * 2);
            EpiStoreBf16 E{WSP(bf16_t, WS_P1), P1W, nullptr, 0}; pg8::gemm_phase<false>(ring, g, S, E); } SEAM(pb + 1);
        if (IN(pb + 2)) { phase_prep(c, l); } SEAM(pb + 2);
        if (IN(pb + 3)) { phase_cum(c); } SEAM(pb + 3);
        if (IN(pb + 4)) {
            { pg8::Cfg g{(unsigned)(P1W * 2), 128u, 512u, 4, nullptr}; pg8::DenseOrder S; S.init(M / 256, 3, c.G, c.bid, WSP(bf16_t, WS_P1) + C_CQ, (size_t)256 * P1W * 2, WSP(bf16_t, WS_WUQT) + (size_t)l * 768 * 256, (size_t)256 * 512);
              EpiStoreBf16 E{WSP(bf16_t, WS_QB), 768, WSP(float, WS_RSTD), 2}; pg8::gemm_phase<false>(ring, g, S, E); }
            { pg8::Cfg g{(unsigned)(P1W * 2), 128u, 256u, 2, nullptr}; pg8::DenseOrder S; S.init(M / 256, 4, c.G, c.bid, WSP(bf16_t, WS_P1) + C_CKV, (size_t)256 * P1W * 2, WSP(bf16_t, WS_WUKVT) + (size_t)l * 1024 * 128, (size_t)256 * 256);
              EpiStoreBf16 E{WSP(bf16_t, WS_KVB), 1024, WSP(float, WS_RSTD) + 1, 2}; pg8::gemm_phase<false>(ring, g, S, E); }
            { pg8::Cfg g{(unsigned)(16 * P1W * 2), (unsigned)(P1W * 2), 4096u, 32, nullptr}; CmpOrder S{c.G, (c.bid + 64) % c.G, (const char*)WSP(bf16_t, WS_P1), (const char*)(WSP(bf16_t, WS_WC1T) + (size_t)l * 2 * 256 * 2048)};
              EpiCmp1 E{WSP(bf16_t, WS_HC), WSP(float, WS_TAB) + l * 256}; pg8::gemm_phase<false>(ring, g, S, E); }
        } SEAM(pb + 4);
        if (IN(pb + 5)) { phase_cmp2_ropeq(c, l); } SEAM(pb + 5);
        if (IN(pb + 6)) { phase_att_nsa_naive(c); phase_att_mla_naive(c); phase_att_fox_naive(c); } SEAM(pb + 6);
        if (IN(pb + 7)) { phase_norm(c, resid, nullptr, nullptr, nullptr, WSP(bf16_t, WS_HG)); } SEAM(pb + 7);
        if (IN(pb + 8)) { pg8::Cfg g{(unsigned)(D * 2), 128u, (unsigned)(D * 2), D / 64, nullptr}; pg8::DenseOrder S; S.init(M / 256, 12, c.G, c.bid, WSP(bf16_t, WS_HG), (size_t)256 * D * 2, WSP(bf16_t, WS_WMT) + (size_t)l * 3072 * D, (size_t)256 * D * 2);
            EpiGates E{WSP(bf16_t, WS_GATES), c.b_merge() + l * 3072}; pg8::gemm_phase<false>(ring, g, S, E); } SEAM(pb + 8);
        if (IN(pb + 9)) {
#pragma unroll 1
            for (int br = 0; br < 3; ++br) { pg8::Cfg g{1024u, 128u, 1024u, 8, nullptr}; pg8::DenseOrder S;
                S.init(M / 256, 4, c.G, c.bid, WSP(bf16_t, br == 0 ? WS_OUTA : br == 1 ? WS_OUTB : WS_OUTC), (size_t)256 * 1024, WSP(bf16_t, WS_WOT) + ((size_t)l * 3 + br) * 1024 * 512, (size_t)256 * 1024);
                EpiOutproj E{WSP(bf16_t, WS_MIXED), WSP(bf16_t, WS_GATES), br}; pg8::gemm_phase<false>(ring, g, S, E); }
        } SEAM(pb + 9);
        if (IN(pb + 10)) { pg8::Cfg g{(unsigned)(D * 2), 128u, (unsigned)(D * 2), D / 64, nullptr}; pg8::DenseOrder S; S.init(M / 256, 4, c.G, c.bid, WSP(bf16_t, WS_MIXED), (size_t)256 * D * 2, WSP(bf16_t, WS_WOUTT) + (size_t)l * D * D, (size_t)256 * D * 2);
            EpiWout E{resid, WSP(float, WS_XA)}; pg8::gemm_phase<false>(ring, g, S, E); } SEAM(pb + 10);
        if (IN(pb + 11)) { phase_router(c, l); } SEAM(pb + 11);
        if (IN(pb + 12)) { phase_place(c, l); } SEAM(pb + 12);
        if (IN(pb + 13)) { LAS int* tab = (LAS int*)(c.lds + LDS_MOETAB); moe_tables(c, l, tab);
            pg8::Cfg g{(unsigned)(D * 2), 128u, (unsigned)(D * 2), D / 64, WSP(int, WS_LTOK)}; MoeOrder S{c.G, c.bid, 2, tab, (const char*)WSP(bf16_t, WS_H2), 0, (const char*)WSP(bf16_t, WS_WGU), (size_t)512 * D * 2, (size_t)256 * D * 2};
            EpiMoe1 E{WSP(bf16_t, WS_HID), WSP(float, WS_LW)}; pg8::gemm_phase<true>(ring, g, S, E); } SEAM(pb + 13);
        if (IN(pb + 14)) { LAS int* tab = (LAS int*)(c.lds + LDS_MOETAB); moe_tables(c, l, tab);
            pg8::Cfg g{512u, 128u, 512u, 4, nullptr}; MoeOrder S{c.G, c.bid, 4, tab, (const char*)WSP(bf16_t, WS_HID), 512, (const char*)WSP(bf16_t, WS_WDT), (size_t)D * 256 * 2, (size_t)256 * 256 * 2};
            EpiMoe2 E{WSP(bf16_t, WS_Y), WSP(unsigned, WS_LSLOT)}; pg8::gemm_phase<false>(ring, g, S, E); } SEAM(pb + 14);
    }
    if (IN(K_FINAL)) { phase_final(c); }
#undef IN
#undef SEAM
}

template <int KIND> static bool prep_kernel() { return hipFuncSetAttribute((const void*)fwd_kernel<KIND>, hipFuncAttributeMaxDynamicSharedMemorySize, LDS_BYTES) == hipSuccess; }
template <int KIND> static void launch_kind(int grid, hipStream_t stream, Args a, int l) { a.l_lo = l; a.l_hi = l + 1; hipLaunchKernelGGL(fwd_kernel<KIND>, dim3(grid), dim3(NTHREADS), LDS_BYTES, stream, a); }
extern "C" void kernel_launch(void* const* d_in, const int* in_sizes, int n_in, void* d_out, int out_size, void* d_ws, size_t ws_size, hipStream_t stream) {
    static int grid = 0;
    if (grid == 0) {
        if (n_in != 32 || ws_size < WS_END) { fprintf(stderr, "kernel_launch: n_in %d ws %zu (need %zu)\n", n_in, ws_size, (size_t)WS_END); grid = -1; return; }
        int dev = 0, cus = 0;
        if (hipGetDevice(&dev) != hipSuccess || hipDeviceGetAttribute(&cus, hipDeviceAttributeMultiprocessorCount, dev) != hipSuccess) { grid = -1; return; }
        bool ok = true;
#if MK_ONE_LAUNCH
        ok = prep_kernel<-1>();
#else
        ok = prep_kernel<0>() && prep_kernel<1>() && prep_kernel<2>() && prep_kernel<3>() && prep_kernel<4>() && prep_kernel<5>() && prep_kernel<6>() && prep_kernel<7>() && prep_kernel<8>() && prep_kernel<9>()
          && prep_kernel<10>() && prep_kernel<11>() && prep_kernel<12>() && prep_kernel<13>() && prep_kernel<14>() && prep_kernel<15>() && prep_kernel<16>();
#endif
        if (!ok) { grid = -1; return; }
        (void)hipGetLastError();
        grid = cus;
    }
    if (grid < 0) return;
    (void)hipMemsetAsync((char*)d_ws + WS_CTL, 0, CTL_BYTES, stream);
    Args a{};
    for (int i = 0; i < 32; ++i) a.in[i] = d_in[i];
    a.out = (float*)d_out; a.ws = (unsigned char*)d_ws;
#if MK_ONE_LAUNCH
    a.l_lo = 0; a.l_hi = NL;
    hipLaunchKernelGGL(fwd_kernel<-1>, dim3(grid), dim3(NTHREADS), LDS_BYTES, stream, a);
#else
    launch_kind<0>(grid, stream, a, 0);
    for (int l = 0; l < NL; ++l) {
        launch_kind<1>(grid, stream, a, l); launch_kind<2>(grid, stream, a, l); launch_kind<3>(grid, stream, a, l); launch_kind<4>(grid, stream, a, l); launch_kind<5>(grid, stream, a, l);
        launch_kind<6>(grid, stream, a, l); launch_kind<7>(grid, stream, a, l); launch_kind<8>(grid, stream, a, l); launch_kind<9>(grid, stream, a, l); launch_kind<10>(grid, stream, a, l);
        launch_kind<11>(grid, stream, a, l); launch_kind<12>(grid, stream, a, l); launch_kind<13>(grid, stream, a, l); launch_kind<14>(grid, stream, a, l); launch_kind<15>(grid, stream, a, l);
    }
    launch_kind<16>(grid, stream, a, 0);
#endif
}
```

```cpp
#include <hip/hip_runtime.h>
#include <stdint.h>
#include <cstdio>

#ifndef MK_ONE_LAUNCH
#define MK_ONE_LAUNCH 1
#endif

#define LAS __attribute__((address_space(3)))
typedef unsigned short bf16_t;
typedef short bf16x8 __attribute__((ext_vector_type(8)));
typedef float f32x4 __attribute__((ext_vector_type(4)));
typedef float f32x16 __attribute__((ext_vector_type(16)));
typedef unsigned u32x4 __attribute__((ext_vector_type(4)));
typedef unsigned u32x2 __attribute__((ext_vector_type(2)));

constexpr int NB = 2, T = 8192, D = 1024, M = NB * T, NL = 2;
constexpr int DIN = 6336;
constexpr int P1W = 3328;
constexpr int C_NQ = 0, C_NKV = 512, C_CQ = 1280, C_CKV = 1536, C_KR = 1664, C_NG = 1696, C_FF = 1720, C_FQKV = 1728;
constexpr int NEXP = 32, EDIM = 256;
constexpr float EPS = 1e-6f;
constexpr int NTHREADS = 512, NWAVES = 8;
constexpr int LDS_BYTES = 147456;
constexpr int MOE_MAXROWS = 40960;

constexpr size_t MiB = 1u << 20;
constexpr size_t WS_CTL = 0;
constexpr size_t CTL_BYTES = 1 * MiB;
constexpr int CW_BAR = 4096;
constexpr int CW_QUEUE = 16384;
constexpr int CW_MOECNT = 32768;
constexpr size_t CTL_LTOK = 512 * 1024;
constexpr size_t WS_WINT = 1 * MiB;
constexpr size_t WS_WMT = 14 * MiB;
constexpr size_t WS_WUQT = 26 * MiB;
constexpr size_t WS_WUKVT = 27 * MiB;
constexpr size_t WS_WOT = 28 * MiB;
constexpr size_t WS_WOUTT = 34 * MiB;
constexpr size_t WS_WC1T = 38 * MiB;
constexpr size_t WS_ROPE = 42 * MiB;
constexpr size_t WS_TAB = 44 * MiB;
constexpr size_t WS_XA = 45 * MiB;
constexpr size_t PB = 109 * MiB;
constexpr size_t WS_P1 = PB;
constexpr size_t WS_QB = PB + 104 * MiB;
constexpr size_t WS_KVB = PB + 128 * MiB;
constexpr size_t WS_OUTA = PB + 160 * MiB;
constexpr size_t WS_OUTB = PB + 176 * MiB;
constexpr size_t WS_OUTC = PB + 192 * MiB;
constexpr size_t WS_H0 = PB + 176 * MiB;
constexpr size_t WS_SM = PB + 208 * MiB;
constexpr size_t WS_RSTD = WS_SM;
constexpr size_t WS_KR = WS_SM + 256 * 1024;
constexpr size_t WS_LF = WS_SM + 1280 * 1024;
constexpr size_t WS_CUM = WS_SM + 1792 * 1024;
constexpr size_t WS_HC = WS_SM + 2304 * 1024;
constexpr size_t WS_KC = WS_SM + 3328 * 1024;
constexpr size_t WS_VC = WS_SM + 3584 * 1024;
constexpr size_t WS_REC = WS_SM + 3840 * 1024;
constexpr size_t WS_LTOK = WS_SM + 4352 * 1024;
constexpr size_t WS_LW = WS_SM + 4608 * 1024;
constexpr size_t WS_LSLOT = WS_SM + 4864 * 1024;
constexpr size_t WS_END = PB + 216 * MiB;
constexpr size_t WS_HG = PB;
constexpr size_t WS_GATES = PB + 32 * MiB;
constexpr size_t WS_MIXED = PB + 128 * MiB;
constexpr size_t WS_H2 = PB;
constexpr size_t WS_WGU = PB + 32 * MiB;
constexpr size_t WS_WDT = PB + 64 * MiB;
constexpr size_t WS_HID = PB + 80 * MiB;
constexpr size_t WS_Y = PB + 100 * MiB;
static_assert(WS_Y + 64 * MiB <= WS_H0, "Y must not overlap H0");
static_assert(WS_END <= 332 * MiB, "workspace budget");

__device__ __forceinline__ float bf2f(bf16_t v) { return __uint_as_float((unsigned)v << 16); }
__device__ __forceinline__ unsigned f2bf(float f) { unsigned u = __float_as_uint(f); return (u + 0x7fffu + ((u >> 16) & 1u)) >> 16; }
__device__ __forceinline__ unsigned pk2(float lo, float hi) { return f2bf(lo) | (f2bf(hi) << 16); }
template <int CTRL> __device__ __forceinline__ float dpp_f(float v) { return __int_as_float(__builtin_amdgcn_update_dpp(0, __float_as_int(v), CTRL, 0xf, 0xf, true)); }
__device__ __forceinline__ float wave_sum(float v) {
    v += dpp_f<0xB1>(v); v += dpp_f<0x4E>(v); v += dpp_f<0x141>(v); v += dpp_f<0x140>(v);
    const float a = __int_as_float(__builtin_amdgcn_readlane(__float_as_int(v), 0)), b = __int_as_float(__builtin_amdgcn_readlane(__float_as_int(v), 16));
    const float c2 = __int_as_float(__builtin_amdgcn_readlane(__float_as_int(v), 32)), d = __int_as_float(__builtin_amdgcn_readlane(__float_as_int(v), 48));
    return (a + b) + (c2 + d);
}
__device__ __forceinline__ float wave_max(float v) {
    v = fmaxf(v, dpp_f<0xB1>(v)); v = fmaxf(v, dpp_f<0x4E>(v)); v = fmaxf(v, dpp_f<0x141>(v)); v = fmaxf(v, dpp_f<0x140>(v));
    const float a = __int_as_float(__builtin_amdgcn_readlane(__float_as_int(v), 0)), b = __int_as_float(__builtin_amdgcn_readlane(__float_as_int(v), 16));
    const float c2 = __int_as_float(__builtin_amdgcn_readlane(__float_as_int(v), 32)), d = __int_as_float(__builtin_amdgcn_readlane(__float_as_int(v), 48));
    return fmaxf(fmaxf(a, b), fmaxf(c2, d));
}
__device__ __forceinline__ float sigmoidf_(float x) { return 1.f / (1.f + __expf(-x)); }
__device__ __forceinline__ float gelu_tanh(float x) { const float u = 0.7978845608028654f * (x + 0.044715f * x * x * x); const float th = 1.f - 2.f / (1.f + __expf(2.f * u)); return 0.5f * x * (1.f + th); }
#define LDS_WAIT() asm volatile("s_waitcnt lgkmcnt(0)" ::: "memory")

#define XB_TMO      128
#define XB_XCNT(j)  (256  + 64 * (j))
#define XB_XSUB(j)  (1280 + 64 * (j))
#define XB_XGEN(j)  (2304 + 64 * (j))
#define XB_TOP      3328
#define XB_TOPGEN   3392
#define XCD_BAR_WORDS 3456
#define XB_SPIN_CAP (1u << 18)

__device__ __forceinline__ unsigned xb_ld(unsigned* p)              { return __hip_atomic_load(p, __ATOMIC_RELAXED, __HIP_MEMORY_SCOPE_AGENT); }
__device__ __forceinline__ unsigned xb_add(unsigned* p, unsigned v) { return __hip_atomic_fetch_add(p, v, __ATOMIC_RELAXED, __HIP_MEMORY_SCOPE_AGENT); }
__device__ __forceinline__ unsigned xb_xcc_id() { return (unsigned)__builtin_amdgcn_s_getreg((3 << 11) | 20) & 0xFu; }
#define XB_SPIN(cond, bar) do { unsigned _sp = 0; while (cond) { __builtin_amdgcn_s_sleep(1); \
    if ((++_sp & 255u) == 0u) { if (xb_ld(&(bar)[XB_TMO])) break; if (_sp > XB_SPIN_CAP) { atomicAdd(&(bar)[XB_TMO], 1u); break; } } } } while (0)

struct XcdBarrier { unsigned* bar; unsigned x; volatile LAS unsigned* st; };

__device__ __forceinline__ XcdBarrier xcd_barrier_post(unsigned* bar, volatile LAS unsigned* st) {
    XcdBarrier b; b.bar = bar; b.x = xb_xcc_id(); b.st = st;
    if (threadIdx.x == 0) (void)xb_add(&bar[XB_XCNT(b.x)], 1u);
    return b;
}
__device__ __forceinline__ void xcd_barrier_complete(unsigned* bar, unsigned x, unsigned& nloc, unsigned& nx) {
    const unsigned G = gridDim.x * gridDim.y * gridDim.z;
    unsigned sum, cnt, mine, sp = 0u;
    for (;;) {
        sum = 0u; cnt = 0u; mine = 0u;
#pragma unroll
        for (unsigned j = 0; j < 16; ++j) { const unsigned c = xb_ld(&bar[XB_XCNT(j)]); sum += c; cnt += (c > 0u) ? 1u : 0u; mine = (j == x) ? c : mine; }
        if (sum == G) break;
        __builtin_amdgcn_s_sleep(1);
        if ((++sp & 255u) == 0u) { if (xb_ld(&bar[XB_TMO])) break; if (sp > XB_SPIN_CAP) { atomicAdd(&bar[XB_TMO], 1u); break; } }
    }
    nloc = mine > 0u ? mine : 1u; nx = cnt > 0u ? cnt : 1u;
}
__device__ __forceinline__ void xcd_barrier(const XcdBarrier& b) {
    asm volatile("s_waitcnt vmcnt(0)" ::: "memory");
    __syncthreads();
    if (threadIdx.x == 0) {
        unsigned* bar = b.bar;
        __builtin_amdgcn_s_waitcnt(0);
        unsigned nloc = b.st[0], nx = b.st[1];
        if (nloc == 0u) { xcd_barrier_complete(bar, b.x, nloc, nx); b.st[0] = nloc; b.st[1] = nx; }
        const unsigned old = xb_add(&bar[XB_XSUB(b.x)], 1u);
        const unsigned gen = old / nloc;
        if (old + 1u == (gen + 1u) * nloc) {
            __builtin_amdgcn_fence(__ATOMIC_RELEASE, "agent");
            asm volatile("s_waitcnt vmcnt(0)" ::: "memory");
            const unsigned og = xb_add(&bar[XB_TOP], 1u);
            const unsigned tg = og / nx;
            if (og + 1u == (tg + 1u) * nx) xb_add(&bar[XB_TOPGEN], 1u);
            else XB_SPIN(xb_ld(&bar[XB_TOPGEN]) == tg, bar);
            __builtin_amdgcn_fence(__ATOMIC_ACQUIRE, "agent");
            xb_add(&bar[XB_XGEN(b.x)], 1u);
            asm volatile("s_waitcnt vmcnt(0)" ::: "memory");
        } else {
            XB_SPIN(xb_ld(&bar[XB_XGEN(b.x)]) == gen, bar);
            __builtin_amdgcn_fence(__ATOMIC_ACQUIRE, "agent");
            asm volatile("s_waitcnt vmcnt(0)" ::: "memory");
        }
    }
    __syncthreads();
}

namespace pg8 {
constexpr int BM = 256, BK = 64, HALF = 128, HTB = HALF * BK * 2, STAGE_BYTES = 8 * HTB;
__host__ __device__ __forceinline__ int lds_byte(int r, int c) { const int st = (r >> 4) * 2 + (c >> 5), rr = r & 15, cc = c & 31, ob = rr * 64 + cc * 2; return st * 1024 + (ob ^ (((ob >> 9) & 1) << 5)); }
__host__ __device__ __forceinline__ void stage_rc(int b, int& R, int& C) { const int st = b / 1024, sb = b % 1024, swz = sb ^ (((sb >> 9) & 1) << 5); R = (st >> 1) * 16 + swz / 64; C = (st & 1) * 32 + (swz % 64) / 2; }

struct Unit { int pm, pn; const char* A; const char* B; int aux; };
struct Cfg { unsigned lda; unsigned kstepA; unsigned ldb; int nt; const int* rowidx; };

struct DenseOrder {
    int nM, nN, nwg, G, c; const char* A; const char* B; size_t tstepA, tstepB;
    __device__ void init(int nM_, int nN_, int G_, int c_, const void* A_, size_t tstepA_, const void* B_, size_t tstepB_) { nM = nM_; nN = nN_; nwg = nM * nN; G = G_; c = c_; A = (const char*)A_; B = (const char*)B_; tstepA = tstepA_; tstepB = tstepB_; }
    __device__ bool next(int i, Unit& u) const {
        const long Lq = (long)i * G + c; if (Lq >= nwg) return false;
        int wgid = (int)Lq; { const int q = nwg / 8, r = nwg % 8, xcd = wgid % 8, off = wgid / 8; wgid = (xcd < r ? xcd * (q + 1) : r * (q + 1) + (xcd - r) * q) + off; }
        const int nig = 8 * nN, gid = wgid / nig, fm = gid * 8, gsz = (nM - fm) < 8 ? (nM - fm) : 8;
        u.pm = fm + ((wgid % nig) % gsz); u.pn = (wgid % nig) / gsz; u.A = A + (size_t)u.pm * tstepA; u.B = B + (size_t)u.pn * tstepB; u.aux = 0; return true;
    }
};

#define PG8_EPI_ROWCOL(row, col) const int row = u.pm * 256 + ai * 128 + wr * 64 + m * 16 + fr; const int col = u.pn * 256 + bj * 128 + wc * 32 + n * 16 + fq * 4;

template <bool INDEXED, class Epi, class Sched>
__device__ __forceinline__ void gemm_phase(LAS unsigned char* lds, int wid, const Cfg g, const Sched& S, const Epi& E) {
    int lane_; asm volatile("v_mbcnt_lo_u32_b32 %0, -1, 0\n\tv_mbcnt_hi_u32_b32 %0, -1, %0" : "=v"(lane_));
    const int lane = lane_, tid = wid * 64 + lane, wr = wid >> 2, wc = wid & 3, fr = lane & 15, fq = lane >> 4;
    const int nt = g.nt;
    int Rs[2], Cs[2]; unsigned voffB[2];
#pragma unroll
    for (int i = 0; i < 2; ++i) { stage_rc(tid * 16 + i * 8192, Rs[i], Cs[i]); voffB[i] = (unsigned)Rs[i] * g.ldb + (unsigned)Cs[i] * 2u; }
    const size_t kstepA = g.kstepA, kstepB = (size_t)(BK * 2);
    const size_t hstepB = (size_t)HALF * g.ldb;
    const unsigned ldsw = (unsigned)wid * 1024u;
    const int aoff = lds_byte(wr * 64 + fr, fq * 8), boff = lds_byte(wc * 32 + fr, fq * 8);
#define PG8_SA(b, h) (((b) * 2 + (h)) * HTB)
#define PG8_SB(b, h) ((4 + (b) * 2 + (h)) * HTB)
#define PG8_STAGE2(bufoff, gbase, v0, v1) do { const char* gb_ = (const char*)(gbase); asm volatile("" : "+s"(gb_)); \
        __builtin_amdgcn_global_load_lds((const unsigned*)(gb_ + (v0)), (LAS unsigned*)(lds + (bufoff) + ldsw), 16, 0, 0); \
        __builtin_amdgcn_global_load_lds((const unsigned*)(gb_ + (v1)), (LAS unsigned*)(lds + (bufoff) + ldsw + 8192), 16, 0, 0); } while (0)
#define PG8_STAGEB(bufoff, gbase) PG8_STAGE2(bufoff, gbase, voffB[0], voffB[1])
#define PG8_LDA(dst, b, h) do { _Pragma("unroll") for (int m = 0; m < 4; ++m) _Pragma("unroll") for (int k = 0; k < 2; ++k) dst[m][k] = *(const LAS bf16x8*)(lds + PG8_SA(b, h) + aoff + m * 2048 + k * 1024); } while (0)
#define PG8_LDB(dst, b, h) do { _Pragma("unroll") for (int n = 0; n < 2; ++n) _Pragma("unroll") for (int k = 0; k < 2; ++k) dst[n][k] = *(const LAS bf16x8*)(lds + PG8_SB(b, h) + boff + n * 2048 + k * 1024); } while (0)
#define PG8_MMA(ai, bj, At, Bt) do { __builtin_amdgcn_s_setprio(1); _Pragma("unroll") for (int m = 0; m < 4; ++m) _Pragma("unroll") for (int n = 0; n < 2; ++n) _Pragma("unroll") for (int k = 0; k < 2; ++k) \
        acc[ai][bj][m][n] = __builtin_amdgcn_mfma_f32_16x16x32_bf16(Bt[n][k], At[m][k], acc[ai][bj][m][n], 0, 0, 0); __builtin_amdgcn_s_setprio(0); } while (0)
#define PG8_WAIT_V(n) asm volatile("s_waitcnt vmcnt(" #n ")" ::: "memory")
#define PG8_WAIT_L(n) asm volatile("s_waitcnt lgkmcnt(" #n ")" ::: "memory")
#define PG8_BAR __builtin_amdgcn_s_barrier()
#define PG8_SCHED __builtin_amdgcn_sched_barrier(0)
    Unit cur, nxt; int ui = 0;
    if (!S.next(0, cur)) return;
    unsigned vAc[2][2], vAn[2][2];
#define PG8_SETVA(v, U) do { _Pragma("unroll") for (int h_ = 0; h_ < 2; ++h_) _Pragma("unroll") for (int i_ = 0; i_ < 2; ++i_) { \
        if constexpr (INDEXED) { const int r_ = g.rowidx[(U).aux + h_ * HALF + Rs[i_]]; v[h_][i_] = (unsigned)r_ * g.lda + (unsigned)Cs[i_] * 2u; } \
        else v[h_][i_] = (unsigned)(h_ * HALF + Rs[i_]) * g.lda + (unsigned)Cs[i_] * 2u; } } while (0)
    PG8_SETVA(vAc, cur);
    f32x4 acc[2][2][4][2];
#pragma unroll
    for (int a = 0; a < 2; ++a)
#pragma unroll
        for (int b = 0; b < 2; ++b)
#pragma unroll
            for (int m = 0; m < 4; ++m)
#pragma unroll
                for (int n = 0; n < 2; ++n) acc[a][b][m][n] = (f32x4){0.f, 0.f, 0.f, 0.f};
    bf16x8 At[4][2], B0[2][2], B1[2][2];
    const char* cA = cur.A; const char* cB = cur.B;
    PG8_STAGEB(PG8_SB(0, 0), cB); PG8_STAGEB(PG8_SB(0, 1), cB + hstepB); PG8_STAGE2(PG8_SA(0, 0), cA, vAc[0][0], vAc[0][1]); PG8_STAGE2(PG8_SA(0, 1), cA, vAc[1][0], vAc[1][1]);
    if (wr == 1) PG8_BAR;
    PG8_WAIT_V(2); PG8_BAR;
    PG8_STAGEB(PG8_SB(1, 0), cB + kstepB); PG8_STAGE2(PG8_SA(1, 0), cA + kstepA, vAc[0][0], vAc[0][1]); PG8_STAGEB(PG8_SB(1, 1), cB + hstepB + kstepB);
    PG8_WAIT_V(6); PG8_BAR;
    for (;;) {
        const bool has_next = S.next(ui + 1, nxt);
        const char* nA = has_next ? nxt.A : cA; const char* nB = has_next ? nxt.B : cB;
        if (has_next) { PG8_SETVA(vAn, nxt); } else {
#pragma unroll
            for (int h_ = 0; h_ < 2; ++h_)
#pragma unroll
                for (int i_ = 0; i_ < 2; ++i_) vAn[h_][i_] = vAc[h_][i_]; }
        for (int t = 0; t < nt; t += 2) {
            const bool last = (t == nt - 2);
            const char* a1 = cA + (size_t)(t + 1) * kstepA;
            const char* a2 = last ? nA : cA + (size_t)(t + 2) * kstepA; const char* b2 = last ? nB : cB + (size_t)(t + 2) * kstepB;
            const char* a3 = a2 + kstepA; const char* b3 = b2 + kstepB;
            const unsigned w00 = last ? vAn[0][0] : vAc[0][0], w01 = last ? vAn[0][1] : vAc[0][1], w10 = last ? vAn[1][0] : vAc[1][0], w11 = last ? vAn[1][1] : vAc[1][1];
            PG8_LDB(B0, 0, 0); PG8_LDB(B1, 0, 1); PG8_SCHED; PG8_LDA(At, 0, 0); PG8_STAGE2(PG8_SA(1, 1), a1, vAc[1][0], vAc[1][1]);
            PG8_WAIT_V(8); PG8_WAIT_L(0); PG8_BAR; PG8_MMA(0, 0, At, B0); PG8_MMA(0, 1, At, B1); PG8_BAR; PG8_SCHED;
            PG8_LDA(At, 0, 1); PG8_STAGEB(PG8_SB(0, 0), b2); PG8_STAGEB(PG8_SB(0, 1), b2 + hstepB); PG8_STAGE2(PG8_SA(0, 0), a2, w00, w01);
            PG8_WAIT_V(8); PG8_WAIT_L(0); PG8_BAR; PG8_MMA(1, 0, At, B0); PG8_MMA(1, 1, At, B1); PG8_BAR; PG8_SCHED;
            PG8_LDB(B0, 1, 0); PG8_LDB(B1, 1, 1); PG8_SCHED; PG8_LDA(At, 1, 0); PG8_STAGE2(PG8_SA(0, 1), a2, w10, w11);
            PG8_WAIT_V(8); PG8_WAIT_L(0); PG8_BAR; PG8_MMA(0, 0, At, B0); PG8_MMA(0, 1, At, B1); PG8_BAR; PG8_SCHED;
            PG8_LDA(At, 1, 1); PG8_STAGEB(PG8_SB(1, 0), b3); PG8_STAGEB(PG8_SB(1, 1), b3 + hstepB); PG8_STAGE2(PG8_SA(1, 0), a3, w00, w01);
            PG8_WAIT_V(8); PG8_WAIT_L(0); PG8_BAR; PG8_MMA(1, 0, At, B0); PG8_MMA(1, 1, At, B1); PG8_BAR; PG8_SCHED;
        }
        E(acc, cur, wr, wc, fr, fq);
        if (!has_next) break;
#pragma unroll
        for (int a = 0; a < 2; ++a)
#pragma unroll
            for (int b = 0; b < 2; ++b)
#pragma unroll
                for (int m = 0; m < 4; ++m)
#pragma unroll
                    for (int n = 0; n < 2; ++n) acc[a][b][m][n] = (f32x4){0.f, 0.f, 0.f, 0.f};
        cur = nxt; cA = nA; cB = nB; ++ui;
#pragma unroll
        for (int h_ = 0; h_ < 2; ++h_)
#pragma unroll
            for (int i_ = 0; i_ < 2; ++i_) vAc[h_][i_] = vAn[h_][i_];
    }
    PG8_WAIT_V(0);
    if (wr == 0) PG8_BAR;
    PG8_BAR;
#undef PG8_SA
#undef PG8_SB
#undef PG8_STAGE2
#undef PG8_STAGEB
#undef PG8_LDA
#undef PG8_LDB
#undef PG8_MMA
#undef PG8_WAIT_V
#undef PG8_WAIT_L
#undef PG8_BAR
#undef PG8_SCHED
#undef PG8_SETVA
}
}

constexpr int LDS_MISC = 131072;
constexpr int LDS_MOETAB = LDS_MISC + 64;
constexpr int LDS_INTAB = LDS_MISC + 512;
struct Ctx {
    float* out; unsigned char* ws;
    LAS unsigned char* lds;
    int tid, lane, wave, G, bid;
    __device__ __forceinline__ const void* inp(int i) const { const LAS unsigned* p = (const LAS unsigned*)(lds + LDS_INTAB) + 2 * i;
        const unsigned lo = (unsigned)__builtin_amdgcn_readfirstlane((int)p[0]), hi = (unsigned)__builtin_amdgcn_readfirstlane((int)p[1]); return (const void*)(((unsigned long long)hi << 32) | lo); }
    __device__ __forceinline__ const float* x() const { return (const float*)inp(0); }
    __device__ __forceinline__ const int* pos() const { return (const int*)inp(1); }
    __device__ __forceinline__ const float* rel_bias() const { return (const float*)inp(2); }
    __device__ __forceinline__ const float* norm_attn() const { return (const float*)inp(3); }
    __device__ __forceinline__ const float* w_in() const { return (const float*)inp(4); }
    __device__ __forceinline__ const float* b_merge() const { return (const float*)inp(5); }
    __device__ __forceinline__ const float* cmp_pe() const { return (const float*)inp(6); }
    __device__ __forceinline__ const float* cmp_k_w1() const { return (const float*)inp(7); }
    __device__ __forceinline__ const float* cmp_k_b1() const { return (const float*)inp(8); }
    __device__ __forceinline__ const float* cmp_k_w2() const { return (const float*)inp(9); }
    __device__ __forceinline__ const float* cmp_v_w1() const { return (const float*)inp(10); }
    __device__ __forceinline__ const float* cmp_v_b1() const { return (const float*)inp(11); }
    __device__ __forceinline__ const float* cmp_v_w2() const { return (const float*)inp(12); }
    __device__ __forceinline__ const float* mla_q_norm() const { return (const float*)inp(13); }
    __device__ __forceinline__ const float* mla_kv_norm() const { return (const float*)inp(14); }
    __device__ __forceinline__ const float* mla_w_uq() const { return (const float*)inp(15); }
    __device__ __forceinline__ const float* mla_w_uk() const { return (const float*)inp(16); }
    __device__ __forceinline__ const float* mla_w_uv() const { return (const float*)inp(17); }
    __device__ __forceinline__ const float* fox_b_f() const { return (const float*)inp(18); }
    __device__ __forceinline__ const float* w_o_nsa() const { return (const float*)inp(19); }
    __device__ __forceinline__ const float* w_o_mla() const { return (const float*)inp(20); }
    __device__ __forceinline__ const float* w_o_fox() const { return (const float*)inp(21); }
    __device__ __forceinline__ const float* w_out() const { return (const float*)inp(22); }
    __device__ __forceinline__ const float* norm_ffn() const { return (const float*)inp(23); }
    __device__ __forceinline__ const float* moe_w_grp() const { return (const float*)inp(24); }
    __device__ __forceinline__ const float* moe_b_grp() const { return (const float*)inp(25); }
    __device__ __forceinline__ const float* moe_w_router() const { return (const float*)inp(26); }
    __device__ __forceinline__ const float* moe_b_router() const { return (const float*)inp(27); }
    __device__ __forceinline__ const float* moe_w_gate() const { return (const float*)inp(28); }
    __device__ __forceinline__ const float* moe_w_up() const { return (const float*)inp(29); }
    __device__ __forceinline__ const float* moe_w_down() const { return (const float*)inp(30); }
    __device__ __forceinline__ const float* norm_final() const { return (const float*)inp(31); }
};
#define WSP(T_, off) ((T_*)(c.ws + (off)))
__device__ __forceinline__ int lane_id_volatile() { int ln; asm volatile("v_mbcnt_lo_u32_b32 %0, -1, 0\n\tv_mbcnt_hi_u32_b32 %0, -1, %0" : "=v"(ln)); return ln; }
__device__ __forceinline__ void relaunder(Ctx& c) { const int ln = lane_id_volatile(); c.lane = ln; c.tid = c.wave * 64 + ln;
    unsigned char* w = c.ws; asm volatile("" : "+s"(w)); c.ws = w; int g_ = c.G, b_ = c.bid, wv_ = c.wave; asm volatile("" : "+s"(g_), "+s"(b_), "+s"(wv_)); c.G = g_; c.bid = b_; c.wave = wv_; }

template <class Map>
__device__ __forceinline__ void transpose_item(const float* W, int ldw, int K, bf16_t* WT, const float* rowscale, Map srcmap, int nblk, LAS float* scr, int item, int lane) {
    const int kb = item / nblk, nb = item % nblk, k0 = 64 * kb, n0 = 32 * nb;
    const int sc = srcmap(n0 + (lane & 31));
#pragma unroll 8
    for (int i = 0; i < 32; ++i) { const int kk = 2 * i + (lane >> 5); float v = 0.f; if (sc >= 0) { v = W[(size_t)(k0 + kk) * ldw + sc]; if (rowscale) v *= rowscale[k0 + kk]; } scr[kk * 33 + (lane & 31)] = v; }
    LDS_WAIT(); asm volatile("" ::: "memory");
    const int cc = lane & 7;
#pragma unroll
    for (int j = 0; j < 4; ++j) { const int n = (lane >> 3) + 8 * j; const LAS float* s = scr + (8 * cc) * 33 + n;
        u32x4 o; o.x = pk2(s[0 * 33], s[1 * 33]); o.y = pk2(s[2 * 33], s[3 * 33]); o.z = pk2(s[4 * 33], s[5 * 33]); o.w = pk2(s[6 * 33], s[7 * 33]);
        *(u32x4*)(WT + (size_t)(n0 + n) * K + k0 + 8 * cc) = o; }
    LDS_WAIT(); asm volatile("" ::: "memory");
}
struct MapId { int off; __device__ int operator()(int n) const { return n + off; } };
struct MapInproj { __device__ int operator()(int n) const { if (n < 1280) return n; if (n < 1696) return n + 24; if (n < 1720) return n - 416; if (n < 1728) return n + 1536; if (n < 3264) return n - 8; return -1; } };
struct MapUq { __device__ int operator()(int n) const { if (n < 512) return (n >> 6) * 96 + (n & 63); const int r = n - 512; return (r >> 5) * 96 + 64 + (r & 31); } };
struct MapPad128 { __device__ int operator()(int n) const { return n < 128 ? n : -1; } };
struct MapGU { __device__ int operator()(int n) const { return (n >> 8) * 128 + (n & 127); } };

__device__ __forceinline__ int rel_bucket_dev(int n) {
    if (n < 16) return n;
    const float lr = __logf((float)n / 16.f) / 2.0794415416798357f;
    int large = 16 + (int)(lr * 16.f);
    return large < 31 ? large : 31;
}

__device__ __forceinline__ void phase_prologue(const Ctx& c) {
    LAS float* scr = (LAS float*)(c.lds + c.wave * 16384);
    const int gw = c.bid * NWAVES + c.wave, NGW = c.G * NWAVES;
    constexpr int I_WIN = 16 * (P1W / 32), I_WM = 16 * 96, I_UQ = 4 * 24, I_UK = 2 * 16, I_UV = 2 * 16, I_WO = 8 * 32, I_WOUT = 16 * 32, I_C1 = 32 * 8;
    constexpr int PER_L = I_WIN + I_WM + I_UQ + I_UK + I_UV + 3 * I_WO + I_WOUT + 2 * I_C1;
    for (int it = gw; it < NL * PER_L; it += NGW) {
        const int l = it / PER_L; int r = it % PER_L;
        if (r < I_WIN) { transpose_item(c.w_in() + (size_t)l * D * DIN, DIN, D, WSP(bf16_t, WS_WINT) + (size_t)l * P1W * D, c.norm_attn() + l * D, MapInproj{}, P1W / 32, scr, r, c.lane); continue; } r -= I_WIN;
        if (r < I_WM) { transpose_item(c.w_in() + (size_t)l * D * DIN, DIN, D, WSP(bf16_t, WS_WMT) + (size_t)l * 3072 * D, c.norm_attn() + l * D, MapId{3264}, 96, scr, r, c.lane); continue; } r -= I_WM;
        if (r < I_UQ) { transpose_item(c.mla_w_uq() + (size_t)l * 256 * 768, 768, 256, WSP(bf16_t, WS_WUQT) + (size_t)l * 768 * 256, c.mla_q_norm() + l * 256, MapUq{}, 24, scr, r, c.lane); continue; } r -= I_UQ;
        if (r < I_UK) { transpose_item(c.mla_w_uk() + (size_t)l * 128 * 512, 512, 128, WSP(bf16_t, WS_WUKVT) + (size_t)l * 1024 * 128, c.mla_kv_norm() + l * 128, MapId{0}, 16, scr, r, c.lane); continue; } r -= I_UK;
        if (r < I_UV) { transpose_item(c.mla_w_uv() + (size_t)l * 128 * 512, 512, 128, WSP(bf16_t, WS_WUKVT) + (size_t)l * 1024 * 128 + 512 * 128, c.mla_kv_norm() + l * 128, MapId{0}, 16, scr, r, c.lane); continue; } r -= I_UV;
        if (r < I_WO) { transpose_item(c.w_o_nsa() + (size_t)l * 512 * 1024, 1024, 512, WSP(bf16_t, WS_WOT) + ((size_t)l * 3 + 0) * 1024 * 512, nullptr, MapId{0}, 32, scr, r, c.lane); continue; } r -= I_WO;
        if (r < I_WO) { transpose_item(c.w_o_mla() + (size_t)l * 512 * 1024, 1024, 512, WSP(bf16_t, WS_WOT) + ((size_t)l * 3 + 1) * 1024 * 512, nullptr, MapId{0}, 32, scr, r, c.lane); continue; } r -= I_WO;
        if (r < I_WO) { transpose_item(c.w_o_fox() + (size_t)l * 512 * 1024, 1024, 512, WSP(bf16_t, WS_WOT) + ((size_t)l * 3 + 2) * 1024 * 512, nullptr, MapId{0}, 32, scr, r, c.lane); continue; } r -= I_WO;
        if (r < I_WOUT) { transpose_item(c.w_out() + (size_t)l * D * D, D, D, WSP(bf16_t, WS_WOUTT) + (size_t)l * D * D, nullptr, MapId{0}, 32, scr, r, c.lane); continue; } r -= I_WOUT;
        { const int kv = r / I_C1; const float* w = (kv == 0 ? c.cmp_k_w1() : c.cmp_v_w1()) + (size_t)l * 2048 * 128;
          transpose_item(w, 128, 2048, WSP(bf16_t, WS_WC1T) + ((size_t)l * 2 + kv) * 256 * 2048, nullptr, MapPad128{}, 8, scr, r % I_C1, c.lane); }
    }
    { float* rc = WSP(float, WS_ROPE); float* rs = rc + (size_t)M * 16;
      for (int i = c.bid * NTHREADS + c.tid; i < M * 16; i += c.G * NTHREADS) { const int m = i >> 4, j = i & 15;
          const float inv = exp2f(-(float)j * 0.8304820237218407f);   const float ang = (float)c.pos()[m] * inv; double rev = (double)ang * 0.15915494309189535; rev -= floor(rev); const float fr_ = (float)rev; rc[i] = __builtin_amdgcn_cosf(fr_); rs[i] = __builtin_amdgcn_sinf(fr_); } }
    float* tab = WSP(float, WS_TAB);
    if (c.bid == 0) {
        const int l = c.tid >> 8, kv = (c.tid >> 7) & 1, j = c.tid & 127;
        const float* w1 = (kv == 0 ? c.cmp_k_w1() : c.cmp_v_w1()) + (size_t)l * 2048 * 128; const float* b1 = (kv == 0 ? c.cmp_k_b1() : c.cmp_v_b1()) + l * 128; const float* pe = c.cmp_pe() + l * 2048;
        float s = b1[j]; for (int k = 0; k < 2048; ++k) s += pe[k] * w1[(size_t)k * 128 + j];
        tab[c.tid] = s;
    }
    if (c.bid == 1 % c.G) {
        for (int i = c.tid; i < 8 * 129; i += NTHREADS) { const int h = i / 129, d = i % 129; tab[512 + h * 132 + d] = c.rel_bias()[rel_bucket_dev(d) * 8 + h]; }
    }
}

__device__ __forceinline__ void phase_norm(const Ctx& c, const float* src, const bf16_t* y0, const bf16_t* y1, float* rout, bf16_t* hout) {
    const int gw = c.bid * NWAVES + c.wave, NGW = c.G * NWAVES;
    for (int m = gw; m < M; m += NGW) {
        const f32x4* xr = (const f32x4*)(src + (size_t)m * D) + c.lane;
        f32x4 v[4]; float s = 0.f;
#pragma unroll
        for (int j = 0; j < 4; ++j) { v[j] = xr[64 * j];
            if (y0) { const u32x2 a = *((const u32x2*)(y0 + (size_t)m * D) + c.lane + 64 * j); const u32x2 b = *((const u32x2*)(y1 + (size_t)m * D) + c.lane + 64 * j);
                v[j].x += __uint_as_float(a.x << 16) + __uint_as_float(b.x << 16); v[j].y += __uint_as_float(a.x & 0xffff0000u) + __uint_as_float(b.x & 0xffff0000u);
                v[j].z += __uint_as_float(a.y << 16) + __uint_as_float(b.y << 16); v[j].w += __uint_as_float(a.y & 0xffff0000u) + __uint_as_float(b.y & 0xffff0000u); }
            s += (v[j].x * v[j].x + v[j].y * v[j].y) + (v[j].z * v[j].z + v[j].w * v[j].w); }
        const float rstd = rsqrtf(wave_sum(s) * (1.f / D) + EPS);
        if (rout) { f32x4* ro = (f32x4*)(rout + (size_t)m * D) + c.lane;
#pragma unroll
            for (int j = 0; j < 4; ++j) ro[64 * j] = v[j]; }
        u32x2* o8 = (u32x2*)(hout + (size_t)m * D) + c.lane;
#pragma unroll
        for (int j = 0; j < 4; ++j) { u32x2 w; w.x = pk2(v[j].x * rstd, v[j].y * rstd); w.y = pk2(v[j].z * rstd, v[j].w * rstd); o8[64 * j] = w; }
    }
}
__device__ __forceinline__ void phase_final(const Ctx& c) {
    const int gw = c.bid * NWAVES + c.wave, NGW = c.G * NWAVES;
    const float* src = WSP(float, WS_XA); const bf16_t* y0 = WSP(bf16_t, WS_Y); const bf16_t* y1 = y0 + (size_t)M * D;
    for (int m = gw; m < M; m += NGW) {
        const f32x4* xr = (const f32x4*)(src + (size_t)m * D) + c.lane;
        f32x4 v[4]; float s = 0.f;
#pragma unroll
        for (int j = 0; j < 4; ++j) { v[j] = xr[64 * j];
            const u32x2 a = *((const u32x2*)(y0 + (size_t)m * D) + c.lane + 64 * j); const u32x2 b = *((const u32x2*)(y1 + (size_t)m * D) + c.lane + 64 * j);
            v[j].x += __uint_as_float(a.x << 16) + __uint_as_float(b.x << 16); v[j].y += __uint_as_float(a.x & 0xffff0000u) + __uint_as_float(b.x & 0xffff0000u);
            v[j].z += __uint_as_float(a.y << 16) + __uint_as_float(b.y << 16); v[j].w += __uint_as_float(a.y & 0xffff0000u) + __uint_as_float(b.y & 0xffff0000u);
            s += (v[j].x * v[j].x + v[j].y * v[j].y) + (v[j].z * v[j].z + v[j].w * v[j].w); }
        const float rstd = rsqrtf(wave_sum(s) * (1.f / D) + EPS);
        f32x4* ro = (f32x4*)(c.out + (size_t)m * D) + c.lane;
#pragma unroll
        for (int j = 0; j < 4; ++j) { const f32x4 g = *((const f32x4*)c.norm_final() + c.lane + 64 * j); ro[64 * j] = v[j] * rstd * g; }
    }
}

__device__ __forceinline__ void phase_prep(const Ctx& c, int l) {
    const int gw = c.bid * NWAVES + c.wave, NGW = c.G * NWAVES;
    const bf16_t* P1 = WSP(bf16_t, WS_P1); float* rstd = WSP(float, WS_RSTD); bf16_t* KR = WSP(bf16_t, WS_KR); float* LF = WSP(float, WS_LF);
    const float* rc = WSP(float, WS_ROPE); const float* rs = rc + (size_t)M * 16;
    for (int m = gw; m < M; m += NGW) {
        const bf16_t* row = P1 + (size_t)m * P1W;
        const u32x2 a = *((const u32x2*)(row + C_CQ) + c.lane);
        float q0 = __uint_as_float(a.x << 16), q1 = __uint_as_float(a.x & 0xffff0000u), q2 = __uint_as_float(a.y << 16), q3 = __uint_as_float(a.y & 0xffff0000u);
        const float sq = wave_sum(q0 * q0 + q1 * q1 + q2 * q2 + q3 * q3);
        const unsigned b = *((const unsigned*)(row + C_CKV) + c.lane);
        float k0 = __uint_as_float(b << 16), k1 = __uint_as_float(b & 0xffff0000u);
        const float sk = wave_sum(k0 * k0 + k1 * k1);
        if (c.lane == 0) { rstd[2 * m] = rsqrtf(sq * (1.f / 256.f) + EPS); rstd[2 * m + 1] = rsqrtf(sk * (1.f / 128.f) + EPS); }
        if (c.lane < 16) { const float x1 = bf2f(row[C_KR + c.lane]), x2 = bf2f(row[C_KR + 16 + c.lane]); const float cs = rc[m * 16 + c.lane], sn = rs[m * 16 + c.lane];
            KR[m * 32 + c.lane] = (bf16_t)f2bf(x1 * cs - x2 * sn); KR[m * 32 + 16 + c.lane] = (bf16_t)f2bf(x1 * sn + x2 * cs); }
        if (c.lane < 8) { const float f = bf2f(row[C_FF + c.lane]) + c.fox_b_f()[l * 8 + c.lane];
            const float ls = fminf(f, 0.f) - __logf(1.f + __expf(-fabsf(f)));
            const int bb = m / T, t = m % T; LF[((size_t)bb * 8 + c.lane) * T + t] = ls; }
    }
}
__device__ __forceinline__ void phase_cum(const Ctx& c) {
    LAS float* sh = (LAS float*)c.lds;
    for (int s = c.bid; s < NB * 8; s += c.G) {
        const float* lf = WSP(float, WS_LF) + (size_t)s * T; float* cum = WSP(float, WS_CUM) + (size_t)s * T;
        float v[16]; float tot = 0.f;
#pragma unroll
        for (int j = 0; j < 16; ++j) { v[j] = lf[c.tid * 16 + j]; tot += v[j]; }
        sh[c.tid] = tot; __syncthreads();
        if (c.tid == 0) { float run = 0.f; for (int i = 0; i < NTHREADS; ++i) { const float t_ = sh[i]; sh[i] = run; run += t_; } }
        __syncthreads();
        float run = sh[c.tid];
#pragma unroll
        for (int j = 0; j < 16; ++j) { run += v[j]; cum[c.tid * 16 + j] = run; }
        __syncthreads();
    }
}
__device__ __forceinline__ void phase_cmp2_ropeq(const Ctx& c, int l) {
    const bf16_t* HC = WSP(bf16_t, WS_HC);
    for (int i = c.bid * NTHREADS + c.tid; i < 2 * 2048 * 64; i += c.G * NTHREADS) {
        const int kv = i / (2048 * 64), row = (i / 64) % 2048, d = i % 64;
        const float* w2 = (kv == 0 ? c.cmp_k_w2() : c.cmp_v_w2()) + (size_t)l * 128 * 64;
        const bf16_t* h = HC + ((size_t)kv * 2048 + row) * 128; float s = 0.f;
        for (int j = 0; j < 128; ++j) s += bf2f(h[j]) * w2[j * 64 + d];
        if ((row & 511) == 511) s = 0.f;
        (kv == 0 ? WSP(bf16_t, WS_KC) : WSP(bf16_t, WS_VC))[(size_t)row * 64 + d] = (bf16_t)f2bf(s);
    }
    bf16_t* QB = WSP(bf16_t, WS_QB); const float* rc = WSP(float, WS_ROPE); const float* rs = rc + (size_t)M * 16;
    for (int i = c.bid * NTHREADS + c.tid; i < M * 128; i += c.G * NTHREADS) {
        const int m = i >> 7, h = (i >> 4) & 7, j = i & 15;
        bf16_t* p = QB + (size_t)m * 768 + 512 + h * 32; const float x1 = bf2f(p[j]), x2 = bf2f(p[16 + j]); const float cs = rc[m * 16 + j], sn = rs[m * 16 + j];
        p[j] = (bf16_t)f2bf(x1 * cs - x2 * sn); p[16 + j] = (bf16_t)f2bf(x1 * sn + x2 * cs);
    }
}

typedef float f32x2_t __attribute__((ext_vector_type(2))); typedef __bf16 bf16x2_t __attribute__((ext_vector_type(2)));
__device__ __forceinline__ unsigned cvtpk(float lo, float hi) { f32x2_t v = {lo, hi}; bf16x2_t b = __builtin_convertvector(v, bf16x2_t); return __builtin_bit_cast(unsigned, b); }
__device__ __forceinline__ u32x2 pk4(f32x4 v) { u32x2 w; w.x = cvtpk(v.x, v.y); w.y = cvtpk(v.z, v.w); return w; }
__device__ __forceinline__ f32x4 unpk4(u32x2 a) { f32x4 r; r.x = __uint_as_float(a.x << 16); r.y = __uint_as_float(a.x & 0xffff0000u); r.z = __uint_as_float(a.y << 16); r.w = __uint_as_float(a.y & 0xffff0000u); return r; }
#define EPI_ARGS const f32x4 (&acc)[2][2][4][2], const pg8::Unit& u, int wr, int wc, int fr, int fq
#define EPI_LOOP _Pragma("unroll") for (int ai = 0; ai < 2; ++ai) _Pragma("unroll") for (int m = 0; m < 4; ++m) _Pragma("unroll") for (int bj = 0; bj < 2; ++bj) _Pragma("unroll") for (int n = 0; n < 2; ++n)

struct EpiStoreBf16 { bf16_t* O; int ldc; const float* rowscale; int rs_stride;
    __device__ __forceinline__ void operator()(EPI_ARGS) const {
        EPI_LOOP { PG8_EPI_ROWCOL(row, col); f32x4 v = acc[ai][bj][m][n]; if (rowscale) v = v * rowscale[(size_t)row * rs_stride]; *(u32x2*)(O + (size_t)row * ldc + col) = pk4(v); } } };
struct EpiGates { bf16_t* O; const float* bias;
    __device__ __forceinline__ void operator()(EPI_ARGS) const {
        EPI_LOOP { PG8_EPI_ROWCOL(row, col); f32x4 v = acc[ai][bj][m][n] + *(const f32x4*)(bias + col);
            v.x = sigmoidf_(v.x); v.y = sigmoidf_(v.y); v.z = sigmoidf_(v.z); v.w = sigmoidf_(v.w); *(u32x2*)(O + (size_t)row * 3072 + col) = pk4(v); } } };
struct EpiCmp1 { bf16_t* HC; const float* bc1;
    __device__ __forceinline__ void operator()(EPI_ARGS) const {
        const int kv = u.pm >> 3, bg = (u.pm >> 1) & 3, half = u.pm & 1;
#pragma unroll
        for (int ai = 0; ai < 2; ++ai)
#pragma unroll
            for (int m = 0; m < 4; ++m)
#pragma unroll
                for (int n = 0; n < 2; ++n) { const int i = half * 256 + ai * 128 + wr * 64 + m * 16 + fr, cc = wc * 32 + n * 16 + fq * 4;
                    f32x4 v = acc[ai][0][m][n] + *(const f32x4*)(bc1 + kv * 128 + cc);
                    v.x = gelu_tanh(v.x); v.y = gelu_tanh(v.y); v.z = gelu_tanh(v.z); v.w = gelu_tanh(v.w);
                    *(u32x2*)(HC + ((size_t)kv * 2048 + bg * 512 + i) * 128 + cc) = pk4(v); } } };
struct EpiOutproj { bf16_t* MIX; const bf16_t* GATES; int br;
    __device__ __forceinline__ void operator()(EPI_ARGS) const {
        EPI_LOOP { PG8_EPI_ROWCOL(row, col); const f32x4 g = unpk4(*(const u32x2*)(GATES + (size_t)row * 3072 + br * 1024 + col)); f32x4 v = acc[ai][bj][m][n] * g;
            u32x2* p = (u32x2*)(MIX + (size_t)row * 1024 + col); if (br > 0) v = v + unpk4(*p); *p = pk4(v); } } };
struct EpiWout { const float* R; float* XA;
    __device__ __forceinline__ void operator()(EPI_ARGS) const {
        EPI_LOOP { PG8_EPI_ROWCOL(row, col); const f32x4 r = *(const f32x4*)(R + (size_t)row * 1024 + col); *(f32x4*)(XA + (size_t)row * 1024 + col) = r + acc[ai][bj][m][n]; } } };
struct EpiMoe1 { bf16_t* HID; const float* LW;
    __device__ __forceinline__ void operator()(EPI_ARGS) const {
#pragma unroll
        for (int ai = 0; ai < 2; ++ai)
#pragma unroll
            for (int m = 0; m < 4; ++m) { int aux_ = u.aux; asm volatile("" : "+s"(aux_)); const unsigned pos = (unsigned)(aux_ + ai * 128 + wr * 64 + m * 16 + fr); const float w = LW[pos];
#pragma unroll
                for (int n = 0; n < 2; ++n) { const f32x4 g = acc[ai][0][m][n], up = acc[ai][1][m][n]; f32x4 h;
                    h.x = g.x * sigmoidf_(g.x) * up.x * w; h.y = g.y * sigmoidf_(g.y) * up.y * w; h.z = g.z * sigmoidf_(g.z) * up.z * w; h.w = g.w * sigmoidf_(g.w) * up.w * w;
                    *(u32x2*)(HID + pos * 256u + (unsigned)(u.pn * 128 + wc * 32 + n * 16 + fq * 4)) = pk4(h); }
                asm volatile("" ::: "memory"); } } };
struct EpiMoe2 { bf16_t* Y; const unsigned* LDST;
    __device__ __forceinline__ void operator()(EPI_ARGS) const {
#pragma unroll
        for (int ai = 0; ai < 2; ++ai)
#pragma unroll
            for (int m = 0; m < 4; ++m) { int aux_ = u.aux; asm volatile("" : "+s"(aux_)); const unsigned pos = (unsigned)(aux_ + ai * 128 + wr * 64 + m * 16 + fr); const unsigned d0 = LDST[pos];
                if (d0 != 0xFFFFFFFFu) { const unsigned off = d0 + (unsigned)(u.pn * 256 + wc * 32 + fq * 4);
#pragma unroll
                    for (int bj = 0; bj < 2; ++bj)
#pragma unroll
                        for (int n = 0; n < 2; ++n) *(u32x2*)(Y + off + bj * 128 + n * 16) = pk4(acc[ai][bj][m][n]); }
                asm volatile("" ::: "memory"); } } };

struct CmpOrder { int G, c; const char* P1; const char* W;
    __device__ bool next(int i, pg8::Unit& u) const { const int L_ = i * G + c; if (L_ >= 16) return false; const int kv = L_ >> 3, b = (L_ >> 2) & 1, g = (L_ >> 1) & 1, half = L_ & 1;
        u.pm = L_; u.pn = 0; u.aux = 0; u.A = P1 + ((size_t)(b * T + 16 * 256 * half) * P1W + C_NKV + (kv * 2 + g) * 64) * 2; u.B = W + (size_t)kv * 256 * 2048 * 2; return true; } };
struct MoeOrder { int G, c, nN; const LAS int* tab; const char* A; size_t a_rowbytes; const char* W; size_t w_expert, w_tile;
    __device__ bool next(int i, pg8::Unit& u) const { const int L_ = i * G + c; const int NT = __builtin_amdgcn_readfirstlane(tab[32]); if (L_ >= NT * nN) return false; const int rt = L_ / nN, pn = L_ % nN;
        int e = 0; while (__builtin_amdgcn_readfirstlane(tab[e + 1]) <= rt) ++e;
        const int off_e = __builtin_amdgcn_readfirstlane(tab[33 + e]), ts_e = __builtin_amdgcn_readfirstlane(tab[e]), cnt_e = __builtin_amdgcn_readfirstlane(tab[66 + e]);
        const int pos0 = off_e + 256 * (rt - ts_e); u.pn = pn; u.aux = pos0; u.pm = off_e + cnt_e;
        u.A = A + (size_t)pos0 * a_rowbytes; u.B = W + (size_t)e * w_expert + (size_t)pn * w_tile; return true; } };
__device__ __forceinline__ void moe_tables(const Ctx& c, int l, LAS int* tab) {
    if (c.tid == 0) { const unsigned* cnt = WSP(unsigned, WS_CTL) + CW_MOECNT + l * 64; int ts = 0, off = 0;
        for (int e = 0; e < 32; ++e) { const int n = (int)cnt[e]; tab[e] = ts; tab[33 + e] = off; tab[66 + e] = n; const int nt_ = (n + 255) >> 8; ts += nt_; off += nt_ * 256; }
        tab[32] = ts; tab[65] = off; }
    __syncthreads();
}

__device__ __forceinline__ void phase_router(const Ctx& c, int l) {
    const int gw = c.bid * NWAVES + c.wave, NGW = c.G * NWAVES;
    const float* XA = WSP(float, WS_XA); bf16_t* H2 = WSP(bf16_t, WS_H2); int* REC = WSP(int, WS_REC); unsigned* cnt = WSP(unsigned, WS_CTL) + CW_MOECNT + l * 64;
    const float* g2 = c.norm_ffn() + l * D; const float* wg = c.moe_w_grp() + (size_t)l * D * 4; const float* wr_ = c.moe_w_router() + (size_t)l * D * 32;
    for (int m = gw; m < M; m += NGW) {
        const f32x4* xr = (const f32x4*)(XA + (size_t)m * D) + c.lane;
        f32x4 v[4]; float s = 0.f;
#pragma unroll
        for (int j = 0; j < 4; ++j) { v[j] = xr[64 * j]; s += (v[j].x * v[j].x + v[j].y * v[j].y) + (v[j].z * v[j].z + v[j].w * v[j].w); }
        const float rstd = rsqrtf(wave_sum(s) * (1.f / D) + EPS);
        u32x2* o8 = (u32x2*)(H2 + (size_t)m * D) + c.lane;
        float lg[36];
#pragma unroll
        for (int o = 0; o < 36; ++o) lg[o] = 0.f;
#pragma unroll
        for (int j = 0; j < 4; ++j) { v[j] = v[j] * rstd; o8[64 * j] = pk4(v[j]);
            const f32x4 gg = *((const f32x4*)g2 + c.lane + 64 * j); const f32x4 tv = v[j] * gg;
#pragma unroll
            for (int e = 0; e < 4; ++e) { const int k = 4 * c.lane + 256 * j + e; const float te = tv[e];
                const f32x4 a = *(const f32x4*)(wg + (size_t)k * 4);
#pragma unroll
                for (int o = 0; o < 4; ++o) lg[o] += te * a[o];
#pragma unroll
                for (int q = 0; q < 8; ++q) { const f32x4 w4 = *(const f32x4*)(wr_ + (size_t)k * 32 + 4 * q);
#pragma unroll
                    for (int o = 0; o < 4; ++o) lg[4 + 4 * q + o] += te * w4[o]; } } }
#pragma unroll
        for (int o = 0; o < 36; ++o) lg[o] = wave_sum(lg[o]);
        float gl[4];
#pragma unroll
        for (int o = 0; o < 4; ++o) gl[o] = lg[o] + c.moe_b_grp()[l * 4 + o];
        int gi = 0; float gm = gl[0];
#pragma unroll
        for (int o = 1; o < 4; ++o) if (gl[o] > gm) { gm = gl[o]; gi = o; }
        float gs = 0.f;
#pragma unroll
        for (int o = 0; o < 4; ++o) gs += __expf(gl[o] - gm);
        const float grp_top = 1.f / gs;
        float el[8];
#pragma unroll
        for (int q = 0; q < 8; ++q) { const float a0 = lg[4 + q], a1 = lg[12 + q], a2 = lg[20 + q], a3 = lg[28 + q]; el[q] = (gi == 0 ? a0 : gi == 1 ? a1 : gi == 2 ? a2 : a3) + c.moe_b_router()[l * 32 + gi * 8 + q]; }
        int i1 = 0; float m1 = el[0];
#pragma unroll
        for (int q = 1; q < 8; ++q) if (el[q] > m1) { m1 = el[q]; i1 = q; }
        int i2 = -1; float m2 = -3.0e38f;
#pragma unroll
        for (int q = 0; q < 8; ++q) if (q != i1 && el[q] > m2) { m2 = el[q]; i2 = q; }
        const float e2 = __expf(m2 - m1); const float w1 = grp_top / (1.f + e2), w2 = grp_top * e2 / (1.f + e2);
        if (c.lane == 0) { const int ea = gi * 8 + i1, eb = gi * 8 + i2; const int ra = (int)atomicAdd(cnt + ea, 1u), rb = (int)atomicAdd(cnt + eb, 1u);
            int* r = REC + (size_t)m * 8; r[0] = ea; r[1] = eb; r[2] = ra; r[3] = rb; r[4] = __float_as_int(w1); r[5] = __float_as_int(w2); }
    }
}
__device__ __forceinline__ void phase_place(const Ctx& c, int l) {
    LAS int* tab = (LAS int*)(c.lds + LDS_MOETAB);
    moe_tables(c, l, tab);
    int* LTOK = WSP(int, WS_LTOK); float* LW = WSP(float, WS_LW); unsigned* LDST = WSP(unsigned, WS_LSLOT); const int* REC = WSP(int, WS_REC);
    for (int m = c.bid * NTHREADS + c.tid; m < M; m += c.G * NTHREADS) { const int* r = REC + (size_t)m * 8;
        const int pa = tab[33 + r[0]] + r[2], pb = tab[33 + r[1]] + r[3];
        LTOK[pa] = m; LDST[pa] = (unsigned)m * 1024u; LW[pa] = __int_as_float(r[4]); LTOK[pb] = m; LDST[pb] = ((unsigned)M + (unsigned)m) * 1024u; LW[pb] = __int_as_float(r[5]); }
    for (int e = c.bid; e < 32; e += c.G) { const int lo = tab[33 + e] + tab[66 + e], hi2 = tab[33 + e + 1];
        for (int p = lo + c.tid; p < hi2; p += NTHREADS) { LTOK[p] = 0; LDST[p] = 0xFFFFFFFFu; LW[p] = 0.f; } }
    LAS float* scr = (LAS float*)(c.lds + c.wave * 16384);
    const int gw = c.bid * NWAVES + c.wave, NGW = c.G * NWAVES;
    constexpr int I_GU = 16 * 16, I_DN = 4 * 32;
    for (int it = gw; it < 32 * (I_GU + I_DN); it += NGW) { const int e = it / (I_GU + I_DN); int r = it % (I_GU + I_DN);
        if (r < I_GU) { const int nb = r % 16; const bool up = ((nb * 32) & 255) >= 128;
            const float* w = (up ? c.moe_w_up() : c.moe_w_gate()) + ((size_t)l * 32 + e) * D * 256;
            transpose_item(w, 256, D, WSP(bf16_t, WS_WGU) + (size_t)e * 512 * D, c.norm_ffn() + l * D, MapGU{}, 16, scr, r, c.lane); }
        else { r -= I_GU; transpose_item(c.moe_w_down() + ((size_t)l * 32 + e) * 256 * D, D, 256, WSP(bf16_t, WS_WDT) + (size_t)e * D * 256, nullptr, MapId{0}, 32, scr, r, c.lane); } }
}

template <int N> __device__ __forceinline__ float dotn(const float* q, const bf16_t* k) {
    float s = 0.f;
#pragma unroll
    for (int c8 = 0; c8 < N / 8; ++c8) { const u32x4 w = *(const u32x4*)(k + 8 * c8);
        s += q[8 * c8 + 0] * __uint_as_float(w.x << 16) + q[8 * c8 + 1] * __uint_as_float(w.x & 0xffff0000u) + q[8 * c8 + 2] * __uint_as_float(w.y << 16) + q[8 * c8 + 3] * __uint_as_float(w.y & 0xffff0000u)
           + q[8 * c8 + 4] * __uint_as_float(w.z << 16) + q[8 * c8 + 5] * __uint_as_float(w.z & 0xffff0000u) + q[8 * c8 + 6] * __uint_as_float(w.w << 16) + q[8 * c8 + 7] * __uint_as_float(w.w & 0xffff0000u); }
    return s;
}
__device__ __forceinline__ void axpy64(float* o, float p, const bf16_t* v) {
#pragma unroll
    for (int c8 = 0; c8 < 8; ++c8) { const u32x4 w = *(const u32x4*)(v + 8 * c8);
        o[8 * c8 + 0] += p * __uint_as_float(w.x << 16); o[8 * c8 + 1] += p * __uint_as_float(w.x & 0xffff0000u); o[8 * c8 + 2] += p * __uint_as_float(w.y << 16); o[8 * c8 + 3] += p * __uint_as_float(w.y & 0xffff0000u);
        o[8 * c8 + 4] += p * __uint_as_float(w.z << 16); o[8 * c8 + 5] += p * __uint_as_float(w.z & 0xffff0000u); o[8 * c8 + 6] += p * __uint_as_float(w.w << 16); o[8 * c8 + 7] += p * __uint_as_float(w.w & 0xffff0000u); }
}
#define ONLINE(sc) do { const float mn_ = fmaxf(mrun, (sc)); lrun = lrun * __expf(mrun - mn_) + __expf((sc) - mn_); mrun = mn_; } while (0)
#define MERGE_ML() const float Mx = wave_max(mrun); const float Ls = wave_sum(mrun == -INFINITY ? 0.f : lrun * __expf(mrun - Mx))
__device__ __forceinline__ void store_o64(float* o, bf16_t* dst, int lane) {
    float r = 0.f;
#pragma unroll
    for (int d = 0; d < 64; ++d) { const float s = wave_sum(o[d]); r = (lane == d) ? s : r; }
    dst[lane] = (bf16_t)f2bf(r);
}

__device__ __forceinline__ void phase_att_fox_naive(const Ctx& c) {
    const int gw = c.bid * NWAVES + c.wave, NGW = c.G * NWAVES;
    const bf16_t* P1 = WSP(bf16_t, WS_P1); bf16_t* OUT = WSP(bf16_t, WS_OUTC);
    for (int item = gw; item < M * 8; item += NGW) {
        const int m = item >> 3, h = item & 7, b = m / T, t = m % T;
        float q[64], o[64];
#pragma unroll
        for (int d = 0; d < 64; ++d) { q[d] = bf2f(P1[(size_t)m * P1W + C_FQKV + h * 64 + d]); o[d] = 0.f; }
        const float* cum = WSP(float, WS_CUM) + ((size_t)b * 8 + h) * T; const float ct = cum[t];
        const bf16_t* Kb = P1 + (size_t)b * T * P1W + C_FQKV + 512 + h * 64; const bf16_t* Vb = Kb + 512;
        float mrun = -INFINITY, lrun = 0.f;
        for (int s = c.lane; s <= t; s += 64) { const float sc = dotn<64>(q, Kb + (size_t)s * P1W) * 0.125f + (ct - cum[s]); ONLINE(sc); }
        MERGE_ML();
        const float inv = 1.f / Ls;
        for (int s = c.lane; s <= t; s += 64) { const float sc = dotn<64>(q, Kb + (size_t)s * P1W) * 0.125f + (ct - cum[s]); axpy64(o, __expf(sc - Mx) * inv, Vb + (size_t)s * P1W); }
        store_o64(o, OUT + (size_t)m * 512 + h * 64, c.lane);
    }
}
__device__ __forceinline__ void phase_att_mla_naive(const Ctx& c) {
    const int gw = c.bid * NWAVES + c.wave, NGW = c.G * NWAVES;
    const bf16_t* QB = WSP(bf16_t, WS_QB); const bf16_t* KVB = WSP(bf16_t, WS_KVB); const bf16_t* KR = WSP(bf16_t, WS_KR); bf16_t* OUT = WSP(bf16_t, WS_OUTB);
    const float scale = 0.10206207261596575f;
    for (int item = gw; item < M * 8; item += NGW) {
        const int m = item >> 3, h = item & 7, b = m / T, t = m % T;
        float q[96], o[64];
#pragma unroll
        for (int d = 0; d < 64; ++d) { q[d] = bf2f(QB[(size_t)m * 768 + h * 64 + d]); o[d] = 0.f; }
#pragma unroll
        for (int d = 0; d < 32; ++d) q[64 + d] = bf2f(QB[(size_t)m * 768 + 512 + h * 32 + d]);
        const bf16_t* Kb = KVB + (size_t)b * T * 1024 + h * 64; const bf16_t* Vb = Kb + 512; const bf16_t* Rb = KR + (size_t)b * T * 32;
        float mrun = -INFINITY, lrun = 0.f;
        for (int s = c.lane; s <= t; s += 64) { const float sc = (dotn<64>(q, Kb + (size_t)s * 1024) + dotn<32>(q + 64, Rb + (size_t)s * 32)) * scale; ONLINE(sc); }
        MERGE_ML();
        const float inv = 1.f / Ls;
        for (int s = c.lane; s <= t; s += 64) { const float sc = (dotn<64>(q, Kb + (size_t)s * 1024) + dotn<32>(q + 64, Rb + (size_t)s * 32)) * scale; axpy64(o, __expf(sc - Mx) * inv, Vb + (size_t)s * 1024); }
        store_o64(o, OUT + (size_t)m * 512 + h * 64, c.lane);
    }
}
__device__ __forceinline__ void phase_att_nsa_naive(const Ctx& c) {
    LAS float* pc = (LAS float*)c.lds;
    LAS float* scw = (LAS float*)(c.lds + 16384) + c.wave * 128;
    const int half = c.wave >> 2, hp = c.wave & 3;
    const bf16_t* P1 = WSP(bf16_t, WS_P1); bf16_t* OUT = WSP(bf16_t, WS_OUTA); const float* tab = WSP(float, WS_TAB);
    for (int it0 = c.bid * 2; it0 < M * 2; it0 += c.G * 2) {
        const int item = it0 + half, m = item >> 1, g = item & 1, b = m / T, t = m % T, h = g * 4 + hp;
        float q[64], o[64];
#pragma unroll
        for (int d = 0; d < 64; ++d) { q[d] = bf2f(P1[(size_t)m * P1W + C_NQ + h * 64 + d]); o[d] = 0.f; }
        const float gc = sigmoidf_(bf2f(P1[(size_t)m * P1W + C_NG + h * 3 + 0])), gs = sigmoidf_(bf2f(P1[(size_t)m * P1W + C_NG + h * 3 + 1])), gwn = sigmoidf_(bf2f(P1[(size_t)m * P1W + C_NG + h * 3 + 2]));
        const float* lut = tab + 512 + h * 132;
        LAS float* pcw = pc + (half * 4 + hp) * 512;
        { const int n_ok = t >= 31 ? ((t - 31) >> 4) + 1 : 0;
          const bf16_t* KCb = WSP(bf16_t, WS_KC) + (size_t)(b * 2 + g) * 512 * 64; const bf16_t* VCb = WSP(bf16_t, WS_VC) + (size_t)(b * 2 + g) * 512 * 64;
          float mrun = -INFINITY, lrun = 0.f;
          for (int i = c.lane; i < n_ok; i += 64) { int dist = t - (16 * i + 31); dist = dist > 128 ? 128 : dist; const float sc = dotn<64>(q, KCb + (size_t)i * 64) * 0.125f + lut[dist]; ONLINE(sc); }
          MERGE_ML();
          const float inv = n_ok > 0 ? 1.f / Ls : 0.f;
          for (int i = c.lane; i < 512; i += 64) { float p = 0.f;
              if (i < n_ok) { int dist = t - (16 * i + 31); dist = dist > 128 ? 128 : dist; const float sc = dotn<64>(q, KCb + (size_t)i * 64) * 0.125f + lut[dist]; p = __expf(sc - Mx) * inv; axpy64(o, p * gc, VCb + (size_t)i * 64); }
              pcw[i] = p; } }
        __syncthreads();
        const int blk = t >> 6;
        { const LAS float* p0 = pc + (half * 4) * 512;
#pragma unroll
          for (int jj = 0; jj < 2; ++jj) { const int j = c.lane + 64 * jj; float imp[5];
#pragma unroll
              for (int e = 0; e < 5; ++e) { const int i = 4 * j + e; imp[e] = (i < 511) ? (p0[i] + p0[512 + i]) + (p0[1024 + i] + p0[1536 + i]) : 0.f; }
              const float ps = imp[0] + 2.f * imp[1] + 2.f * imp[2] + 2.f * imp[3] + imp[4];
              const bool forced = (j == 0) || (j <= blk && j > blk - 2);
              scw[j] = (j <= blk) ? (forced ? 1e9f : ps) : -1e30f; } }
        __syncthreads();
        unsigned long long selmask[2];
#pragma unroll
        for (int jj = 0; jj < 2; ++jj) { const int j = c.lane + 64 * jj; const float sj = scw[j]; int rank = 0;
            for (int k = 0; k < 128; ++k) { const float sk = scw[k]; rank += (sk > sj || (sk == sj && k < j)) ? 1 : 0; }
            selmask[jj] = __ballot(rank < 16 && j <= blk); }
        { const bf16_t* KS = P1 + (size_t)b * T * P1W + C_NKV + ((1 * 2 + 0) * 2 + g) * 64; const bf16_t* VS = P1 + (size_t)b * T * P1W + C_NKV + ((1 * 2 + 1) * 2 + g) * 64;
          float mrun = -INFINITY, lrun = 0.f;
#pragma unroll
          for (int jj = 0; jj < 2; ++jj) { unsigned long long mk = selmask[jj];
              while (mk) { const int j = __builtin_ctzll(mk) + 64 * jj; mk &= mk - 1; const int s = j * 64 + c.lane;
                  if (s <= t) { int dist = t - s; dist = dist > 128 ? 128 : dist; const float sc = dotn<64>(q, KS + (size_t)s * P1W) * 0.125f + lut[dist]; ONLINE(sc); } } }
          MERGE_ML();
          const float inv = gs / Ls;
#pragma unroll
          for (int jj = 0; jj < 2; ++jj) { unsigned long long mk = selmask[jj];
              while (mk) { const int j = __builtin_ctzll(mk) + 64 * jj; mk &= mk - 1; const int s = j * 64 + c.lane;
                  if (s <= t) { int dist = t - s; dist = dist > 128 ? 128 : dist; const float sc = dotn<64>(q, KS + (size_t)s * P1W) * 0.125f + lut[dist]; axpy64(o, __expf(sc - Mx) * inv, VS + (size_t)s * P1W); } } } }
        { const bf16_t* KW = P1 + (size_t)b * T * P1W + C_NKV + ((2 * 2 + 0) * 2 + g) * 64; const bf16_t* VW = P1 + (size_t)b * T * P1W + C_NKV + ((2 * 2 + 1) * 2 + g) * 64;
          const int s0 = t - 511 > 0 ? t - 511 : 0;
          float mrun = -INFINITY, lrun = 0.f;
          for (int s = s0 + c.lane; s <= t; s += 64) { int dist = t - s; dist = dist > 128 ? 128 : dist; const float sc = dotn<64>(q, KW + (size_t)s * P1W) * 0.125f + lut[dist]; ONLINE(sc); }
          MERGE_ML();
          const float inv = gwn / Ls;
          for (int s = s0 + c.lane; s <= t; s += 64) { int dist = t - s; dist = dist > 128 ? 128 : dist; const float sc = dotn<64>(q, KW + (size_t)s * P1W) * 0.125f + lut[dist]; axpy64(o, __expf(sc - Mx) * inv, VW + (size_t)s * P1W); } }
        store_o64(o, OUT + (size_t)m * 512 + h * 64, c.lane);
        __syncthreads();
    }
}

#ifndef ATT_FAST_FOX
#define ATT_FAST_FOX 1
#endif
#ifndef ATT_FAST_MLA
#define ATT_FAST_MLA 1
#endif
#ifndef ATT_FAST_NSA
#define ATT_FAST_NSA 1
#endif
namespace fa {
constexpr int KPITCH = 208, VPITCH = 136;
constexpr int L_K = 0, L_V = 2 * 64 * KPITCH, L_CUM = L_V + 2 * 64 * VPITCH, L_LUT = L_CUM + 512, L_PS = 49152, L_F = L_PS + 64 * 132 * 4, L_SEL = L_F + 64 * 132 * 4, L_UNI = L_SEL + 1024, L_TL = L_UNI + 16, L_TLN = L_TL + 128, L_UNIT = L_TLN + 16;
static_assert(L_LUT + 8 * 132 * 4 <= L_PS && L_UNIT + 64 <= 131072, "attention LDS map");
__device__ __forceinline__ int crow(int i, int hh) { return (i & 3) + 8 * (i >> 2) + 4 * hh; }
__device__ __forceinline__ float swap32_max(float v) { auto rr = __builtin_amdgcn_permlane32_swap(__float_as_uint(v), __float_as_uint(v), false, false); return fmaxf(__uint_as_float(rr[0]), __uint_as_float(rr[1])); }
__device__ __forceinline__ float swap32_sum(float v) { auto rr = __builtin_amdgcn_permlane32_swap(__float_as_uint(v), __float_as_uint(v), false, false); return __uint_as_float(rr[0]) + __uint_as_float(rr[1]); }

struct KVSrc { const bf16_t* K; int kpitch; const bf16_t* K2; int k2pitch; const bf16_t* V; int vpitch; const float* cum; };
struct TileRegs { u32x4 k, k2, v; float cm; };
template <bool HAS_K2, bool HAS_CUM>
__device__ __forceinline__ void tile_load(TileRegs& R, const KVSrc& s, int kv0, int tid) {
    const int row = tid >> 3, ch = tid & 7;
    R.k = *(const u32x4*)(s.K + (size_t)(kv0 + row) * s.kpitch + ch * 8);
    R.v = *(const u32x4*)(s.V + (size_t)(kv0 + row) * s.vpitch + ch * 8);
    if constexpr (HAS_K2) { if (tid < 256) R.k2 = *(const u32x4*)(s.K2 + (size_t)(kv0 + (tid >> 2)) * s.k2pitch + (tid & 3) * 8); }
    if constexpr (HAS_CUM) { if (tid < 64) R.cm = s.cum[kv0 + tid]; }
}
template <bool HAS_K2, bool HAS_CUM>
__device__ __forceinline__ void tile_store(const TileRegs& R, LAS unsigned char* lds, int buf, int tid) {
    const int row = tid >> 3, ch = tid & 7;
    *(LAS u32x4*)(lds + L_K + buf * 64 * KPITCH + row * KPITCH + ch * 16) = R.k;
    if constexpr (HAS_K2) { if (tid < 256) *(LAS u32x4*)(lds + L_K + buf * 64 * KPITCH + (tid >> 2) * KPITCH + 128 + (tid & 3) * 16) = R.k2; }
    LAS unsigned short* vt = (LAS unsigned short*)(lds + L_V + buf * 64 * VPITCH + (ch * 8) * VPITCH + row * 2);
    vt[0 * (VPITCH / 2)] = (unsigned short)(R.v.x & 0xffffu); vt[1 * (VPITCH / 2)] = (unsigned short)(R.v.x >> 16);
    vt[2 * (VPITCH / 2)] = (unsigned short)(R.v.y & 0xffffu); vt[3 * (VPITCH / 2)] = (unsigned short)(R.v.y >> 16);
    vt[4 * (VPITCH / 2)] = (unsigned short)(R.v.z & 0xffffu); vt[5 * (VPITCH / 2)] = (unsigned short)(R.v.z >> 16);
    vt[6 * (VPITCH / 2)] = (unsigned short)(R.v.w & 0xffffu); vt[7 * (VPITCH / 2)] = (unsigned short)(R.v.w >> 16);
    if constexpr (HAS_CUM) { if (tid < 64) ((LAS float*)(lds + L_CUM))[buf * 64 + tid] = R.cm; }
}
template <int NKS>
__device__ __forceinline__ void qk_tile(f32x16 (&st)[2], const LAS unsigned char* lds, int buf, const bf16x8 (&qf)[NKS], int r, int hh) {
#pragma unroll
    for (int rb = 0; rb < 2; ++rb) {
        f32x16 a = {0.f, 0.f, 0.f, 0.f, 0.f, 0.f, 0.f, 0.f, 0.f, 0.f, 0.f, 0.f, 0.f, 0.f, 0.f, 0.f};
        const LAS unsigned char* kp = lds + L_K + buf * 64 * KPITCH + (32 * rb + r) * KPITCH + hh * 16;
#pragma unroll
        for (int ks = 0; ks < NKS; ++ks) { const bf16x8 kf = *(const LAS bf16x8*)(kp + ks * 32); a = __builtin_amdgcn_mfma_f32_32x32x16_bf16(kf, qf[ks], a, 0, 0, 0); }
        st[rb] = a; }
}
__device__ __forceinline__ void pv_tile(f32x16 (&ot)[2], const LAS unsigned char* lds, int buf, const f32x16 (&p)[2], int r, int hh) {
#pragma unroll
    for (int rb = 0; rb < 2; ++rb)
#pragma unroll
        for (int s_ = 0; s_ < 2; ++s_) {
            u32x4 pw; pw.x = cvtpk(p[rb][8 * s_ + 0], p[rb][8 * s_ + 1]); pw.y = cvtpk(p[rb][8 * s_ + 2], p[rb][8 * s_ + 3]); pw.z = cvtpk(p[rb][8 * s_ + 4], p[rb][8 * s_ + 5]); pw.w = cvtpk(p[rb][8 * s_ + 6], p[rb][8 * s_ + 7]);
            const bf16x8 pf = __builtin_bit_cast(bf16x8, pw);
#pragma unroll
            for (int db = 0; db < 2; ++db) { const LAS unsigned char* vp = lds + L_V + buf * 64 * VPITCH + (32 * db + r) * VPITCH + (32 * rb + 16 * s_ + 4 * hh) * 2;
                const u32x2 lo = *(const LAS u32x2*)vp, hi = *(const LAS u32x2*)(vp + 16); u32x4 vw; vw.x = lo.x; vw.y = lo.y; vw.z = hi.x; vw.w = hi.y;
                ot[db] = __builtin_amdgcn_mfma_f32_32x32x16_bf16(__builtin_bit_cast(bf16x8, vw), pf, ot[db], 0, 0, 0); } }
}
struct SmState { float m, l; };
__device__ __forceinline__ void sm_update(f32x16 (&st)[2], SmState& S, f32x16 (&ot)[2]) {
    float mx = -INFINITY;
#pragma unroll
    for (int rb = 0; rb < 2; ++rb)
#pragma unroll
        for (int i = 0; i < 16; ++i) mx = fmaxf(mx, st[rb][i]);
    mx = swap32_max(mx);
    const float mn = fmaxf(S.m, mx);
    const float msafe = (mn == -INFINITY) ? 0.f : mn;
    const float alpha = __expf(S.m - msafe);
    float sum = 0.f;
#pragma unroll
    for (int rb = 0; rb < 2; ++rb)
#pragma unroll
        for (int i = 0; i < 16; ++i) { const float p = __expf(st[rb][i] - msafe); st[rb][i] = p; sum += p; }
    S.l = S.l * alpha + sum; S.m = mn;
    if (__any(alpha != 1.f)) {
#pragma unroll
        for (int db = 0; db < 2; ++db)
#pragma unroll
            for (int i = 0; i < 16; ++i) ot[db][i] *= alpha; }
}
__device__ __forceinline__ void zero_acc(f32x16 (&a)[2]) {
#pragma unroll
    for (int db = 0; db < 2; ++db)
#pragma unroll
        for (int i = 0; i < 16; ++i) a[db][i] = 0.f;
}
__device__ __forceinline__ void store_ot(const f32x16 (&o)[2], float sc, bf16_t* orow, int hh) {
#pragma unroll
    for (int db = 0; db < 2; ++db)
#pragma unroll
        for (int a = 0; a < 4; ++a) { u32x2 w; w.x = cvtpk(o[db][4 * a + 0] * sc, o[db][4 * a + 1] * sc); w.y = cvtpk(o[db][4 * a + 2] * sc, o[db][4 * a + 3] * sc);
            *(u32x2*)(orow + 32 * db + 8 * a + 4 * hh) = w; }
}

template <bool IS_MLA>
__device__ __forceinline__ void dense_unit(const Ctx& c, int b, int h, int qb) {
    constexpr int NKS = IS_MLA ? 6 : 4;
    const int tid = c.tid, lane = c.lane, r = lane & 31, hh = lane >> 5, w = c.wave;
    LAS unsigned char* lds = c.lds;
    const int q0 = qb * 256, qrow = q0 + 32 * w + r; const size_t mrow = (size_t)b * T + qrow;
    KVSrc src; bf16x8 qf[NKS]; float cq = 0.f; bf16_t* orow;
    if constexpr (IS_MLA) {
        const bf16_t* QB = WSP(bf16_t, WS_QB); const bf16_t* KVB = WSP(bf16_t, WS_KVB);
        src.K = KVB + (size_t)b * T * 1024 + h * 64; src.kpitch = 1024; src.K2 = WSP(bf16_t, WS_KR) + (size_t)b * T * 32; src.k2pitch = 32; src.V = KVB + (size_t)b * T * 1024 + 512 + h * 64; src.vpitch = 1024; src.cum = nullptr;
#pragma unroll
        for (int ks = 0; ks < 4; ++ks) qf[ks] = *(const bf16x8*)(QB + mrow * 768 + h * 64 + 16 * ks + 8 * hh);
#pragma unroll
        for (int ks = 0; ks < 2; ++ks) qf[4 + ks] = *(const bf16x8*)(QB + mrow * 768 + 512 + h * 32 + 16 * ks + 8 * hh);
        orow = WSP(bf16_t, WS_OUTB) + mrow * 512 + h * 64;
    } else {
        const bf16_t* P1 = WSP(bf16_t, WS_P1);
        src.K = P1 + (size_t)b * T * P1W + C_FQKV + 512 + h * 64; src.kpitch = P1W; src.K2 = nullptr; src.k2pitch = 0; src.V = P1 + (size_t)b * T * P1W + C_FQKV + 1024 + h * 64; src.vpitch = P1W;
        src.cum = WSP(float, WS_CUM) + ((size_t)b * 8 + h) * T;
#pragma unroll
        for (int ks = 0; ks < 4; ++ks) qf[ks] = *(const bf16x8*)(P1 + mrow * P1W + C_FQKV + h * 64 + 16 * ks + 8 * hh);
        cq = src.cum[qrow];
        orow = WSP(bf16_t, WS_OUTC) + mrow * 512 + h * 64;
    }
    const float scale = IS_MLA ? 0.10206207261596575f : 0.125f;
    f32x16 st[2], ot[2]; zero_acc(ot); SmState S{-INFINITY, 0.f};
    const int nt = 4 * qb + 4;
    const int wlast = (q0 + 32 * w + 31) >> 6;
    TileRegs R;
    tile_load<IS_MLA, !IS_MLA>(R, src, 0, tid); tile_store<IS_MLA, !IS_MLA>(R, lds, 0, tid);
    if (nt > 1) tile_load<IS_MLA, !IS_MLA>(R, src, 64, tid);
    __syncthreads();
    for (int t = 0; t < nt; ++t) { const int buf = t & 1, kv0 = 64 * t;
        if (t <= wlast) {
            qk_tile<NKS>(st, lds, buf, qf, r, hh);
            const bool diag = (kv0 + 63 > q0 + 32 * w);
#pragma unroll
            for (int rb = 0; rb < 2; ++rb)
#pragma unroll
                for (int a = 0; a < 4; ++a) {
                    f32x4 ck = {0.f, 0.f, 0.f, 0.f};
                    if constexpr (!IS_MLA) ck = *(const LAS f32x4*)(lds + L_CUM + (buf * 64 + 32 * rb + 8 * a + 4 * hh) * 4);
#pragma unroll
                    for (int e = 0; e < 4; ++e) { const int i = 4 * a + e; float s_ = st[rb][i] * scale; if constexpr (!IS_MLA) s_ += cq - ck[e];
                        if (diag && (kv0 + 32 * rb + 8 * a + 4 * hh + e > qrow)) s_ = -INFINITY; st[rb][i] = s_; } }
            sm_update(st, S, ot);
            pv_tile(ot, lds, buf, st, r, hh);
        }
        if (t + 1 < nt) { tile_store<IS_MLA, !IS_MLA>(R, lds, buf ^ 1, tid); if (t + 2 < nt) tile_load<IS_MLA, !IS_MLA>(R, src, kv0 + 128, tid); }
        __syncthreads();
    }
    const float lt = swap32_sum(S.l);
    store_ot(ot, 1.f / lt, orow, hh);
}

__device__ __forceinline__ void sm_stats(const f32x16 (&st)[2], SmState& S) {
    float mx = -INFINITY;
#pragma unroll
    for (int rb = 0; rb < 2; ++rb)
#pragma unroll
        for (int i = 0; i < 16; ++i) mx = fmaxf(mx, st[rb][i]);
    mx = swap32_max(mx);
    const float mn = fmaxf(S.m, mx); const float msafe = (mn == -INFINITY) ? 0.f : mn; const float alpha = __expf(S.m - msafe);
    float sum = 0.f;
#pragma unroll
    for (int rb = 0; rb < 2; ++rb)
#pragma unroll
        for (int i = 0; i < 16; ++i) sum += __expf(st[rb][i] - msafe);
    S.l = S.l * alpha + sum; S.m = mn;
}
#define FA_STREAM(SRC, NT, TILE_EXPR, BODY) do { TileRegs R_; const int nt_ = (NT); \
    if (nt_ > 0) { { const int idx = 0; tile_load<false, false>(R_, SRC, 64 * (TILE_EXPR), tid); } tile_store<false, false>(R_, lds, 0, tid); \
      if (nt_ > 1) { const int idx = 1; tile_load<false, false>(R_, SRC, 64 * (TILE_EXPR), tid); } \
      __syncthreads(); \
      for (int it_ = 0; it_ < nt_; ++it_) { const int buf = it_ & 1; int tile; { const int idx = it_; tile = (TILE_EXPR); } \
          BODY \
          if (it_ + 1 < nt_) { tile_store<false, false>(R_, lds, buf ^ 1, tid); if (it_ + 2 < nt_) { const int idx = it_ + 2; tile_load<false, false>(R_, SRC, 64 * (TILE_EXPR), tid); } } \
          __syncthreads(); } } } while (0)
#define FA_FOREACH_REG(CODE) _Pragma("unroll") for (int rb = 0; rb < 2; ++rb) _Pragma("unroll") for (int a = 0; a < 4; ++a) _Pragma("unroll") for (int e = 0; e < 4; ++e) { const int i = 4 * a + e; const int kvl = 32 * rb + 8 * a + 4 * hh + e; CODE }

__device__ __forceinline__ void nsa_unit(const Ctx& c, int b, int g, int j) {
    const int tid = c.tid, lane = c.lane, r = lane & 31, hh = lane >> 5, w = c.wave;
    LAS unsigned char* lds = c.lds;
    const int t0 = 64 * j, tl = r >> 2, hp = r & 3, tokl = 8 * w + tl, tq = t0 + tokl, head = 4 * g + hp; const size_t mrow = (size_t)b * T + tq;
    const bf16_t* P1 = WSP(bf16_t, WS_P1);
    bf16x8 qf[4];
#pragma unroll
    for (int ks = 0; ks < 4; ++ks) qf[ks] = *(const bf16x8*)(P1 + mrow * P1W + C_NQ + head * 64 + 16 * ks + 8 * hh);
    const float gc = sigmoidf_(bf2f(P1[mrow * P1W + C_NG + head * 3 + 0])), gsl = sigmoidf_(bf2f(P1[mrow * P1W + C_NG + head * 3 + 1])), gwn = sigmoidf_(bf2f(P1[mrow * P1W + C_NG + head * 3 + 2]));
    const LAS float* lutL = (const LAS float*)(lds + L_LUT) + head * 132;
    LAS float* PS = (LAS float*)(lds + L_PS); LAS float* FM = (LAS float*)(lds + L_F); LAS unsigned* SEL = (LAS unsigned*)(lds + L_SEL); LAS unsigned* UNI = (LAS unsigned*)(lds + L_UNI);
    LAS unsigned char* TL = (LAS unsigned char*)(lds + L_TL); LAS int* TLN = (LAS int*)(lds + L_TLN);
    f32x16 st[2], ot[2], otot[2]; zero_acc(otot);
    for (int i = tid; i < 2 * 64 * 132; i += NTHREADS) PS[i] = 0.f;
    if (tid < 256) SEL[tid] = 0u; if (tid < 4) UNI[tid] = 0u;
    const int n_ok_max = (t0 + 63 >= 31) ? ((t0 + 63 - 31) >> 4) + 1 : 0; const int nct = (n_ok_max + 63) >> 6;
    KVSrc srcc; srcc.K = WSP(bf16_t, WS_KC) + (size_t)(b * 2 + g) * 512 * 64; srcc.kpitch = 64; srcc.K2 = nullptr; srcc.k2pitch = 0; srcc.V = WSP(bf16_t, WS_VC) + (size_t)(b * 2 + g) * 512 * 64; srcc.vpitch = 64; srcc.cum = nullptr;
    SmState Sc{-INFINITY, 0.f};
    FA_STREAM(srcc, nct, idx, {
        qk_tile<4>(st, lds, buf, qf, r, hh);
        FA_FOREACH_REG({ int dist = tq - (16 * (64 * tile + kvl) + 31); float s_ = st[rb][i] * 0.125f + lutL[dist < 0 ? 0 : (dist > 128 ? 128 : dist)]; st[rb][i] = dist < 0 ? -INFINITY : s_; })
        sm_stats(st, Sc); });
    { const float lt = swap32_sum(Sc.l); const float inv = lt > 0.f ? 1.f / lt : 0.f; const float msafe = (Sc.m == -INFINITY) ? 0.f : Sc.m;
      zero_acc(ot);
      FA_STREAM(srcc, nct, idx, {
        qk_tile<4>(st, lds, buf, qf, r, hh);
        FA_FOREACH_REG({ int dist = tq - (16 * (64 * tile + kvl) + 31); float s_ = st[rb][i] * 0.125f + lutL[dist < 0 ? 0 : (dist > 128 ? 128 : dist)]; st[rb][i] = dist < 0 ? 0.f : __expf(s_ - msafe) * inv; })
_Pragma("unroll")
        for (int rb = 0; rb < 2; ++rb)
_Pragma("unroll")
            for (int a = 0; a < 4; ++a) { float q4[4];
_Pragma("unroll")
                for (int e = 0; e < 4; ++e) { float v = st[rb][4 * a + e]; v += dpp_f<0xB1>(v); v += dpp_f<0x4E>(v); q4[e] = v; }
                if (hp == 0) { const int G = 16 * tile + 8 * rb + 2 * a + hh; PS[tokl * 132 + G] = q4[0] + 2.f * (q4[1] + q4[2] + q4[3]); FM[tokl * 132 + G] = q4[0]; } }
        pv_tile(ot, lds, buf, st, r, hh); });
#pragma unroll
      for (int db = 0; db < 2; ++db)
#pragma unroll
          for (int i = 0; i < 16; ++i) otot[db][i] += gc * ot[db][i]; }
    if (j + 1 <= 16) { if (tid < 64) SEL[tid * 4] = (j == 15) ? 0xFFFFu : ((1u << (j + 1)) - 1u); if (tid == 0) UNI[0] = (j == 15) ? 0xFFFFu : ((1u << (j + 1)) - 1u); }
    else {
        for (int i = tid; i < 64 * 128; i += NTHREADS) { const int tk = i >> 7, G = i & 127; if (G >= 1 && G <= j - 2) PS[tk * 132 + G] += FM[tk * 132 + G + 1]; }
        __syncthreads();
        const int tk = tid >> 3, sub = tid & 7; unsigned bits[4] = {0u, 0u, 0u, 0u};
#pragma unroll 1
        for (int k = 0; k < 16; ++k) { const int G = sub + 8 * k;
            if (G >= 1 && G <= j - 2) { const float v = PS[tk * 132 + G]; int cnt = 0;
                for (int G2 = 1; G2 <= j - 2; ++G2) { const float v2 = PS[tk * 132 + G2]; cnt += (v2 > v || (v2 == v && G2 < G)) ? 1 : 0; }
                if (cnt < 13) { if (k < 4) bits[0] |= 1u << G; else if (k < 8) bits[1] |= 1u << (G - 32); else if (k < 12) bits[2] |= 1u << (G - 64); else bits[3] |= 1u << (G - 96); } } }
        if (sub == 0) { bits[0] |= 1u; { const int G = j; if (G < 32) bits[0] |= 1u << G; else if (G < 64) bits[1] |= 1u << (G - 32); else if (G < 96) bits[2] |= 1u << (G - 64); else bits[3] |= 1u << (G - 96); }
                        { const int G = j - 1; if (G < 32) bits[0] |= 1u << G; else if (G < 64) bits[1] |= 1u << (G - 32); else if (G < 96) bits[2] |= 1u << (G - 64); else bits[3] |= 1u << (G - 96); } }
#pragma unroll
        for (int q = 0; q < 4; ++q) if (bits[q]) { atomicOr((unsigned*)(SEL + tk * 4 + q), bits[q]); atomicOr((unsigned*)(UNI + q), bits[q]); }
    }
    __syncthreads();
    if (tid == 0) { int n = 0; for (int q = 0; q < 4; ++q) { unsigned m_ = UNI[q]; while (m_) { const int bpos = __builtin_ctz(m_); m_ &= m_ - 1u; TL[n++] = (unsigned char)(32 * q + bpos); } } TLN[0] = n; }
    __syncthreads();
    const unsigned msk0 = SEL[tokl * 4 + 0], msk1 = SEL[tokl * 4 + 1], msk2 = SEL[tokl * 4 + 2], msk3 = SEL[tokl * 4 + 3];
    const int nsel = __builtin_amdgcn_readfirstlane(TLN[0]);
    const float bfar = lutL[128];
    { KVSrc srcs; srcs.K = P1 + (size_t)b * T * P1W + C_NKV + ((1 * 2 + 0) * 2 + g) * 64; srcs.kpitch = P1W; srcs.K2 = nullptr; srcs.k2pitch = 0; srcs.V = P1 + (size_t)b * T * P1W + C_NKV + ((1 * 2 + 1) * 2 + g) * 64; srcs.vpitch = P1W; srcs.cum = nullptr;
      SmState Ss{-INFINITY, 0.f}; zero_acc(ot);
      FA_STREAM(srcs, nsel, (int)TL[idx], {
        const int wq = tile >> 5; const unsigned mw = wq == 0 ? msk0 : wq == 1 ? msk1 : wq == 2 ? msk2 : msk3; const bool mine = (mw >> (tile & 31)) & 1u;
        if (__any(mine)) {
            qk_tile<4>(st, lds, buf, qf, r, hh);
            const bool far = (64 * tile + 63 + 128 <= t0 + 8 * w);
            if (far) { FA_FOREACH_REG({ (void)kvl; st[rb][i] = mine ? st[rb][i] * 0.125f + bfar : -INFINITY; }) }
            else { FA_FOREACH_REG({ const int dist = tq - (64 * tile + kvl); const float s_ = st[rb][i] * 0.125f + lutL[dist < 0 ? 0 : (dist > 128 ? 128 : dist)]; st[rb][i] = (mine && dist >= 0) ? s_ : -INFINITY; }) }
            sm_update(st, Ss, ot);
            pv_tile(ot, lds, buf, st, r, hh); } });
      const float lt = swap32_sum(Ss.l); const float sc = lt > 0.f ? gsl / lt : 0.f;
#pragma unroll
      for (int db = 0; db < 2; ++db)
#pragma unroll
          for (int i = 0; i < 16; ++i) otot[db][i] += sc * ot[db][i]; }
    { KVSrc srcw; srcw.K = P1 + (size_t)b * T * P1W + C_NKV + ((2 * 2 + 0) * 2 + g) * 64; srcw.kpitch = P1W; srcw.K2 = nullptr; srcw.k2pitch = 0; srcw.V = P1 + (size_t)b * T * P1W + C_NKV + ((2 * 2 + 1) * 2 + g) * 64; srcw.vpitch = P1W; srcw.cum = nullptr;
      const int jlo = j - 8 > 0 ? j - 8 : 0;
      SmState Sw{-INFINITY, 0.f}; zero_acc(ot);
      FA_STREAM(srcw, j - jlo + 1, jlo + idx, {
        qk_tile<4>(st, lds, buf, qf, r, hh);
        FA_FOREACH_REG({ const int dist = tq - (64 * tile + kvl); const float s_ = st[rb][i] * 0.125f + lutL[dist < 0 ? 0 : (dist > 128 ? 128 : dist)]; st[rb][i] = (dist >= 0 && dist < 512) ? s_ : -INFINITY; })
        sm_update(st, Sw, ot);
        pv_tile(ot, lds, buf, st, r, hh); });
      const float lt = swap32_sum(Sw.l); const float sc = lt > 0.f ? gwn / lt : 0.f;
#pragma unroll
      for (int db = 0; db < 2; ++db)
#pragma unroll
          for (int i = 0; i < 16; ++i) otot[db][i] += sc * ot[db][i]; }
    store_ot(otot, 1.f, WSP(bf16_t, WS_OUTA) + mrow * 512 + head * 64, hh);
}
}

__device__ __forceinline__ int next_unit(const Ctx& c, unsigned* ctr) {
    LAS int* u = (LAS int*)(c.lds + fa::L_UNIT);
    __syncthreads();
    if (c.tid == 0) u[0] = (int)__hip_atomic_fetch_add(ctr, 1u, __ATOMIC_RELAXED, __HIP_MEMORY_SCOPE_AGENT);
    __syncthreads();
    return __builtin_amdgcn_readfirstlane(u[0]);
}
__device__ __forceinline__ void phase_att_fast(const Ctx& c0, int l) {
    Ctx c = c0;
    unsigned* ctr = WSP(unsigned, WS_CTL) + CW_QUEUE + 64 * l;
    { const float* lut = WSP(float, WS_TAB) + 512; LAS float* L_ = (LAS float*)(c.lds + fa::L_LUT); for (int i = c.tid; i < 8 * 132; i += NTHREADS) L_[i] = lut[i]; }
    for (;;) {
        const int u = next_unit(c, ctr);
        if (u >= 32 * 48) break;
        relaunder(c);
        const int lv = 31 - u / 48, k = u % 48, kind = k >> 4, id = k & 15;
        if (kind == 0) { if (ATT_FAST_MLA) fa::dense_unit<true>(c, id >> 3, id & 7, lv); }
        else if (kind == 1) { if (ATT_FAST_NSA) fa::nsa_unit(c, (id >> 1) & 1, id & 1, 4 * lv + 3 - (id >> 2)); }
        else { if (ATT_FAST_FOX) fa::dense_unit<false>(c, id >> 3, id & 7, lv); }
    }
}

struct Args { const void* in[32]; float* out; unsigned char* ws; int l_lo, l_hi; };
constexpr int PH_PER_LAYER = 15, K_FINAL = 1 + PH_PER_LAYER;
template <int KIND>
__global__ void __launch_bounds__(NTHREADS, 2) fwd_kernel(Args a) {
    extern __shared__ __attribute__((aligned(16))) unsigned char lds_raw[];
    Ctx c;
    c.out = a.out; c.ws = a.ws; c.lds = (LAS unsigned char*)lds_raw;
    c.tid = threadIdx.x; c.lane = c.tid & 63; c.wave = __builtin_amdgcn_readfirstlane(c.tid >> 6); c.G = gridDim.x; c.bid = blockIdx.x;
    if (c.tid < 4) ((LAS unsigned*)(c.lds + LDS_MISC))[c.tid] = 0u;
    if (c.tid < 32) { const unsigned long long pv = (unsigned long long)a.in[c.tid]; ((LAS unsigned*)(c.lds + LDS_INTAB))[2 * c.tid] = (unsigned)pv; ((LAS unsigned*)(c.lds + LDS_INTAB))[2 * c.tid + 1] = (unsigned)(pv >> 32); }
    __syncthreads();
    XcdBarrier bar; bar.bar = WSP(unsigned, WS_CTL) + CW_BAR; bar.x = 0; bar.st = nullptr;
    if constexpr (KIND < 0) bar = xcd_barrier_post(WSP(unsigned, WS_CTL) + CW_BAR, (volatile LAS unsigned*)(c.lds + LDS_MISC));
#define IN(k) ((KIND < 0 || KIND == (k)) && (relaunder(c), true))
#define SEAM(k) do { if constexpr (KIND < 0) { unsigned* bb_ = bar.bar; asm volatile("" : "+s"(bb_)); bar.bar = bb_; xcd_barrier(bar); } } while (0)
    LAS unsigned char* ring = c.lds;

    if (IN(0)) { phase_prologue(c); } SEAM(0);
    for (int l = a.l_lo; l < a.l_hi; ++l) {
        constexpr int pb = 1;
        const float* resid = (l == 0) ? c.x() : WSP(float, WS_XA);
        if (IN(pb + 0)) { if (l == 0) phase_norm(c, c.x(), nullptr, nullptr, nullptr, WSP(bf16_t, WS_H0));
                          else phase_norm(c, WSP(float, WS_XA), WSP(bf16_t, WS_Y), WSP(bf16_t, WS_Y) + (size_t)M * D, WSP(float, WS_XA), WSP(bf16_t, WS_H0)); } SEAM(pb + 0);
        if (IN(pb + 1)) { pg8::Cfg g{(unsigned)(D * 2), 128u, (unsigned)(D * 2), D / 64, nullptr}; pg8::DenseOrder S; S.init(M / 256, P1W / 256, c.G, c.bid, WSP(bf16_t, WS_H0), (size_t)256 * D * 2, WSP(bf16_t, WS_WINT) + (size_t)l * P1W * D, (size_t)256 * D * 2);
            EpiStoreBf16 E{WSP(bf16_t, WS_P1), P1W, nullptr, 0}; pg8::gemm_phase<false>(ring, c.wave, g, S, E); } SEAM(pb + 1);
        if (IN(pb + 2)) { phase_prep(c, l); } SEAM(pb + 2);
        if (IN(pb + 3)) { phase_cum(c); } SEAM(pb + 3);
        if (IN(pb + 4)) {
            { pg8::Cfg g{(unsigned)(P1W * 2), 128u, 512u, 4, nullptr}; pg8::DenseOrder S; S.init(M / 256, 3, c.G, c.bid, WSP(bf16_t, WS_P1) + C_CQ, (size_t)256 * P1W * 2, WSP(bf16_t, WS_WUQT) + (size_t)l * 768 * 256, (size_t)256 * 512);
              EpiStoreBf16 E{WSP(bf16_t, WS_QB), 768, WSP(float, WS_RSTD), 2}; pg8::gemm_phase<false>(ring, c.wave, g, S, E); }
            { pg8::Cfg g{(unsigned)(P1W * 2), 128u, 256u, 2, nullptr}; pg8::DenseOrder S; S.init(M / 256, 4, c.G, c.bid, WSP(bf16_t, WS_P1) + C_CKV, (size_t)256 * P1W * 2, WSP(bf16_t, WS_WUKVT) + (size_t)l * 1024 * 128, (size_t)256 * 256);
              EpiStoreBf16 E{WSP(bf16_t, WS_KVB), 1024, WSP(float, WS_RSTD) + 1, 2}; pg8::gemm_phase<false>(ring, c.wave, g, S, E); }
            { pg8::Cfg g{(unsigned)(16 * P1W * 2), (unsigned)(P1W * 2), 4096u, 32, nullptr}; CmpOrder S{c.G, (c.bid + 64) % c.G, (const char*)WSP(bf16_t, WS_P1), (const char*)(WSP(bf16_t, WS_WC1T) + (size_t)l * 2 * 256 * 2048)};
              EpiCmp1 E{WSP(bf16_t, WS_HC), WSP(float, WS_TAB) + l * 256}; pg8::gemm_phase<false>(ring, c.wave, g, S, E); }
        } SEAM(pb + 4);
        if (IN(pb + 5)) { phase_cmp2_ropeq(c, l); } SEAM(pb + 5);
        if (IN(pb + 6)) { phase_att_fast(c, l); if (!ATT_FAST_NSA) phase_att_nsa_naive(c); if (!ATT_FAST_MLA) phase_att_mla_naive(c); if (!ATT_FAST_FOX) phase_att_fox_naive(c); } SEAM(pb + 6);
        if (IN(pb + 7)) { phase_norm(c, resid, nullptr, nullptr, nullptr, WSP(bf16_t, WS_HG)); } SEAM(pb + 7);
        if (IN(pb + 8)) { pg8::Cfg g{(unsigned)(D * 2), 128u, (unsigned)(D * 2), D / 64, nullptr}; pg8::DenseOrder S; S.init(M / 256, 12, c.G, c.bid, WSP(bf16_t, WS_HG), (size_t)256 * D * 2, WSP(bf16_t, WS_WMT) + (size_t)l * 3072 * D, (size_t)256 * D * 2);
            EpiGates E{WSP(bf16_t, WS_GATES), c.b_merge() + l * 3072}; pg8::gemm_phase<false>(ring, c.wave, g, S, E); } SEAM(pb + 8);
        if (IN(pb + 9)) {
#pragma unroll 1
            for (int br = 0; br < 3; ++br) { pg8::Cfg g{1024u, 128u, 1024u, 8, nullptr}; pg8::DenseOrder S;
                S.init(M / 256, 4, c.G, c.bid, WSP(bf16_t, br == 0 ? WS_OUTA : br == 1 ? WS_OUTB : WS_OUTC), (size_t)256 * 1024, WSP(bf16_t, WS_WOT) + ((size_t)l * 3 + br) * 1024 * 512, (size_t)256 * 1024);
                EpiOutproj E{WSP(bf16_t, WS_MIXED), WSP(bf16_t, WS_GATES), br}; pg8::gemm_phase<false>(ring, c.wave, g, S, E); }
        } SEAM(pb + 9);
        if (IN(pb + 10)) { pg8::Cfg g{(unsigned)(D * 2), 128u, (unsigned)(D * 2), D / 64, nullptr}; pg8::DenseOrder S; S.init(M / 256, 4, c.G, c.bid, WSP(bf16_t, WS_MIXED), (size_t)256 * D * 2, WSP(bf16_t, WS_WOUTT) + (size_t)l * D * D, (size_t)256 * D * 2);
            EpiWout E{resid, WSP(float, WS_XA)}; pg8::gemm_phase<false>(ring, c.wave, g, S, E); } SEAM(pb + 10);
        if (IN(pb + 11)) { phase_router(c, l); } SEAM(pb + 11);
        if (IN(pb + 12)) { phase_place(c, l); } SEAM(pb + 12);
        if (IN(pb + 13)) { LAS int* tab = (LAS int*)(c.lds + LDS_MOETAB); moe_tables(c, l, tab);
            pg8::Cfg g{(unsigned)(D * 2), 128u, (unsigned)(D * 2), D / 64, WSP(int, WS_LTOK)}; MoeOrder S{c.G, c.bid, 2, tab, (const char*)WSP(bf16_t, WS_H2), 0, (const char*)WSP(bf16_t, WS_WGU), (size_t)512 * D * 2, (size_t)256 * D * 2};
            EpiMoe1 E{WSP(bf16_t, WS_HID), WSP(float, WS_LW)}; pg8::gemm_phase<true>(ring, c.wave, g, S, E); } SEAM(pb + 13);
        if (IN(pb + 14)) { LAS int* tab = (LAS int*)(c.lds + LDS_MOETAB); moe_tables(c, l, tab);
            pg8::Cfg g{512u, 128u, 512u, 4, nullptr}; MoeOrder S{c.G, c.bid, 4, tab, (const char*)WSP(bf16_t, WS_HID), 512, (const char*)WSP(bf16_t, WS_WDT), (size_t)D * 256 * 2, (size_t)256 * 256 * 2};
            EpiMoe2 E{WSP(bf16_t, WS_Y), WSP(unsigned, WS_LSLOT)}; pg8::gemm_phase<false>(ring, c.wave, g, S, E); } SEAM(pb + 14);
    }
    if (IN(K_FINAL)) { phase_final(c); }
#undef IN
#undef SEAM
}

template <int KIND> static bool prep_kernel() { return hipFuncSetAttribute((const void*)fwd_kernel<KIND>, hipFuncAttributeMaxDynamicSharedMemorySize, LDS_BYTES) == hipSuccess; }
template <int KIND> static void launch_kind(int grid, hipStream_t stream, Args a, int l) { a.l_lo = l; a.l_hi = l + 1; hipLaunchKernelGGL(fwd_kernel<KIND>, dim3(grid), dim3(NTHREADS), LDS_BYTES, stream, a); }
extern "C" void kernel_launch(void* const* d_in, const int* in_sizes, int n_in, void* d_out, int out_size, void* d_ws, size_t ws_size, hipStream_t stream) {
    static int grid = 0;
    if (grid == 0) {
        if (n_in != 32 || ws_size < WS_END) { fprintf(stderr, "kernel_launch: n_in %d ws %zu (need %zu)\n", n_in, ws_size, (size_t)WS_END); grid = -1; return; }
        int dev = 0, cus = 0;
        if (hipGetDevice(&dev) != hipSuccess || hipDeviceGetAttribute(&cus, hipDeviceAttributeMultiprocessorCount, dev) != hipSuccess) { grid = -1; return; }
        bool ok = true;
#if MK_ONE_LAUNCH
        ok = prep_kernel<-1>();
#else
        ok = prep_kernel<0>() && prep_kernel<1>() && prep_kernel<2>() && prep_kernel<3>() && prep_kernel<4>() && prep_kernel<5>() && prep_kernel<6>() && prep_kernel<7>() && prep_kernel<8>() && prep_kernel<9>()
          && prep_kernel<10>() && prep_kernel<11>() && prep_kernel<12>() && prep_kernel<13>() && prep_kernel<14>() && prep_kernel<15>() && prep_kernel<16>();
#endif
        if (!ok) { grid = -1; return; }
        (void)hipGetLastError();
        grid = cus;
    }
    if (grid < 0) return;
    (void)hipMemsetAsync((char*)d_ws + WS_CTL, 0, CTL_BYTES, stream);
    Args a{};
    for (int i = 0; i < 32; ++i) a.in[i] = d_in[i];
    a.out = (float*)d_out; a.ws = (unsigned char*)d_ws;
#if MK_ONE_LAUNCH
    a.l_lo = 0; a.l_hi = NL;
    hipLaunchKernelGGL(fwd_kernel<-1>, dim3(grid), dim3(NTHREADS), LDS_BYTES, stream, a);
#else
    launch_kind<0>(grid, stream, a, 0);
    for (int l = 0; l < NL; ++l) {
        launch_kind<1>(grid, stream, a, l); launch_kind<2>(grid, stream, a, l); launch_kind<3>(grid, stream, a, l); launch_kind<4>(grid, stream, a, l); launch_kind<5>(grid, stream, a, l);
        launch_kind<6>(grid, stream, a, l); launch_kind<7>(grid, stream, a, l); launch_kind<8>(grid, stream, a, l); launch_kind<9>(grid, stream, a, l); launch_kind<10>(grid, stream, a, l);
        launch_kind<11>(grid, stream, a, l); launch_kind<12>(grid, stream, a, l); launch_kind<13>(grid, stream, a, l); launch_kind<14>(grid, stream, a, l); launch_kind<15>(grid, stream, a, l);
    }
    launch_kind<16>(grid, stream, a, 0);
#endif
}
```

```cpp
#include <hip/hip_runtime.h>
#include <stdint.h>
#include <cstdio>

#ifndef MK_ONE_LAUNCH
#define MK_ONE_LAUNCH 1
#endif

#define LAS __attribute__((address_space(3)))
typedef unsigned short bf16_t;
typedef short bf16x8 __attribute__((ext_vector_type(8)));
typedef float f32x4 __attribute__((ext_vector_type(4)));
typedef float f32x16 __attribute__((ext_vector_type(16)));
typedef unsigned u32x4 __attribute__((ext_vector_type(4)));
typedef unsigned u32x2 __attribute__((ext_vector_type(2)));

constexpr int NB = 2, T = 8192, D = 1024, M = NB * T, NL = 2;
constexpr int DIN = 6336;
constexpr int P1W = 3328;
constexpr int C_NQ = 0, C_NKV = 512, C_CQ = 1280, C_CKV = 1536, C_KR = 1664, C_NG = 1696, C_FF = 1720, C_FQKV = 1728;
constexpr int NEXP = 32, EDIM = 256;
constexpr float EPS = 1e-6f;
constexpr float LOG2E = 1.4426950408889634f;
constexpr float QSCALE64 = 0.125f * LOG2E, QSCALE96 = 0.10206207261596575f * LOG2E;
constexpr int NTHREADS = 512, NWAVES = 8;
constexpr int LDS_BYTES = 147456;
constexpr int MOE_MAXROWS = 40960;

constexpr size_t MiB = 1u << 20;
constexpr size_t WS_CTL = 0;
constexpr size_t CTL_BYTES = 1 * MiB;
constexpr int CW_BAR = 4096;
constexpr int CW_QUEUE = 16384;
constexpr int CW_MOECNT = 32768;
constexpr size_t CTL_LTOK = 512 * 1024;
constexpr size_t WS_WINT = 1 * MiB;
constexpr size_t WS_WMT = 14 * MiB;
constexpr size_t WS_WUQT = 26 * MiB;
constexpr size_t WS_WUKVT = 27 * MiB;
constexpr size_t WS_WOT = 28 * MiB;
constexpr size_t WS_WOUTT = 34 * MiB;
constexpr size_t WS_WC1T = 38 * MiB;
constexpr size_t WS_ROPE = 42 * MiB;
constexpr size_t WS_TAB = 44 * MiB;
constexpr size_t WS_XA = 45 * MiB;
constexpr size_t PB = 109 * MiB;
constexpr size_t WS_P1 = PB;
constexpr size_t WS_QB = PB + 104 * MiB;
constexpr size_t WS_KVB = PB + 128 * MiB;
constexpr size_t WS_OUTA = PB + 160 * MiB;
constexpr size_t WS_OUTB = PB + 176 * MiB;
constexpr size_t WS_OUTC = PB + 192 * MiB;
constexpr size_t WS_H0 = PB + 176 * MiB;
constexpr size_t WS_SM = PB + 208 * MiB;
constexpr size_t WS_RSTD = WS_SM;
constexpr size_t WS_KR = WS_SM + 256 * 1024;
constexpr size_t WS_LF = WS_SM + 1280 * 1024;
constexpr size_t WS_CUM = WS_SM + 1792 * 1024;
constexpr size_t WS_HC = WS_SM + 2304 * 1024;
constexpr size_t WS_KC = WS_SM + 3328 * 1024;
constexpr size_t WS_VC = WS_SM + 3584 * 1024;
constexpr size_t WS_REC = WS_SM + 3840 * 1024;
constexpr size_t WS_LTOK = WS_SM + 4352 * 1024;
constexpr size_t WS_LW = WS_SM + 4608 * 1024;
constexpr size_t WS_LSLOT = WS_SM + 4864 * 1024;
constexpr size_t WS_END = PB + 216 * MiB;
constexpr size_t WS_HG = PB;
constexpr size_t WS_GATES = PB + 32 * MiB;
constexpr size_t WS_MIXED = PB + 128 * MiB;
constexpr size_t WS_H2 = PB;
constexpr size_t WS_WGU = PB + 32 * MiB;
constexpr size_t WS_WDT = PB + 64 * MiB;
constexpr size_t WS_HID = PB + 80 * MiB;
constexpr size_t WS_Y = PB + 100 * MiB;
static_assert(WS_Y + 64 * MiB <= WS_H0, "Y must not overlap H0");
static_assert(WS_END <= 332 * MiB, "workspace budget");

__device__ __forceinline__ float bf2f(bf16_t v) { return __uint_as_float((unsigned)v << 16); }
__device__ __forceinline__ unsigned f2bf(float f) { unsigned u = __float_as_uint(f); return (u + 0x7fffu + ((u >> 16) & 1u)) >> 16; }
__device__ __forceinline__ unsigned pk2(float lo, float hi) { return f2bf(lo) | (f2bf(hi) << 16); }
template <int CTRL> __device__ __forceinline__ float dpp_f(float v) { return __int_as_float(__builtin_amdgcn_update_dpp(0, __float_as_int(v), CTRL, 0xf, 0xf, true)); }
__device__ __forceinline__ float wave_sum(float v) {
    v += dpp_f<0xB1>(v); v += dpp_f<0x4E>(v); v += dpp_f<0x141>(v); v += dpp_f<0x140>(v);
    const float a = __int_as_float(__builtin_amdgcn_readlane(__float_as_int(v), 0)), b = __int_as_float(__builtin_amdgcn_readlane(__float_as_int(v), 16));
    const float c2 = __int_as_float(__builtin_amdgcn_readlane(__float_as_int(v), 32)), d = __int_as_float(__builtin_amdgcn_readlane(__float_as_int(v), 48));
    return (a + b) + (c2 + d);
}
__device__ __forceinline__ float wave_max(float v) {
    v = fmaxf(v, dpp_f<0xB1>(v)); v = fmaxf(v, dpp_f<0x4E>(v)); v = fmaxf(v, dpp_f<0x141>(v)); v = fmaxf(v, dpp_f<0x140>(v));
    const float a = __int_as_float(__builtin_amdgcn_readlane(__float_as_int(v), 0)), b = __int_as_float(__builtin_amdgcn_readlane(__float_as_int(v), 16));
    const float c2 = __int_as_float(__builtin_amdgcn_readlane(__float_as_int(v), 32)), d = __int_as_float(__builtin_amdgcn_readlane(__float_as_int(v), 48));
    return fmaxf(fmaxf(a, b), fmaxf(c2, d));
}
__device__ __forceinline__ float sigmoidf_(float x) { return 1.f / (1.f + __expf(-x)); }
__device__ __forceinline__ float gelu_tanh(float x) { const float u = 0.7978845608028654f * (x + 0.044715f * x * x * x); const float th = 1.f - 2.f / (1.f + __expf(2.f * u)); return 0.5f * x * (1.f + th); }
#define LDS_WAIT() asm volatile("s_waitcnt lgkmcnt(0)" ::: "memory")

#define XB_TMO      128
#define XB_XCNT(j)  (256  + 64 * (j))
#define XB_XSUB(j)  (1280 + 64 * (j))
#define XB_XGEN(j)  (2304 + 64 * (j))
#define XB_TOP      3328
#define XB_TOPGEN   3392
#define XCD_BAR_WORDS 3456
#define XB_SPIN_CAP (1u << 18)

__device__ __forceinline__ unsigned xb_ld(unsigned* p)              { return __hip_atomic_load(p, __ATOMIC_RELAXED, __HIP_MEMORY_SCOPE_AGENT); }
__device__ __forceinline__ unsigned xb_add(unsigned* p, unsigned v) { return __hip_atomic_fetch_add(p, v, __ATOMIC_RELAXED, __HIP_MEMORY_SCOPE_AGENT); }
__device__ __forceinline__ unsigned xb_xcc_id() { return (unsigned)__builtin_amdgcn_s_getreg((3 << 11) | 20) & 0xFu; }
#define XB_SPIN(cond, bar) do { unsigned _sp = 0; while (cond) { __builtin_amdgcn_s_sleep(1); \
    if ((++_sp & 255u) == 0u) { if (xb_ld(&(bar)[XB_TMO])) break; if (_sp > XB_SPIN_CAP) { atomicAdd(&(bar)[XB_TMO], 1u); break; } } } } while (0)

struct XcdBarrier { unsigned* bar; unsigned x; volatile LAS unsigned* st; };

__device__ __forceinline__ XcdBarrier xcd_barrier_post(unsigned* bar, volatile LAS unsigned* st) {
    XcdBarrier b; b.bar = bar; b.x = xb_xcc_id(); b.st = st;
    if (threadIdx.x == 0) (void)xb_add(&bar[XB_XCNT(b.x)], 1u);
    return b;
}
__device__ __forceinline__ void xcd_barrier_complete(unsigned* bar, unsigned x, unsigned& nloc, unsigned& nx) {
    const unsigned G = gridDim.x * gridDim.y * gridDim.z;
    unsigned sum, cnt, mine, sp = 0u;
    for (;;) {
        sum = 0u; cnt = 0u; mine = 0u;
#pragma unroll
        for (unsigned j = 0; j < 16; ++j) { const unsigned c = xb_ld(&bar[XB_XCNT(j)]); sum += c; cnt += (c > 0u) ? 1u : 0u; mine = (j == x) ? c : mine; }
        if (sum == G) break;
        __builtin_amdgcn_s_sleep(1);
        if ((++sp & 255u) == 0u) { if (xb_ld(&bar[XB_TMO])) break; if (sp > XB_SPIN_CAP) { atomicAdd(&bar[XB_TMO], 1u); break; } }
    }
    nloc = mine > 0u ? mine : 1u; nx = cnt > 0u ? cnt : 1u;
}
__device__ __forceinline__ void xcd_barrier(const XcdBarrier& b) {
    asm volatile("s_waitcnt vmcnt(0)" ::: "memory");
    __syncthreads();
    if (threadIdx.x == 0) {
        unsigned* bar = b.bar;
        __builtin_amdgcn_s_waitcnt(0);
        unsigned nloc = b.st[0], nx = b.st[1];
        if (nloc == 0u) { xcd_barrier_complete(bar, b.x, nloc, nx); b.st[0] = nloc; b.st[1] = nx; }
        const unsigned old = xb_add(&bar[XB_XSUB(b.x)], 1u);
        const unsigned gen = old / nloc;
        if (old + 1u == (gen + 1u) * nloc) {
            __builtin_amdgcn_fence(__ATOMIC_RELEASE, "agent");
            asm volatile("s_waitcnt vmcnt(0)" ::: "memory");
            const unsigned og = xb_add(&bar[XB_TOP], 1u);
            const unsigned tg = og / nx;
            if (og + 1u == (tg + 1u) * nx) xb_add(&bar[XB_TOPGEN], 1u);
            else XB_SPIN(xb_ld(&bar[XB_TOPGEN]) == tg, bar);
            __builtin_amdgcn_fence(__ATOMIC_ACQUIRE, "agent");
            xb_add(&bar[XB_XGEN(b.x)], 1u);
            asm volatile("s_waitcnt vmcnt(0)" ::: "memory");
        } else {
            XB_SPIN(xb_ld(&bar[XB_XGEN(b.x)]) == gen, bar);
            __builtin_amdgcn_fence(__ATOMIC_ACQUIRE, "agent");
            asm volatile("s_waitcnt vmcnt(0)" ::: "memory");
        }
    }
    __syncthreads();
}

namespace pg8 {
constexpr int BM = 256, BK = 64, HALF = 128, HTB = HALF * BK * 2, STAGE_BYTES = 8 * HTB;
__host__ __device__ __forceinline__ int lds_byte(int r, int c) { const int st = (r >> 4) * 2 + (c >> 5), rr = r & 15, cc = c & 31, ob = rr * 64 + cc * 2; return st * 1024 + (ob ^ (((ob >> 9) & 1) << 5)); }
__host__ __device__ __forceinline__ void stage_rc(int b, int& R, int& C) { const int st = b / 1024, sb = b % 1024, swz = sb ^ (((sb >> 9) & 1) << 5); R = (st >> 1) * 16 + swz / 64; C = (st & 1) * 32 + (swz % 64) / 2; }

struct Unit { int pm, pn; const char* A; const char* B; int aux; };
struct Cfg { unsigned lda; unsigned kstepA; unsigned ldb; int nt; const int* rowidx; };

struct DenseOrder {
    int nM, nN, nwg, G, c; const char* A; const char* B; size_t tstepA, tstepB;
    __device__ void init(int nM_, int nN_, int G_, int c_, const void* A_, size_t tstepA_, const void* B_, size_t tstepB_) { nM = nM_; nN = nN_; nwg = nM * nN; G = G_; c = c_; A = (const char*)A_; B = (const char*)B_; tstepA = tstepA_; tstepB = tstepB_; }
    __device__ bool next(int i, Unit& u) const {
        const long Lq = (long)i * G + c; if (Lq >= nwg) return false;
        int wgid = (int)Lq; { const int q = nwg / 8, r = nwg % 8, xcd = wgid % 8, off = wgid / 8; wgid = (xcd < r ? xcd * (q + 1) : r * (q + 1) + (xcd - r) * q) + off; }
        const int nig = 8 * nN, gid = wgid / nig, fm = gid * 8, gsz = (nM - fm) < 8 ? (nM - fm) : 8;
        u.pm = fm + ((wgid % nig) % gsz); u.pn = (wgid % nig) / gsz; u.A = A + (size_t)u.pm * tstepA; u.B = B + (size_t)u.pn * tstepB; u.aux = 0; return true;
    }
};

#define PG8_EPI_ROWCOL(row, col) const int row = u.pm * 256 + ai * 128 + wr * 64 + m * 16 + fr; const int col = u.pn * 256 + bj * 128 + wc * 32 + n * 16 + fq * 4;

template <bool INDEXED, class Epi, class Sched>
__device__ __forceinline__ void gemm_phase(LAS unsigned char* lds, int wid, const Cfg g, const Sched& S, const Epi& E) {
    int lane_; asm volatile("v_mbcnt_lo_u32_b32 %0, -1, 0\n\tv_mbcnt_hi_u32_b32 %0, -1, %0" : "=v"(lane_));
    const int lane = lane_, tid = wid * 64 + lane, wr = wid >> 2, wc = wid & 3, fr = lane & 15, fq = lane >> 4;
    const int nt = g.nt;
    int Rs[2], Cs[2]; unsigned voffB[2];
#pragma unroll
    for (int i = 0; i < 2; ++i) { stage_rc(tid * 16 + i * 8192, Rs[i], Cs[i]); voffB[i] = (unsigned)Rs[i] * g.ldb + (unsigned)Cs[i] * 2u; }
    const size_t kstepA = g.kstepA, kstepB = (size_t)(BK * 2);
    const size_t hstepB = (size_t)HALF * g.ldb;
    const unsigned ldsw = (unsigned)wid * 1024u;
    const int aoff = lds_byte(wr * 64 + fr, fq * 8), boff = lds_byte(wc * 32 + fr, fq * 8);
#define PG8_SA(b, h) (((b) * 2 + (h)) * HTB)
#define PG8_SB(b, h) ((4 + (b) * 2 + (h)) * HTB)
#define PG8_STAGE2(bufoff, gbase, v0, v1) do { const char* gb_ = (const char*)(gbase); asm volatile("" : "+s"(gb_)); \
        __builtin_amdgcn_global_load_lds((const unsigned*)(gb_ + (v0)), (LAS unsigned*)(lds + (bufoff) + ldsw), 16, 0, 0); \
        __builtin_amdgcn_global_load_lds((const unsigned*)(gb_ + (v1)), (LAS unsigned*)(lds + (bufoff) + ldsw + 8192), 16, 0, 0); } while (0)
#define PG8_STAGEB(bufoff, gbase) PG8_STAGE2(bufoff, gbase, voffB[0], voffB[1])
#define PG8_LDA(dst, b, h) do { _Pragma("unroll") for (int m = 0; m < 4; ++m) _Pragma("unroll") for (int k = 0; k < 2; ++k) dst[m][k] = *(const LAS bf16x8*)(lds + PG8_SA(b, h) + aoff + m * 2048 + k * 1024); } while (0)
#define PG8_LDB(dst, b, h) do { _Pragma("unroll") for (int n = 0; n < 2; ++n) _Pragma("unroll") for (int k = 0; k < 2; ++k) dst[n][k] = *(const LAS bf16x8*)(lds + PG8_SB(b, h) + boff + n * 2048 + k * 1024); } while (0)
#define PG8_MMA(ai, bj, At, Bt) do { __builtin_amdgcn_s_setprio(1); _Pragma("unroll") for (int m = 0; m < 4; ++m) _Pragma("unroll") for (int n = 0; n < 2; ++n) _Pragma("unroll") for (int k = 0; k < 2; ++k) \
        acc[ai][bj][m][n] = __builtin_amdgcn_mfma_f32_16x16x32_bf16(Bt[n][k], At[m][k], acc[ai][bj][m][n], 0, 0, 0); __builtin_amdgcn_s_setprio(0); } while (0)
#define PG8_WAIT_V(n) asm volatile("s_waitcnt vmcnt(" #n ")" ::: "memory")
#define PG8_WAIT_L(n) asm volatile("s_waitcnt lgkmcnt(" #n ")" ::: "memory")
#define PG8_BAR __builtin_amdgcn_s_barrier()
#define PG8_SCHED __builtin_amdgcn_sched_barrier(0)
    Unit cur, nxt; int ui = 0;
    if (!S.next(0, cur)) return;
    unsigned vAc[2][2], vAn[2][2];
#define PG8_SETVA(v, U) do { _Pragma("unroll") for (int h_ = 0; h_ < 2; ++h_) _Pragma("unroll") for (int i_ = 0; i_ < 2; ++i_) { \
        if constexpr (INDEXED) { const int r_ = g.rowidx[(U).aux + h_ * HALF + Rs[i_]]; v[h_][i_] = (unsigned)r_ * g.lda + (unsigned)Cs[i_] * 2u; } \
        else v[h_][i_] = (unsigned)(h_ * HALF + Rs[i_]) * g.lda + (unsigned)Cs[i_] * 2u; } } while (0)
    PG8_SETVA(vAc, cur);
    f32x4 acc[2][2][4][2];
#pragma unroll
    for (int a = 0; a < 2; ++a)
#pragma unroll
        for (int b = 0; b < 2; ++b)
#pragma unroll
            for (int m = 0; m < 4; ++m)
#pragma unroll
                for (int n = 0; n < 2; ++n) acc[a][b][m][n] = (f32x4){0.f, 0.f, 0.f, 0.f};
    bf16x8 At[4][2], B0[2][2], B1[2][2];
    const char* cA = cur.A; const char* cB = cur.B;
    PG8_STAGEB(PG8_SB(0, 0), cB); PG8_STAGEB(PG8_SB(0, 1), cB + hstepB); PG8_STAGE2(PG8_SA(0, 0), cA, vAc[0][0], vAc[0][1]); PG8_STAGE2(PG8_SA(0, 1), cA, vAc[1][0], vAc[1][1]);
    if (wr == 1) PG8_BAR;
    PG8_WAIT_V(2); PG8_BAR;
    PG8_STAGEB(PG8_SB(1, 0), cB + kstepB); PG8_STAGE2(PG8_SA(1, 0), cA + kstepA, vAc[0][0], vAc[0][1]); PG8_STAGEB(PG8_SB(1, 1), cB + hstepB + kstepB);
    PG8_WAIT_V(6); PG8_BAR;
    for (;;) {
        const bool has_next = S.next(ui + 1, nxt);
        const char* nA = has_next ? nxt.A : cA; const char* nB = has_next ? nxt.B : cB;
        if (has_next) { PG8_SETVA(vAn, nxt); } else {
#pragma unroll
            for (int h_ = 0; h_ < 2; ++h_)
#pragma unroll
                for (int i_ = 0; i_ < 2; ++i_) vAn[h_][i_] = vAc[h_][i_]; }
        for (int t = 0; t < nt; t += 2) {
            const bool last = (t == nt - 2);
            const char* a1 = cA + (size_t)(t + 1) * kstepA;
            const char* a2 = last ? nA : cA + (size_t)(t + 2) * kstepA; const char* b2 = last ? nB : cB + (size_t)(t + 2) * kstepB;
            const char* a3 = a2 + kstepA; const char* b3 = b2 + kstepB;
            const unsigned w00 = last ? vAn[0][0] : vAc[0][0], w01 = last ? vAn[0][1] : vAc[0][1], w10 = last ? vAn[1][0] : vAc[1][0], w11 = last ? vAn[1][1] : vAc[1][1];
            PG8_LDB(B0, 0, 0); PG8_LDB(B1, 0, 1); PG8_SCHED; PG8_LDA(At, 0, 0); PG8_STAGE2(PG8_SA(1, 1), a1, vAc[1][0], vAc[1][1]);
            PG8_WAIT_V(8); PG8_WAIT_L(0); PG8_BAR; PG8_MMA(0, 0, At, B0); PG8_MMA(0, 1, At, B1); PG8_BAR; PG8_SCHED;
            PG8_LDA(At, 0, 1); PG8_STAGEB(PG8_SB(0, 0), b2); PG8_STAGEB(PG8_SB(0, 1), b2 + hstepB); PG8_STAGE2(PG8_SA(0, 0), a2, w00, w01);
            PG8_WAIT_V(8); PG8_WAIT_L(0); PG8_BAR; PG8_MMA(1, 0, At, B0); PG8_MMA(1, 1, At, B1); PG8_BAR; PG8_SCHED;
            PG8_LDB(B0, 1, 0); PG8_LDB(B1, 1, 1); PG8_SCHED; PG8_LDA(At, 1, 0); PG8_STAGE2(PG8_SA(0, 1), a2, w10, w11);
            PG8_WAIT_V(8); PG8_WAIT_L(0); PG8_BAR; PG8_MMA(0, 0, At, B0); PG8_MMA(0, 1, At, B1); PG8_BAR; PG8_SCHED;
            PG8_LDA(At, 1, 1); PG8_STAGEB(PG8_SB(1, 0), b3); PG8_STAGEB(PG8_SB(1, 1), b3 + hstepB); PG8_STAGE2(PG8_SA(1, 0), a3, w00, w01);
            PG8_WAIT_V(8); PG8_WAIT_L(0); PG8_BAR; PG8_MMA(1, 0, At, B0); PG8_MMA(1, 1, At, B1); PG8_BAR; PG8_SCHED;
        }
        E(acc, cur, wr, wc, fr, fq);
        if (!has_next) break;
#pragma unroll
        for (int a = 0; a < 2; ++a)
#pragma unroll
            for (int b = 0; b < 2; ++b)
#pragma unroll
                for (int m = 0; m < 4; ++m)
#pragma unroll
                    for (int n = 0; n < 2; ++n) acc[a][b][m][n] = (f32x4){0.f, 0.f, 0.f, 0.f};
        cur = nxt; cA = nA; cB = nB; ++ui;
#pragma unroll
        for (int h_ = 0; h_ < 2; ++h_)
#pragma unroll
            for (int i_ = 0; i_ < 2; ++i_) vAc[h_][i_] = vAn[h_][i_];
    }
    PG8_WAIT_V(0);
    if (wr == 0) PG8_BAR;
    PG8_BAR;
#undef PG8_SA
#undef PG8_SB
#undef PG8_STAGE2
#undef PG8_STAGEB
#undef PG8_LDA
#undef PG8_LDB
#undef PG8_MMA
#undef PG8_WAIT_V
#undef PG8_WAIT_L
#undef PG8_BAR
#undef PG8_SCHED
#undef PG8_SETVA
}
}

constexpr int LDS_MISC = 131072;
constexpr int LDS_MOETAB = LDS_MISC + 64;
constexpr int LDS_INTAB = LDS_MISC + 512;
struct Ctx {
    float* out; unsigned char* ws;
    LAS unsigned char* lds;
    int tid, lane, wave, G, bid;
    __device__ __forceinline__ const void* inp(int i) const { const LAS unsigned* p = (const LAS unsigned*)(lds + LDS_INTAB) + 2 * i;
        const unsigned lo = (unsigned)__builtin_amdgcn_readfirstlane((int)p[0]), hi = (unsigned)__builtin_amdgcn_readfirstlane((int)p[1]); return (const void*)(((unsigned long long)hi << 32) | lo); }
    __device__ __forceinline__ const float* x() const { return (const float*)inp(0); }
    __device__ __forceinline__ const int* pos() const { return (const int*)inp(1); }
    __device__ __forceinline__ const float* rel_bias() const { return (const float*)inp(2); }
    __device__ __forceinline__ const float* norm_attn() const { return (const float*)inp(3); }
    __device__ __forceinline__ const float* w_in() const { return (const float*)inp(4); }
    __device__ __forceinline__ const float* b_merge() const { return (const float*)inp(5); }
    __device__ __forceinline__ const float* cmp_pe() const { return (const float*)inp(6); }
    __device__ __forceinline__ const float* cmp_k_w1() const { return (const float*)inp(7); }
    __device__ __forceinline__ const float* cmp_k_b1() const { return (const float*)inp(8); }
    __device__ __forceinline__ const float* cmp_k_w2() const { return (const float*)inp(9); }
    __device__ __forceinline__ const float* cmp_v_w1() const { return (const float*)inp(10); }
    __device__ __forceinline__ const float* cmp_v_b1() const { return (const float*)inp(11); }
    __device__ __forceinline__ const float* cmp_v_w2() const { return (const float*)inp(12); }
    __device__ __forceinline__ const float* mla_q_norm() const { return (const float*)inp(13); }
    __device__ __forceinline__ const float* mla_kv_norm() const { return (const float*)inp(14); }
    __device__ __forceinline__ const float* mla_w_uq() const { return (const float*)inp(15); }
    __device__ __forceinline__ const float* mla_w_uk() const { return (const float*)inp(16); }
    __device__ __forceinline__ const float* mla_w_uv() const { return (const float*)inp(17); }
    __device__ __forceinline__ const float* fox_b_f() const { return (const float*)inp(18); }
    __device__ __forceinline__ const float* w_o_nsa() const { return (const float*)inp(19); }
    __device__ __forceinline__ const float* w_o_mla() const { return (const float*)inp(20); }
    __device__ __forceinline__ const float* w_o_fox() const { return (const float*)inp(21); }
    __device__ __forceinline__ const float* w_out() const { return (const float*)inp(22); }
    __device__ __forceinline__ const float* norm_ffn() const { return (const float*)inp(23); }
    __device__ __forceinline__ const float* moe_w_grp() const { return (const float*)inp(24); }
    __device__ __forceinline__ const float* moe_b_grp() const { return (const float*)inp(25); }
    __device__ __forceinline__ const float* moe_w_router() const { return (const float*)inp(26); }
    __device__ __forceinline__ const float* moe_b_router() const { return (const float*)inp(27); }
    __device__ __forceinline__ const float* moe_w_gate() const { return (const float*)inp(28); }
    __device__ __forceinline__ const float* moe_w_up() const { return (const float*)inp(29); }
    __device__ __forceinline__ const float* moe_w_down() const { return (const float*)inp(30); }
    __device__ __forceinline__ const float* norm_final() const { return (const float*)inp(31); }
};
#define WSP(T_, off) ((T_*)(c.ws + (off)))
__device__ __forceinline__ int lane_id_volatile() { int ln; asm volatile("v_mbcnt_lo_u32_b32 %0, -1, 0\n\tv_mbcnt_hi_u32_b32 %0, -1, %0" : "=v"(ln)); return ln; }
__device__ __forceinline__ void relaunder(Ctx& c) { const int ln = lane_id_volatile(); c.lane = ln; c.tid = c.wave * 64 + ln;
    unsigned char* w = c.ws; asm volatile("" : "+s"(w)); c.ws = w; int g_ = c.G, b_ = c.bid, wv_ = c.wave; asm volatile("" : "+s"(g_), "+s"(b_), "+s"(wv_)); c.G = g_; c.bid = b_; c.wave = wv_; }

template <class Map>
__device__ __forceinline__ void transpose_item(const float* W, int ldw, int K, bf16_t* WT, const float* rowscale, Map srcmap, int nblk, LAS float* scr, int item, int lane, float colscale = 1.f) {
    const int kb = item / nblk, nb = item % nblk, k0 = 64 * kb, n0 = 32 * nb;
    const int sc = srcmap(n0 + (lane & 31));
#pragma unroll 8
    for (int i = 0; i < 32; ++i) { const int kk = 2 * i + (lane >> 5); float v = 0.f; if (sc >= 0) { v = W[(size_t)(k0 + kk) * ldw + sc] * colscale; if (rowscale) v *= rowscale[k0 + kk]; } scr[kk * 33 + (lane & 31)] = v; }
    LDS_WAIT(); asm volatile("" ::: "memory");
    const int cc = lane & 7;
#pragma unroll
    for (int j = 0; j < 4; ++j) { const int n = (lane >> 3) + 8 * j; const LAS float* s = scr + (8 * cc) * 33 + n;
        u32x4 o; o.x = pk2(s[0 * 33], s[1 * 33]); o.y = pk2(s[2 * 33], s[3 * 33]); o.z = pk2(s[4 * 33], s[5 * 33]); o.w = pk2(s[6 * 33], s[7 * 33]);
        *(u32x4*)(WT + (size_t)(n0 + n) * K + k0 + 8 * cc) = o; }
    LDS_WAIT(); asm volatile("" ::: "memory");
}
struct MapId { int off; __device__ int operator()(int n) const { return n + off; } };
struct MapInproj { __device__ int operator()(int n) const { if (n < 1280) return n; if (n < 1696) return n + 24; if (n < 1720) return n - 416; if (n < 1728) return n + 1536; if (n < 3264) return n - 8; return -1; } };
struct MapUq { __device__ int operator()(int n) const { if (n < 512) return (n >> 6) * 96 + (n & 63); const int r = n - 512; return (r >> 5) * 96 + 64 + (r & 31); } };
struct MapPad128 { __device__ int operator()(int n) const { return n < 128 ? n : -1; } };
struct MapGU { __device__ int operator()(int n) const { return (n >> 8) * 128 + (n & 127); } };

__device__ __forceinline__ int rel_bucket_dev(int n) {
    if (n < 16) return n;
    const float lr = __logf((float)n / 16.f) / 2.0794415416798357f;
    int large = 16 + (int)(lr * 16.f);
    return large < 31 ? large : 31;
}

__device__ __forceinline__ void phase_prologue(const Ctx& c) {
    LAS float* scr = (LAS float*)(c.lds + c.wave * 16384);
    const int gw = c.bid * NWAVES + c.wave, NGW = c.G * NWAVES;
    constexpr int I_WIN = 16 * (P1W / 32), I_WM = 16 * 96, I_UQ = 4 * 24, I_UK = 2 * 16, I_UV = 2 * 16, I_WO = 8 * 32, I_WOUT = 16 * 32, I_C1 = 32 * 8;
    constexpr int PER_L = I_WIN + I_WM + I_UQ + I_UK + I_UV + 3 * I_WO + I_WOUT + 2 * I_C1;
    for (int it = gw; it < NL * PER_L; it += NGW) {
        const int l = it / PER_L; int r = it % PER_L;
        if (r < I_WIN) { const int n0_ = 32 * (r % (P1W / 32)); const float cs_ = (n0_ < 512 || (n0_ >= C_FQKV && n0_ < C_FQKV + 512)) ? QSCALE64 : 1.f;
            transpose_item(c.w_in() + (size_t)l * D * DIN, DIN, D, WSP(bf16_t, WS_WINT) + (size_t)l * P1W * D, c.norm_attn() + l * D, MapInproj{}, P1W / 32, scr, r, c.lane, cs_); continue; } r -= I_WIN;
        if (r < I_WM) { transpose_item(c.w_in() + (size_t)l * D * DIN, DIN, D, WSP(bf16_t, WS_WMT) + (size_t)l * 3072 * D, c.norm_attn() + l * D, MapId{3264}, 96, scr, r, c.lane); continue; } r -= I_WM;
        if (r < I_UQ) { transpose_item(c.mla_w_uq() + (size_t)l * 256 * 768, 768, 256, WSP(bf16_t, WS_WUQT) + (size_t)l * 768 * 256, c.mla_q_norm() + l * 256, MapUq{}, 24, scr, r, c.lane, QSCALE96); continue; } r -= I_UQ;
        if (r < I_UK) { transpose_item(c.mla_w_uk() + (size_t)l * 128 * 512, 512, 128, WSP(bf16_t, WS_WUKVT) + (size_t)l * 1024 * 128, c.mla_kv_norm() + l * 128, MapId{0}, 16, scr, r, c.lane); continue; } r -= I_UK;
        if (r < I_UV) { transpose_item(c.mla_w_uv() + (size_t)l * 128 * 512, 512, 128, WSP(bf16_t, WS_WUKVT) + (size_t)l * 1024 * 128 + 512 * 128, c.mla_kv_norm() + l * 128, MapId{0}, 16, scr, r, c.lane); continue; } r -= I_UV;
        if (r < I_WO) { transpose_item(c.w_o_nsa() + (size_t)l * 512 * 1024, 1024, 512, WSP(bf16_t, WS_WOT) + ((size_t)l * 3 + 0) * 1024 * 512, nullptr, MapId{0}, 32, scr, r, c.lane); continue; } r -= I_WO;
        if (r < I_WO) { transpose_item(c.w_o_mla() + (size_t)l * 512 * 1024, 1024, 512, WSP(bf16_t, WS_WOT) + ((size_t)l * 3 + 1) * 1024 * 512, nullptr, MapId{0}, 32, scr, r, c.lane); continue; } r -= I_WO;
        if (r < I_WO) { transpose_item(c.w_o_fox() + (size_t)l * 512 * 1024, 1024, 512, WSP(bf16_t, WS_WOT) + ((size_t)l * 3 + 2) * 1024 * 512, nullptr, MapId{0}, 32, scr, r, c.lane); continue; } r -= I_WO;
        if (r < I_WOUT) { transpose_item(c.w_out() + (size_t)l * D * D, D, D, WSP(bf16_t, WS_WOUTT) + (size_t)l * D * D, nullptr, MapId{0}, 32, scr, r, c.lane); continue; } r -= I_WOUT;
        { const int kv = r / I_C1; const float* w = (kv == 0 ? c.cmp_k_w1() : c.cmp_v_w1()) + (size_t)l * 2048 * 128;
          transpose_item(w, 128, 2048, WSP(bf16_t, WS_WC1T) + ((size_t)l * 2 + kv) * 256 * 2048, nullptr, MapPad128{}, 8, scr, r % I_C1, c.lane); }
    }
    { float* rc = WSP(float, WS_ROPE); float* rs = rc + (size_t)M * 16;
      for (int i = c.bid * NTHREADS + c.tid; i < M * 16; i += c.G * NTHREADS) { const int m = i >> 4, j = i & 15;
          const float inv = exp2f(-(float)j * 0.8304820237218407f);   const float ang = (float)c.pos()[m] * inv; double rev = (double)ang * 0.15915494309189535; rev -= floor(rev); const float fr_ = (float)rev; rc[i] = __builtin_amdgcn_cosf(fr_); rs[i] = __builtin_amdgcn_sinf(fr_); } }
    float* tab = WSP(float, WS_TAB);
    if (c.bid == 0) {
        const int l = c.tid >> 8, kv = (c.tid >> 7) & 1, j = c.tid & 127;
        const float* w1 = (kv == 0 ? c.cmp_k_w1() : c.cmp_v_w1()) + (size_t)l * 2048 * 128; const float* b1 = (kv == 0 ? c.cmp_k_b1() : c.cmp_v_b1()) + l * 128; const float* pe = c.cmp_pe() + l * 2048;
        float s = b1[j]; for (int k = 0; k < 2048; ++k) s += pe[k] * w1[(size_t)k * 128 + j];
        tab[c.tid] = s;
    }
    if (c.bid == 1 % c.G) {
        for (int i = c.tid; i < 8 * 129; i += NTHREADS) { const int h = i / 129, d = i % 129; tab[512 + h * 132 + d] = c.rel_bias()[rel_bucket_dev(d) * 8 + h] * LOG2E; }
    }
}

__device__ __forceinline__ void phase_norm(const Ctx& c, const float* src, const bf16_t* y0, const bf16_t* y1, float* rout, bf16_t* hout) {
    const int gw = c.bid * NWAVES + c.wave, NGW = c.G * NWAVES;
    for (int m = gw; m < M; m += NGW) {
        const f32x4* xr = (const f32x4*)(src + (size_t)m * D) + c.lane;
        f32x4 v[4]; float s = 0.f;
#pragma unroll
        for (int j = 0; j < 4; ++j) { v[j] = xr[64 * j];
            if (y0) { const u32x2 a = *((const u32x2*)(y0 + (size_t)m * D) + c.lane + 64 * j); const u32x2 b = *((const u32x2*)(y1 + (size_t)m * D) + c.lane + 64 * j);
                v[j].x += __uint_as_float(a.x << 16) + __uint_as_float(b.x << 16); v[j].y += __uint_as_float(a.x & 0xffff0000u) + __uint_as_float(b.x & 0xffff0000u);
                v[j].z += __uint_as_float(a.y << 16) + __uint_as_float(b.y << 16); v[j].w += __uint_as_float(a.y & 0xffff0000u) + __uint_as_float(b.y & 0xffff0000u); }
            s += (v[j].x * v[j].x + v[j].y * v[j].y) + (v[j].z * v[j].z + v[j].w * v[j].w); }
        const float rstd = rsqrtf(wave_sum(s) * (1.f / D) + EPS);
        if (rout) { f32x4* ro = (f32x4*)(rout + (size_t)m * D) + c.lane;
#pragma unroll
            for (int j = 0; j < 4; ++j) ro[64 * j] = v[j]; }
        u32x2* o8 = (u32x2*)(hout + (size_t)m * D) + c.lane;
#pragma unroll
        for (int j = 0; j < 4; ++j) { u32x2 w; w.x = pk2(v[j].x * rstd, v[j].y * rstd); w.y = pk2(v[j].z * rstd, v[j].w * rstd); o8[64 * j] = w; }
    }
}
__device__ __forceinline__ void phase_final(const Ctx& c) {
    const int gw = c.bid * NWAVES + c.wave, NGW = c.G * NWAVES;
    const float* src = WSP(float, WS_XA); const bf16_t* y0 = WSP(bf16_t, WS_Y); const bf16_t* y1 = y0 + (size_t)M * D;
    for (int m = gw; m < M; m += NGW) {
        const f32x4* xr = (const f32x4*)(src + (size_t)m * D) + c.lane;
        f32x4 v[4]; float s = 0.f;
#pragma unroll
        for (int j = 0; j < 4; ++j) { v[j] = xr[64 * j];
            const u32x2 a = *((const u32x2*)(y0 + (size_t)m * D) + c.lane + 64 * j); const u32x2 b = *((const u32x2*)(y1 + (size_t)m * D) + c.lane + 64 * j);
            v[j].x += __uint_as_float(a.x << 16) + __uint_as_float(b.x << 16); v[j].y += __uint_as_float(a.x & 0xffff0000u) + __uint_as_float(b.x & 0xffff0000u);
            v[j].z += __uint_as_float(a.y << 16) + __uint_as_float(b.y << 16); v[j].w += __uint_as_float(a.y & 0xffff0000u) + __uint_as_float(b.y & 0xffff0000u);
            s += (v[j].x * v[j].x + v[j].y * v[j].y) + (v[j].z * v[j].z + v[j].w * v[j].w); }
        const float rstd = rsqrtf(wave_sum(s) * (1.f / D) + EPS);
        f32x4* ro = (f32x4*)(c.out + (size_t)m * D) + c.lane;
#pragma unroll
        for (int j = 0; j < 4; ++j) { const f32x4 g = *((const f32x4*)c.norm_final() + c.lane + 64 * j); ro[64 * j] = v[j] * rstd * g; }
    }
}

__device__ __forceinline__ void phase_prep(const Ctx& c, int l) {
    const int gw = c.bid * NWAVES + c.wave, NGW = c.G * NWAVES;
    const bf16_t* P1 = WSP(bf16_t, WS_P1); float* rstd = WSP(float, WS_RSTD); bf16_t* KR = WSP(bf16_t, WS_KR); float* LF = WSP(float, WS_LF);
    const float* rc = WSP(float, WS_ROPE); const float* rs = rc + (size_t)M * 16;
    for (int m = gw; m < M; m += NGW) {
        const bf16_t* row = P1 + (size_t)m * P1W;
        const u32x2 a = *((const u32x2*)(row + C_CQ) + c.lane);
        float q0 = __uint_as_float(a.x << 16), q1 = __uint_as_float(a.x & 0xffff0000u), q2 = __uint_as_float(a.y << 16), q3 = __uint_as_float(a.y & 0xffff0000u);
        const float sq = wave_sum(q0 * q0 + q1 * q1 + q2 * q2 + q3 * q3);
        const unsigned b = *((const unsigned*)(row + C_CKV) + c.lane);
        float k0 = __uint_as_float(b << 16), k1 = __uint_as_float(b & 0xffff0000u);
        const float sk = wave_sum(k0 * k0 + k1 * k1);
        if (c.lane == 0) { rstd[2 * m] = rsqrtf(sq * (1.f / 256.f) + EPS); rstd[2 * m + 1] = rsqrtf(sk * (1.f / 128.f) + EPS); }
        if (c.lane < 16) { const float x1 = bf2f(row[C_KR + c.lane]), x2 = bf2f(row[C_KR + 16 + c.lane]); const float cs = rc[m * 16 + c.lane], sn = rs[m * 16 + c.lane];
            KR[m * 32 + c.lane] = (bf16_t)f2bf(x1 * cs - x2 * sn); KR[m * 32 + 16 + c.lane] = (bf16_t)f2bf(x1 * sn + x2 * cs); }
        if (c.lane < 8) { const float f = bf2f(row[C_FF + c.lane]) + c.fox_b_f()[l * 8 + c.lane];
            const float ls = fminf(f, 0.f) - __logf(1.f + __expf(-fabsf(f)));
            const int bb = m / T, t = m % T; LF[((size_t)bb * 8 + c.lane) * T + t] = ls; }
    }
}
__device__ __forceinline__ void phase_cum(const Ctx& c) {
    LAS float* sh = (LAS float*)c.lds;
    for (int s = c.bid; s < NB * 8; s += c.G) {
        const float* lf = WSP(float, WS_LF) + (size_t)s * T; float* cum = WSP(float, WS_CUM) + (size_t)s * T;
        float v[16]; float tot = 0.f;
#pragma unroll
        for (int j = 0; j < 16; ++j) { v[j] = lf[c.tid * 16 + j]; tot += v[j]; }
        sh[c.tid] = tot; __syncthreads();
        if (c.tid == 0) { float run = 0.f; for (int i = 0; i < NTHREADS; ++i) { const float t_ = sh[i]; sh[i] = run; run += t_; } }
        __syncthreads();
        float run = sh[c.tid];
#pragma unroll
        for (int j = 0; j < 16; ++j) { run += v[j]; cum[c.tid * 16 + j] = run * LOG2E; }
        __syncthreads();
    }
}
__device__ __forceinline__ void phase_cmp2_ropeq(const Ctx& c, int l) {
    const bf16_t* HC = WSP(bf16_t, WS_HC);
    for (int i = c.bid * NTHREADS + c.tid; i < 2 * 2048 * 64; i += c.G * NTHREADS) {
        const int kv = i / (2048 * 64), row = (i / 64) % 2048, d = i % 64;
        const float* w2 = (kv == 0 ? c.cmp_k_w2() : c.cmp_v_w2()) + (size_t)l * 128 * 64;
        const bf16_t* h = HC + ((size_t)kv * 2048 + row) * 128; float s = 0.f;
        for (int j = 0; j < 128; ++j) s += bf2f(h[j]) * w2[j * 64 + d];
        if ((row & 511) == 511) s = 0.f;
        (kv == 0 ? WSP(bf16_t, WS_KC) : WSP(bf16_t, WS_VC))[(size_t)row * 64 + d] = (bf16_t)f2bf(s);
    }
    bf16_t* QB = WSP(bf16_t, WS_QB); const float* rc = WSP(float, WS_ROPE); const float* rs = rc + (size_t)M * 16;
    for (int i = c.bid * NTHREADS + c.tid; i < M * 128; i += c.G * NTHREADS) {
        const int m = i >> 7, h = (i >> 4) & 7, j = i & 15;
        bf16_t* p = QB + (size_t)m * 768 + 512 + h * 32; const float x1 = bf2f(p[j]), x2 = bf2f(p[16 + j]); const float cs = rc[m * 16 + j], sn = rs[m * 16 + j];
        p[j] = (bf16_t)f2bf(x1 * cs - x2 * sn); p[16 + j] = (bf16_t)f2bf(x1 * sn + x2 * cs);
    }
}

typedef float f32x2_t __attribute__((ext_vector_type(2))); typedef __bf16 bf16x2_t __attribute__((ext_vector_type(2)));
__device__ __forceinline__ unsigned cvtpk(float lo, float hi) { f32x2_t v = {lo, hi}; bf16x2_t b = __builtin_convertvector(v, bf16x2_t); return __builtin_bit_cast(unsigned, b); }
__device__ __forceinline__ u32x2 pk4(f32x4 v) { u32x2 w; w.x = cvtpk(v.x, v.y); w.y = cvtpk(v.z, v.w); return w; }
__device__ __forceinline__ f32x4 unpk4(u32x2 a) { f32x4 r; r.x = __uint_as_float(a.x << 16); r.y = __uint_as_float(a.x & 0xffff0000u); r.z = __uint_as_float(a.y << 16); r.w = __uint_as_float(a.y & 0xffff0000u); return r; }
#define EPI_ARGS const f32x4 (&acc)[2][2][4][2], const pg8::Unit& u, int wr, int wc, int fr, int fq
#define EPI_LOOP _Pragma("unroll") for (int ai = 0; ai < 2; ++ai) _Pragma("unroll") for (int m = 0; m < 4; ++m) _Pragma("unroll") for (int bj = 0; bj < 2; ++bj) _Pragma("unroll") for (int n = 0; n < 2; ++n)

struct EpiStoreBf16 { bf16_t* O; int ldc; const float* rowscale; int rs_stride;
    __device__ __forceinline__ void operator()(EPI_ARGS) const {
        EPI_LOOP { PG8_EPI_ROWCOL(row, col); f32x4 v = acc[ai][bj][m][n]; if (rowscale) v = v * rowscale[(size_t)row * rs_stride]; *(u32x2*)(O + (size_t)row * ldc + col) = pk4(v); } } };
struct EpiGates { bf16_t* O; const float* bias;
    __device__ __forceinline__ void operator()(EPI_ARGS) const {
        EPI_LOOP { PG8_EPI_ROWCOL(row, col); f32x4 v = acc[ai][bj][m][n] + *(const f32x4*)(bias + col);
            v.x = sigmoidf_(v.x); v.y = sigmoidf_(v.y); v.z = sigmoidf_(v.z); v.w = sigmoidf_(v.w); *(u32x2*)(O + (size_t)row * 3072 + col) = pk4(v); } } };
struct EpiCmp1 { bf16_t* HC; const float* bc1;
    __device__ __forceinline__ void operator()(EPI_ARGS) const {
        const int kv = u.pm >> 3, bg = (u.pm >> 1) & 3, half = u.pm & 1;
#pragma unroll
        for (int ai = 0; ai < 2; ++ai)
#pragma unroll
            for (int m = 0; m < 4; ++m)
#pragma unroll
                for (int n = 0; n < 2; ++n) { const int i = half * 256 + ai * 128 + wr * 64 + m * 16 + fr, cc = wc * 32 + n * 16 + fq * 4;
                    f32x4 v = acc[ai][0][m][n] + *(const f32x4*)(bc1 + kv * 128 + cc);
                    v.x = gelu_tanh(v.x); v.y = gelu_tanh(v.y); v.z = gelu_tanh(v.z); v.w = gelu_tanh(v.w);
                    *(u32x2*)(HC + ((size_t)kv * 2048 + bg * 512 + i) * 128 + cc) = pk4(v); } } };
struct EpiOutproj { bf16_t* MIX; const bf16_t* GATES; int br;
    __device__ __forceinline__ void operator()(EPI_ARGS) const {
        EPI_LOOP { PG8_EPI_ROWCOL(row, col); const f32x4 g = unpk4(*(const u32x2*)(GATES + (size_t)row * 3072 + br * 1024 + col)); f32x4 v = acc[ai][bj][m][n] * g;
            u32x2* p = (u32x2*)(MIX + (size_t)row * 1024 + col); if (br > 0) v = v + unpk4(*p); *p = pk4(v); } } };
struct EpiWout { const float* R; float* XA;
    __device__ __forceinline__ void operator()(EPI_ARGS) const {
        EPI_LOOP { PG8_EPI_ROWCOL(row, col); const f32x4 r = *(const f32x4*)(R + (size_t)row * 1024 + col); *(f32x4*)(XA + (size_t)row * 1024 + col) = r + acc[ai][bj][m][n]; } } };
struct EpiMoe1 { bf16_t* HID; const float* LW;
    __device__ __forceinline__ void operator()(EPI_ARGS) const {
#pragma unroll
        for (int ai = 0; ai < 2; ++ai)
#pragma unroll
            for (int m = 0; m < 4; ++m) { int aux_ = u.aux; asm volatile("" : "+s"(aux_)); const unsigned pos = (unsigned)(aux_ + ai * 128 + wr * 64 + m * 16 + fr); const float w = LW[pos];
#pragma unroll
                for (int n = 0; n < 2; ++n) { const f32x4 g = acc[ai][0][m][n], up = acc[ai][1][m][n]; f32x4 h;
                    h.x = g.x * sigmoidf_(g.x) * up.x * w; h.y = g.y * sigmoidf_(g.y) * up.y * w; h.z = g.z * sigmoidf_(g.z) * up.z * w; h.w = g.w * sigmoidf_(g.w) * up.w * w;
                    *(u32x2*)(HID + pos * 256u + (unsigned)(u.pn * 128 + wc * 32 + n * 16 + fq * 4)) = pk4(h); }
                asm volatile("" ::: "memory"); } } };
struct EpiMoe2 { bf16_t* Y; const unsigned* LDST;
    __device__ __forceinline__ void operator()(EPI_ARGS) const {
#pragma unroll
        for (int ai = 0; ai < 2; ++ai)
#pragma unroll
            for (int m = 0; m < 4; ++m) { int aux_ = u.aux; asm volatile("" : "+s"(aux_)); const unsigned pos = (unsigned)(aux_ + ai * 128 + wr * 64 + m * 16 + fr); const unsigned d0 = LDST[pos];
                if (d0 != 0xFFFFFFFFu) { const unsigned off = d0 + (unsigned)(u.pn * 256 + wc * 32 + fq * 4);
#pragma unroll
                    for (int bj = 0; bj < 2; ++bj)
#pragma unroll
                        for (int n = 0; n < 2; ++n) *(u32x2*)(Y + off + bj * 128 + n * 16) = pk4(acc[ai][bj][m][n]); }
                asm volatile("" ::: "memory"); } } };

struct CmpOrder { int G, c; const char* P1; const char* W;
    __device__ bool next(int i, pg8::Unit& u) const { const int L_ = i * G + c; if (L_ >= 16) return false; const int kv = L_ >> 3, b = (L_ >> 2) & 1, g = (L_ >> 1) & 1, half = L_ & 1;
        u.pm = L_; u.pn = 0; u.aux = 0; u.A = P1 + ((size_t)(b * T + 16 * 256 * half) * P1W + C_NKV + (kv * 2 + g) * 64) * 2; u.B = W + (size_t)kv * 256 * 2048 * 2; return true; } };
struct MoeOrder { int G, c, nN; const LAS int* tab; const char* A; size_t a_rowbytes; const char* W; size_t w_expert, w_tile;
    __device__ bool next(int i, pg8::Unit& u) const { const int L_ = i * G + c; const int NT = __builtin_amdgcn_readfirstlane(tab[32]); if (L_ >= NT * nN) return false; const int rt = L_ / nN, pn = L_ % nN;
        int e = 0; while (__builtin_amdgcn_readfirstlane(tab[e + 1]) <= rt) ++e;
        const int off_e = __builtin_amdgcn_readfirstlane(tab[33 + e]), ts_e = __builtin_amdgcn_readfirstlane(tab[e]), cnt_e = __builtin_amdgcn_readfirstlane(tab[66 + e]);
        const int pos0 = off_e + 256 * (rt - ts_e); u.pn = pn; u.aux = pos0; u.pm = off_e + cnt_e;
        u.A = A + (size_t)pos0 * a_rowbytes; u.B = W + (size_t)e * w_expert + (size_t)pn * w_tile; return true; } };
__device__ __forceinline__ void moe_tables(const Ctx& c, int l, LAS int* tab) {
    if (c.tid == 0) { const unsigned* cnt = WSP(unsigned, WS_CTL) + CW_MOECNT + l * 64; int ts = 0, off = 0;
        for (int e = 0; e < 32; ++e) { const int n = (int)cnt[e]; tab[e] = ts; tab[33 + e] = off; tab[66 + e] = n; const int nt_ = (n + 255) >> 8; ts += nt_; off += nt_ * 256; }
        tab[32] = ts; tab[65] = off; }
    __syncthreads();
}

__device__ __forceinline__ void phase_router(const Ctx& c, int l) {
    const int gw = c.bid * NWAVES + c.wave, NGW = c.G * NWAVES;
    const float* XA = WSP(float, WS_XA); bf16_t* H2 = WSP(bf16_t, WS_H2); int* REC = WSP(int, WS_REC); unsigned* cnt = WSP(unsigned, WS_CTL) + CW_MOECNT + l * 64;
    const float* g2 = c.norm_ffn() + l * D; const float* wg = c.moe_w_grp() + (size_t)l * D * 4; const float* wr_ = c.moe_w_router() + (size_t)l * D * 32;
    for (int m = gw; m < M; m += NGW) {
        const f32x4* xr = (const f32x4*)(XA + (size_t)m * D) + c.lane;
        f32x4 v[4]; float s = 0.f;
#pragma unroll
        for (int j = 0; j < 4; ++j) { v[j] = xr[64 * j]; s += (v[j].x * v[j].x + v[j].y * v[j].y) + (v[j].z * v[j].z + v[j].w * v[j].w); }
        const float rstd = rsqrtf(wave_sum(s) * (1.f / D) + EPS);
        u32x2* o8 = (u32x2*)(H2 + (size_t)m * D) + c.lane;
        float lg[36];
#pragma unroll
        for (int o = 0; o < 36; ++o) lg[o] = 0.f;
#pragma unroll
        for (int j = 0; j < 4; ++j) { v[j] = v[j] * rstd; o8[64 * j] = pk4(v[j]);
            const f32x4 gg = *((const f32x4*)g2 + c.lane + 64 * j); const f32x4 tv = v[j] * gg;
#pragma unroll
            for (int e = 0; e < 4; ++e) { const int k = 4 * c.lane + 256 * j + e; const float te = tv[e];
                const f32x4 a = *(const f32x4*)(wg + (size_t)k * 4);
#pragma unroll
                for (int o = 0; o < 4; ++o) lg[o] += te * a[o];
#pragma unroll
                for (int q = 0; q < 8; ++q) { const f32x4 w4 = *(const f32x4*)(wr_ + (size_t)k * 32 + 4 * q);
#pragma unroll
                    for (int o = 0; o < 4; ++o) lg[4 + 4 * q + o] += te * w4[o]; } } }
#pragma unroll
        for (int o = 0; o < 36; ++o) lg[o] = wave_sum(lg[o]);
        float gl[4];
#pragma unroll
        for (int o = 0; o < 4; ++o) gl[o] = lg[o] + c.moe_b_grp()[l * 4 + o];
        int gi = 0; float gm = gl[0];
#pragma unroll
        for (int o = 1; o < 4; ++o) if (gl[o] > gm) { gm = gl[o]; gi = o; }
        float gs = 0.f;
#pragma unroll
        for (int o = 0; o < 4; ++o) gs += __expf(gl[o] - gm);
        const float grp_top = 1.f / gs;
        float el[8];
#pragma unroll
        for (int q = 0; q < 8; ++q) { const float a0 = lg[4 + q], a1 = lg[12 + q], a2 = lg[20 + q], a3 = lg[28 + q]; el[q] = (gi == 0 ? a0 : gi == 1 ? a1 : gi == 2 ? a2 : a3) + c.moe_b_router()[l * 32 + gi * 8 + q]; }
        int i1 = 0; float m1 = el[0];
#pragma unroll
        for (int q = 1; q < 8; ++q) if (el[q] > m1) { m1 = el[q]; i1 = q; }
        int i2 = -1; float m2 = -3.0e38f;
#pragma unroll
        for (int q = 0; q < 8; ++q) if (q != i1 && el[q] > m2) { m2 = el[q]; i2 = q; }
        const float e2 = __expf(m2 - m1); const float w1 = grp_top / (1.f + e2), w2 = grp_top * e2 / (1.f + e2);
        if (c.lane == 0) { const int ea = gi * 8 + i1, eb = gi * 8 + i2; const int ra = (int)atomicAdd(cnt + ea, 1u), rb = (int)atomicAdd(cnt + eb, 1u);
            int* r = REC + (size_t)m * 8; r[0] = ea; r[1] = eb; r[2] = ra; r[3] = rb; r[4] = __float_as_int(w1); r[5] = __float_as_int(w2); }
    }
}
__device__ __forceinline__ void phase_place(const Ctx& c, int l) {
    LAS int* tab = (LAS int*)(c.lds + LDS_MOETAB);
    moe_tables(c, l, tab);
    int* LTOK = WSP(int, WS_LTOK); float* LW = WSP(float, WS_LW); unsigned* LDST = WSP(unsigned, WS_LSLOT); const int* REC = WSP(int, WS_REC);
    for (int m = c.bid * NTHREADS + c.tid; m < M; m += c.G * NTHREADS) { const int* r = REC + (size_t)m * 8;
        const int pa = tab[33 + r[0]] + r[2], pb = tab[33 + r[1]] + r[3];
        LTOK[pa] = m; LDST[pa] = (unsigned)m * 1024u; LW[pa] = __int_as_float(r[4]); LTOK[pb] = m; LDST[pb] = ((unsigned)M + (unsigned)m) * 1024u; LW[pb] = __int_as_float(r[5]); }
    for (int e = c.bid; e < 32; e += c.G) { const int lo = tab[33 + e] + tab[66 + e], hi2 = tab[33 + e + 1];
        for (int p = lo + c.tid; p < hi2; p += NTHREADS) { LTOK[p] = 0; LDST[p] = 0xFFFFFFFFu; LW[p] = 0.f; } }
    LAS float* scr = (LAS float*)(c.lds + c.wave * 16384);
    const int gw = c.bid * NWAVES + c.wave, NGW = c.G * NWAVES;
    constexpr int I_GU = 16 * 16, I_DN = 4 * 32;
    for (int it = gw; it < 32 * (I_GU + I_DN); it += NGW) { const int e = it / (I_GU + I_DN); int r = it % (I_GU + I_DN);
        if (r < I_GU) { const int nb = r % 16; const bool up = ((nb * 32) & 255) >= 128;
            const float* w = (up ? c.moe_w_up() : c.moe_w_gate()) + ((size_t)l * 32 + e) * D * 256;
            transpose_item(w, 256, D, WSP(bf16_t, WS_WGU) + (size_t)e * 512 * D, c.norm_ffn() + l * D, MapGU{}, 16, scr, r, c.lane); }
        else { r -= I_GU; transpose_item(c.moe_w_down() + ((size_t)l * 32 + e) * 256 * D, D, 256, WSP(bf16_t, WS_WDT) + (size_t)e * D * 256, nullptr, MapId{0}, 32, scr, r, c.lane); } }
}

#ifndef ATT_FAST_FOX
#define ATT_FAST_FOX 1
#endif
#ifndef ATT_FAST_MLA
#define ATT_FAST_MLA 1
#endif
#ifndef ATT_FAST_NSA
#define ATT_FAST_NSA 1
#endif
namespace fa {
constexpr int KPITCH = 208, VPITCH = 192;
constexpr int KBUF = 64 * KPITCH, VBUF = 64 * VPITCH;
constexpr int L_K = 0, L_V = 2 * KBUF, L_CUM = L_V + 2 * VBUF, L_LUT = L_CUM + 512, L_PS = 57344, L_F = L_PS + 64 * 132 * 4, L_SEL = L_F + 64 * 132 * 4, L_UNI = L_SEL + 1024, L_TL = L_UNI + 16, L_TLN = L_TL + 128, L_UNIT = L_TLN + 16;
static_assert(L_LUT + 8 * 132 * 4 <= L_PS && L_UNIT + 64 <= 131072, "attention LDS map");
typedef short v4i16_t __attribute__((ext_vector_type(4)));
__device__ __forceinline__ float swap32_max(float v) { auto rr = __builtin_amdgcn_permlane32_swap(__float_as_uint(v), __float_as_uint(v), false, false); return fmaxf(__uint_as_float(rr[0]), __uint_as_float(rr[1])); }
__device__ __forceinline__ float swap32_sum(float v) { auto rr = __builtin_amdgcn_permlane32_swap(__float_as_uint(v), __float_as_uint(v), false, false); return __uint_as_float(rr[0]) + __uint_as_float(rr[1]); }
__device__ __forceinline__ float ex2(float x) { return __builtin_amdgcn_exp2f(x); }

struct KVSrc { const bf16_t* K; int kpitch; const bf16_t* K2; int k2pitch; const bf16_t* V; int vpitch; const float* cum; float cref; };
struct TileRegs { u32x4 k, k2, v; float cm; };
template <bool HAS_K2, bool HAS_CUM>
__device__ __forceinline__ void tile_load(TileRegs& R, const KVSrc& s, int kv0, int tid) {
    const int row = tid >> 3, ch = tid & 7;
    R.k = *(const u32x4*)(s.K + (size_t)(kv0 + row) * s.kpitch + ch * 8);
    R.v = *(const u32x4*)(s.V + (size_t)(kv0 + row) * s.vpitch + ch * 8);
    if constexpr (HAS_K2) { if (tid < 256) R.k2 = *(const u32x4*)(s.K2 + (size_t)(kv0 + (tid >> 2)) * s.k2pitch + (tid & 3) * 8); }
    if constexpr (HAS_CUM) { if (tid < 64) R.cm = s.cum[kv0 + tid] - s.cref; }
}
template <bool HAS_K2, bool HAS_CUM>
__device__ __forceinline__ void tile_store(const TileRegs& R, LAS unsigned char* lds, int buf, int tid) {
    const int row = tid >> 3, ch = tid & 7;
    *(LAS u32x4*)(lds + L_K + buf * KBUF + row * KPITCH + ch * 16) = R.k;
    if constexpr (HAS_K2) { if (tid < 256) *(LAS u32x4*)(lds + L_K + buf * KBUF + (tid >> 2) * KPITCH + 128 + (tid & 3) * 16) = R.k2; }
    *(LAS u32x4*)(lds + L_V + buf * VBUF + row * VPITCH + ch * 16) = R.v;
    if constexpr (HAS_CUM) { if (tid < 64) ((LAS float*)(lds + L_CUM))[buf * 64 + tid] = R.cm; }
}
template <int NKS>
__device__ __forceinline__ void qk_tile(f32x16 (&st)[2], const LAS unsigned char* lds, int buf, const bf16x8 (&qf)[NKS], int r, int hh) {
#pragma unroll
    for (int rb = 0; rb < 2; ++rb) {
        f32x16 a = {0.f, 0.f, 0.f, 0.f, 0.f, 0.f, 0.f, 0.f, 0.f, 0.f, 0.f, 0.f, 0.f, 0.f, 0.f, 0.f};
        const LAS unsigned char* kp = lds + L_K + buf * KBUF + (32 * rb + r) * KPITCH + hh * 16;
#pragma unroll
        for (int ks = 0; ks < NKS; ++ks) { const bf16x8 kf = *(const LAS bf16x8*)(kp + ks * 32); a = __builtin_amdgcn_mfma_f32_32x32x16_bf16(kf, qf[ks], a, 0, 0, 0); }
        st[rb] = a; }
}
__device__ __forceinline__ void pv_tile(f32x16 (&ot)[2], const LAS unsigned char* lds, int buf, const f32x16 (&p)[2], int lane) {
    const int i16 = lane & 15, blk = (lane >> 4) & 1, hh = lane >> 5;
    const LAS unsigned char* vb = lds + L_V + buf * VBUF + (4 * hh + (i16 >> 2)) * VPITCH + 32 * blk + 8 * (i16 & 3);
#pragma unroll
    for (int rb = 0; rb < 2; ++rb)
#pragma unroll
        for (int s_ = 0; s_ < 2; ++s_) {
            u32x4 pw; pw.x = cvtpk(p[rb][8 * s_ + 0], p[rb][8 * s_ + 1]); pw.y = cvtpk(p[rb][8 * s_ + 2], p[rb][8 * s_ + 3]); pw.z = cvtpk(p[rb][8 * s_ + 4], p[rb][8 * s_ + 5]); pw.w = cvtpk(p[rb][8 * s_ + 6], p[rb][8 * s_ + 7]);
            const bf16x8 pf = __builtin_bit_cast(bf16x8, pw);
#pragma unroll
            for (int db = 0; db < 2; ++db) { const LAS unsigned char* vp = vb + (32 * rb + 16 * s_) * VPITCH + 64 * db;
                const v4i16_t lo = __builtin_amdgcn_ds_read_tr16_b64_v4i16((LAS v4i16_t*)vp), hi = __builtin_amdgcn_ds_read_tr16_b64_v4i16((LAS v4i16_t*)(vp + 8 * VPITCH));
                const bf16x8 vf = {lo[0], lo[1], lo[2], lo[3], hi[0], hi[1], hi[2], hi[3]};
                ot[db] = __builtin_amdgcn_mfma_f32_32x32x16_bf16(vf, pf, ot[db], 0, 0, 0); } }
}
struct SmState { float m, l; };
constexpr float RESC_THR = 8.f;
__device__ __forceinline__ void sm_update(f32x16 (&st)[2], SmState& S, f32x16 (&ot)[2]) {
    float mx = fmaxf(st[0][0], st[1][0]);
#pragma unroll
    for (int i = 1; i < 16; ++i) mx = fmaxf(fmaxf(mx, st[0][i]), st[1][i]);
    mx = swap32_max(mx);
    if (__any(mx > S.m + RESC_THR)) {
        const float mn = fmaxf(S.m, mx); const float alpha = (mn == -INFINITY) ? 1.f : ex2(S.m - mn);
        S.l *= alpha; S.m = mn;
#pragma unroll
        for (int db = 0; db < 2; ++db)
#pragma unroll
            for (int i = 0; i < 16; ++i) ot[db][i] *= alpha;
    }
    const float ms = (S.m == -INFINITY) ? 0.f : S.m;
    float sum = 0.f;
#pragma unroll
    for (int rb = 0; rb < 2; ++rb)
#pragma unroll
        for (int i = 0; i < 16; ++i) { const float p = ex2(st[rb][i] - ms); st[rb][i] = p; sum += p; }
    S.l += sum;
}
__device__ __forceinline__ void sm_stats(const f32x16 (&st)[2], SmState& S) {
    float mx = fmaxf(st[0][0], st[1][0]);
#pragma unroll
    for (int i = 1; i < 16; ++i) mx = fmaxf(fmaxf(mx, st[0][i]), st[1][i]);
    mx = swap32_max(mx);
    if (__any(mx > S.m + RESC_THR)) { const float mn = fmaxf(S.m, mx); const float alpha = (mn == -INFINITY) ? 1.f : ex2(S.m - mn); S.l *= alpha; S.m = mn; }
    const float ms = (S.m == -INFINITY) ? 0.f : S.m;
    float sum = 0.f;
#pragma unroll
    for (int rb = 0; rb < 2; ++rb)
#pragma unroll
        for (int i = 0; i < 16; ++i) sum += ex2(st[rb][i] - ms);
    S.l += sum;
}
__device__ __forceinline__ void zero_acc(f32x16 (&a)[2]) {
#pragma unroll
    for (int db = 0; db < 2; ++db)
#pragma unroll
        for (int i = 0; i < 16; ++i) a[db][i] = 0.f;
}
__device__ __forceinline__ void store_ot(const f32x16 (&o)[2], float sc, bf16_t* orow, int hh) {
#pragma unroll
    for (int db = 0; db < 2; ++db)
#pragma unroll
        for (int a = 0; a < 4; ++a) { u32x2 w; w.x = cvtpk(o[db][4 * a + 0] * sc, o[db][4 * a + 1] * sc); w.y = cvtpk(o[db][4 * a + 2] * sc, o[db][4 * a + 3] * sc);
            *(u32x2*)(orow + 32 * db + 8 * a + 4 * hh) = w; }
}
#define FA_FOREACH_REG(CODE) _Pragma("unroll") for (int rb = 0; rb < 2; ++rb) _Pragma("unroll") for (int a = 0; a < 4; ++a) _Pragma("unroll") for (int e = 0; e < 4; ++e) { const int i = 4 * a + e; const int kc = 32 * rb + 8 * a + e; (void)kc; CODE }
#define FA_LAUNDER(x) asm volatile("" : "+v"(x))

template <bool IS_MLA>
__device__ __forceinline__ void dense_unit(const Ctx& c, int b, int h, int qb) {
    constexpr int NKS = IS_MLA ? 6 : 4;
    const int tid = c.tid, lane = c.lane, r = lane & 31, hh = lane >> 5, w = c.wave;
    LAS unsigned char* lds = c.lds;
    const int q0 = qb * 256, qrow = q0 + 32 * w + r; const size_t mrow = (size_t)b * T + qrow;
    KVSrc src; bf16x8 qf[NKS]; bf16_t* orow;
    if constexpr (IS_MLA) {
        const bf16_t* QB = WSP(bf16_t, WS_QB); const bf16_t* KVB = WSP(bf16_t, WS_KVB);
        src.K = KVB + (size_t)b * T * 1024 + h * 64; src.kpitch = 1024; src.K2 = WSP(bf16_t, WS_KR) + (size_t)b * T * 32; src.k2pitch = 32; src.V = KVB + (size_t)b * T * 1024 + 512 + h * 64; src.vpitch = 1024; src.cum = nullptr; src.cref = 0.f;
#pragma unroll
        for (int ks = 0; ks < 4; ++ks) qf[ks] = *(const bf16x8*)(QB + mrow * 768 + h * 64 + 16 * ks + 8 * hh);
#pragma unroll
        for (int ks = 0; ks < 2; ++ks) qf[4 + ks] = *(const bf16x8*)(QB + mrow * 768 + 512 + h * 32 + 16 * ks + 8 * hh);
        orow = WSP(bf16_t, WS_OUTB) + mrow * 512 + h * 64;
    } else {
        const bf16_t* P1 = WSP(bf16_t, WS_P1);
        src.K = P1 + (size_t)b * T * P1W + C_FQKV + 512 + h * 64; src.kpitch = P1W; src.K2 = nullptr; src.k2pitch = 0; src.V = P1 + (size_t)b * T * P1W + C_FQKV + 1024 + h * 64; src.vpitch = P1W;
        src.cum = WSP(float, WS_CUM) + ((size_t)b * 8 + h) * T; src.cref = src.cum[q0];
#pragma unroll
        for (int ks = 0; ks < 4; ++ks) qf[ks] = *(const bf16x8*)(P1 + mrow * P1W + C_FQKV + h * 64 + 16 * ks + 8 * hh);
        orow = WSP(bf16_t, WS_OUTC) + mrow * 512 + h * 64;
    }
    f32x16 st[2], ot[2]; zero_acc(ot); SmState S{-INFINITY, 0.f};
    const int nt = 4 * qb + 4;
    const int wlast = (q0 + 32 * w + 31) >> 6;
    TileRegs R;
    tile_load<IS_MLA, !IS_MLA>(R, src, 0, tid); tile_store<IS_MLA, !IS_MLA>(R, lds, 0, tid);
    if (nt > 1) tile_load<IS_MLA, !IS_MLA>(R, src, 64, tid);
    __syncthreads();
    for (int t = 0; t < nt; ++t) { const int buf = t & 1, kv0 = 64 * t;
        if (t <= wlast) {
            qk_tile<NKS>(st, lds, buf, qf, r, hh);
            if constexpr (!IS_MLA) {
#pragma unroll
                for (int rb = 0; rb < 2; ++rb)
#pragma unroll
                    for (int a = 0; a < 4; ++a) { const f32x4 ck = *(const LAS f32x4*)(lds + L_CUM + (buf * 64 + 32 * rb + 8 * a + 4 * hh) * 4);
#pragma unroll
                        for (int e = 0; e < 4; ++e) st[rb][4 * a + e] -= ck[e]; } }
            if (kv0 + 63 > q0 + 32 * w) { int lim = qrow - kv0 - 4 * hh; FA_LAUNDER(lim); FA_FOREACH_REG({ if (kc > lim) st[rb][i] = -INFINITY; }) }
            sm_update(st, S, ot);
            pv_tile(ot, lds, buf, st, lane);
        }
        if (t + 1 < nt) { tile_store<IS_MLA, !IS_MLA>(R, lds, buf ^ 1, tid); if (t + 2 < nt) tile_load<IS_MLA, !IS_MLA>(R, src, kv0 + 128, tid); }
        __syncthreads();
    }
    const float lt = swap32_sum(S.l);
    store_ot(ot, 1.f / lt, orow, hh);
}

#define FA_STREAM(SRC, NT, TILE_EXPR, BODY) do { TileRegs R_; const int nt_ = (NT); \
    if (nt_ > 0) { { const int idx = 0; tile_load<false, false>(R_, SRC, 64 * (TILE_EXPR), tid); } tile_store<false, false>(R_, lds, 0, tid); \
      if (nt_ > 1) { const int idx = 1; tile_load<false, false>(R_, SRC, 64 * (TILE_EXPR), tid); } \
      __syncthreads(); \
      for (int it_ = 0; it_ < nt_; ++it_) { const int buf = it_ & 1; int tile; { const int idx = it_; tile = (TILE_EXPR); } \
          BODY \
          if (it_ + 1 < nt_) { tile_store<false, false>(R_, lds, buf ^ 1, tid); if (it_ + 2 < nt_) { const int idx = it_ + 2; tile_load<false, false>(R_, SRC, 64 * (TILE_EXPR), tid); } } \
          __syncthreads(); } } } while (0)

__device__ __forceinline__ void nsa_unit(const Ctx& c, int b, int g, int j) {
    const int tid = c.tid, lane = c.lane, r = lane & 31, hh = lane >> 5, w = c.wave;
    LAS unsigned char* lds = c.lds;
    const int t0 = 64 * j, tl = r >> 2, hp = r & 3, tokl = 8 * w + tl, tq = t0 + tokl, head = 4 * g + hp; const size_t mrow = (size_t)b * T + tq;
    const bf16_t* P1 = WSP(bf16_t, WS_P1);
    bf16x8 qf[4];
#pragma unroll
    for (int ks = 0; ks < 4; ++ks) qf[ks] = *(const bf16x8*)(P1 + mrow * P1W + C_NQ + head * 64 + 16 * ks + 8 * hh);
    const float gc = sigmoidf_(bf2f(P1[mrow * P1W + C_NG + head * 3 + 0])), gsl = sigmoidf_(bf2f(P1[mrow * P1W + C_NG + head * 3 + 1])), gwn = sigmoidf_(bf2f(P1[mrow * P1W + C_NG + head * 3 + 2]));
    const LAS float* lutL = (const LAS float*)(lds + L_LUT) + head * 132;
    LAS float* PS = (LAS float*)(lds + L_PS); LAS float* FM = (LAS float*)(lds + L_F); LAS unsigned* SEL = (LAS unsigned*)(lds + L_SEL); LAS unsigned* UNI = (LAS unsigned*)(lds + L_UNI);
    LAS unsigned char* TL = (LAS unsigned char*)(lds + L_TL); LAS int* TLN = (LAS int*)(lds + L_TLN);
    f32x16 st[2], ot[2], otot[2]; zero_acc(otot);
    for (int i = tid; i < 2 * 64 * 132; i += NTHREADS) PS[i] = 0.f;
    if (tid < 256) SEL[tid] = 0u; if (tid < 4) UNI[tid] = 0u;
    const float bfar = lutL[128];
    const int tmin = t0 + 8 * w;
    const int n_ok_max = ((t0 + 63 - 31) >> 4) + 1; const int nct = (n_ok_max + 63) >> 6;
    KVSrc srcc; srcc.K = WSP(bf16_t, WS_KC) + (size_t)(b * 2 + g) * 512 * 64; srcc.kpitch = 64; srcc.K2 = nullptr; srcc.k2pitch = 0; srcc.V = WSP(bf16_t, WS_VC) + (size_t)(b * 2 + g) * 512 * 64; srcc.vpitch = 64; srcc.cum = nullptr; srcc.cref = 0.f;
    SmState Sc{-INFINITY, 0.f};
    FA_STREAM(srcc, nct, idx, {
        qk_tile<4>(st, lds, buf, qf, r, hh);
        if (16 * (64 * tile + 63) + 31 + 128 <= tmin) { FA_FOREACH_REG({ st[rb][i] += bfar; }) }
        else { int db_ = tq - 31 - 1024 * tile - 64 * hh; FA_LAUNDER(db_); FA_FOREACH_REG({ const int dist = db_ - 16 * kc; const float s_ = st[rb][i] + lutL[dist < 0 ? 0 : (dist > 128 ? 128 : dist)]; st[rb][i] = dist < 0 ? -INFINITY : s_; }) }
        sm_stats(st, Sc); });
    { const float lt = swap32_sum(Sc.l); const float inv = lt > 0.f ? 1.f / lt : 0.f; const float msafe = (Sc.m == -INFINITY) ? 0.f : Sc.m;
      zero_acc(ot);
      FA_STREAM(srcc, nct, idx, {
        qk_tile<4>(st, lds, buf, qf, r, hh);
        if (16 * (64 * tile + 63) + 31 + 128 <= tmin) { FA_FOREACH_REG({ st[rb][i] = ex2(st[rb][i] + bfar - msafe) * inv; }) }
        else { int db_ = tq - 31 - 1024 * tile - 64 * hh; FA_LAUNDER(db_); FA_FOREACH_REG({ const int dist = db_ - 16 * kc; const float s_ = st[rb][i] + lutL[dist < 0 ? 0 : (dist > 128 ? 128 : dist)]; st[rb][i] = dist < 0 ? 0.f : ex2(s_ - msafe) * inv; }) }
_Pragma("unroll")
        for (int rb = 0; rb < 2; ++rb)
_Pragma("unroll")
            for (int a = 0; a < 4; ++a) { float q4[4];
_Pragma("unroll")
                for (int e = 0; e < 4; ++e) { float v = st[rb][4 * a + e]; v += dpp_f<0xB1>(v); v += dpp_f<0x4E>(v); q4[e] = v; }
                if (hp == 0) { const int G = 16 * tile + 8 * rb + 2 * a + hh; PS[tokl * 132 + G] = q4[0] + 2.f * (q4[1] + q4[2] + q4[3]); FM[tokl * 132 + G] = q4[0]; } }
        pv_tile(ot, lds, buf, st, lane); });
#pragma unroll
      for (int db = 0; db < 2; ++db)
#pragma unroll
          for (int i = 0; i < 16; ++i) otot[db][i] += gc * ot[db][i]; }
    if (j + 1 <= 16) { if (tid < 64) SEL[tid * 4] = (1u << (j + 1)) - 1u; if (tid == 0) UNI[0] = (1u << (j + 1)) - 1u; }
    else {
        for (int i = tid; i < 64 * 128; i += NTHREADS) { const int tk = i >> 7, G = i & 127; if (G >= 1 && G <= j - 2) PS[tk * 132 + G] += FM[tk * 132 + G + 1]; }
        __syncthreads();
        const int tk = tid >> 3, sub = tid & 7; unsigned bits[4] = {0u, 0u, 0u, 0u};
#pragma unroll 1
        for (int k = 0; k < 16; ++k) { const int G = sub + 8 * k;
            if (G >= 1 && G <= j - 2) { const float v = PS[tk * 132 + G]; int cnt = 0;
                for (int G2 = 1; G2 <= j - 2; ++G2) { const float v2 = PS[tk * 132 + G2]; cnt += (v2 > v || (v2 == v && G2 < G)) ? 1 : 0; }
                if (cnt < 13) { if (k < 4) bits[0] |= 1u << G; else if (k < 8) bits[1] |= 1u << (G - 32); else if (k < 12) bits[2] |= 1u << (G - 64); else bits[3] |= 1u << (G - 96); } } }
        if (sub == 0) { bits[0] |= 1u; { const int G = j; if (G < 32) bits[0] |= 1u << G; else if (G < 64) bits[1] |= 1u << (G - 32); else if (G < 96) bits[2] |= 1u << (G - 64); else bits[3] |= 1u << (G - 96); }
                        { const int G = j - 1; if (G < 32) bits[0] |= 1u << G; else if (G < 64) bits[1] |= 1u << (G - 32); else if (G < 96) bits[2] |= 1u << (G - 64); else bits[3] |= 1u << (G - 96); } }
#pragma unroll
        for (int q = 0; q < 4; ++q) if (bits[q]) { atomicOr((unsigned*)(SEL + tk * 4 + q), bits[q]); atomicOr((unsigned*)(UNI + q), bits[q]); }
    }
    __syncthreads();
    if (tid == 0) { int n = 0; for (int q = 0; q < 4; ++q) { unsigned m_ = UNI[q]; while (m_) { const int bpos = __builtin_ctz(m_); m_ &= m_ - 1u; TL[n++] = (unsigned char)(32 * q + bpos); } } TLN[0] = n; }
    __syncthreads();
    const unsigned msk0 = SEL[tokl * 4 + 0], msk1 = SEL[tokl * 4 + 1], msk2 = SEL[tokl * 4 + 2], msk3 = SEL[tokl * 4 + 3];
    const int nsel = __builtin_amdgcn_readfirstlane(TLN[0]);
    { KVSrc srcs; srcs.K = P1 + (size_t)b * T * P1W + C_NKV + ((1 * 2 + 0) * 2 + g) * 64; srcs.kpitch = P1W; srcs.K2 = nullptr; srcs.k2pitch = 0; srcs.V = P1 + (size_t)b * T * P1W + C_NKV + ((1 * 2 + 1) * 2 + g) * 64; srcs.vpitch = P1W; srcs.cum = nullptr; srcs.cref = 0.f;
      SmState Ss{-INFINITY, 0.f}; zero_acc(ot);
      FA_STREAM(srcs, nsel, (int)TL[idx], {
        const int wq = tile >> 5; const unsigned mw = wq == 0 ? msk0 : wq == 1 ? msk1 : wq == 2 ? msk2 : msk3; const bool mine = (mw >> (tile & 31)) & 1u;
        if (__any(mine)) {
            qk_tile<4>(st, lds, buf, qf, r, hh);
            if (64 * tile + 63 + 128 <= tmin) { FA_FOREACH_REG({ st[rb][i] = mine ? st[rb][i] + bfar : -INFINITY; }) }
            else { int db_ = tq - 64 * tile - 4 * hh; FA_LAUNDER(db_); FA_FOREACH_REG({ const int dist = db_ - kc; const float s_ = st[rb][i] + lutL[dist < 0 ? 0 : (dist > 128 ? 128 : dist)]; st[rb][i] = (mine && dist >= 0) ? s_ : -INFINITY; }) }
            sm_update(st, Ss, ot);
            pv_tile(ot, lds, buf, st, lane); } });
      const float lt = swap32_sum(Ss.l); const float sc = lt > 0.f ? gsl / lt : 0.f;
#pragma unroll
      for (int db = 0; db < 2; ++db)
#pragma unroll
          for (int i = 0; i < 16; ++i) otot[db][i] += sc * ot[db][i]; }
    { KVSrc srcw; srcw.K = P1 + (size_t)b * T * P1W + C_NKV + ((2 * 2 + 0) * 2 + g) * 64; srcw.kpitch = P1W; srcw.K2 = nullptr; srcw.k2pitch = 0; srcw.V = P1 + (size_t)b * T * P1W + C_NKV + ((2 * 2 + 1) * 2 + g) * 64; srcw.vpitch = P1W; srcw.cum = nullptr; srcw.cref = 0.f;
      const int jlo = j - 8 > 0 ? j - 8 : 0;
      SmState Sw{-INFINITY, 0.f}; zero_acc(ot);
      FA_STREAM(srcw, j - jlo + 1, jlo + idx, {
        qk_tile<4>(st, lds, buf, qf, r, hh);
        { int db_ = tq - 64 * tile - 4 * hh; FA_LAUNDER(db_); FA_FOREACH_REG({ const int dist = db_ - kc; const float s_ = st[rb][i] + lutL[dist < 0 ? 0 : (dist > 128 ? 128 : dist)]; st[rb][i] = (dist >= 0 && dist < 512) ? s_ : -INFINITY; }) }
        sm_update(st, Sw, ot);
        pv_tile(ot, lds, buf, st, lane); });
      const float lt = swap32_sum(Sw.l); const float sc = lt > 0.f ? gwn / lt : 0.f;
#pragma unroll
      for (int db = 0; db < 2; ++db)
#pragma unroll
          for (int i = 0; i < 16; ++i) otot[db][i] += sc * ot[db][i]; }
    store_ot(otot, 1.f, WSP(bf16_t, WS_OUTA) + mrow * 512 + head * 64, hh);
}
}

__device__ __forceinline__ int next_unit(const Ctx& c, unsigned* ctr) {
    LAS int* u = (LAS int*)(c.lds + fa::L_UNIT);
    __syncthreads();
    if (c.tid == 0) u[0] = (int)__hip_atomic_fetch_add(ctr, 1u, __ATOMIC_RELAXED, __HIP_MEMORY_SCOPE_AGENT);
    __syncthreads();
    return __builtin_amdgcn_readfirstlane(u[0]);
}
__device__ __forceinline__ void phase_att_fast(const Ctx& c0, int l) {
    Ctx c = c0;
    unsigned* ctr = WSP(unsigned, WS_CTL) + CW_QUEUE + 64 * l;
    { const float* lut = WSP(float, WS_TAB) + 512; LAS float* L_ = (LAS float*)(c.lds + fa::L_LUT); for (int i = c.tid; i < 8 * 132; i += NTHREADS) L_[i] = lut[i]; }
    for (;;) {
        const int u = next_unit(c, ctr);
        if (u >= 32 * 48) break;
        relaunder(c);
        const int lv = 31 - u / 48, k = u % 48, kind = k >> 4, id = k & 15;
        if (kind == 0) { if (ATT_FAST_MLA) fa::dense_unit<true>(c, id >> 3, id & 7, lv); }
        else if (kind == 1) { if (ATT_FAST_NSA) fa::nsa_unit(c, (id >> 1) & 1, id & 1, 4 * lv + 3 - (id >> 2)); }
        else { if (ATT_FAST_FOX) fa::dense_unit<false>(c, id >> 3, id & 7, lv); }
    }
}

struct Args { const void* in[32]; float* out; unsigned char* ws; int l_lo, l_hi; };
constexpr int PH_PER_LAYER = 15, K_FINAL = 1 + PH_PER_LAYER;
template <int KIND>
__global__ void __launch_bounds__(NTHREADS, 2) fwd_kernel(Args a) {
    extern __shared__ __attribute__((aligned(16))) unsigned char lds_raw[];
    Ctx c;
    c.out = a.out; c.ws = a.ws; c.lds = (LAS unsigned char*)lds_raw;
    c.tid = threadIdx.x; c.lane = c.tid & 63; c.wave = __builtin_amdgcn_readfirstlane(c.tid >> 6); c.G = gridDim.x; c.bid = blockIdx.x;
    if (c.tid < 4) ((LAS unsigned*)(c.lds + LDS_MISC))[c.tid] = 0u;
    if (c.tid < 32) { const unsigned long long pv = (unsigned long long)a.in[c.tid]; ((LAS unsigned*)(c.lds + LDS_INTAB))[2 * c.tid] = (unsigned)pv; ((LAS unsigned*)(c.lds + LDS_INTAB))[2 * c.tid + 1] = (unsigned)(pv >> 32); }
    __syncthreads();
    XcdBarrier bar; bar.bar = WSP(unsigned, WS_CTL) + CW_BAR; bar.x = 0; bar.st = nullptr;
    if constexpr (KIND < 0) bar = xcd_barrier_post(WSP(unsigned, WS_CTL) + CW_BAR, (volatile LAS unsigned*)(c.lds + LDS_MISC));
#define IN(k) ((KIND < 0 || KIND == (k)) && (relaunder(c), true))
#define SEAM(k) do { if constexpr (KIND < 0) { unsigned* bb_ = bar.bar; asm volatile("" : "+s"(bb_)); bar.bar = bb_; xcd_barrier(bar); } } while (0)
    LAS unsigned char* ring = c.lds;

    if (IN(0)) { phase_prologue(c); } SEAM(0);
    for (int l = a.l_lo; l < a.l_hi; ++l) {
        constexpr int pb = 1;
        const float* resid = (l == 0) ? c.x() : WSP(float, WS_XA);
        if (IN(pb + 0)) { if (l == 0) phase_norm(c, c.x(), nullptr, nullptr, nullptr, WSP(bf16_t, WS_H0));
                          else phase_norm(c, WSP(float, WS_XA), WSP(bf16_t, WS_Y), WSP(bf16_t, WS_Y) + (size_t)M * D, WSP(float, WS_XA), WSP(bf16_t, WS_H0)); } SEAM(pb + 0);
        if (IN(pb + 1)) { pg8::Cfg g{(unsigned)(D * 2), 128u, (unsigned)(D * 2), D / 64, nullptr}; pg8::DenseOrder S; S.init(M / 256, P1W / 256, c.G, c.bid, WSP(bf16_t, WS_H0), (size_t)256 * D * 2, WSP(bf16_t, WS_WINT) + (size_t)l * P1W * D, (size_t)256 * D * 2);
            EpiStoreBf16 E{WSP(bf16_t, WS_P1), P1W, nullptr, 0}; pg8::gemm_phase<false>(ring, c.wave, g, S, E); } SEAM(pb + 1);
        if (IN(pb + 2)) { phase_prep(c, l); } SEAM(pb + 2);
        if (IN(pb + 3)) { phase_cum(c); } SEAM(pb + 3);
        if (IN(pb + 4)) {
            { pg8::Cfg g{(unsigned)(P1W * 2), 128u, 512u, 4, nullptr}; pg8::DenseOrder S; S.init(M / 256, 3, c.G, c.bid, WSP(bf16_t, WS_P1) + C_CQ, (size_t)256 * P1W * 2, WSP(bf16_t, WS_WUQT) + (size_t)l * 768 * 256, (size_t)256 * 512);
              EpiStoreBf16 E{WSP(bf16_t, WS_QB), 768, WSP(float, WS_RSTD), 2}; pg8::gemm_phase<false>(ring, c.wave, g, S, E); }
            { pg8::Cfg g{(unsigned)(P1W * 2), 128u, 256u, 2, nullptr}; pg8::DenseOrder S; S.init(M / 256, 4, c.G, c.bid, WSP(bf16_t, WS_P1) + C_CKV, (size_t)256 * P1W * 2, WSP(bf16_t, WS_WUKVT) + (size_t)l * 1024 * 128, (size_t)256 * 256);
              EpiStoreBf16 E{WSP(bf16_t, WS_KVB), 1024, WSP(float, WS_RSTD) + 1, 2}; pg8::gemm_phase<false>(ring, c.wave, g, S, E); }
            { pg8::Cfg g{(unsigned)(16 * P1W * 2), (unsigned)(P1W * 2), 4096u, 32, nullptr}; CmpOrder S{c.G, (c.bid + 64) % c.G, (const char*)WSP(bf16_t, WS_P1), (const char*)(WSP(bf16_t, WS_WC1T) + (size_t)l * 2 * 256 * 2048)};
              EpiCmp1 E{WSP(bf16_t, WS_HC), WSP(float, WS_TAB) + l * 256}; pg8::gemm_phase<false>(ring, c.wave, g, S, E); }
        } SEAM(pb + 4);
        if (IN(pb + 5)) { phase_cmp2_ropeq(c, l); } SEAM(pb + 5);
        if (IN(pb + 6)) { phase_att_fast(c, l); } SEAM(pb + 6);
        if (IN(pb + 7)) { phase_norm(c, resid, nullptr, nullptr, nullptr, WSP(bf16_t, WS_HG)); } SEAM(pb + 7);
        if (IN(pb + 8)) { pg8::Cfg g{(unsigned)(D * 2), 128u, (unsigned)(D * 2), D / 64, nullptr}; pg8::DenseOrder S; S.init(M / 256, 12, c.G, c.bid, WSP(bf16_t, WS_HG), (size_t)256 * D * 2, WSP(bf16_t, WS_WMT) + (size_t)l * 3072 * D, (size_t)256 * D * 2);
            EpiGates E{WSP(bf16_t, WS_GATES), c.b_merge() + l * 3072}; pg8::gemm_phase<false>(ring, c.wave, g, S, E); } SEAM(pb + 8);
        if (IN(pb + 9)) {
#pragma unroll 1
            for (int br = 0; br < 3; ++br) { pg8::Cfg g{1024u, 128u, 1024u, 8, nullptr}; pg8::DenseOrder S;
                S.init(M / 256, 4, c.G, c.bid, WSP(bf16_t, br == 0 ? WS_OUTA : br == 1 ? WS_OUTB : WS_OUTC), (size_t)256 * 1024, WSP(bf16_t, WS_WOT) + ((size_t)l * 3 + br) * 1024 * 512, (size_t)256 * 1024);
                EpiOutproj E{WSP(bf16_t, WS_MIXED), WSP(bf16_t, WS_GATES), br}; pg8::gemm_phase<false>(ring, c.wave, g, S, E); }
        } SEAM(pb + 9);
        if (IN(pb + 10)) { pg8::Cfg g{(unsigned)(D * 2), 128u, (unsigned)(D * 2), D / 64, nullptr}; pg8::DenseOrder S; S.init(M / 256, 4, c.G, c.bid, WSP(bf16_t, WS_MIXED), (size_t)256 * D * 2, WSP(bf16_t, WS_WOUTT) + (size_t)l * D * D, (size_t)256 * D * 2);
            EpiWout E{resid, WSP(float, WS_XA)}; pg8::gemm_phase<false>(ring, c.wave, g, S, E); } SEAM(pb + 10);
        if (IN(pb + 11)) { phase_router(c, l); } SEAM(pb + 11);
        if (IN(pb + 12)) { phase_place(c, l); } SEAM(pb + 12);
        if (IN(pb + 13)) { LAS int* tab = (LAS int*)(c.lds + LDS_MOETAB); moe_tables(c, l, tab);
            pg8::Cfg g{(unsigned)(D * 2), 128u, (unsigned)(D * 2), D / 64, WSP(int, WS_LTOK)}; MoeOrder S{c.G, c.bid, 2, tab, (const char*)WSP(bf16_t, WS_H2), 0, (const char*)WSP(bf16_t, WS_WGU), (size_t)512 * D * 2, (size_t)256 * D * 2};
            EpiMoe1 E{WSP(bf16_t, WS_HID), WSP(float, WS_LW)}; pg8::gemm_phase<true>(ring, c.wave, g, S, E); } SEAM(pb + 13);
        if (IN(pb + 14)) { LAS int* tab = (LAS int*)(c.lds + LDS_MOETAB); moe_tables(c, l, tab);
            pg8::Cfg g{512u, 128u, 512u, 4, nullptr}; MoeOrder S{c.G, c.bid, 4, tab, (const char*)WSP(bf16_t, WS_HID), 512, (const char*)WSP(bf16_t, WS_WDT), (size_t)D * 256 * 2, (size_t)256 * 256 * 2};
            EpiMoe2 E{WSP(bf16_t, WS_Y), WSP(unsigned, WS_LSLOT)}; pg8::gemm_phase<false>(ring, c.wave, g, S, E); } SEAM(pb + 14);
    }
    if (IN(K_FINAL)) { phase_final(c); }
#undef IN
#undef SEAM
}

template <int KIND> static bool prep_kernel() { return hipFuncSetAttribute((const void*)fwd_kernel<KIND>, hipFuncAttributeMaxDynamicSharedMemorySize, LDS_BYTES) == hipSuccess; }
template <int KIND> static void launch_kind(int grid, hipStream_t stream, Args a, int l) { a.l_lo = l; a.l_hi = l + 1; hipLaunchKernelGGL(fwd_kernel<KIND>, dim3(grid), dim3(NTHREADS), LDS_BYTES, stream, a); }
extern "C" void kernel_launch(void* const* d_in, const int* in_sizes, int n_in, void* d_out, int out_size, void* d_ws, size_t ws_size, hipStream_t stream) {
    static int grid = 0;
    if (grid == 0) {
        if (n_in != 32 || ws_size < WS_END) { fprintf(stderr, "kernel_launch: n_in %d ws %zu (need %zu)\n", n_in, ws_size, (size_t)WS_END); grid = -1; return; }
        int dev = 0, cus = 0;
        if (hipGetDevice(&dev) != hipSuccess || hipDeviceGetAttribute(&cus, hipDeviceAttributeMultiprocessorCount, dev) != hipSuccess) { grid = -1; return; }
        bool ok = true;
#if MK_ONE_LAUNCH
        ok = prep_kernel<-1>();
#else
        ok = prep_kernel<0>() && prep_kernel<1>() && prep_kernel<2>() && prep_kernel<3>() && prep_kernel<4>() && prep_kernel<5>() && prep_kernel<6>() && prep_kernel<7>() && prep_kernel<8>() && prep_kernel<9>()
          && prep_kernel<10>() && prep_kernel<11>() && prep_kernel<12>() && prep_kernel<13>() && prep_kernel<14>() && prep_kernel<15>() && prep_kernel<16>();
#endif
        if (!ok) { grid = -1; return; }
        (void)hipGetLastError();
        grid = cus;
    }
    if (grid < 0) return;
    (void)hipMemsetAsync((char*)d_ws + WS_CTL, 0, CTL_BYTES, stream);
    Args a{};
    for (int i = 0; i < 32; ++i) a.in[i] = d_in[i];
    a.out = (float*)d_out; a.ws = (unsigned char*)d_ws;
#if MK_ONE_LAUNCH
    a.l_lo = 0; a.l_hi = NL;
    hipLaunchKernelGGL(fwd_kernel<-1>, dim3(grid), dim3(NTHREADS), LDS_BYTES, stream, a);
#else
    launch_kind<0>(grid, stream, a, 0);
    for (int l = 0; l < NL; ++l) {
        launch_kind<1>(grid, stream, a, l); launch_kind<2>(grid, stream, a, l); launch_kind<3>(grid, stream, a, l); launch_kind<4>(grid, stream, a, l); launch_kind<5>(grid, stream, a, l);
        launch_kind<6>(grid, stream, a, l); launch_kind<7>(grid, stream, a, l); launch_kind<8>(grid, stream, a, l); launch_kind<9>(grid, stream, a, l); launch_kind<10>(grid, stream, a, l);
        launch_kind<11>(grid, stream, a, l); launch_kind<12>(grid, stream, a, l); launch_kind<13>(grid, stream, a, l); launch_kind<14>(grid, stream, a, l); launch_kind<15>(grid, stream, a, l);
    }
    launch_kind<16>(grid, stream, a, 0);
#endif
}
```

```cpp
#include <hip/hip_runtime.h>
#include <stdint.h>
#include <cstdio>

#ifndef PROBE_DOUBLE
#define PROBE_DOUBLE 0
#endif
#ifndef MK_ONE_LAUNCH
#define MK_ONE_LAUNCH 1
#endif

#define LAS __attribute__((address_space(3)))
typedef unsigned short bf16_t;
typedef short bf16x8 __attribute__((ext_vector_type(8)));
typedef float f32x4 __attribute__((ext_vector_type(4)));
typedef float f32x16 __attribute__((ext_vector_type(16)));
typedef unsigned u32x4 __attribute__((ext_vector_type(4)));
typedef unsigned u32x2 __attribute__((ext_vector_type(2)));

constexpr int NB = 2, T = 8192, D = 1024, M = NB * T, NL = 2;
constexpr int DIN = 6336;
constexpr int P1W = 3328;
constexpr int C_NQ = 0, C_NKV = 512, C_CQ = 1280, C_CKV = 1536, C_KR = 1664, C_NG = 1696, C_FF = 1720, C_FQKV = 1728;
constexpr int NEXP = 32, EDIM = 256;
constexpr float EPS = 1e-6f;
constexpr float LOG2E = 1.4426950408889634f;
constexpr float QSCALE64 = 0.125f * LOG2E, QSCALE96 = 0.10206207261596575f * LOG2E;
constexpr int NTHREADS = 512, NWAVES = 8;
constexpr int LDS_BYTES = 147456;
constexpr int MOE_MAXROWS = 40960;

constexpr size_t MiB = 1u << 20;
constexpr size_t WS_CTL = 0;
constexpr size_t CTL_BYTES = 1 * MiB;
constexpr int CW_BAR = 4096;
constexpr int CW_QUEUE = 16384;
constexpr int CW_MOECNT = 32768;
constexpr int CW_CNTB = 65536;
constexpr size_t CTL_LTOK = 512 * 1024;
constexpr size_t WS_WINT = 1 * MiB;
constexpr size_t WS_WMT = 14 * MiB;
constexpr size_t WS_WUQT = 26 * MiB;
constexpr size_t WS_WUKVT = 27 * MiB;
constexpr size_t WS_WOT = 28 * MiB;
constexpr size_t WS_WOUTT = 34 * MiB;
constexpr size_t WS_WC1T = 38 * MiB;
constexpr size_t WS_ROPE = 42 * MiB;
constexpr size_t WS_TAB = 44 * MiB;
constexpr size_t WS_XA = 45 * MiB;
constexpr size_t PB = 109 * MiB;
constexpr size_t WS_P1 = PB;
constexpr size_t WS_QB = PB + 104 * MiB;
constexpr size_t WS_KVB = PB + 128 * MiB;
constexpr size_t WS_OUTA = PB + 160 * MiB;
constexpr size_t WS_OUTB = PB + 176 * MiB;
constexpr size_t WS_OUTC = PB + 192 * MiB;
constexpr size_t WS_H0 = PB + 176 * MiB;
constexpr size_t WS_SM = PB + 208 * MiB;
constexpr size_t WS_RSTD = WS_SM;
constexpr size_t WS_KR = WS_SM + 256 * 1024;
constexpr size_t WS_LF = WS_SM + 1280 * 1024;
constexpr size_t WS_CUM = WS_SM + 1792 * 1024;
constexpr size_t WS_HC = WS_SM + 2304 * 1024;
constexpr size_t WS_KC = WS_SM + 3328 * 1024;
constexpr size_t WS_VC = WS_SM + 3584 * 1024;
constexpr size_t WS_REC = WS_SM + 3840 * 1024;
constexpr size_t WS_LTOK = WS_SM + 4352 * 1024;
constexpr size_t WS_LW = WS_SM + 4608 * 1024;
constexpr size_t WS_LSLOT = WS_SM + 4864 * 1024;
constexpr size_t WS_END = PB + 216 * MiB;
constexpr size_t WS_HG = PB;
constexpr size_t WS_GATES = PB + 32 * MiB;
constexpr size_t WS_MIXED = PB + 128 * MiB;
constexpr size_t WS_H2 = PB;
constexpr size_t WS_WGU = PB + 32 * MiB;
constexpr size_t WS_WDT = PB + 64 * MiB;
constexpr size_t WS_HID = PB + 80 * MiB;
constexpr size_t WS_Y = PB + 100 * MiB;
static_assert(WS_Y + 64 * MiB <= WS_H0, "Y must not overlap H0");
static_assert(WS_END <= 332 * MiB, "workspace budget");

__device__ __forceinline__ float bf2f(bf16_t v) { return __uint_as_float((unsigned)v << 16); }
__device__ __forceinline__ unsigned f2bf(float f) { unsigned u = __float_as_uint(f); return (u + 0x7fffu + ((u >> 16) & 1u)) >> 16; }
__device__ __forceinline__ unsigned pk2(float lo, float hi) { return f2bf(lo) | (f2bf(hi) << 16); }
template <int CTRL> __device__ __forceinline__ float dpp_f(float v) { return __int_as_float(__builtin_amdgcn_update_dpp(0, __float_as_int(v), CTRL, 0xf, 0xf, true)); }
__device__ __forceinline__ float wave_sum(float v) {
    v += dpp_f<0xB1>(v); v += dpp_f<0x4E>(v); v += dpp_f<0x141>(v); v += dpp_f<0x140>(v);
    const float a = __int_as_float(__builtin_amdgcn_readlane(__float_as_int(v), 0)), b = __int_as_float(__builtin_amdgcn_readlane(__float_as_int(v), 16));
    const float c2 = __int_as_float(__builtin_amdgcn_readlane(__float_as_int(v), 32)), d = __int_as_float(__builtin_amdgcn_readlane(__float_as_int(v), 48));
    return (a + b) + (c2 + d);
}
__device__ __forceinline__ float wave_max(float v) {
    v = fmaxf(v, dpp_f<0xB1>(v)); v = fmaxf(v, dpp_f<0x4E>(v)); v = fmaxf(v, dpp_f<0x141>(v)); v = fmaxf(v, dpp_f<0x140>(v));
    const float a = __int_as_float(__builtin_amdgcn_readlane(__float_as_int(v), 0)), b = __int_as_float(__builtin_amdgcn_readlane(__float_as_int(v), 16));
    const float c2 = __int_as_float(__builtin_amdgcn_readlane(__float_as_int(v), 32)), d = __int_as_float(__builtin_amdgcn_readlane(__float_as_int(v), 48));
    return fmaxf(fmaxf(a, b), fmaxf(c2, d));
}
__device__ __forceinline__ float half_sum(float v) { auto rr = __builtin_amdgcn_permlane32_swap(__float_as_uint(v), __float_as_uint(v), false, false); return __uint_as_float(rr[0]) + __uint_as_float(rr[1]); }
__device__ __forceinline__ float sigmoidf_(float x) { return 1.f / (1.f + __expf(-x)); }
__device__ __forceinline__ float gelu_tanh(float x) { const float u = 0.7978845608028654f * (x + 0.044715f * x * x * x); const float th = 1.f - 2.f / (1.f + __expf(2.f * u)); return 0.5f * x * (1.f + th); }
#define LDS_WAIT() asm volatile("s_waitcnt lgkmcnt(0)" ::: "memory")

#define XB_TMO      128
#define XB_XCNT(j)  (256  + 64 * (j))
#define XB_XSUB(j)  (1280 + 64 * (j))
#define XB_XGEN(j)  (2304 + 64 * (j))
#define XB_TOP      3328
#define XB_TOPGEN   3392
#define XCD_BAR_WORDS 3456
#define XB_SPIN_CAP (1u << 18)

__device__ __forceinline__ unsigned xb_ld(unsigned* p)              { return __hip_atomic_load(p, __ATOMIC_RELAXED, __HIP_MEMORY_SCOPE_AGENT); }
__device__ __forceinline__ unsigned xb_add(unsigned* p, unsigned v) { return __hip_atomic_fetch_add(p, v, __ATOMIC_RELAXED, __HIP_MEMORY_SCOPE_AGENT); }
__device__ __forceinline__ unsigned xb_xcc_id() { return (unsigned)__builtin_amdgcn_s_getreg((3 << 11) | 20) & 0xFu; }
#define XB_SPIN(cond, bar) do { unsigned _sp = 0; while (cond) { __builtin_amdgcn_s_sleep(1); \
    if ((++_sp & 255u) == 0u) { if (xb_ld(&(bar)[XB_TMO])) break; if (_sp > XB_SPIN_CAP) { atomicAdd(&(bar)[XB_TMO], 1u); break; } } } } while (0)

struct XcdBarrier { unsigned* bar; unsigned x; volatile LAS unsigned* st; };

__device__ __forceinline__ XcdBarrier xcd_barrier_post(unsigned* bar, volatile LAS unsigned* st) {
    XcdBarrier b; b.bar = bar; b.x = xb_xcc_id(); b.st = st;
    if (threadIdx.x == 0) (void)xb_add(&bar[XB_XCNT(b.x)], 1u);
    return b;
}
__device__ __forceinline__ void xcd_barrier_complete(unsigned* bar, unsigned x, unsigned& nloc, unsigned& nx) {
    const unsigned G = gridDim.x * gridDim.y * gridDim.z;
    unsigned sum, cnt, mine, sp = 0u;
    for (;;) {
        sum = 0u; cnt = 0u; mine = 0u;
#pragma unroll
        for (unsigned j = 0; j < 16; ++j) { const unsigned c = xb_ld(&bar[XB_XCNT(j)]); sum += c; cnt += (c > 0u) ? 1u : 0u; mine = (j == x) ? c : mine; }
        if (sum == G) break;
        __builtin_amdgcn_s_sleep(1);
        if ((++sp & 255u) == 0u) { if (xb_ld(&bar[XB_TMO])) break; if (sp > XB_SPIN_CAP) { atomicAdd(&bar[XB_TMO], 1u); break; } }
    }
    nloc = mine > 0u ? mine : 1u; nx = cnt > 0u ? cnt : 1u;
}
__device__ __forceinline__ void xcd_barrier(const XcdBarrier& b) {
    asm volatile("s_waitcnt vmcnt(0)" ::: "memory");
    __syncthreads();
    if (threadIdx.x == 0) {
        unsigned* bar = b.bar;
        __builtin_amdgcn_s_waitcnt(0);
        unsigned nloc = b.st[0], nx = b.st[1];
        if (nloc == 0u) { xcd_barrier_complete(bar, b.x, nloc, nx); b.st[0] = nloc; b.st[1] = nx; }
        const unsigned old = xb_add(&bar[XB_XSUB(b.x)], 1u);
        const unsigned gen = old / nloc;
        if (old + 1u == (gen + 1u) * nloc) {
            __builtin_amdgcn_fence(__ATOMIC_RELEASE, "agent");
            asm volatile("s_waitcnt vmcnt(0)" ::: "memory");
            const unsigned og = xb_add(&bar[XB_TOP], 1u);
            const unsigned tg = og / nx;
            if (og + 1u == (tg + 1u) * nx) xb_add(&bar[XB_TOPGEN], 1u);
            else XB_SPIN(xb_ld(&bar[XB_TOPGEN]) == tg, bar);
            __builtin_amdgcn_fence(__ATOMIC_ACQUIRE, "agent");
            xb_add(&bar[XB_XGEN(b.x)], 1u);
            asm volatile("s_waitcnt vmcnt(0)" ::: "memory");
        } else {
            XB_SPIN(xb_ld(&bar[XB_XGEN(b.x)]) == gen, bar);
            __builtin_amdgcn_fence(__ATOMIC_ACQUIRE, "agent");
            asm volatile("s_waitcnt vmcnt(0)" ::: "memory");
        }
    }
    __syncthreads();
}

namespace pg8 {
constexpr int BM = 256, BK = 64, HALF = 128, HTB = HALF * BK * 2, STAGE_BYTES = 8 * HTB;
__host__ __device__ __forceinline__ int lds_byte(int r, int c) { const int st = (r >> 4) * 2 + (c >> 5), rr = r & 15, cc = c & 31, ob = rr * 64 + cc * 2; return st * 1024 + (ob ^ (((ob >> 9) & 1) << 5)); }
__host__ __device__ __forceinline__ void stage_rc(int b, int& R, int& C) { const int st = b / 1024, sb = b % 1024, swz = sb ^ (((sb >> 9) & 1) << 5); R = (st >> 1) * 16 + swz / 64; C = (st & 1) * 32 + (swz % 64) / 2; }

struct Unit { int pm, pn; const char* A; const char* B; int aux; };
struct Cfg { unsigned lda; unsigned kstepA; unsigned ldb; int nt; const int* rowidx; };

struct DenseOrder {
    int nM, nN, nwg, G, c; const char* A; const char* B; size_t tstepA, tstepB;
    __device__ void init(int nM_, int nN_, int G_, int c_, const void* A_, size_t tstepA_, const void* B_, size_t tstepB_) { nM = nM_; nN = nN_; nwg = nM * nN; G = G_; c = c_; A = (const char*)A_; B = (const char*)B_; tstepA = tstepA_; tstepB = tstepB_; }
    __device__ bool next(int i, Unit& u) const {
        const long Lq = (long)i * G + c; if (Lq >= nwg) return false;
        int wgid = (int)Lq; { const int q = nwg / 8, r = nwg % 8, xcd = wgid % 8, off = wgid / 8; wgid = (xcd < r ? xcd * (q + 1) : r * (q + 1) + (xcd - r) * q) + off; }
        const int nig = 8 * nN, gid = wgid / nig, fm = gid * 8, gsz = (nM - fm) < 8 ? (nM - fm) : 8;
        u.pm = fm + ((wgid % nig) % gsz); u.pn = (wgid % nig) / gsz; u.A = A + (size_t)u.pm * tstepA; u.B = B + (size_t)u.pn * tstepB; u.aux = 0; return true;
    }
};

#define PG8_EPI_ROWCOL(row, col) const int row = u.pm * 256 + ai * 128 + wr * 64 + m * 16 + fr; const int col = u.pn * 256 + bj * 128 + wc * 32 + n * 16 + fq * 4;

template <bool INDEXED, class Epi, class Sched>
__device__ __forceinline__ void gemm_phase(LAS unsigned char* lds, int wid, const Cfg g, const Sched& S, const Epi& E) {
    int lane_; asm volatile("v_mbcnt_lo_u32_b32 %0, -1, 0\n\tv_mbcnt_hi_u32_b32 %0, -1, %0" : "=v"(lane_));
    const int lane = lane_, tid = wid * 64 + lane, wr = wid >> 2, wc = wid & 3, fr = lane & 15, fq = lane >> 4;
    const int nt = g.nt;
    int Rs[2], Cs[2]; unsigned voffB[2];
#pragma unroll
    for (int i = 0; i < 2; ++i) { stage_rc(tid * 16 + i * 8192, Rs[i], Cs[i]); voffB[i] = (unsigned)Rs[i] * g.ldb + (unsigned)Cs[i] * 2u; }
    const size_t kstepA = g.kstepA, kstepB = (size_t)(BK * 2);
    const size_t hstepB = (size_t)HALF * g.ldb;
    const unsigned ldsw = (unsigned)wid * 1024u;
    const int aoff = lds_byte(wr * 64 + fr, fq * 8), boff = lds_byte(wc * 32 + fr, fq * 8);
#define PG8_SA(b, h) (((b) * 2 + (h)) * HTB)
#define PG8_SB(b, h) ((4 + (b) * 2 + (h)) * HTB)
#define PG8_STAGE2(bufoff, gbase, v0, v1) do { const char* gb_ = (const char*)(gbase); asm volatile("" : "+s"(gb_)); \
        __builtin_amdgcn_global_load_lds((const unsigned*)(gb_ + (v0)), (LAS unsigned*)(lds + (bufoff) + ldsw), 16, 0, 0); \
        __builtin_amdgcn_global_load_lds((const unsigned*)(gb_ + (v1)), (LAS unsigned*)(lds + (bufoff) + ldsw + 8192), 16, 0, 0); } while (0)
#define PG8_STAGEB(bufoff, gbase) PG8_STAGE2(bufoff, gbase, voffB[0], voffB[1])
#define PG8_LDA(dst, b, h) do { _Pragma("unroll") for (int m = 0; m < 4; ++m) _Pragma("unroll") for (int k = 0; k < 2; ++k) dst[m][k] = *(const LAS bf16x8*)(lds + PG8_SA(b, h) + aoff + m * 2048 + k * 1024); } while (0)
#define PG8_LDB(dst, b, h) do { _Pragma("unroll") for (int n = 0; n < 2; ++n) _Pragma("unroll") for (int k = 0; k < 2; ++k) dst[n][k] = *(const LAS bf16x8*)(lds + PG8_SB(b, h) + boff + n * 2048 + k * 1024); } while (0)
#define PG8_MMA(ai, bj, At, Bt) do { __builtin_amdgcn_s_setprio(1); _Pragma("unroll") for (int m = 0; m < 4; ++m) _Pragma("unroll") for (int n = 0; n < 2; ++n) _Pragma("unroll") for (int k = 0; k < 2; ++k) \
        acc[ai][bj][m][n] = __builtin_amdgcn_mfma_f32_16x16x32_bf16(Bt[n][k], At[m][k], acc[ai][bj][m][n], 0, 0, 0); __builtin_amdgcn_s_setprio(0); } while (0)
#define PG8_WAIT_V(n) asm volatile("s_waitcnt vmcnt(" #n ")" ::: "memory")
#define PG8_WAIT_L(n) asm volatile("s_waitcnt lgkmcnt(" #n ")" ::: "memory")
#define PG8_BAR __builtin_amdgcn_s_barrier()
#define PG8_SCHED __builtin_amdgcn_sched_barrier(0)
    Unit cur, nxt; int ui = 0;
    if (!S.next(0, cur)) return;
    unsigned vAc[2][2], vAn[2][2];
#define PG8_SETVA(v, U) do { _Pragma("unroll") for (int h_ = 0; h_ < 2; ++h_) _Pragma("unroll") for (int i_ = 0; i_ < 2; ++i_) { \
        if constexpr (INDEXED) { const int r_ = g.rowidx[(U).aux + h_ * HALF + Rs[i_]]; v[h_][i_] = (unsigned)r_ * g.lda + (unsigned)Cs[i_] * 2u; } \
        else v[h_][i_] = (unsigned)(h_ * HALF + Rs[i_]) * g.lda + (unsigned)Cs[i_] * 2u; } } while (0)
    PG8_SETVA(vAc, cur);
    f32x4 acc[2][2][4][2];
#pragma unroll
    for (int a = 0; a < 2; ++a)
#pragma unroll
        for (int b = 0; b < 2; ++b)
#pragma unroll
            for (int m = 0; m < 4; ++m)
#pragma unroll
                for (int n = 0; n < 2; ++n) acc[a][b][m][n] = (f32x4){0.f, 0.f, 0.f, 0.f};
    bf16x8 At[4][2], B0[2][2], B1[2][2];
    const char* cA = cur.A; const char* cB = cur.B;
    PG8_STAGEB(PG8_SB(0, 0), cB); PG8_STAGEB(PG8_SB(0, 1), cB + hstepB); PG8_STAGE2(PG8_SA(0, 0), cA, vAc[0][0], vAc[0][1]); PG8_STAGE2(PG8_SA(0, 1), cA, vAc[1][0], vAc[1][1]);
    if (wr == 1) PG8_BAR;
    PG8_WAIT_V(2); PG8_BAR;
    PG8_STAGEB(PG8_SB(1, 0), cB + kstepB); PG8_STAGE2(PG8_SA(1, 0), cA + kstepA, vAc[0][0], vAc[0][1]); PG8_STAGEB(PG8_SB(1, 1), cB + hstepB + kstepB);
    PG8_WAIT_V(6); PG8_BAR;
    for (;;) {
        const bool has_next = S.next(ui + 1, nxt);
        const char* nA = has_next ? nxt.A : cA; const char* nB = has_next ? nxt.B : cB;
        if (has_next) { PG8_SETVA(vAn, nxt); } else {
#pragma unroll
            for (int h_ = 0; h_ < 2; ++h_)
#pragma unroll
                for (int i_ = 0; i_ < 2; ++i_) vAn[h_][i_] = vAc[h_][i_]; }
        for (int t = 0; t < nt; t += 2) {
            const bool last = (t == nt - 2);
            const char* a1 = cA + (size_t)(t + 1) * kstepA;
            const char* a2 = last ? nA : cA + (size_t)(t + 2) * kstepA; const char* b2 = last ? nB : cB + (size_t)(t + 2) * kstepB;
            const char* a3 = a2 + kstepA; const char* b3 = b2 + kstepB;
            const unsigned w00 = last ? vAn[0][0] : vAc[0][0], w01 = last ? vAn[0][1] : vAc[0][1], w10 = last ? vAn[1][0] : vAc[1][0], w11 = last ? vAn[1][1] : vAc[1][1];
            PG8_LDB(B0, 0, 0); PG8_LDB(B1, 0, 1); PG8_SCHED; PG8_LDA(At, 0, 0); PG8_STAGE2(PG8_SA(1, 1), a1, vAc[1][0], vAc[1][1]);
            PG8_WAIT_V(8); PG8_WAIT_L(0); PG8_BAR; PG8_MMA(0, 0, At, B0); PG8_MMA(0, 1, At, B1); PG8_BAR; PG8_SCHED;
            PG8_LDA(At, 0, 1); PG8_STAGEB(PG8_SB(0, 0), b2); PG8_STAGEB(PG8_SB(0, 1), b2 + hstepB); PG8_STAGE2(PG8_SA(0, 0), a2, w00, w01);
            PG8_WAIT_V(8); PG8_WAIT_L(0); PG8_BAR; PG8_MMA(1, 0, At, B0); PG8_MMA(1, 1, At, B1); PG8_BAR; PG8_SCHED;
            PG8_LDB(B0, 1, 0); PG8_LDB(B1, 1, 1); PG8_SCHED; PG8_LDA(At, 1, 0); PG8_STAGE2(PG8_SA(0, 1), a2, w10, w11);
            PG8_WAIT_V(8); PG8_WAIT_L(0); PG8_BAR; PG8_MMA(0, 0, At, B0); PG8_MMA(0, 1, At, B1); PG8_BAR; PG8_SCHED;
            PG8_LDA(At, 1, 1); PG8_STAGEB(PG8_SB(1, 0), b3); PG8_STAGEB(PG8_SB(1, 1), b3 + hstepB); PG8_STAGE2(PG8_SA(1, 0), a3, w00, w01);
            PG8_WAIT_V(8); PG8_WAIT_L(0); PG8_BAR; PG8_MMA(1, 0, At, B0); PG8_MMA(1, 1, At, B1); PG8_BAR; PG8_SCHED;
        }
        E(acc, cur, wr, wc, fr, fq);
        if (!has_next) break;
#pragma unroll
        for (int a = 0; a < 2; ++a)
#pragma unroll
            for (int b = 0; b < 2; ++b)
#pragma unroll
                for (int m = 0; m < 4; ++m)
#pragma unroll
                    for (int n = 0; n < 2; ++n) acc[a][b][m][n] = (f32x4){0.f, 0.f, 0.f, 0.f};
        cur = nxt; cA = nA; cB = nB; ++ui;
#pragma unroll
        for (int h_ = 0; h_ < 2; ++h_)
#pragma unroll
            for (int i_ = 0; i_ < 2; ++i_) vAc[h_][i_] = vAn[h_][i_];
    }
    PG8_WAIT_V(0);
    if (wr == 0) PG8_BAR;
    PG8_BAR;
#undef PG8_SA
#undef PG8_SB
#undef PG8_STAGE2
#undef PG8_STAGEB
#undef PG8_LDA
#undef PG8_LDB
#undef PG8_MMA
#undef PG8_WAIT_V
#undef PG8_WAIT_L
#undef PG8_BAR
#undef PG8_SCHED
#undef PG8_SETVA
}
}

constexpr int LDS_MISC = 131072;
constexpr int LDS_MOETAB = LDS_MISC + 64;
constexpr int LDS_INTAB = LDS_MISC + 512;
struct Ctx {
    float* out; unsigned char* ws; unsigned char* ws0;
    LAS unsigned char* lds;
    int tid, lane, wave, G, bid;
    __device__ __forceinline__ const void* inp(int i) const { const LAS unsigned* p = (const LAS unsigned*)(lds + LDS_INTAB) + 2 * i;
        const unsigned lo = (unsigned)__builtin_amdgcn_readfirstlane((int)p[0]), hi = (unsigned)__builtin_amdgcn_readfirstlane((int)p[1]); return (const void*)(const __attribute__((address_space(1))) char*)(((unsigned long long)hi << 32) | lo); }
    __device__ __forceinline__ const float* x() const { return (const float*)inp(0); }
    __device__ __forceinline__ const int* pos() const { return (const int*)inp(1); }
    __device__ __forceinline__ const float* rel_bias() const { return (const float*)inp(2); }
    __device__ __forceinline__ const float* norm_attn() const { return (const float*)inp(3); }
    __device__ __forceinline__ const float* w_in() const { return (const float*)inp(4); }
    __device__ __forceinline__ const float* b_merge() const { return (const float*)inp(5); }
    __device__ __forceinline__ const float* cmp_pe() const { return (const float*)inp(6); }
    __device__ __forceinline__ const float* cmp_k_w1() const { return (const float*)inp(7); }
    __device__ __forceinline__ const float* cmp_k_b1() const { return (const float*)inp(8); }
    __device__ __forceinline__ const float* cmp_k_w2() const { return (const float*)inp(9); }
    __device__ __forceinline__ const float* cmp_v_w1() const { return (const float*)inp(10); }
    __device__ __forceinline__ const float* cmp_v_b1() const { return (const float*)inp(11); }
    __device__ __forceinline__ const float* cmp_v_w2() const { return (const float*)inp(12); }
    __device__ __forceinline__ const float* mla_q_norm() const { return (const float*)inp(13); }
    __device__ __forceinline__ const float* mla_kv_norm() const { return (const float*)inp(14); }
    __device__ __forceinline__ const float* mla_w_uq() const { return (const float*)inp(15); }
    __device__ __forceinline__ const float* mla_w_uk() const { return (const float*)inp(16); }
    __device__ __forceinline__ const float* mla_w_uv() const { return (const float*)inp(17); }
    __device__ __forceinline__ const float* fox_b_f() const { return (const float*)inp(18); }
    __device__ __forceinline__ const float* w_o_nsa() const { return (const float*)inp(19); }
    __device__ __forceinline__ const float* w_o_mla() const { return (const float*)inp(20); }
    __device__ __forceinline__ const float* w_o_fox() const { return (const float*)inp(21); }
    __device__ __forceinline__ const float* w_out() const { return (const float*)inp(22); }
    __device__ __forceinline__ const float* norm_ffn() const { return (const float*)inp(23); }
    __device__ __forceinline__ const float* moe_w_grp() const { return (const float*)inp(24); }
    __device__ __forceinline__ const float* moe_b_grp() const { return (const float*)inp(25); }
    __device__ __forceinline__ const float* moe_w_router() const { return (const float*)inp(26); }
    __device__ __forceinline__ const float* moe_b_router() const { return (const float*)inp(27); }
    __device__ __forceinline__ const float* moe_w_gate() const { return (const float*)inp(28); }
    __device__ __forceinline__ const float* moe_w_up() const { return (const float*)inp(29); }
    __device__ __forceinline__ const float* moe_w_down() const { return (const float*)inp(30); }
    __device__ __forceinline__ const float* norm_final() const { return (const float*)inp(31); }
};
#define WSP(T_, off) ((T_*)(c.ws + (off)))
__device__ __forceinline__ int lane_id_volatile() { int ln; asm volatile("v_mbcnt_lo_u32_b32 %0, -1, 0\n\tv_mbcnt_hi_u32_b32 %0, -1, %0" : "=v"(ln)); return ln; }
__device__ __forceinline__ void relaunder(Ctx& c) { const int ln = lane_id_volatile(); c.lane = ln; c.tid = c.wave * 64 + ln;
    size_t z_ = 0; asm volatile("" : "+s"(z_)); c.ws = c.ws0 + z_; int g_ = c.G, b_ = c.bid, wv_ = c.wave; asm volatile("" : "+s"(g_), "+s"(b_), "+s"(wv_)); c.G = g_; c.bid = b_; c.wave = wv_; }

template <class Map>
__device__ __forceinline__ void transpose_item(const float* W, int ldw, int K, bf16_t* WT, const float* rowscale, Map srcmap, int nblk, LAS float* scr, int item, int lane, float colscale = 1.f) {
    const int kb = item / nblk, nb = item % nblk, k0 = 64 * kb, n0 = 32 * nb;
    const int sc = srcmap(n0 + (lane & 31));
#pragma unroll 8
    for (int i = 0; i < 32; ++i) { const int kk = 2 * i + (lane >> 5); float v = 0.f; if (sc >= 0) { v = W[(size_t)(k0 + kk) * ldw + sc] * colscale; if (rowscale) v *= rowscale[k0 + kk]; } scr[kk * 33 + (lane & 31)] = v; }
    LDS_WAIT(); asm volatile("" ::: "memory");
    const int cc = lane & 7;
#pragma unroll
    for (int j = 0; j < 4; ++j) { const int n = (lane >> 3) + 8 * j; const LAS float* s = scr + (8 * cc) * 33 + n;
        u32x4 o; o.x = pk2(s[0 * 33], s[1 * 33]); o.y = pk2(s[2 * 33], s[3 * 33]); o.z = pk2(s[4 * 33], s[5 * 33]); o.w = pk2(s[6 * 33], s[7 * 33]);
        *(u32x4*)(WT + (size_t)(n0 + n) * K + k0 + 8 * cc) = o; }
    LDS_WAIT(); asm volatile("" ::: "memory");
}
struct MapId { int off; __device__ int operator()(int n) const { return n + off; } };
struct MapInproj { __device__ int operator()(int n) const { if (n < 1280) return n; if (n < 1696) return n + 24; if (n < 1720) return n - 416; if (n < 1728) return n + 1536; if (n < 3264) return n - 8; return -1; } };
struct MapUq { __device__ int operator()(int n) const { if (n < 512) return (n >> 6) * 96 + (n & 63); const int r = n - 512; return (r >> 5) * 96 + 64 + (r & 31); } };
struct MapPad128 { __device__ int operator()(int n) const { return n < 128 ? n : -1; } };
struct MapGU { __device__ int operator()(int n) const { return (n >> 8) * 128 + (n & 127); } };

__device__ __forceinline__ int rel_bucket_dev(int n) {
    if (n < 16) return n;
    const float lr = __logf((float)n / 16.f) / 2.0794415416798357f;
    int large = 16 + (int)(lr * 16.f);
    return large < 31 ? large : 31;
}

__device__ __forceinline__ void phase_prologue(const Ctx& c) {
    LAS float* scr = (LAS float*)(c.lds + c.wave * 16384);
    const int gw = c.bid * NWAVES + c.wave, NGW = c.G * NWAVES;
    constexpr int I_WIN = 16 * (P1W / 32), I_WM = 16 * 96, I_UQ = 4 * 24, I_UK = 2 * 16, I_UV = 2 * 16, I_WO = 8 * 32, I_WOUT = 16 * 32, I_C1 = 32 * 8;
    constexpr int PER_L = I_WIN + I_WM + I_UQ + I_UK + I_UV + 3 * I_WO + I_WOUT + 2 * I_C1;
    for (int it = gw; it < NL * PER_L; it += NGW) {
        const int l = it / PER_L; int r = it % PER_L;
        if (r < I_WIN) { const int n0_ = 32 * (r % (P1W / 32)); const float cs_ = (n0_ < 512 || (n0_ >= C_FQKV && n0_ < C_FQKV + 512)) ? QSCALE64 : 1.f;
            transpose_item(c.w_in() + (size_t)l * D * DIN, DIN, D, WSP(bf16_t, WS_WINT) + (size_t)l * P1W * D, c.norm_attn() + l * D, MapInproj{}, P1W / 32, scr, r, c.lane, cs_); continue; } r -= I_WIN;
        if (r < I_WM) { transpose_item(c.w_in() + (size_t)l * D * DIN, DIN, D, WSP(bf16_t, WS_WMT) + (size_t)l * 3072 * D, c.norm_attn() + l * D, MapId{3264}, 96, scr, r, c.lane); continue; } r -= I_WM;
        if (r < I_UQ) { transpose_item(c.mla_w_uq() + (size_t)l * 256 * 768, 768, 256, WSP(bf16_t, WS_WUQT) + (size_t)l * 768 * 256, c.mla_q_norm() + l * 256, MapUq{}, 24, scr, r, c.lane, QSCALE96); continue; } r -= I_UQ;
        if (r < I_UK) { transpose_item(c.mla_w_uk() + (size_t)l * 128 * 512, 512, 128, WSP(bf16_t, WS_WUKVT) + (size_t)l * 1024 * 128, c.mla_kv_norm() + l * 128, MapId{0}, 16, scr, r, c.lane); continue; } r -= I_UK;
        if (r < I_UV) { transpose_item(c.mla_w_uv() + (size_t)l * 128 * 512, 512, 128, WSP(bf16_t, WS_WUKVT) + (size_t)l * 1024 * 128 + 512 * 128, c.mla_kv_norm() + l * 128, MapId{0}, 16, scr, r, c.lane); continue; } r -= I_UV;
        if (r < I_WO) { transpose_item(c.w_o_nsa() + (size_t)l * 512 * 1024, 1024, 512, WSP(bf16_t, WS_WOT) + ((size_t)l * 3 + 0) * 1024 * 512, nullptr, MapId{0}, 32, scr, r, c.lane); continue; } r -= I_WO;
        if (r < I_WO) { transpose_item(c.w_o_mla() + (size_t)l * 512 * 1024, 1024, 512, WSP(bf16_t, WS_WOT) + ((size_t)l * 3 + 1) * 1024 * 512, nullptr, MapId{0}, 32, scr, r, c.lane); continue; } r -= I_WO;
        if (r < I_WO) { transpose_item(c.w_o_fox() + (size_t)l * 512 * 1024, 1024, 512, WSP(bf16_t, WS_WOT) + ((size_t)l * 3 + 2) * 1024 * 512, nullptr, MapId{0}, 32, scr, r, c.lane); continue; } r -= I_WO;
        if (r < I_WOUT) { transpose_item(c.w_out() + (size_t)l * D * D, D, D, WSP(bf16_t, WS_WOUTT) + (size_t)l * D * D, nullptr, MapId{0}, 32, scr, r, c.lane); continue; } r -= I_WOUT;
        { const int kv = r / I_C1; const float* w = (kv == 0 ? c.cmp_k_w1() : c.cmp_v_w1()) + (size_t)l * 2048 * 128;
          transpose_item(w, 128, 2048, WSP(bf16_t, WS_WC1T) + ((size_t)l * 2 + kv) * 256 * 2048, nullptr, MapPad128{}, 8, scr, r % I_C1, c.lane); }
    }
    { float* rc = WSP(float, WS_ROPE); float* rs = rc + (size_t)M * 16;
      for (int i = c.bid * NTHREADS + c.tid; i < M * 16; i += c.G * NTHREADS) { const int m = i >> 4, j = i & 15;
          const float inv = exp2f(-(float)j * 0.8304820237218407f);   const float ang = (float)c.pos()[m] * inv; double rev = (double)ang * 0.15915494309189535; rev -= floor(rev); const float fr_ = (float)rev; rc[i] = __builtin_amdgcn_cosf(fr_); rs[i] = __builtin_amdgcn_sinf(fr_); } }
    float* tab = WSP(float, WS_TAB);
    if (c.bid == 0) {
        const int l = c.tid >> 8, kv = (c.tid >> 7) & 1, j = c.tid & 127;
        const float* w1 = (kv == 0 ? c.cmp_k_w1() : c.cmp_v_w1()) + (size_t)l * 2048 * 128; const float* b1 = (kv == 0 ? c.cmp_k_b1() : c.cmp_v_b1()) + l * 128; const float* pe = c.cmp_pe() + l * 2048;
        float s = b1[j]; for (int k = 0; k < 2048; ++k) s += pe[k] * w1[(size_t)k * 128 + j];
        tab[c.tid] = s;
    }
    if (c.bid == 1 % c.G) {
        for (int i = c.tid; i < 8 * 129; i += NTHREADS) { const int h = i / 129, d = i % 129; tab[512 + h * 132 + d] = c.rel_bias()[rel_bucket_dev(d) * 8 + h] * LOG2E; }
    }
}

__device__ __forceinline__ void phase_norm(const Ctx& c, const float* src, const bf16_t* y0, const bf16_t* y1, float* rout, bf16_t* hout) {
    const int gw = c.bid * NWAVES + c.wave, NGW = c.G * NWAVES;
    for (int m = gw; m < M; m += NGW) {
        const f32x4* xr = (const f32x4*)(src + (size_t)m * D) + c.lane;
        f32x4 v[4]; float s = 0.f;
#pragma unroll
        for (int j = 0; j < 4; ++j) { v[j] = xr[64 * j];
            if (y0) { const u32x2 a = *((const u32x2*)(y0 + (size_t)m * D) + c.lane + 64 * j); const u32x2 b = *((const u32x2*)(y1 + (size_t)m * D) + c.lane + 64 * j);
                v[j].x += __uint_as_float(a.x << 16) + __uint_as_float(b.x << 16); v[j].y += __uint_as_float(a.x & 0xffff0000u) + __uint_as_float(b.x & 0xffff0000u);
                v[j].z += __uint_as_float(a.y << 16) + __uint_as_float(b.y << 16); v[j].w += __uint_as_float(a.y & 0xffff0000u) + __uint_as_float(b.y & 0xffff0000u); }
            s += (v[j].x * v[j].x + v[j].y * v[j].y) + (v[j].z * v[j].z + v[j].w * v[j].w); }
        const float rstd = rsqrtf(wave_sum(s) * (1.f / D) + EPS);
        if (rout) { f32x4* ro = (f32x4*)(rout + (size_t)m * D) + c.lane;
#pragma unroll
            for (int j = 0; j < 4; ++j) ro[64 * j] = v[j]; }
        u32x2* o8 = (u32x2*)(hout + (size_t)m * D) + c.lane;
#pragma unroll
        for (int j = 0; j < 4; ++j) { u32x2 w; w.x = pk2(v[j].x * rstd, v[j].y * rstd); w.y = pk2(v[j].z * rstd, v[j].w * rstd); o8[64 * j] = w; }
    }
}
__device__ __forceinline__ void phase_final(const Ctx& c) {
    const int gw = c.bid * NWAVES + c.wave, NGW = c.G * NWAVES;
    const float* src = WSP(float, WS_XA); const bf16_t* y0 = WSP(bf16_t, WS_Y); const bf16_t* y1 = y0 + (size_t)M * D;
    for (int m = gw; m < M; m += NGW) {
        const f32x4* xr = (const f32x4*)(src + (size_t)m * D) + c.lane;
        f32x4 v[4]; float s = 0.f;
#pragma unroll
        for (int j = 0; j < 4; ++j) { v[j] = xr[64 * j];
            const u32x2 a = *((const u32x2*)(y0 + (size_t)m * D) + c.lane + 64 * j); const u32x2 b = *((const u32x2*)(y1 + (size_t)m * D) + c.lane + 64 * j);
            v[j].x += __uint_as_float(a.x << 16) + __uint_as_float(b.x << 16); v[j].y += __uint_as_float(a.x & 0xffff0000u) + __uint_as_float(b.x & 0xffff0000u);
            v[j].z += __uint_as_float(a.y << 16) + __uint_as_float(b.y << 16); v[j].w += __uint_as_float(a.y & 0xffff0000u) + __uint_as_float(b.y & 0xffff0000u);
            s += (v[j].x * v[j].x + v[j].y * v[j].y) + (v[j].z * v[j].z + v[j].w * v[j].w); }
        const float rstd = rsqrtf(wave_sum(s) * (1.f / D) + EPS);
        f32x4* ro = (f32x4*)(c.out + (size_t)m * D) + c.lane;
#pragma unroll
        for (int j = 0; j < 4; ++j) { const f32x4 g = *((const f32x4*)c.norm_final() + c.lane + 64 * j); ro[64 * j] = v[j] * rstd * g; }
    }
}

__device__ __forceinline__ void phase_prep(const Ctx& c, int l) {
    const int gw = c.bid * NWAVES + c.wave, NGW = c.G * NWAVES;
    const bf16_t* P1 = WSP(bf16_t, WS_P1); float* rstd = WSP(float, WS_RSTD); bf16_t* KR = WSP(bf16_t, WS_KR); float* LF = WSP(float, WS_LF);
    const float* rc = WSP(float, WS_ROPE); const float* rs = rc + (size_t)M * 16;
    for (int m = gw; m < M; m += NGW) {
        const bf16_t* row = P1 + (size_t)m * P1W;
        const u32x2 a = *((const u32x2*)(row + C_CQ) + c.lane);
        float q0 = __uint_as_float(a.x << 16), q1 = __uint_as_float(a.x & 0xffff0000u), q2 = __uint_as_float(a.y << 16), q3 = __uint_as_float(a.y & 0xffff0000u);
        const float sq = wave_sum(q0 * q0 + q1 * q1 + q2 * q2 + q3 * q3);
        const unsigned b = *((const unsigned*)(row + C_CKV) + c.lane);
        float k0 = __uint_as_float(b << 16), k1 = __uint_as_float(b & 0xffff0000u);
        const float sk = wave_sum(k0 * k0 + k1 * k1);
        if (c.lane == 0) { rstd[2 * m] = rsqrtf(sq * (1.f / 256.f) + EPS); rstd[2 * m + 1] = rsqrtf(sk * (1.f / 128.f) + EPS); }
        if (c.lane < 16) { const float x1 = bf2f(row[C_KR + c.lane]), x2 = bf2f(row[C_KR + 16 + c.lane]); const float cs = rc[m * 16 + c.lane], sn = rs[m * 16 + c.lane];
            KR[m * 32 + c.lane] = (bf16_t)f2bf(x1 * cs - x2 * sn); KR[m * 32 + 16 + c.lane] = (bf16_t)f2bf(x1 * sn + x2 * cs); }
        if (c.lane < 8) { const float f = bf2f(row[C_FF + c.lane]) + c.fox_b_f()[l * 8 + c.lane];
            const float ls = fminf(f, 0.f) - __logf(1.f + __expf(-fabsf(f)));
            const int bb = m / T, t = m % T; LF[((size_t)bb * 8 + c.lane) * T + t] = ls; }
    }
}
__device__ __forceinline__ void phase_cum(const Ctx& c) {
    LAS float* sh = (LAS float*)c.lds;
    for (int s = c.bid; s < NB * 8; s += c.G) {
        const float* lf = WSP(float, WS_LF) + (size_t)s * T; float* cum = WSP(float, WS_CUM) + (size_t)s * T;
        float v[16]; float tot = 0.f;
#pragma unroll
        for (int j = 0; j < 16; ++j) { v[j] = lf[c.tid * 16 + j]; tot += v[j]; }
        sh[c.tid] = tot; __syncthreads();
        if (c.tid == 0) { float run = 0.f; for (int i = 0; i < NTHREADS; ++i) { const float t_ = sh[i]; sh[i] = run; run += t_; } }
        __syncthreads();
        float run = sh[c.tid];
#pragma unroll
        for (int j = 0; j < 16; ++j) { run += v[j]; cum[c.tid * 16 + j] = run * LOG2E; }
        __syncthreads();
    }
}
__device__ __forceinline__ void phase_cmp2_ropeq(const Ctx& c, int l) {
    const bf16_t* HC = WSP(bf16_t, WS_HC);
    for (int i = c.bid * NTHREADS + c.tid; i < 2 * 2048 * 64; i += c.G * NTHREADS) {
        const int kv = i / (2048 * 64), row = (i / 64) % 2048, d = i % 64;
        const float* w2 = (kv == 0 ? c.cmp_k_w2() : c.cmp_v_w2()) + (size_t)l * 128 * 64;
        const bf16_t* h = HC + ((size_t)kv * 2048 + row) * 128; float s = 0.f;
        for (int j = 0; j < 128; ++j) s += bf2f(h[j]) * w2[j * 64 + d];
        if ((row & 511) == 511) s = 0.f;
        (kv == 0 ? WSP(bf16_t, WS_KC) : WSP(bf16_t, WS_VC))[(size_t)row * 64 + d] = (bf16_t)f2bf(s);
    }
    bf16_t* QB = WSP(bf16_t, WS_QB); const float* rc = WSP(float, WS_ROPE); const float* rs = rc + (size_t)M * 16;
    for (int i = c.bid * NTHREADS + c.tid; i < M * 128; i += c.G * NTHREADS) {
        const int m = i >> 7, h = (i >> 4) & 7, j = i & 15;
        bf16_t* p = QB + (size_t)m * 768 + 512 + h * 32; const float x1 = bf2f(p[j]), x2 = bf2f(p[16 + j]); const float cs = rc[m * 16 + j], sn = rs[m * 16 + j];
        p[j] = (bf16_t)f2bf(x1 * cs - x2 * sn); p[16 + j] = (bf16_t)f2bf(x1 * sn + x2 * cs);
    }
}

typedef float f32x2_t __attribute__((ext_vector_type(2))); typedef __bf16 bf16x2_t __attribute__((ext_vector_type(2)));
__device__ __forceinline__ unsigned cvtpk(float lo, float hi) { f32x2_t v = {lo, hi}; bf16x2_t b = __builtin_convertvector(v, bf16x2_t); return __builtin_bit_cast(unsigned, b); }
__device__ __forceinline__ u32x2 pk4(f32x4 v) { u32x2 w; w.x = cvtpk(v.x, v.y); w.y = cvtpk(v.z, v.w); return w; }
__device__ __forceinline__ f32x4 unpk4(u32x2 a) { f32x4 r; r.x = __uint_as_float(a.x << 16); r.y = __uint_as_float(a.x & 0xffff0000u); r.z = __uint_as_float(a.y << 16); r.w = __uint_as_float(a.y & 0xffff0000u); return r; }
#define EPI_ARGS const f32x4 (&acc)[2][2][4][2], const pg8::Unit& u, int wr, int wc, int fr, int fq
#define EPI_LOOP _Pragma("unroll") for (int ai = 0; ai < 2; ++ai) _Pragma("unroll") for (int m = 0; m < 4; ++m) _Pragma("unroll") for (int bj = 0; bj < 2; ++bj) _Pragma("unroll") for (int n = 0; n < 2; ++n)

struct EpiStoreBf16 { bf16_t* O; int ldc; const float* rowscale; int rs_stride;
    __device__ __forceinline__ void operator()(EPI_ARGS) const {
        EPI_LOOP { PG8_EPI_ROWCOL(row, col); f32x4 v = acc[ai][bj][m][n]; if (rowscale) v = v * rowscale[(size_t)row * rs_stride]; *(u32x2*)(O + (size_t)row * ldc + col) = pk4(v); } } };
struct EpiGates { bf16_t* O; const float* bias;
    __device__ __forceinline__ void operator()(EPI_ARGS) const {
        EPI_LOOP { PG8_EPI_ROWCOL(row, col); f32x4 v = acc[ai][bj][m][n] + *(const f32x4*)(bias + col);
            v.x = sigmoidf_(v.x); v.y = sigmoidf_(v.y); v.z = sigmoidf_(v.z); v.w = sigmoidf_(v.w); *(u32x2*)(O + (size_t)row * 3072 + col) = pk4(v); } } };
struct EpiCmp1 { bf16_t* HC; const float* bc1;
    __device__ __forceinline__ void operator()(EPI_ARGS) const {
        const int kv = u.pm >> 3, bg = (u.pm >> 1) & 3, half = u.pm & 1;
#pragma unroll
        for (int ai = 0; ai < 2; ++ai)
#pragma unroll
            for (int m = 0; m < 4; ++m)
#pragma unroll
                for (int n = 0; n < 2; ++n) { const int i = half * 256 + ai * 128 + wr * 64 + m * 16 + fr, cc = wc * 32 + n * 16 + fq * 4;
                    f32x4 v = acc[ai][0][m][n] + *(const f32x4*)(bc1 + kv * 128 + cc);
                    v.x = gelu_tanh(v.x); v.y = gelu_tanh(v.y); v.z = gelu_tanh(v.z); v.w = gelu_tanh(v.w);
                    *(u32x2*)(HC + ((size_t)kv * 2048 + bg * 512 + i) * 128 + cc) = pk4(v); } } };
struct EpiOutproj { bf16_t* MIX; const bf16_t* GATES; int br;
    __device__ __forceinline__ void operator()(EPI_ARGS) const {
        EPI_LOOP { PG8_EPI_ROWCOL(row, col); const f32x4 g = unpk4(*(const u32x2*)(GATES + (size_t)row * 3072 + br * 1024 + col)); f32x4 v = acc[ai][bj][m][n] * g;
            u32x2* p = (u32x2*)(MIX + (size_t)row * 1024 + col); if (br > 0) v = v + unpk4(*p); *p = pk4(v); } } };
struct EpiWout { const float* R; float* XA;
    __device__ __forceinline__ void operator()(EPI_ARGS) const {
        EPI_LOOP { PG8_EPI_ROWCOL(row, col); const f32x4 r = *(const f32x4*)(R + (size_t)row * 1024 + col); *(f32x4*)(XA + (size_t)row * 1024 + col) = r + acc[ai][bj][m][n]; } } };
struct EpiMoe1 { bf16_t* HID; const float* LW;
    __device__ __forceinline__ void operator()(EPI_ARGS) const {
#pragma unroll
        for (int ai = 0; ai < 2; ++ai)
#pragma unroll
            for (int m = 0; m < 4; ++m) { int aux_ = u.aux; asm volatile("" : "+s"(aux_)); const unsigned pos = (unsigned)(aux_ + ai * 128 + wr * 64 + m * 16 + fr); const float w = LW[pos];
#pragma unroll
                for (int n = 0; n < 2; ++n) { const f32x4 g = acc[ai][0][m][n], up = acc[ai][1][m][n]; f32x4 h;
                    h.x = g.x * sigmoidf_(g.x) * up.x * w; h.y = g.y * sigmoidf_(g.y) * up.y * w; h.z = g.z * sigmoidf_(g.z) * up.z * w; h.w = g.w * sigmoidf_(g.w) * up.w * w;
                    *(u32x2*)(HID + pos * 256u + (unsigned)(u.pn * 128 + wc * 32 + n * 16 + fq * 4)) = pk4(h); }
                asm volatile("" ::: "memory"); } } };
struct EpiMoe2 { bf16_t* Y; const unsigned* LDST;
    __device__ __forceinline__ void operator()(EPI_ARGS) const {
#pragma unroll
        for (int ai = 0; ai < 2; ++ai)
#pragma unroll
            for (int m = 0; m < 4; ++m) { int aux_ = u.aux; asm volatile("" : "+s"(aux_)); const unsigned pos = (unsigned)(aux_ + ai * 128 + wr * 64 + m * 16 + fr); const unsigned d0 = LDST[pos];
                if (d0 != 0xFFFFFFFFu) { const unsigned off = d0 + (unsigned)(u.pn * 256 + wc * 32 + fq * 4);
#pragma unroll
                    for (int bj = 0; bj < 2; ++bj)
#pragma unroll
                        for (int n = 0; n < 2; ++n) *(u32x2*)(Y + off + bj * 128 + n * 16) = pk4(acc[ai][bj][m][n]); }
                asm volatile("" ::: "memory"); } } };

struct CmpOrder { int G, c; const char* P1; const char* W;
    __device__ bool next(int i, pg8::Unit& u) const { const int L_ = i * G + c; if (L_ >= 16) return false; const int kv = L_ >> 3, b = (L_ >> 2) & 1, g = (L_ >> 1) & 1, half = L_ & 1;
        u.pm = L_; u.pn = 0; u.aux = 0; u.A = P1 + ((size_t)(b * T + 16 * 256 * half) * P1W + C_NKV + (kv * 2 + g) * 64) * 2; u.B = W + (size_t)kv * 256 * 2048 * 2; return true; } };
struct MoeOrder { int G, c, nN; const LAS int* tab; const char* A; size_t a_rowbytes; const char* W; size_t w_expert, w_tile;
    __device__ bool next(int i, pg8::Unit& u) const { const int L_ = i * G + c; const int NT = __builtin_amdgcn_readfirstlane(tab[32]); if (L_ >= NT * nN) return false; const int rt = L_ / nN, pn = L_ % nN;
        int e = 0; while (__builtin_amdgcn_readfirstlane(tab[e + 1]) <= rt) ++e;
        const int off_e = __builtin_amdgcn_readfirstlane(tab[33 + e]), ts_e = __builtin_amdgcn_readfirstlane(tab[e]), cnt_e = __builtin_amdgcn_readfirstlane(tab[66 + e]);
        const int pos0 = off_e + 256 * (rt - ts_e); u.pn = pn; u.aux = pos0; u.pm = off_e + cnt_e;
        u.A = A + (size_t)pos0 * a_rowbytes; u.B = W + (size_t)e * w_expert + (size_t)pn * w_tile; return true; } };
__device__ __forceinline__ void moe_tables(const Ctx& c, int l, LAS int* tab) {
    if (c.tid == 0) { const unsigned* cnt = WSP(unsigned, WS_CTL) + CW_MOECNT + l * 64; int ts = 0, off = 0;
        for (int e = 0; e < 32; ++e) { const int n = (int)cnt[e]; tab[e] = ts; tab[33 + e] = off; tab[66 + e] = n; const int nt_ = (n + 255) >> 8; ts += nt_; off += nt_ * 256; }
        tab[32] = ts; tab[65] = off; }
    __syncthreads();
}

constexpr int LDS_RSM = LDS_MISC + 1024;
__device__ __forceinline__ void phase_router(const Ctx& c, int l, int dummy = 0) {
    const int gw = c.bid * NWAVES + c.wave, NGW = c.G * NWAVES, lane = c.lane;
    const float* XA = WSP(float, WS_XA); bf16_t* H2 = WSP(bf16_t, WS_H2); int* REC = WSP(int, dummy ? WS_HID : WS_REC); unsigned* cnt = WSP(unsigned, WS_CTL) + CW_MOECNT + (l + 2 * dummy) * 64;
    const float* g2 = c.norm_ffn() + l * D; const float* wg = c.moe_w_grp() + (size_t)l * D * 4; const float* wr_ = c.moe_w_router() + (size_t)l * D * 32;
    const float* bgp = c.moe_b_grp() + l * 4; const float* brp = c.moe_b_router() + l * 32;
    LAS f32x4* Tk = (LAS f32x4*)(c.lds + c.wave * 16384);
    LAS float* PG = (LAS float*)(c.lds + LDS_RSM + c.wave * 1792); LAS float* EL = PG + 256; LAS float* GL = EL + 128;
    LAS unsigned* cntL = (LAS unsigned*)(c.lds + LDS_MOETAB);
    if (c.tid < 32) cntL[c.tid] = 0u;
    __syncthreads();
    for (int task = gw; task < M / 4; task += NGW) {
        const int m0 = task * 4;
        f32x4 v[4][4]; float rs[4];
#pragma unroll
        for (int r = 0; r < 4; ++r) { const f32x4* xr = (const f32x4*)(XA + (size_t)(m0 + r) * D) + lane; float s = 0.f;
#pragma unroll
            for (int j = 0; j < 4; ++j) { v[r][j] = xr[64 * j]; s += (v[r][j].x * v[r][j].x + v[r][j].y * v[r][j].y) + (v[r][j].z * v[r][j].z + v[r][j].w * v[r][j].w); }
            rs[r] = rsqrtf(wave_sum(s) * (1.f / D) + EPS); }
#pragma unroll
        for (int j = 0; j < 4; ++j) { const f32x4 gg = *((const f32x4*)g2 + lane + 64 * j);
#pragma unroll
            for (int r = 0; r < 4; ++r) { v[r][j] = v[r][j] * rs[r]; *((u32x2*)(H2 + (size_t)(m0 + r) * D) + lane + 64 * j) = pk4(v[r][j]); v[r][j] = v[r][j] * gg; }
#pragma unroll
            for (int e = 0; e < 4; ++e) { f32x4 t4; t4.x = v[0][j][e]; t4.y = v[1][j][e]; t4.z = v[2][j][e]; t4.w = v[3][j][e]; Tk[4 * lane + 256 * j + e] = t4; } }
        LDS_WAIT(); asm volatile("" ::: "memory");
        { const int o = lane & 31, sh = lane >> 5; f32x4 acc = {0.f, 0.f, 0.f, 0.f}; const float* wp = wr_ + (size_t)(512 * sh) * 32 + o; const LAS f32x4* tp = Tk + 512 * sh;
#pragma unroll 1
          for (int kb = 0; kb < 512; kb += 32) { float w[32];
#pragma unroll
              for (int i = 0; i < 32; ++i) w[i] = wp[(size_t)(kb + i) * 32];
              __builtin_amdgcn_sched_barrier(0);
#pragma unroll
              for (int i = 0; i < 32; ++i) acc += tp[kb + i] * w[i]; }
          acc.x = half_sum(acc.x); acc.y = half_sum(acc.y); acc.z = half_sum(acc.z); acc.w = half_sum(acc.w);
          if (lane < 32) { const float bb = brp[o]; EL[0 * 32 + o] = acc.x + bb; EL[1 * 32 + o] = acc.y + bb; EL[2 * 32 + o] = acc.z + bb; EL[3 * 32 + o] = acc.w + bb; } }
        { const int og = lane & 3, s16 = lane >> 2; f32x4 acc = {0.f, 0.f, 0.f, 0.f}; const float* wp = wg + (size_t)(64 * s16) * 4 + og; const LAS f32x4* tp = Tk + 64 * s16;
#pragma unroll 1
          for (int kb = 0; kb < 64; kb += 32) { float w[32];
#pragma unroll
              for (int i = 0; i < 32; ++i) w[i] = wp[(size_t)(kb + i) * 4];
              __builtin_amdgcn_sched_barrier(0);
#pragma unroll
              for (int i = 0; i < 32; ++i) acc += tp[kb + i] * w[i]; }
          PG[(0 * 4 + og) * 16 + s16] = acc.x; PG[(1 * 4 + og) * 16 + s16] = acc.y; PG[(2 * 4 + og) * 16 + s16] = acc.z; PG[(3 * 4 + og) * 16 + s16] = acc.w; }
        LDS_WAIT(); asm volatile("" ::: "memory");
        if (lane < 16) { float s = 0.f;
#pragma unroll
            for (int q = 0; q < 16; ++q) s += PG[lane * 16 + q];
            GL[lane] = s + bgp[lane & 3]; }
        LDS_WAIT(); asm volatile("" ::: "memory");
        if (lane < 4) { const int r = lane;
            int gi = 0; float gm = GL[r * 4];
            for (int o = 1; o < 4; ++o) { const float x_ = GL[r * 4 + o]; if (x_ > gm) { gm = x_; gi = o; } }
            float gs = 0.f; for (int o = 0; o < 4; ++o) gs += __expf(GL[r * 4 + o] - gm);
            const float grp_top = 1.f / gs;
            int i1 = 0; float m1 = EL[r * 32 + gi * 8];
            for (int q = 1; q < 8; ++q) { const float x_ = EL[r * 32 + gi * 8 + q]; if (x_ > m1) { m1 = x_; i1 = q; } }
            int i2 = -1; float m2 = -3.0e38f;
            for (int q = 0; q < 8; ++q) { const float x_ = EL[r * 32 + gi * 8 + q]; if (q != i1 && x_ > m2) { m2 = x_; i2 = q; } }
            const float e2 = __expf(m2 - m1); const float w1 = grp_top / (1.f + e2), w2 = grp_top * e2 / (1.f + e2);
            const int ea = gi * 8 + i1, eb = gi * 8 + i2; const int ra = (int)atomicAdd((unsigned*)(cntL + ea), 1u), rb = (int)atomicAdd((unsigned*)(cntL + eb), 1u);
            int* rr = REC + (size_t)(m0 + r) * 8; rr[0] = ea; rr[1] = eb; rr[2] = ra; rr[3] = rb; rr[4] = __float_as_int(w1); rr[5] = __float_as_int(w2); rr[6] = c.bid; }
        LDS_WAIT(); asm volatile("" ::: "memory");
    }
    __syncthreads();
    if (c.tid < 32) { const unsigned n = cntL[c.tid]; (WSP(unsigned, WS_CTL) + CW_CNTB)[(dummy ? 8192 : 0) + c.bid * 32 + c.tid] = n; if (n) atomicAdd(cnt + c.tid, n); }
}
__device__ __forceinline__ void phase_place(const Ctx& c, int l) {
    LAS int* tab = (LAS int*)(c.lds + LDS_MOETAB);
    moe_tables(c, l, tab);
    int* LTOK = WSP(int, WS_LTOK); float* LW = WSP(float, WS_LW); unsigned* LDST = WSP(unsigned, WS_LSLOT); const int* REC = WSP(int, WS_REC);
    LAS int* BASE = (LAS int*)c.lds;
    if (c.tid < 32) { const unsigned* cb = WSP(unsigned, WS_CTL) + CW_CNTB + c.tid; int run = 0; for (int b_ = 0; b_ < c.G; ++b_) { BASE[b_ * 32 + c.tid] = run; run += (int)cb[b_ * 32]; } }
    __syncthreads();
    for (int m = c.bid * NTHREADS + c.tid; m < M; m += c.G * NTHREADS) { const int* r = REC + (size_t)m * 8;
        const int pa = tab[33 + r[0]] + BASE[r[6] * 32 + r[0]] + r[2], pb = tab[33 + r[1]] + BASE[r[6] * 32 + r[1]] + r[3];
        LTOK[pa] = m; LDST[pa] = (unsigned)m * 1024u; LW[pa] = __int_as_float(r[4]); LTOK[pb] = m; LDST[pb] = ((unsigned)M + (unsigned)m) * 1024u; LW[pb] = __int_as_float(r[5]); }
    for (int e = c.bid; e < 32; e += c.G) { const int lo = tab[33 + e] + tab[66 + e], hi2 = tab[33 + e + 1];
        for (int p = lo + c.tid; p < hi2; p += NTHREADS) { LTOK[p] = 0; LDST[p] = 0xFFFFFFFFu; LW[p] = 0.f; } }
    __syncthreads();
    LAS float* scr = (LAS float*)(c.lds + c.wave * 16384);
    const int gw = c.bid * NWAVES + c.wave, NGW = c.G * NWAVES;
    constexpr int I_GU = 16 * 16, I_DN = 4 * 32;
    for (int it = gw; it < 32 * (I_GU + I_DN); it += NGW) { const int e = it / (I_GU + I_DN); int r = it % (I_GU + I_DN);
        if (r < I_GU) { const int nb = r % 16; const bool up = ((nb * 32) & 255) >= 128;
            const float* w = (up ? c.moe_w_up() : c.moe_w_gate()) + ((size_t)l * 32 + e) * D * 256;
            transpose_item(w, 256, D, WSP(bf16_t, WS_WGU) + (size_t)e * 512 * D, c.norm_ffn() + l * D, MapGU{}, 16, scr, r, c.lane); }
        else { r -= I_GU; transpose_item(c.moe_w_down() + ((size_t)l * 32 + e) * 256 * D, D, 256, WSP(bf16_t, WS_WDT) + (size_t)e * D * 256, nullptr, MapId{0}, 32, scr, r, c.lane); } }
}

#ifndef ATT_FAST_FOX
#define ATT_FAST_FOX 1
#endif
#ifndef ATT_FAST_MLA
#define ATT_FAST_MLA 1
#endif
#ifndef ATT_FAST_NSA
#define ATT_FAST_NSA 1
#endif
namespace fa {
constexpr int KPITCH = 208, VPITCH = 192;
constexpr int KBUF = 64 * KPITCH, VBUF = 64 * VPITCH;
constexpr int L_K = 0, L_V = 2 * KBUF, L_CUM = L_V + 2 * VBUF, L_LUT = L_CUM + 512, L_PS = 57344, L_F = L_PS + 64 * 132 * 4, L_SEL = L_F + 64 * 132 * 4, L_UNI = L_SEL + 1024, L_TL = L_UNI + 16, L_TLN = L_TL + 128, L_UNIT = L_TLN + 16;
static_assert(L_LUT + 8 * 132 * 4 <= L_PS && L_UNIT + 64 <= 131072, "attention LDS map");
typedef short v4i16_t __attribute__((ext_vector_type(4)));
__device__ __forceinline__ float swap32_max(float v) { auto rr = __builtin_amdgcn_permlane32_swap(__float_as_uint(v), __float_as_uint(v), false, false); return fmaxf(__uint_as_float(rr[0]), __uint_as_float(rr[1])); }
__device__ __forceinline__ float swap32_sum(float v) { auto rr = __builtin_amdgcn_permlane32_swap(__float_as_uint(v), __float_as_uint(v), false, false); return __uint_as_float(rr[0]) + __uint_as_float(rr[1]); }
__device__ __forceinline__ float ex2(float x) { return __builtin_amdgcn_exp2f(x); }

struct KVSrc { const bf16_t* K; int kpitch; const bf16_t* K2; int k2pitch; const bf16_t* V; int vpitch; const float* cum; float cref; };
struct TileRegs { u32x4 k, k2, v; float cm; };
template <bool HAS_K2, bool HAS_CUM>
__device__ __forceinline__ void tile_load(TileRegs& R, const KVSrc& s, int kv0, int tid) {
    const int row = tid >> 3, ch = tid & 7;
    R.k = *(const u32x4*)(s.K + (size_t)(kv0 + row) * s.kpitch + ch * 8);
    R.v = *(const u32x4*)(s.V + (size_t)(kv0 + row) * s.vpitch + ch * 8);
    if constexpr (HAS_K2) { if (tid < 256) R.k2 = *(const u32x4*)(s.K2 + (size_t)(kv0 + (tid >> 2)) * s.k2pitch + (tid & 3) * 8); }
    if constexpr (HAS_CUM) { if (tid < 64) R.cm = s.cum[kv0 + tid] - s.cref; }
}
template <bool HAS_K2, bool HAS_CUM>
__device__ __forceinline__ void tile_store(const TileRegs& R, LAS unsigned char* lds, int buf, int tid) {
    const int row = tid >> 3, ch = tid & 7;
    *(LAS u32x4*)(lds + L_K + buf * KBUF + row * KPITCH + ch * 16) = R.k;
    if constexpr (HAS_K2) { if (tid < 256) *(LAS u32x4*)(lds + L_K + buf * KBUF + (tid >> 2) * KPITCH + 128 + (tid & 3) * 16) = R.k2; }
    *(LAS u32x4*)(lds + L_V + buf * VBUF + row * VPITCH + ch * 16) = R.v;
    if constexpr (HAS_CUM) { if (tid < 64) ((LAS float*)(lds + L_CUM))[buf * 64 + tid] = R.cm; }
}
template <int NKS>
__device__ __forceinline__ void qk_tile(f32x16 (&st)[2], const LAS unsigned char* lds, int buf, const bf16x8 (&qf)[NKS], int r, int hh) {
#pragma unroll
    for (int rb = 0; rb < 2; ++rb) {
        f32x16 a = {0.f, 0.f, 0.f, 0.f, 0.f, 0.f, 0.f, 0.f, 0.f, 0.f, 0.f, 0.f, 0.f, 0.f, 0.f, 0.f};
        const LAS unsigned char* kp = lds + L_K + buf * KBUF + (32 * rb + r) * KPITCH + hh * 16;
#pragma unroll
        for (int ks = 0; ks < NKS; ++ks) { const bf16x8 kf = *(const LAS bf16x8*)(kp + ks * 32); a = __builtin_amdgcn_mfma_f32_32x32x16_bf16(kf, qf[ks], a, 0, 0, 0); }
        st[rb] = a; }
}
__device__ __forceinline__ void pv_tile(f32x16 (&ot)[2], const LAS unsigned char* lds, int buf, const f32x16 (&p)[2], int lane) {
    const int i16 = lane & 15, blk = (lane >> 4) & 1, hh = lane >> 5;
    const LAS unsigned char* vb = lds + L_V + buf * VBUF + (4 * hh + (i16 >> 2)) * VPITCH + 32 * blk + 8 * (i16 & 3);
#pragma unroll
    for (int rb = 0; rb < 2; ++rb)
#pragma unroll
        for (int s_ = 0; s_ < 2; ++s_) {
            u32x4 pw; pw.x = cvtpk(p[rb][8 * s_ + 0], p[rb][8 * s_ + 1]); pw.y = cvtpk(p[rb][8 * s_ + 2], p[rb][8 * s_ + 3]); pw.z = cvtpk(p[rb][8 * s_ + 4], p[rb][8 * s_ + 5]); pw.w = cvtpk(p[rb][8 * s_ + 6], p[rb][8 * s_ + 7]);
            const bf16x8 pf = __builtin_bit_cast(bf16x8, pw);
#pragma unroll
            for (int db = 0; db < 2; ++db) { const LAS unsigned char* vp = vb + (32 * rb + 16 * s_) * VPITCH + 64 * db;
                const v4i16_t lo = __builtin_amdgcn_ds_read_tr16_b64_v4i16((LAS v4i16_t*)vp), hi = __builtin_amdgcn_ds_read_tr16_b64_v4i16((LAS v4i16_t*)(vp + 8 * VPITCH));
                const bf16x8 vf = {lo[0], lo[1], lo[2], lo[3], hi[0], hi[1], hi[2], hi[3]};
                ot[db] = __builtin_amdgcn_mfma_f32_32x32x16_bf16(vf, pf, ot[db], 0, 0, 0); } }
}
struct SmState { float m, l; };
constexpr float RESC_THR = 8.f;
__device__ __forceinline__ void sm_update(f32x16 (&st)[2], SmState& S, f32x16 (&ot)[2]) {
    float mx = fmaxf(st[0][0], st[1][0]);
#pragma unroll
    for (int i = 1; i < 16; ++i) mx = fmaxf(fmaxf(mx, st[0][i]), st[1][i]);
    mx = swap32_max(mx);
    if (__any(mx > S.m + RESC_THR)) {
        const float mn = fmaxf(S.m, mx); const float alpha = (mn == -INFINITY) ? 1.f : ex2(S.m - mn);
        S.l *= alpha; S.m = mn;
#pragma unroll
        for (int db = 0; db < 2; ++db)
#pragma unroll
            for (int i = 0; i < 16; ++i) ot[db][i] *= alpha;
    }
    const float ms = (S.m == -INFINITY) ? 0.f : S.m;
    float sum = 0.f;
#pragma unroll
    for (int rb = 0; rb < 2; ++rb)
#pragma unroll
        for (int i = 0; i < 16; ++i) { const float p = ex2(st[rb][i] - ms); st[rb][i] = p; sum += p; }
    S.l += sum;
}
__device__ __forceinline__ void sm_stats(const f32x16 (&st)[2], SmState& S) {
    float mx = fmaxf(st[0][0], st[1][0]);
#pragma unroll
    for (int i = 1; i < 16; ++i) mx = fmaxf(fmaxf(mx, st[0][i]), st[1][i]);
    mx = swap32_max(mx);
    if (__any(mx > S.m + RESC_THR)) { const float mn = fmaxf(S.m, mx); const float alpha = (mn == -INFINITY) ? 1.f : ex2(S.m - mn); S.l *= alpha; S.m = mn; }
    const float ms = (S.m == -INFINITY) ? 0.f : S.m;
    float sum = 0.f;
#pragma unroll
    for (int rb = 0; rb < 2; ++rb)
#pragma unroll
        for (int i = 0; i < 16; ++i) sum += ex2(st[rb][i] - ms);
    S.l += sum;
}
__device__ __forceinline__ void zero_acc(f32x16 (&a)[2]) {
#pragma unroll
    for (int db = 0; db < 2; ++db)
#pragma unroll
        for (int i = 0; i < 16; ++i) a[db][i] = 0.f;
}
__device__ __forceinline__ void store_ot(const f32x16 (&o)[2], float sc, bf16_t* orow, int hh) {
#pragma unroll
    for (int db = 0; db < 2; ++db)
#pragma unroll
        for (int a = 0; a < 4; ++a) { u32x2 w; w.x = cvtpk(o[db][4 * a + 0] * sc, o[db][4 * a + 1] * sc); w.y = cvtpk(o[db][4 * a + 2] * sc, o[db][4 * a + 3] * sc);
            *(u32x2*)(orow + 32 * db + 8 * a + 4 * hh) = w; }
}
#define FA_FOREACH_REG(CODE) _Pragma("unroll") for (int rb = 0; rb < 2; ++rb) _Pragma("unroll") for (int a = 0; a < 4; ++a) _Pragma("unroll") for (int e = 0; e < 4; ++e) { const int i = 4 * a + e; const int kc = 32 * rb + 8 * a + e; (void)kc; CODE }
#define FA_LAUNDER(x) asm volatile("" : "+v"(x))

template <bool IS_MLA>
__device__ __forceinline__ void dense_unit(const Ctx& c, int b, int h, int qb) {
    constexpr int NKS = IS_MLA ? 6 : 4;
    const int tid = c.tid, lane = c.lane, r = lane & 31, hh = lane >> 5, w = c.wave;
    LAS unsigned char* lds = c.lds;
    const int q0 = qb * 256, qrow = q0 + 32 * w + r; const size_t mrow = (size_t)b * T + qrow;
    KVSrc src; bf16x8 qf[NKS]; bf16_t* orow;
    if constexpr (IS_MLA) {
        const bf16_t* QB = WSP(bf16_t, WS_QB); const bf16_t* KVB = WSP(bf16_t, WS_KVB);
        src.K = KVB + (size_t)b * T * 1024 + h * 64; src.kpitch = 1024; src.K2 = WSP(bf16_t, WS_KR) + (size_t)b * T * 32; src.k2pitch = 32; src.V = KVB + (size_t)b * T * 1024 + 512 + h * 64; src.vpitch = 1024; src.cum = nullptr; src.cref = 0.f;
#pragma unroll
        for (int ks = 0; ks < 4; ++ks) qf[ks] = *(const bf16x8*)(QB + mrow * 768 + h * 64 + 16 * ks + 8 * hh);
#pragma unroll
        for (int ks = 0; ks < 2; ++ks) qf[4 + ks] = *(const bf16x8*)(QB + mrow * 768 + 512 + h * 32 + 16 * ks + 8 * hh);
        orow = WSP(bf16_t, WS_OUTB) + mrow * 512 + h * 64;
    } else {
        const bf16_t* P1 = WSP(bf16_t, WS_P1);
        src.K = P1 + (size_t)b * T * P1W + C_FQKV + 512 + h * 64; src.kpitch = P1W; src.K2 = nullptr; src.k2pitch = 0; src.V = P1 + (size_t)b * T * P1W + C_FQKV + 1024 + h * 64; src.vpitch = P1W;
        src.cum = WSP(float, WS_CUM) + ((size_t)b * 8 + h) * T; src.cref = src.cum[q0];
#pragma unroll
        for (int ks = 0; ks < 4; ++ks) qf[ks] = *(const bf16x8*)(P1 + mrow * P1W + C_FQKV + h * 64 + 16 * ks + 8 * hh);
        orow = WSP(bf16_t, WS_OUTC) + mrow * 512 + h * 64;
    }
    f32x16 st[2], ot[2]; zero_acc(ot); SmState S{-INFINITY, 0.f};
    const int nt = 4 * qb + 4;
    const int wlast = (q0 + 32 * w + 31) >> 6;
    TileRegs R;
    tile_load<IS_MLA, !IS_MLA>(R, src, 0, tid); tile_store<IS_MLA, !IS_MLA>(R, lds, 0, tid);
    if (nt > 1) tile_load<IS_MLA, !IS_MLA>(R, src, 64, tid);
    __syncthreads();
    for (int t = 0; t < nt; ++t) { const int buf = t & 1, kv0 = 64 * t;
        if (t <= wlast) {
            qk_tile<NKS>(st, lds, buf, qf, r, hh);
            if constexpr (!IS_MLA) {
#pragma unroll
                for (int rb = 0; rb < 2; ++rb)
#pragma unroll
                    for (int a = 0; a < 4; ++a) { const f32x4 ck = *(const LAS f32x4*)(lds + L_CUM + (buf * 64 + 32 * rb + 8 * a + 4 * hh) * 4);
#pragma unroll
                        for (int e = 0; e < 4; ++e) st[rb][4 * a + e] -= ck[e]; } }
            if (kv0 + 63 > q0 + 32 * w) { int lim = qrow - kv0 - 4 * hh; FA_LAUNDER(lim); FA_FOREACH_REG({ if (kc > lim) st[rb][i] = -INFINITY; }) }
            sm_update(st, S, ot);
            pv_tile(ot, lds, buf, st, lane);
        }
        if (t + 1 < nt) { tile_store<IS_MLA, !IS_MLA>(R, lds, buf ^ 1, tid); if (t + 2 < nt) tile_load<IS_MLA, !IS_MLA>(R, src, kv0 + 128, tid); }
        __syncthreads();
    }
    const float lt = swap32_sum(S.l);
    store_ot(ot, 1.f / lt, orow, hh);
}

#define FA_STREAM(SRC, NT, TILE_EXPR, BODY) do { TileRegs R_; const int nt_ = (NT); \
    if (nt_ > 0) { { const int idx = 0; tile_load<false, false>(R_, SRC, 64 * (TILE_EXPR), tid); } tile_store<false, false>(R_, lds, 0, tid); \
      if (nt_ > 1) { const int idx = 1; tile_load<false, false>(R_, SRC, 64 * (TILE_EXPR), tid); } \
      __syncthreads(); \
      for (int it_ = 0; it_ < nt_; ++it_) { const int buf = it_ & 1; int tile; { const int idx = it_; tile = (TILE_EXPR); } \
          BODY \
          if (it_ + 1 < nt_) { tile_store<false, false>(R_, lds, buf ^ 1, tid); if (it_ + 2 < nt_) { const int idx = it_ + 2; tile_load<false, false>(R_, SRC, 64 * (TILE_EXPR), tid); } } \
          __syncthreads(); } } } while (0)

__device__ __forceinline__ void nsa_unit(const Ctx& c, int b, int g, int j) {
    const int tid = c.tid, lane = c.lane, r = lane & 31, hh = lane >> 5, w = c.wave;
    LAS unsigned char* lds = c.lds;
    const int t0 = 64 * j, tl = r >> 2, hp = r & 3, tokl = 8 * w + tl, tq = t0 + tokl, head = 4 * g + hp; const size_t mrow = (size_t)b * T + tq;
    const bf16_t* P1 = WSP(bf16_t, WS_P1);
    bf16x8 qf[4];
#pragma unroll
    for (int ks = 0; ks < 4; ++ks) qf[ks] = *(const bf16x8*)(P1 + mrow * P1W + C_NQ + head * 64 + 16 * ks + 8 * hh);
    const float gc = sigmoidf_(bf2f(P1[mrow * P1W + C_NG + head * 3 + 0])), gsl = sigmoidf_(bf2f(P1[mrow * P1W + C_NG + head * 3 + 1])), gwn = sigmoidf_(bf2f(P1[mrow * P1W + C_NG + head * 3 + 2]));
    const LAS float* lutL = (const LAS float*)(lds + L_LUT) + head * 132;
    LAS float* PS = (LAS float*)(lds + L_PS); LAS float* FM = (LAS float*)(lds + L_F); LAS unsigned* SEL = (LAS unsigned*)(lds + L_SEL); LAS unsigned* UNI = (LAS unsigned*)(lds + L_UNI);
    LAS unsigned char* TL = (LAS unsigned char*)(lds + L_TL); LAS int* TLN = (LAS int*)(lds + L_TLN);
    f32x16 st[2], ot[2], otot[2]; zero_acc(otot);
    for (int i = tid; i < 2 * 64 * 132; i += NTHREADS) PS[i] = 0.f;
    if (tid < 256) SEL[tid] = 0u; if (tid < 4) UNI[tid] = 0u;
    const float bfar = lutL[128];
    const int tmin = t0 + 8 * w;
    const int n_ok_max = ((t0 + 63 - 31) >> 4) + 1; const int nct = (n_ok_max + 63) >> 6;
    KVSrc srcc; srcc.K = WSP(bf16_t, WS_KC) + (size_t)(b * 2 + g) * 512 * 64; srcc.kpitch = 64; srcc.K2 = nullptr; srcc.k2pitch = 0; srcc.V = WSP(bf16_t, WS_VC) + (size_t)(b * 2 + g) * 512 * 64; srcc.vpitch = 64; srcc.cum = nullptr; srcc.cref = 0.f;
    SmState Sc{-INFINITY, 0.f};
    FA_STREAM(srcc, nct, idx, {
        qk_tile<4>(st, lds, buf, qf, r, hh);
        if (16 * (64 * tile + 63) + 31 + 128 <= tmin) { FA_FOREACH_REG({ st[rb][i] += bfar; }) }
        else { int db_ = tq - 31 - 1024 * tile - 64 * hh; FA_LAUNDER(db_); FA_FOREACH_REG({ const int dist = db_ - 16 * kc; const float s_ = st[rb][i] + lutL[dist < 0 ? 0 : (dist > 128 ? 128 : dist)]; st[rb][i] = dist < 0 ? -INFINITY : s_; }) }
        sm_stats(st, Sc); });
    { const float lt = swap32_sum(Sc.l); const float inv = lt > 0.f ? 1.f / lt : 0.f; const float msafe = (Sc.m == -INFINITY) ? 0.f : Sc.m;
      zero_acc(ot);
      FA_STREAM(srcc, nct, idx, {
        qk_tile<4>(st, lds, buf, qf, r, hh);
        if (16 * (64 * tile + 63) + 31 + 128 <= tmin) { FA_FOREACH_REG({ st[rb][i] = ex2(st[rb][i] + bfar - msafe) * inv; }) }
        else { int db_ = tq - 31 - 1024 * tile - 64 * hh; FA_LAUNDER(db_); FA_FOREACH_REG({ const int dist = db_ - 16 * kc; const float s_ = st[rb][i] + lutL[dist < 0 ? 0 : (dist > 128 ? 128 : dist)]; st[rb][i] = dist < 0 ? 0.f : ex2(s_ - msafe) * inv; }) }
_Pragma("unroll")
        for (int rb = 0; rb < 2; ++rb)
_Pragma("unroll")
            for (int a = 0; a < 4; ++a) { float q4[4];
_Pragma("unroll")
                for (int e = 0; e < 4; ++e) { float v = st[rb][4 * a + e]; v += dpp_f<0xB1>(v); v += dpp_f<0x4E>(v); q4[e] = v; }
                if (hp == 0) { const int G = 16 * tile + 8 * rb + 2 * a + hh; PS[tokl * 132 + G] = q4[0] + 2.f * (q4[1] + q4[2] + q4[3]); FM[tokl * 132 + G] = q4[0]; } }
        pv_tile(ot, lds, buf, st, lane); });
#pragma unroll
      for (int db = 0; db < 2; ++db)
#pragma unroll
          for (int i = 0; i < 16; ++i) otot[db][i] += gc * ot[db][i]; }
    if (j + 1 <= 16) { if (tid < 64) SEL[tid * 4] = (1u << (j + 1)) - 1u; if (tid == 0) UNI[0] = (1u << (j + 1)) - 1u; }
    else {
        for (int i = tid; i < 64 * 128; i += NTHREADS) { const int tk = i >> 7, G = i & 127; if (G >= 1 && G <= j - 2) PS[tk * 132 + G] += FM[tk * 132 + G + 1]; }
        __syncthreads();
        const int tk = tid >> 3, sub = tid & 7; unsigned bits[4] = {0u, 0u, 0u, 0u};
#pragma unroll 1
        for (int k = 0; k < 16; ++k) { const int G = sub + 8 * k;
            if (G >= 1 && G <= j - 2) { const float v = PS[tk * 132 + G]; int cnt = 0;
                for (int G2 = 1; G2 <= j - 2; ++G2) { const float v2 = PS[tk * 132 + G2]; cnt += (v2 > v || (v2 == v && G2 < G)) ? 1 : 0; }
                if (cnt < 13) { if (k < 4) bits[0] |= 1u << G; else if (k < 8) bits[1] |= 1u << (G - 32); else if (k < 12) bits[2] |= 1u << (G - 64); else bits[3] |= 1u << (G - 96); } } }
        if (sub == 0) { bits[0] |= 1u; { const int G = j; if (G < 32) bits[0] |= 1u << G; else if (G < 64) bits[1] |= 1u << (G - 32); else if (G < 96) bits[2] |= 1u << (G - 64); else bits[3] |= 1u << (G - 96); }
                        { const int G = j - 1; if (G < 32) bits[0] |= 1u << G; else if (G < 64) bits[1] |= 1u << (G - 32); else if (G < 96) bits[2] |= 1u << (G - 64); else bits[3] |= 1u << (G - 96); } }
#pragma unroll
        for (int q = 0; q < 4; ++q) if (bits[q]) { atomicOr((unsigned*)(SEL + tk * 4 + q), bits[q]); atomicOr((unsigned*)(UNI + q), bits[q]); }
    }
    __syncthreads();
    if (tid == 0) { int n = 0; for (int q = 0; q < 4; ++q) { unsigned m_ = UNI[q]; while (m_) { const int bpos = __builtin_ctz(m_); m_ &= m_ - 1u; TL[n++] = (unsigned char)(32 * q + bpos); } } TLN[0] = n; }
    __syncthreads();
    const unsigned msk0 = SEL[tokl * 4 + 0], msk1 = SEL[tokl * 4 + 1], msk2 = SEL[tokl * 4 + 2], msk3 = SEL[tokl * 4 + 3];
    const int nsel = __builtin_amdgcn_readfirstlane(TLN[0]);
    { KVSrc srcs; srcs.K = P1 + (size_t)b * T * P1W + C_NKV + ((1 * 2 + 0) * 2 + g) * 64; srcs.kpitch = P1W; srcs.K2 = nullptr; srcs.k2pitch = 0; srcs.V = P1 + (size_t)b * T * P1W + C_NKV + ((1 * 2 + 1) * 2 + g) * 64; srcs.vpitch = P1W; srcs.cum = nullptr; srcs.cref = 0.f;
      SmState Ss{-INFINITY, 0.f}; zero_acc(ot);
      FA_STREAM(srcs, nsel, (int)TL[idx], {
        const int wq = tile >> 5; const unsigned mw = wq == 0 ? msk0 : wq == 1 ? msk1 : wq == 2 ? msk2 : msk3; const bool mine = (mw >> (tile & 31)) & 1u;
        if (__any(mine)) {
            qk_tile<4>(st, lds, buf, qf, r, hh);
            if (64 * tile + 63 + 128 <= tmin) { FA_FOREACH_REG({ st[rb][i] = mine ? st[rb][i] + bfar : -INFINITY; }) }
            else { int db_ = tq - 64 * tile - 4 * hh; FA_LAUNDER(db_); FA_FOREACH_REG({ const int dist = db_ - kc; const float s_ = st[rb][i] + lutL[dist < 0 ? 0 : (dist > 128 ? 128 : dist)]; st[rb][i] = (mine && dist >= 0) ? s_ : -INFINITY; }) }
            sm_update(st, Ss, ot);
            pv_tile(ot, lds, buf, st, lane); } });
      const float lt = swap32_sum(Ss.l); const float sc = lt > 0.f ? gsl / lt : 0.f;
#pragma unroll
      for (int db = 0; db < 2; ++db)
#pragma unroll
          for (int i = 0; i < 16; ++i) otot[db][i] += sc * ot[db][i]; }
    { KVSrc srcw; srcw.K = P1 + (size_t)b * T * P1W + C_NKV + ((2 * 2 + 0) * 2 + g) * 64; srcw.kpitch = P1W; srcw.K2 = nullptr; srcw.k2pitch = 0; srcw.V = P1 + (size_t)b * T * P1W + C_NKV + ((2 * 2 + 1) * 2 + g) * 64; srcw.vpitch = P1W; srcw.cum = nullptr; srcw.cref = 0.f;
      const int jlo = j - 8 > 0 ? j - 8 : 0;
      SmState Sw{-INFINITY, 0.f}; zero_acc(ot);
      FA_STREAM(srcw, j - jlo + 1, jlo + idx, {
        qk_tile<4>(st, lds, buf, qf, r, hh);
        { int db_ = tq - 64 * tile - 4 * hh; FA_LAUNDER(db_); FA_FOREACH_REG({ const int dist = db_ - kc; const float s_ = st[rb][i] + lutL[dist < 0 ? 0 : (dist > 128 ? 128 : dist)]; st[rb][i] = (dist >= 0 && dist < 512) ? s_ : -INFINITY; }) }
        sm_update(st, Sw, ot);
        pv_tile(ot, lds, buf, st, lane); });
      const float lt = swap32_sum(Sw.l); const float sc = lt > 0.f ? gwn / lt : 0.f;
#pragma unroll
      for (int db = 0; db < 2; ++db)
#pragma unroll
          for (int i = 0; i < 16; ++i) otot[db][i] += sc * ot[db][i]; }
    store_ot(otot, 1.f, WSP(bf16_t, WS_OUTA) + mrow * 512 + head * 64, hh);
}
}

__device__ __forceinline__ int next_unit(const Ctx& c, unsigned* ctr) {
    LAS int* u = (LAS int*)(c.lds + fa::L_UNIT);
    __syncthreads();
    if (c.tid == 0) u[0] = (int)__hip_atomic_fetch_add(ctr, 1u, __ATOMIC_RELAXED, __HIP_MEMORY_SCOPE_AGENT);
    __syncthreads();
    return __builtin_amdgcn_readfirstlane(u[0]);
}
__device__ __forceinline__ void phase_att_fast(const Ctx& c0, int l) {
    Ctx c = c0;
    unsigned* ctr = WSP(unsigned, WS_CTL) + CW_QUEUE + 64 * l;
    { const float* lut = WSP(float, WS_TAB) + 512; LAS float* L_ = (LAS float*)(c.lds + fa::L_LUT); for (int i = c.tid; i < 8 * 132; i += NTHREADS) L_[i] = lut[i]; }
    for (;;) {
        const int u = next_unit(c, ctr);
        if (u >= 32 * 48) break;
        relaunder(c);
        const int lv = 31 - u / 48, k = u % 48, kind = k >> 4, id = k & 15;
        if (kind == 0) { if (ATT_FAST_MLA) fa::dense_unit<true>(c, id >> 3, id & 7, lv); }
        else if (kind == 1) { if (ATT_FAST_NSA) fa::nsa_unit(c, (id >> 1) & 1, id & 1, 4 * lv + 3 - (id >> 2)); }
        else { if (ATT_FAST_FOX) fa::dense_unit<false>(c, id >> 3, id & 7, lv); }
    }
}

struct Args { const void* in[32]; float* out; unsigned char* ws; int l_lo, l_hi; };
constexpr int PH_PER_LAYER = 15, K_FINAL = 1 + PH_PER_LAYER;
template <int KIND>
__global__ void __launch_bounds__(NTHREADS, 2) fwd_kernel(Args a) {
    extern __shared__ __attribute__((aligned(16))) unsigned char lds_raw[];
    Ctx c;
    c.out = a.out; c.ws = a.ws; c.ws0 = a.ws; c.lds = (LAS unsigned char*)lds_raw;
    c.tid = threadIdx.x; c.lane = c.tid & 63; c.wave = __builtin_amdgcn_readfirstlane(c.tid >> 6); c.G = gridDim.x; c.bid = blockIdx.x;
    if (c.tid < 4) ((LAS unsigned*)(c.lds + LDS_MISC))[c.tid] = 0u;
    if (c.tid < 32) { const unsigned long long pv = (unsigned long long)a.in[c.tid]; ((LAS unsigned*)(c.lds + LDS_INTAB))[2 * c.tid] = (unsigned)pv; ((LAS unsigned*)(c.lds + LDS_INTAB))[2 * c.tid + 1] = (unsigned)(pv >> 32); }
    __syncthreads();
    XcdBarrier bar; bar.bar = WSP(unsigned, WS_CTL) + CW_BAR; bar.x = 0; bar.st = nullptr;
    if constexpr (KIND < 0) bar = xcd_barrier_post(WSP(unsigned, WS_CTL) + CW_BAR, (volatile LAS unsigned*)(c.lds + LDS_MISC));
#define IN(k) ((KIND < 0 || KIND == (k)) && (relaunder(c), true))
#define REP(p) for (int rep_ = 0; rep_ < ((PROBE_DOUBLE == (p)) ? 2 : 1); ++rep_)
#define SEAM(k) do { if constexpr (KIND < 0) { unsigned* bb_ = bar.bar; asm volatile("" : "+s"(bb_)); bar.bar = bb_; xcd_barrier(bar); } } while (0)
    LAS unsigned char* ring = c.lds;

    if (IN(0)) REP(4) { phase_prologue(c); } SEAM(0);
    for (int l = a.l_lo; l < a.l_hi; ++l) {
        constexpr int pb = 1;
        const float* resid = (l == 0) ? c.x() : WSP(float, WS_XA);
        if (IN(pb + 0)) { if (l == 0) phase_norm(c, c.x(), nullptr, nullptr, nullptr, WSP(bf16_t, WS_H0));
                          else phase_norm(c, WSP(float, WS_XA), WSP(bf16_t, WS_Y), WSP(bf16_t, WS_Y) + (size_t)M * D, WSP(float, WS_XA), WSP(bf16_t, WS_H0));
#if PROBE_DOUBLE == 6
                          if (l == 0) phase_norm(c, c.x(), nullptr, nullptr, nullptr, WSP(bf16_t, WS_HG));
                          else phase_norm(c, WSP(float, WS_XA), WSP(bf16_t, WS_Y), WSP(bf16_t, WS_Y) + (size_t)M * D, WSP(float, WS_P1), WSP(bf16_t, WS_QB));
#endif
        } SEAM(pb + 0);
        if (IN(pb + 1)) REP(2) { pg8::Cfg g{(unsigned)(D * 2), 128u, (unsigned)(D * 2), D / 64, nullptr}; pg8::DenseOrder S; S.init(M / 256, P1W / 256, c.G, c.bid, WSP(bf16_t, WS_H0), (size_t)256 * D * 2, WSP(bf16_t, WS_WINT) + (size_t)l * P1W * D, (size_t)256 * D * 2);
            EpiStoreBf16 E{WSP(bf16_t, WS_P1), P1W, nullptr, 0}; pg8::gemm_phase<false>(ring, c.wave, g, S, E); } SEAM(pb + 1);
        if (IN(pb + 2)) REP(5) { phase_prep(c, l); } SEAM(pb + 2);
        if (IN(pb + 3)) REP(5) { phase_cum(c); } SEAM(pb + 3);
        if (IN(pb + 4)) REP(2) {
            { pg8::Cfg g{(unsigned)(P1W * 2), 128u, 512u, 4, nullptr}; pg8::DenseOrder S; S.init(M / 256, 3, c.G, c.bid, WSP(bf16_t, WS_P1) + C_CQ, (size_t)256 * P1W * 2, WSP(bf16_t, WS_WUQT) + (size_t)l * 768 * 256, (size_t)256 * 512);
              EpiStoreBf16 E{WSP(bf16_t, WS_QB), 768, WSP(float, WS_RSTD), 2}; pg8::gemm_phase<false>(ring, c.wave, g, S, E); }
            { pg8::Cfg g{(unsigned)(P1W * 2), 128u, 256u, 2, nullptr}; pg8::DenseOrder S; S.init(M / 256, 4, c.G, c.bid, WSP(bf16_t, WS_P1) + C_CKV, (size_t)256 * P1W * 2, WSP(bf16_t, WS_WUKVT) + (size_t)l * 1024 * 128, (size_t)256 * 256);
              EpiStoreBf16 E{WSP(bf16_t, WS_KVB), 1024, WSP(float, WS_RSTD) + 1, 2}; pg8::gemm_phase<false>(ring, c.wave, g, S, E); }
            { pg8::Cfg g{(unsigned)(16 * P1W * 2), (unsigned)(P1W * 2), 4096u, 32, nullptr}; CmpOrder S{c.G, (c.bid + 64) % c.G, (const char*)WSP(bf16_t, WS_P1), (const char*)(WSP(bf16_t, WS_WC1T) + (size_t)l * 2 * 256 * 2048)};
              EpiCmp1 E{WSP(bf16_t, WS_HC), WSP(float, WS_TAB) + l * 256}; pg8::gemm_phase<false>(ring, c.wave, g, S, E); }
        } SEAM(pb + 4);
        if (IN(pb + 5)) { phase_cmp2_ropeq(c, l); } SEAM(pb + 5);
        if (IN(pb + 6)) { phase_att_fast(c, l);
#if PROBE_DOUBLE == 1
            phase_att_fast(c, l + 2);
#endif
        } SEAM(pb + 6);
        if (IN(pb + 7)) REP(5) { phase_norm(c, resid, nullptr, nullptr, nullptr, WSP(bf16_t, WS_HG)); } SEAM(pb + 7);
        if (IN(pb + 8)) REP(2) { pg8::Cfg g{(unsigned)(D * 2), 128u, (unsigned)(D * 2), D / 64, nullptr}; pg8::DenseOrder S; S.init(M / 256, 12, c.G, c.bid, WSP(bf16_t, WS_HG), (size_t)256 * D * 2, WSP(bf16_t, WS_WMT) + (size_t)l * 3072 * D, (size_t)256 * D * 2);
            EpiGates E{WSP(bf16_t, WS_GATES), c.b_merge() + l * 3072}; pg8::gemm_phase<false>(ring, c.wave, g, S, E); } SEAM(pb + 8);
        if (IN(pb + 9)) REP(2) {
#pragma unroll 1
            for (int br = 0; br < 3; ++br) { pg8::Cfg g{1024u, 128u, 1024u, 8, nullptr}; pg8::DenseOrder S;
                S.init(M / 256, 4, c.G, c.bid, WSP(bf16_t, br == 0 ? WS_OUTA : br == 1 ? WS_OUTB : WS_OUTC), (size_t)256 * 1024, WSP(bf16_t, WS_WOT) + ((size_t)l * 3 + br) * 1024 * 512, (size_t)256 * 1024);
                EpiOutproj E{WSP(bf16_t, WS_MIXED), WSP(bf16_t, WS_GATES), br}; pg8::gemm_phase<false>(ring, c.wave, g, S, E); }
        } SEAM(pb + 9);
        if (IN(pb + 10)) { pg8::Cfg g{(unsigned)(D * 2), 128u, (unsigned)(D * 2), D / 64, nullptr}; pg8::DenseOrder S; S.init(M / 256, 4, c.G, c.bid, WSP(bf16_t, WS_MIXED), (size_t)256 * D * 2, WSP(bf16_t, WS_WOUTT) + (size_t)l * D * D, (size_t)256 * D * 2);
            EpiWout E{resid, WSP(float, WS_XA)}; pg8::gemm_phase<false>(ring, c.wave, g, S, E);
#if PROBE_DOUBLE == 6
            { EpiWout E2{resid, (float*)(c.ws + PB + 32 * MiB)}; pg8::gemm_phase<false>(ring, c.wave, g, S, E2); }
#endif
        } SEAM(pb + 10);
        if (IN(pb + 11)) { phase_router(c, l);
#if PROBE_DOUBLE == 3
            phase_router(c, l, 1);
#endif
        } SEAM(pb + 11);
        if (IN(pb + 12)) REP(4) { phase_place(c, l); } SEAM(pb + 12);
        if (IN(pb + 13)) REP(2) { LAS int* tab = (LAS int*)(c.lds + LDS_MOETAB); moe_tables(c, l, tab);
            pg8::Cfg g{(unsigned)(D * 2), 128u, (unsigned)(D * 2), D / 64, WSP(int, WS_LTOK)}; MoeOrder S{c.G, c.bid, 2, tab, (const char*)WSP(bf16_t, WS_H2), 0, (const char*)WSP(bf16_t, WS_WGU), (size_t)512 * D * 2, (size_t)256 * D * 2};
            EpiMoe1 E{WSP(bf16_t, WS_HID), WSP(float, WS_LW)}; pg8::gemm_phase<true>(ring, c.wave, g, S, E); } SEAM(pb + 13);
        if (IN(pb + 14)) REP(2) { LAS int* tab = (LAS int*)(c.lds + LDS_MOETAB); moe_tables(c, l, tab);
            pg8::Cfg g{512u, 128u, 512u, 4, nullptr}; MoeOrder S{c.G, c.bid, 4, tab, (const char*)WSP(bf16_t, WS_HID), 512, (const char*)WSP(bf16_t, WS_WDT), (size_t)D * 256 * 2, (size_t)256 * 256 * 2};
            EpiMoe2 E{WSP(bf16_t, WS_Y), WSP(unsigned, WS_LSLOT)}; pg8::gemm_phase<false>(ring, c.wave, g, S, E); } SEAM(pb + 14);
    }
    if (IN(K_FINAL)) REP(6) { phase_final(c); }
#undef IN
#undef SEAM
}

template <int KIND> static bool prep_kernel() { return hipFuncSetAttribute((const void*)fwd_kernel<KIND>, hipFuncAttributeMaxDynamicSharedMemorySize, LDS_BYTES) == hipSuccess; }
template <int KIND> static void launch_kind(int grid, hipStream_t stream, Args a, int l) { a.l_lo = l; a.l_hi = l + 1; hipLaunchKernelGGL(fwd_kernel<KIND>, dim3(grid), dim3(NTHREADS), LDS_BYTES, stream, a); }
extern "C" void kernel_launch(void* const* d_in, const int* in_sizes, int n_in, void* d_out, int out_size, void* d_ws, size_t ws_size, hipStream_t stream) {
    static int grid = 0;
    if (grid == 0) {
        if (n_in != 32 || ws_size < WS_END) { fprintf(stderr, "kernel_launch: n_in %d ws %zu (need %zu)\n", n_in, ws_size, (size_t)WS_END); grid = -1; return; }
        int dev = 0, cus = 0;
        if (hipGetDevice(&dev) != hipSuccess || hipDeviceGetAttribute(&cus, hipDeviceAttributeMultiprocessorCount, dev) != hipSuccess) { grid = -1; return; }
        bool ok = true;
#if MK_ONE_LAUNCH
        ok = prep_kernel<-1>();
#else
        ok = prep_kernel<0>() && prep_kernel<1>() && prep_kernel<2>() && prep_kernel<3>() && prep_kernel<4>() && prep_kernel<5>() && prep_kernel<6>() && prep_kernel<7>() && prep_kernel<8>() && prep_kernel<9>()
          && prep_kernel<10>() && prep_kernel<11>() && prep_kernel<12>() && prep_kernel<13>() && prep_kernel<14>() && prep_kernel<15>() && prep_kernel<16>();
#endif
        if (!ok) { grid = -1; return; }
        (void)hipGetLastError();
        grid = cus;
    }
    if (grid < 0) return;
    (void)hipMemsetAsync((char*)d_ws + WS_CTL, 0, CTL_BYTES, stream);
    Args a{};
    for (int i = 0; i < 32; ++i) a.in[i] = d_in[i];
    a.out = (float*)d_out; a.ws = (unsigned char*)d_ws;
#if MK_ONE_LAUNCH
    a.l_lo = 0; a.l_hi = NL;
    hipLaunchKernelGGL(fwd_kernel<-1>, dim3(grid), dim3(NTHREADS), LDS_BYTES, stream, a);
#else
    launch_kind<0>(grid, stream, a, 0);
    for (int l = 0; l < NL; ++l) {
        launch_kind<1>(grid, stream, a, l); launch_kind<2>(grid, stream, a, l); launch_kind<3>(grid, stream, a, l); launch_kind<4>(grid, stream, a, l); launch_kind<5>(grid, stream, a, l);
        launch_kind<6>(grid, stream, a, l); launch_kind<7>(grid, stream, a, l); launch_kind<8>(grid, stream, a, l); launch_kind<9>(grid, stream, a, l); launch_kind<10>(grid, stream, a, l);
        launch_kind<11>(grid, stream, a, l); launch_kind<12>(grid, stream, a, l); launch_kind<13>(grid, stream, a, l); launch_kind<14>(grid, stream, a, l); launch_kind<15>(grid, stream, a, l);
    }
    launch_kind<16>(grid, stream, a, 0);
#endif
}
```

```cpp
#include <hip/hip_runtime.h>
#include <stdint.h>
#include <cstdio>

#ifndef PROBE_DOUBLE
#define PROBE_DOUBLE 0
#endif
#ifndef MK_ONE_LAUNCH
#define MK_ONE_LAUNCH 1
#endif

#define LAS __attribute__((address_space(3)))
typedef unsigned short bf16_t;
typedef short bf16x8 __attribute__((ext_vector_type(8)));
typedef float f32x4 __attribute__((ext_vector_type(4)));
typedef float f32x16 __attribute__((ext_vector_type(16)));
typedef unsigned u32x4 __attribute__((ext_vector_type(4)));
typedef unsigned u32x2 __attribute__((ext_vector_type(2)));

constexpr int NB = 2, T = 8192, D = 1024, M = NB * T, NL = 2;
constexpr int DIN = 6336;
constexpr int P1W = 3328;
constexpr int C_NQ = 0, C_NKV = 512, C_CQ = 1280, C_CKV = 1536, C_KR = 1664, C_NG = 1696, C_FF = 1720, C_FQKV = 1728;
constexpr int NEXP = 32, EDIM = 256;
constexpr float EPS = 1e-6f;
constexpr float LOG2E = 1.4426950408889634f;
constexpr float QSCALE64 = 0.125f * LOG2E, QSCALE96 = 0.10206207261596575f * LOG2E;
constexpr int NTHREADS = 512, NWAVES = 8;
constexpr int LDS_BYTES = 147456;
constexpr int MOE_MAXROWS = 40960;

constexpr size_t MiB = 1u << 20;
constexpr size_t WS_CTL = 0;
constexpr size_t CTL_BYTES = 1 * MiB;
constexpr int CW_BAR = 4096;
constexpr int CW_QUEUE = 16384;
constexpr int CW_MOECNT = 32768;
constexpr int CW_CNTB = 65536;
constexpr size_t CTL_LTOK = 512 * 1024;
constexpr size_t WS_WINT = 1 * MiB;
constexpr size_t WS_WMT = 14 * MiB;
constexpr size_t WS_WUQT = 26 * MiB;
constexpr size_t WS_WUKVT = 27 * MiB;
constexpr size_t WS_WOT = 28 * MiB;
constexpr size_t WS_WOUTT = 34 * MiB;
constexpr size_t WS_WC1T = 38 * MiB;
constexpr size_t WS_ROPE = 42 * MiB;
constexpr size_t WS_TAB = 44 * MiB;
constexpr size_t WS_XA = 45 * MiB;
constexpr size_t PB = 109 * MiB;
constexpr size_t WS_P1 = PB;
constexpr size_t WS_QB = PB + 104 * MiB;
constexpr size_t WS_KVB = PB + 128 * MiB;
constexpr size_t WS_OUTA = PB + 160 * MiB;
constexpr size_t WS_OUTB = PB + 176 * MiB;
constexpr size_t WS_OUTC = PB + 192 * MiB;
constexpr size_t WS_H0 = PB + 176 * MiB;
constexpr size_t WS_SM = PB + 208 * MiB;
constexpr size_t WS_RSTD = WS_SM;
constexpr size_t WS_KR = WS_SM + 256 * 1024;
constexpr size_t WS_LF = WS_SM + 1280 * 1024;
constexpr size_t WS_CUM = WS_SM + 1792 * 1024;
constexpr size_t WS_HC = WS_SM + 2304 * 1024;
constexpr size_t WS_KC = WS_SM + 3328 * 1024;
constexpr size_t WS_VC = WS_SM + 3584 * 1024;
constexpr size_t WS_REC = WS_SM + 3840 * 1024;
constexpr size_t WS_LTOK = WS_SM + 4352 * 1024;
constexpr size_t WS_LW = WS_SM + 4608 * 1024;
constexpr size_t WS_LSLOT = WS_SM + 4864 * 1024;
constexpr size_t WS_END = PB + 216 * MiB;
constexpr size_t WS_HG = PB;
constexpr size_t WS_GATES = PB + 32 * MiB;
constexpr size_t WS_MIXED = PB + 128 * MiB;
constexpr size_t WS_H2 = PB;
constexpr size_t WS_WGU = PB + 32 * MiB;
constexpr size_t WS_WDT = PB + 64 * MiB;
constexpr size_t WS_HID = PB + 80 * MiB;
constexpr size_t WS_Y = PB + 100 * MiB;
static_assert(WS_Y + 64 * MiB <= WS_H0, "Y must not overlap H0");
static_assert(WS_END <= 332 * MiB, "workspace budget");

__device__ __forceinline__ float bf2f(bf16_t v) { return __uint_as_float((unsigned)v << 16); }
__device__ __forceinline__ unsigned f2bf(float f) { unsigned u = __float_as_uint(f); return (u + 0x7fffu + ((u >> 16) & 1u)) >> 16; }
__device__ __forceinline__ unsigned pk2(float lo, float hi) { return f2bf(lo) | (f2bf(hi) << 16); }
template <int CTRL> __device__ __forceinline__ float dpp_f(float v) { return __int_as_float(__builtin_amdgcn_update_dpp(0, __float_as_int(v), CTRL, 0xf, 0xf, true)); }
__device__ __forceinline__ float wave_sum(float v) {
    v += dpp_f<0xB1>(v); v += dpp_f<0x4E>(v); v += dpp_f<0x141>(v); v += dpp_f<0x140>(v);
    const float a = __int_as_float(__builtin_amdgcn_readlane(__float_as_int(v), 0)), b = __int_as_float(__builtin_amdgcn_readlane(__float_as_int(v), 16));
    const float c2 = __int_as_float(__builtin_amdgcn_readlane(__float_as_int(v), 32)), d = __int_as_float(__builtin_amdgcn_readlane(__float_as_int(v), 48));
    return (a + b) + (c2 + d);
}
__device__ __forceinline__ float wave_max(float v) {
    v = fmaxf(v, dpp_f<0xB1>(v)); v = fmaxf(v, dpp_f<0x4E>(v)); v = fmaxf(v, dpp_f<0x141>(v)); v = fmaxf(v, dpp_f<0x140>(v));
    const float a = __int_as_float(__builtin_amdgcn_readlane(__float_as_int(v), 0)), b = __int_as_float(__builtin_amdgcn_readlane(__float_as_int(v), 16));
    const float c2 = __int_as_float(__builtin_amdgcn_readlane(__float_as_int(v), 32)), d = __int_as_float(__builtin_amdgcn_readlane(__float_as_int(v), 48));
    return fmaxf(fmaxf(a, b), fmaxf(c2, d));
}
__device__ __forceinline__ float half_sum(float v) { auto rr = __builtin_amdgcn_permlane32_swap(__float_as_uint(v), __float_as_uint(v), false, false); return __uint_as_float(rr[0]) + __uint_as_float(rr[1]); }
__device__ __forceinline__ float sigmoidf_(float x) { return 1.f / (1.f + __expf(-x)); }
__device__ __forceinline__ float gelu_tanh(float x) { const float u = 0.7978845608028654f * (x + 0.044715f * x * x * x); const float th = 1.f - 2.f / (1.f + __expf(2.f * u)); return 0.5f * x * (1.f + th); }
#define LDS_WAIT() asm volatile("s_waitcnt lgkmcnt(0)" ::: "memory")

#define XB_TMO      128
#define XB_XCNT(j)  (256  + 64 * (j))
#define XB_XSUB(j)  (1280 + 64 * (j))
#define XB_XGEN(j)  (2304 + 64 * (j))
#define XB_TOP      3328
#define XB_TOPGEN   3392
#define XCD_BAR_WORDS 3456
#define XB_SPIN_CAP (1u << 18)

__device__ __forceinline__ unsigned xb_ld(unsigned* p)              { return __hip_atomic_load(p, __ATOMIC_RELAXED, __HIP_MEMORY_SCOPE_AGENT); }
__device__ __forceinline__ unsigned xb_add(unsigned* p, unsigned v) { return __hip_atomic_fetch_add(p, v, __ATOMIC_RELAXED, __HIP_MEMORY_SCOPE_AGENT); }
__device__ __forceinline__ unsigned xb_xcc_id() { return (unsigned)__builtin_amdgcn_s_getreg((3 << 11) | 20) & 0xFu; }
#define XB_SPIN(cond, bar) do { unsigned _sp = 0; while (cond) { __builtin_amdgcn_s_sleep(1); \
    if ((++_sp & 255u) == 0u) { if (xb_ld(&(bar)[XB_TMO])) break; if (_sp > XB_SPIN_CAP) { atomicAdd(&(bar)[XB_TMO], 1u); break; } } } } while (0)

struct XcdBarrier { unsigned* bar; unsigned x; volatile LAS unsigned* st; };

__device__ __forceinline__ XcdBarrier xcd_barrier_post(unsigned* bar, volatile LAS unsigned* st) {
    XcdBarrier b; b.bar = bar; b.x = xb_xcc_id(); b.st = st;
    if (threadIdx.x == 0) (void)xb_add(&bar[XB_XCNT(b.x)], 1u);
    return b;
}
__device__ __forceinline__ void xcd_barrier_complete(unsigned* bar, unsigned x, unsigned& nloc, unsigned& nx) {
    const unsigned G = gridDim.x * gridDim.y * gridDim.z;
    unsigned sum, cnt, mine, sp = 0u;
    for (;;) {
        sum = 0u; cnt = 0u; mine = 0u;
#pragma unroll
        for (unsigned j = 0; j < 16; ++j) { const unsigned c = xb_ld(&bar[XB_XCNT(j)]); sum += c; cnt += (c > 0u) ? 1u : 0u; mine = (j == x) ? c : mine; }
        if (sum == G) break;
        __builtin_amdgcn_s_sleep(1);
        if ((++sp & 255u) == 0u) { if (xb_ld(&bar[XB_TMO])) break; if (sp > XB_SPIN_CAP) { atomicAdd(&bar[XB_TMO], 1u); break; } }
    }
    nloc = mine > 0u ? mine : 1u; nx = cnt > 0u ? cnt : 1u;
}
__device__ __forceinline__ void xcd_barrier(const XcdBarrier& b) {
    asm volatile("s_waitcnt vmcnt(0)" ::: "memory");
    __syncthreads();
    if (threadIdx.x == 0) {
        unsigned* bar = b.bar;
        __builtin_amdgcn_s_waitcnt(0);
        unsigned nloc = b.st[0], nx = b.st[1];
        if (nloc == 0u) { xcd_barrier_complete(bar, b.x, nloc, nx); b.st[0] = nloc; b.st[1] = nx; }
        const unsigned old = xb_add(&bar[XB_XSUB(b.x)], 1u);
        const unsigned gen = old / nloc;
        if (old + 1u == (gen + 1u) * nloc) {
            __builtin_amdgcn_fence(__ATOMIC_RELEASE, "agent");
            asm volatile("s_waitcnt vmcnt(0)" ::: "memory");
            const unsigned og = xb_add(&bar[XB_TOP], 1u);
            const unsigned tg = og / nx;
            if (og + 1u == (tg + 1u) * nx) xb_add(&bar[XB_TOPGEN], 1u);
            else XB_SPIN(xb_ld(&bar[XB_TOPGEN]) == tg, bar);
            __builtin_amdgcn_fence(__ATOMIC_ACQUIRE, "agent");
            xb_add(&bar[XB_XGEN(b.x)], 1u);
            asm volatile("s_waitcnt vmcnt(0)" ::: "memory");
        } else {
            XB_SPIN(xb_ld(&bar[XB_XGEN(b.x)]) == gen, bar);
            __builtin_amdgcn_fence(__ATOMIC_ACQUIRE, "agent");
            asm volatile("s_waitcnt vmcnt(0)" ::: "memory");
        }
    }
    __syncthreads();
}

namespace pg8 {
constexpr int BM = 256, BK = 64, HALF = 128, HTB = HALF * BK * 2, STAGE_BYTES = 8 * HTB;
__host__ __device__ __forceinline__ int lds_byte(int r, int c) { const int st = (r >> 4) * 2 + (c >> 5), rr = r & 15, cc = c & 31, ob = rr * 64 + cc * 2; return st * 1024 + (ob ^ (((ob >> 9) & 1) << 5)); }
__host__ __device__ __forceinline__ void stage_rc(int b, int& R, int& C) { const int st = b / 1024, sb = b % 1024, swz = sb ^ (((sb >> 9) & 1) << 5); R = (st >> 1) * 16 + swz / 64; C = (st & 1) * 32 + (swz % 64) / 2; }

struct Unit { int pm, pn; const char* A; const char* B; int aux; };
struct Cfg { unsigned lda; unsigned kstepA; unsigned ldb; int nt; const int* rowidx; };

struct DenseOrder {
    int nM, nN, nwg, G, c; const char* A; const char* B; size_t tstepA, tstepB;
    __device__ void init(int nM_, int nN_, int G_, int c_, const void* A_, size_t tstepA_, const void* B_, size_t tstepB_) { nM = nM_; nN = nN_; nwg = nM * nN; G = G_; c = c_; A = (const char*)A_; B = (const char*)B_; tstepA = tstepA_; tstepB = tstepB_; }
    __device__ bool next(int i, Unit& u) const {
        const long Lq = (long)i * G + c; if (Lq >= nwg) return false;
        int wgid = (int)Lq; { const int q = nwg / 8, r = nwg % 8, xcd = wgid % 8, off = wgid / 8; wgid = (xcd < r ? xcd * (q + 1) : r * (q + 1) + (xcd - r) * q) + off; }
        const int nig = 8 * nN, gid = wgid / nig, fm = gid * 8, gsz = (nM - fm) < 8 ? (nM - fm) : 8;
        u.pm = fm + ((wgid % nig) % gsz); u.pn = (wgid % nig) / gsz; u.A = A + (size_t)u.pm * tstepA; u.B = B + (size_t)u.pn * tstepB; u.aux = 0; return true;
    }
};

#define PG8_EPI_ROWCOL(row, col) const int row = u.pm * 256 + ai * 128 + wr * 64 + m * 16 + fr; const int col = u.pn * 256 + bj * 128 + wc * 32 + n * 16 + fq * 4;

template <bool INDEXED, class Epi, class Sched>
__device__ __forceinline__ void gemm_phase(LAS unsigned char* lds, int wid, const Cfg g, const Sched& S, const Epi& E) {
    int lane_; asm volatile("v_mbcnt_lo_u32_b32 %0, -1, 0\n\tv_mbcnt_hi_u32_b32 %0, -1, %0" : "=v"(lane_));
    const int lane = lane_, tid = wid * 64 + lane, wr = wid >> 2, wc = wid & 3, fr = lane & 15, fq = lane >> 4;
    const int nt = g.nt;
    int Rs[2], Cs[2]; unsigned voffB[2];
#pragma unroll
    for (int i = 0; i < 2; ++i) { stage_rc(tid * 16 + i * 8192, Rs[i], Cs[i]); voffB[i] = (unsigned)Rs[i] * g.ldb + (unsigned)Cs[i] * 2u; }
    const size_t kstepA = g.kstepA, kstepB = (size_t)(BK * 2);
    const size_t hstepB = (size_t)HALF * g.ldb;
    const unsigned ldsw = (unsigned)wid * 1024u;
    const int aoff = lds_byte(wr * 64 + fr, fq * 8), boff = lds_byte(wc * 32 + fr, fq * 8);
#define PG8_SA(b, h) (((b) * 2 + (h)) * HTB)
#define PG8_SB(b, h) ((4 + (b) * 2 + (h)) * HTB)
#define PG8_STAGE2(bufoff, gbase, v0, v1) do { const char* gb_ = (const char*)(gbase); asm volatile("" : "+s"(gb_)); \
        __builtin_amdgcn_global_load_lds((const unsigned*)(gb_ + (v0)), (LAS unsigned*)(lds + (bufoff) + ldsw), 16, 0, 0); \
        __builtin_amdgcn_global_load_lds((const unsigned*)(gb_ + (v1)), (LAS unsigned*)(lds + (bufoff) + ldsw + 8192), 16, 0, 0); } while (0)
#define PG8_STAGEB(bufoff, gbase) PG8_STAGE2(bufoff, gbase, voffB[0], voffB[1])
#define PG8_LDA(dst, b, h) do { _Pragma("unroll") for (int m = 0; m < 4; ++m) _Pragma("unroll") for (int k = 0; k < 2; ++k) dst[m][k] = *(const LAS bf16x8*)(lds + PG8_SA(b, h) + aoff + m * 2048 + k * 1024); } while (0)
#define PG8_LDB(dst, b, h) do { _Pragma("unroll") for (int n = 0; n < 2; ++n) _Pragma("unroll") for (int k = 0; k < 2; ++k) dst[n][k] = *(const LAS bf16x8*)(lds + PG8_SB(b, h) + boff + n * 2048 + k * 1024); } while (0)
#define PG8_MMA(ai, bj, At, Bt) do { __builtin_amdgcn_s_setprio(1); _Pragma("unroll") for (int m = 0; m < 4; ++m) _Pragma("unroll") for (int n = 0; n < 2; ++n) _Pragma("unroll") for (int k = 0; k < 2; ++k) \
        acc[ai][bj][m][n] = __builtin_amdgcn_mfma_f32_16x16x32_bf16(Bt[n][k], At[m][k], acc[ai][bj][m][n], 0, 0, 0); __builtin_amdgcn_s_setprio(0); } while (0)
#define PG8_WAIT_V(n) asm volatile("s_waitcnt vmcnt(" #n ")" ::: "memory")
#define PG8_WAIT_L(n) asm volatile("s_waitcnt lgkmcnt(" #n ")" ::: "memory")
#define PG8_BAR __builtin_amdgcn_s_barrier()
#define PG8_SCHED __builtin_amdgcn_sched_barrier(0)
    Unit cur, nxt; int ui = 0;
    if (!S.next(0, cur)) return;
    unsigned vAc[2][2], vAn[2][2];
#define PG8_SETVA(v, U) do { _Pragma("unroll") for (int h_ = 0; h_ < 2; ++h_) _Pragma("unroll") for (int i_ = 0; i_ < 2; ++i_) { \
        if constexpr (INDEXED) { const int r_ = g.rowidx[(U).aux + h_ * HALF + Rs[i_]]; v[h_][i_] = (unsigned)r_ * g.lda + (unsigned)Cs[i_] * 2u; } \
        else v[h_][i_] = (unsigned)(h_ * HALF + Rs[i_]) * g.lda + (unsigned)Cs[i_] * 2u; } } while (0)
    PG8_SETVA(vAc, cur);
    f32x4 acc[2][2][4][2];
#pragma unroll
    for (int a = 0; a < 2; ++a)
#pragma unroll
        for (int b = 0; b < 2; ++b)
#pragma unroll
            for (int m = 0; m < 4; ++m)
#pragma unroll
                for (int n = 0; n < 2; ++n) acc[a][b][m][n] = (f32x4){0.f, 0.f, 0.f, 0.f};
    bf16x8 At[4][2], B0[2][2], B1[2][2];
    const char* cA = cur.A; const char* cB = cur.B;
    PG8_STAGEB(PG8_SB(0, 0), cB); PG8_STAGEB(PG8_SB(0, 1), cB + hstepB); PG8_STAGE2(PG8_SA(0, 0), cA, vAc[0][0], vAc[0][1]); PG8_STAGE2(PG8_SA(0, 1), cA, vAc[1][0], vAc[1][1]);
    if (wr == 1) PG8_BAR;
    PG8_WAIT_V(2); PG8_BAR;
    PG8_STAGEB(PG8_SB(1, 0), cB + kstepB); PG8_STAGE2(PG8_SA(1, 0), cA + kstepA, vAc[0][0], vAc[0][1]); PG8_STAGEB(PG8_SB(1, 1), cB + hstepB + kstepB);
    PG8_WAIT_V(6); PG8_BAR;
    for (;;) {
        const bool has_next = S.next(ui + 1, nxt);
        const char* nA = has_next ? nxt.A : cA; const char* nB = has_next ? nxt.B : cB;
        if (has_next) { PG8_SETVA(vAn, nxt); } else {
#pragma unroll
            for (int h_ = 0; h_ < 2; ++h_)
#pragma unroll
                for (int i_ = 0; i_ < 2; ++i_) vAn[h_][i_] = vAc[h_][i_]; }
        for (int t = 0; t < nt; t += 2) {
            const bool last = (t == nt - 2);
            const char* a1 = cA + (size_t)(t + 1) * kstepA;
            const char* a2 = last ? nA : cA + (size_t)(t + 2) * kstepA; const char* b2 = last ? nB : cB + (size_t)(t + 2) * kstepB;
            const char* a3 = a2 + kstepA; const char* b3 = b2 + kstepB;
            const unsigned w00 = last ? vAn[0][0] : vAc[0][0], w01 = last ? vAn[0][1] : vAc[0][1], w10 = last ? vAn[1][0] : vAc[1][0], w11 = last ? vAn[1][1] : vAc[1][1];
            PG8_LDB(B0, 0, 0); PG8_LDB(B1, 0, 1); PG8_SCHED; PG8_LDA(At, 0, 0); PG8_STAGE2(PG8_SA(1, 1), a1, vAc[1][0], vAc[1][1]);
            PG8_WAIT_V(8); PG8_WAIT_L(0); PG8_BAR; PG8_MMA(0, 0, At, B0); PG8_MMA(0, 1, At, B1); PG8_BAR; PG8_SCHED;
            PG8_LDA(At, 0, 1); PG8_STAGEB(PG8_SB(0, 0), b2); PG8_STAGEB(PG8_SB(0, 1), b2 + hstepB); PG8_STAGE2(PG8_SA(0, 0), a2, w00, w01);
            PG8_WAIT_V(8); PG8_WAIT_L(0); PG8_BAR; PG8_MMA(1, 0, At, B0); PG8_MMA(1, 1, At, B1); PG8_BAR; PG8_SCHED;
            PG8_LDB(B0, 1, 0); PG8_LDB(B1, 1, 1); PG8_SCHED; PG8_LDA(At, 1, 0); PG8_STAGE2(PG8_SA(0, 1), a2, w10, w11);
            PG8_WAIT_V(8); PG8_WAIT_L(0); PG8_BAR; PG8_MMA(0, 0, At, B0); PG8_MMA(0, 1, At, B1); PG8_BAR; PG8_SCHED;
            PG8_LDA(At, 1, 1); PG8_STAGEB(PG8_SB(1, 0), b3); PG8_STAGEB(PG8_SB(1, 1), b3 + hstepB); PG8_STAGE2(PG8_SA(1, 0), a3, w00, w01);
            PG8_WAIT_V(8); PG8_WAIT_L(0); PG8_BAR; PG8_MMA(1, 0, At, B0); PG8_MMA(1, 1, At, B1); PG8_BAR; PG8_SCHED;
        }
        E(acc, cur, wr, wc, fr, fq);
        if (!has_next) break;
#pragma unroll
        for (int a = 0; a < 2; ++a)
#pragma unroll
            for (int b = 0; b < 2; ++b)
#pragma unroll
                for (int m = 0; m < 4; ++m)
#pragma unroll
                    for (int n = 0; n < 2; ++n) acc[a][b][m][n] = (f32x4){0.f, 0.f, 0.f, 0.f};
        cur = nxt; cA = nA; cB = nB; ++ui;
#pragma unroll
        for (int h_ = 0; h_ < 2; ++h_)
#pragma unroll
            for (int i_ = 0; i_ < 2; ++i_) vAc[h_][i_] = vAn[h_][i_];
    }
    PG8_WAIT_V(0);
    if (wr == 0) PG8_BAR;
    PG8_BAR;
#undef PG8_SA
#undef PG8_SB
#undef PG8_STAGE2
#undef PG8_STAGEB
#undef PG8_LDA
#undef PG8_LDB
#undef PG8_MMA
#undef PG8_WAIT_V
#undef PG8_WAIT_L
#undef PG8_BAR
#undef PG8_SCHED
#undef PG8_SETVA
}
}

constexpr int LDS_MISC = 131072;
constexpr int LDS_MOETAB = LDS_MISC + 64;
constexpr int LDS_INTAB = LDS_MISC + 512;
struct Ctx {
    float* out; unsigned char* ws; unsigned char* ws0;
    LAS unsigned char* lds;
    int tid, lane, wave, G, bid;
    __device__ __forceinline__ const void* inp(int i) const { const LAS unsigned* p = (const LAS unsigned*)(lds + LDS_INTAB) + 2 * i;
        const unsigned lo = (unsigned)__builtin_amdgcn_readfirstlane((int)p[0]), hi = (unsigned)__builtin_amdgcn_readfirstlane((int)p[1]); return (const void*)(const __attribute__((address_space(1))) char*)(((unsigned long long)hi << 32) | lo); }
    __device__ __forceinline__ const float* x() const { return (const float*)inp(0); }
    __device__ __forceinline__ const int* pos() const { return (const int*)inp(1); }
    __device__ __forceinline__ const float* rel_bias() const { return (const float*)inp(2); }
    __device__ __forceinline__ const float* norm_attn() const { return (const float*)inp(3); }
    __device__ __forceinline__ const float* w_in() const { return (const float*)inp(4); }
    __device__ __forceinline__ const float* b_merge() const { return (const float*)inp(5); }
    __device__ __forceinline__ const float* cmp_pe() const { return (const float*)inp(6); }
    __device__ __forceinline__ const float* cmp_k_w1() const { return (const float*)inp(7); }
    __device__ __forceinline__ const float* cmp_k_b1() const { return (const float*)inp(8); }
    __device__ __forceinline__ const float* cmp_k_w2() const { return (const float*)inp(9); }
    __device__ __forceinline__ const float* cmp_v_w1() const { return (const float*)inp(10); }
    __device__ __forceinline__ const float* cmp_v_b1() const { return (const float*)inp(11); }
    __device__ __forceinline__ const float* cmp_v_w2() const { return (const float*)inp(12); }
    __device__ __forceinline__ const float* mla_q_norm() const { return (const float*)inp(13); }
    __device__ __forceinline__ const float* mla_kv_norm() const { return (const float*)inp(14); }
    __device__ __forceinline__ const float* mla_w_uq() const { return (const float*)inp(15); }
    __device__ __forceinline__ const float* mla_w_uk() const { return (const float*)inp(16); }
    __device__ __forceinline__ const float* mla_w_uv() const { return (const float*)inp(17); }
    __device__ __forceinline__ const float* fox_b_f() const { return (const float*)inp(18); }
    __device__ __forceinline__ const float* w_o_nsa() const { return (const float*)inp(19); }
    __device__ __forceinline__ const float* w_o_mla() const { return (const float*)inp(20); }
    __device__ __forceinline__ const float* w_o_fox() const { return (const float*)inp(21); }
    __device__ __forceinline__ const float* w_out() const { return (const float*)inp(22); }
    __device__ __forceinline__ const float* norm_ffn() const { return (const float*)inp(23); }
    __device__ __forceinline__ const float* moe_w_grp() const { return (const float*)inp(24); }
    __device__ __forceinline__ const float* moe_b_grp() const { return (const float*)inp(25); }
    __device__ __forceinline__ const float* moe_w_router() const { return (const float*)inp(26); }
    __device__ __forceinline__ const float* moe_b_router() const { return (const float*)inp(27); }
    __device__ __forceinline__ const float* moe_w_gate() const { return (const float*)inp(28); }
    __device__ __forceinline__ const float* moe_w_up() const { return (const float*)inp(29); }
    __device__ __forceinline__ const float* moe_w_down() const { return (const float*)inp(30); }
    __device__ __forceinline__ const float* norm_final() const { return (const float*)inp(31); }
};
#define WSP(T_, off) ((T_*)(c.ws + (off)))
__device__ __forceinline__ int lane_id_volatile() { int ln; asm volatile("v_mbcnt_lo_u32_b32 %0, -1, 0\n\tv_mbcnt_hi_u32_b32 %0, -1, %0" : "=v"(ln)); return ln; }
__device__ __forceinline__ void relaunder(Ctx& c) { const int ln = lane_id_volatile(); c.lane = ln; c.tid = c.wave * 64 + ln;
    size_t z_ = 0; asm volatile("" : "+s"(z_)); c.ws = c.ws0 + z_; int g_ = c.G, b_ = c.bid, wv_ = c.wave; asm volatile("" : "+s"(g_), "+s"(b_), "+s"(wv_)); c.G = g_; c.bid = b_; c.wave = wv_; }

template <class Map>
__device__ __forceinline__ void transpose_item(const float* W, int ldw, int K, bf16_t* WT, const float* rowscale, Map srcmap, int nblk, LAS float* scr, int item, int lane, float colscale = 1.f) {
    const int kb = item / nblk, nb = item % nblk, k0 = 64 * kb, n0 = 32 * nb;
    const int sc = srcmap(n0 + (lane & 31));
#pragma unroll 8
    for (int i = 0; i < 32; ++i) { const int kk = 2 * i + (lane >> 5); float v = 0.f; if (sc >= 0) { v = W[(size_t)(k0 + kk) * ldw + sc] * colscale; if (rowscale) v *= rowscale[k0 + kk]; } scr[kk * 33 + (lane & 31)] = v; }
    LDS_WAIT(); asm volatile("" ::: "memory");
    const int cc = lane & 7;
#pragma unroll
    for (int j = 0; j < 4; ++j) { const int n = (lane >> 3) + 8 * j; const LAS float* s = scr + (8 * cc) * 33 + n;
        u32x4 o; o.x = pk2(s[0 * 33], s[1 * 33]); o.y = pk2(s[2 * 33], s[3 * 33]); o.z = pk2(s[4 * 33], s[5 * 33]); o.w = pk2(s[6 * 33], s[7 * 33]);
        *(u32x4*)(WT + (size_t)(n0 + n) * K + k0 + 8 * cc) = o; }
    LDS_WAIT(); asm volatile("" ::: "memory");
}
struct MapId { int off; __device__ int operator()(int n) const { return n + off; } };
struct MapInproj { __device__ int operator()(int n) const { if (n < 1280) return n; if (n < 1696) return n + 24; if (n < 1720) return n - 416; if (n < 1728) return n + 1536; if (n < 3264) return n - 8; return -1; } };
struct MapUq { __device__ int operator()(int n) const { if (n < 512) return (n >> 6) * 96 + (n & 63); const int r = n - 512; return (r >> 5) * 96 + 64 + (r & 31); } };
struct MapPad128 { __device__ int operator()(int n) const { return n < 128 ? n : -1; } };
struct MapGU { __device__ int operator()(int n) const { return (n >> 8) * 128 + (n & 127); } };

__device__ __forceinline__ int rel_bucket_dev(int n) {
    if (n < 16) return n;
    const float lr = __logf((float)n / 16.f) / 2.0794415416798357f;
    int large = 16 + (int)(lr * 16.f);
    return large < 31 ? large : 31;
}

__device__ __forceinline__ void phase_prologue(const Ctx& c) {
    LAS float* scr = (LAS float*)(c.lds + c.wave * 16384);
    const int gw = c.bid * NWAVES + c.wave, NGW = c.G * NWAVES;
    constexpr int I_WIN = 16 * (P1W / 32), I_WM = 16 * 96, I_UQ = 4 * 24, I_UK = 2 * 16, I_UV = 2 * 16, I_WO = 8 * 32, I_WOUT = 16 * 32, I_C1 = 32 * 8;
    constexpr int PER_L = I_WIN + I_WM + I_UQ + I_UK + I_UV + 3 * I_WO + I_WOUT + 2 * I_C1;
    for (int it = gw; it < NL * PER_L; it += NGW) {
        const int l = it / PER_L; int r = it % PER_L;
        if (r < I_WIN) { const int n0_ = 32 * (r % (P1W / 32)); const float cs_ = (n0_ < 512 || (n0_ >= C_FQKV && n0_ < C_FQKV + 512)) ? QSCALE64 : 1.f;
            transpose_item(c.w_in() + (size_t)l * D * DIN, DIN, D, WSP(bf16_t, WS_WINT) + (size_t)l * P1W * D, c.norm_attn() + l * D, MapInproj{}, P1W / 32, scr, r, c.lane, cs_); continue; } r -= I_WIN;
        if (r < I_WM) { transpose_item(c.w_in() + (size_t)l * D * DIN, DIN, D, WSP(bf16_t, WS_WMT) + (size_t)l * 3072 * D, c.norm_attn() + l * D, MapId{3264}, 96, scr, r, c.lane); continue; } r -= I_WM;
        if (r < I_UQ) { transpose_item(c.mla_w_uq() + (size_t)l * 256 * 768, 768, 256, WSP(bf16_t, WS_WUQT) + (size_t)l * 768 * 256, c.mla_q_norm() + l * 256, MapUq{}, 24, scr, r, c.lane, QSCALE96); continue; } r -= I_UQ;
        if (r < I_UK) { transpose_item(c.mla_w_uk() + (size_t)l * 128 * 512, 512, 128, WSP(bf16_t, WS_WUKVT) + (size_t)l * 1024 * 128, c.mla_kv_norm() + l * 128, MapId{0}, 16, scr, r, c.lane); continue; } r -= I_UK;
        if (r < I_UV) { transpose_item(c.mla_w_uv() + (size_t)l * 128 * 512, 512, 128, WSP(bf16_t, WS_WUKVT) + (size_t)l * 1024 * 128 + 512 * 128, c.mla_kv_norm() + l * 128, MapId{0}, 16, scr, r, c.lane); continue; } r -= I_UV;
        if (r < I_WO) { transpose_item(c.w_o_nsa() + (size_t)l * 512 * 1024, 1024, 512, WSP(bf16_t, WS_WOT) + ((size_t)l * 3 + 0) * 1024 * 512, nullptr, MapId{0}, 32, scr, r, c.lane); continue; } r -= I_WO;
        if (r < I_WO) { transpose_item(c.w_o_mla() + (size_t)l * 512 * 1024, 1024, 512, WSP(bf16_t, WS_WOT) + ((size_t)l * 3 + 1) * 1024 * 512, nullptr, MapId{0}, 32, scr, r, c.lane); continue; } r -= I_WO;
        if (r < I_WO) { transpose_item(c.w_o_fox() + (size_t)l * 512 * 1024, 1024, 512, WSP(bf16_t, WS_WOT) + ((size_t)l * 3 + 2) * 1024 * 512, nullptr, MapId{0}, 32, scr, r, c.lane); continue; } r -= I_WO;
        if (r < I_WOUT) { transpose_item(c.w_out() + (size_t)l * D * D, D, D, WSP(bf16_t, WS_WOUTT) + (size_t)l * D * D, nullptr, MapId{0}, 32, scr, r, c.lane); continue; } r -= I_WOUT;
        { const int kv = r / I_C1; const float* w = (kv == 0 ? c.cmp_k_w1() : c.cmp_v_w1()) + (size_t)l * 2048 * 128;
          transpose_item(w, 128, 2048, WSP(bf16_t, WS_WC1T) + ((size_t)l * 2 + kv) * 256 * 2048, nullptr, MapPad128{}, 8, scr, r % I_C1, c.lane); }
    }
    { float* rc = WSP(float, WS_ROPE); float* rs = rc + (size_t)M * 16;
      for (int i = c.bid * NTHREADS + c.tid; i < M * 16; i += c.G * NTHREADS) { const int m = i >> 4, j = i & 15;
          const float inv = exp2f(-(float)j * 0.8304820237218407f);   const float ang = (float)c.pos()[m] * inv; double rev = (double)ang * 0.15915494309189535; rev -= floor(rev); const float fr_ = (float)rev; rc[i] = __builtin_amdgcn_cosf(fr_); rs[i] = __builtin_amdgcn_sinf(fr_); } }
    float* tab = WSP(float, WS_TAB);
    if (c.bid == 0) {
        const int l = c.tid >> 8, kv = (c.tid >> 7) & 1, j = c.tid & 127;
        const float* w1 = (kv == 0 ? c.cmp_k_w1() : c.cmp_v_w1()) + (size_t)l * 2048 * 128; const float* b1 = (kv == 0 ? c.cmp_k_b1() : c.cmp_v_b1()) + l * 128; const float* pe = c.cmp_pe() + l * 2048;
        float s = b1[j]; for (int k = 0; k < 2048; ++k) s += pe[k] * w1[(size_t)k * 128 + j];
        tab[c.tid] = s;
    }
    if (c.bid == 1 % c.G) {
        for (int i = c.tid; i < 8 * 129; i += NTHREADS) { const int h = i / 129, d = i % 129; tab[512 + h * 132 + d] = c.rel_bias()[rel_bucket_dev(d) * 8 + h] * LOG2E; }
    }
}

__device__ __forceinline__ void phase_norm(const Ctx& c, const float* src, const bf16_t* y0, const bf16_t* y1, float* rout, bf16_t* hout) {
    const int gw = c.bid * NWAVES + c.wave, NGW = c.G * NWAVES;
    for (int m = gw; m < M; m += NGW) {
        const f32x4* xr = (const f32x4*)(src + (size_t)m * D) + c.lane;
        f32x4 v[4]; float s = 0.f;
#pragma unroll
        for (int j = 0; j < 4; ++j) { v[j] = xr[64 * j];
            if (y0) { const u32x2 a = *((const u32x2*)(y0 + (size_t)m * D) + c.lane + 64 * j); const u32x2 b = *((const u32x2*)(y1 + (size_t)m * D) + c.lane + 64 * j);
                v[j].x += __uint_as_float(a.x << 16) + __uint_as_float(b.x << 16); v[j].y += __uint_as_float(a.x & 0xffff0000u) + __uint_as_float(b.x & 0xffff0000u);
                v[j].z += __uint_as_float(a.y << 16) + __uint_as_float(b.y << 16); v[j].w += __uint_as_float(a.y & 0xffff0000u) + __uint_as_float(b.y & 0xffff0000u); }
            s += (v[j].x * v[j].x + v[j].y * v[j].y) + (v[j].z * v[j].z + v[j].w * v[j].w); }
        const float rstd = rsqrtf(wave_sum(s) * (1.f / D) + EPS);
        if (rout) { f32x4* ro = (f32x4*)(rout + (size_t)m * D) + c.lane;
#pragma unroll
            for (int j = 0; j < 4; ++j) ro[64 * j] = v[j]; }
        u32x2* o8 = (u32x2*)(hout + (size_t)m * D) + c.lane;
#pragma unroll
        for (int j = 0; j < 4; ++j) { u32x2 w; w.x = pk2(v[j].x * rstd, v[j].y * rstd); w.y = pk2(v[j].z * rstd, v[j].w * rstd); o8[64 * j] = w; }
    }
}
__device__ __forceinline__ void phase_final(const Ctx& c) {
    const int gw = c.bid * NWAVES + c.wave, NGW = c.G * NWAVES;
    const float* src = WSP(float, WS_XA); const bf16_t* y0 = WSP(bf16_t, WS_Y); const bf16_t* y1 = y0 + (size_t)M * D;
    for (int m = gw; m < M; m += NGW) {
        const f32x4* xr = (const f32x4*)(src + (size_t)m * D) + c.lane;
        f32x4 v[4]; float s = 0.f;
#pragma unroll
        for (int j = 0; j < 4; ++j) { v[j] = xr[64 * j];
            const u32x2 a = *((const u32x2*)(y0 + (size_t)m * D) + c.lane + 64 * j); const u32x2 b = *((const u32x2*)(y1 + (size_t)m * D) + c.lane + 64 * j);
            v[j].x += __uint_as_float(a.x << 16) + __uint_as_float(b.x << 16); v[j].y += __uint_as_float(a.x & 0xffff0000u) + __uint_as_float(b.x & 0xffff0000u);
            v[j].z += __uint_as_float(a.y << 16) + __uint_as_float(b.y << 16); v[j].w += __uint_as_float(a.y & 0xffff0000u) + __uint_as_float(b.y & 0xffff0000u);
            s += (v[j].x * v[j].x + v[j].y * v[j].y) + (v[j].z * v[j].z + v[j].w * v[j].w); }
        const float rstd = rsqrtf(wave_sum(s) * (1.f / D) + EPS);
        f32x4* ro = (f32x4*)(c.out + (size_t)m * D) + c.lane;
#pragma unroll
        for (int j = 0; j < 4; ++j) { const f32x4 g = *((const f32x4*)c.norm_final() + c.lane + 64 * j); ro[64 * j] = v[j] * rstd * g; }
    }
}

__device__ __forceinline__ void phase_prep(const Ctx& c, int l) {
    const int gw = c.bid * NWAVES + c.wave, NGW = c.G * NWAVES;
    const bf16_t* P1 = WSP(bf16_t, WS_P1); float* rstd = WSP(float, WS_RSTD); bf16_t* KR = WSP(bf16_t, WS_KR); float* LF = WSP(float, WS_LF);
    const float* rc = WSP(float, WS_ROPE); const float* rs = rc + (size_t)M * 16;
    for (int m = gw; m < M; m += NGW) {
        const bf16_t* row = P1 + (size_t)m * P1W;
        const u32x2 a = *((const u32x2*)(row + C_CQ) + c.lane);
        float q0 = __uint_as_float(a.x << 16), q1 = __uint_as_float(a.x & 0xffff0000u), q2 = __uint_as_float(a.y << 16), q3 = __uint_as_float(a.y & 0xffff0000u);
        const float sq = wave_sum(q0 * q0 + q1 * q1 + q2 * q2 + q3 * q3);
        const unsigned b = *((const unsigned*)(row + C_CKV) + c.lane);
        float k0 = __uint_as_float(b << 16), k1 = __uint_as_float(b & 0xffff0000u);
        const float sk = wave_sum(k0 * k0 + k1 * k1);
        if (c.lane == 0) { rstd[2 * m] = rsqrtf(sq * (1.f / 256.f) + EPS); rstd[2 * m + 1] = rsqrtf(sk * (1.f / 128.f) + EPS); }
        if (c.lane < 16) { const float x1 = bf2f(row[C_KR + c.lane]), x2 = bf2f(row[C_KR + 16 + c.lane]); const float cs = rc[m * 16 + c.lane], sn = rs[m * 16 + c.lane];
            KR[m * 32 + c.lane] = (bf16_t)f2bf(x1 * cs - x2 * sn); KR[m * 32 + 16 + c.lane] = (bf16_t)f2bf(x1 * sn + x2 * cs); }
        if (c.lane < 8) { const float f = bf2f(row[C_FF + c.lane]) + c.fox_b_f()[l * 8 + c.lane];
            const float ls = fminf(f, 0.f) - __logf(1.f + __expf(-fabsf(f)));
            const int bb = m / T, t = m % T; LF[((size_t)bb * 8 + c.lane) * T + t] = ls; }
    }
}
__device__ __forceinline__ void phase_cum(const Ctx& c) {
    LAS float* sh = (LAS float*)c.lds;
    for (int s = c.bid; s < NB * 8; s += c.G) {
        const float* lf = WSP(float, WS_LF) + (size_t)s * T; float* cum = WSP(float, WS_CUM) + (size_t)s * T;
        float v[16]; float tot = 0.f;
#pragma unroll
        for (int j = 0; j < 16; ++j) { v[j] = lf[c.tid * 16 + j]; tot += v[j]; }
        sh[c.tid] = tot; __syncthreads();
        if (c.tid == 0) { float run = 0.f; for (int i = 0; i < NTHREADS; ++i) { const float t_ = sh[i]; sh[i] = run; run += t_; } }
        __syncthreads();
        float run = sh[c.tid];
#pragma unroll
        for (int j = 0; j < 16; ++j) { run += v[j]; cum[c.tid * 16 + j] = run * LOG2E; }
        __syncthreads();
    }
}
__device__ __forceinline__ void phase_cmp2_ropeq(const Ctx& c, int l) {
    const bf16_t* HC = WSP(bf16_t, WS_HC);
    for (int i = c.bid * NTHREADS + c.tid; i < 2 * 2048 * 64; i += c.G * NTHREADS) {
        const int kv = i / (2048 * 64), row = (i / 64) % 2048, d = i % 64;
        const float* w2 = (kv == 0 ? c.cmp_k_w2() : c.cmp_v_w2()) + (size_t)l * 128 * 64;
        const bf16_t* h = HC + ((size_t)kv * 2048 + row) * 128; float s = 0.f;
        for (int j = 0; j < 128; ++j) s += bf2f(h[j]) * w2[j * 64 + d];
        if ((row & 511) == 511) s = 0.f;
        (kv == 0 ? WSP(bf16_t, WS_KC) : WSP(bf16_t, WS_VC))[(size_t)row * 64 + d] = (bf16_t)f2bf(s);
    }
    bf16_t* QB = WSP(bf16_t, WS_QB); const float* rc = WSP(float, WS_ROPE); const float* rs = rc + (size_t)M * 16;
    for (int i = c.bid * NTHREADS + c.tid; i < M * 128; i += c.G * NTHREADS) {
        const int m = i >> 7, h = (i >> 4) & 7, j = i & 15;
        bf16_t* p = QB + (size_t)m * 768 + 512 + h * 32; const float x1 = bf2f(p[j]), x2 = bf2f(p[16 + j]); const float cs = rc[m * 16 + j], sn = rs[m * 16 + j];
        p[j] = (bf16_t)f2bf(x1 * cs - x2 * sn); p[16 + j] = (bf16_t)f2bf(x1 * sn + x2 * cs);
    }
}

typedef float f32x2_t __attribute__((ext_vector_type(2))); typedef __bf16 bf16x2_t __attribute__((ext_vector_type(2)));
__device__ __forceinline__ unsigned cvtpk(float lo, float hi) { f32x2_t v = {lo, hi}; bf16x2_t b = __builtin_convertvector(v, bf16x2_t); return __builtin_bit_cast(unsigned, b); }
__device__ __forceinline__ u32x2 pk4(f32x4 v) { u32x2 w; w.x = cvtpk(v.x, v.y); w.y = cvtpk(v.z, v.w); return w; }
__device__ __forceinline__ f32x4 unpk4(u32x2 a) { f32x4 r; r.x = __uint_as_float(a.x << 16); r.y = __uint_as_float(a.x & 0xffff0000u); r.z = __uint_as_float(a.y << 16); r.w = __uint_as_float(a.y & 0xffff0000u); return r; }
#define EPI_ARGS const f32x4 (&acc)[2][2][4][2], const pg8::Unit& u, int wr, int wc, int fr, int fq
#define EPI_LOOP _Pragma("unroll") for (int ai = 0; ai < 2; ++ai) _Pragma("unroll") for (int m = 0; m < 4; ++m) _Pragma("unroll") for (int bj = 0; bj < 2; ++bj) _Pragma("unroll") for (int n = 0; n < 2; ++n)

struct EpiStoreBf16 { bf16_t* O; int ldc; const float* rowscale; int rs_stride;
    __device__ __forceinline__ void operator()(EPI_ARGS) const {
        EPI_LOOP { PG8_EPI_ROWCOL(row, col); f32x4 v = acc[ai][bj][m][n]; if (rowscale) v = v * rowscale[(size_t)row * rs_stride]; *(u32x2*)(O + (size_t)row * ldc + col) = pk4(v); } } };
struct EpiGates { bf16_t* O; const float* bias;
    __device__ __forceinline__ void operator()(EPI_ARGS) const {
        EPI_LOOP { PG8_EPI_ROWCOL(row, col); f32x4 v = acc[ai][bj][m][n] + *(const f32x4*)(bias + col);
            v.x = sigmoidf_(v.x); v.y = sigmoidf_(v.y); v.z = sigmoidf_(v.z); v.w = sigmoidf_(v.w); *(u32x2*)(O + (size_t)row * 3072 + col) = pk4(v); } } };
struct EpiCmp1 { bf16_t* HC; const float* bc1;
    __device__ __forceinline__ void operator()(EPI_ARGS) const {
        const int kv = u.pm >> 3, bg = (u.pm >> 1) & 3, half = u.pm & 1;
#pragma unroll
        for (int ai = 0; ai < 2; ++ai)
#pragma unroll
            for (int m = 0; m < 4; ++m)
#pragma unroll
                for (int n = 0; n < 2; ++n) { const int i = half * 256 + ai * 128 + wr * 64 + m * 16 + fr, cc = wc * 32 + n * 16 + fq * 4;
                    f32x4 v = acc[ai][0][m][n] + *(const f32x4*)(bc1 + kv * 128 + cc);
                    v.x = gelu_tanh(v.x); v.y = gelu_tanh(v.y); v.z = gelu_tanh(v.z); v.w = gelu_tanh(v.w);
                    *(u32x2*)(HC + ((size_t)kv * 2048 + bg * 512 + i) * 128 + cc) = pk4(v); } } };
struct EpiOutproj { bf16_t* MIX; const bf16_t* GATES; int br;
    __device__ __forceinline__ void operator()(EPI_ARGS) const {
        EPI_LOOP { PG8_EPI_ROWCOL(row, col); const f32x4 g = unpk4(*(const u32x2*)(GATES + (size_t)row * 3072 + br * 1024 + col)); f32x4 v = acc[ai][bj][m][n] * g;
            u32x2* p = (u32x2*)(MIX + (size_t)row * 1024 + col); if (br > 0) v = v + unpk4(*p); *p = pk4(v); } } };
struct EpiWout { const float* R; float* XA;
    __device__ __forceinline__ void operator()(EPI_ARGS) const {
        EPI_LOOP { PG8_EPI_ROWCOL(row, col); const f32x4 r = *(const f32x4*)(R + (size_t)row * 1024 + col); *(f32x4*)(XA + (size_t)row * 1024 + col) = r + acc[ai][bj][m][n]; } } };
struct EpiMoe1 { bf16_t* HID; const float* LW;
    __device__ __forceinline__ void operator()(EPI_ARGS) const {
#pragma unroll
        for (int ai = 0; ai < 2; ++ai)
#pragma unroll
            for (int m = 0; m < 4; ++m) { int aux_ = u.aux; asm volatile("" : "+s"(aux_)); const unsigned pos = (unsigned)(aux_ + ai * 128 + wr * 64 + m * 16 + fr); const float w = LW[pos];
#pragma unroll
                for (int n = 0; n < 2; ++n) { const f32x4 g = acc[ai][0][m][n], up = acc[ai][1][m][n]; f32x4 h;
                    h.x = g.x * sigmoidf_(g.x) * up.x * w; h.y = g.y * sigmoidf_(g.y) * up.y * w; h.z = g.z * sigmoidf_(g.z) * up.z * w; h.w = g.w * sigmoidf_(g.w) * up.w * w;
                    *(u32x2*)(HID + pos * 256u + (unsigned)(u.pn * 128 + wc * 32 + n * 16 + fq * 4)) = pk4(h); }
                asm volatile("" ::: "memory"); } } };
struct EpiMoe2 { bf16_t* Y; const unsigned* LDST;
    __device__ __forceinline__ void operator()(EPI_ARGS) const {
#pragma unroll
        for (int ai = 0; ai < 2; ++ai)
#pragma unroll
            for (int m = 0; m < 4; ++m) { int aux_ = u.aux; asm volatile("" : "+s"(aux_)); const unsigned pos = (unsigned)(aux_ + ai * 128 + wr * 64 + m * 16 + fr); const unsigned d0 = LDST[pos];
                if (d0 != 0xFFFFFFFFu) { const unsigned off = d0 + (unsigned)(u.pn * 256 + wc * 32 + fq * 4);
#pragma unroll
                    for (int bj = 0; bj < 2; ++bj)
#pragma unroll
                        for (int n = 0; n < 2; ++n) *(u32x2*)(Y + off + bj * 128 + n * 16) = pk4(acc[ai][bj][m][n]); }
                asm volatile("" ::: "memory"); } } };

struct CmpOrder { int G, c; const char* P1; const char* W;
    __device__ bool next(int i, pg8::Unit& u) const { const int L_ = i * G + c; if (L_ >= 16) return false; const int kv = L_ >> 3, b = (L_ >> 2) & 1, g = (L_ >> 1) & 1, half = L_ & 1;
        u.pm = L_; u.pn = 0; u.aux = 0; u.A = P1 + ((size_t)(b * T + 16 * 256 * half) * P1W + C_NKV + (kv * 2 + g) * 64) * 2; u.B = W + (size_t)kv * 256 * 2048 * 2; return true; } };
struct MoeOrder { int G, c, nN; const LAS int* tab; const char* A; size_t a_rowbytes; const char* W; size_t w_expert, w_tile;
    __device__ bool next(int i, pg8::Unit& u) const { const int L_ = i * G + c; const int NT = __builtin_amdgcn_readfirstlane(tab[32]); if (L_ >= NT * nN) return false; const int rt = L_ / nN, pn = L_ % nN;
        int e = 0; while (__builtin_amdgcn_readfirstlane(tab[e + 1]) <= rt) ++e;
        const int off_e = __builtin_amdgcn_readfirstlane(tab[33 + e]), ts_e = __builtin_amdgcn_readfirstlane(tab[e]), cnt_e = __builtin_amdgcn_readfirstlane(tab[66 + e]);
        const int pos0 = off_e + 256 * (rt - ts_e); u.pn = pn; u.aux = pos0; u.pm = off_e + cnt_e;
        u.A = A + (size_t)pos0 * a_rowbytes; u.B = W + (size_t)e * w_expert + (size_t)pn * w_tile; return true; } };
__device__ __forceinline__ void moe_tables(const Ctx& c, int l, LAS int* tab) {
    if (c.tid == 0) { const unsigned* cnt = WSP(unsigned, WS_CTL) + CW_MOECNT + l * 64; int ts = 0, off = 0;
        for (int e = 0; e < 32; ++e) { const int n = (int)cnt[e]; tab[e] = ts; tab[33 + e] = off; tab[66 + e] = n; const int nt_ = (n + 255) >> 8; ts += nt_; off += nt_ * 256; }
        tab[32] = ts; tab[65] = off; }
    __syncthreads();
}

constexpr int LDS_RSM = LDS_MISC + 1024;
__device__ __forceinline__ void phase_router(const Ctx& c, int l, int dummy = 0) {
    const int gw = c.bid * NWAVES + c.wave, NGW = c.G * NWAVES, lane = c.lane;
    const float* XA = WSP(float, WS_XA); bf16_t* H2 = WSP(bf16_t, WS_H2); int* REC = WSP(int, dummy ? WS_HID : WS_REC); unsigned* cnt = WSP(unsigned, WS_CTL) + CW_MOECNT + (l + 2 * dummy) * 64;
    const float* g2 = c.norm_ffn() + l * D; const float* wg = c.moe_w_grp() + (size_t)l * D * 4; const float* wr_ = c.moe_w_router() + (size_t)l * D * 32;
    const float* bgp = c.moe_b_grp() + l * 4; const float* brp = c.moe_b_router() + l * 32;
    LAS f32x4* Tk = (LAS f32x4*)(c.lds + c.wave * 16384);
    LAS float* PG = (LAS float*)(c.lds + LDS_RSM + c.wave * 1792); LAS float* EL = PG + 256; LAS float* GL = EL + 128;
    LAS unsigned* cntL = (LAS unsigned*)(c.lds + LDS_MOETAB);
    if (c.tid < 32) cntL[c.tid] = 0u;
    __syncthreads();
    for (int task = gw; task < M / 4; task += NGW) {
        const int m0 = task * 4;
        f32x4 v[4][4]; float rs[4];
#pragma unroll
        for (int r = 0; r < 4; ++r) { const f32x4* xr = (const f32x4*)(XA + (size_t)(m0 + r) * D) + lane; float s = 0.f;
#pragma unroll
            for (int j = 0; j < 4; ++j) { v[r][j] = xr[64 * j]; s += (v[r][j].x * v[r][j].x + v[r][j].y * v[r][j].y) + (v[r][j].z * v[r][j].z + v[r][j].w * v[r][j].w); }
            rs[r] = rsqrtf(wave_sum(s) * (1.f / D) + EPS); }
#pragma unroll
        for (int j = 0; j < 4; ++j) { const f32x4 gg = *((const f32x4*)g2 + lane + 64 * j);
#pragma unroll
            for (int r = 0; r < 4; ++r) { v[r][j] = v[r][j] * rs[r]; *((u32x2*)(H2 + (size_t)(m0 + r) * D) + lane + 64 * j) = pk4(v[r][j]); v[r][j] = v[r][j] * gg; }
#pragma unroll
            for (int e = 0; e < 4; ++e) { f32x4 t4; t4.x = v[0][j][e]; t4.y = v[1][j][e]; t4.z = v[2][j][e]; t4.w = v[3][j][e]; Tk[4 * lane + 256 * j + e] = t4; } }
        LDS_WAIT(); asm volatile("" ::: "memory");
        { const int o = lane & 31, sh = lane >> 5; f32x4 acc = {0.f, 0.f, 0.f, 0.f}; const float* wp = wr_ + (size_t)(512 * sh) * 32 + o; const LAS f32x4* tp = Tk + 512 * sh;
#pragma unroll 1
          for (int kb = 0; kb < 512; kb += 32) { float w[32];
#pragma unroll
              for (int i = 0; i < 32; ++i) w[i] = wp[(size_t)(kb + i) * 32];
              __builtin_amdgcn_sched_barrier(0);
#pragma unroll
              for (int i = 0; i < 32; ++i) acc += tp[kb + i] * w[i]; }
          acc.x = half_sum(acc.x); acc.y = half_sum(acc.y); acc.z = half_sum(acc.z); acc.w = half_sum(acc.w);
          if (lane < 32) { const float bb = brp[o]; EL[0 * 32 + o] = acc.x + bb; EL[1 * 32 + o] = acc.y + bb; EL[2 * 32 + o] = acc.z + bb; EL[3 * 32 + o] = acc.w + bb; } }
        { const int og = lane & 3, s16 = lane >> 2; f32x4 acc = {0.f, 0.f, 0.f, 0.f}; const float* wp = wg + (size_t)(64 * s16) * 4 + og; const LAS f32x4* tp = Tk + 64 * s16;
#pragma unroll 1
          for (int kb = 0; kb < 64; kb += 32) { float w[32];
#pragma unroll
              for (int i = 0; i < 32; ++i) w[i] = wp[(size_t)(kb + i) * 4];
              __builtin_amdgcn_sched_barrier(0);
#pragma unroll
              for (int i = 0; i < 32; ++i) acc += tp[kb + i] * w[i]; }
          PG[(0 * 4 + og) * 16 + s16] = acc.x; PG[(1 * 4 + og) * 16 + s16] = acc.y; PG[(2 * 4 + og) * 16 + s16] = acc.z; PG[(3 * 4 + og) * 16 + s16] = acc.w; }
        LDS_WAIT(); asm volatile("" ::: "memory");
        if (lane < 16) { float s = 0.f;
#pragma unroll
            for (int q = 0; q < 16; ++q) s += PG[lane * 16 + q];
            GL[lane] = s + bgp[lane & 3]; }
        LDS_WAIT(); asm volatile("" ::: "memory");
        if (lane < 4) { const int r = lane;
            int gi = 0; float gm = GL[r * 4];
            for (int o = 1; o < 4; ++o) { const float x_ = GL[r * 4 + o]; if (x_ > gm) { gm = x_; gi = o; } }
            float gs = 0.f; for (int o = 0; o < 4; ++o) gs += __expf(GL[r * 4 + o] - gm);
            const float grp_top = 1.f / gs;
            int i1 = 0; float m1 = EL[r * 32 + gi * 8];
            for (int q = 1; q < 8; ++q) { const float x_ = EL[r * 32 + gi * 8 + q]; if (x_ > m1) { m1 = x_; i1 = q; } }
            int i2 = -1; float m2 = -3.0e38f;
            for (int q = 0; q < 8; ++q) { const float x_ = EL[r * 32 + gi * 8 + q]; if (q != i1 && x_ > m2) { m2 = x_; i2 = q; } }
            const float e2 = __expf(m2 - m1); const float w1 = grp_top / (1.f + e2), w2 = grp_top * e2 / (1.f + e2);
            const int ea = gi * 8 + i1, eb = gi * 8 + i2; const int ra = (int)atomicAdd((unsigned*)(cntL + ea), 1u), rb = (int)atomicAdd((unsigned*)(cntL + eb), 1u);
            int* rr = REC + (size_t)(m0 + r) * 8; rr[0] = ea; rr[1] = eb; rr[2] = ra; rr[3] = rb; rr[4] = __float_as_int(w1); rr[5] = __float_as_int(w2); rr[6] = c.bid; }
        LDS_WAIT(); asm volatile("" ::: "memory");
    }
    __syncthreads();
    if (c.tid < 32) { const unsigned n = cntL[c.tid]; (WSP(unsigned, WS_CTL) + CW_CNTB)[(dummy ? 8192 : 0) + c.bid * 32 + c.tid] = n; if (n) atomicAdd(cnt + c.tid, n); }
}
__device__ __forceinline__ void phase_place(const Ctx& c, int l) {
    LAS int* tab = (LAS int*)(c.lds + LDS_MOETAB);
    moe_tables(c, l, tab);
    int* LTOK = WSP(int, WS_LTOK); float* LW = WSP(float, WS_LW); unsigned* LDST = WSP(unsigned, WS_LSLOT); const int* REC = WSP(int, WS_REC);
    LAS int* BASE = (LAS int*)c.lds;
    if (c.tid < 32) { const unsigned* cb = WSP(unsigned, WS_CTL) + CW_CNTB + c.tid; int run = 0; for (int b_ = 0; b_ < c.G; ++b_) { BASE[b_ * 32 + c.tid] = run; run += (int)cb[b_ * 32]; } }
    __syncthreads();
    for (int m = c.bid * NTHREADS + c.tid; m < M; m += c.G * NTHREADS) { const int* r = REC + (size_t)m * 8;
        const int pa = tab[33 + r[0]] + BASE[r[6] * 32 + r[0]] + r[2], pb = tab[33 + r[1]] + BASE[r[6] * 32 + r[1]] + r[3];
        LTOK[pa] = m; LDST[pa] = (unsigned)m * 1024u; LW[pa] = __int_as_float(r[4]); LTOK[pb] = m; LDST[pb] = ((unsigned)M + (unsigned)m) * 1024u; LW[pb] = __int_as_float(r[5]); }
    for (int e = c.bid; e < 32; e += c.G) { const int lo = tab[33 + e] + tab[66 + e], hi2 = tab[33 + e + 1];
        for (int p = lo + c.tid; p < hi2; p += NTHREADS) { LTOK[p] = 0; LDST[p] = 0xFFFFFFFFu; LW[p] = 0.f; } }
    __syncthreads();
    LAS float* scr = (LAS float*)(c.lds + c.wave * 16384);
    const int gw = c.bid * NWAVES + c.wave, NGW = c.G * NWAVES;
    constexpr int I_GU = 16 * 16, I_DN = 4 * 32;
    for (int it = gw; it < 32 * (I_GU + I_DN); it += NGW) { const int e = it / (I_GU + I_DN); int r = it % (I_GU + I_DN);
        if (r < I_GU) { const int nb = r % 16; const bool up = ((nb * 32) & 255) >= 128;
            const float* w = (up ? c.moe_w_up() : c.moe_w_gate()) + ((size_t)l * 32 + e) * D * 256;
            transpose_item(w, 256, D, WSP(bf16_t, WS_WGU) + (size_t)e * 512 * D, c.norm_ffn() + l * D, MapGU{}, 16, scr, r, c.lane); }
        else { r -= I_GU; transpose_item(c.moe_w_down() + ((size_t)l * 32 + e) * 256 * D, D, 256, WSP(bf16_t, WS_WDT) + (size_t)e * D * 256, nullptr, MapId{0}, 32, scr, r, c.lane); } }
}

#ifndef ATT_FAST_FOX
#define ATT_FAST_FOX 1
#endif
#ifndef ATT_FAST_MLA
#define ATT_FAST_MLA 1
#endif
#ifndef ATT_FAST_NSA
#define ATT_FAST_NSA 1
#endif
namespace fa {
constexpr int KPITCH = 208, VPITCH = 192;
constexpr int KBUF = 64 * KPITCH, VBUF = 64 * VPITCH;
constexpr int L_K = 0, L_V = 2 * KBUF, L_CUM = L_V + 2 * VBUF, L_LUT = L_CUM + 512, L_PS = 57344, L_F = L_PS + 64 * 132 * 4, L_SEL = L_F + 64 * 132 * 4, L_UNI = L_SEL + 1024, L_TL = L_UNI + 16, L_TLN = L_TL + 128, L_UNIT = L_TLN + 16;
static_assert(L_LUT + 8 * 132 * 4 <= L_PS && L_UNIT + 64 <= 131072, "attention LDS map");
typedef short v4i16_t __attribute__((ext_vector_type(4)));
__device__ __forceinline__ float swap32_max(float v) { auto rr = __builtin_amdgcn_permlane32_swap(__float_as_uint(v), __float_as_uint(v), false, false); return fmaxf(__uint_as_float(rr[0]), __uint_as_float(rr[1])); }
__device__ __forceinline__ float swap32_sum(float v) { auto rr = __builtin_amdgcn_permlane32_swap(__float_as_uint(v), __float_as_uint(v), false, false); return __uint_as_float(rr[0]) + __uint_as_float(rr[1]); }
__device__ __forceinline__ float ex2(float x) { return __builtin_amdgcn_exp2f(x); }

struct KVSrc { const bf16_t* K; int kpitch; const bf16_t* K2; int k2pitch; const bf16_t* V; int vpitch; const float* cum; float cref; };
struct TileRegs { u32x4 k, k2, v; float cm; };
template <bool HAS_K2, bool HAS_CUM>
__device__ __forceinline__ void tile_load(TileRegs& R, const KVSrc& s, int kv0, int tid) {
    const int row = tid >> 3, ch = tid & 7;
    R.k = *(const u32x4*)(s.K + (size_t)(kv0 + row) * s.kpitch + ch * 8);
    R.v = *(const u32x4*)(s.V + (size_t)(kv0 + row) * s.vpitch + ch * 8);
    if constexpr (HAS_K2) { if (tid < 256) R.k2 = *(const u32x4*)(s.K2 + (size_t)(kv0 + (tid >> 2)) * s.k2pitch + (tid & 3) * 8); }
    if constexpr (HAS_CUM) { if (tid < 64) R.cm = s.cum[kv0 + tid]; }
}
template <bool HAS_K2, bool HAS_CUM>
__device__ __forceinline__ void tile_store(const TileRegs& R, LAS unsigned char* lds, int buf, int tid, float cref = 0.f) {
    const int row = tid >> 3, ch = tid & 7;
    *(LAS u32x4*)(lds + L_K + buf * KBUF + row * KPITCH + ch * 16) = R.k;
    if constexpr (HAS_K2) { if (tid < 256) *(LAS u32x4*)(lds + L_K + buf * KBUF + (tid >> 2) * KPITCH + 128 + (tid & 3) * 16) = R.k2; }
    *(LAS u32x4*)(lds + L_V + buf * VBUF + row * VPITCH + ch * 16) = R.v;
    if constexpr (HAS_CUM) { if (tid < 64) ((LAS float*)(lds + L_CUM))[buf * 64 + tid] = R.cm - cref; }
}
template <int NKS>
__device__ __forceinline__ void qk_tile(f32x16 (&st)[2], const LAS unsigned char* lds, int buf, const bf16x8 (&qf)[NKS], int r, int hh, float cval) {
    const LAS unsigned char* kp = lds + L_K + buf * KBUF + r * KPITCH + hh * 16;
    bf16x8 kf[2][NKS];
#pragma unroll
    for (int ks = 0; ks < NKS; ++ks)
#pragma unroll
        for (int rb = 0; rb < 2; ++rb) kf[rb][ks] = *(const LAS bf16x8*)(kp + rb * 32 * KPITCH + ks * 32);
    f32x16 cin;
#pragma unroll
    for (int i = 0; i < 16; ++i) cin[i] = cval;
    __builtin_amdgcn_sched_barrier(0);
    f32x16 a0 = __builtin_amdgcn_mfma_f32_32x32x16_bf16(kf[0][0], qf[0], cin, 0, 0, 0), a1 = __builtin_amdgcn_mfma_f32_32x32x16_bf16(kf[1][0], qf[0], cin, 0, 0, 0);
#pragma unroll
    for (int ks = 1; ks < NKS; ++ks) { a0 = __builtin_amdgcn_mfma_f32_32x32x16_bf16(kf[0][ks], qf[ks], a0, 0, 0, 0); a1 = __builtin_amdgcn_mfma_f32_32x32x16_bf16(kf[1][ks], qf[ks], a1, 0, 0, 0); }
    st[0] = a0; st[1] = a1;
}
__device__ __forceinline__ void pv_tile(f32x16 (&ot)[2], const LAS unsigned char* lds, int buf, const f32x16 (&p)[2], int lane) {
    const int i16 = lane & 15, blk = (lane >> 4) & 1, hh = lane >> 5;
    const LAS unsigned char* vb = lds + L_V + buf * VBUF + (4 * hh + (i16 >> 2)) * VPITCH + 32 * blk + 8 * (i16 & 3);
    v4i16_t lo[4][2], hi[4][2]; bf16x8 pf[4];
#pragma unroll
    for (int q = 0; q < 4; ++q)
#pragma unroll
        for (int db = 0; db < 2; ++db) { const LAS unsigned char* vp = vb + (16 * q) * VPITCH + 64 * db;
            lo[q][db] = __builtin_amdgcn_ds_read_tr16_b64_v4i16((LAS v4i16_t*)vp); hi[q][db] = __builtin_amdgcn_ds_read_tr16_b64_v4i16((LAS v4i16_t*)(vp + 8 * VPITCH)); }
#pragma unroll
    for (int q = 0; q < 4; ++q) { const int rb = q >> 1, s_ = q & 1;
        u32x4 pw; pw.x = cvtpk(p[rb][8 * s_ + 0], p[rb][8 * s_ + 1]); pw.y = cvtpk(p[rb][8 * s_ + 2], p[rb][8 * s_ + 3]); pw.z = cvtpk(p[rb][8 * s_ + 4], p[rb][8 * s_ + 5]); pw.w = cvtpk(p[rb][8 * s_ + 6], p[rb][8 * s_ + 7]);
        pf[q] = __builtin_bit_cast(bf16x8, pw); }
    __builtin_amdgcn_sched_barrier(0);
#pragma unroll
    for (int q = 0; q < 4; ++q)
#pragma unroll
        for (int db = 0; db < 2; ++db) { const bf16x8 vf = {lo[q][db][0], lo[q][db][1], lo[q][db][2], lo[q][db][3], hi[q][db][0], hi[q][db][1], hi[q][db][2], hi[q][db][3]};
            ot[db] = __builtin_amdgcn_mfma_f32_32x32x16_bf16(vf, pf[q], ot[db], 0, 0, 0); }
}
struct SmState { float m, l; };
constexpr float RESC_THR = 8.f;
__device__ __forceinline__ float sm_cval(const SmState& S) { return (S.m == -INFINITY) ? 0.f : -S.m; }
__device__ __forceinline__ float row_max32(const f32x16 (&st)[2]) {
    float mx = fmaxf(st[0][0], st[1][0]);
#pragma unroll
    for (int i = 1; i < 16; ++i) mx = fmaxf(fmaxf(mx, st[0][i]), st[1][i]);
    return swap32_max(mx);
}
typedef float f32x2v __attribute__((ext_vector_type(2)));
template <bool WITH_O>
__device__ __forceinline__ void sm_shift(f32x16 (&st)[2], SmState& S, f32x16 (&ot)[2], float mx) {
    const bool fresh = (S.m == -INFINITY);
    const bool up = fresh ? (mx > -INFINITY) : (mx > RESC_THR);
    if (__any(up)) {
        const float d = up ? mx : 0.f; const float alpha = fresh ? 1.f : ex2(-d);
        S.l *= alpha; S.m = up ? ((fresh ? 0.f : S.m) + d) : S.m;
#pragma unroll
        for (int rb = 0; rb < 2; ++rb)
#pragma unroll
            for (int i = 0; i < 16; ++i) st[rb][i] -= d;
        if constexpr (WITH_O) {
#pragma unroll
            for (int db = 0; db < 2; ++db)
#pragma unroll
                for (int i = 0; i < 16; ++i) ot[db][i] *= alpha; }
    }
}
__device__ __forceinline__ void sm_update(f32x16 (&st)[2], SmState& S, f32x16 (&ot)[2]) {
    sm_shift<true>(st, S, ot, row_max32(st));
    f32x2v sum = {0.f, 0.f};
#pragma unroll
    for (int rb = 0; rb < 2; ++rb)
#pragma unroll
        for (int i = 0; i < 16; i += 2) { f32x2v p; p.x = ex2(st[rb][i]); p.y = ex2(st[rb][i + 1]); st[rb][i] = p.x; st[rb][i + 1] = p.y; sum += p; }
    S.l += sum.x + sum.y;
}
__device__ __forceinline__ void sm_stats(f32x16 (&st)[2], SmState& S) {
    f32x16 dummy[2];
    sm_shift<false>(st, S, dummy, row_max32(st));
    f32x2v sum = {0.f, 0.f};
#pragma unroll
    for (int rb = 0; rb < 2; ++rb)
#pragma unroll
        for (int i = 0; i < 16; i += 2) { f32x2v p; p.x = ex2(st[rb][i]); p.y = ex2(st[rb][i + 1]); sum += p; }
    S.l += sum.x + sum.y;
}
__device__ __forceinline__ void zero_acc(f32x16 (&a)[2]) {
#pragma unroll
    for (int db = 0; db < 2; ++db)
#pragma unroll
        for (int i = 0; i < 16; ++i) a[db][i] = 0.f;
}
__device__ __forceinline__ void store_ot(const f32x16 (&o)[2], float sc, bf16_t* orow, int hh) {
#pragma unroll
    for (int db = 0; db < 2; ++db)
#pragma unroll
        for (int a = 0; a < 4; ++a) { u32x2 w; w.x = cvtpk(o[db][4 * a + 0] * sc, o[db][4 * a + 1] * sc); w.y = cvtpk(o[db][4 * a + 2] * sc, o[db][4 * a + 3] * sc);
            *(u32x2*)(orow + 32 * db + 8 * a + 4 * hh) = w; }
}
#define FA_FOREACH_REG(CODE) _Pragma("unroll") for (int rb = 0; rb < 2; ++rb) _Pragma("unroll") for (int a = 0; a < 4; ++a) _Pragma("unroll") for (int e = 0; e < 4; ++e) { const int i = 4 * a + e; const int kc = 32 * rb + 8 * a + e; (void)kc; CODE }
#define FA_LAUNDER(x) asm volatile("" : "+v"(x))

template <bool IS_MLA>
__device__ __forceinline__ void dense_unit(const Ctx& c, int b, int h, int qb) {
    constexpr int NKS = IS_MLA ? 6 : 4;
    const int tid = c.tid, lane = c.lane, r = lane & 31, hh = lane >> 5, w = c.wave;
    LAS unsigned char* lds = c.lds;
    const int q0 = qb * 256, qrow = q0 + 32 * w + r; const size_t mrow = (size_t)b * T + qrow;
    KVSrc src; bf16x8 qf[NKS]; bf16_t* orow;
    if constexpr (IS_MLA) {
        const bf16_t* QB = WSP(bf16_t, WS_QB); const bf16_t* KVB = WSP(bf16_t, WS_KVB);
        src.K = KVB + (size_t)b * T * 1024 + h * 64; src.kpitch = 1024; src.K2 = WSP(bf16_t, WS_KR) + (size_t)b * T * 32; src.k2pitch = 32; src.V = KVB + (size_t)b * T * 1024 + 512 + h * 64; src.vpitch = 1024; src.cum = nullptr; src.cref = 0.f;
#pragma unroll
        for (int ks = 0; ks < 4; ++ks) qf[ks] = *(const bf16x8*)(QB + mrow * 768 + h * 64 + 16 * ks + 8 * hh);
#pragma unroll
        for (int ks = 0; ks < 2; ++ks) qf[4 + ks] = *(const bf16x8*)(QB + mrow * 768 + 512 + h * 32 + 16 * ks + 8 * hh);
        orow = WSP(bf16_t, WS_OUTB) + mrow * 512 + h * 64;
    } else {
        const bf16_t* P1 = WSP(bf16_t, WS_P1);
        src.K = P1 + (size_t)b * T * P1W + C_FQKV + 512 + h * 64; src.kpitch = P1W; src.K2 = nullptr; src.k2pitch = 0; src.V = P1 + (size_t)b * T * P1W + C_FQKV + 1024 + h * 64; src.vpitch = P1W;
        src.cum = WSP(float, WS_CUM) + ((size_t)b * 8 + h) * T; src.cref = src.cum[q0];
#pragma unroll
        for (int ks = 0; ks < 4; ++ks) qf[ks] = *(const bf16x8*)(P1 + mrow * P1W + C_FQKV + h * 64 + 16 * ks + 8 * hh);
        orow = WSP(bf16_t, WS_OUTC) + mrow * 512 + h * 64;
    }
    f32x16 st[2], ot[2]; zero_acc(ot); SmState S{-INFINITY, 0.f};
    const int nt = 4 * qb + 4;
    const int wlast = (q0 + 32 * w + 31) >> 6;
    TileRegs R;
    tile_load<IS_MLA, !IS_MLA>(R, src, 0, tid); tile_store<IS_MLA, !IS_MLA>(R, lds, 0, tid, src.cref);
    if (nt > 1) tile_load<IS_MLA, !IS_MLA>(R, src, 64, tid);
    __syncthreads();
    for (int t = 0; t < nt; ++t) { const int buf = t & 1, kv0 = 64 * t;
        if (t <= wlast) {
            qk_tile<NKS>(st, lds, buf, qf, r, hh, sm_cval(S));
            if constexpr (!IS_MLA) {
#pragma unroll
                for (int rb = 0; rb < 2; ++rb)
#pragma unroll
                    for (int a = 0; a < 4; ++a) { const f32x4 ck = *(const LAS f32x4*)(lds + L_CUM + (buf * 64 + 32 * rb + 8 * a + 4 * hh) * 4);
                        f32x2v x0 = {st[rb][4 * a + 0], st[rb][4 * a + 1]}, x1 = {st[rb][4 * a + 2], st[rb][4 * a + 3]}; const f32x2v c0 = {ck[0], ck[1]}, c1 = {ck[2], ck[3]};
                        x0 -= c0; x1 -= c1; st[rb][4 * a + 0] = x0.x; st[rb][4 * a + 1] = x0.y; st[rb][4 * a + 2] = x1.x; st[rb][4 * a + 3] = x1.y; } }
            if (kv0 + 63 > q0 + 32 * w) { int lim = qrow - kv0 - 4 * hh; FA_LAUNDER(lim); FA_FOREACH_REG({ if (kc > lim) st[rb][i] = -INFINITY; }) }
            sm_update(st, S, ot);
            pv_tile(ot, lds, buf, st, lane);
        }
        if (t + 1 < nt) { tile_store<IS_MLA, !IS_MLA>(R, lds, buf ^ 1, tid, src.cref); if (t + 2 < nt) tile_load<IS_MLA, !IS_MLA>(R, src, kv0 + 128, tid); }
        __syncthreads();
    }
    const float lt = swap32_sum(S.l);
    store_ot(ot, 1.f / lt, orow, hh);
}

#define FA_STREAM(SRC, NT, TILE_EXPR, BODY) do { TileRegs R_; const int nt_ = (NT); \
    if (nt_ > 0) { { const int idx = 0; tile_load<false, false>(R_, SRC, 64 * (TILE_EXPR), tid); } tile_store<false, false>(R_, lds, 0, tid); \
      if (nt_ > 1) { const int idx = 1; tile_load<false, false>(R_, SRC, 64 * (TILE_EXPR), tid); } \
      __syncthreads(); \
      for (int it_ = 0; it_ < nt_; ++it_) { const int buf = it_ & 1; int tile; { const int idx = it_; tile = (TILE_EXPR); } \
          BODY \
          if (it_ + 1 < nt_) { tile_store<false, false>(R_, lds, buf ^ 1, tid); if (it_ + 2 < nt_) { const int idx = it_ + 2; tile_load<false, false>(R_, SRC, 64 * (TILE_EXPR), tid); } } \
          __syncthreads(); } } } while (0)

__device__ __forceinline__ void nsa_unit(const Ctx& c, int b, int g, int j) {
    const int tid = c.tid, lane = c.lane, r = lane & 31, hh = lane >> 5, w = c.wave;
    LAS unsigned char* lds = c.lds;
    const int t0 = 64 * j, tl = r >> 2, hp = r & 3, tokl = 8 * w + tl, tq = t0 + tokl, head = 4 * g + hp; const size_t mrow = (size_t)b * T + tq;
    const bf16_t* P1 = WSP(bf16_t, WS_P1);
    bf16x8 qf[4];
#pragma unroll
    for (int ks = 0; ks < 4; ++ks) qf[ks] = *(const bf16x8*)(P1 + mrow * P1W + C_NQ + head * 64 + 16 * ks + 8 * hh);
    const float gc = sigmoidf_(bf2f(P1[mrow * P1W + C_NG + head * 3 + 0])), gsl = sigmoidf_(bf2f(P1[mrow * P1W + C_NG + head * 3 + 1])), gwn = sigmoidf_(bf2f(P1[mrow * P1W + C_NG + head * 3 + 2]));
    const LAS float* lutL = (const LAS float*)(lds + L_LUT) + head * 132;
    LAS float* PS = (LAS float*)(lds + L_PS); LAS float* FM = (LAS float*)(lds + L_F); LAS unsigned* SEL = (LAS unsigned*)(lds + L_SEL); LAS unsigned* UNI = (LAS unsigned*)(lds + L_UNI);
    LAS unsigned char* TL = (LAS unsigned char*)(lds + L_TL); LAS int* TLN = (LAS int*)(lds + L_TLN);
    f32x16 st[2], ot[2], otot[2]; zero_acc(otot);
    for (int i = tid; i < 2 * 64 * 132; i += NTHREADS) PS[i] = 0.f;
    if (tid < 256) SEL[tid] = 0u; if (tid < 4) UNI[tid] = 0u;
    const float bfar = lutL[128];
    const int tmin = t0 + 8 * w;
    const int n_ok_max = ((t0 + 63 - 31) >> 4) + 1; const int nct = (n_ok_max + 63) >> 6;
    KVSrc srcc; srcc.K = WSP(bf16_t, WS_KC) + (size_t)(b * 2 + g) * 512 * 64; srcc.kpitch = 64; srcc.K2 = nullptr; srcc.k2pitch = 0; srcc.V = WSP(bf16_t, WS_VC) + (size_t)(b * 2 + g) * 512 * 64; srcc.vpitch = 64; srcc.cum = nullptr; srcc.cref = 0.f;
    SmState Sc{-INFINITY, 0.f};
    FA_STREAM(srcc, nct, idx, {
        const bool farc = (16 * (64 * tile + 63) + 31 + 128 <= tmin);
        qk_tile<4>(st, lds, buf, qf, r, hh, sm_cval(Sc) + (farc ? bfar : 0.f));
        if (!farc) { int db_ = tq - 31 - 1024 * tile - 64 * hh; FA_LAUNDER(db_); FA_FOREACH_REG({ const int dist = db_ - 16 * kc; const float s_ = st[rb][i] + lutL[dist < 0 ? 0 : (dist > 128 ? 128 : dist)]; st[rb][i] = dist < 0 ? -INFINITY : s_; }) }
        sm_stats(st, Sc); });
    { const float lt = swap32_sum(Sc.l); const float inv = lt > 0.f ? 1.f / lt : 0.f; const float msafe = (Sc.m == -INFINITY) ? 0.f : Sc.m;
      zero_acc(ot);
      FA_STREAM(srcc, nct, idx, {
        const bool farc = (16 * (64 * tile + 63) + 31 + 128 <= tmin);
        qk_tile<4>(st, lds, buf, qf, r, hh, (farc ? bfar : 0.f) - msafe);
        if (farc) { FA_FOREACH_REG({ st[rb][i] = ex2(st[rb][i]) * inv; }) }
        else { int db_ = tq - 31 - 1024 * tile - 64 * hh; FA_LAUNDER(db_); FA_FOREACH_REG({ const int dist = db_ - 16 * kc; const float s_ = st[rb][i] + lutL[dist < 0 ? 0 : (dist > 128 ? 128 : dist)]; st[rb][i] = dist < 0 ? 0.f : ex2(s_) * inv; }) }
_Pragma("unroll")
        for (int rb = 0; rb < 2; ++rb)
_Pragma("unroll")
            for (int a = 0; a < 4; ++a) { float q4[4];
_Pragma("unroll")
                for (int e = 0; e < 4; ++e) { float v = st[rb][4 * a + e]; v += dpp_f<0xB1>(v); v += dpp_f<0x4E>(v); q4[e] = v; }
                if (hp == 0) { const int G = 16 * tile + 8 * rb + 2 * a + hh; PS[tokl * 132 + G] = q4[0] + 2.f * (q4[1] + q4[2] + q4[3]); FM[tokl * 132 + G] = q4[0]; } }
        pv_tile(ot, lds, buf, st, lane); });
#pragma unroll
      for (int db = 0; db < 2; ++db)
#pragma unroll
          for (int i = 0; i < 16; ++i) otot[db][i] += gc * ot[db][i]; }
    if (j + 1 <= 16) { if (tid < 64) SEL[tid * 4] = (1u << (j + 1)) - 1u; if (tid == 0) UNI[0] = (1u << (j + 1)) - 1u; }
    else {
        for (int i = tid; i < 64 * 128; i += NTHREADS) { const int tk = i >> 7, G = i & 127; if (G >= 1 && G <= j - 2) PS[tk * 132 + G] += FM[tk * 132 + G + 1]; }
        __syncthreads();
        const int tk = tid >> 3, sub = tid & 7; unsigned bits[4] = {0u, 0u, 0u, 0u};
#pragma unroll 1
        for (int k = 0; k < 16; ++k) { const int G = sub + 8 * k;
            if (G >= 1 && G <= j - 2) { const float v = PS[tk * 132 + G]; int cnt = 0;
                for (int G2 = 1; G2 <= j - 2; ++G2) { const float v2 = PS[tk * 132 + G2]; cnt += (v2 > v || (v2 == v && G2 < G)) ? 1 : 0; }
                if (cnt < 13) { if (k < 4) bits[0] |= 1u << G; else if (k < 8) bits[1] |= 1u << (G - 32); else if (k < 12) bits[2] |= 1u << (G - 64); else bits[3] |= 1u << (G - 96); } } }
        if (sub == 0) { bits[0] |= 1u; { const int G = j; if (G < 32) bits[0] |= 1u << G; else if (G < 64) bits[1] |= 1u << (G - 32); else if (G < 96) bits[2] |= 1u << (G - 64); else bits[3] |= 1u << (G - 96); }
                        { const int G = j - 1; if (G < 32) bits[0] |= 1u << G; else if (G < 64) bits[1] |= 1u << (G - 32); else if (G < 96) bits[2] |= 1u << (G - 64); else bits[3] |= 1u << (G - 96); } }
#pragma unroll
        for (int q = 0; q < 4; ++q) if (bits[q]) { atomicOr((unsigned*)(SEL + tk * 4 + q), bits[q]); atomicOr((unsigned*)(UNI + q), bits[q]); }
    }
    __syncthreads();
    if (tid == 0) { int n = 0; for (int q = 0; q < 4; ++q) { unsigned m_ = UNI[q]; while (m_) { const int bpos = __builtin_ctz(m_); m_ &= m_ - 1u; TL[n++] = (unsigned char)(32 * q + bpos); } } TLN[0] = n; }
    __syncthreads();
    const unsigned msk0 = SEL[tokl * 4 + 0], msk1 = SEL[tokl * 4 + 1], msk2 = SEL[tokl * 4 + 2], msk3 = SEL[tokl * 4 + 3];
    const int nsel = __builtin_amdgcn_readfirstlane(TLN[0]);
    { KVSrc srcs; srcs.K = P1 + (size_t)b * T * P1W + C_NKV + ((1 * 2 + 0) * 2 + g) * 64; srcs.kpitch = P1W; srcs.K2 = nullptr; srcs.k2pitch = 0; srcs.V = P1 + (size_t)b * T * P1W + C_NKV + ((1 * 2 + 1) * 2 + g) * 64; srcs.vpitch = P1W; srcs.cum = nullptr; srcs.cref = 0.f;
      SmState Ss{-INFINITY, 0.f}; zero_acc(ot);
      FA_STREAM(srcs, nsel, (int)TL[idx], {
        const int wq = tile >> 5; const unsigned mw = wq == 0 ? msk0 : wq == 1 ? msk1 : wq == 2 ? msk2 : msk3; const bool mine = (mw >> (tile & 31)) & 1u;
        if (__any(mine)) {
            const bool fars = (64 * tile + 63 + 128 <= tmin);
            qk_tile<4>(st, lds, buf, qf, r, hh, mine ? sm_cval(Ss) + (fars ? bfar : 0.f) : -INFINITY);
            if (!fars) { int db_ = tq - 64 * tile - 4 * hh; FA_LAUNDER(db_); FA_FOREACH_REG({ const int dist = db_ - kc; const float s_ = st[rb][i] + lutL[dist < 0 ? 0 : (dist > 128 ? 128 : dist)]; st[rb][i] = (dist >= 0) ? s_ : -INFINITY; }) }
            sm_update(st, Ss, ot);
            pv_tile(ot, lds, buf, st, lane); } });
      const float lt = swap32_sum(Ss.l); const float sc = lt > 0.f ? gsl / lt : 0.f;
#pragma unroll
      for (int db = 0; db < 2; ++db)
#pragma unroll
          for (int i = 0; i < 16; ++i) otot[db][i] += sc * ot[db][i]; }
    { KVSrc srcw; srcw.K = P1 + (size_t)b * T * P1W + C_NKV + ((2 * 2 + 0) * 2 + g) * 64; srcw.kpitch = P1W; srcw.K2 = nullptr; srcw.k2pitch = 0; srcw.V = P1 + (size_t)b * T * P1W + C_NKV + ((2 * 2 + 1) * 2 + g) * 64; srcw.vpitch = P1W; srcw.cum = nullptr; srcw.cref = 0.f;
      const int jlo = j - 8 > 0 ? j - 8 : 0;
      SmState Sw{-INFINITY, 0.f}; zero_acc(ot);
      FA_STREAM(srcw, j - jlo + 1, jlo + idx, {
        qk_tile<4>(st, lds, buf, qf, r, hh, sm_cval(Sw));
        { int db_ = tq - 64 * tile - 4 * hh; FA_LAUNDER(db_); FA_FOREACH_REG({ const int dist = db_ - kc; const float s_ = st[rb][i] + lutL[dist < 0 ? 0 : (dist > 128 ? 128 : dist)]; st[rb][i] = (dist >= 0 && dist < 512) ? s_ : -INFINITY; }) }
        sm_update(st, Sw, ot);
        pv_tile(ot, lds, buf, st, lane); });
      const float lt = swap32_sum(Sw.l); const float sc = lt > 0.f ? gwn / lt : 0.f;
#pragma unroll
      for (int db = 0; db < 2; ++db)
#pragma unroll
          for (int i = 0; i < 16; ++i) otot[db][i] += sc * ot[db][i]; }
    store_ot(otot, 1.f, WSP(bf16_t, WS_OUTA) + mrow * 512 + head * 64, hh);
}
}

__device__ __forceinline__ int next_unit(const Ctx& c, unsigned* ctr) {
    LAS int* u = (LAS int*)(c.lds + fa::L_UNIT);
    __syncthreads();
    if (c.tid == 0) u[0] = (int)__hip_atomic_fetch_add(ctr, 1u, __ATOMIC_RELAXED, __HIP_MEMORY_SCOPE_AGENT);
    __syncthreads();
    return __builtin_amdgcn_readfirstlane(u[0]);
}
__device__ __forceinline__ void phase_att_fast(const Ctx& c0, int l) {
    Ctx c = c0;
    unsigned* ctr = WSP(unsigned, WS_CTL) + CW_QUEUE + 64 * l;
    { const float* lut = WSP(float, WS_TAB) + 512; LAS float* L_ = (LAS float*)(c.lds + fa::L_LUT); for (int i = c.tid; i < 8 * 132; i += NTHREADS) L_[i] = lut[i]; }
    for (;;) {
        const int u = next_unit(c, ctr);
        if (u >= 32 * 48) break;
        relaunder(c);
        const int lv = 31 - u / 48, k = u % 48, kind = k >> 4, id = k & 15;
        if (kind == 0) { if (ATT_FAST_MLA) fa::dense_unit<true>(c, id >> 3, id & 7, lv); }
        else if (kind == 1) { if (ATT_FAST_NSA) fa::nsa_unit(c, (id >> 1) & 1, id & 1, 4 * lv + 3 - (id >> 2)); }
        else { if (ATT_FAST_FOX) fa::dense_unit<false>(c, id >> 3, id & 7, lv); }
    }
}

struct Args { const void* in[32]; float* out; unsigned char* ws; int l_lo, l_hi; };
constexpr int PH_PER_LAYER = 15, K_FINAL = 1 + PH_PER_LAYER;
template <int KIND>
__global__ void __launch_bounds__(NTHREADS, 2) fwd_kernel(Args a) {
    extern __shared__ __attribute__((aligned(16))) unsigned char lds_raw[];
    Ctx c;
    c.out = a.out; c.ws = a.ws; c.ws0 = a.ws; c.lds = (LAS unsigned char*)lds_raw;
    c.tid = threadIdx.x; c.lane = c.tid & 63; c.wave = __builtin_amdgcn_readfirstlane(c.tid >> 6); c.G = gridDim.x; c.bid = blockIdx.x;
    if (c.tid < 4) ((LAS unsigned*)(c.lds + LDS_MISC))[c.tid] = 0u;
    if (c.tid < 32) { const unsigned long long pv = (unsigned long long)a.in[c.tid]; ((LAS unsigned*)(c.lds + LDS_INTAB))[2 * c.tid] = (unsigned)pv; ((LAS unsigned*)(c.lds + LDS_INTAB))[2 * c.tid + 1] = (unsigned)(pv >> 32); }
    __syncthreads();
    XcdBarrier bar; bar.bar = WSP(unsigned, WS_CTL) + CW_BAR; bar.x = 0; bar.st = nullptr;
    if constexpr (KIND < 0) bar = xcd_barrier_post(WSP(unsigned, WS_CTL) + CW_BAR, (volatile LAS unsigned*)(c.lds + LDS_MISC));
#define IN(k) ((KIND < 0 || KIND == (k)) && (relaunder(c), true))
#define REP(p) for (int rep_ = 0; rep_ < ((PROBE_DOUBLE == (p)) ? 2 : 1); ++rep_)
#define SEAM(k) do { if constexpr (KIND < 0) { unsigned* bb_ = bar.bar; asm volatile("" : "+s"(bb_)); bar.bar = bb_; xcd_barrier(bar); } } while (0)
    LAS unsigned char* ring = c.lds;

    if (IN(0)) REP(4) { phase_prologue(c); } SEAM(0);
    for (int l = a.l_lo; l < a.l_hi; ++l) {
        constexpr int pb = 1;
        const float* resid = (l == 0) ? c.x() : WSP(float, WS_XA);
        if (IN(pb + 0)) { if (l == 0) phase_norm(c, c.x(), nullptr, nullptr, nullptr, WSP(bf16_t, WS_H0));
                          else phase_norm(c, WSP(float, WS_XA), WSP(bf16_t, WS_Y), WSP(bf16_t, WS_Y) + (size_t)M * D, WSP(float, WS_XA), WSP(bf16_t, WS_H0));
#if PROBE_DOUBLE == 6
                          if (l == 0) phase_norm(c, c.x(), nullptr, nullptr, nullptr, WSP(bf16_t, WS_HG));
                          else phase_norm(c, WSP(float, WS_XA), WSP(bf16_t, WS_Y), WSP(bf16_t, WS_Y) + (size_t)M * D, WSP(float, WS_P1), WSP(bf16_t, WS_QB));
#endif
        } SEAM(pb + 0);
        if (IN(pb + 1)) REP(2) { pg8::Cfg g{(unsigned)(D * 2), 128u, (unsigned)(D * 2), D / 64, nullptr}; pg8::DenseOrder S; S.init(M / 256, P1W / 256, c.G, c.bid, WSP(bf16_t, WS_H0), (size_t)256 * D * 2, WSP(bf16_t, WS_WINT) + (size_t)l * P1W * D, (size_t)256 * D * 2);
            EpiStoreBf16 E{WSP(bf16_t, WS_P1), P1W, nullptr, 0}; pg8::gemm_phase<false>(ring, c.wave, g, S, E); } SEAM(pb + 1);
        if (IN(pb + 2)) REP(5) { phase_prep(c, l); } SEAM(pb + 2);
        if (IN(pb + 3)) REP(5) { phase_cum(c); } SEAM(pb + 3);
        if (IN(pb + 4)) REP(2) {
            { pg8::Cfg g{(unsigned)(P1W * 2), 128u, 512u, 4, nullptr}; pg8::DenseOrder S; S.init(M / 256, 3, c.G, c.bid, WSP(bf16_t, WS_P1) + C_CQ, (size_t)256 * P1W * 2, WSP(bf16_t, WS_WUQT) + (size_t)l * 768 * 256, (size_t)256 * 512);
              EpiStoreBf16 E{WSP(bf16_t, WS_QB), 768, WSP(float, WS_RSTD), 2}; pg8::gemm_phase<false>(ring, c.wave, g, S, E); }
            { pg8::Cfg g{(unsigned)(P1W * 2), 128u, 256u, 2, nullptr}; pg8::DenseOrder S; S.init(M / 256, 4, c.G, c.bid, WSP(bf16_t, WS_P1) + C_CKV, (size_t)256 * P1W * 2, WSP(bf16_t, WS_WUKVT) + (size_t)l * 1024 * 128, (size_t)256 * 256);
              EpiStoreBf16 E{WSP(bf16_t, WS_KVB), 1024, WSP(float, WS_RSTD) + 1, 2}; pg8::gemm_phase<false>(ring, c.wave, g, S, E); }
            { pg8::Cfg g{(unsigned)(16 * P1W * 2), (unsigned)(P1W * 2), 4096u, 32, nullptr}; CmpOrder S{c.G, (c.bid + 64) % c.G, (const char*)WSP(bf16_t, WS_P1), (const char*)(WSP(bf16_t, WS_WC1T) + (size_t)l * 2 * 256 * 2048)};
              EpiCmp1 E{WSP(bf16_t, WS_HC), WSP(float, WS_TAB) + l * 256}; pg8::gemm_phase<false>(ring, c.wave, g, S, E); }
        } SEAM(pb + 4);
        if (IN(pb + 5)) { phase_cmp2_ropeq(c, l); } SEAM(pb + 5);
        if (IN(pb + 6)) { phase_att_fast(c, l);
#if PROBE_DOUBLE == 1
            phase_att_fast(c, l + 2);
#endif
        } SEAM(pb + 6);
        if (IN(pb + 7)) REP(5) { phase_norm(c, resid, nullptr, nullptr, nullptr, WSP(bf16_t, WS_HG)); } SEAM(pb + 7);
        if (IN(pb + 8)) REP(2) { pg8::Cfg g{(unsigned)(D * 2), 128u, (unsigned)(D * 2), D / 64, nullptr}; pg8::DenseOrder S; S.init(M / 256, 12, c.G, c.bid, WSP(bf16_t, WS_HG), (size_t)256 * D * 2, WSP(bf16_t, WS_WMT) + (size_t)l * 3072 * D, (size_t)256 * D * 2);
            EpiGates E{WSP(bf16_t, WS_GATES), c.b_merge() + l * 3072}; pg8::gemm_phase<false>(ring, c.wave, g, S, E); } SEAM(pb + 8);
        if (IN(pb + 9)) REP(2) {
#pragma unroll 1
            for (int br = 0; br < 3; ++br) { pg8::Cfg g{1024u, 128u, 1024u, 8, nullptr}; pg8::DenseOrder S;
                S.init(M / 256, 4, c.G, c.bid, WSP(bf16_t, br == 0 ? WS_OUTA : br == 1 ? WS_OUTB : WS_OUTC), (size_t)256 * 1024, WSP(bf16_t, WS_WOT) + ((size_t)l * 3 + br) * 1024 * 512, (size_t)256 * 1024);
                EpiOutproj E{WSP(bf16_t, WS_MIXED), WSP(bf16_t, WS_GATES), br}; pg8::gemm_phase<false>(ring, c.wave, g, S, E); }
        } SEAM(pb + 9);
        if (IN(pb + 10)) { pg8::Cfg g{(unsigned)(D * 2), 128u, (unsigned)(D * 2), D / 64, nullptr}; pg8::DenseOrder S; S.init(M / 256, 4, c.G, c.bid, WSP(bf16_t, WS_MIXED), (size_t)256 * D * 2, WSP(bf16_t, WS_WOUTT) + (size_t)l * D * D, (size_t)256 * D * 2);
            EpiWout E{resid, WSP(float, WS_XA)}; pg8::gemm_phase<false>(ring, c.wave, g, S, E);
#if PROBE_DOUBLE == 6
            { EpiWout E2{resid, (float*)(c.ws + PB + 32 * MiB)}; pg8::gemm_phase<false>(ring, c.wave, g, S, E2); }
#endif
        } SEAM(pb + 10);
        if (IN(pb + 11)) { phase_router(c, l);
#if PROBE_DOUBLE == 3
            phase_router(c, l, 1);
#endif
        } SEAM(pb + 11);
        if (IN(pb + 12)) REP(4) { phase_place(c, l); } SEAM(pb + 12);
        if (IN(pb + 13)) REP(2) { LAS int* tab = (LAS int*)(c.lds + LDS_MOETAB); moe_tables(c, l, tab);
            pg8::Cfg g{(unsigned)(D * 2), 128u, (unsigned)(D * 2), D / 64, WSP(int, WS_LTOK)}; MoeOrder S{c.G, c.bid, 2, tab, (const char*)WSP(bf16_t, WS_H2), 0, (const char*)WSP(bf16_t, WS_WGU), (size_t)512 * D * 2, (size_t)256 * D * 2};
            EpiMoe1 E{WSP(bf16_t, WS_HID), WSP(float, WS_LW)}; pg8::gemm_phase<true>(ring, c.wave, g, S, E); } SEAM(pb + 13);
        if (IN(pb + 14)) REP(2) { LAS int* tab = (LAS int*)(c.lds + LDS_MOETAB); moe_tables(c, l, tab);
            pg8::Cfg g{512u, 128u, 512u, 4, nullptr}; MoeOrder S{c.G, c.bid, 4, tab, (const char*)WSP(bf16_t, WS_HID), 512, (const char*)WSP(bf16_t, WS_WDT), (size_t)D * 256 * 2, (size_t)256 * 256 * 2};
            EpiMoe2 E{WSP(bf16_t, WS_Y), WSP(unsigned, WS_LSLOT)}; pg8::gemm_phase<false>(ring, c.wave, g, S, E); } SEAM(pb + 14);
    }
    if (IN(K_FINAL)) REP(6) { phase_final(c); }
#undef IN
#undef SEAM
}

template <int KIND> static bool prep_kernel() { return hipFuncSetAttribute((const void*)fwd_kernel<KIND>, hipFuncAttributeMaxDynamicSharedMemorySize, LDS_BYTES) == hipSuccess; }
template <int KIND> static void launch_kind(int grid, hipStream_t stream, Args a, int l) { a.l_lo = l; a.l_hi = l + 1; hipLaunchKernelGGL(fwd_kernel<KIND>, dim3(grid), dim3(NTHREADS), LDS_BYTES, stream, a); }
extern "C" void kernel_launch(void* const* d_in, const int* in_sizes, int n_in, void* d_out, int out_size, void* d_ws, size_t ws_size, hipStream_t stream) {
    static int grid = 0;
    if (grid == 0) {
        if (n_in != 32 || ws_size < WS_END) { fprintf(stderr, "kernel_launch: n_in %d ws %zu (need %zu)\n", n_in, ws_size, (size_t)WS_END); grid = -1; return; }
        int dev = 0, cus = 0;
        if (hipGetDevice(&dev) != hipSuccess || hipDeviceGetAttribute(&cus, hipDeviceAttributeMultiprocessorCount, dev) != hipSuccess) { grid = -1; return; }
        bool ok = true;
#if MK_ONE_LAUNCH
        ok = prep_kernel<-1>();
#else
        ok = prep_kernel<0>() && prep_kernel<1>() && prep_kernel<2>() && prep_kernel<3>() && prep_kernel<4>() && prep_kernel<5>() && prep_kernel<6>() && prep_kernel<7>() && prep_kernel<8>() && prep_kernel<9>()
          && prep_kernel<10>() && prep_kernel<11>() && prep_kernel<12>() && prep_kernel<13>() && prep_kernel<14>() && prep_kernel<15>() && prep_kernel<16>();
#endif
        if (!ok) { grid = -1; return; }
        (void)hipGetLastError();
        grid = cus;
    }
    if (grid < 0) return;
    (void)hipMemsetAsync((char*)d_ws + WS_CTL, 0, CTL_BYTES, stream);
    Args a{};
    for (int i = 0; i < 32; ++i) a.in[i] = d_in[i];
    a.out = (float*)d_out; a.ws = (unsigned char*)d_ws;
#if MK_ONE_LAUNCH
    a.l_lo = 0; a.l_hi = NL;
    hipLaunchKernelGGL(fwd_kernel<-1>, dim3(grid), dim3(NTHREADS), LDS_BYTES, stream, a);
#else
    launch_kind<0>(grid, stream, a, 0);
    for (int l = 0; l < NL; ++l) {
        launch_kind<1>(grid, stream, a, l); launch_kind<2>(grid, stream, a, l); launch_kind<3>(grid, stream, a, l); launch_kind<4>(grid, stream, a, l); launch_kind<5>(grid, stream, a, l);
        launch_kind<6>(grid, stream, a, l); launch_kind<7>(grid, stream, a, l); launch_kind<8>(grid, stream, a, l); launch_kind<9>(grid, stream, a, l); launch_kind<10>(grid, stream, a, l);
        launch_kind<11>(grid, stream, a, l); launch_kind<12>(grid, stream, a, l); launch_kind<13>(grid, stream, a, l); launch_kind<14>(grid, stream, a, l); launch_kind<15>(grid, stream, a, l);
    }
    launch_kind<16>(grid, stream, a, 0);
#endif
}
```

```cpp
#include <hip/hip_runtime.h>
#include <stdint.h>
#include <cstdio>

#ifndef PROBE_DOUBLE
#define PROBE_DOUBLE 0
#endif
#ifndef MK_ONE_LAUNCH
#define MK_ONE_LAUNCH 1
#endif

#define LAS __attribute__((address_space(3)))
typedef unsigned short bf16_t;
typedef short bf16x8 __attribute__((ext_vector_type(8)));
typedef float f32x4 __attribute__((ext_vector_type(4)));
typedef float f32x16 __attribute__((ext_vector_type(16)));
typedef unsigned u32x4 __attribute__((ext_vector_type(4)));
typedef unsigned u32x2 __attribute__((ext_vector_type(2)));

constexpr int NB = 2, T = 8192, D = 1024, M = NB * T, NL = 2;
constexpr int DIN = 6336;
constexpr int P1W = 3328;
constexpr int C_NQ = 0, C_NKV = 512, C_CQ = 1280, C_CKV = 1536, C_KR = 1664, C_NG = 1696, C_FF = 1720, C_FQKV = 1728;
constexpr int NEXP = 32, EDIM = 256;
constexpr float EPS = 1e-6f;
constexpr float LOG2E = 1.4426950408889634f;
constexpr float QSCALE64 = 0.125f * LOG2E, QSCALE96 = 0.10206207261596575f * LOG2E;
constexpr int NTHREADS = 512, NWAVES = 8;
constexpr int LDS_BYTES = 147456;
constexpr int MOE_MAXROWS = 40960;

constexpr size_t MiB = 1u << 20;
constexpr size_t WS_CTL = 0;
constexpr size_t CTL_BYTES = 1 * MiB;
constexpr int CW_BAR = 4096;
constexpr int CW_QUEUE = 16384;
constexpr int CW_MOECNT = 32768;
constexpr int CW_CNTB = 65536;
constexpr size_t CTL_LTOK = 512 * 1024;
constexpr size_t WS_WINT = 1 * MiB;
constexpr size_t WS_WMT = 14 * MiB;
constexpr size_t WS_WUQT = 26 * MiB;
constexpr size_t WS_WUKVT = 27 * MiB;
constexpr size_t WS_WOT = 28 * MiB;
constexpr size_t WS_WOUTT = 34 * MiB;
constexpr size_t WS_WC1T = 38 * MiB;
constexpr size_t WS_ROPE = 42 * MiB;
constexpr size_t WS_TAB = 44 * MiB;
constexpr size_t WS_XA = 45 * MiB;
constexpr size_t PB = 109 * MiB;
constexpr size_t WS_P1 = PB;
constexpr size_t WS_QB = PB + 104 * MiB;
constexpr size_t WS_KVB = PB + 128 * MiB;
constexpr size_t WS_OUTA = PB + 160 * MiB;
constexpr size_t WS_OUTB = PB + 176 * MiB;
constexpr size_t WS_OUTC = PB + 192 * MiB;
constexpr size_t WS_H0 = PB + 176 * MiB;
constexpr size_t WS_SM = PB + 208 * MiB;
constexpr size_t WS_RSTD = WS_SM;
constexpr size_t WS_KR = WS_SM + 256 * 1024;
constexpr size_t WS_LF = WS_SM + 1280 * 1024;
constexpr size_t WS_CUM = WS_SM + 1792 * 1024;
constexpr size_t WS_HC = WS_SM + 2304 * 1024;
constexpr size_t WS_KC = WS_SM + 3328 * 1024;
constexpr size_t WS_VC = WS_SM + 3584 * 1024;
constexpr size_t WS_REC = WS_SM + 3840 * 1024;
constexpr size_t WS_LTOK = WS_SM + 4352 * 1024;
constexpr size_t WS_LW = WS_SM + 4608 * 1024;
constexpr size_t WS_LSLOT = WS_SM + 4864 * 1024;
constexpr size_t WS_END = PB + 216 * MiB;
constexpr size_t WS_HG = PB;
constexpr size_t WS_GATES = PB + 32 * MiB;
constexpr size_t WS_MIXED = PB + 128 * MiB;
constexpr size_t WS_H2 = PB;
constexpr size_t WS_WGU = PB + 32 * MiB;
constexpr size_t WS_WDT = PB + 64 * MiB;
constexpr size_t WS_HID = PB + 80 * MiB;
constexpr size_t WS_Y = PB + 100 * MiB;
static_assert(WS_Y + 64 * MiB <= WS_H0, "Y must not overlap H0");
static_assert(WS_END <= 332 * MiB, "workspace budget");

__device__ __forceinline__ float bf2f(bf16_t v) { return __uint_as_float((unsigned)v << 16); }
__device__ __forceinline__ unsigned f2bf(float f) { unsigned u = __float_as_uint(f); return (u + 0x7fffu + ((u >> 16) & 1u)) >> 16; }
__device__ __forceinline__ unsigned pk2(float lo, float hi) { return f2bf(lo) | (f2bf(hi) << 16); }
typedef float f32x2_t __attribute__((ext_vector_type(2))); typedef __bf16 bf16x2_t __attribute__((ext_vector_type(2)));
__device__ __forceinline__ unsigned cvtpk(float lo, float hi) { f32x2_t v = {lo, hi}; bf16x2_t b = __builtin_convertvector(v, bf16x2_t); return __builtin_bit_cast(unsigned, b); }
template <int CTRL> __device__ __forceinline__ float dpp_f(float v) { return __int_as_float(__builtin_amdgcn_update_dpp(0, __float_as_int(v), CTRL, 0xf, 0xf, true)); }
__device__ __forceinline__ float wave_sum(float v) {
    v += dpp_f<0xB1>(v); v += dpp_f<0x4E>(v); v += dpp_f<0x141>(v); v += dpp_f<0x140>(v);
    const float a = __int_as_float(__builtin_amdgcn_readlane(__float_as_int(v), 0)), b = __int_as_float(__builtin_amdgcn_readlane(__float_as_int(v), 16));
    const float c2 = __int_as_float(__builtin_amdgcn_readlane(__float_as_int(v), 32)), d = __int_as_float(__builtin_amdgcn_readlane(__float_as_int(v), 48));
    return (a + b) + (c2 + d);
}
__device__ __forceinline__ float wave_max(float v) {
    v = fmaxf(v, dpp_f<0xB1>(v)); v = fmaxf(v, dpp_f<0x4E>(v)); v = fmaxf(v, dpp_f<0x141>(v)); v = fmaxf(v, dpp_f<0x140>(v));
    const float a = __int_as_float(__builtin_amdgcn_readlane(__float_as_int(v), 0)), b = __int_as_float(__builtin_amdgcn_readlane(__float_as_int(v), 16));
    const float c2 = __int_as_float(__builtin_amdgcn_readlane(__float_as_int(v), 32)), d = __int_as_float(__builtin_amdgcn_readlane(__float_as_int(v), 48));
    return fmaxf(fmaxf(a, b), fmaxf(c2, d));
}
__device__ __forceinline__ float half_sum(float v) { auto rr = __builtin_amdgcn_permlane32_swap(__float_as_uint(v), __float_as_uint(v), false, false); return __uint_as_float(rr[0]) + __uint_as_float(rr[1]); }
__device__ __forceinline__ float sigmoidf_(float x) { return 1.f / (1.f + __expf(-x)); }
__device__ __forceinline__ float gelu_tanh(float x) { const float u = 0.7978845608028654f * (x + 0.044715f * x * x * x); const float th = 1.f - 2.f / (1.f + __expf(2.f * u)); return 0.5f * x * (1.f + th); }
#define LDS_WAIT() asm volatile("s_waitcnt lgkmcnt(0)" ::: "memory")

#define XB_TMO      128
#define XB_XCNT(j)  (256  + 64 * (j))
#define XB_XSUB(j)  (1280 + 64 * (j))
#define XB_XGEN(j)  (2304 + 64 * (j))
#define XB_TOP      3328
#define XB_TOPGEN   3392
#define XCD_BAR_WORDS 3456
#define XB_SPIN_CAP (1u << 18)

__device__ __forceinline__ unsigned xb_ld(unsigned* p)              { return __hip_atomic_load(p, __ATOMIC_RELAXED, __HIP_MEMORY_SCOPE_AGENT); }
__device__ __forceinline__ unsigned xb_add(unsigned* p, unsigned v) { return __hip_atomic_fetch_add(p, v, __ATOMIC_RELAXED, __HIP_MEMORY_SCOPE_AGENT); }
__device__ __forceinline__ unsigned xb_xcc_id() { return (unsigned)__builtin_amdgcn_s_getreg((3 << 11) | 20) & 0xFu; }
#define XB_SPIN(cond, bar) do { unsigned _sp = 0; while (cond) { __builtin_amdgcn_s_sleep(1); \
    if ((++_sp & 255u) == 0u) { if (xb_ld(&(bar)[XB_TMO])) break; if (_sp > XB_SPIN_CAP) { atomicAdd(&(bar)[XB_TMO], 1u); break; } } } } while (0)

struct XcdBarrier { unsigned* bar; unsigned x; volatile LAS unsigned* st; };

__device__ __forceinline__ XcdBarrier xcd_barrier_post(unsigned* bar, volatile LAS unsigned* st) {
    XcdBarrier b; b.bar = bar; b.x = xb_xcc_id(); b.st = st;
    if (threadIdx.x == 0) (void)xb_add(&bar[XB_XCNT(b.x)], 1u);
    return b;
}
__device__ __forceinline__ void xcd_barrier_complete(unsigned* bar, unsigned x, unsigned& nloc, unsigned& nx) {
    const unsigned G = gridDim.x * gridDim.y * gridDim.z;
    unsigned sum, cnt, mine, sp = 0u;
    for (;;) {
        sum = 0u; cnt = 0u; mine = 0u;
#pragma unroll
        for (unsigned j = 0; j < 16; ++j) { const unsigned c = xb_ld(&bar[XB_XCNT(j)]); sum += c; cnt += (c > 0u) ? 1u : 0u; mine = (j == x) ? c : mine; }
        if (sum == G) break;
        __builtin_amdgcn_s_sleep(1);
        if ((++sp & 255u) == 0u) { if (xb_ld(&bar[XB_TMO])) break; if (sp > XB_SPIN_CAP) { atomicAdd(&bar[XB_TMO], 1u); break; } }
    }
    nloc = mine > 0u ? mine : 1u; nx = cnt > 0u ? cnt : 1u;
}
__device__ __forceinline__ void xcd_barrier(const XcdBarrier& b) {
    asm volatile("s_waitcnt vmcnt(0)" ::: "memory");
    __syncthreads();
    if (threadIdx.x == 0) {
        unsigned* bar = b.bar;
        __builtin_amdgcn_s_waitcnt(0);
        unsigned nloc = b.st[0], nx = b.st[1];
        if (nloc == 0u) { xcd_barrier_complete(bar, b.x, nloc, nx); b.st[0] = nloc; b.st[1] = nx; }
        const unsigned old = xb_add(&bar[XB_XSUB(b.x)], 1u);
        const unsigned gen = old / nloc;
        if (old + 1u == (gen + 1u) * nloc) {
            __builtin_amdgcn_fence(__ATOMIC_RELEASE, "agent");
            asm volatile("s_waitcnt vmcnt(0)" ::: "memory");
            const unsigned og = xb_add(&bar[XB_TOP], 1u);
            const unsigned tg = og / nx;
            if (og + 1u == (tg + 1u) * nx) xb_add(&bar[XB_TOPGEN], 1u);
            else XB_SPIN(xb_ld(&bar[XB_TOPGEN]) == tg, bar);
            __builtin_amdgcn_fence(__ATOMIC_ACQUIRE, "agent");
            xb_add(&bar[XB_XGEN(b.x)], 1u);
            asm volatile("s_waitcnt vmcnt(0)" ::: "memory");
        } else {
            XB_SPIN(xb_ld(&bar[XB_XGEN(b.x)]) == gen, bar);
            __builtin_amdgcn_fence(__ATOMIC_ACQUIRE, "agent");
            asm volatile("s_waitcnt vmcnt(0)" ::: "memory");
        }
    }
    __syncthreads();
}

namespace pg8 {
constexpr int BM = 256, BK = 64, HALF = 128, HTB = HALF * BK * 2, STAGE_BYTES = 8 * HTB;
__host__ __device__ __forceinline__ int lds_byte(int r, int c) { const int st = (r >> 4) * 2 + (c >> 5), rr = r & 15, cc = c & 31, ob = rr * 64 + cc * 2; return st * 1024 + (ob ^ (((ob >> 9) & 1) << 5)); }
__host__ __device__ __forceinline__ void stage_rc(int b, int& R, int& C) { const int st = b / 1024, sb = b % 1024, swz = sb ^ (((sb >> 9) & 1) << 5); R = (st >> 1) * 16 + swz / 64; C = (st & 1) * 32 + (swz % 64) / 2; }

struct Unit { int pm, pn; const char* A; const char* B; int aux; };
struct Cfg { unsigned lda; unsigned kstepA; unsigned ldb; int nt; const int* rowidx; };

struct DenseOrder {
    int nM, nN, nwg, G, c; const char* A; const char* B; size_t tstepA, tstepB;
    __device__ void init(int nM_, int nN_, int G_, int c_, const void* A_, size_t tstepA_, const void* B_, size_t tstepB_) { nM = nM_; nN = nN_; nwg = nM * nN; G = G_; c = c_; A = (const char*)A_; B = (const char*)B_; tstepA = tstepA_; tstepB = tstepB_; }
    __device__ bool next(int i, Unit& u) const {
        const long Lq = (long)i * G + c; if (Lq >= nwg) return false;
        int wgid = (int)Lq; { const int q = nwg / 8, r = nwg % 8, xcd = wgid % 8, off = wgid / 8; wgid = (xcd < r ? xcd * (q + 1) : r * (q + 1) + (xcd - r) * q) + off; }
        const int nig = 8 * nN, gid = wgid / nig, fm = gid * 8, gsz = (nM - fm) < 8 ? (nM - fm) : 8;
        u.pm = fm + ((wgid % nig) % gsz); u.pn = (wgid % nig) / gsz; u.A = A + (size_t)u.pm * tstepA; u.B = B + (size_t)u.pn * tstepB; u.aux = 0; return true;
    }
};

#define PG8_EPI_ROWCOL(row, col) const int row = u.pm * 256 + ai * 128 + wr * 64 + m * 16 + fr; const int col = u.pn * 256 + bj * 128 + wc * 32 + n * 16 + fq * 4;

template <bool INDEXED, class Epi, class Sched>
__device__ __forceinline__ void gemm_phase(LAS unsigned char* lds, int wid, const Cfg g, const Sched& S, const Epi& E) {
    int lane_; asm volatile("v_mbcnt_lo_u32_b32 %0, -1, 0\n\tv_mbcnt_hi_u32_b32 %0, -1, %0" : "=v"(lane_));
    const int lane = lane_, tid = wid * 64 + lane, wr = wid >> 2, wc = wid & 3, fr = lane & 15, fq = lane >> 4;
    const int nt = g.nt;
    int Rs[2], Cs[2]; unsigned voffB[2];
#pragma unroll
    for (int i = 0; i < 2; ++i) { stage_rc(tid * 16 + i * 8192, Rs[i], Cs[i]); voffB[i] = (unsigned)Rs[i] * g.ldb + (unsigned)Cs[i] * 2u; }
    const size_t kstepA = g.kstepA, kstepB = (size_t)(BK * 2);
    const size_t hstepB = (size_t)HALF * g.ldb;
    const unsigned ldsw = (unsigned)wid * 1024u;
    const int aoff = lds_byte(wr * 64 + fr, fq * 8), boff = lds_byte(wc * 32 + fr, fq * 8);
#define PG8_SA(b, h) (((b) * 2 + (h)) * HTB)
#define PG8_SB(b, h) ((4 + (b) * 2 + (h)) * HTB)
#define PG8_STAGE2(bufoff, gbase, v0, v1) do { const char* gb_ = (const char*)(gbase); asm volatile("" : "+s"(gb_)); \
        __builtin_amdgcn_global_load_lds((const unsigned*)(gb_ + (v0)), (LAS unsigned*)(lds + (bufoff) + ldsw), 16, 0, 0); \
        __builtin_amdgcn_global_load_lds((const unsigned*)(gb_ + (v1)), (LAS unsigned*)(lds + (bufoff) + ldsw + 8192), 16, 0, 0); } while (0)
#define PG8_STAGEB(bufoff, gbase) PG8_STAGE2(bufoff, gbase, voffB[0], voffB[1])
#define PG8_LDA(dst, b, h) do { _Pragma("unroll") for (int m = 0; m < 4; ++m) _Pragma("unroll") for (int k = 0; k < 2; ++k) dst[m][k] = *(const LAS bf16x8*)(lds + PG8_SA(b, h) + aoff + m * 2048 + k * 1024); } while (0)
#define PG8_LDB(dst, b, h) do { _Pragma("unroll") for (int n = 0; n < 2; ++n) _Pragma("unroll") for (int k = 0; k < 2; ++k) dst[n][k] = *(const LAS bf16x8*)(lds + PG8_SB(b, h) + boff + n * 2048 + k * 1024); } while (0)
#define PG8_MMA(ai, bj, At, Bt) do { __builtin_amdgcn_s_setprio(1); _Pragma("unroll") for (int m = 0; m < 4; ++m) _Pragma("unroll") for (int n = 0; n < 2; ++n) _Pragma("unroll") for (int k = 0; k < 2; ++k) \
        acc[ai][bj][m][n] = __builtin_amdgcn_mfma_f32_16x16x32_bf16(Bt[n][k], At[m][k], acc[ai][bj][m][n], 0, 0, 0); __builtin_amdgcn_s_setprio(0); } while (0)
#define PG8_WAIT_V(n) asm volatile("s_waitcnt vmcnt(" #n ")" ::: "memory")
#define PG8_WAIT_L(n) asm volatile("s_waitcnt lgkmcnt(" #n ")" ::: "memory")
#define PG8_BAR __builtin_amdgcn_s_barrier()
#define PG8_SCHED __builtin_amdgcn_sched_barrier(0)
    Unit cur, nxt; int ui = 0;
    if (!S.next(0, cur)) return;
    unsigned vAc[2][2], vAn[2][2];
#define PG8_SETVA(v, U) do { _Pragma("unroll") for (int h_ = 0; h_ < 2; ++h_) _Pragma("unroll") for (int i_ = 0; i_ < 2; ++i_) { \
        if constexpr (INDEXED) { const int r_ = g.rowidx[(U).aux + h_ * HALF + Rs[i_]]; v[h_][i_] = (unsigned)r_ * g.lda + (unsigned)Cs[i_] * 2u; } \
        else v[h_][i_] = (unsigned)(h_ * HALF + Rs[i_]) * g.lda + (unsigned)Cs[i_] * 2u; } } while (0)
    PG8_SETVA(vAc, cur);
    f32x4 acc[2][2][4][2];
#pragma unroll
    for (int a = 0; a < 2; ++a)
#pragma unroll
        for (int b = 0; b < 2; ++b)
#pragma unroll
            for (int m = 0; m < 4; ++m)
#pragma unroll
                for (int n = 0; n < 2; ++n) acc[a][b][m][n] = (f32x4){0.f, 0.f, 0.f, 0.f};
    bf16x8 At[4][2], B0[2][2], B1[2][2];
    const char* cA = cur.A; const char* cB = cur.B;
    PG8_STAGEB(PG8_SB(0, 0), cB); PG8_STAGEB(PG8_SB(0, 1), cB + hstepB); PG8_STAGE2(PG8_SA(0, 0), cA, vAc[0][0], vAc[0][1]); PG8_STAGE2(PG8_SA(0, 1), cA, vAc[1][0], vAc[1][1]);
    if (wr == 1) PG8_BAR;
    PG8_WAIT_V(2); PG8_BAR;
    PG8_STAGEB(PG8_SB(1, 0), cB + kstepB); PG8_STAGE2(PG8_SA(1, 0), cA + kstepA, vAc[0][0], vAc[0][1]); PG8_STAGEB(PG8_SB(1, 1), cB + hstepB + kstepB);
    PG8_WAIT_V(6); PG8_BAR;
    for (;;) {
        const bool has_next = S.next(ui + 1, nxt);
        const char* nA = has_next ? nxt.A : cA; const char* nB = has_next ? nxt.B : cB;
        if (has_next) { PG8_SETVA(vAn, nxt); } else {
#pragma unroll
            for (int h_ = 0; h_ < 2; ++h_)
#pragma unroll
                for (int i_ = 0; i_ < 2; ++i_) vAn[h_][i_] = vAc[h_][i_]; }
        for (int t = 0; t < nt; t += 2) {
            const bool last = (t == nt - 2);
            const char* a1 = cA + (size_t)(t + 1) * kstepA;
            const char* a2 = last ? nA : cA + (size_t)(t + 2) * kstepA; const char* b2 = last ? nB : cB + (size_t)(t + 2) * kstepB;
            const char* a3 = a2 + kstepA; const char* b3 = b2 + kstepB;
            const unsigned w00 = last ? vAn[0][0] : vAc[0][0], w01 = last ? vAn[0][1] : vAc[0][1], w10 = last ? vAn[1][0] : vAc[1][0], w11 = last ? vAn[1][1] : vAc[1][1];
            PG8_LDB(B0, 0, 0); PG8_LDB(B1, 0, 1); PG8_SCHED; PG8_LDA(At, 0, 0); PG8_STAGE2(PG8_SA(1, 1), a1, vAc[1][0], vAc[1][1]);
            PG8_WAIT_V(8); PG8_WAIT_L(0); PG8_BAR; PG8_MMA(0, 0, At, B0); PG8_MMA(0, 1, At, B1); PG8_BAR; PG8_SCHED;
            PG8_LDA(At, 0, 1); PG8_STAGEB(PG8_SB(0, 0), b2); PG8_STAGEB(PG8_SB(0, 1), b2 + hstepB); PG8_STAGE2(PG8_SA(0, 0), a2, w00, w01);
            PG8_WAIT_V(8); PG8_WAIT_L(0); PG8_BAR; PG8_MMA(1, 0, At, B0); PG8_MMA(1, 1, At, B1); PG8_BAR; PG8_SCHED;
            PG8_LDB(B0, 1, 0); PG8_LDB(B1, 1, 1); PG8_SCHED; PG8_LDA(At, 1, 0); PG8_STAGE2(PG8_SA(0, 1), a2, w10, w11);
            PG8_WAIT_V(8); PG8_WAIT_L(0); PG8_BAR; PG8_MMA(0, 0, At, B0); PG8_MMA(0, 1, At, B1); PG8_BAR; PG8_SCHED;
            PG8_LDA(At, 1, 1); PG8_STAGEB(PG8_SB(1, 0), b3); PG8_STAGEB(PG8_SB(1, 1), b3 + hstepB); PG8_STAGE2(PG8_SA(1, 0), a3, w00, w01);
            PG8_WAIT_V(8); PG8_WAIT_L(0); PG8_BAR; PG8_MMA(1, 0, At, B0); PG8_MMA(1, 1, At, B1); PG8_BAR; PG8_SCHED;
        }
        { int l2_; asm volatile("v_mbcnt_lo_u32_b32 %0, -1, 0\n\tv_mbcnt_hi_u32_b32 %0, -1, %0" : "=v"(l2_)); E(acc, cur, wr, wc, l2_ & 15, l2_ >> 4); }
        if (!has_next) break;
#pragma unroll
        for (int a = 0; a < 2; ++a)
#pragma unroll
            for (int b = 0; b < 2; ++b)
#pragma unroll
                for (int m = 0; m < 4; ++m)
#pragma unroll
                    for (int n = 0; n < 2; ++n) acc[a][b][m][n] = (f32x4){0.f, 0.f, 0.f, 0.f};
        cur = nxt; cA = nA; cB = nB; ++ui;
#pragma unroll
        for (int h_ = 0; h_ < 2; ++h_)
#pragma unroll
            for (int i_ = 0; i_ < 2; ++i_) vAc[h_][i_] = vAn[h_][i_];
    }
    PG8_WAIT_V(0);
    if (wr == 0) PG8_BAR;
    PG8_BAR;
#undef PG8_SA
#undef PG8_SB
#undef PG8_STAGE2
#undef PG8_STAGEB
#undef PG8_LDA
#undef PG8_LDB
#undef PG8_MMA
#undef PG8_WAIT_V
#undef PG8_WAIT_L
#undef PG8_BAR
#undef PG8_SCHED
#undef PG8_SETVA
}
}

constexpr int LDS_MISC = 131072;
constexpr int LDS_MOETAB = LDS_MISC + 64;
constexpr int LDS_INTAB = LDS_MISC + 512;
struct Ctx {
    float* out; unsigned char* ws; unsigned char* ws0;
    LAS unsigned char* lds;
    int tid, lane, wave, G, bid;
    __device__ __forceinline__ const void* inp(int i) const { const LAS unsigned* p = (const LAS unsigned*)(lds + LDS_INTAB) + 2 * i;
        const unsigned lo = (unsigned)__builtin_amdgcn_readfirstlane((int)p[0]), hi = (unsigned)__builtin_amdgcn_readfirstlane((int)p[1]); return (const void*)(const __attribute__((address_space(1))) char*)(((unsigned long long)hi << 32) | lo); }
    __device__ __forceinline__ const float* x() const { return (const float*)inp(0); }
    __device__ __forceinline__ const int* pos() const { return (const int*)inp(1); }
    __device__ __forceinline__ const float* rel_bias() const { return (const float*)inp(2); }
    __device__ __forceinline__ const float* norm_attn() const { return (const float*)inp(3); }
    __device__ __forceinline__ const float* w_in() const { return (const float*)inp(4); }
    __device__ __forceinline__ const float* b_merge() const { return (const float*)inp(5); }
    __device__ __forceinline__ const float* cmp_pe() const { return (const float*)inp(6); }
    __device__ __forceinline__ const float* cmp_k_w1() const { return (const float*)inp(7); }
    __device__ __forceinline__ const float* cmp_k_b1() const { return (const float*)inp(8); }
    __device__ __forceinline__ const float* cmp_k_w2() const { return (const float*)inp(9); }
    __device__ __forceinline__ const float* cmp_v_w1() const { return (const float*)inp(10); }
    __device__ __forceinline__ const float* cmp_v_b1() const { return (const float*)inp(11); }
    __device__ __forceinline__ const float* cmp_v_w2() const { return (const float*)inp(12); }
    __device__ __forceinline__ const float* mla_q_norm() const { return (const float*)inp(13); }
    __device__ __forceinline__ const float* mla_kv_norm() const { return (const float*)inp(14); }
    __device__ __forceinline__ const float* mla_w_uq() const { return (const float*)inp(15); }
    __device__ __forceinline__ const float* mla_w_uk() const { return (const float*)inp(16); }
    __device__ __forceinline__ const float* mla_w_uv() const { return (const float*)inp(17); }
    __device__ __forceinline__ const float* fox_b_f() const { return (const float*)inp(18); }
    __device__ __forceinline__ const float* w_o_nsa() const { return (const float*)inp(19); }
    __device__ __forceinline__ const float* w_o_mla() const { return (const float*)inp(20); }
    __device__ __forceinline__ const float* w_o_fox() const { return (const float*)inp(21); }
    __device__ __forceinline__ const float* w_out() const { return (const float*)inp(22); }
    __device__ __forceinline__ const float* norm_ffn() const { return (const float*)inp(23); }
    __device__ __forceinline__ const float* moe_w_grp() const { return (const float*)inp(24); }
    __device__ __forceinline__ const float* moe_b_grp() const { return (const float*)inp(25); }
    __device__ __forceinline__ const float* moe_w_router() const { return (const float*)inp(26); }
    __device__ __forceinline__ const float* moe_b_router() const { return (const float*)inp(27); }
    __device__ __forceinline__ const float* moe_w_gate() const { return (const float*)inp(28); }
    __device__ __forceinline__ const float* moe_w_up() const { return (const float*)inp(29); }
    __device__ __forceinline__ const float* moe_w_down() const { return (const float*)inp(30); }
    __device__ __forceinline__ const float* norm_final() const { return (const float*)inp(31); }
};
#define WSP(T_, off) ((T_*)(c.ws + (off)))
__device__ __forceinline__ int lane_id_volatile() { int ln; asm volatile("v_mbcnt_lo_u32_b32 %0, -1, 0\n\tv_mbcnt_hi_u32_b32 %0, -1, %0" : "=v"(ln)); return ln; }
__device__ __forceinline__ void relaunder(Ctx& c) { const int ln = lane_id_volatile(); c.lane = ln; c.tid = c.wave * 64 + ln;
    size_t z_ = 0; asm volatile("" : "+s"(z_)); c.ws = c.ws0 + z_; int g_ = c.G, b_ = c.bid, wv_ = c.wave; asm volatile("" : "+s"(g_), "+s"(b_), "+s"(wv_)); c.G = g_; c.bid = b_; c.wave = wv_; }

template <class Map>
__device__ __forceinline__ void transpose_item(const float* W, int ldw, int K, bf16_t* WT, const float* rowscale, Map srcmap, int nblk, LAS float* scr, int item, int lane, float colscale = 1.f) {
    const int kb = item / nblk, nb = item % nblk, k0 = 64 * kb, n0 = 32 * nb;
    const int sc = srcmap(n0 + (lane & 31));
    const int cc = lane & 7;
    float rsc[8];
#pragma unroll
    for (int i = 0; i < 8; ++i) rsc[i] = rowscale ? rowscale[k0 + 8 * cc + i] * colscale : colscale;
    float v[32];
    const float* wp = W + (size_t)(k0 + (lane >> 5)) * ldw + (sc >= 0 ? sc : 0);
#pragma unroll
    for (int i = 0; i < 32; ++i) v[i] = wp[(size_t)(2 * i) * ldw];
    __builtin_amdgcn_sched_barrier(0);
#pragma unroll
    for (int i = 0; i < 32; ++i) scr[(2 * i + (lane >> 5)) * 33 + (lane & 31)] = (sc >= 0) ? v[i] : 0.f;
    LDS_WAIT(); asm volatile("" ::: "memory");
#pragma unroll
    for (int j = 0; j < 4; ++j) { const int n = (lane >> 3) + 8 * j; const LAS float* s = scr + (8 * cc) * 33 + n;
        u32x4 o; o.x = cvtpk(s[0 * 33] * rsc[0], s[1 * 33] * rsc[1]); o.y = cvtpk(s[2 * 33] * rsc[2], s[3 * 33] * rsc[3]); o.z = cvtpk(s[4 * 33] * rsc[4], s[5 * 33] * rsc[5]); o.w = cvtpk(s[6 * 33] * rsc[6], s[7 * 33] * rsc[7]);
        *(u32x4*)(WT + (size_t)(n0 + n) * K + k0 + 8 * cc) = o; }
    LDS_WAIT(); asm volatile("" ::: "memory");
}
struct MapId { int off; __device__ int operator()(int n) const { return n + off; } };
struct MapInproj { __device__ int operator()(int n) const { if (n < 1280) return n; if (n < 1696) return n + 24; if (n < 1720) return n - 416; if (n < 1728) return n + 1536; if (n < 3264) return n - 8; return -1; } };
struct MapUq { __device__ int operator()(int n) const { if (n < 512) return (n >> 6) * 96 + (n & 63); const int r = n - 512; return (r >> 5) * 96 + 64 + (r & 31); } };
struct MapPad128 { __device__ int operator()(int n) const { return n < 128 ? n : -1; } };
struct MapGU { __device__ int operator()(int n) const { return (n >> 8) * 128 + (n & 127); } };

__device__ __forceinline__ int rel_bucket_dev(int n) {
    if (n < 16) return n;
    const float lr = __logf((float)n / 16.f) / 2.0794415416798357f;
    int large = 16 + (int)(lr * 16.f);
    return large < 31 ? large : 31;
}

__device__ __forceinline__ void phase_prologue(const Ctx& c) {
    LAS float* scr = (LAS float*)(c.lds + c.wave * 16384);
    const int gw = c.bid * NWAVES + c.wave, NGW = c.G * NWAVES;
    constexpr int I_WIN = 16 * (P1W / 32), I_WM = 16 * 96, I_UQ = 4 * 24, I_UK = 2 * 16, I_UV = 2 * 16, I_WO = 8 * 32, I_WOUT = 16 * 32, I_C1 = 32 * 8;
    constexpr int PER_L = I_WIN + I_WM + I_UQ + I_UK + I_UV + 3 * I_WO + I_WOUT + 2 * I_C1;
    for (int it = gw; it < NL * PER_L; it += NGW) {
        const int l = it / PER_L; int r = it % PER_L;
        if (r < I_WIN) { const int n0_ = 32 * (r % (P1W / 32)); const float cs_ = (n0_ < 512 || (n0_ >= C_FQKV && n0_ < C_FQKV + 512)) ? QSCALE64 : 1.f;
            transpose_item(c.w_in() + (size_t)l * D * DIN, DIN, D, WSP(bf16_t, WS_WINT) + (size_t)l * P1W * D, c.norm_attn() + l * D, MapInproj{}, P1W / 32, scr, r, c.lane, cs_); continue; } r -= I_WIN;
        if (r < I_WM) { transpose_item(c.w_in() + (size_t)l * D * DIN, DIN, D, WSP(bf16_t, WS_WMT) + (size_t)l * 3072 * D, c.norm_attn() + l * D, MapId{3264}, 96, scr, r, c.lane); continue; } r -= I_WM;
        if (r < I_UQ) { transpose_item(c.mla_w_uq() + (size_t)l * 256 * 768, 768, 256, WSP(bf16_t, WS_WUQT) + (size_t)l * 768 * 256, c.mla_q_norm() + l * 256, MapUq{}, 24, scr, r, c.lane, QSCALE96); continue; } r -= I_UQ;
        if (r < I_UK) { transpose_item(c.mla_w_uk() + (size_t)l * 128 * 512, 512, 128, WSP(bf16_t, WS_WUKVT) + (size_t)l * 1024 * 128, c.mla_kv_norm() + l * 128, MapId{0}, 16, scr, r, c.lane); continue; } r -= I_UK;
        if (r < I_UV) { transpose_item(c.mla_w_uv() + (size_t)l * 128 * 512, 512, 128, WSP(bf16_t, WS_WUKVT) + (size_t)l * 1024 * 128 + 512 * 128, c.mla_kv_norm() + l * 128, MapId{0}, 16, scr, r, c.lane); continue; } r -= I_UV;
        if (r < I_WO) { transpose_item(c.w_o_nsa() + (size_t)l * 512 * 1024, 1024, 512, WSP(bf16_t, WS_WOT) + ((size_t)l * 3 + 0) * 1024 * 512, nullptr, MapId{0}, 32, scr, r, c.lane); continue; } r -= I_WO;
        if (r < I_WO) { transpose_item(c.w_o_mla() + (size_t)l * 512 * 1024, 1024, 512, WSP(bf16_t, WS_WOT) + ((size_t)l * 3 + 1) * 1024 * 512, nullptr, MapId{0}, 32, scr, r, c.lane); continue; } r -= I_WO;
        if (r < I_WO) { transpose_item(c.w_o_fox() + (size_t)l * 512 * 1024, 1024, 512, WSP(bf16_t, WS_WOT) + ((size_t)l * 3 + 2) * 1024 * 512, nullptr, MapId{0}, 32, scr, r, c.lane); continue; } r -= I_WO;
        if (r < I_WOUT) { transpose_item(c.w_out() + (size_t)l * D * D, D, D, WSP(bf16_t, WS_WOUTT) + (size_t)l * D * D, nullptr, MapId{0}, 32, scr, r, c.lane); continue; } r -= I_WOUT;
        { const int kv = r / I_C1; const float* w = (kv == 0 ? c.cmp_k_w1() : c.cmp_v_w1()) + (size_t)l * 2048 * 128;
          transpose_item(w, 128, 2048, WSP(bf16_t, WS_WC1T) + ((size_t)l * 2 + kv) * 256 * 2048, nullptr, MapPad128{}, 8, scr, r % I_C1, c.lane); }
    }
    { float* rc = WSP(float, WS_ROPE); float* rs = rc + (size_t)M * 16;
      for (int i = c.bid * NTHREADS + c.tid; i < M * 16; i += c.G * NTHREADS) { const int m = i >> 4, j = i & 15;
          const float inv = exp2f(-(float)j * 0.8304820237218407f);   const float ang = (float)c.pos()[m] * inv; double rev = (double)ang * 0.15915494309189535; rev -= floor(rev); const float fr_ = (float)rev; rc[i] = __builtin_amdgcn_cosf(fr_); rs[i] = __builtin_amdgcn_sinf(fr_); } }
    float* tab = WSP(float, WS_TAB);
    if (c.bid == 0) {
        const int l = c.tid >> 8, kv = (c.tid >> 7) & 1, j = c.tid & 127;
        const float* w1 = (kv == 0 ? c.cmp_k_w1() : c.cmp_v_w1()) + (size_t)l * 2048 * 128; const float* b1 = (kv == 0 ? c.cmp_k_b1() : c.cmp_v_b1()) + l * 128; const float* pe = c.cmp_pe() + l * 2048;
        float s = b1[j]; for (int k = 0; k < 2048; ++k) s += pe[k] * w1[(size_t)k * 128 + j];
        tab[c.tid] = s;
    }
    if (c.bid == 1 % c.G) {
        for (int i = c.tid; i < 8 * 129; i += NTHREADS) { const int h = i / 129, d = i % 129; tab[512 + h * 132 + d] = c.rel_bias()[rel_bucket_dev(d) * 8 + h] * LOG2E; }
    }
}

__device__ __forceinline__ void phase_norm(const Ctx& c, const float* src, const bf16_t* y0, const bf16_t* y1, float* rout, bf16_t* hout) {
    const int gw = c.bid * NWAVES + c.wave, NGW = c.G * NWAVES;
    for (int m = gw; m < M; m += NGW) {
        const f32x4* xr = (const f32x4*)(src + (size_t)m * D) + c.lane;
        f32x4 v[4]; float s = 0.f;
#pragma unroll
        for (int j = 0; j < 4; ++j) { v[j] = xr[64 * j];
            if (y0) { const u32x2 a = *((const u32x2*)(y0 + (size_t)m * D) + c.lane + 64 * j); const u32x2 b = *((const u32x2*)(y1 + (size_t)m * D) + c.lane + 64 * j);
                v[j].x += __uint_as_float(a.x << 16) + __uint_as_float(b.x << 16); v[j].y += __uint_as_float(a.x & 0xffff0000u) + __uint_as_float(b.x & 0xffff0000u);
                v[j].z += __uint_as_float(a.y << 16) + __uint_as_float(b.y << 16); v[j].w += __uint_as_float(a.y & 0xffff0000u) + __uint_as_float(b.y & 0xffff0000u); }
            s += (v[j].x * v[j].x + v[j].y * v[j].y) + (v[j].z * v[j].z + v[j].w * v[j].w); }
        const float rstd = rsqrtf(wave_sum(s) * (1.f / D) + EPS);
        if (rout) { f32x4* ro = (f32x4*)(rout + (size_t)m * D) + c.lane;
#pragma unroll
            for (int j = 0; j < 4; ++j) ro[64 * j] = v[j]; }
        u32x2* o8 = (u32x2*)(hout + (size_t)m * D) + c.lane;
#pragma unroll
        for (int j = 0; j < 4; ++j) { u32x2 w; w.x = pk2(v[j].x * rstd, v[j].y * rstd); w.y = pk2(v[j].z * rstd, v[j].w * rstd); o8[64 * j] = w; }
    }
}
__device__ __forceinline__ void phase_final(const Ctx& c) {
    const int gw = c.bid * NWAVES + c.wave, NGW = c.G * NWAVES;
    const float* src = WSP(float, WS_XA); const bf16_t* y0 = WSP(bf16_t, WS_Y); const bf16_t* y1 = y0 + (size_t)M * D;
    for (int m = gw; m < M; m += NGW) {
        const f32x4* xr = (const f32x4*)(src + (size_t)m * D) + c.lane;
        f32x4 v[4]; float s = 0.f;
#pragma unroll
        for (int j = 0; j < 4; ++j) { v[j] = xr[64 * j];
            const u32x2 a = *((const u32x2*)(y0 + (size_t)m * D) + c.lane + 64 * j); const u32x2 b = *((const u32x2*)(y1 + (size_t)m * D) + c.lane + 64 * j);
            v[j].x += __uint_as_float(a.x << 16) + __uint_as_float(b.x << 16); v[j].y += __uint_as_float(a.x & 0xffff0000u) + __uint_as_float(b.x & 0xffff0000u);
            v[j].z += __uint_as_float(a.y << 16) + __uint_as_float(b.y << 16); v[j].w += __uint_as_float(a.y & 0xffff0000u) + __uint_as_float(b.y & 0xffff0000u);
            s += (v[j].x * v[j].x + v[j].y * v[j].y) + (v[j].z * v[j].z + v[j].w * v[j].w); }
        const float rstd = rsqrtf(wave_sum(s) * (1.f / D) + EPS);
        f32x4* ro = (f32x4*)(c.out + (size_t)m * D) + c.lane;
#pragma unroll
        for (int j = 0; j < 4; ++j) { const f32x4 g = *((const f32x4*)c.norm_final() + c.lane + 64 * j); ro[64 * j] = v[j] * rstd * g; }
    }
}

__device__ __forceinline__ void phase_prep(const Ctx& c, int l) {
    const int gw = c.bid * NWAVES + c.wave, NGW = c.G * NWAVES;
    const bf16_t* P1 = WSP(bf16_t, WS_P1); float* rstd = WSP(float, WS_RSTD); bf16_t* KR = WSP(bf16_t, WS_KR); float* LF = WSP(float, WS_LF);
    const float* rc = WSP(float, WS_ROPE); const float* rs = rc + (size_t)M * 16;
    for (int m = gw; m < M; m += NGW) {
        const bf16_t* row = P1 + (size_t)m * P1W;
        const u32x2 a = *((const u32x2*)(row + C_CQ) + c.lane);
        float q0 = __uint_as_float(a.x << 16), q1 = __uint_as_float(a.x & 0xffff0000u), q2 = __uint_as_float(a.y << 16), q3 = __uint_as_float(a.y & 0xffff0000u);
        const float sq = wave_sum(q0 * q0 + q1 * q1 + q2 * q2 + q3 * q3);
        const unsigned b = *((const unsigned*)(row + C_CKV) + c.lane);
        float k0 = __uint_as_float(b << 16), k1 = __uint_as_float(b & 0xffff0000u);
        const float sk = wave_sum(k0 * k0 + k1 * k1);
        if (c.lane == 0) { rstd[2 * m] = rsqrtf(sq * (1.f / 256.f) + EPS); rstd[2 * m + 1] = rsqrtf(sk * (1.f / 128.f) + EPS); }
        if (c.lane < 16) { const float x1 = bf2f(row[C_KR + c.lane]), x2 = bf2f(row[C_KR + 16 + c.lane]); const float cs = rc[m * 16 + c.lane], sn = rs[m * 16 + c.lane];
            KR[m * 32 + c.lane] = (bf16_t)f2bf(x1 * cs - x2 * sn); KR[m * 32 + 16 + c.lane] = (bf16_t)f2bf(x1 * sn + x2 * cs); }
        if (c.lane < 8) { const float f = bf2f(row[C_FF + c.lane]) + c.fox_b_f()[l * 8 + c.lane];
            const float ls = fminf(f, 0.f) - __logf(1.f + __expf(-fabsf(f)));
            const int bb = m / T, t = m % T; LF[((size_t)bb * 8 + c.lane) * T + t] = ls; }
    }
}
__device__ __forceinline__ void phase_cum(const Ctx& c) {
    LAS float* sh = (LAS float*)c.lds;
    for (int s = c.bid; s < NB * 8; s += c.G) {
        const float* lf = WSP(float, WS_LF) + (size_t)s * T; float* cum = WSP(float, WS_CUM) + (size_t)s * T;
        float v[16]; float tot = 0.f;
#pragma unroll
        for (int j = 0; j < 16; ++j) { v[j] = lf[c.tid * 16 + j]; tot += v[j]; }
        sh[c.tid] = tot; __syncthreads();
        if (c.tid < 8) { float run = 0.f; for (int i = 0; i < 64; ++i) { const float t_ = sh[c.tid * 64 + i]; sh[c.tid * 64 + i] = run; run += t_; } sh[NTHREADS + c.tid] = run; }
        __syncthreads();
        float run = sh[c.tid]; for (int w_ = 0; w_ < (c.tid >> 6); ++w_) run += sh[NTHREADS + w_];
#pragma unroll
        for (int j = 0; j < 16; ++j) { run += v[j]; cum[c.tid * 16 + j] = run * LOG2E; }
        __syncthreads();
    }
}
__device__ __forceinline__ void phase_cmp2_ropeq(const Ctx& c, int l) {
    const bf16_t* HC = WSP(bf16_t, WS_HC);
    for (int pr = c.bid * NWAVES + c.wave; pr < 2 * 2048; pr += c.G * NWAVES) {
        const int kv = pr >> 11, row = pr & 2047, d = c.lane;
        const float* w2 = (kv == 0 ? c.cmp_k_w2() : c.cmp_v_w2()) + (size_t)l * 128 * 64 + d;
        const bf16_t* h = HC + ((size_t)kv * 2048 + row) * 128; float s = 0.f;
        u32x4 hv[16];
#pragma unroll
        for (int q = 0; q < 16; ++q) hv[q] = *(const u32x4*)(h + 8 * q);
#pragma unroll
        for (int jb = 0; jb < 4; ++jb) { float wv[32];
#pragma unroll
            for (int i = 0; i < 32; ++i) wv[i] = w2[(size_t)(32 * jb + i) * 64];
            __builtin_amdgcn_sched_barrier(0);
#pragma unroll
            for (int q = 0; q < 4; ++q) { const u32x4 hw = hv[4 * jb + q];
                s += __uint_as_float(hw.x << 16) * wv[8 * q + 0] + __uint_as_float(hw.x & 0xffff0000u) * wv[8 * q + 1] + __uint_as_float(hw.y << 16) * wv[8 * q + 2] + __uint_as_float(hw.y & 0xffff0000u) * wv[8 * q + 3]
                   + __uint_as_float(hw.z << 16) * wv[8 * q + 4] + __uint_as_float(hw.z & 0xffff0000u) * wv[8 * q + 5] + __uint_as_float(hw.w << 16) * wv[8 * q + 6] + __uint_as_float(hw.w & 0xffff0000u) * wv[8 * q + 7]; } }
        if ((row & 511) == 511) s = 0.f;
        (kv == 0 ? WSP(bf16_t, WS_KC) : WSP(bf16_t, WS_VC))[(size_t)row * 64 + d] = (bf16_t)f2bf(s);
    }
    bf16_t* QB = WSP(bf16_t, WS_QB); const float* rc = WSP(float, WS_ROPE); const float* rs = rc + (size_t)M * 16;
    for (int i = c.bid * NTHREADS + c.tid; i < M * 128; i += c.G * NTHREADS) {
        const int m = i >> 7, h = (i >> 4) & 7, j = i & 15;
        bf16_t* p = QB + (size_t)m * 768 + 512 + h * 32; const float x1 = bf2f(p[j]), x2 = bf2f(p[16 + j]); const float cs = rc[m * 16 + j], sn = rs[m * 16 + j];
        p[j] = (bf16_t)f2bf(x1 * cs - x2 * sn); p[16 + j] = (bf16_t)f2bf(x1 * sn + x2 * cs);
    }
}

__device__ __forceinline__ u32x2 pk4(f32x4 v) { u32x2 w; w.x = cvtpk(v.x, v.y); w.y = cvtpk(v.z, v.w); return w; }
__device__ __forceinline__ f32x4 unpk4(u32x2 a) { f32x4 r; r.x = __uint_as_float(a.x << 16); r.y = __uint_as_float(a.x & 0xffff0000u); r.z = __uint_as_float(a.y << 16); r.w = __uint_as_float(a.y & 0xffff0000u); return r; }
#define EPI_ARGS const f32x4 (&acc)[2][2][4][2], const pg8::Unit& u, int wr, int wc, int fr, int fq
#define EPI_LOOP _Pragma("unroll") for (int ai = 0; ai < 2; ++ai) _Pragma("unroll") for (int m = 0; m < 4; ++m) _Pragma("unroll") for (int bj = 0; bj < 2; ++bj) _Pragma("unroll") for (int n = 0; n < 2; ++n)

#define EPI_ROW(ai, m) (u.pm * 256 + (ai) * 128 + wr * 64 + (m) * 16 + fr)
#define EPI_COL(bj, n) (u.pn * 256 + (bj) * 128 + wc * 32 + (n) * 16 + fq * 4)
struct EpiStoreBf16 { bf16_t* O; int ldc; const float* rowscale; int rs_stride;
    __device__ __forceinline__ void operator()(EPI_ARGS) const {
        float rs[2][4];
#pragma unroll
        for (int ai = 0; ai < 2; ++ai)
#pragma unroll
            for (int m = 0; m < 4; ++m) rs[ai][m] = rowscale ? rowscale[(size_t)EPI_ROW(ai, m) * rs_stride] : 1.f;
        __builtin_amdgcn_sched_barrier(0);
        EPI_LOOP { const unsigned off = (unsigned)EPI_ROW(ai, m) * (unsigned)ldc + (unsigned)EPI_COL(bj, n); *(u32x2*)(O + off) = pk4(acc[ai][bj][m][n] * rs[ai][m]); } } };
struct EpiGates { bf16_t* O; const float* bias;
    __device__ __forceinline__ void operator()(EPI_ARGS) const {
        f32x4 bv[2][2];
#pragma unroll
        for (int bj = 0; bj < 2; ++bj)
#pragma unroll
            for (int n = 0; n < 2; ++n) bv[bj][n] = *(const f32x4*)(bias + EPI_COL(bj, n));
        __builtin_amdgcn_sched_barrier(0);
        EPI_LOOP { f32x4 v = acc[ai][bj][m][n] + bv[bj][n];
            v.x = sigmoidf_(v.x); v.y = sigmoidf_(v.y); v.z = sigmoidf_(v.z); v.w = sigmoidf_(v.w); *(u32x2*)(O + (unsigned)EPI_ROW(ai, m) * 3072u + (unsigned)EPI_COL(bj, n)) = pk4(v); } } };
struct EpiCmp1 { bf16_t* HC; const float* bc1;
    __device__ __forceinline__ void operator()(EPI_ARGS) const {
        const int kv = u.pm >> 3, bg = (u.pm >> 1) & 3, half = u.pm & 1;
        f32x4 bv[2];
#pragma unroll
        for (int n = 0; n < 2; ++n) bv[n] = *(const f32x4*)(bc1 + kv * 128 + wc * 32 + n * 16 + fq * 4);
        __builtin_amdgcn_sched_barrier(0);
#pragma unroll
        for (int ai = 0; ai < 2; ++ai)
#pragma unroll
            for (int m = 0; m < 4; ++m)
#pragma unroll
                for (int n = 0; n < 2; ++n) { const int i = half * 256 + ai * 128 + wr * 64 + m * 16 + fr, cc = wc * 32 + n * 16 + fq * 4;
                    f32x4 v = acc[ai][0][m][n] + bv[n];
                    v.x = gelu_tanh(v.x); v.y = gelu_tanh(v.y); v.z = gelu_tanh(v.z); v.w = gelu_tanh(v.w);
                    *(u32x2*)(HC + ((size_t)kv * 2048 + bg * 512 + i) * 128 + cc) = pk4(v); } } };
struct EpiOutproj { bf16_t* MIX; const bf16_t* GATES; int br;
    __device__ __forceinline__ void operator()(EPI_ARGS) const {
#pragma unroll
        for (int ai = 0; ai < 2; ++ai)
#pragma unroll
          for (int mh = 0; mh < 2; ++mh) { u32x2 gw[2][2][2], mw[2][2][2];
#pragma unroll
            for (int m2 = 0; m2 < 2; ++m2)
#pragma unroll
                for (int bj = 0; bj < 2; ++bj)
#pragma unroll
                    for (int n = 0; n < 2; ++n) { const unsigned row = (unsigned)EPI_ROW(ai, 2 * mh + m2), col = (unsigned)EPI_COL(bj, n);
                        gw[m2][bj][n] = *(const u32x2*)(GATES + row * 3072u + (unsigned)br * 1024u + col); if (br > 0) mw[m2][bj][n] = *(const u32x2*)(MIX + row * 1024u + col); }
            __builtin_amdgcn_sched_barrier(0);
#pragma unroll
            for (int m2 = 0; m2 < 2; ++m2)
#pragma unroll
                for (int bj = 0; bj < 2; ++bj)
#pragma unroll
                    for (int n = 0; n < 2; ++n) { f32x4 v = acc[ai][bj][2 * mh + m2][n] * unpk4(gw[m2][bj][n]); if (br > 0) v = v + unpk4(mw[m2][bj][n]);
                        *(u32x2*)(MIX + (unsigned)EPI_ROW(ai, 2 * mh + m2) * 1024u + (unsigned)EPI_COL(bj, n)) = pk4(v); }
            __builtin_amdgcn_sched_barrier(0); } } };
struct EpiWout { const float* R; float* XA;
    __device__ __forceinline__ void operator()(EPI_ARGS) const {
#pragma unroll
        for (int ai = 0; ai < 2; ++ai)
#pragma unroll
          for (int mh = 0; mh < 2; ++mh) { f32x4 rv[2][2][2];
#pragma unroll
            for (int m2 = 0; m2 < 2; ++m2)
#pragma unroll
                for (int bj = 0; bj < 2; ++bj)
#pragma unroll
                    for (int n = 0; n < 2; ++n) rv[m2][bj][n] = *(const f32x4*)(R + (unsigned)EPI_ROW(ai, 2 * mh + m2) * 1024u + (unsigned)EPI_COL(bj, n));
            __builtin_amdgcn_sched_barrier(0);
#pragma unroll
            for (int m2 = 0; m2 < 2; ++m2)
#pragma unroll
                for (int bj = 0; bj < 2; ++bj)
#pragma unroll
                    for (int n = 0; n < 2; ++n) *(f32x4*)(XA + (unsigned)EPI_ROW(ai, 2 * mh + m2) * 1024u + (unsigned)EPI_COL(bj, n)) = rv[m2][bj][n] + acc[ai][bj][2 * mh + m2][n];
            __builtin_amdgcn_sched_barrier(0); } } };
struct EpiMoe1 { bf16_t* HID; const float* LW;
    __device__ __forceinline__ void operator()(EPI_ARGS) const {
        int aux_ = u.aux; asm volatile("" : "+s"(aux_));
        float w8[2][4];
#pragma unroll
        for (int ai = 0; ai < 2; ++ai)
#pragma unroll
            for (int m = 0; m < 4; ++m) w8[ai][m] = LW[(unsigned)(aux_ + ai * 128 + wr * 64 + m * 16 + fr)];
        __builtin_amdgcn_sched_barrier(0);
#pragma unroll
        for (int ai = 0; ai < 2; ++ai)
#pragma unroll
            for (int m = 0; m < 4; ++m) { const unsigned pos = (unsigned)(aux_ + ai * 128 + wr * 64 + m * 16 + fr); const float w = w8[ai][m];
#pragma unroll
                for (int n = 0; n < 2; ++n) { const f32x4 g = acc[ai][0][m][n], up = acc[ai][1][m][n]; f32x4 h;
                    h.x = g.x * sigmoidf_(g.x) * up.x * w; h.y = g.y * sigmoidf_(g.y) * up.y * w; h.z = g.z * sigmoidf_(g.z) * up.z * w; h.w = g.w * sigmoidf_(g.w) * up.w * w;
                    *(u32x2*)(HID + pos * 256u + (unsigned)(u.pn * 128 + wc * 32 + n * 16 + fq * 4)) = pk4(h); } } } };
struct EpiMoe2 { bf16_t* Y; const unsigned* LDST;
    __device__ __forceinline__ void operator()(EPI_ARGS) const {
        int aux_ = u.aux; asm volatile("" : "+s"(aux_));
        unsigned d8[2][4];
#pragma unroll
        for (int ai = 0; ai < 2; ++ai)
#pragma unroll
            for (int m = 0; m < 4; ++m) d8[ai][m] = LDST[(unsigned)(aux_ + ai * 128 + wr * 64 + m * 16 + fr)];
        __builtin_amdgcn_sched_barrier(0);
#pragma unroll
        for (int ai = 0; ai < 2; ++ai)
#pragma unroll
            for (int m = 0; m < 4; ++m) { const unsigned d0 = d8[ai][m];
                if (d0 != 0xFFFFFFFFu) { const unsigned off = d0 + (unsigned)(u.pn * 256 + wc * 32 + fq * 4);
#pragma unroll
                    for (int bj = 0; bj < 2; ++bj)
#pragma unroll
                        for (int n = 0; n < 2; ++n) *(u32x2*)(Y + off + bj * 128 + n * 16) = pk4(acc[ai][bj][m][n]); } } } };

struct CmpOrder { int G, c; const char* P1; const char* W;
    __device__ bool next(int i, pg8::Unit& u) const { const int L_ = i * G + c; if (L_ >= 16) return false; const int kv = L_ >> 3, b = (L_ >> 2) & 1, g = (L_ >> 1) & 1, half = L_ & 1;
        u.pm = L_; u.pn = 0; u.aux = 0; u.A = P1 + ((size_t)(b * T + 16 * 256 * half) * P1W + C_NKV + (kv * 2 + g) * 64) * 2; u.B = W + (size_t)kv * 256 * 2048 * 2; return true; } };
struct MoeOrder { int G, c, nN; const LAS int* tab; const char* A; size_t a_rowbytes; const char* W; size_t w_expert, w_tile;
    __device__ bool next(int i, pg8::Unit& u) const { const int L_ = i * G + c; const int NT = __builtin_amdgcn_readfirstlane(tab[32]); if (L_ >= NT * nN) return false; const int rt = L_ / nN, pn = L_ % nN;
        int e = 0; while (__builtin_amdgcn_readfirstlane(tab[e + 1]) <= rt) ++e;
        const int off_e = __builtin_amdgcn_readfirstlane(tab[33 + e]), ts_e = __builtin_amdgcn_readfirstlane(tab[e]), cnt_e = __builtin_amdgcn_readfirstlane(tab[66 + e]);
        const int pos0 = off_e + 256 * (rt - ts_e); u.pn = pn; u.aux = pos0; u.pm = off_e + cnt_e;
        u.A = A + (size_t)pos0 * a_rowbytes; u.B = W + (size_t)e * w_expert + (size_t)pn * w_tile; return true; } };
__device__ __forceinline__ void moe_tables(const Ctx& c, int l, LAS int* tab) {
    if (c.tid == 0) { const unsigned* cnt = WSP(unsigned, WS_CTL) + CW_MOECNT + l * 64; int ts = 0, off = 0;
        for (int e = 0; e < 32; ++e) { const int n = (int)cnt[e]; tab[e] = ts; tab[33 + e] = off; tab[66 + e] = n; const int nt_ = (n + 255) >> 8; ts += nt_; off += nt_ * 256; }
        tab[32] = ts; tab[65] = off; }
    __syncthreads();
}

constexpr int LDS_RSM = LDS_MISC + 1024;
__device__ __forceinline__ void phase_router(const Ctx& c, int l, int dummy = 0) {
    const int gw = c.bid * NWAVES + c.wave, NGW = c.G * NWAVES, lane = c.lane;
    const float* XA = WSP(float, WS_XA); bf16_t* H2 = WSP(bf16_t, WS_H2); int* REC = WSP(int, dummy ? WS_HID : WS_REC); unsigned* cnt = WSP(unsigned, WS_CTL) + CW_MOECNT + (l + 2 * dummy) * 64;
    const float* g2 = c.norm_ffn() + l * D; const float* wg = c.moe_w_grp() + (size_t)l * D * 4; const float* wr_ = c.moe_w_router() + (size_t)l * D * 32;
    const float* bgp = c.moe_b_grp() + l * 4; const float* brp = c.moe_b_router() + l * 32;
    LAS f32x4* Tk = (LAS f32x4*)(c.lds + c.wave * 16384);
    LAS float* PG = (LAS float*)(c.lds + LDS_RSM + c.wave * 1792); LAS float* EL = PG + 256; LAS float* GL = EL + 128;
    LAS unsigned* cntL = (LAS unsigned*)(c.lds + LDS_MOETAB);
    if (c.tid < 32) cntL[c.tid] = 0u;
    __syncthreads();
    for (int task = gw; task < M / 4; task += NGW) {
        const int m0 = task * 4;
        f32x4 v[4][4]; float rs[4];
#pragma unroll
        for (int r = 0; r < 4; ++r) { const f32x4* xr = (const f32x4*)(XA + (size_t)(m0 + r) * D) + lane; float s = 0.f;
#pragma unroll
            for (int j = 0; j < 4; ++j) { v[r][j] = xr[64 * j]; s += (v[r][j].x * v[r][j].x + v[r][j].y * v[r][j].y) + (v[r][j].z * v[r][j].z + v[r][j].w * v[r][j].w); }
            rs[r] = rsqrtf(wave_sum(s) * (1.f / D) + EPS); }
#pragma unroll
        for (int j = 0; j < 4; ++j) { const f32x4 gg = *((const f32x4*)g2 + lane + 64 * j);
#pragma unroll
            for (int r = 0; r < 4; ++r) { v[r][j] = v[r][j] * rs[r]; *((u32x2*)(H2 + (size_t)(m0 + r) * D) + lane + 64 * j) = pk4(v[r][j]); v[r][j] = v[r][j] * gg; }
#pragma unroll
            for (int e = 0; e < 4; ++e) { f32x4 t4; t4.x = v[0][j][e]; t4.y = v[1][j][e]; t4.z = v[2][j][e]; t4.w = v[3][j][e]; Tk[4 * lane + 256 * j + e] = t4; } }
        LDS_WAIT(); asm volatile("" ::: "memory");
        { const int o = lane & 31, sh = lane >> 5; f32x4 acc = {0.f, 0.f, 0.f, 0.f}; const float* wp = wr_ + (size_t)(512 * sh) * 32 + o; const LAS f32x4* tp = Tk + 512 * sh;
#pragma unroll 1
          for (int kb = 0; kb < 512; kb += 32) { float w[32];
#pragma unroll
              for (int i = 0; i < 32; ++i) w[i] = wp[(size_t)(kb + i) * 32];
              __builtin_amdgcn_sched_barrier(0);
#pragma unroll
              for (int i = 0; i < 32; ++i) acc += tp[kb + i] * w[i]; }
          acc.x = half_sum(acc.x); acc.y = half_sum(acc.y); acc.z = half_sum(acc.z); acc.w = half_sum(acc.w);
          if (lane < 32) { const float bb = brp[o]; EL[0 * 32 + o] = acc.x + bb; EL[1 * 32 + o] = acc.y + bb; EL[2 * 32 + o] = acc.z + bb; EL[3 * 32 + o] = acc.w + bb; } }
        { const int og = lane & 3, s16 = lane >> 2; f32x4 acc = {0.f, 0.f, 0.f, 0.f}; const float* wp = wg + (size_t)(64 * s16) * 4 + og; const LAS f32x4* tp = Tk + 64 * s16;
#pragma unroll 1
          for (int kb = 0; kb < 64; kb += 32) { float w[32];
#pragma unroll
              for (int i = 0; i < 32; ++i) w[i] = wp[(size_t)(kb + i) * 4];
              __builtin_amdgcn_sched_barrier(0);
#pragma unroll
              for (int i = 0; i < 32; ++i) acc += tp[kb + i] * w[i]; }
          PG[(0 * 4 + og) * 16 + s16] = acc.x; PG[(1 * 4 + og) * 16 + s16] = acc.y; PG[(2 * 4 + og) * 16 + s16] = acc.z; PG[(3 * 4 + og) * 16 + s16] = acc.w; }
        LDS_WAIT(); asm volatile("" ::: "memory");
        if (lane < 16) { float s = 0.f;
#pragma unroll
            for (int q = 0; q < 16; ++q) s += PG[lane * 16 + q];
            GL[lane] = s + bgp[lane & 3]; }
        LDS_WAIT(); asm volatile("" ::: "memory");
        if (lane < 4) { const int r = lane;
            int gi = 0; float gm = GL[r * 4];
            for (int o = 1; o < 4; ++o) { const float x_ = GL[r * 4 + o]; if (x_ > gm) { gm = x_; gi = o; } }
            float gs = 0.f; for (int o = 0; o < 4; ++o) gs += __expf(GL[r * 4 + o] - gm);
            const float grp_top = 1.f / gs;
            int i1 = 0; float m1 = EL[r * 32 + gi * 8];
            for (int q = 1; q < 8; ++q) { const float x_ = EL[r * 32 + gi * 8 + q]; if (x_ > m1) { m1 = x_; i1 = q; } }
            int i2 = -1; float m2 = -3.0e38f;
            for (int q = 0; q < 8; ++q) { const float x_ = EL[r * 32 + gi * 8 + q]; if (q != i1 && x_ > m2) { m2 = x_; i2 = q; } }
            const float e2 = __expf(m2 - m1); const float w1 = grp_top / (1.f + e2), w2 = grp_top * e2 / (1.f + e2);
            const int ea = gi * 8 + i1, eb = gi * 8 + i2; const int ra = (int)atomicAdd((unsigned*)(cntL + ea), 1u), rb = (int)atomicAdd((unsigned*)(cntL + eb), 1u);
            int* rr = REC + (size_t)(m0 + r) * 8; rr[0] = ea; rr[1] = eb; rr[2] = ra; rr[3] = rb; rr[4] = __float_as_int(w1); rr[5] = __float_as_int(w2); rr[6] = c.bid; }
        LDS_WAIT(); asm volatile("" ::: "memory");
    }
    __syncthreads();
    if (c.tid < 32) { const unsigned n = cntL[c.tid]; (WSP(unsigned, WS_CTL) + CW_CNTB)[(dummy ? 8192 : 0) + c.bid * 32 + c.tid] = n; if (n) atomicAdd(cnt + c.tid, n); }
}
__device__ __forceinline__ void phase_place(const Ctx& c, int l) {
    LAS int* tab = (LAS int*)(c.lds + LDS_MOETAB);
    moe_tables(c, l, tab);
    int* LTOK = WSP(int, WS_LTOK); float* LW = WSP(float, WS_LW); unsigned* LDST = WSP(unsigned, WS_LSLOT); const int* REC = WSP(int, WS_REC);
    LAS int* BASE = (LAS int*)c.lds;
    if (c.tid < 32) { const unsigned* cb = WSP(unsigned, WS_CTL) + CW_CNTB + c.tid; int run = 0; for (int b_ = 0; b_ < c.G; ++b_) { BASE[b_ * 32 + c.tid] = run; run += (int)cb[b_ * 32]; } }
    __syncthreads();
    for (int m = c.bid * NTHREADS + c.tid; m < M; m += c.G * NTHREADS) { const int* r = REC + (size_t)m * 8;
        const int pa = tab[33 + r[0]] + BASE[r[6] * 32 + r[0]] + r[2], pb = tab[33 + r[1]] + BASE[r[6] * 32 + r[1]] + r[3];
        LTOK[pa] = m; LDST[pa] = (unsigned)m * 1024u; LW[pa] = __int_as_float(r[4]); LTOK[pb] = m; LDST[pb] = ((unsigned)M + (unsigned)m) * 1024u; LW[pb] = __int_as_float(r[5]); }
    for (int e = c.bid; e < 32; e += c.G) { const int lo = tab[33 + e] + tab[66 + e], hi2 = tab[33 + e + 1];
        for (int p = lo + c.tid; p < hi2; p += NTHREADS) { LTOK[p] = 0; LDST[p] = 0xFFFFFFFFu; LW[p] = 0.f; } }
    __syncthreads();
    LAS float* scr = (LAS float*)(c.lds + c.wave * 16384);
    const int gw = c.bid * NWAVES + c.wave, NGW = c.G * NWAVES;
    constexpr int I_GU = 16 * 16, I_DN = 4 * 32;
    for (int it = gw; it < 32 * (I_GU + I_DN); it += NGW) { const int e = it / (I_GU + I_DN); int r = it % (I_GU + I_DN);
        if (r < I_GU) { const int nb = r % 16; const bool up = ((nb * 32) & 255) >= 128;
            const float* w = (up ? c.moe_w_up() : c.moe_w_gate()) + ((size_t)l * 32 + e) * D * 256;
            transpose_item(w, 256, D, WSP(bf16_t, WS_WGU) + (size_t)e * 512 * D, c.norm_ffn() + l * D, MapGU{}, 16, scr, r, c.lane); }
        else { r -= I_GU; transpose_item(c.moe_w_down() + ((size_t)l * 32 + e) * 256 * D, D, 256, WSP(bf16_t, WS_WDT) + (size_t)e * D * 256, nullptr, MapId{0}, 32, scr, r, c.lane); } }
}

#ifndef ATT_FAST_FOX
#define ATT_FAST_FOX 1
#endif
#ifndef ATT_FAST_MLA
#define ATT_FAST_MLA 1
#endif
#ifndef ATT_FAST_NSA
#define ATT_FAST_NSA 1
#endif
namespace fa {
constexpr int KPITCH = 208, VPITCH = 192;
constexpr int KBUF = 64 * KPITCH, VBUF = 64 * VPITCH;
constexpr int L_K = 0, L_V = 2 * KBUF, L_CUM = L_V + 2 * VBUF, L_LUT = L_CUM + 512, L_PS = 57344, L_F = L_PS + 64 * 132 * 4, L_SEL = L_F + 64 * 132 * 4, L_UNI = L_SEL + 1024, L_TL = L_UNI + 16, L_TLN = L_TL + 128, L_UNIT = L_TLN + 16;
static_assert(L_LUT + 8 * 132 * 4 <= L_PS && L_UNIT + 64 <= 131072, "attention LDS map");
typedef short v4i16_t __attribute__((ext_vector_type(4)));
__device__ __forceinline__ float swap32_max(float v) { auto rr = __builtin_amdgcn_permlane32_swap(__float_as_uint(v), __float_as_uint(v), false, false); return fmaxf(__uint_as_float(rr[0]), __uint_as_float(rr[1])); }
__device__ __forceinline__ float swap32_sum(float v) { auto rr = __builtin_amdgcn_permlane32_swap(__float_as_uint(v), __float_as_uint(v), false, false); return __uint_as_float(rr[0]) + __uint_as_float(rr[1]); }
__device__ __forceinline__ float ex2(float x) { return __builtin_amdgcn_exp2f(x); }

struct KVSrc { const bf16_t* K; int kpitch; const bf16_t* K2; int k2pitch; const bf16_t* V; int vpitch; const float* cum; float cref; };
struct TileRegs { u32x4 k, k2, v; float cm; };
template <bool HAS_K2, bool HAS_CUM>
__device__ __forceinline__ void tile_load(TileRegs& R, const KVSrc& s, int kv0, int tid) {
    const int row = tid >> 3, ch = tid & 7;
    R.k = *(const u32x4*)(s.K + (size_t)(kv0 + row) * s.kpitch + ch * 8);
    R.v = *(const u32x4*)(s.V + (size_t)(kv0 + row) * s.vpitch + ch * 8);
    if constexpr (HAS_K2) { if (tid < 256) R.k2 = *(const u32x4*)(s.K2 + (size_t)(kv0 + (tid >> 2)) * s.k2pitch + (tid & 3) * 8); }
    if constexpr (HAS_CUM) { if (tid < 64) R.cm = s.cum[kv0 + tid]; }
}
template <bool HAS_K2, bool HAS_CUM>
__device__ __forceinline__ void tile_store(const TileRegs& R, LAS unsigned char* lds, int buf, int tid, float cref = 0.f) {
    const int row = tid >> 3, ch = tid & 7;
    *(LAS u32x4*)(lds + L_K + buf * KBUF + row * KPITCH + ch * 16) = R.k;
    if constexpr (HAS_K2) { if (tid < 256) *(LAS u32x4*)(lds + L_K + buf * KBUF + (tid >> 2) * KPITCH + 128 + (tid & 3) * 16) = R.k2; }
    *(LAS u32x4*)(lds + L_V + buf * VBUF + row * VPITCH + ch * 16) = R.v;
    if constexpr (HAS_CUM) { if (tid < 64) ((LAS float*)(lds + L_CUM))[buf * 64 + tid] = R.cm - cref; }
}
template <int NKS>
__device__ __forceinline__ void qk_tile(f32x16 (&st)[2], const LAS unsigned char* lds, int buf, const bf16x8 (&qf)[NKS], int r, int hh, float cval) {
    const LAS unsigned char* kp = lds + L_K + buf * KBUF + r * KPITCH + hh * 16;
    bf16x8 kf[2][NKS];
#pragma unroll
    for (int ks = 0; ks < NKS; ++ks)
#pragma unroll
        for (int rb = 0; rb < 2; ++rb) kf[rb][ks] = *(const LAS bf16x8*)(kp + rb * 32 * KPITCH + ks * 32);
    f32x16 cin;
#pragma unroll
    for (int i = 0; i < 16; ++i) cin[i] = cval;
    __builtin_amdgcn_sched_barrier(0);
    f32x16 a0 = __builtin_amdgcn_mfma_f32_32x32x16_bf16(kf[0][0], qf[0], cin, 0, 0, 0), a1 = __builtin_amdgcn_mfma_f32_32x32x16_bf16(kf[1][0], qf[0], cin, 0, 0, 0);
#pragma unroll
    for (int ks = 1; ks < NKS; ++ks) { a0 = __builtin_amdgcn_mfma_f32_32x32x16_bf16(kf[0][ks], qf[ks], a0, 0, 0, 0); a1 = __builtin_amdgcn_mfma_f32_32x32x16_bf16(kf[1][ks], qf[ks], a1, 0, 0, 0); }
    st[0] = a0; st[1] = a1;
}
__device__ __forceinline__ void pv_tile(f32x16 (&ot)[2], const LAS unsigned char* lds, int buf, const f32x16 (&p)[2], int lane) {
    const int i16 = lane & 15, blk = (lane >> 4) & 1, hh = lane >> 5;
    const LAS unsigned char* vb = lds + L_V + buf * VBUF + (4 * hh + (i16 >> 2)) * VPITCH + 32 * blk + 8 * (i16 & 3);
    v4i16_t lo[4][2], hi[4][2]; bf16x8 pf[4];
#pragma unroll
    for (int q = 0; q < 4; ++q)
#pragma unroll
        for (int db = 0; db < 2; ++db) { const LAS unsigned char* vp = vb + (16 * q) * VPITCH + 64 * db;
            lo[q][db] = __builtin_amdgcn_ds_read_tr16_b64_v4i16((LAS v4i16_t*)vp); hi[q][db] = __builtin_amdgcn_ds_read_tr16_b64_v4i16((LAS v4i16_t*)(vp + 8 * VPITCH)); }
#pragma unroll
    for (int q = 0; q < 4; ++q) { const int rb = q >> 1, s_ = q & 1;
        u32x4 pw; pw.x = cvtpk(p[rb][8 * s_ + 0], p[rb][8 * s_ + 1]); pw.y = cvtpk(p[rb][8 * s_ + 2], p[rb][8 * s_ + 3]); pw.z = cvtpk(p[rb][8 * s_ + 4], p[rb][8 * s_ + 5]); pw.w = cvtpk(p[rb][8 * s_ + 6], p[rb][8 * s_ + 7]);
        pf[q] = __builtin_bit_cast(bf16x8, pw); }
    __builtin_amdgcn_sched_barrier(0);
#pragma unroll
    for (int q = 0; q < 4; ++q)
#pragma unroll
        for (int db = 0; db < 2; ++db) { const bf16x8 vf = {lo[q][db][0], lo[q][db][1], lo[q][db][2], lo[q][db][3], hi[q][db][0], hi[q][db][1], hi[q][db][2], hi[q][db][3]};
            ot[db] = __builtin_amdgcn_mfma_f32_32x32x16_bf16(vf, pf[q], ot[db], 0, 0, 0); }
}
struct SmState { float m, l; };
constexpr float RESC_THR = 8.f;
__device__ __forceinline__ float sm_cval(const SmState& S) { return (S.m == -INFINITY) ? 0.f : -S.m; }
__device__ __forceinline__ float row_max32(const f32x16 (&st)[2]) {
    float mx = fmaxf(st[0][0], st[1][0]);
#pragma unroll
    for (int i = 1; i < 16; ++i) mx = fmaxf(fmaxf(mx, st[0][i]), st[1][i]);
    return swap32_max(mx);
}
typedef float f32x2v __attribute__((ext_vector_type(2)));
template <bool WITH_O>
__device__ __forceinline__ void sm_shift(f32x16 (&st)[2], SmState& S, f32x16 (&ot)[2], float mx) {
    const bool fresh = (S.m == -INFINITY);
    const bool up = fresh ? (mx > -INFINITY) : (mx > RESC_THR);
    if (__any(up)) {
        const float d = up ? mx : 0.f; const float alpha = fresh ? 1.f : ex2(-d);
        S.l *= alpha; S.m = up ? ((fresh ? 0.f : S.m) + d) : S.m;
#pragma unroll
        for (int rb = 0; rb < 2; ++rb)
#pragma unroll
            for (int i = 0; i < 16; ++i) st[rb][i] -= d;
        if constexpr (WITH_O) {
#pragma unroll
            for (int db = 0; db < 2; ++db)
#pragma unroll
                for (int i = 0; i < 16; ++i) ot[db][i] *= alpha; }
    }
}
__device__ __forceinline__ void sm_update(f32x16 (&st)[2], SmState& S, f32x16 (&ot)[2]) {
    sm_shift<true>(st, S, ot, row_max32(st));
    f32x2v sum = {0.f, 0.f};
#pragma unroll
    for (int rb = 0; rb < 2; ++rb)
#pragma unroll
        for (int i = 0; i < 16; i += 2) { f32x2v p; p.x = ex2(st[rb][i]); p.y = ex2(st[rb][i + 1]); st[rb][i] = p.x; st[rb][i + 1] = p.y; sum += p; }
    S.l += sum.x + sum.y;
}
__device__ __forceinline__ void sm_stats(f32x16 (&st)[2], SmState& S) {
    f32x16 dummy[2];
    sm_shift<false>(st, S, dummy, row_max32(st));
    f32x2v sum = {0.f, 0.f};
#pragma unroll
    for (int rb = 0; rb < 2; ++rb)
#pragma unroll
        for (int i = 0; i < 16; i += 2) { f32x2v p; p.x = ex2(st[rb][i]); p.y = ex2(st[rb][i + 1]); sum += p; }
    S.l += sum.x + sum.y;
}
__device__ __forceinline__ void zero_acc(f32x16 (&a)[2]) {
#pragma unroll
    for (int db = 0; db < 2; ++db)
#pragma unroll
        for (int i = 0; i < 16; ++i) a[db][i] = 0.f;
}
__device__ __forceinline__ void store_ot(const f32x16 (&o)[2], float sc, bf16_t* orow, int hh) {
#pragma unroll
    for (int db = 0; db < 2; ++db)
#pragma unroll
        for (int a = 0; a < 4; ++a) { u32x2 w; w.x = cvtpk(o[db][4 * a + 0] * sc, o[db][4 * a + 1] * sc); w.y = cvtpk(o[db][4 * a + 2] * sc, o[db][4 * a + 3] * sc);
            *(u32x2*)(orow + 32 * db + 8 * a + 4 * hh) = w; }
}
#define FA_FOREACH_REG(CODE) _Pragma("unroll") for (int rb = 0; rb < 2; ++rb) _Pragma("unroll") for (int a = 0; a < 4; ++a) _Pragma("unroll") for (int e = 0; e < 4; ++e) { const int i = 4 * a + e; const int kc = 32 * rb + 8 * a + e; (void)kc; CODE }
#define FA_LAUNDER(x) asm volatile("" : "+v"(x))

template <bool IS_MLA>
__device__ __forceinline__ void dense_unit(const Ctx& c, int b, int h, int qb) {
    constexpr int NKS = IS_MLA ? 6 : 4;
    const int tid = c.tid, lane = c.lane, r = lane & 31, hh = lane >> 5, w = c.wave;
    LAS unsigned char* lds = c.lds;
    const int q0 = qb * 256, qrow = q0 + 32 * w + r; const size_t mrow = (size_t)b * T + qrow;
    KVSrc src; bf16x8 qf[NKS]; bf16_t* orow;
    if constexpr (IS_MLA) {
        const bf16_t* QB = WSP(bf16_t, WS_QB); const bf16_t* KVB = WSP(bf16_t, WS_KVB);
        src.K = KVB + (size_t)b * T * 1024 + h * 64; src.kpitch = 1024; src.K2 = WSP(bf16_t, WS_KR) + (size_t)b * T * 32; src.k2pitch = 32; src.V = KVB + (size_t)b * T * 1024 + 512 + h * 64; src.vpitch = 1024; src.cum = nullptr; src.cref = 0.f;
#pragma unroll
        for (int ks = 0; ks < 4; ++ks) qf[ks] = *(const bf16x8*)(QB + mrow * 768 + h * 64 + 16 * ks + 8 * hh);
#pragma unroll
        for (int ks = 0; ks < 2; ++ks) qf[4 + ks] = *(const bf16x8*)(QB + mrow * 768 + 512 + h * 32 + 16 * ks + 8 * hh);
        orow = WSP(bf16_t, WS_OUTB) + mrow * 512 + h * 64;
    } else {
        const bf16_t* P1 = WSP(bf16_t, WS_P1);
        src.K = P1 + (size_t)b * T * P1W + C_FQKV + 512 + h * 64; src.kpitch = P1W; src.K2 = nullptr; src.k2pitch = 0; src.V = P1 + (size_t)b * T * P1W + C_FQKV + 1024 + h * 64; src.vpitch = P1W;
        src.cum = WSP(float, WS_CUM) + ((size_t)b * 8 + h) * T; src.cref = src.cum[q0];
#pragma unroll
        for (int ks = 0; ks < 4; ++ks) qf[ks] = *(const bf16x8*)(P1 + mrow * P1W + C_FQKV + h * 64 + 16 * ks + 8 * hh);
        orow = WSP(bf16_t, WS_OUTC) + mrow * 512 + h * 64;
    }
    f32x16 st[2], ot[2]; zero_acc(ot); SmState S{-INFINITY, 0.f};
    const int nt = 4 * qb + 4;
    const int wlast = (q0 + 32 * w + 31) >> 6;
    TileRegs R;
    tile_load<IS_MLA, !IS_MLA>(R, src, 0, tid); tile_store<IS_MLA, !IS_MLA>(R, lds, 0, tid, src.cref);
    if (nt > 1) tile_load<IS_MLA, !IS_MLA>(R, src, 64, tid);
    __syncthreads();
    for (int t = 0; t < nt; ++t) { const int buf = t & 1, kv0 = 64 * t;
        if (t <= wlast) {
            qk_tile<NKS>(st, lds, buf, qf, r, hh, sm_cval(S));
            if constexpr (!IS_MLA) {
#pragma unroll
                for (int rb = 0; rb < 2; ++rb)
#pragma unroll
                    for (int a = 0; a < 4; ++a) { const f32x4 ck = *(const LAS f32x4*)(lds + L_CUM + (buf * 64 + 32 * rb + 8 * a + 4 * hh) * 4);
                        f32x2v x0 = {st[rb][4 * a + 0], st[rb][4 * a + 1]}, x1 = {st[rb][4 * a + 2], st[rb][4 * a + 3]}; const f32x2v c0 = {ck[0], ck[1]}, c1 = {ck[2], ck[3]};
                        x0 -= c0; x1 -= c1; st[rb][4 * a + 0] = x0.x; st[rb][4 * a + 1] = x0.y; st[rb][4 * a + 2] = x1.x; st[rb][4 * a + 3] = x1.y; } }
            if (kv0 + 63 > q0 + 32 * w) { int lim = qrow - kv0 - 4 * hh; FA_LAUNDER(lim); FA_FOREACH_REG({ if (kc > lim) st[rb][i] = -INFINITY; }) }
            sm_update(st, S, ot);
            pv_tile(ot, lds, buf, st, lane);
        }
        if (t + 1 < nt) { tile_store<IS_MLA, !IS_MLA>(R, lds, buf ^ 1, tid, src.cref); if (t + 2 < nt) tile_load<IS_MLA, !IS_MLA>(R, src, kv0 + 128, tid); }
        __syncthreads();
    }
    const float lt = swap32_sum(S.l);
    store_ot(ot, 1.f / lt, orow, hh);
}

#define FA_STREAM(SRC, NT, TILE_EXPR, BODY) do { TileRegs R_; const int nt_ = (NT); \
    if (nt_ > 0) { { const int idx = 0; tile_load<false, false>(R_, SRC, 64 * (TILE_EXPR), tid); } tile_store<false, false>(R_, lds, 0, tid); \
      if (nt_ > 1) { const int idx = 1; tile_load<false, false>(R_, SRC, 64 * (TILE_EXPR), tid); } \
      __syncthreads(); \
      for (int it_ = 0; it_ < nt_; ++it_) { const int buf = it_ & 1; int tile; { const int idx = it_; tile = (TILE_EXPR); } \
          BODY \
          if (it_ + 1 < nt_) { tile_store<false, false>(R_, lds, buf ^ 1, tid); if (it_ + 2 < nt_) { const int idx = it_ + 2; tile_load<false, false>(R_, SRC, 64 * (TILE_EXPR), tid); } } \
          __syncthreads(); } } } while (0)

__device__ __forceinline__ void nsa_unit(const Ctx& c, int b, int g, int j) {
    const int tid = c.tid, lane = c.lane, r = lane & 31, hh = lane >> 5, w = c.wave;
    LAS unsigned char* lds = c.lds;
    const int t0 = 64 * j, tl = r >> 2, hp = r & 3, tokl = 8 * w + tl, tq = t0 + tokl, head = 4 * g + hp; const size_t mrow = (size_t)b * T + tq;
    const bf16_t* P1 = WSP(bf16_t, WS_P1);
    bf16x8 qf[4];
#pragma unroll
    for (int ks = 0; ks < 4; ++ks) qf[ks] = *(const bf16x8*)(P1 + mrow * P1W + C_NQ + head * 64 + 16 * ks + 8 * hh);
    const float gc = sigmoidf_(bf2f(P1[mrow * P1W + C_NG + head * 3 + 0])), gsl = sigmoidf_(bf2f(P1[mrow * P1W + C_NG + head * 3 + 1])), gwn = sigmoidf_(bf2f(P1[mrow * P1W + C_NG + head * 3 + 2]));
    const LAS float* lutL = (const LAS float*)(lds + L_LUT) + head * 132;
    LAS float* PS = (LAS float*)(lds + L_PS); LAS float* FM = (LAS float*)(lds + L_F); LAS unsigned* SEL = (LAS unsigned*)(lds + L_SEL); LAS unsigned* UNI = (LAS unsigned*)(lds + L_UNI);
    LAS unsigned char* TL = (LAS unsigned char*)(lds + L_TL); LAS int* TLN = (LAS int*)(lds + L_TLN);
    f32x16 st[2], ot[2], otot[2]; zero_acc(otot);
    for (int i = tid; i < 2 * 64 * 132; i += NTHREADS) PS[i] = 0.f;
    if (tid < 256) SEL[tid] = 0u; if (tid < 4) UNI[tid] = 0u;
    const float bfar = lutL[128];
    const int tmin = t0 + 8 * w;
    const int n_ok_max = ((t0 + 63 - 31) >> 4) + 1; const int nct = (n_ok_max + 63) >> 6;
    KVSrc srcc; srcc.K = WSP(bf16_t, WS_KC) + (size_t)(b * 2 + g) * 512 * 64; srcc.kpitch = 64; srcc.K2 = nullptr; srcc.k2pitch = 0; srcc.V = WSP(bf16_t, WS_VC) + (size_t)(b * 2 + g) * 512 * 64; srcc.vpitch = 64; srcc.cum = nullptr; srcc.cref = 0.f;
    SmState Sc{-INFINITY, 0.f};
    FA_STREAM(srcc, nct, idx, {
        const bool farc = (16 * (64 * tile + 63) + 31 + 128 <= tmin);
        qk_tile<4>(st, lds, buf, qf, r, hh, sm_cval(Sc) + (farc ? bfar : 0.f));
        if (!farc) { int db_ = tq - 31 - 1024 * tile - 64 * hh; FA_LAUNDER(db_); FA_FOREACH_REG({ const int dist = db_ - 16 * kc; const float s_ = st[rb][i] + lutL[dist < 0 ? 0 : (dist > 128 ? 128 : dist)]; st[rb][i] = dist < 0 ? -INFINITY : s_; }) }
        sm_stats(st, Sc); });
    { const float lt = swap32_sum(Sc.l); const float inv = lt > 0.f ? 1.f / lt : 0.f; const float msafe = (Sc.m == -INFINITY) ? 0.f : Sc.m;
      zero_acc(ot);
      FA_STREAM(srcc, nct, idx, {
        const bool farc = (16 * (64 * tile + 63) + 31 + 128 <= tmin);
        qk_tile<4>(st, lds, buf, qf, r, hh, (farc ? bfar : 0.f) - msafe);
        if (farc) { FA_FOREACH_REG({ st[rb][i] = ex2(st[rb][i]) * inv; }) }
        else { int db_ = tq - 31 - 1024 * tile - 64 * hh; FA_LAUNDER(db_); FA_FOREACH_REG({ const int dist = db_ - 16 * kc; const float s_ = st[rb][i] + lutL[dist < 0 ? 0 : (dist > 128 ? 128 : dist)]; st[rb][i] = dist < 0 ? 0.f : ex2(s_) * inv; }) }
_Pragma("unroll")
        for (int rb = 0; rb < 2; ++rb)
_Pragma("unroll")
            for (int a = 0; a < 4; ++a) { float q4[4];
_Pragma("unroll")
                for (int e = 0; e < 4; ++e) { float v = st[rb][4 * a + e]; v += dpp_f<0xB1>(v); v += dpp_f<0x4E>(v); q4[e] = v; }
                if (hp == 0) { const int G = 16 * tile + 8 * rb + 2 * a + hh; PS[tokl * 132 + G] = q4[0] + 2.f * (q4[1] + q4[2] + q4[3]); FM[tokl * 132 + G] = q4[0]; } }
        pv_tile(ot, lds, buf, st, lane); });
#pragma unroll
      for (int db = 0; db < 2; ++db)
#pragma unroll
          for (int i = 0; i < 16; ++i) otot[db][i] += gc * ot[db][i]; }
    if (j + 1 <= 16) { if (tid < 64) SEL[tid * 4] = (1u << (j + 1)) - 1u; if (tid == 0) UNI[0] = (1u << (j + 1)) - 1u; }
    else {
        for (int i = tid; i < 64 * 128; i += NTHREADS) { const int tk = i >> 7, G = i & 127; if (G >= 1 && G <= j - 2) PS[tk * 132 + G] += FM[tk * 132 + G + 1]; }
        __syncthreads();
        const int tk = tid >> 3, sub = tid & 7; unsigned bits[4] = {0u, 0u, 0u, 0u};
#pragma unroll 1
        for (int k = 0; k < 16; ++k) { const int G = sub + 8 * k;
            if (G >= 1 && G <= j - 2) { const float v = PS[tk * 132 + G]; int cnt = 0;
                for (int G2 = 1; G2 <= j - 2; ++G2) { const float v2 = PS[tk * 132 + G2]; cnt += (v2 > v || (v2 == v && G2 < G)) ? 1 : 0; }
                if (cnt < 13) { if (k < 4) bits[0] |= 1u << G; else if (k < 8) bits[1] |= 1u << (G - 32); else if (k < 12) bits[2] |= 1u << (G - 64); else bits[3] |= 1u << (G - 96); } } }
        if (sub == 0) { bits[0] |= 1u; { const int G = j; if (G < 32) bits[0] |= 1u << G; else if (G < 64) bits[1] |= 1u << (G - 32); else if (G < 96) bits[2] |= 1u << (G - 64); else bits[3] |= 1u << (G - 96); }
                        { const int G = j - 1; if (G < 32) bits[0] |= 1u << G; else if (G < 64) bits[1] |= 1u << (G - 32); else if (G < 96) bits[2] |= 1u << (G - 64); else bits[3] |= 1u << (G - 96); } }
#pragma unroll
        for (int q = 0; q < 4; ++q) if (bits[q]) { atomicOr((unsigned*)(SEL + tk * 4 + q), bits[q]); atomicOr((unsigned*)(UNI + q), bits[q]); }
    }
    __syncthreads();
    if (tid == 0) { int n = 0; for (int q = 0; q < 4; ++q) { unsigned m_ = UNI[q]; while (m_) { const int bpos = __builtin_ctz(m_); m_ &= m_ - 1u; TL[n++] = (unsigned char)(32 * q + bpos); } } TLN[0] = n; }
    __syncthreads();
    const unsigned msk0 = SEL[tokl * 4 + 0], msk1 = SEL[tokl * 4 + 1], msk2 = SEL[tokl * 4 + 2], msk3 = SEL[tokl * 4 + 3];
    const int nsel = __builtin_amdgcn_readfirstlane(TLN[0]);
    { KVSrc srcs; srcs.K = P1 + (size_t)b * T * P1W + C_NKV + ((1 * 2 + 0) * 2 + g) * 64; srcs.kpitch = P1W; srcs.K2 = nullptr; srcs.k2pitch = 0; srcs.V = P1 + (size_t)b * T * P1W + C_NKV + ((1 * 2 + 1) * 2 + g) * 64; srcs.vpitch = P1W; srcs.cum = nullptr; srcs.cref = 0.f;
      SmState Ss{-INFINITY, 0.f}; zero_acc(ot);
      FA_STREAM(srcs, nsel, (int)TL[idx], {
        const int wq = tile >> 5; const unsigned mw = wq == 0 ? msk0 : wq == 1 ? msk1 : wq == 2 ? msk2 : msk3; const bool mine = (mw >> (tile & 31)) & 1u;
        if (__any(mine)) {
            const bool fars = (64 * tile + 63 + 128 <= tmin);
            qk_tile<4>(st, lds, buf, qf, r, hh, mine ? sm_cval(Ss) + (fars ? bfar : 0.f) : -INFINITY);
            if (!fars) { int db_ = tq - 64 * tile - 4 * hh; FA_LAUNDER(db_); FA_FOREACH_REG({ const int dist = db_ - kc; const float s_ = st[rb][i] + lutL[dist < 0 ? 0 : (dist > 128 ? 128 : dist)]; st[rb][i] = (dist >= 0) ? s_ : -INFINITY; }) }
            sm_update(st, Ss, ot);
            pv_tile(ot, lds, buf, st, lane); } });
      const float lt = swap32_sum(Ss.l); const float sc = lt > 0.f ? gsl / lt : 0.f;
#pragma unroll
      for (int db = 0; db < 2; ++db)
#pragma unroll
          for (int i = 0; i < 16; ++i) otot[db][i] += sc * ot[db][i]; }
    { KVSrc srcw; srcw.K = P1 + (size_t)b * T * P1W + C_NKV + ((2 * 2 + 0) * 2 + g) * 64; srcw.kpitch = P1W; srcw.K2 = nullptr; srcw.k2pitch = 0; srcw.V = P1 + (size_t)b * T * P1W + C_NKV + ((2 * 2 + 1) * 2 + g) * 64; srcw.vpitch = P1W; srcw.cum = nullptr; srcw.cref = 0.f;
      const int jlo = j - 8 > 0 ? j - 8 : 0;
      SmState Sw{-INFINITY, 0.f}; zero_acc(ot);
      FA_STREAM(srcw, j - jlo + 1, jlo + idx, {
        qk_tile<4>(st, lds, buf, qf, r, hh, sm_cval(Sw));
        { int db_ = tq - 64 * tile - 4 * hh; FA_LAUNDER(db_); FA_FOREACH_REG({ const int dist = db_ - kc; const float s_ = st[rb][i] + lutL[dist < 0 ? 0 : (dist > 128 ? 128 : dist)]; st[rb][i] = (dist >= 0 && dist < 512) ? s_ : -INFINITY; }) }
        sm_update(st, Sw, ot);
        pv_tile(ot, lds, buf, st, lane); });
      const float lt = swap32_sum(Sw.l); const float sc = lt > 0.f ? gwn / lt : 0.f;
#pragma unroll
      for (int db = 0; db < 2; ++db)
#pragma unroll
          for (int i = 0; i < 16; ++i) otot[db][i] += sc * ot[db][i]; }
    store_ot(otot, 1.f, WSP(bf16_t, WS_OUTA) + mrow * 512 + head * 64, hh);
}
}

__device__ __forceinline__ int next_unit(const Ctx& c, unsigned* ctr) {
    LAS int* u = (LAS int*)(c.lds + fa::L_UNIT);
    __syncthreads();
    if (c.tid == 0) u[0] = (int)__hip_atomic_fetch_add(ctr, 1u, __ATOMIC_RELAXED, __HIP_MEMORY_SCOPE_AGENT);
    __syncthreads();
    return __builtin_amdgcn_readfirstlane(u[0]);
}
__device__ __forceinline__ void phase_att_fast(const Ctx& c0, int l) {
    Ctx c = c0;
    unsigned* ctr = WSP(unsigned, WS_CTL) + CW_QUEUE + 64 * l;
    { const float* lut = WSP(float, WS_TAB) + 512; LAS float* L_ = (LAS float*)(c.lds + fa::L_LUT); for (int i = c.tid; i < 8 * 132; i += NTHREADS) L_[i] = lut[i]; }
    for (;;) {
        const int u = next_unit(c, ctr);
        if (u >= 32 * 48) break;
        relaunder(c);
        const int lv = 31 - u / 48, k = u % 48, kind = k >> 4, id = k & 15;
        if (kind == 0) { if (ATT_FAST_MLA) fa::dense_unit<true>(c, id >> 3, id & 7, lv); }
        else if (kind == 1) { if (ATT_FAST_NSA) fa::nsa_unit(c, (id >> 1) & 1, id & 1, 4 * lv + 3 - (id >> 2)); }
        else { if (ATT_FAST_FOX) fa::dense_unit<false>(c, id >> 3, id & 7, lv); }
    }
}

struct Args { const void* in[32]; float* out; unsigned char* ws; int l_lo, l_hi; };
constexpr int PH_PER_LAYER = 15, K_FINAL = 1 + PH_PER_LAYER;
template <int KIND>
__global__ void __launch_bounds__(NTHREADS, 2) fwd_kernel(Args a) {
    extern __shared__ __attribute__((aligned(16))) unsigned char lds_raw[];
    Ctx c;
    c.out = a.out; c.ws = a.ws; c.ws0 = a.ws; c.lds = (LAS unsigned char*)lds_raw;
    c.tid = threadIdx.x; c.lane = c.tid & 63; c.wave = __builtin_amdgcn_readfirstlane(c.tid >> 6); c.G = gridDim.x; c.bid = blockIdx.x;
    if (c.tid < 4) ((LAS unsigned*)(c.lds + LDS_MISC))[c.tid] = 0u;
    if (c.tid < 32) { const unsigned long long pv = (unsigned long long)a.in[c.tid]; ((LAS unsigned*)(c.lds + LDS_INTAB))[2 * c.tid] = (unsigned)pv; ((LAS unsigned*)(c.lds + LDS_INTAB))[2 * c.tid + 1] = (unsigned)(pv >> 32); }
    __syncthreads();
    XcdBarrier bar; bar.bar = WSP(unsigned, WS_CTL) + CW_BAR; bar.x = 0; bar.st = nullptr;
    if constexpr (KIND < 0) bar = xcd_barrier_post(WSP(unsigned, WS_CTL) + CW_BAR, (volatile LAS unsigned*)(c.lds + LDS_MISC));
#define IN(k) ((KIND < 0 || KIND == (k)) && (relaunder(c), true))
#define REP(p) for (int rep_ = 0; rep_ < ((PROBE_DOUBLE == (p)) ? 2 : 1); ++rep_)
#define SEAM(k) do { if constexpr (KIND < 0) { unsigned* bb_ = bar.bar; asm volatile("" : "+s"(bb_)); bar.bar = bb_; xcd_barrier(bar); } } while (0)
    LAS unsigned char* ring = c.lds;

    if (IN(0)) REP(4) { phase_prologue(c); } SEAM(0);
    for (int l = a.l_lo; l < a.l_hi; ++l) {
        constexpr int pb = 1;
        const float* resid = (l == 0) ? c.x() : WSP(float, WS_XA);
        if (IN(pb + 0)) { if (l == 0) phase_norm(c, c.x(), nullptr, nullptr, nullptr, WSP(bf16_t, WS_H0));
                          else phase_norm(c, WSP(float, WS_XA), WSP(bf16_t, WS_Y), WSP(bf16_t, WS_Y) + (size_t)M * D, WSP(float, WS_XA), WSP(bf16_t, WS_H0));
#if PROBE_DOUBLE == 6
                          if (l == 0) phase_norm(c, c.x(), nullptr, nullptr, nullptr, WSP(bf16_t, WS_HG));
                          else phase_norm(c, WSP(float, WS_XA), WSP(bf16_t, WS_Y), WSP(bf16_t, WS_Y) + (size_t)M * D, WSP(float, WS_P1), WSP(bf16_t, WS_QB));
#endif
        } SEAM(pb + 0);
        if (IN(pb + 1)) REP(2) { pg8::Cfg g{(unsigned)(D * 2), 128u, (unsigned)(D * 2), D / 64, nullptr}; pg8::DenseOrder S; S.init(M / 256, P1W / 256, c.G, c.bid, WSP(bf16_t, WS_H0), (size_t)256 * D * 2, WSP(bf16_t, WS_WINT) + (size_t)l * P1W * D, (size_t)256 * D * 2);
            EpiStoreBf16 E{WSP(bf16_t, WS_P1), P1W, nullptr, 0}; pg8::gemm_phase<false>(ring, c.wave, g, S, E); } SEAM(pb + 1);
        if (IN(pb + 2)) REP(5) { phase_prep(c, l); } SEAM(pb + 2);
        if (IN(pb + 3)) REP(5) { phase_cum(c); } SEAM(pb + 3);
        if (IN(pb + 4)) REP(2) {
            { pg8::Cfg g{(unsigned)(P1W * 2), 128u, 512u, 4, nullptr}; pg8::DenseOrder S; S.init(M / 256, 3, c.G, c.bid, WSP(bf16_t, WS_P1) + C_CQ, (size_t)256 * P1W * 2, WSP(bf16_t, WS_WUQT) + (size_t)l * 768 * 256, (size_t)256 * 512);
              EpiStoreBf16 E{WSP(bf16_t, WS_QB), 768, WSP(float, WS_RSTD), 2}; pg8::gemm_phase<false>(ring, c.wave, g, S, E); }
            { pg8::Cfg g{(unsigned)(P1W * 2), 128u, 256u, 2, nullptr}; pg8::DenseOrder S; S.init(M / 256, 4, c.G, c.bid, WSP(bf16_t, WS_P1) + C_CKV, (size_t)256 * P1W * 2, WSP(bf16_t, WS_WUKVT) + (size_t)l * 1024 * 128, (size_t)256 * 256);
              EpiStoreBf16 E{WSP(bf16_t, WS_KVB), 1024, WSP(float, WS_RSTD) + 1, 2}; pg8::gemm_phase<false>(ring, c.wave, g, S, E); }
            { pg8::Cfg g{(unsigned)(16 * P1W * 2), (unsigned)(P1W * 2), 4096u, 32, nullptr}; CmpOrder S{c.G, (c.bid + 64) % c.G, (const char*)WSP(bf16_t, WS_P1), (const char*)(WSP(bf16_t, WS_WC1T) + (size_t)l * 2 * 256 * 2048)};
              EpiCmp1 E{WSP(bf16_t, WS_HC), WSP(float, WS_TAB) + l * 256}; pg8::gemm_phase<false>(ring, c.wave, g, S, E); }
        } SEAM(pb + 4);
        if (IN(pb + 5)) { phase_cmp2_ropeq(c, l); } SEAM(pb + 5);
        if (IN(pb + 6)) { phase_att_fast(c, l);
#if PROBE_DOUBLE == 1
            phase_att_fast(c, l + 2);
#endif
        } SEAM(pb + 6);
        if (IN(pb + 7)) REP(5) { phase_norm(c, resid, nullptr, nullptr, nullptr, WSP(bf16_t, WS_HG)); } SEAM(pb + 7);
        if (IN(pb + 8)) REP(2) { pg8::Cfg g{(unsigned)(D * 2), 128u, (unsigned)(D * 2), D / 64, nullptr}; pg8::DenseOrder S; S.init(M / 256, 12, c.G, c.bid, WSP(bf16_t, WS_HG), (size_t)256 * D * 2, WSP(bf16_t, WS_WMT) + (size_t)l * 3072 * D, (size_t)256 * D * 2);
            EpiGates E{WSP(bf16_t, WS_GATES), c.b_merge() + l * 3072}; pg8::gemm_phase<false>(ring, c.wave, g, S, E); } SEAM(pb + 8);
        if (IN(pb + 9)) REP(2) {
#pragma unroll 1
            for (int br = 0; br < 3; ++br) { pg8::Cfg g{1024u, 128u, 1024u, 8, nullptr}; pg8::DenseOrder S;
                S.init(M / 256, 4, c.G, c.bid, WSP(bf16_t, br == 0 ? WS_OUTA : br == 1 ? WS_OUTB : WS_OUTC), (size_t)256 * 1024, WSP(bf16_t, WS_WOT) + ((size_t)l * 3 + br) * 1024 * 512, (size_t)256 * 1024);
                EpiOutproj E{WSP(bf16_t, WS_MIXED), WSP(bf16_t, WS_GATES), br}; pg8::gemm_phase<false>(ring, c.wave, g, S, E); }
        } SEAM(pb + 9);
        if (IN(pb + 10)) { pg8::Cfg g{(unsigned)(D * 2), 128u, (unsigned)(D * 2), D / 64, nullptr}; pg8::DenseOrder S; S.init(M / 256, 4, c.G, c.bid, WSP(bf16_t, WS_MIXED), (size_t)256 * D * 2, WSP(bf16_t, WS_WOUTT) + (size_t)l * D * D, (size_t)256 * D * 2);
            EpiWout E{resid, WSP(float, WS_XA)}; pg8::gemm_phase<false>(ring, c.wave, g, S, E);
#if PROBE_DOUBLE == 6
            { EpiWout E2{resid, (float*)(c.ws + PB + 32 * MiB)}; pg8::gemm_phase<false>(ring, c.wave, g, S, E2); }
#endif
        } SEAM(pb + 10);
        if (IN(pb + 11)) { phase_router(c, l);
#if PROBE_DOUBLE == 3
            phase_router(c, l, 1);
#endif
        } SEAM(pb + 11);
        if (IN(pb + 12)) REP(4) { phase_place(c, l); } SEAM(pb + 12);
        if (IN(pb + 13)) REP(2) { LAS int* tab = (LAS int*)(c.lds + LDS_MOETAB); moe_tables(c, l, tab);
            pg8::Cfg g{(unsigned)(D * 2), 128u, (unsigned)(D * 2), D / 64, WSP(int, WS_LTOK)}; MoeOrder S{c.G, c.bid, 2, tab, (const char*)WSP(bf16_t, WS_H2), 0, (const char*)WSP(bf16_t, WS_WGU), (size_t)512 * D * 2, (size_t)256 * D * 2};
            EpiMoe1 E{WSP(bf16_t, WS_HID), WSP(float, WS_LW)}; pg8::gemm_phase<true>(ring, c.wave, g, S, E); } SEAM(pb + 13);
        if (IN(pb + 14)) REP(2) { LAS int* tab = (LAS int*)(c.lds + LDS_MOETAB); moe_tables(c, l, tab);
            pg8::Cfg g{512u, 128u, 512u, 4, nullptr}; MoeOrder S{c.G, c.bid, 4, tab, (const char*)WSP(bf16_t, WS_HID), 512, (const char*)WSP(bf16_t, WS_WDT), (size_t)D * 256 * 2, (size_t)256 * 256 * 2};
            EpiMoe2 E{WSP(bf16_t, WS_Y), WSP(unsigned, WS_LSLOT)}; pg8::gemm_phase<false>(ring, c.wave, g, S, E); } SEAM(pb + 14);
    }
    if (IN(K_FINAL)) REP(6) { phase_final(c); }
#undef IN
#undef SEAM
}

template <int KIND> static bool prep_kernel() { return hipFuncSetAttribute((const void*)fwd_kernel<KIND>, hipFuncAttributeMaxDynamicSharedMemorySize, LDS_BYTES) == hipSuccess; }
template <int KIND> static void launch_kind(int grid, hipStream_t stream, Args a, int l) { a.l_lo = l; a.l_hi = l + 1; hipLaunchKernelGGL(fwd_kernel<KIND>, dim3(grid), dim3(NTHREADS), LDS_BYTES, stream, a); }
extern "C" void kernel_launch(void* const* d_in, const int* in_sizes, int n_in, void* d_out, int out_size, void* d_ws, size_t ws_size, hipStream_t stream) {
    static int grid = 0;
    if (grid == 0) {
        if (n_in != 32 || ws_size < WS_END) { fprintf(stderr, "kernel_launch: n_in %d ws %zu (need %zu)\n", n_in, ws_size, (size_t)WS_END); grid = -1; return; }
        int dev = 0, cus = 0;
        if (hipGetDevice(&dev) != hipSuccess || hipDeviceGetAttribute(&cus, hipDeviceAttributeMultiprocessorCount, dev) != hipSuccess) { grid = -1; return; }
        bool ok = true;
#if MK_ONE_LAUNCH
        ok = prep_kernel<-1>();
#else
        ok = prep_kernel<0>() && prep_kernel<1>() && prep_kernel<2>() && prep_kernel<3>() && prep_kernel<4>() && prep_kernel<5>() && prep_kernel<6>() && prep_kernel<7>() && prep_kernel<8>() && prep_kernel<9>()
          && prep_kernel<10>() && prep_kernel<11>() && prep_kernel<12>() && prep_kernel<13>() && prep_kernel<14>() && prep_kernel<15>() && prep_kernel<16>();
#endif
        if (!ok) { grid = -1; return; }
        (void)hipGetLastError();
        grid = cus;
    }
    if (grid < 0) return;
    (void)hipMemsetAsync((char*)d_ws + WS_CTL, 0, CTL_BYTES, stream);
    Args a{};
    for (int i = 0; i < 32; ++i) a.in[i] = d_in[i];
    a.out = (float*)d_out; a.ws = (unsigned char*)d_ws;
#if MK_ONE_LAUNCH
    a.l_lo = 0; a.l_hi = NL;
    hipLaunchKernelGGL(fwd_kernel<-1>, dim3(grid), dim3(NTHREADS), LDS_BYTES, stream, a);
#else
    launch_kind<0>(grid, stream, a, 0);
    for (int l = 0; l < NL; ++l) {
        launch_kind<1>(grid, stream, a, l); launch_kind<2>(grid, stream, a, l); launch_kind<3>(grid, stream, a, l); launch_kind<4>(grid, stream, a, l); launch_kind<5>(grid, stream, a, l);
        launch_kind<6>(grid, stream, a, l); launch_kind<7>(grid, stream, a, l); launch_kind<8>(grid, stream, a, l); launch_kind<9>(grid, stream, a, l); launch_kind<10>(grid, stream, a, l);
        launch_kind<11>(grid, stream, a, l); launch_kind<12>(grid, stream, a, l); launch_kind<13>(grid, stream, a, l); launch_kind<14>(grid, stream, a, l); launch_kind<15>(grid, stream, a, l);
    }
    launch_kind<16>(grid, stream, a, 0);
#endif
}
```

```cpp
#include <hip/hip_runtime.h>
#include <stdint.h>
#include <cstdio>

#ifndef PROBE_DOUBLE
#define PROBE_DOUBLE 0
#endif
#ifndef MK_ONE_LAUNCH
#define MK_ONE_LAUNCH 1
#endif

#define LAS __attribute__((address_space(3)))
typedef unsigned short bf16_t;
typedef short bf16x8 __attribute__((ext_vector_type(8)));
typedef float f32x4 __attribute__((ext_vector_type(4)));
typedef float f32x16 __attribute__((ext_vector_type(16)));
typedef unsigned u32x4 __attribute__((ext_vector_type(4)));
typedef unsigned u32x2 __attribute__((ext_vector_type(2)));

constexpr int NB = 2, T = 8192, D = 1024, M = NB * T, NL = 2;
constexpr int DIN = 6336;
constexpr int P1W = 3328;
constexpr int C_NQ = 0, C_NKV = 512, C_CQ = 1280, C_CKV = 1536, C_KR = 1664, C_NG = 1696, C_FF = 1720, C_FQKV = 1728;
constexpr int NEXP = 32, EDIM = 256;
constexpr float EPS = 1e-6f;
constexpr float LOG2E = 1.4426950408889634f;
constexpr float QSCALE64 = 0.125f * LOG2E, QSCALE96 = 0.10206207261596575f * LOG2E;
constexpr int NTHREADS = 512, NWAVES = 8;
constexpr int LDS_BYTES = 147456;
constexpr int MOE_MAXROWS = 40960;

constexpr size_t MiB = 1u << 20;
constexpr size_t WS_CTL = 0;
constexpr size_t CTL_BYTES = 1 * MiB;
constexpr int CW_BAR = 4096;
constexpr int CW_QUEUE = 16384;
constexpr int CW_MOECNT = 32768;
constexpr int CW_KMAX = 24576;
constexpr int CW_CNTB = 65536;
constexpr size_t CTL_LTOK = 512 * 1024;
constexpr size_t WS_WINT = 1 * MiB;
constexpr size_t WS_WMT = 14 * MiB;
constexpr size_t WS_WUQT = 26 * MiB;
constexpr size_t WS_WUKVT = 27 * MiB;
constexpr size_t WS_WOT = 28 * MiB;
constexpr size_t WS_WOUTT = 34 * MiB;
constexpr size_t WS_WC1T = 38 * MiB;
constexpr size_t WS_ROPE = 42 * MiB;
constexpr size_t WS_TAB = 44 * MiB;
constexpr size_t WS_XA = 45 * MiB;
constexpr size_t PB = 109 * MiB;
constexpr size_t WS_P1 = PB;
constexpr size_t WS_QB = PB + 104 * MiB;
constexpr size_t WS_KVB = PB + 128 * MiB;
constexpr size_t WS_OUTA = PB + 160 * MiB;
constexpr size_t WS_OUTB = PB + 176 * MiB;
constexpr size_t WS_OUTC = PB + 192 * MiB;
constexpr size_t WS_H0 = PB + 176 * MiB;
constexpr size_t WS_SM = PB + 208 * MiB;
constexpr size_t WS_RSTD = WS_SM;
constexpr size_t WS_KR = WS_SM + 256 * 1024;
constexpr size_t WS_LF = WS_SM + 1280 * 1024;
constexpr size_t WS_CUM = WS_SM + 1792 * 1024;
constexpr size_t WS_HC = WS_SM + 2304 * 1024;
constexpr size_t WS_KC = WS_SM + 3328 * 1024;
constexpr size_t WS_VC = WS_SM + 3584 * 1024;
constexpr size_t WS_REC = WS_SM + 3840 * 1024;
constexpr size_t WS_LTOK = WS_SM + 4352 * 1024;
constexpr size_t WS_LW = WS_SM + 4608 * 1024;
constexpr size_t WS_LSLOT = WS_SM + 4864 * 1024;
constexpr size_t WS_END = PB + 216 * MiB;
constexpr size_t WS_HG = PB;
constexpr size_t WS_GATES = PB + 32 * MiB;
constexpr size_t WS_MIXED = PB + 128 * MiB;
constexpr size_t WS_H2 = PB;
constexpr size_t WS_WGU = PB + 32 * MiB;
constexpr size_t WS_WDT = PB + 64 * MiB;
constexpr size_t WS_HID = PB + 80 * MiB;
constexpr size_t WS_Y = PB + 100 * MiB;
static_assert(WS_Y + 64 * MiB <= WS_H0, "Y must not overlap H0");
static_assert(WS_END <= 332 * MiB, "workspace budget");

__device__ __forceinline__ float bf2f(bf16_t v) { return __uint_as_float((unsigned)v << 16); }
__device__ __forceinline__ unsigned f2bf(float f) { unsigned u = __float_as_uint(f); return (u + 0x7fffu + ((u >> 16) & 1u)) >> 16; }
__device__ __forceinline__ unsigned pk2(float lo, float hi) { return f2bf(lo) | (f2bf(hi) << 16); }
typedef float f32x2_t __attribute__((ext_vector_type(2))); typedef __bf16 bf16x2_t __attribute__((ext_vector_type(2)));
__device__ __forceinline__ unsigned cvtpk(float lo, float hi) { f32x2_t v = {lo, hi}; bf16x2_t b = __builtin_convertvector(v, bf16x2_t); return __builtin_bit_cast(unsigned, b); }
__device__ __forceinline__ f32x4 unpk4(u32x2 a) { f32x4 r; r.x = __uint_as_float(a.x << 16); r.y = __uint_as_float(a.x & 0xffff0000u); r.z = __uint_as_float(a.y << 16); r.w = __uint_as_float(a.y & 0xffff0000u); return r; }
template <int CTRL> __device__ __forceinline__ float dpp_f(float v) { return __int_as_float(__builtin_amdgcn_update_dpp(0, __float_as_int(v), CTRL, 0xf, 0xf, true)); }
__device__ __forceinline__ float wave_sum(float v) {
    v += dpp_f<0xB1>(v); v += dpp_f<0x4E>(v); v += dpp_f<0x141>(v); v += dpp_f<0x140>(v);
    const float a = __int_as_float(__builtin_amdgcn_readlane(__float_as_int(v), 0)), b = __int_as_float(__builtin_amdgcn_readlane(__float_as_int(v), 16));
    const float c2 = __int_as_float(__builtin_amdgcn_readlane(__float_as_int(v), 32)), d = __int_as_float(__builtin_amdgcn_readlane(__float_as_int(v), 48));
    return (a + b) + (c2 + d);
}
__device__ __forceinline__ float wave_max(float v) {
    v = fmaxf(v, dpp_f<0xB1>(v)); v = fmaxf(v, dpp_f<0x4E>(v)); v = fmaxf(v, dpp_f<0x141>(v)); v = fmaxf(v, dpp_f<0x140>(v));
    const float a = __int_as_float(__builtin_amdgcn_readlane(__float_as_int(v), 0)), b = __int_as_float(__builtin_amdgcn_readlane(__float_as_int(v), 16));
    const float c2 = __int_as_float(__builtin_amdgcn_readlane(__float_as_int(v), 32)), d = __int_as_float(__builtin_amdgcn_readlane(__float_as_int(v), 48));
    return fmaxf(fmaxf(a, b), fmaxf(c2, d));
}
__device__ __forceinline__ float half_sum(float v) { auto rr = __builtin_amdgcn_permlane32_swap(__float_as_uint(v), __float_as_uint(v), false, false); return __uint_as_float(rr[0]) + __uint_as_float(rr[1]); }
__device__ __forceinline__ float sigmoidf_(float x) { return 1.f / (1.f + __expf(-x)); }
__device__ __forceinline__ float gelu_tanh(float x) { const float u = 0.7978845608028654f * (x + 0.044715f * x * x * x); const float th = 1.f - 2.f / (1.f + __expf(2.f * u)); return 0.5f * x * (1.f + th); }
#define LDS_WAIT() asm volatile("s_waitcnt lgkmcnt(0)" ::: "memory")

#define XB_TMO      128
#define XB_XCNT(j)  (256  + 64 * (j))
#define XB_XSUB(j)  (1280 + 64 * (j))
#define XB_XGEN(j)  (2304 + 64 * (j))
#define XB_TOP      3328
#define XB_TOPGEN   3392
#define XCD_BAR_WORDS 3456
#define XB_SPIN_CAP (1u << 18)

__device__ __forceinline__ unsigned xb_ld(unsigned* p)              { return __hip_atomic_load(p, __ATOMIC_RELAXED, __HIP_MEMORY_SCOPE_AGENT); }
__device__ __forceinline__ unsigned xb_add(unsigned* p, unsigned v) { return __hip_atomic_fetch_add(p, v, __ATOMIC_RELAXED, __HIP_MEMORY_SCOPE_AGENT); }
__device__ __forceinline__ unsigned xb_xcc_id() { return (unsigned)__builtin_amdgcn_s_getreg((3 << 11) | 20) & 0xFu; }
#define XB_SPIN(cond, bar) do { unsigned _sp = 0; while (cond) { __builtin_amdgcn_s_sleep(1); \
    if ((++_sp & 255u) == 0u) { if (xb_ld(&(bar)[XB_TMO])) break; if (_sp > XB_SPIN_CAP) { atomicAdd(&(bar)[XB_TMO], 1u); break; } } } } while (0)

struct XcdBarrier { unsigned* bar; unsigned x; volatile LAS unsigned* st; };

__device__ __forceinline__ XcdBarrier xcd_barrier_post(unsigned* bar, volatile LAS unsigned* st) {
    XcdBarrier b; b.bar = bar; b.x = xb_xcc_id(); b.st = st;
    if (threadIdx.x == 0) (void)xb_add(&bar[XB_XCNT(b.x)], 1u);
    return b;
}
__device__ __forceinline__ void xcd_barrier_complete(unsigned* bar, unsigned x, unsigned& nloc, unsigned& nx) {
    const unsigned G = gridDim.x * gridDim.y * gridDim.z;
    unsigned sum, cnt, mine, sp = 0u;
    for (;;) {
        sum = 0u; cnt = 0u; mine = 0u;
#pragma unroll
        for (unsigned j = 0; j < 16; ++j) { const unsigned c = xb_ld(&bar[XB_XCNT(j)]); sum += c; cnt += (c > 0u) ? 1u : 0u; mine = (j == x) ? c : mine; }
        if (sum == G) break;
        __builtin_amdgcn_s_sleep(1);
        if ((++sp & 255u) == 0u) { if (xb_ld(&bar[XB_TMO])) break; if (sp > XB_SPIN_CAP) { atomicAdd(&bar[XB_TMO], 1u); break; } }
    }
    nloc = mine > 0u ? mine : 1u; nx = cnt > 0u ? cnt : 1u;
}
__device__ __forceinline__ void xcd_barrier(const XcdBarrier& b) {
    asm volatile("s_waitcnt vmcnt(0)" ::: "memory");
    __syncthreads();
    if (threadIdx.x == 0) {
        unsigned* bar = b.bar;
        __builtin_amdgcn_s_waitcnt(0);
        unsigned nloc = b.st[0], nx = b.st[1];
        if (nloc == 0u) { xcd_barrier_complete(bar, b.x, nloc, nx); b.st[0] = nloc; b.st[1] = nx; }
        const unsigned old = xb_add(&bar[XB_XSUB(b.x)], 1u);
        const unsigned gen = old / nloc;
        if (old + 1u == (gen + 1u) * nloc) {
            __builtin_amdgcn_fence(__ATOMIC_RELEASE, "agent");
            asm volatile("s_waitcnt vmcnt(0)" ::: "memory");
            const unsigned og = xb_add(&bar[XB_TOP], 1u);
            const unsigned tg = og / nx;
            if (og + 1u == (tg + 1u) * nx) xb_add(&bar[XB_TOPGEN], 1u);
            else XB_SPIN(xb_ld(&bar[XB_TOPGEN]) == tg, bar);
            __builtin_amdgcn_fence(__ATOMIC_ACQUIRE, "agent");
            xb_add(&bar[XB_XGEN(b.x)], 1u);
            asm volatile("s_waitcnt vmcnt(0)" ::: "memory");
        } else {
            XB_SPIN(xb_ld(&bar[XB_XGEN(b.x)]) == gen, bar);
            __builtin_amdgcn_fence(__ATOMIC_ACQUIRE, "agent");
            asm volatile("s_waitcnt vmcnt(0)" ::: "memory");
        }
    }
    __syncthreads();
}

namespace pg8 {
constexpr int BM = 256, BK = 64, HALF = 128, HTB = HALF * BK * 2, STAGE_BYTES = 8 * HTB;
__host__ __device__ __forceinline__ int lds_byte(int r, int c) { const int st = (r >> 4) * 2 + (c >> 5), rr = r & 15, cc = c & 31, ob = rr * 64 + cc * 2; return st * 1024 + (ob ^ (((ob >> 9) & 1) << 5)); }
__host__ __device__ __forceinline__ void stage_rc(int b, int& R, int& C) { const int st = b / 1024, sb = b % 1024, swz = sb ^ (((sb >> 9) & 1) << 5); R = (st >> 1) * 16 + swz / 64; C = (st & 1) * 32 + (swz % 64) / 2; }

struct Unit { int pm, pn; const char* A; const char* B; int aux; };
struct Cfg { unsigned lda; unsigned kstepA; unsigned ldb; int nt; const int* rowidx; };

struct DenseOrder {
    int nM, nN, nwg, G, c; const char* A; const char* B; size_t tstepA, tstepB;
    __device__ void init(int nM_, int nN_, int G_, int c_, const void* A_, size_t tstepA_, const void* B_, size_t tstepB_) { nM = nM_; nN = nN_; nwg = nM * nN; G = G_; c = c_; A = (const char*)A_; B = (const char*)B_; tstepA = tstepA_; tstepB = tstepB_; }
    __device__ bool next(int i, Unit& u) const {
        const long Lq = (long)i * G + c; if (Lq >= nwg) return false;
        int wgid = (int)Lq; { const int q = nwg / 8, r = nwg % 8, xcd = wgid % 8, off = wgid / 8; wgid = (xcd < r ? xcd * (q + 1) : r * (q + 1) + (xcd - r) * q) + off; }
        const int nig = 8 * nN, gid = wgid / nig, fm = gid * 8, gsz = (nM - fm) < 8 ? (nM - fm) : 8;
        u.pm = fm + ((wgid % nig) % gsz); u.pn = (wgid % nig) / gsz; u.A = A + (size_t)u.pm * tstepA; u.B = B + (size_t)u.pn * tstepB; u.aux = 0; return true;
    }
};

#define PG8_EPI_ROWCOL(row, col) const int row = u.pm * 256 + ai * 128 + wr * 64 + m * 16 + fr; const int col = u.pn * 256 + bj * 128 + wc * 32 + n * 16 + fq * 4;

template <bool INDEXED, class Epi, class Sched>
__device__ __forceinline__ void gemm_phase(LAS unsigned char* lds, int wid, const Cfg g, const Sched& S, const Epi& E) {
    int lane_; asm volatile("v_mbcnt_lo_u32_b32 %0, -1, 0\n\tv_mbcnt_hi_u32_b32 %0, -1, %0" : "=v"(lane_));
    const int lane = lane_, tid = wid * 64 + lane, wr = wid >> 2, wc = wid & 3, fr = lane & 15, fq = lane >> 4;
    const int nt = g.nt;
    int Rs[2], Cs[2]; unsigned voffB[2];
#pragma unroll
    for (int i = 0; i < 2; ++i) { stage_rc(tid * 16 + i * 8192, Rs[i], Cs[i]); voffB[i] = (unsigned)Rs[i] * g.ldb + (unsigned)Cs[i] * 2u; }
    const size_t kstepA = g.kstepA, kstepB = (size_t)(BK * 2);
    const size_t hstepB = (size_t)HALF * g.ldb;
    const unsigned ldsw = (unsigned)wid * 1024u;
    const int aoff = lds_byte(wr * 64 + fr, fq * 8), boff = lds_byte(wc * 32 + fr, fq * 8);
#define PG8_SA(b, h) (((b) * 2 + (h)) * HTB)
#define PG8_SB(b, h) ((4 + (b) * 2 + (h)) * HTB)
#define PG8_STAGE2(bufoff, gbase, v0, v1) do { const char* gb_ = (const char*)(gbase); asm volatile("" : "+s"(gb_)); \
        __builtin_amdgcn_global_load_lds((const unsigned*)(gb_ + (v0)), (LAS unsigned*)(lds + (bufoff) + ldsw), 16, 0, 0); \
        __builtin_amdgcn_global_load_lds((const unsigned*)(gb_ + (v1)), (LAS unsigned*)(lds + (bufoff) + ldsw + 8192), 16, 0, 0); } while (0)
#define PG8_STAGEB(bufoff, gbase) PG8_STAGE2(bufoff, gbase, voffB[0], voffB[1])
#define PG8_LDA(dst, b, h) do { _Pragma("unroll") for (int m = 0; m < 4; ++m) _Pragma("unroll") for (int k = 0; k < 2; ++k) dst[m][k] = *(const LAS bf16x8*)(lds + PG8_SA(b, h) + aoff + m * 2048 + k * 1024); } while (0)
#define PG8_LDB(dst, b, h) do { _Pragma("unroll") for (int n = 0; n < 2; ++n) _Pragma("unroll") for (int k = 0; k < 2; ++k) dst[n][k] = *(const LAS bf16x8*)(lds + PG8_SB(b, h) + boff + n * 2048 + k * 1024); } while (0)
#define PG8_MMA(ai, bj, At, Bt) do { __builtin_amdgcn_s_setprio(1); _Pragma("unroll") for (int m = 0; m < 4; ++m) _Pragma("unroll") for (int n = 0; n < 2; ++n) _Pragma("unroll") for (int k = 0; k < 2; ++k) \
        acc[ai][bj][m][n] = __builtin_amdgcn_mfma_f32_16x16x32_bf16(Bt[n][k], At[m][k], acc[ai][bj][m][n], 0, 0, 0); __builtin_amdgcn_s_setprio(0); } while (0)
#define PG8_WAIT_V(n) asm volatile("s_waitcnt vmcnt(" #n ")" ::: "memory")
#define PG8_WAIT_L(n) asm volatile("s_waitcnt lgkmcnt(" #n ")" ::: "memory")
#define PG8_BAR __builtin_amdgcn_s_barrier()
#define PG8_SCHED __builtin_amdgcn_sched_barrier(0)
    Unit cur, nxt; int ui = 0;
    if (!S.next(0, cur)) return;
    unsigned vAc[2][2], vAn[2][2];
#define PG8_SETVA(v, U) do { _Pragma("unroll") for (int h_ = 0; h_ < 2; ++h_) _Pragma("unroll") for (int i_ = 0; i_ < 2; ++i_) { \
        if constexpr (INDEXED) { const int r_ = g.rowidx[(U).aux + h_ * HALF + Rs[i_]]; v[h_][i_] = (unsigned)r_ * g.lda + (unsigned)Cs[i_] * 2u; } \
        else v[h_][i_] = (unsigned)(h_ * HALF + Rs[i_]) * g.lda + (unsigned)Cs[i_] * 2u; } } while (0)
    PG8_SETVA(vAc, cur);
    f32x4 acc[2][2][4][2];
#pragma unroll
    for (int a = 0; a < 2; ++a)
#pragma unroll
        for (int b = 0; b < 2; ++b)
#pragma unroll
            for (int m = 0; m < 4; ++m)
#pragma unroll
                for (int n = 0; n < 2; ++n) acc[a][b][m][n] = (f32x4){0.f, 0.f, 0.f, 0.f};
    bf16x8 At[4][2], B0[2][2], B1[2][2];
    const char* cA = cur.A; const char* cB = cur.B;
    PG8_STAGEB(PG8_SB(0, 0), cB); PG8_STAGEB(PG8_SB(0, 1), cB + hstepB); PG8_STAGE2(PG8_SA(0, 0), cA, vAc[0][0], vAc[0][1]); PG8_STAGE2(PG8_SA(0, 1), cA, vAc[1][0], vAc[1][1]);
    if (wr == 1) PG8_BAR;
    PG8_WAIT_V(2); PG8_BAR;
    PG8_STAGEB(PG8_SB(1, 0), cB + kstepB); PG8_STAGE2(PG8_SA(1, 0), cA + kstepA, vAc[0][0], vAc[0][1]); PG8_STAGEB(PG8_SB(1, 1), cB + hstepB + kstepB);
    PG8_WAIT_V(6); PG8_BAR;
    for (;;) {
        const bool has_next = S.next(ui + 1, nxt);
        const char* nA = has_next ? nxt.A : cA; const char* nB = has_next ? nxt.B : cB;
        if (has_next) { PG8_SETVA(vAn, nxt); } else {
#pragma unroll
            for (int h_ = 0; h_ < 2; ++h_)
#pragma unroll
                for (int i_ = 0; i_ < 2; ++i_) vAn[h_][i_] = vAc[h_][i_]; }
        for (int t = 0; t < nt; t += 2) {
            const bool last = (t == nt - 2);
            const char* a1 = cA + (size_t)(t + 1) * kstepA;
            const char* a2 = last ? nA : cA + (size_t)(t + 2) * kstepA; const char* b2 = last ? nB : cB + (size_t)(t + 2) * kstepB;
            const char* a3 = a2 + kstepA; const char* b3 = b2 + kstepB;
            const unsigned w00 = last ? vAn[0][0] : vAc[0][0], w01 = last ? vAn[0][1] : vAc[0][1], w10 = last ? vAn[1][0] : vAc[1][0], w11 = last ? vAn[1][1] : vAc[1][1];
            PG8_LDB(B0, 0, 0); PG8_LDB(B1, 0, 1); PG8_SCHED; PG8_LDA(At, 0, 0); PG8_STAGE2(PG8_SA(1, 1), a1, vAc[1][0], vAc[1][1]);
            PG8_WAIT_V(8); PG8_WAIT_L(0); PG8_BAR; PG8_MMA(0, 0, At, B0); PG8_MMA(0, 1, At, B1); PG8_BAR; PG8_SCHED;
            PG8_LDA(At, 0, 1); PG8_STAGEB(PG8_SB(0, 0), b2); PG8_STAGEB(PG8_SB(0, 1), b2 + hstepB); PG8_STAGE2(PG8_SA(0, 0), a2, w00, w01);
            PG8_WAIT_V(8); PG8_WAIT_L(0); PG8_BAR; PG8_MMA(1, 0, At, B0); PG8_MMA(1, 1, At, B1); PG8_BAR; PG8_SCHED;
            PG8_LDB(B0, 1, 0); PG8_LDB(B1, 1, 1); PG8_SCHED; PG8_LDA(At, 1, 0); PG8_STAGE2(PG8_SA(0, 1), a2, w10, w11);
            PG8_WAIT_V(8); PG8_WAIT_L(0); PG8_BAR; PG8_MMA(0, 0, At, B0); PG8_MMA(0, 1, At, B1); PG8_BAR; PG8_SCHED;
            PG8_LDA(At, 1, 1); PG8_STAGEB(PG8_SB(1, 0), b3); PG8_STAGEB(PG8_SB(1, 1), b3 + hstepB); PG8_STAGE2(PG8_SA(1, 0), a3, w00, w01);
            PG8_WAIT_V(8); PG8_WAIT_L(0); PG8_BAR; PG8_MMA(1, 0, At, B0); PG8_MMA(1, 1, At, B1); PG8_BAR; PG8_SCHED;
        }
        { int l2_; asm volatile("v_mbcnt_lo_u32_b32 %0, -1, 0\n\tv_mbcnt_hi_u32_b32 %0, -1, %0" : "=v"(l2_)); E(acc, cur, wr, wc, l2_ & 15, l2_ >> 4); }
        if (!has_next) break;
#pragma unroll
        for (int a = 0; a < 2; ++a)
#pragma unroll
            for (int b = 0; b < 2; ++b)
#pragma unroll
                for (int m = 0; m < 4; ++m)
#pragma unroll
                    for (int n = 0; n < 2; ++n) acc[a][b][m][n] = (f32x4){0.f, 0.f, 0.f, 0.f};
        cur = nxt; cA = nA; cB = nB; ++ui;
#pragma unroll
        for (int h_ = 0; h_ < 2; ++h_)
#pragma unroll
            for (int i_ = 0; i_ < 2; ++i_) vAc[h_][i_] = vAn[h_][i_];
    }
    PG8_WAIT_V(0);
    if (wr == 0) PG8_BAR;
    PG8_BAR;
#undef PG8_SA
#undef PG8_SB
#undef PG8_STAGE2
#undef PG8_STAGEB
#undef PG8_LDA
#undef PG8_LDB
#undef PG8_MMA
#undef PG8_WAIT_V
#undef PG8_WAIT_L
#undef PG8_BAR
#undef PG8_SCHED
#undef PG8_SETVA
}
}

constexpr int LDS_MISC = 131072;
constexpr int LDS_MOETAB = LDS_MISC + 64;
constexpr int LDS_INTAB = LDS_MISC + 512;
struct Ctx {
    float* out; unsigned char* ws; unsigned char* ws0;
    LAS unsigned char* lds;
    int tid, lane, wave, G, bid;
    __device__ __forceinline__ const void* inp(int i) const { const LAS unsigned* p = (const LAS unsigned*)(lds + LDS_INTAB) + 2 * i;
        const unsigned lo = (unsigned)__builtin_amdgcn_readfirstlane((int)p[0]), hi = (unsigned)__builtin_amdgcn_readfirstlane((int)p[1]); return (const void*)(const __attribute__((address_space(1))) char*)(((unsigned long long)hi << 32) | lo); }
    __device__ __forceinline__ const float* x() const { return (const float*)inp(0); }
    __device__ __forceinline__ const int* pos() const { return (const int*)inp(1); }
    __device__ __forceinline__ const float* rel_bias() const { return (const float*)inp(2); }
    __device__ __forceinline__ const float* norm_attn() const { return (const float*)inp(3); }
    __device__ __forceinline__ const float* w_in() const { return (const float*)inp(4); }
    __device__ __forceinline__ const float* b_merge() const { return (const float*)inp(5); }
    __device__ __forceinline__ const float* cmp_pe() const { return (const float*)inp(6); }
    __device__ __forceinline__ const float* cmp_k_w1() const { return (const float*)inp(7); }
    __device__ __forceinline__ const float* cmp_k_b1() const { return (const float*)inp(8); }
    __device__ __forceinline__ const float* cmp_k_w2() const { return (const float*)inp(9); }
    __device__ __forceinline__ const float* cmp_v_w1() const { return (const float*)inp(10); }
    __device__ __forceinline__ const float* cmp_v_b1() const { return (const float*)inp(11); }
    __device__ __forceinline__ const float* cmp_v_w2() const { return (const float*)inp(12); }
    __device__ __forceinline__ const float* mla_q_norm() const { return (const float*)inp(13); }
    __device__ __forceinline__ const float* mla_kv_norm() const { return (const float*)inp(14); }
    __device__ __forceinline__ const float* mla_w_uq() const { return (const float*)inp(15); }
    __device__ __forceinline__ const float* mla_w_uk() const { return (const float*)inp(16); }
    __device__ __forceinline__ const float* mla_w_uv() const { return (const float*)inp(17); }
    __device__ __forceinline__ const float* fox_b_f() const { return (const float*)inp(18); }
    __device__ __forceinline__ const float* w_o_nsa() const { return (const float*)inp(19); }
    __device__ __forceinline__ const float* w_o_mla() const { return (const float*)inp(20); }
    __device__ __forceinline__ const float* w_o_fox() const { return (const float*)inp(21); }
    __device__ __forceinline__ const float* w_out() const { return (const float*)inp(22); }
    __device__ __forceinline__ const float* norm_ffn() const { return (const float*)inp(23); }
    __device__ __forceinline__ const float* moe_w_grp() const { return (const float*)inp(24); }
    __device__ __forceinline__ const float* moe_b_grp() const { return (const float*)inp(25); }
    __device__ __forceinline__ const float* moe_w_router() const { return (const float*)inp(26); }
    __device__ __forceinline__ const float* moe_b_router() const { return (const float*)inp(27); }
    __device__ __forceinline__ const float* moe_w_gate() const { return (const float*)inp(28); }
    __device__ __forceinline__ const float* moe_w_up() const { return (const float*)inp(29); }
    __device__ __forceinline__ const float* moe_w_down() const { return (const float*)inp(30); }
    __device__ __forceinline__ const float* norm_final() const { return (const float*)inp(31); }
};
#define WSP(T_, off) ((T_*)(c.ws + (off)))
__device__ __forceinline__ int lane_id_volatile() { int ln; asm volatile("v_mbcnt_lo_u32_b32 %0, -1, 0\n\tv_mbcnt_hi_u32_b32 %0, -1, %0" : "=v"(ln)); return ln; }
__device__ __forceinline__ void relaunder(Ctx& c) { const int ln = lane_id_volatile(); c.lane = ln; c.tid = c.wave * 64 + ln;
    size_t z_ = 0; asm volatile("" : "+s"(z_)); c.ws = c.ws0 + z_; int g_ = c.G, b_ = c.bid, wv_ = c.wave; asm volatile("" : "+s"(g_), "+s"(b_), "+s"(wv_)); c.G = g_; c.bid = b_; c.wave = wv_; }

template <class Map>
__device__ __forceinline__ void transpose_item(const float* W, int ldw, int K, bf16_t* WT, const float* rowscale, Map srcmap, int nblk, LAS float* scr, int item, int lane, float colscale = 1.f) {
    const int kb = item / nblk, nb = item % nblk, k0 = 64 * kb, n0 = 32 * nb;
    const int sc = srcmap(n0 + (lane & 31));
    const int cc = lane & 7;
    float rsc[8];
#pragma unroll
    for (int i = 0; i < 8; ++i) rsc[i] = rowscale ? rowscale[k0 + 8 * cc + i] * colscale : colscale;
    float v[32];
    const float* wp = W + (size_t)(k0 + (lane >> 5)) * ldw + (sc >= 0 ? sc : 0);
#pragma unroll
    for (int i = 0; i < 32; ++i) v[i] = wp[(size_t)(2 * i) * ldw];
    __builtin_amdgcn_sched_barrier(0);
#pragma unroll
    for (int i = 0; i < 32; ++i) scr[(2 * i + (lane >> 5)) * 33 + (lane & 31)] = (sc >= 0) ? v[i] : 0.f;
    LDS_WAIT(); asm volatile("" ::: "memory");
#pragma unroll
    for (int j = 0; j < 4; ++j) { const int n = (lane >> 3) + 8 * j; const LAS float* s = scr + (8 * cc) * 33 + n;
        u32x4 o; o.x = cvtpk(s[0 * 33] * rsc[0], s[1 * 33] * rsc[1]); o.y = cvtpk(s[2 * 33] * rsc[2], s[3 * 33] * rsc[3]); o.z = cvtpk(s[4 * 33] * rsc[4], s[5 * 33] * rsc[5]); o.w = cvtpk(s[6 * 33] * rsc[6], s[7 * 33] * rsc[7]);
        *(u32x4*)(WT + (size_t)(n0 + n) * K + k0 + 8 * cc) = o; }
    LDS_WAIT(); asm volatile("" ::: "memory");
}
struct MapId { int off; __device__ int operator()(int n) const { return n + off; } };
struct MapInproj { __device__ int operator()(int n) const { if (n < 1280) return n; if (n < 1696) return n + 24; if (n < 1720) return n - 416; if (n < 1728) return n + 1536; if (n < 3264) return n - 8; return -1; } };
struct MapUq { __device__ int operator()(int n) const { if (n < 512) return (n >> 6) * 96 + (n & 63); const int r = n - 512; return (r >> 5) * 96 + 64 + (r & 31); } };
struct MapPad128 { __device__ int operator()(int n) const { return n < 128 ? n : -1; } };
struct MapGU { __device__ int operator()(int n) const { return (n >> 8) * 128 + (n & 127); } };

__device__ __forceinline__ int rel_bucket_dev(int n) {
    if (n < 16) return n;
    const float lr = __logf((float)n / 16.f) / 2.0794415416798357f;
    int large = 16 + (int)(lr * 16.f);
    return large < 31 ? large : 31;
}

__device__ __forceinline__ void phase_prologue(const Ctx& c) {
    LAS float* scr = (LAS float*)(c.lds + c.wave * 16384);
    const int gw = c.bid * NWAVES + c.wave, NGW = c.G * NWAVES;
    constexpr int I_WIN = 16 * (P1W / 32), I_WM = 16 * 96, I_UQ = 4 * 24, I_UK = 2 * 16, I_UV = 2 * 16, I_WO = 8 * 32, I_WOUT = 16 * 32, I_C1 = 32 * 8;
    constexpr int PER_L = I_WIN + I_WM + I_UQ + I_UK + I_UV + 3 * I_WO + I_WOUT + 2 * I_C1;
    for (int it = gw; it < NL * PER_L; it += NGW) {
        const int l = it / PER_L; int r = it % PER_L;
        if (r < I_WIN) { const int n0_ = 32 * (r % (P1W / 32)); const float cs_ = (n0_ < 512 || (n0_ >= C_FQKV && n0_ < C_FQKV + 512)) ? QSCALE64 : 1.f;
            transpose_item(c.w_in() + (size_t)l * D * DIN, DIN, D, WSP(bf16_t, WS_WINT) + (size_t)l * P1W * D, c.norm_attn() + l * D, MapInproj{}, P1W / 32, scr, r, c.lane, cs_); continue; } r -= I_WIN;
        if (r < I_WM) { transpose_item(c.w_in() + (size_t)l * D * DIN, DIN, D, WSP(bf16_t, WS_WMT) + (size_t)l * 3072 * D, c.norm_attn() + l * D, MapId{3264}, 96, scr, r, c.lane); continue; } r -= I_WM;
        if (r < I_UQ) { transpose_item(c.mla_w_uq() + (size_t)l * 256 * 768, 768, 256, WSP(bf16_t, WS_WUQT) + (size_t)l * 768 * 256, c.mla_q_norm() + l * 256, MapUq{}, 24, scr, r, c.lane, QSCALE96); continue; } r -= I_UQ;
        if (r < I_UK) { transpose_item(c.mla_w_uk() + (size_t)l * 128 * 512, 512, 128, WSP(bf16_t, WS_WUKVT) + (size_t)l * 1024 * 128, c.mla_kv_norm() + l * 128, MapId{0}, 16, scr, r, c.lane); continue; } r -= I_UK;
        if (r < I_UV) { transpose_item(c.mla_w_uv() + (size_t)l * 128 * 512, 512, 128, WSP(bf16_t, WS_WUKVT) + (size_t)l * 1024 * 128 + 512 * 128, c.mla_kv_norm() + l * 128, MapId{0}, 16, scr, r, c.lane); continue; } r -= I_UV;
        if (r < I_WO) { transpose_item(c.w_o_nsa() + (size_t)l * 512 * 1024, 1024, 512, WSP(bf16_t, WS_WOT) + ((size_t)l * 3 + 0) * 1024 * 512, nullptr, MapId{0}, 32, scr, r, c.lane); continue; } r -= I_WO;
        if (r < I_WO) { transpose_item(c.w_o_mla() + (size_t)l * 512 * 1024, 1024, 512, WSP(bf16_t, WS_WOT) + ((size_t)l * 3 + 1) * 1024 * 512, nullptr, MapId{0}, 32, scr, r, c.lane); continue; } r -= I_WO;
        if (r < I_WO) { transpose_item(c.w_o_fox() + (size_t)l * 512 * 1024, 1024, 512, WSP(bf16_t, WS_WOT) + ((size_t)l * 3 + 2) * 1024 * 512, nullptr, MapId{0}, 32, scr, r, c.lane); continue; } r -= I_WO;
        if (r < I_WOUT) { transpose_item(c.w_out() + (size_t)l * D * D, D, D, WSP(bf16_t, WS_WOUTT) + (size_t)l * D * D, nullptr, MapId{0}, 32, scr, r, c.lane); continue; } r -= I_WOUT;
        { const int kv = r / I_C1; const float* w = (kv == 0 ? c.cmp_k_w1() : c.cmp_v_w1()) + (size_t)l * 2048 * 128;
          transpose_item(w, 128, 2048, WSP(bf16_t, WS_WC1T) + ((size_t)l * 2 + kv) * 256 * 2048, nullptr, MapPad128{}, 8, scr, r % I_C1, c.lane); }
    }
    { float* rc = WSP(float, WS_ROPE); float* rs = rc + (size_t)M * 16;
      for (int i = c.bid * NTHREADS + c.tid; i < M * 16; i += c.G * NTHREADS) { const int m = i >> 4, j = i & 15;
          const float inv = exp2f(-(float)j * 0.8304820237218407f);   const float ang = (float)c.pos()[m] * inv; double rev = (double)ang * 0.15915494309189535; rev -= floor(rev); const float fr_ = (float)rev; rc[i] = __builtin_amdgcn_cosf(fr_); rs[i] = __builtin_amdgcn_sinf(fr_); } }
    float* tab = WSP(float, WS_TAB);
    if (c.bid == 0) {
        const int l = c.tid >> 8, kv = (c.tid >> 7) & 1, j = c.tid & 127;
        const float* w1 = (kv == 0 ? c.cmp_k_w1() : c.cmp_v_w1()) + (size_t)l * 2048 * 128; const float* b1 = (kv == 0 ? c.cmp_k_b1() : c.cmp_v_b1()) + l * 128; const float* pe = c.cmp_pe() + l * 2048;
        float s = b1[j]; for (int k = 0; k < 2048; ++k) s += pe[k] * w1[(size_t)k * 128 + j];
        tab[c.tid] = s;
    }
    if (c.bid == 1 % c.G) {
        for (int i = c.tid; i < 8 * 129; i += NTHREADS) { const int h = i / 129, d = i % 129; tab[512 + h * 132 + d] = c.rel_bias()[rel_bucket_dev(d) * 8 + h] * LOG2E; }
    }
}

__device__ __forceinline__ void phase_norm(const Ctx& c, const float* src, const bf16_t* y0, const bf16_t* y1, float* rout, bf16_t* hout) {
    const int gw = c.bid * NWAVES + c.wave, NGW = c.G * NWAVES;
    for (int m = gw; m < M; m += NGW) {
        const f32x4* xr = (const f32x4*)(src + (size_t)m * D) + c.lane;
        f32x4 v[4]; float s = 0.f;
#pragma unroll
        for (int j = 0; j < 4; ++j) { v[j] = xr[64 * j];
            if (y0) { const u32x2 a = *((const u32x2*)(y0 + (size_t)m * D) + c.lane + 64 * j); const u32x2 b = *((const u32x2*)(y1 + (size_t)m * D) + c.lane + 64 * j);
                v[j].x += __uint_as_float(a.x << 16) + __uint_as_float(b.x << 16); v[j].y += __uint_as_float(a.x & 0xffff0000u) + __uint_as_float(b.x & 0xffff0000u);
                v[j].z += __uint_as_float(a.y << 16) + __uint_as_float(b.y << 16); v[j].w += __uint_as_float(a.y & 0xffff0000u) + __uint_as_float(b.y & 0xffff0000u); }
            s += (v[j].x * v[j].x + v[j].y * v[j].y) + (v[j].z * v[j].z + v[j].w * v[j].w); }
        const float rstd = rsqrtf(wave_sum(s) * (1.f / D) + EPS);
        if (rout) { f32x4* ro = (f32x4*)(rout + (size_t)m * D) + c.lane;
#pragma unroll
            for (int j = 0; j < 4; ++j) ro[64 * j] = v[j]; }
        u32x2* o8 = (u32x2*)(hout + (size_t)m * D) + c.lane;
#pragma unroll
        for (int j = 0; j < 4; ++j) { u32x2 w; w.x = pk2(v[j].x * rstd, v[j].y * rstd); w.y = pk2(v[j].z * rstd, v[j].w * rstd); o8[64 * j] = w; }
    }
}
__device__ __forceinline__ void phase_final(const Ctx& c) {
    const int gw = c.bid * NWAVES + c.wave, NGW = c.G * NWAVES;
    const float* src = WSP(float, WS_XA); const bf16_t* y0 = WSP(bf16_t, WS_Y); const bf16_t* y1 = y0 + (size_t)M * D;
    for (int m = gw; m < M; m += NGW) {
        const f32x4* xr = (const f32x4*)(src + (size_t)m * D) + c.lane;
        f32x4 v[4]; float s = 0.f;
#pragma unroll
        for (int j = 0; j < 4; ++j) { v[j] = xr[64 * j];
            const u32x2 a = *((const u32x2*)(y0 + (size_t)m * D) + c.lane + 64 * j); const u32x2 b = *((const u32x2*)(y1 + (size_t)m * D) + c.lane + 64 * j);
            v[j].x += __uint_as_float(a.x << 16) + __uint_as_float(b.x << 16); v[j].y += __uint_as_float(a.x & 0xffff0000u) + __uint_as_float(b.x & 0xffff0000u);
            v[j].z += __uint_as_float(a.y << 16) + __uint_as_float(b.y << 16); v[j].w += __uint_as_float(a.y & 0xffff0000u) + __uint_as_float(b.y & 0xffff0000u);
            s += (v[j].x * v[j].x + v[j].y * v[j].y) + (v[j].z * v[j].z + v[j].w * v[j].w); }
        const float rstd = rsqrtf(wave_sum(s) * (1.f / D) + EPS);
        f32x4* ro = (f32x4*)(c.out + (size_t)m * D) + c.lane;
#pragma unroll
        for (int j = 0; j < 4; ++j) { const f32x4 g = *((const f32x4*)c.norm_final() + c.lane + 64 * j); ro[64 * j] = v[j] * rstd * g; }
    }
}

__device__ __forceinline__ void phase_prep(const Ctx& c, int l) {
    const int gw = c.bid * NWAVES + c.wave, NGW = c.G * NWAVES;
    const bf16_t* P1 = WSP(bf16_t, WS_P1); float* rstd = WSP(float, WS_RSTD); bf16_t* KR = WSP(bf16_t, WS_KR); float* LF = WSP(float, WS_LF);
    const float* rc = WSP(float, WS_ROPE); const float* rs = rc + (size_t)M * 16;
    float kmx0 = 0.f, kmx1 = 0.f;
    LAS unsigned* kml = (LAS unsigned*)(c.lds + 4096);
    if (c.tid < 16) kml[c.tid] = 0u;
    __syncthreads();
    for (int m = gw; m < M; m += NGW) {
        const bf16_t* row = P1 + (size_t)m * P1W;
        const u32x2 a = *((const u32x2*)(row + C_CQ) + c.lane);
        float q0 = __uint_as_float(a.x << 16), q1 = __uint_as_float(a.x & 0xffff0000u), q2 = __uint_as_float(a.y << 16), q3 = __uint_as_float(a.y & 0xffff0000u);
        const float sq = wave_sum(q0 * q0 + q1 * q1 + q2 * q2 + q3 * q3);
        const unsigned b = *((const unsigned*)(row + C_CKV) + c.lane);
        float k0 = __uint_as_float(b << 16), k1 = __uint_as_float(b & 0xffff0000u);
        const float sk = wave_sum(k0 * k0 + k1 * k1);
        if (c.lane == 0) { rstd[2 * m] = rsqrtf(sq * (1.f / 256.f) + EPS); rstd[2 * m + 1] = rsqrtf(sk * (1.f / 128.f) + EPS); }
        if (c.lane < 16) { const float x1 = bf2f(row[C_KR + c.lane]), x2 = bf2f(row[C_KR + 16 + c.lane]); const float cs = rc[m * 16 + c.lane], sn = rs[m * 16 + c.lane];
            KR[m * 32 + c.lane] = (bf16_t)f2bf(x1 * cs - x2 * sn); KR[m * 32 + 16 + c.lane] = (bf16_t)f2bf(x1 * sn + x2 * cs); }
        { const u32x4 kq = *((const u32x4*)(row + C_FQKV + 512) + c.lane); const f32x4 a0 = unpk4((u32x2){kq.x, kq.y}), a1 = unpk4((u32x2){kq.z, kq.w});
          float ss = (a0.x * a0.x + a0.y * a0.y) + (a0.z * a0.z + a0.w * a0.w) + (a1.x * a1.x + a1.y * a1.y) + (a1.z * a1.z + a1.w * a1.w);
          ss += dpp_f<0xB1>(ss); ss += dpp_f<0x4E>(ss); ss += dpp_f<0x141>(ss);
          const int bb_ = m / T; if (bb_ == 0) kmx0 = fmaxf(kmx0, ss); else kmx1 = fmaxf(kmx1, ss); }
        if (c.lane < 8) { const float f = bf2f(row[C_FF + c.lane]) + c.fox_b_f()[l * 8 + c.lane];
            const float ls = fminf(f, 0.f) - __logf(1.f + __expf(-fabsf(f)));
            const int bb = m / T, t = m % T; LF[((size_t)bb * 8 + c.lane) * T + t] = ls; }
    }
    if ((c.lane & 7) == 0) { atomicMax((unsigned*)(kml + (c.lane >> 3)), __float_as_uint(kmx0)); atomicMax((unsigned*)(kml + 8 + (c.lane >> 3)), __float_as_uint(kmx1)); }
    __syncthreads();
    if (c.tid < 16) atomicMax(WSP(unsigned, WS_CTL) + CW_KMAX + l * 16 + c.tid, kml[c.tid]);
}
__device__ __forceinline__ void phase_cum(const Ctx& c) {
    LAS float* sh = (LAS float*)c.lds;
    for (int s = c.bid; s < NB * 8; s += c.G) {
        const float* lf = WSP(float, WS_LF) + (size_t)s * T; float* cum = WSP(float, WS_CUM) + (size_t)s * T;
        float v[16]; float tot = 0.f;
#pragma unroll
        for (int j = 0; j < 16; ++j) { v[j] = lf[c.tid * 16 + j]; tot += v[j]; }
        sh[c.tid] = tot; __syncthreads();
        if (c.tid < 8) { float run = 0.f; for (int i = 0; i < 64; ++i) { const float t_ = sh[c.tid * 64 + i]; sh[c.tid * 64 + i] = run; run += t_; } sh[NTHREADS + c.tid] = run; }
        __syncthreads();
        float run = sh[c.tid]; for (int w_ = 0; w_ < (c.tid >> 6); ++w_) run += sh[NTHREADS + w_];
#pragma unroll
        for (int j = 0; j < 16; ++j) { run += v[j]; cum[c.tid * 16 + j] = run * LOG2E; }
        __syncthreads();
    }
}
__device__ __forceinline__ void phase_cmp2_ropeq(const Ctx& c, int l) {
    const bf16_t* HC = WSP(bf16_t, WS_HC);
    for (int pr = c.bid * NWAVES + c.wave; pr < 2 * 2048; pr += c.G * NWAVES) {
        const int kv = pr >> 11, row = pr & 2047, d = c.lane;
        const float* w2 = (kv == 0 ? c.cmp_k_w2() : c.cmp_v_w2()) + (size_t)l * 128 * 64 + d;
        const bf16_t* h = HC + ((size_t)kv * 2048 + row) * 128; float s = 0.f;
        u32x4 hv[16];
#pragma unroll
        for (int q = 0; q < 16; ++q) hv[q] = *(const u32x4*)(h + 8 * q);
#pragma unroll
        for (int jb = 0; jb < 4; ++jb) { float wv[32];
#pragma unroll
            for (int i = 0; i < 32; ++i) wv[i] = w2[(size_t)(32 * jb + i) * 64];
            __builtin_amdgcn_sched_barrier(0);
#pragma unroll
            for (int q = 0; q < 4; ++q) { const u32x4 hw = hv[4 * jb + q];
                s += __uint_as_float(hw.x << 16) * wv[8 * q + 0] + __uint_as_float(hw.x & 0xffff0000u) * wv[8 * q + 1] + __uint_as_float(hw.y << 16) * wv[8 * q + 2] + __uint_as_float(hw.y & 0xffff0000u) * wv[8 * q + 3]
                   + __uint_as_float(hw.z << 16) * wv[8 * q + 4] + __uint_as_float(hw.z & 0xffff0000u) * wv[8 * q + 5] + __uint_as_float(hw.w << 16) * wv[8 * q + 6] + __uint_as_float(hw.w & 0xffff0000u) * wv[8 * q + 7]; } }
        if ((row & 511) == 511) s = 0.f;
        (kv == 0 ? WSP(bf16_t, WS_KC) : WSP(bf16_t, WS_VC))[(size_t)row * 64 + d] = (bf16_t)f2bf(s);
    }
    bf16_t* QB = WSP(bf16_t, WS_QB); const float* rc = WSP(float, WS_ROPE); const float* rs = rc + (size_t)M * 16;
    for (int i = c.bid * NTHREADS + c.tid; i < M * 128; i += c.G * NTHREADS) {
        const int m = i >> 7, h = (i >> 4) & 7, j = i & 15;
        bf16_t* p = QB + (size_t)m * 768 + 512 + h * 32; const float x1 = bf2f(p[j]), x2 = bf2f(p[16 + j]); const float cs = rc[m * 16 + j], sn = rs[m * 16 + j];
        p[j] = (bf16_t)f2bf(x1 * cs - x2 * sn); p[16 + j] = (bf16_t)f2bf(x1 * sn + x2 * cs);
    }
}

__device__ __forceinline__ u32x2 pk4(f32x4 v) { u32x2 w; w.x = cvtpk(v.x, v.y); w.y = cvtpk(v.z, v.w); return w; }
#define EPI_ARGS const f32x4 (&acc)[2][2][4][2], const pg8::Unit& u, int wr, int wc, int fr, int fq
#define EPI_LOOP _Pragma("unroll") for (int ai = 0; ai < 2; ++ai) _Pragma("unroll") for (int m = 0; m < 4; ++m) _Pragma("unroll") for (int bj = 0; bj < 2; ++bj) _Pragma("unroll") for (int n = 0; n < 2; ++n)

#define EPI_ROW(ai, m) (u.pm * 256 + (ai) * 128 + wr * 64 + (m) * 16 + fr)
#define EPI_COL(bj, n) (u.pn * 256 + (bj) * 128 + wc * 32 + (n) * 16 + fq * 4)
struct EpiStoreBf16 { bf16_t* O; int ldc; const float* rowscale; int rs_stride;
    __device__ __forceinline__ void operator()(EPI_ARGS) const {
        float rs[2][4];
#pragma unroll
        for (int ai = 0; ai < 2; ++ai)
#pragma unroll
            for (int m = 0; m < 4; ++m) rs[ai][m] = rowscale ? rowscale[(size_t)EPI_ROW(ai, m) * rs_stride] : 1.f;
        __builtin_amdgcn_sched_barrier(0);
        EPI_LOOP { const unsigned off = (unsigned)EPI_ROW(ai, m) * (unsigned)ldc + (unsigned)EPI_COL(bj, n); *(u32x2*)(O + off) = pk4(acc[ai][bj][m][n] * rs[ai][m]); } } };
struct EpiGates { bf16_t* O; const float* bias;
    __device__ __forceinline__ void operator()(EPI_ARGS) const {
        f32x4 bv[2][2];
#pragma unroll
        for (int bj = 0; bj < 2; ++bj)
#pragma unroll
            for (int n = 0; n < 2; ++n) bv[bj][n] = *(const f32x4*)(bias + EPI_COL(bj, n));
        __builtin_amdgcn_sched_barrier(0);
        EPI_LOOP { f32x4 v = acc[ai][bj][m][n] + bv[bj][n];
            v.x = sigmoidf_(v.x); v.y = sigmoidf_(v.y); v.z = sigmoidf_(v.z); v.w = sigmoidf_(v.w); *(u32x2*)(O + (unsigned)EPI_ROW(ai, m) * 3072u + (unsigned)EPI_COL(bj, n)) = pk4(v); } } };
struct EpiCmp1 { bf16_t* HC; const float* bc1;
    __device__ __forceinline__ void operator()(EPI_ARGS) const {
        const int kv = u.pm >> 3, bg = (u.pm >> 1) & 3, half = u.pm & 1;
        f32x4 bv[2];
#pragma unroll
        for (int n = 0; n < 2; ++n) bv[n] = *(const f32x4*)(bc1 + kv * 128 + wc * 32 + n * 16 + fq * 4);
        __builtin_amdgcn_sched_barrier(0);
#pragma unroll
        for (int ai = 0; ai < 2; ++ai)
#pragma unroll
            for (int m = 0; m < 4; ++m)
#pragma unroll
                for (int n = 0; n < 2; ++n) { const int i = half * 256 + ai * 128 + wr * 64 + m * 16 + fr, cc = wc * 32 + n * 16 + fq * 4;
                    f32x4 v = acc[ai][0][m][n] + bv[n];
                    v.x = gelu_tanh(v.x); v.y = gelu_tanh(v.y); v.z = gelu_tanh(v.z); v.w = gelu_tanh(v.w);
                    *(u32x2*)(HC + ((size_t)kv * 2048 + bg * 512 + i) * 128 + cc) = pk4(v); } } };
struct EpiOutproj { bf16_t* MIX; const bf16_t* GATES; int br;
    __device__ __forceinline__ void operator()(EPI_ARGS) const {
#pragma unroll
        for (int ai = 0; ai < 2; ++ai)
#pragma unroll
          for (int mh = 0; mh < 2; ++mh) { u32x2 gw[2][2][2], mw[2][2][2];
#pragma unroll
            for (int m2 = 0; m2 < 2; ++m2)
#pragma unroll
                for (int bj = 0; bj < 2; ++bj)
#pragma unroll
                    for (int n = 0; n < 2; ++n) { const unsigned row = (unsigned)EPI_ROW(ai, 2 * mh + m2), col = (unsigned)EPI_COL(bj, n);
                        gw[m2][bj][n] = *(const u32x2*)(GATES + row * 3072u + (unsigned)br * 1024u + col); if (br > 0) mw[m2][bj][n] = *(const u32x2*)(MIX + row * 1024u + col); }
            __builtin_amdgcn_sched_barrier(0);
#pragma unroll
            for (int m2 = 0; m2 < 2; ++m2)
#pragma unroll
                for (int bj = 0; bj < 2; ++bj)
#pragma unroll
                    for (int n = 0; n < 2; ++n) { f32x4 v = acc[ai][bj][2 * mh + m2][n] * unpk4(gw[m2][bj][n]); if (br > 0) v = v + unpk4(mw[m2][bj][n]);
                        *(u32x2*)(MIX + (unsigned)EPI_ROW(ai, 2 * mh + m2) * 1024u + (unsigned)EPI_COL(bj, n)) = pk4(v); }
            __builtin_amdgcn_sched_barrier(0); } } };
struct EpiWout { const float* R; float* XA;
    __device__ __forceinline__ void operator()(EPI_ARGS) const {
#pragma unroll
        for (int ai = 0; ai < 2; ++ai)
#pragma unroll
          for (int mh = 0; mh < 2; ++mh) { f32x4 rv[2][2][2];
#pragma unroll
            for (int m2 = 0; m2 < 2; ++m2)
#pragma unroll
                for (int bj = 0; bj < 2; ++bj)
#pragma unroll
                    for (int n = 0; n < 2; ++n) rv[m2][bj][n] = *(const f32x4*)(R + (unsigned)EPI_ROW(ai, 2 * mh + m2) * 1024u + (unsigned)EPI_COL(bj, n));
            __builtin_amdgcn_sched_barrier(0);
#pragma unroll
            for (int m2 = 0; m2 < 2; ++m2)
#pragma unroll
                for (int bj = 0; bj < 2; ++bj)
#pragma unroll
                    for (int n = 0; n < 2; ++n) *(f32x4*)(XA + (unsigned)EPI_ROW(ai, 2 * mh + m2) * 1024u + (unsigned)EPI_COL(bj, n)) = rv[m2][bj][n] + acc[ai][bj][2 * mh + m2][n];
            __builtin_amdgcn_sched_barrier(0); } } };
struct EpiMoe1 { bf16_t* HID; const float* LW;
    __device__ __forceinline__ void operator()(EPI_ARGS) const {
        int aux_ = u.aux; asm volatile("" : "+s"(aux_));
        float w8[2][4];
#pragma unroll
        for (int ai = 0; ai < 2; ++ai)
#pragma unroll
            for (int m = 0; m < 4; ++m) w8[ai][m] = LW[(unsigned)(aux_ + ai * 128 + wr * 64 + m * 16 + fr)];
        __builtin_amdgcn_sched_barrier(0);
#pragma unroll
        for (int ai = 0; ai < 2; ++ai)
#pragma unroll
            for (int m = 0; m < 4; ++m) { const unsigned pos = (unsigned)(aux_ + ai * 128 + wr * 64 + m * 16 + fr); const float w = w8[ai][m];
#pragma unroll
                for (int n = 0; n < 2; ++n) { const f32x4 g = acc[ai][0][m][n], up = acc[ai][1][m][n]; f32x4 h;
                    h.x = g.x * sigmoidf_(g.x) * up.x * w; h.y = g.y * sigmoidf_(g.y) * up.y * w; h.z = g.z * sigmoidf_(g.z) * up.z * w; h.w = g.w * sigmoidf_(g.w) * up.w * w;
                    *(u32x2*)(HID + pos * 256u + (unsigned)(u.pn * 128 + wc * 32 + n * 16 + fq * 4)) = pk4(h); } } } };
struct EpiMoe2 { bf16_t* Y; const unsigned* LDST;
    __device__ __forceinline__ void operator()(EPI_ARGS) const {
        int aux_ = u.aux; asm volatile("" : "+s"(aux_));
        unsigned d8[2][4];
#pragma unroll
        for (int ai = 0; ai < 2; ++ai)
#pragma unroll
            for (int m = 0; m < 4; ++m) d8[ai][m] = LDST[(unsigned)(aux_ + ai * 128 + wr * 64 + m * 16 + fr)];
        __builtin_amdgcn_sched_barrier(0);
#pragma unroll
        for (int ai = 0; ai < 2; ++ai)
#pragma unroll
            for (int m = 0; m < 4; ++m) { const unsigned d0 = d8[ai][m];
                if (d0 != 0xFFFFFFFFu) { const unsigned off = d0 + (unsigned)(u.pn * 256 + wc * 32 + fq * 4);
#pragma unroll
                    for (int bj = 0; bj < 2; ++bj)
#pragma unroll
                        for (int n = 0; n < 2; ++n) *(u32x2*)(Y + off + bj * 128 + n * 16) = pk4(acc[ai][bj][m][n]); } } } };

struct CmpOrder { int G, c; const char* P1; const char* W;
    __device__ bool next(int i, pg8::Unit& u) const { const int L_ = i * G + c; if (L_ >= 16) return false; const int kv = L_ >> 3, b = (L_ >> 2) & 1, g = (L_ >> 1) & 1, half = L_ & 1;
        u.pm = L_; u.pn = 0; u.aux = 0; u.A = P1 + ((size_t)(b * T + 16 * 256 * half) * P1W + C_NKV + (kv * 2 + g) * 64) * 2; u.B = W + (size_t)kv * 256 * 2048 * 2; return true; } };
struct MoeOrder { int G, c, nN; const LAS int* tab; const char* A; size_t a_rowbytes; const char* W; size_t w_expert, w_tile;
    __device__ bool next(int i, pg8::Unit& u) const { const int L_ = i * G + c; const int NT = __builtin_amdgcn_readfirstlane(tab[32]); if (L_ >= NT * nN) return false; const int rt = L_ / nN, pn = L_ % nN;
        int e = 0; while (__builtin_amdgcn_readfirstlane(tab[e + 1]) <= rt) ++e;
        const int off_e = __builtin_amdgcn_readfirstlane(tab[33 + e]), ts_e = __builtin_amdgcn_readfirstlane(tab[e]), cnt_e = __builtin_amdgcn_readfirstlane(tab[66 + e]);
        const int pos0 = off_e + 256 * (rt - ts_e); u.pn = pn; u.aux = pos0; u.pm = off_e + cnt_e;
        u.A = A + (size_t)pos0 * a_rowbytes; u.B = W + (size_t)e * w_expert + (size_t)pn * w_tile; return true; } };
__device__ __forceinline__ void moe_tables(const Ctx& c, int l, LAS int* tab) {
    if (c.tid == 0) { const unsigned* cnt = WSP(unsigned, WS_CTL) + CW_MOECNT + l * 64; int ts = 0, off = 0;
        for (int e = 0; e < 32; ++e) { const int n = (int)cnt[e]; tab[e] = ts; tab[33 + e] = off; tab[66 + e] = n; const int nt_ = (n + 255) >> 8; ts += nt_; off += nt_ * 256; }
        tab[32] = ts; tab[65] = off; }
    __syncthreads();
}

constexpr int LDS_RSM = LDS_MISC + 1024;
__device__ __forceinline__ void phase_router(const Ctx& c, int l, int dummy = 0) {
    const int gw = c.bid * NWAVES + c.wave, NGW = c.G * NWAVES, lane = c.lane;
    const float* XA = WSP(float, WS_XA); bf16_t* H2 = WSP(bf16_t, WS_H2); int* REC = WSP(int, dummy ? WS_HID : WS_REC); unsigned* cnt = WSP(unsigned, WS_CTL) + CW_MOECNT + (l + 2 * dummy) * 64;
    const float* g2 = c.norm_ffn() + l * D; const float* wg = c.moe_w_grp() + (size_t)l * D * 4; const float* wr_ = c.moe_w_router() + (size_t)l * D * 32;
    const float* bgp = c.moe_b_grp() + l * 4; const float* brp = c.moe_b_router() + l * 32;
    LAS f32x4* Tk = (LAS f32x4*)(c.lds + c.wave * 16384);
    LAS float* PG = (LAS float*)(c.lds + LDS_RSM + c.wave * 1792); LAS float* EL = PG + 256; LAS float* GL = EL + 128;
    LAS unsigned* cntL = (LAS unsigned*)(c.lds + LDS_MOETAB);
    if (c.tid < 32) cntL[c.tid] = 0u;
    __syncthreads();
    for (int task = gw; task < M / 4; task += NGW) {
        const int m0 = task * 4;
        f32x4 v[4][4]; float rs[4];
#pragma unroll
        for (int r = 0; r < 4; ++r) { const f32x4* xr = (const f32x4*)(XA + (size_t)(m0 + r) * D) + lane; float s = 0.f;
#pragma unroll
            for (int j = 0; j < 4; ++j) { v[r][j] = xr[64 * j]; s += (v[r][j].x * v[r][j].x + v[r][j].y * v[r][j].y) + (v[r][j].z * v[r][j].z + v[r][j].w * v[r][j].w); }
            rs[r] = rsqrtf(wave_sum(s) * (1.f / D) + EPS); }
#pragma unroll
        for (int j = 0; j < 4; ++j) { const f32x4 gg = *((const f32x4*)g2 + lane + 64 * j);
#pragma unroll
            for (int r = 0; r < 4; ++r) { v[r][j] = v[r][j] * rs[r]; *((u32x2*)(H2 + (size_t)(m0 + r) * D) + lane + 64 * j) = pk4(v[r][j]); v[r][j] = v[r][j] * gg; }
#pragma unroll
            for (int e = 0; e < 4; ++e) { f32x4 t4; t4.x = v[0][j][e]; t4.y = v[1][j][e]; t4.z = v[2][j][e]; t4.w = v[3][j][e]; Tk[4 * lane + 256 * j + e] = t4; } }
        LDS_WAIT(); asm volatile("" ::: "memory");
        { const int o = lane & 31, sh = lane >> 5; f32x4 acc = {0.f, 0.f, 0.f, 0.f}; const float* wp = wr_ + (size_t)(512 * sh) * 32 + o; const LAS f32x4* tp = Tk + 512 * sh;
#pragma unroll 1
          for (int kb = 0; kb < 512; kb += 32) { float w[32];
#pragma unroll
              for (int i = 0; i < 32; ++i) w[i] = wp[(size_t)(kb + i) * 32];
              __builtin_amdgcn_sched_barrier(0);
#pragma unroll
              for (int i = 0; i < 32; ++i) acc += tp[kb + i] * w[i]; }
          acc.x = half_sum(acc.x); acc.y = half_sum(acc.y); acc.z = half_sum(acc.z); acc.w = half_sum(acc.w);
          if (lane < 32) { const float bb = brp[o]; EL[0 * 32 + o] = acc.x + bb; EL[1 * 32 + o] = acc.y + bb; EL[2 * 32 + o] = acc.z + bb; EL[3 * 32 + o] = acc.w + bb; } }
        { const int og = lane & 3, s16 = lane >> 2; f32x4 acc = {0.f, 0.f, 0.f, 0.f}; const float* wp = wg + (size_t)(64 * s16) * 4 + og; const LAS f32x4* tp = Tk + 64 * s16;
#pragma unroll 1
          for (int kb = 0; kb < 64; kb += 32) { float w[32];
#pragma unroll
              for (int i = 0; i < 32; ++i) w[i] = wp[(size_t)(kb + i) * 4];
              __builtin_amdgcn_sched_barrier(0);
#pragma unroll
              for (int i = 0; i < 32; ++i) acc += tp[kb + i] * w[i]; }
          PG[(0 * 4 + og) * 16 + s16] = acc.x; PG[(1 * 4 + og) * 16 + s16] = acc.y; PG[(2 * 4 + og) * 16 + s16] = acc.z; PG[(3 * 4 + og) * 16 + s16] = acc.w; }
        LDS_WAIT(); asm volatile("" ::: "memory");
        if (lane < 16) { float s = 0.f;
#pragma unroll
            for (int q = 0; q < 16; ++q) s += PG[lane * 16 + q];
            GL[lane] = s + bgp[lane & 3]; }
        LDS_WAIT(); asm volatile("" ::: "memory");
        if (lane < 4) { const int r = lane;
            int gi = 0; float gm = GL[r * 4];
            for (int o = 1; o < 4; ++o) { const float x_ = GL[r * 4 + o]; if (x_ > gm) { gm = x_; gi = o; } }
            float gs = 0.f; for (int o = 0; o < 4; ++o) gs += __expf(GL[r * 4 + o] - gm);
            const float grp_top = 1.f / gs;
            int i1 = 0; float m1 = EL[r * 32 + gi * 8];
            for (int q = 1; q < 8; ++q) { const float x_ = EL[r * 32 + gi * 8 + q]; if (x_ > m1) { m1 = x_; i1 = q; } }
            int i2 = -1; float m2 = -3.0e38f;
            for (int q = 0; q < 8; ++q) { const float x_ = EL[r * 32 + gi * 8 + q]; if (q != i1 && x_ > m2) { m2 = x_; i2 = q; } }
            const float e2 = __expf(m2 - m1); const float w1 = grp_top / (1.f + e2), w2 = grp_top * e2 / (1.f + e2);
            const int ea = gi * 8 + i1, eb = gi * 8 + i2; const int ra = (int)atomicAdd((unsigned*)(cntL + ea), 1u), rb = (int)atomicAdd((unsigned*)(cntL + eb), 1u);
            int* rr = REC + (size_t)(m0 + r) * 8; rr[0] = ea; rr[1] = eb; rr[2] = ra; rr[3] = rb; rr[4] = __float_as_int(w1); rr[5] = __float_as_int(w2); rr[6] = c.bid; }
        LDS_WAIT(); asm volatile("" ::: "memory");
    }
    __syncthreads();
    if (c.tid < 32) { const unsigned n = cntL[c.tid]; (WSP(unsigned, WS_CTL) + CW_CNTB)[(dummy ? 8192 : 0) + c.bid * 32 + c.tid] = n; if (n) atomicAdd(cnt + c.tid, n); }
}
__device__ __forceinline__ void phase_place(const Ctx& c, int l) {
    LAS int* tab = (LAS int*)(c.lds + LDS_MOETAB);
    moe_tables(c, l, tab);
    int* LTOK = WSP(int, WS_LTOK); float* LW = WSP(float, WS_LW); unsigned* LDST = WSP(unsigned, WS_LSLOT); const int* REC = WSP(int, WS_REC);
    LAS int* BASE = (LAS int*)c.lds;
    if (c.tid < 32) { const unsigned* cb = WSP(unsigned, WS_CTL) + CW_CNTB + c.tid; int run = 0; for (int b_ = 0; b_ < c.G; ++b_) { BASE[b_ * 32 + c.tid] = run; run += (int)cb[b_ * 32]; } }
    __syncthreads();
    for (int m = c.bid * NTHREADS + c.tid; m < M; m += c.G * NTHREADS) { const int* r = REC + (size_t)m * 8;
        const int pa = tab[33 + r[0]] + BASE[r[6] * 32 + r[0]] + r[2], pb = tab[33 + r[1]] + BASE[r[6] * 32 + r[1]] + r[3];
        LTOK[pa] = m; LDST[pa] = (unsigned)m * 1024u; LW[pa] = __int_as_float(r[4]); LTOK[pb] = m; LDST[pb] = ((unsigned)M + (unsigned)m) * 1024u; LW[pb] = __int_as_float(r[5]); }
    for (int e = c.bid; e < 32; e += c.G) { const int lo = tab[33 + e] + tab[66 + e], hi2 = tab[33 + e + 1];
        for (int p = lo + c.tid; p < hi2; p += NTHREADS) { LTOK[p] = 0; LDST[p] = 0xFFFFFFFFu; LW[p] = 0.f; } }
    __syncthreads();
    LAS float* scr = (LAS float*)(c.lds + c.wave * 16384);
    const int gw = c.bid * NWAVES + c.wave, NGW = c.G * NWAVES;
    constexpr int I_GU = 16 * 16, I_DN = 4 * 32;
    for (int it = gw; it < 32 * (I_GU + I_DN); it += NGW) { const int e = it / (I_GU + I_DN); int r = it % (I_GU + I_DN);
        if (r < I_GU) { const int nb = r % 16; const bool up = ((nb * 32) & 255) >= 128;
            const float* w = (up ? c.moe_w_up() : c.moe_w_gate()) + ((size_t)l * 32 + e) * D * 256;
            transpose_item(w, 256, D, WSP(bf16_t, WS_WGU) + (size_t)e * 512 * D, c.norm_ffn() + l * D, MapGU{}, 16, scr, r, c.lane); }
        else { r -= I_GU; transpose_item(c.moe_w_down() + ((size_t)l * 32 + e) * 256 * D, D, 256, WSP(bf16_t, WS_WDT) + (size_t)e * D * 256, nullptr, MapId{0}, 32, scr, r, c.lane); } }
}

#ifndef ATT_FAST_FOX
#define ATT_FAST_FOX 1
#endif
#ifndef ATT_FAST_MLA
#define ATT_FAST_MLA 1
#endif
#ifndef ATT_FAST_NSA
#define ATT_FAST_NSA 1
#endif
namespace fa {
constexpr int KPITCH = 208, VPITCH = 192;
constexpr int KBUF = 64 * KPITCH, VBUF = 64 * VPITCH;
constexpr int L_K = 0, L_V = 2 * KBUF, L_CUM = L_V + 2 * VBUF, L_LUT = L_CUM + 512, L_PS = 57344, L_F = L_PS + 64 * 132 * 4, L_SEL = L_F + 64 * 132 * 4, L_UNI = L_SEL + 1024, L_TL = L_UNI + 16, L_TLN = L_TL + 128, L_UNIT = L_TLN + 16;
static_assert(L_LUT + 8 * 132 * 4 <= L_PS && L_UNIT + 64 <= 131072, "attention LDS map");
typedef short v4i16_t __attribute__((ext_vector_type(4)));
__device__ __forceinline__ float swap32_max(float v) { auto rr = __builtin_amdgcn_permlane32_swap(__float_as_uint(v), __float_as_uint(v), false, false); return fmaxf(__uint_as_float(rr[0]), __uint_as_float(rr[1])); }
__device__ __forceinline__ float swap32_sum(float v) { auto rr = __builtin_amdgcn_permlane32_swap(__float_as_uint(v), __float_as_uint(v), false, false); return __uint_as_float(rr[0]) + __uint_as_float(rr[1]); }
__device__ __forceinline__ float ex2(float x) { return __builtin_amdgcn_exp2f(x); }

struct KVSrc { const bf16_t* K; int kpitch; const bf16_t* K2; int k2pitch; const bf16_t* V; int vpitch; const float* cum; float cref; };
struct TileRegs { u32x4 k, k2, v; float cm; };
template <bool HAS_K2, bool HAS_CUM>
__device__ __forceinline__ void tile_load(TileRegs& R, const KVSrc& s, int kv0, int tid) {
    const int row = tid >> 3, ch = tid & 7;
    R.k = *(const u32x4*)(s.K + (size_t)(kv0 + row) * s.kpitch + ch * 8);
    R.v = *(const u32x4*)(s.V + (size_t)(kv0 + row) * s.vpitch + ch * 8);
    if constexpr (HAS_K2) { if (tid < 256) R.k2 = *(const u32x4*)(s.K2 + (size_t)(kv0 + (tid >> 2)) * s.k2pitch + (tid & 3) * 8); }
    if constexpr (HAS_CUM) { if (tid < 64) R.cm = s.cum[kv0 + tid]; }
}
template <bool HAS_K2, bool HAS_CUM>
__device__ __forceinline__ void tile_store(const TileRegs& R, LAS unsigned char* lds, int buf, int tid, float cref = 0.f) {
    const int row = tid >> 3, ch = tid & 7;
    *(LAS u32x4*)(lds + L_K + buf * KBUF + row * KPITCH + ch * 16) = R.k;
    if constexpr (HAS_K2) { if (tid < 256) *(LAS u32x4*)(lds + L_K + buf * KBUF + (tid >> 2) * KPITCH + 128 + (tid & 3) * 16) = R.k2; }
    *(LAS u32x4*)(lds + L_V + buf * VBUF + row * VPITCH + ch * 16) = R.v;
    if constexpr (HAS_CUM) { if (tid < 64) { const float x = cref - R.cm; const unsigned hi_ = f2bf(x); const float xl = x - __uint_as_float(hi_ << 16); const unsigned lo_ = f2bf(xl);
            unsigned zz = 0u; asm volatile("" : "+v"(zz)); u32x4 w0; w0.x = hi_ | (lo_ << 16); w0.y = zz; w0.z = zz; w0.w = zz; u32x4 z0; z0.x = zz; z0.y = zz; z0.z = zz; z0.w = zz;
            *(LAS u32x4*)(lds + L_K + buf * KBUF + tid * KPITCH + 128) = w0; *(LAS u32x4*)(lds + L_K + buf * KBUF + tid * KPITCH + 144) = z0; } }
}
template <int NKS>
__device__ __forceinline__ void qk_tile(f32x16 (&st)[2], const LAS unsigned char* lds, int buf, const bf16x8 (&qf)[NKS], int r, int hh, float cval) {
    const LAS unsigned char* kp = lds + L_K + buf * KBUF + r * KPITCH + hh * 16;
    bf16x8 kf[2][NKS];
#pragma unroll
    for (int ks = 0; ks < NKS; ++ks)
#pragma unroll
        for (int rb = 0; rb < 2; ++rb) kf[rb][ks] = *(const LAS bf16x8*)(kp + rb * 32 * KPITCH + ks * 32);
    f32x16 cin;
#pragma unroll
    for (int i = 0; i < 16; ++i) cin[i] = cval;
    __builtin_amdgcn_sched_barrier(0);
    f32x16 a0 = __builtin_amdgcn_mfma_f32_32x32x16_bf16(kf[0][0], qf[0], cin, 0, 0, 0), a1 = __builtin_amdgcn_mfma_f32_32x32x16_bf16(kf[1][0], qf[0], cin, 0, 0, 0);
#pragma unroll
    for (int ks = 1; ks < NKS; ++ks) { a0 = __builtin_amdgcn_mfma_f32_32x32x16_bf16(kf[0][ks], qf[ks], a0, 0, 0, 0); a1 = __builtin_amdgcn_mfma_f32_32x32x16_bf16(kf[1][ks], qf[ks], a1, 0, 0, 0); }
    st[0] = a0; st[1] = a1;
}
__device__ __forceinline__ void pv_tile(f32x16 (&ot)[2], const LAS unsigned char* lds, int buf, const f32x16 (&p)[2], int lane) {
    const int i16 = lane & 15, blk = (lane >> 4) & 1, hh = lane >> 5;
    const LAS unsigned char* vb = lds + L_V + buf * VBUF + (4 * hh + (i16 >> 2)) * VPITCH + 32 * blk + 8 * (i16 & 3);
    v4i16_t lo[4][2], hi[4][2]; bf16x8 pf[4];
#pragma unroll
    for (int q = 0; q < 4; ++q)
#pragma unroll
        for (int db = 0; db < 2; ++db) { const LAS unsigned char* vp = vb + (16 * q) * VPITCH + 64 * db;
            lo[q][db] = __builtin_amdgcn_ds_read_tr16_b64_v4i16((LAS v4i16_t*)vp); hi[q][db] = __builtin_amdgcn_ds_read_tr16_b64_v4i16((LAS v4i16_t*)(vp + 8 * VPITCH)); }
#pragma unroll
    for (int q = 0; q < 4; ++q) { const int rb = q >> 1, s_ = q & 1;
        u32x4 pw; pw.x = cvtpk(p[rb][8 * s_ + 0], p[rb][8 * s_ + 1]); pw.y = cvtpk(p[rb][8 * s_ + 2], p[rb][8 * s_ + 3]); pw.z = cvtpk(p[rb][8 * s_ + 4], p[rb][8 * s_ + 5]); pw.w = cvtpk(p[rb][8 * s_ + 6], p[rb][8 * s_ + 7]);
        pf[q] = __builtin_bit_cast(bf16x8, pw); }
    __builtin_amdgcn_sched_barrier(0);
#pragma unroll
    for (int q = 0; q < 4; ++q)
#pragma unroll
        for (int db = 0; db < 2; ++db) { const bf16x8 vf = {lo[q][db][0], lo[q][db][1], lo[q][db][2], lo[q][db][3], hi[q][db][0], hi[q][db][1], hi[q][db][2], hi[q][db][3]};
            ot[db] = __builtin_amdgcn_mfma_f32_32x32x16_bf16(vf, pf[q], ot[db], 0, 0, 0); }
}
struct SmState { float m, l; };
constexpr float RESC_THR = 8.f;
__device__ __forceinline__ float sm_cval(const SmState& S) { return (S.m == -INFINITY) ? 0.f : -S.m; }
__device__ __forceinline__ float row_max32(const f32x16 (&st)[2]) {
    float mx = fmaxf(st[0][0], st[1][0]);
#pragma unroll
    for (int i = 1; i < 16; ++i) mx = fmaxf(fmaxf(mx, st[0][i]), st[1][i]);
    return swap32_max(mx);
}
typedef float f32x2v __attribute__((ext_vector_type(2)));
template <bool WITH_O>
__device__ __forceinline__ void sm_shift(f32x16 (&st)[2], SmState& S, f32x16 (&ot)[2], float mx) {
    const bool fresh = (S.m == -INFINITY);
    const bool up = fresh ? (mx > -INFINITY) : (mx > RESC_THR);
    if (__any(up)) {
        const float d = up ? mx : 0.f; const float alpha = fresh ? 1.f : ex2(-d);
        S.l *= alpha; S.m = up ? ((fresh ? 0.f : S.m) + d) : S.m;
#pragma unroll
        for (int rb = 0; rb < 2; ++rb)
#pragma unroll
            for (int i = 0; i < 16; ++i) st[rb][i] -= d;
        if constexpr (WITH_O) {
#pragma unroll
            for (int db = 0; db < 2; ++db)
#pragma unroll
                for (int i = 0; i < 16; ++i) ot[db][i] *= alpha; }
    }
}
__device__ __forceinline__ void sm_update(f32x16 (&st)[2], SmState& S, f32x16 (&ot)[2]) {
    sm_shift<true>(st, S, ot, row_max32(st));
    float sum = 0.f;
#pragma unroll
    for (int rb = 0; rb < 2; ++rb)
#pragma unroll
        for (int i = 0; i < 16; ++i) { const float p = ex2(st[rb][i]); st[rb][i] = p; sum += p; }
    S.l += sum;
}
__device__ __forceinline__ void sm_stats(f32x16 (&st)[2], SmState& S) {
    f32x16 dummy[2];
    sm_shift<false>(st, S, dummy, row_max32(st));
    float sum = 0.f;
#pragma unroll
    for (int rb = 0; rb < 2; ++rb)
#pragma unroll
        for (int i = 0; i < 16; ++i) sum += ex2(st[rb][i]);
    S.l += sum;
}
__device__ __forceinline__ void zero_acc(f32x16 (&a)[2]) {
#pragma unroll
    for (int db = 0; db < 2; ++db)
#pragma unroll
        for (int i = 0; i < 16; ++i) a[db][i] = 0.f;
}
__device__ __forceinline__ void store_ot(const f32x16 (&o)[2], float sc, bf16_t* orow, int hh) {
#pragma unroll
    for (int db = 0; db < 2; ++db)
#pragma unroll
        for (int a = 0; a < 4; ++a) { u32x2 w; w.x = cvtpk(o[db][4 * a + 0] * sc, o[db][4 * a + 1] * sc); w.y = cvtpk(o[db][4 * a + 2] * sc, o[db][4 * a + 3] * sc);
            *(u32x2*)(orow + 32 * db + 8 * a + 4 * hh) = w; }
}
#define FA_FOREACH_REG(CODE) _Pragma("unroll") for (int rb = 0; rb < 2; ++rb) _Pragma("unroll") for (int a = 0; a < 4; ++a) _Pragma("unroll") for (int e = 0; e < 4; ++e) { const int i = 4 * a + e; const int kc = 32 * rb + 8 * a + e; (void)kc; CODE }
#define FA_LAUNDER(x) asm volatile("" : "+v"(x))

template <bool IS_MLA>
__device__ __forceinline__ void dense_unit(const Ctx& c, int lyr, int b, int h, int qb) {
    constexpr int NKS = IS_MLA ? 6 : 5;
    const int tid = c.tid, lane = c.lane, r = lane & 31, hh = lane >> 5, w = c.wave;
    LAS unsigned char* lds = c.lds;
    const int q0 = qb * 256, qrow = q0 + 32 * w + r; const size_t mrow = (size_t)b * T + qrow;
    KVSrc src; bf16x8 qf[NKS]; bf16_t* orow;
    if constexpr (IS_MLA) {
        const bf16_t* QB = WSP(bf16_t, WS_QB); const bf16_t* KVB = WSP(bf16_t, WS_KVB);
        src.K = KVB + (size_t)b * T * 1024 + h * 64; src.kpitch = 1024; src.K2 = WSP(bf16_t, WS_KR) + (size_t)b * T * 32; src.k2pitch = 32; src.V = KVB + (size_t)b * T * 1024 + 512 + h * 64; src.vpitch = 1024; src.cum = nullptr; src.cref = 0.f;
#pragma unroll
        for (int ks = 0; ks < 4; ++ks) qf[ks] = *(const bf16x8*)(QB + mrow * 768 + h * 64 + 16 * ks + 8 * hh);
#pragma unroll
        for (int ks = 0; ks < 2; ++ks) qf[4 + ks] = *(const bf16x8*)(QB + mrow * 768 + 512 + h * 32 + 16 * ks + 8 * hh);
        orow = WSP(bf16_t, WS_OUTB) + mrow * 512 + h * 64;
    } else {
        const bf16_t* P1 = WSP(bf16_t, WS_P1);
        src.K = P1 + (size_t)b * T * P1W + C_FQKV + 512 + h * 64; src.kpitch = P1W; src.K2 = nullptr; src.k2pitch = 0; src.V = P1 + (size_t)b * T * P1W + C_FQKV + 1024 + h * 64; src.vpitch = P1W;
        src.cum = WSP(float, WS_CUM) + ((size_t)b * 8 + h) * T; src.cref = src.cum[q0];
#pragma unroll
        for (int ks = 0; ks < 4; ++ks) qf[ks] = *(const bf16x8*)(P1 + mrow * P1W + C_FQKV + h * 64 + 16 * ks + 8 * hh);
        { unsigned one2 = hh ? 0u : 0x3F803F80u; asm volatile("" : "+v"(one2)); u32x4 aq; aq.x = one2; aq.y = 0u; aq.z = 0u; aq.w = 0u; qf[4] = __builtin_bit_cast(bf16x8, aq); }
        orow = WSP(bf16_t, WS_OUTC) + mrow * 512 + h * 64;
    }
    f32x16 st[2], ot[2]; zero_acc(ot); SmState S{-INFINITY, 0.f};
    const int nt = 4 * qb + 4;
    const int wlast = (q0 + 32 * w + 31) >> 6;
    constexpr float FOX_SKIP = 40.f;
    float qbound = 0.f, mmin_blk = -INFINITY; LAS float* MM = (LAS float*)(lds + L_UNIT + 16);
    if constexpr (!IS_MLA) {
        float ss = 0.f;
#pragma unroll
        for (int ks = 0; ks < 4; ++ks)
#pragma unroll
            for (int j = 0; j < 8; ++j) { const float x_ = bf2f((bf16_t)qf[ks][j]); ss += x_ * x_; }
        ss = swap32_sum(ss);
        const float km2 = __uint_as_float((WSP(unsigned, WS_CTL) + CW_KMAX)[lyr * 16 + b * 8 + h]);
        qbound = sqrtf(ss * km2) * 1.001f + 0.01f;
    }
    TileRegs R;
    tile_load<IS_MLA, !IS_MLA>(R, src, 64 * (nt - 1), tid); tile_store<IS_MLA, !IS_MLA>(R, lds, 0, tid, src.cref);
    if (nt > 1) tile_load<IS_MLA, !IS_MLA>(R, src, 64 * (nt - 2), tid);
    float cx_next = 0.f; if constexpr (!IS_MLA) cx_next = src.cum[64 * (nt - 2) + 63];
    __syncthreads();
    for (int it = 0; it < nt; ++it) { const int t = nt - 1 - it, buf = it & 1, kv0 = 64 * t;
        if constexpr (!IS_MLA) {
            const float cx_t = cx_next;
            if (it >= 4 && (src.cref - cx_t) < mmin_blk - FOX_SKIP) break;
            if (t >= 1) cx_next = src.cum[64 * (t - 1) + 63];
        }
        if (t <= wlast) {
            qk_tile<NKS>(st, lds, buf, qf, r, hh, sm_cval(S));
            if (kv0 + 63 > q0 + 32 * w) { int lim = qrow - kv0 - 4 * hh; FA_LAUNDER(lim); FA_FOREACH_REG({ if (kc > lim) st[rb][i] = -INFINITY; }) }
            sm_update(st, S, ot);
            pv_tile(ot, lds, buf, st, lane);
        }
        if constexpr (!IS_MLA) { if (it == 3) { const float v_ = -wave_max(-(S.m - qbound)); if (lane == 0) MM[w] = v_; } }
        if (it + 1 < nt) { tile_store<IS_MLA, !IS_MLA>(R, lds, buf ^ 1, tid, src.cref); if (it + 2 < nt) tile_load<IS_MLA, !IS_MLA>(R, src, kv0 - 128, tid); }
        __syncthreads();
        if constexpr (!IS_MLA) { if (it == 3) { float mm_ = MM[0];
#pragma unroll
            for (int q_ = 1; q_ < 8; ++q_) mm_ = fminf(mm_, MM[q_]);
            mmin_blk = mm_; } }
    }
    const float lt = swap32_sum(S.l);
    store_ot(ot, 1.f / lt, orow, hh);
}

#define FA_STREAM(SRC, NT, TILE_EXPR, BODY) do { TileRegs R_; const int nt_ = (NT); \
    if (nt_ > 0) { { const int idx = 0; tile_load<false, false>(R_, SRC, 64 * (TILE_EXPR), tid); } tile_store<false, false>(R_, lds, 0, tid); \
      if (nt_ > 1) { const int idx = 1; tile_load<false, false>(R_, SRC, 64 * (TILE_EXPR), tid); } \
      __syncthreads(); \
      for (int it_ = 0; it_ < nt_; ++it_) { const int buf = it_ & 1; int tile; { const int idx = it_; tile = (TILE_EXPR); } \
          BODY \
          if (it_ + 1 < nt_) { tile_store<false, false>(R_, lds, buf ^ 1, tid); if (it_ + 2 < nt_) { const int idx = it_ + 2; tile_load<false, false>(R_, SRC, 64 * (TILE_EXPR), tid); } } \
          __syncthreads(); } } } while (0)

__device__ __forceinline__ void nsa_unit(const Ctx& c, int b, int g, int j) {
    const int tid = c.tid, lane = c.lane, r = lane & 31, hh = lane >> 5, w = c.wave;
    LAS unsigned char* lds = c.lds;
    const int t0 = 64 * j, tl = r >> 2, hp = r & 3, tokl = 8 * w + tl, tq = t0 + tokl, head = 4 * g + hp; const size_t mrow = (size_t)b * T + tq;
    const bf16_t* P1 = WSP(bf16_t, WS_P1);
    bf16x8 qf[4];
#pragma unroll
    for (int ks = 0; ks < 4; ++ks) qf[ks] = *(const bf16x8*)(P1 + mrow * P1W + C_NQ + head * 64 + 16 * ks + 8 * hh);
    const float gc = sigmoidf_(bf2f(P1[mrow * P1W + C_NG + head * 3 + 0])), gsl = sigmoidf_(bf2f(P1[mrow * P1W + C_NG + head * 3 + 1])), gwn = sigmoidf_(bf2f(P1[mrow * P1W + C_NG + head * 3 + 2]));
    const LAS float* lutL = (const LAS float*)(lds + L_LUT) + head * 132;
    LAS float* PS = (LAS float*)(lds + L_PS); LAS float* FM = (LAS float*)(lds + L_F); LAS unsigned* SEL = (LAS unsigned*)(lds + L_SEL); LAS unsigned* UNI = (LAS unsigned*)(lds + L_UNI);
    LAS unsigned char* TL = (LAS unsigned char*)(lds + L_TL); LAS int* TLN = (LAS int*)(lds + L_TLN);
    f32x16 st[2], ot[2], otot[2]; zero_acc(otot);
    for (int i = tid; i < 2 * 64 * 132; i += NTHREADS) PS[i] = 0.f;
    if (tid < 256) SEL[tid] = 0u; if (tid < 4) UNI[tid] = 0u;
    const float bfar = lutL[128];
    const int tmin = t0 + 8 * w;
    const int n_ok_max = ((t0 + 63 - 31) >> 4) + 1; const int nct = (n_ok_max + 63) >> 6;
    KVSrc srcc; srcc.K = WSP(bf16_t, WS_KC) + (size_t)(b * 2 + g) * 512 * 64; srcc.kpitch = 64; srcc.K2 = nullptr; srcc.k2pitch = 0; srcc.V = WSP(bf16_t, WS_VC) + (size_t)(b * 2 + g) * 512 * 64; srcc.vpitch = 64; srcc.cum = nullptr; srcc.cref = 0.f;
    SmState Sc{-INFINITY, 0.f};
    FA_STREAM(srcc, nct, idx, {
        const bool farc = (16 * (64 * tile + 63) + 31 + 128 <= tmin);
        qk_tile<4>(st, lds, buf, qf, r, hh, sm_cval(Sc) + (farc ? bfar : 0.f));
        if (!farc) { int db_ = tq - 31 - 1024 * tile - 64 * hh; FA_LAUNDER(db_); FA_FOREACH_REG({ const int dist = db_ - 16 * kc; const float s_ = st[rb][i] + lutL[dist < 0 ? 0 : (dist > 128 ? 128 : dist)]; st[rb][i] = dist < 0 ? -INFINITY : s_; }) }
        sm_stats(st, Sc); });
    { const float lt = swap32_sum(Sc.l); const float inv = lt > 0.f ? 1.f / lt : 0.f; const float msafe = (Sc.m == -INFINITY) ? 0.f : Sc.m;
      zero_acc(ot);
      FA_STREAM(srcc, nct, idx, {
        const bool farc = (16 * (64 * tile + 63) + 31 + 128 <= tmin);
        qk_tile<4>(st, lds, buf, qf, r, hh, (farc ? bfar : 0.f) - msafe);
        if (farc) { FA_FOREACH_REG({ st[rb][i] = ex2(st[rb][i]) * inv; }) }
        else { int db_ = tq - 31 - 1024 * tile - 64 * hh; FA_LAUNDER(db_); FA_FOREACH_REG({ const int dist = db_ - 16 * kc; const float s_ = st[rb][i] + lutL[dist < 0 ? 0 : (dist > 128 ? 128 : dist)]; st[rb][i] = dist < 0 ? 0.f : ex2(s_) * inv; }) }
_Pragma("unroll")
        for (int rb = 0; rb < 2; ++rb)
_Pragma("unroll")
            for (int a = 0; a < 4; ++a) { float q4[4];
_Pragma("unroll")
                for (int e = 0; e < 4; ++e) { float v = st[rb][4 * a + e]; v += dpp_f<0xB1>(v); v += dpp_f<0x4E>(v); q4[e] = v; }
                if (hp == 0) { const int G = 16 * tile + 8 * rb + 2 * a + hh; PS[tokl * 132 + G] = q4[0] + 2.f * (q4[1] + q4[2] + q4[3]); FM[tokl * 132 + G] = q4[0]; } }
        pv_tile(ot, lds, buf, st, lane); });
#pragma unroll
      for (int db = 0; db < 2; ++db)
#pragma unroll
          for (int i = 0; i < 16; ++i) otot[db][i] += gc * ot[db][i]; }
    if (j + 1 <= 16) { if (tid < 64) SEL[tid * 4] = (1u << (j + 1)) - 1u; if (tid == 0) UNI[0] = (1u << (j + 1)) - 1u; }
    else {
        for (int i = tid; i < 64 * 128; i += NTHREADS) { const int tk = i >> 7, G = i & 127; if (G >= 1 && G <= j - 2) PS[tk * 132 + G] += FM[tk * 132 + G + 1]; }
        __syncthreads();
        const int tk = tid >> 3, sub = tid & 7; unsigned bits[4] = {0u, 0u, 0u, 0u};
#pragma unroll 1
        for (int k = 0; k < 16; ++k) { const int G = sub + 8 * k;
            if (G >= 1 && G <= j - 2) { const float v = PS[tk * 132 + G]; int cnt = 0;
                for (int G2 = 1; G2 <= j - 2; ++G2) { const float v2 = PS[tk * 132 + G2]; cnt += (v2 > v || (v2 == v && G2 < G)) ? 1 : 0; }
                if (cnt < 13) { if (k < 4) bits[0] |= 1u << G; else if (k < 8) bits[1] |= 1u << (G - 32); else if (k < 12) bits[2] |= 1u << (G - 64); else bits[3] |= 1u << (G - 96); } } }
        if (sub == 0) { bits[0] |= 1u; { const int G = j; if (G < 32) bits[0] |= 1u << G; else if (G < 64) bits[1] |= 1u << (G - 32); else if (G < 96) bits[2] |= 1u << (G - 64); else bits[3] |= 1u << (G - 96); }
                        { const int G = j - 1; if (G < 32) bits[0] |= 1u << G; else if (G < 64) bits[1] |= 1u << (G - 32); else if (G < 96) bits[2] |= 1u << (G - 64); else bits[3] |= 1u << (G - 96); } }
#pragma unroll
        for (int q = 0; q < 4; ++q) if (bits[q]) { atomicOr((unsigned*)(SEL + tk * 4 + q), bits[q]); atomicOr((unsigned*)(UNI + q), bits[q]); }
    }
    __syncthreads();
    if (tid == 0) { int n = 0; for (int q = 0; q < 4; ++q) { unsigned m_ = UNI[q]; while (m_) { const int bpos = __builtin_ctz(m_); m_ &= m_ - 1u; TL[n++] = (unsigned char)(32 * q + bpos); } } TLN[0] = n; }
    __syncthreads();
    const unsigned msk0 = SEL[tokl * 4 + 0], msk1 = SEL[tokl * 4 + 1], msk2 = SEL[tokl * 4 + 2], msk3 = SEL[tokl * 4 + 3];
    const int nsel = __builtin_amdgcn_readfirstlane(TLN[0]);
    { KVSrc srcs; srcs.K = P1 + (size_t)b * T * P1W + C_NKV + ((1 * 2 + 0) * 2 + g) * 64; srcs.kpitch = P1W; srcs.K2 = nullptr; srcs.k2pitch = 0; srcs.V = P1 + (size_t)b * T * P1W + C_NKV + ((1 * 2 + 1) * 2 + g) * 64; srcs.vpitch = P1W; srcs.cum = nullptr; srcs.cref = 0.f;
      SmState Ss{-INFINITY, 0.f}; zero_acc(ot);
      FA_STREAM(srcs, nsel, (int)TL[idx], {
        const int wq = tile >> 5; const unsigned mw = wq == 0 ? msk0 : wq == 1 ? msk1 : wq == 2 ? msk2 : msk3; const bool mine = (mw >> (tile & 31)) & 1u;
        if (__any(mine)) {
            const bool fars = (64 * tile + 63 + 128 <= tmin);
            qk_tile<4>(st, lds, buf, qf, r, hh, mine ? sm_cval(Ss) + (fars ? bfar : 0.f) : -INFINITY);
            if (!fars) { int db_ = tq - 64 * tile - 4 * hh; FA_LAUNDER(db_); FA_FOREACH_REG({ const int dist = db_ - kc; const float s_ = st[rb][i] + lutL[dist < 0 ? 0 : (dist > 128 ? 128 : dist)]; st[rb][i] = (dist >= 0) ? s_ : -INFINITY; }) }
            sm_update(st, Ss, ot);
            pv_tile(ot, lds, buf, st, lane); } });
      const float lt = swap32_sum(Ss.l); const float sc = lt > 0.f ? gsl / lt : 0.f;
#pragma unroll
      for (int db = 0; db < 2; ++db)
#pragma unroll
          for (int i = 0; i < 16; ++i) otot[db][i] += sc * ot[db][i]; }
    { KVSrc srcw; srcw.K = P1 + (size_t)b * T * P1W + C_NKV + ((2 * 2 + 0) * 2 + g) * 64; srcw.kpitch = P1W; srcw.K2 = nullptr; srcw.k2pitch = 0; srcw.V = P1 + (size_t)b * T * P1W + C_NKV + ((2 * 2 + 1) * 2 + g) * 64; srcw.vpitch = P1W; srcw.cum = nullptr; srcw.cref = 0.f;
      const int jlo = j - 8 > 0 ? j - 8 : 0;
      SmState Sw{-INFINITY, 0.f}; zero_acc(ot);
      FA_STREAM(srcw, j - jlo + 1, jlo + idx, {
        qk_tile<4>(st, lds, buf, qf, r, hh, sm_cval(Sw));
        { int db_ = tq - 64 * tile - 4 * hh; FA_LAUNDER(db_); FA_FOREACH_REG({ const int dist = db_ - kc; const float s_ = st[rb][i] + lutL[dist < 0 ? 0 : (dist > 128 ? 128 : dist)]; st[rb][i] = (dist >= 0 && dist < 512) ? s_ : -INFINITY; }) }
        sm_update(st, Sw, ot);
        pv_tile(ot, lds, buf, st, lane); });
      const float lt = swap32_sum(Sw.l); const float sc = lt > 0.f ? gwn / lt : 0.f;
#pragma unroll
      for (int db = 0; db < 2; ++db)
#pragma unroll
          for (int i = 0; i < 16; ++i) otot[db][i] += sc * ot[db][i]; }
    store_ot(otot, 1.f, WSP(bf16_t, WS_OUTA) + mrow * 512 + head * 64, hh);
}
}

__device__ __forceinline__ int next_unit(const Ctx& c, unsigned* ctr) {
    LAS int* u = (LAS int*)(c.lds + fa::L_UNIT);
    __syncthreads();
    if (c.tid == 0) u[0] = (int)__hip_atomic_fetch_add(ctr, 1u, __ATOMIC_RELAXED, __HIP_MEMORY_SCOPE_AGENT);
    __syncthreads();
    return __builtin_amdgcn_readfirstlane(u[0]);
}
__device__ __forceinline__ void phase_att_fast(const Ctx& c0, int l) {
    Ctx c = c0;
    unsigned* ctr0 = WSP(unsigned, WS_CTL) + CW_QUEUE + 64 * 8 * l;
    { const float* lut = WSP(float, WS_TAB) + 512; LAS float* L_ = (LAS float*)(c.lds + fa::L_LUT); for (int i = c.tid; i < 8 * 132; i += NTHREADS) L_[i] = lut[i]; }
    const int myx = (int)(xb_xcc_id() & 7u);
    for (int qi = 0; qi < 8; ++qi) {
        const int x = (myx + qi) & 7;
        for (;;) {
            const int u = next_unit(c, ctr0 + 64 * x);
            if (u >= 192) break;
            relaunder(c);
            const int sidx = u >> 5, k = u & 31;
            if (sidx == 0 || sidx == 3) { const int p = 2 * x + (sidx == 3); if (ATT_FAST_MLA) fa::dense_unit<true>(c, l & 1, p >> 3, p & 7, 31 - k); }
            else if (sidx == 1 || sidx == 4) { const int p = 2 * x + (sidx == 4); if (ATT_FAST_FOX) fa::dense_unit<false>(c, l & 1, p >> 3, p & 7, 31 - k); }
            else { const int n = (sidx == 5 ? 32 : 0) + k, grp = x >> 1; if (ATT_FAST_NSA) fa::nsa_unit(c, grp >> 1, grp & 1, 127 - 2 * n - (x & 1)); }
        }
    }
}

struct Args { const void* in[32]; float* out; unsigned char* ws; int l_lo, l_hi; };
constexpr int PH_PER_LAYER = 15, K_FINAL = 1 + PH_PER_LAYER;
template <int KIND>
__global__ void __launch_bounds__(NTHREADS, 2) fwd_kernel(Args a) {
    extern __shared__ __attribute__((aligned(16))) unsigned char lds_raw[];
    Ctx c;
    c.out = a.out; c.ws = a.ws; c.ws0 = a.ws; c.lds = (LAS unsigned char*)lds_raw;
    c.tid = threadIdx.x; c.lane = c.tid & 63; c.wave = __builtin_amdgcn_readfirstlane(c.tid >> 6); c.G = gridDim.x; c.bid = blockIdx.x;
    if (c.tid < 4) ((LAS unsigned*)(c.lds + LDS_MISC))[c.tid] = 0u;
    if (c.tid < 32) { const unsigned long long pv = (unsigned long long)a.in[c.tid]; ((LAS unsigned*)(c.lds + LDS_INTAB))[2 * c.tid] = (unsigned)pv; ((LAS unsigned*)(c.lds + LDS_INTAB))[2 * c.tid + 1] = (unsigned)(pv >> 32); }
    __syncthreads();
    XcdBarrier bar; bar.bar = WSP(unsigned, WS_CTL) + CW_BAR; bar.x = 0; bar.st = nullptr;
    if constexpr (KIND < 0) bar = xcd_barrier_post(WSP(unsigned, WS_CTL) + CW_BAR, (volatile LAS unsigned*)(c.lds + LDS_MISC));
#define IN(k) ((KIND < 0 || KIND == (k)) && (relaunder(c), true))
#define REP(p) for (int rep_ = 0; rep_ < ((PROBE_DOUBLE == (p)) ? 2 : 1); ++rep_)
#define SEAM(k) do { if constexpr (KIND < 0) { unsigned* bb_ = bar.bar; asm volatile("" : "+s"(bb_)); bar.bar = bb_; xcd_barrier(bar); } } while (0)
    LAS unsigned char* ring = c.lds;

    if (IN(0)) REP(4) { phase_prologue(c); } SEAM(0);
    for (int l = a.l_lo; l < a.l_hi; ++l) {
        constexpr int pb = 1;
        const float* resid = (l == 0) ? c.x() : WSP(float, WS_XA);
        if (IN(pb + 0)) { if (l == 0) phase_norm(c, c.x(), nullptr, nullptr, nullptr, WSP(bf16_t, WS_H0));
                          else phase_norm(c, WSP(float, WS_XA), WSP(bf16_t, WS_Y), WSP(bf16_t, WS_Y) + (size_t)M * D, WSP(float, WS_XA), WSP(bf16_t, WS_H0));
#if PROBE_DOUBLE == 6
                          if (l == 0) phase_norm(c, c.x(), nullptr, nullptr, nullptr, WSP(bf16_t, WS_HG));
                          else phase_norm(c, WSP(float, WS_XA), WSP(bf16_t, WS_Y), WSP(bf16_t, WS_Y) + (size_t)M * D, WSP(float, WS_P1), WSP(bf16_t, WS_QB));
#endif
        } SEAM(pb + 0);
        if (IN(pb + 1)) REP(2) { pg8::Cfg g{(unsigned)(D * 2), 128u, (unsigned)(D * 2), D / 64, nullptr}; pg8::DenseOrder S; S.init(M / 256, P1W / 256, c.G, c.bid, WSP(bf16_t, WS_H0), (size_t)256 * D * 2, WSP(bf16_t, WS_WINT) + (size_t)l * P1W * D, (size_t)256 * D * 2);
            EpiStoreBf16 E{WSP(bf16_t, WS_P1), P1W, nullptr, 0}; pg8::gemm_phase<false>(ring, c.wave, g, S, E); } SEAM(pb + 1);
        if (IN(pb + 2)) REP(5) { phase_prep(c, l); } SEAM(pb + 2);
        if (IN(pb + 3)) REP(5) { phase_cum(c); } SEAM(pb + 3);
        if (IN(pb + 4)) REP(2) {
            { pg8::Cfg g{(unsigned)(P1W * 2), 128u, 512u, 4, nullptr}; pg8::DenseOrder S; S.init(M / 256, 3, c.G, c.bid, WSP(bf16_t, WS_P1) + C_CQ, (size_t)256 * P1W * 2, WSP(bf16_t, WS_WUQT) + (size_t)l * 768 * 256, (size_t)256 * 512);
              EpiStoreBf16 E{WSP(bf16_t, WS_QB), 768, WSP(float, WS_RSTD), 2}; pg8::gemm_phase<false>(ring, c.wave, g, S, E); }
            { pg8::Cfg g{(unsigned)(P1W * 2), 128u, 256u, 2, nullptr}; pg8::DenseOrder S; S.init(M / 256, 4, c.G, c.bid, WSP(bf16_t, WS_P1) + C_CKV, (size_t)256 * P1W * 2, WSP(bf16_t, WS_WUKVT) + (size_t)l * 1024 * 128, (size_t)256 * 256);
              EpiStoreBf16 E{WSP(bf16_t, WS_KVB), 1024, WSP(float, WS_RSTD) + 1, 2}; pg8::gemm_phase<false>(ring, c.wave, g, S, E); }
            { pg8::Cfg g{(unsigned)(16 * P1W * 2), (unsigned)(P1W * 2), 4096u, 32, nullptr}; CmpOrder S{c.G, (c.bid + 64) % c.G, (const char*)WSP(bf16_t, WS_P1), (const char*)(WSP(bf16_t, WS_WC1T) + (size_t)l * 2 * 256 * 2048)};
              EpiCmp1 E{WSP(bf16_t, WS_HC), WSP(float, WS_TAB) + l * 256}; pg8::gemm_phase<false>(ring, c.wave, g, S, E); }
        } SEAM(pb + 4);
        if (IN(pb + 5)) { phase_cmp2_ropeq(c, l); } SEAM(pb + 5);
        if (IN(pb + 6)) { phase_att_fast(c, l);
#if PROBE_DOUBLE == 1
            phase_att_fast(c, l + 2);
#endif
        } SEAM(pb + 6);
        if (IN(pb + 7)) REP(5) { phase_norm(c, resid, nullptr, nullptr, nullptr, WSP(bf16_t, WS_HG)); } SEAM(pb + 7);
        if (IN(pb + 8)) REP(2) { pg8::Cfg g{(unsigned)(D * 2), 128u, (unsigned)(D * 2), D / 64, nullptr}; pg8::DenseOrder S; S.init(M / 256, 12, c.G, c.bid, WSP(bf16_t, WS_HG), (size_t)256 * D * 2, WSP(bf16_t, WS_WMT) + (size_t)l * 3072 * D, (size_t)256 * D * 2);
            EpiGates E{WSP(bf16_t, WS_GATES), c.b_merge() + l * 3072}; pg8::gemm_phase<false>(ring, c.wave, g, S, E); } SEAM(pb + 8);
        if (IN(pb + 9)) REP(2) {
#pragma unroll 1
            for (int br = 0; br < 3; ++br) { pg8::Cfg g{1024u, 128u, 1024u, 8, nullptr}; pg8::DenseOrder S;
                S.init(M / 256, 4, c.G, c.bid, WSP(bf16_t, br == 0 ? WS_OUTA : br == 1 ? WS_OUTB : WS_OUTC), (size_t)256 * 1024, WSP(bf16_t, WS_WOT) + ((size_t)l * 3 + br) * 1024 * 512, (size_t)256 * 1024);
                EpiOutproj E{WSP(bf16_t, WS_MIXED), WSP(bf16_t, WS_GATES), br}; pg8::gemm_phase<false>(ring, c.wave, g, S, E); }
        } SEAM(pb + 9);
        if (IN(pb + 10)) { pg8::Cfg g{(unsigned)(D * 2), 128u, (unsigned)(D * 2), D / 64, nullptr}; pg8::DenseOrder S; S.init(M / 256, 4, c.G, c.bid, WSP(bf16_t, WS_MIXED), (size_t)256 * D * 2, WSP(bf16_t, WS_WOUTT) + (size_t)l * D * D, (size_t)256 * D * 2);
            EpiWout E{resid, WSP(float, WS_XA)}; pg8::gemm_phase<false>(ring, c.wave, g, S, E);
#if PROBE_DOUBLE == 6
            { EpiWout E2{resid, (float*)(c.ws + PB + 32 * MiB)}; pg8::gemm_phase<false>(ring, c.wave, g, S, E2); }
#endif
        } SEAM(pb + 10);
        if (IN(pb + 11)) { phase_router(c, l);
#if PROBE_DOUBLE == 3
            phase_router(c, l, 1);
#endif
        } SEAM(pb + 11);
        if (IN(pb + 12)) REP(4) { phase_place(c, l); } SEAM(pb + 12);
        if (IN(pb + 13)) REP(2) { LAS int* tab = (LAS int*)(c.lds + LDS_MOETAB); moe_tables(c, l, tab);
            pg8::Cfg g{(unsigned)(D * 2), 128u, (unsigned)(D * 2), D / 64, WSP(int, WS_LTOK)}; MoeOrder S{c.G, c.bid, 2, tab, (const char*)WSP(bf16_t, WS_H2), 0, (const char*)WSP(bf16_t, WS_WGU), (size_t)512 * D * 2, (size_t)256 * D * 2};
            EpiMoe1 E{WSP(bf16_t, WS_HID), WSP(float, WS_LW)}; pg8::gemm_phase<true>(ring, c.wave, g, S, E); } SEAM(pb + 13);
        if (IN(pb + 14)) REP(2) { LAS int* tab = (LAS int*)(c.lds + LDS_MOETAB); moe_tables(c, l, tab);
            pg8::Cfg g{512u, 128u, 512u, 4, nullptr}; MoeOrder S{c.G, c.bid, 4, tab, (const char*)WSP(bf16_t, WS_HID), 512, (const char*)WSP(bf16_t, WS_WDT), (size_t)D * 256 * 2, (size_t)256 * 256 * 2};
            EpiMoe2 E{WSP(bf16_t, WS_Y), WSP(unsigned, WS_LSLOT)}; pg8::gemm_phase<false>(ring, c.wave, g, S, E); } SEAM(pb + 14);
    }
    if (IN(K_FINAL)) REP(6) { phase_final(c); }
#undef IN
#undef SEAM
}

template <int KIND> static bool prep_kernel() { return hipFuncSetAttribute((const void*)fwd_kernel<KIND>, hipFuncAttributeMaxDynamicSharedMemorySize, LDS_BYTES) == hipSuccess; }
template <int KIND> static void launch_kind(int grid, hipStream_t stream, Args a, int l) { a.l_lo = l; a.l_hi = l + 1; hipLaunchKernelGGL(fwd_kernel<KIND>, dim3(grid), dim3(NTHREADS), LDS_BYTES, stream, a); }
extern "C" void kernel_launch(void* const* d_in, const int* in_sizes, int n_in, void* d_out, int out_size, void* d_ws, size_t ws_size, hipStream_t stream) {
    static int grid = 0;
    if (grid == 0) {
        if (n_in != 32 || ws_size < WS_END) { fprintf(stderr, "kernel_launch: n_in %d ws %zu (need %zu)\n", n_in, ws_size, (size_t)WS_END); grid = -1; return; }
        int dev = 0, cus = 0;
        if (hipGetDevice(&dev) != hipSuccess || hipDeviceGetAttribute(&cus, hipDeviceAttributeMultiprocessorCount, dev) != hipSuccess) { grid = -1; return; }
        bool ok = true;
#if MK_ONE_LAUNCH
        ok = prep_kernel<-1>();
#else
        ok = prep_kernel<0>() && prep_kernel<1>() && prep_kernel<2>() && prep_kernel<3>() && prep_kernel<4>() && prep_kernel<5>() && prep_kernel<6>() && prep_kernel<7>() && prep_kernel<8>() && prep_kernel<9>()
          && prep_kernel<10>() && prep_kernel<11>() && prep_kernel<12>() && prep_kernel<13>() && prep_kernel<14>() && prep_kernel<15>() && prep_kernel<16>();
#endif
        if (!ok) { grid = -1; return; }
        (void)hipGetLastError();
        grid = cus;
    }
    if (grid < 0) return;
    (void)hipMemsetAsync((char*)d_ws + WS_CTL, 0, CTL_BYTES, stream);
    Args a{};
    for (int i = 0; i < 32; ++i) a.in[i] = d_in[i];
    a.out = (float*)d_out; a.ws = (unsigned char*)d_ws;
#if MK_ONE_LAUNCH
    a.l_lo = 0; a.l_hi = NL;
    hipLaunchKernelGGL(fwd_kernel<-1>, dim3(grid), dim3(NTHREADS), LDS_BYTES, stream, a);
#else
    launch_kind<0>(grid, stream, a, 0);
    for (int l = 0; l < NL; ++l) {
        launch_kind<1>(grid, stream, a, l); launch_kind<2>(grid, stream, a, l); launch_kind<3>(grid, stream, a, l); launch_kind<4>(grid, stream, a, l); launch_kind<5>(grid, stream, a, l);
        launch_kind<6>(grid, stream, a, l); launch_kind<7>(grid, stream, a, l); launch_kind<8>(grid, stream, a, l); launch_kind<9>(grid, stream, a, l); launch_kind<10>(grid, stream, a, l);
        launch_kind<11>(grid, stream, a, l); launch_kind<12>(grid, stream, a, l); launch_kind<13>(grid, stream, a, l); launch_kind<14>(grid, stream, a, l); launch_kind<15>(grid, stream, a, l);
    }
    launch_kind<16>(grid, stream, a, 0);
#endif
}
```

```cpp
#include <hip/hip_runtime.h>
#include <stdint.h>
#include <cstdio>

#ifndef PROBE_DOUBLE
#define PROBE_DOUBLE 0
#endif
#ifndef MK_ONE_LAUNCH
#define MK_ONE_LAUNCH 1
#endif

#define LAS __attribute__((address_space(3)))
typedef unsigned short bf16_t;
typedef short bf16x8 __attribute__((ext_vector_type(8)));
typedef float f32x4 __attribute__((ext_vector_type(4)));
typedef float f32x16 __attribute__((ext_vector_type(16)));
typedef unsigned u32x4 __attribute__((ext_vector_type(4)));
typedef unsigned u32x2 __attribute__((ext_vector_type(2)));

constexpr int NB = 2, T = 8192, D = 1024, M = NB * T, NL = 2;
constexpr int DIN = 6336;
constexpr int P1W = 3328;
constexpr int C_NQ = 0, C_NKV = 512, C_CQ = 1280, C_CKV = 1536, C_KR = 1664, C_NG = 1696, C_FF = 1720, C_FQKV = 1728;
constexpr int NEXP = 32, EDIM = 256;
constexpr float EPS = 1e-6f;
constexpr float LOG2E = 1.4426950408889634f;
constexpr float QSCALE64 = 0.125f * LOG2E, QSCALE96 = 0.10206207261596575f * LOG2E;
constexpr int NTHREADS = 512, NWAVES = 8;
constexpr int LDS_BYTES = 147456;
constexpr int MOE_MAXROWS = 40960;

constexpr size_t MiB = 1u << 20;
constexpr size_t WS_CTL = 0;
constexpr size_t CTL_BYTES = 1 * MiB;
constexpr int CW_BAR = 4096;
constexpr int CW_QUEUE = 16384;
constexpr int CW_MOECNT = 32768;
constexpr int CW_KMAX = 24576;
constexpr int CW_CNTB = 65536;
constexpr size_t CTL_LTOK = 512 * 1024;
constexpr size_t WS_WINT = 1 * MiB;
constexpr size_t WS_WMT = 14 * MiB;
constexpr size_t WS_WUQT = 26 * MiB;
constexpr size_t WS_WUKVT = 27 * MiB;
constexpr size_t WS_WOT = 28 * MiB;
constexpr size_t WS_WOUTT = 34 * MiB;
constexpr size_t WS_WC1T = 38 * MiB;
constexpr size_t WS_ROPE = 42 * MiB;
constexpr size_t WS_TAB = 44 * MiB;
constexpr size_t WS_XA = 45 * MiB;
constexpr size_t PB = 109 * MiB;
constexpr size_t WS_P1 = PB;
constexpr size_t WS_QB = PB + 104 * MiB;
constexpr size_t WS_KVB = PB + 128 * MiB;
constexpr size_t WS_OUTA = PB + 160 * MiB;
constexpr size_t WS_OUTB = PB + 176 * MiB;
constexpr size_t WS_OUTC = PB + 192 * MiB;
constexpr size_t WS_H0 = PB + 176 * MiB;
constexpr size_t WS_SM = PB + 208 * MiB;
constexpr size_t WS_RSTD = WS_SM;
constexpr size_t WS_KR = WS_SM + 256 * 1024;
constexpr size_t WS_LF = WS_SM + 1280 * 1024;
constexpr size_t WS_CUM = WS_SM + 1792 * 1024;
constexpr size_t WS_SL = WS_SM + 2304 * 1024;
constexpr size_t WS_KC = WS_SM + 6400 * 1024;
constexpr size_t WS_VC = WS_SM + 6656 * 1024;
constexpr size_t WS_REC = WS_SM + 6912 * 1024;
constexpr size_t WS_LTOK = WS_SM + 7424 * 1024;
constexpr size_t WS_LW = WS_SM + 7616 * 1024;
constexpr size_t WS_LSLOT = WS_SM + 7808 * 1024;
static_assert(WS_LSLOT + MOE_MAXROWS * 4 <= WS_SM + 8 * MiB, "small region");
constexpr size_t WS_END = PB + 216 * MiB;
constexpr size_t WS_HG = PB;
constexpr size_t WS_GATES = PB + 32 * MiB;
constexpr size_t WS_MIXED = PB + 128 * MiB;
constexpr size_t WS_H2 = PB;
constexpr size_t WS_WGU = PB + 32 * MiB;
constexpr size_t WS_WDT = PB + 64 * MiB;
constexpr size_t WS_HID = PB + 80 * MiB;
constexpr size_t WS_Y = PB + 100 * MiB;
static_assert(WS_Y + 64 * MiB <= WS_H0, "Y must not overlap H0");
static_assert(WS_END <= 332 * MiB, "workspace budget");

__device__ __forceinline__ float bf2f(bf16_t v) { return __uint_as_float((unsigned)v << 16); }
__device__ __forceinline__ unsigned f2bf(float f) { unsigned u = __float_as_uint(f); return (u + 0x7fffu + ((u >> 16) & 1u)) >> 16; }
__device__ __forceinline__ unsigned pk2(float lo, float hi) { return f2bf(lo) | (f2bf(hi) << 16); }
typedef float f32x2_t __attribute__((ext_vector_type(2))); typedef __bf16 bf16x2_t __attribute__((ext_vector_type(2)));
__device__ __forceinline__ unsigned cvtpk(float lo, float hi) { f32x2_t v = {lo, hi}; bf16x2_t b = __builtin_convertvector(v, bf16x2_t); return __builtin_bit_cast(unsigned, b); }
__device__ __forceinline__ f32x4 unpk4(u32x2 a) { f32x4 r; r.x = __uint_as_float(a.x << 16); r.y = __uint_as_float(a.x & 0xffff0000u); r.z = __uint_as_float(a.y << 16); r.w = __uint_as_float(a.y & 0xffff0000u); return r; }
template <int CTRL> __device__ __forceinline__ float dpp_f(float v) { return __int_as_float(__builtin_amdgcn_update_dpp(0, __float_as_int(v), CTRL, 0xf, 0xf, true)); }
__device__ __forceinline__ float wave_sum(float v) {
    v += dpp_f<0xB1>(v); v += dpp_f<0x4E>(v); v += dpp_f<0x141>(v); v += dpp_f<0x140>(v);
    const float a = __int_as_float(__builtin_amdgcn_readlane(__float_as_int(v), 0)), b = __int_as_float(__builtin_amdgcn_readlane(__float_as_int(v), 16));
    const float c2 = __int_as_float(__builtin_amdgcn_readlane(__float_as_int(v), 32)), d = __int_as_float(__builtin_amdgcn_readlane(__float_as_int(v), 48));
    return (a + b) + (c2 + d);
}
__device__ __forceinline__ float wave_max(float v) {
    v = fmaxf(v, dpp_f<0xB1>(v)); v = fmaxf(v, dpp_f<0x4E>(v)); v = fmaxf(v, dpp_f<0x141>(v)); v = fmaxf(v, dpp_f<0x140>(v));
    const float a = __int_as_float(__builtin_amdgcn_readlane(__float_as_int(v), 0)), b = __int_as_float(__builtin_amdgcn_readlane(__float_as_int(v), 16));
    const float c2 = __int_as_float(__builtin_amdgcn_readlane(__float_as_int(v), 32)), d = __int_as_float(__builtin_amdgcn_readlane(__float_as_int(v), 48));
    return fmaxf(fmaxf(a, b), fmaxf(c2, d));
}
__device__ __forceinline__ float half_sum(float v) { auto rr = __builtin_amdgcn_permlane32_swap(__float_as_uint(v), __float_as_uint(v), false, false); return __uint_as_float(rr[0]) + __uint_as_float(rr[1]); }
__device__ __forceinline__ float sigmoidf_(float x) { return 1.f / (1.f + __expf(-x)); }
__device__ __forceinline__ float gelu_tanh(float x) { const float u = 0.7978845608028654f * (x + 0.044715f * x * x * x); const float th = 1.f - 2.f / (1.f + __expf(2.f * u)); return 0.5f * x * (1.f + th); }
#define LDS_WAIT() asm volatile("s_waitcnt lgkmcnt(0)" ::: "memory")

#define XB_TMO      128
#define XB_XCNT(j)  (256  + 64 * (j))
#define XB_XSUB(j)  (1280 + 64 * (j))
#define XB_XGEN(j)  (2304 + 64 * (j))
#define XB_TOP      3328
#define XB_TOPGEN   3392
#define XCD_BAR_WORDS 3456
#define XB_SPIN_CAP (1u << 18)

__device__ __forceinline__ unsigned xb_ld(unsigned* p)              { return __hip_atomic_load(p, __ATOMIC_RELAXED, __HIP_MEMORY_SCOPE_AGENT); }
__device__ __forceinline__ unsigned xb_add(unsigned* p, unsigned v) { return __hip_atomic_fetch_add(p, v, __ATOMIC_RELAXED, __HIP_MEMORY_SCOPE_AGENT); }
__device__ __forceinline__ unsigned xb_xcc_id() { return (unsigned)__builtin_amdgcn_s_getreg((3 << 11) | 20) & 0xFu; }
#define XB_SPIN(cond, bar) do { unsigned _sp = 0; while (cond) { __builtin_amdgcn_s_sleep(1); \
    if ((++_sp & 255u) == 0u) { if (xb_ld(&(bar)[XB_TMO])) break; if (_sp > XB_SPIN_CAP) { atomicAdd(&(bar)[XB_TMO], 1u); break; } } } } while (0)

struct XcdBarrier { unsigned* bar; unsigned x; volatile LAS unsigned* st; };

__device__ __forceinline__ XcdBarrier xcd_barrier_post(unsigned* bar, volatile LAS unsigned* st) {
    XcdBarrier b; b.bar = bar; b.x = xb_xcc_id(); b.st = st;
    if (threadIdx.x == 0) (void)xb_add(&bar[XB_XCNT(b.x)], 1u);
    return b;
}
__device__ __forceinline__ void xcd_barrier_complete(unsigned* bar, unsigned x, unsigned& nloc, unsigned& nx) {
    const unsigned G = gridDim.x * gridDim.y * gridDim.z;
    unsigned sum, cnt, mine, sp = 0u;
    for (;;) {
        sum = 0u; cnt = 0u; mine = 0u;
#pragma unroll
        for (unsigned j = 0; j < 16; ++j) { const unsigned c = xb_ld(&bar[XB_XCNT(j)]); sum += c; cnt += (c > 0u) ? 1u : 0u; mine = (j == x) ? c : mine; }
        if (sum == G) break;
        __builtin_amdgcn_s_sleep(1);
        if ((++sp & 255u) == 0u) { if (xb_ld(&bar[XB_TMO])) break; if (sp > XB_SPIN_CAP) { atomicAdd(&bar[XB_TMO], 1u); break; } }
    }
    nloc = mine > 0u ? mine : 1u; nx = cnt > 0u ? cnt : 1u;
}
__device__ __forceinline__ void xcd_barrier(const XcdBarrier& b) {
    asm volatile("s_waitcnt vmcnt(0)" ::: "memory");
    __syncthreads();
    if (threadIdx.x == 0) {
        unsigned* bar = b.bar;
        __builtin_amdgcn_s_waitcnt(0);
        unsigned nloc = b.st[0], nx = b.st[1];
        if (nloc == 0u) { xcd_barrier_complete(bar, b.x, nloc, nx); b.st[0] = nloc; b.st[1] = nx; }
        const unsigned old = xb_add(&bar[XB_XSUB(b.x)], 1u);
        const unsigned gen = old / nloc;
        if (old + 1u == (gen + 1u) * nloc) {
            __builtin_amdgcn_fence(__ATOMIC_RELEASE, "agent");
            asm volatile("s_waitcnt vmcnt(0)" ::: "memory");
            const unsigned og = xb_add(&bar[XB_TOP], 1u);
            const unsigned tg = og / nx;
            if (og + 1u == (tg + 1u) * nx) xb_add(&bar[XB_TOPGEN], 1u);
            else XB_SPIN(xb_ld(&bar[XB_TOPGEN]) == tg, bar);
            __builtin_amdgcn_fence(__ATOMIC_ACQUIRE, "agent");
            xb_add(&bar[XB_XGEN(b.x)], 1u);
            asm volatile("s_waitcnt vmcnt(0)" ::: "memory");
        } else {
            XB_SPIN(xb_ld(&bar[XB_XGEN(b.x)]) == gen, bar);
            __builtin_amdgcn_fence(__ATOMIC_ACQUIRE, "agent");
            asm volatile("s_waitcnt vmcnt(0)" ::: "memory");
        }
    }
    __syncthreads();
}

namespace pg8 {
constexpr int BM = 256, BK = 64, HALF = 128, HTB = HALF * BK * 2, STAGE_BYTES = 8 * HTB;
__host__ __device__ __forceinline__ int lds_byte(int r, int c) { const int st = (r >> 4) * 2 + (c >> 5), rr = r & 15, cc = c & 31, ob = rr * 64 + cc * 2; return st * 1024 + (ob ^ (((ob >> 9) & 1) << 5)); }
__host__ __device__ __forceinline__ void stage_rc(int b, int& R, int& C) { const int st = b / 1024, sb = b % 1024, swz = sb ^ (((sb >> 9) & 1) << 5); R = (st >> 1) * 16 + swz / 64; C = (st & 1) * 32 + (swz % 64) / 2; }

struct Unit { int pm, pn; const char* A; const char* B; int aux; };
struct Cfg { unsigned lda; unsigned kstepA; unsigned ldb; int nt; const int* rowidx; };

struct DenseOrder {
    int nM, nN, nwg, G, c; const char* A; const char* B; size_t tstepA, tstepB;
    __device__ void init(int nM_, int nN_, int G_, int c_, const void* A_, size_t tstepA_, const void* B_, size_t tstepB_) { nM = nM_; nN = nN_; nwg = nM * nN; G = G_; c = c_; A = (const char*)A_; B = (const char*)B_; tstepA = tstepA_; tstepB = tstepB_; }
    __device__ bool next(int i, Unit& u) const {
        const long Lq = (long)i * G + c; if (Lq >= nwg) return false;
        int wgid = (int)Lq; { const int q = nwg / 8, r = nwg % 8, xcd = wgid % 8, off = wgid / 8; wgid = (xcd < r ? xcd * (q + 1) : r * (q + 1) + (xcd - r) * q) + off; }
        const int nig = 8 * nN, gid = wgid / nig, fm = gid * 8, gsz = (nM - fm) < 8 ? (nM - fm) : 8;
        u.pm = fm + ((wgid % nig) % gsz); u.pn = (wgid % nig) / gsz; u.A = A + (size_t)u.pm * tstepA; u.B = B + (size_t)u.pn * tstepB; u.aux = 0; return true;
    }
};

#define PG8_EPI_ROWCOL(row, col) const int row = u.pm * 256 + ai * 128 + wr * 64 + m * 16 + fr; const int col = u.pn * 256 + bj * 128 + wc * 32 + n * 16 + fq * 4;

template <bool INDEXED, class Epi, class Sched>
__device__ __forceinline__ void gemm_phase(LAS unsigned char* lds, int wid, const Cfg g, const Sched& S, const Epi& E) {
    int lane_; asm volatile("v_mbcnt_lo_u32_b32 %0, -1, 0\n\tv_mbcnt_hi_u32_b32 %0, -1, %0" : "=v"(lane_));
    const int lane = lane_, tid = wid * 64 + lane, wr = wid >> 2, wc = wid & 3, fr = lane & 15, fq = lane >> 4;
    const int nt = g.nt;
    int Rs[2], Cs[2]; unsigned voffB[2];
#pragma unroll
    for (int i = 0; i < 2; ++i) { stage_rc(tid * 16 + i * 8192, Rs[i], Cs[i]); voffB[i] = (unsigned)Rs[i] * g.ldb + (unsigned)Cs[i] * 2u; }
    const size_t kstepA = g.kstepA, kstepB = (size_t)(BK * 2);
    const size_t hstepB = (size_t)HALF * g.ldb;
    const unsigned ldsw = (unsigned)wid * 1024u;
    const int aoff = lds_byte(wr * 64 + fr, fq * 8), boff = lds_byte(wc * 32 + fr, fq * 8);
#define PG8_SA(b, h) (((b) * 2 + (h)) * HTB)
#define PG8_SB(b, h) ((4 + (b) * 2 + (h)) * HTB)
#define PG8_STAGE2(bufoff, gbase, v0, v1) do { const char* gb_ = (const char*)(gbase); asm volatile("" : "+s"(gb_)); \
        __builtin_amdgcn_global_load_lds((const unsigned*)(gb_ + (v0)), (LAS unsigned*)(lds + (bufoff) + ldsw), 16, 0, 0); \
        __builtin_amdgcn_global_load_lds((const unsigned*)(gb_ + (v1)), (LAS unsigned*)(lds + (bufoff) + ldsw + 8192), 16, 0, 0); } while (0)
#define PG8_STAGEB(bufoff, gbase) PG8_STAGE2(bufoff, gbase, voffB[0], voffB[1])
#define PG8_LDA(dst, b, h) do { _Pragma("unroll") for (int m = 0; m < 4; ++m) _Pragma("unroll") for (int k = 0; k < 2; ++k) dst[m][k] = *(const LAS bf16x8*)(lds + PG8_SA(b, h) + aoff + m * 2048 + k * 1024); } while (0)
#define PG8_LDB(dst, b, h) do { _Pragma("unroll") for (int n = 0; n < 2; ++n) _Pragma("unroll") for (int k = 0; k < 2; ++k) dst[n][k] = *(const LAS bf16x8*)(lds + PG8_SB(b, h) + boff + n * 2048 + k * 1024); } while (0)
#define PG8_MMA(ai, bj, At, Bt) do { __builtin_amdgcn_s_setprio(1); _Pragma("unroll") for (int m = 0; m < 4; ++m) _Pragma("unroll") for (int n = 0; n < 2; ++n) _Pragma("unroll") for (int k = 0; k < 2; ++k) \
        acc[ai][bj][m][n] = __builtin_amdgcn_mfma_f32_16x16x32_bf16(Bt[n][k], At[m][k], acc[ai][bj][m][n], 0, 0, 0); __builtin_amdgcn_s_setprio(0); } while (0)
#define PG8_WAIT_V(n) asm volatile("s_waitcnt vmcnt(" #n ")" ::: "memory")
#define PG8_WAIT_L(n) asm volatile("s_waitcnt lgkmcnt(" #n ")" ::: "memory")
#define PG8_BAR __builtin_amdgcn_s_barrier()
#define PG8_SCHED __builtin_amdgcn_sched_barrier(0)
    Unit cur, nxt; int ui = 0;
    if (!S.next(0, cur)) return;
    unsigned vAc[2][2], vAn[2][2];
#define PG8_SETVA(v, U) do { _Pragma("unroll") for (int h_ = 0; h_ < 2; ++h_) _Pragma("unroll") for (int i_ = 0; i_ < 2; ++i_) { \
        if constexpr (INDEXED) { const int r_ = g.rowidx[(U).aux + h_ * HALF + Rs[i_]]; v[h_][i_] = (unsigned)r_ * g.lda + (unsigned)Cs[i_] * 2u; } \
        else v[h_][i_] = (unsigned)(h_ * HALF + Rs[i_]) * g.lda + (unsigned)Cs[i_] * 2u; } } while (0)
    PG8_SETVA(vAc, cur);
    f32x4 acc[2][2][4][2];
#pragma unroll
    for (int a = 0; a < 2; ++a)
#pragma unroll
        for (int b = 0; b < 2; ++b)
#pragma unroll
            for (int m = 0; m < 4; ++m)
#pragma unroll
                for (int n = 0; n < 2; ++n) acc[a][b][m][n] = (f32x4){0.f, 0.f, 0.f, 0.f};
    bf16x8 At[4][2], B0[2][2], B1[2][2];
    const char* cA = cur.A; const char* cB = cur.B;
    PG8_STAGEB(PG8_SB(0, 0), cB); PG8_STAGEB(PG8_SB(0, 1), cB + hstepB); PG8_STAGE2(PG8_SA(0, 0), cA, vAc[0][0], vAc[0][1]); PG8_STAGE2(PG8_SA(0, 1), cA, vAc[1][0], vAc[1][1]);
    if (wr == 1) PG8_BAR;
    PG8_WAIT_V(2); PG8_BAR;
    PG8_STAGEB(PG8_SB(1, 0), cB + kstepB); PG8_STAGE2(PG8_SA(1, 0), cA + kstepA, vAc[0][0], vAc[0][1]); PG8_STAGEB(PG8_SB(1, 1), cB + hstepB + kstepB);
    PG8_WAIT_V(6); PG8_BAR;
    for (;;) {
        const bool has_next = S.next(ui + 1, nxt);
        const char* nA = has_next ? nxt.A : cA; const char* nB = has_next ? nxt.B : cB;
        if (has_next) { PG8_SETVA(vAn, nxt); } else {
#pragma unroll
            for (int h_ = 0; h_ < 2; ++h_)
#pragma unroll
                for (int i_ = 0; i_ < 2; ++i_) vAn[h_][i_] = vAc[h_][i_]; }
        for (int t = 0; t < nt; t += 2) {
            const bool last = (t == nt - 2);
            const char* a1 = cA + (size_t)(t + 1) * kstepA;
            const char* a2 = last ? nA : cA + (size_t)(t + 2) * kstepA; const char* b2 = last ? nB : cB + (size_t)(t + 2) * kstepB;
            const char* a3 = a2 + kstepA; const char* b3 = b2 + kstepB;
            const unsigned w00 = last ? vAn[0][0] : vAc[0][0], w01 = last ? vAn[0][1] : vAc[0][1], w10 = last ? vAn[1][0] : vAc[1][0], w11 = last ? vAn[1][1] : vAc[1][1];
            PG8_LDB(B0, 0, 0); PG8_LDB(B1, 0, 1); PG8_SCHED; PG8_LDA(At, 0, 0); PG8_STAGE2(PG8_SA(1, 1), a1, vAc[1][0], vAc[1][1]);
            PG8_WAIT_V(8); PG8_WAIT_L(0); PG8_BAR; PG8_MMA(0, 0, At, B0); PG8_MMA(0, 1, At, B1); PG8_BAR; PG8_SCHED;
            PG8_LDA(At, 0, 1); PG8_STAGEB(PG8_SB(0, 0), b2); PG8_STAGEB(PG8_SB(0, 1), b2 + hstepB); PG8_STAGE2(PG8_SA(0, 0), a2, w00, w01);
            PG8_WAIT_V(8); PG8_WAIT_L(0); PG8_BAR; PG8_MMA(1, 0, At, B0); PG8_MMA(1, 1, At, B1); PG8_BAR; PG8_SCHED;
            PG8_LDB(B0, 1, 0); PG8_LDB(B1, 1, 1); PG8_SCHED; PG8_LDA(At, 1, 0); PG8_STAGE2(PG8_SA(0, 1), a2, w10, w11);
            PG8_WAIT_V(8); PG8_WAIT_L(0); PG8_BAR; PG8_MMA(0, 0, At, B0); PG8_MMA(0, 1, At, B1); PG8_BAR; PG8_SCHED;
            PG8_LDA(At, 1, 1); PG8_STAGEB(PG8_SB(1, 0), b3); PG8_STAGEB(PG8_SB(1, 1), b3 + hstepB); PG8_STAGE2(PG8_SA(1, 0), a3, w00, w01);
            PG8_WAIT_V(8); PG8_WAIT_L(0); PG8_BAR; PG8_MMA(1, 0, At, B0); PG8_MMA(1, 1, At, B1); PG8_BAR; PG8_SCHED;
        }
        { int l2_; asm volatile("v_mbcnt_lo_u32_b32 %0, -1, 0\n\tv_mbcnt_hi_u32_b32 %0, -1, %0" : "=v"(l2_)); E(acc, cur, wr, wc, l2_ & 15, l2_ >> 4); }
        if (!has_next) break;
#pragma unroll
        for (int a = 0; a < 2; ++a)
#pragma unroll
            for (int b = 0; b < 2; ++b)
#pragma unroll
                for (int m = 0; m < 4; ++m)
#pragma unroll
                    for (int n = 0; n < 2; ++n) acc[a][b][m][n] = (f32x4){0.f, 0.f, 0.f, 0.f};
        cur = nxt; cA = nA; cB = nB; ++ui;
#pragma unroll
        for (int h_ = 0; h_ < 2; ++h_)
#pragma unroll
            for (int i_ = 0; i_ < 2; ++i_) vAc[h_][i_] = vAn[h_][i_];
    }
    PG8_WAIT_V(0);
    if (wr == 0) PG8_BAR;
    PG8_BAR;
#undef PG8_SA
#undef PG8_SB
#undef PG8_STAGE2
#undef PG8_STAGEB
#undef PG8_LDA
#undef PG8_LDB
#undef PG8_MMA
#undef PG8_WAIT_V
#undef PG8_WAIT_L
#undef PG8_BAR
#undef PG8_SCHED
#undef PG8_SETVA
}
}

constexpr int LDS_MISC = 131072;
constexpr int LDS_MOETAB = LDS_MISC + 64;
constexpr int LDS_INTAB = LDS_MISC + 512;
struct Ctx {
    float* out; unsigned char* ws; unsigned char* ws0;
    LAS unsigned char* lds;
    int tid, lane, wave, G, bid;
    __device__ __forceinline__ const void* inp(int i) const { const LAS unsigned* p = (const LAS unsigned*)(lds + LDS_INTAB) + 2 * i;
        const unsigned lo = (unsigned)__builtin_amdgcn_readfirstlane((int)p[0]), hi = (unsigned)__builtin_amdgcn_readfirstlane((int)p[1]); return (const void*)(const __attribute__((address_space(1))) char*)(((unsigned long long)hi << 32) | lo); }
    __device__ __forceinline__ const float* x() const { return (const float*)inp(0); }
    __device__ __forceinline__ const int* pos() const { return (const int*)inp(1); }
    __device__ __forceinline__ const float* rel_bias() const { return (const float*)inp(2); }
    __device__ __forceinline__ const float* norm_attn() const { return (const float*)inp(3); }
    __device__ __forceinline__ const float* w_in() const { return (const float*)inp(4); }
    __device__ __forceinline__ const float* b_merge() const { return (const float*)inp(5); }
    __device__ __forceinline__ const float* cmp_pe() const { return (const float*)inp(6); }
    __device__ __forceinline__ const float* cmp_k_w1() const { return (const float*)inp(7); }
    __device__ __forceinline__ const float* cmp_k_b1() const { return (const float*)inp(8); }
    __device__ __forceinline__ const float* cmp_k_w2() const { return (const float*)inp(9); }
    __device__ __forceinline__ const float* cmp_v_w1() const { return (const float*)inp(10); }
    __device__ __forceinline__ const float* cmp_v_b1() const { return (const float*)inp(11); }
    __device__ __forceinline__ const float* cmp_v_w2() const { return (const float*)inp(12); }
    __device__ __forceinline__ const float* mla_q_norm() const { return (const float*)inp(13); }
    __device__ __forceinline__ const float* mla_kv_norm() const { return (const float*)inp(14); }
    __device__ __forceinline__ const float* mla_w_uq() const { return (const float*)inp(15); }
    __device__ __forceinline__ const float* mla_w_uk() const { return (const float*)inp(16); }
    __device__ __forceinline__ const float* mla_w_uv() const { return (const float*)inp(17); }
    __device__ __forceinline__ const float* fox_b_f() const { return (const float*)inp(18); }
    __device__ __forceinline__ const float* w_o_nsa() const { return (const float*)inp(19); }
    __device__ __forceinline__ const float* w_o_mla() const { return (const float*)inp(20); }
    __device__ __forceinline__ const float* w_o_fox() const { return (const float*)inp(21); }
    __device__ __forceinline__ const float* w_out() const { return (const float*)inp(22); }
    __device__ __forceinline__ const float* norm_ffn() const { return (const float*)inp(23); }
    __device__ __forceinline__ const float* moe_w_grp() const { return (const float*)inp(24); }
    __device__ __forceinline__ const float* moe_b_grp() const { return (const float*)inp(25); }
    __device__ __forceinline__ const float* moe_w_router() const { return (const float*)inp(26); }
    __device__ __forceinline__ const float* moe_b_router() const { return (const float*)inp(27); }
    __device__ __forceinline__ const float* moe_w_gate() const { return (const float*)inp(28); }
    __device__ __forceinline__ const float* moe_w_up() const { return (const float*)inp(29); }
    __device__ __forceinline__ const float* moe_w_down() const { return (const float*)inp(30); }
    __device__ __forceinline__ const float* norm_final() const { return (const float*)inp(31); }
};
#define WSP(T_, off) ((T_*)(c.ws + (off)))
__device__ __forceinline__ int lane_id_volatile() { int ln; asm volatile("v_mbcnt_lo_u32_b32 %0, -1, 0\n\tv_mbcnt_hi_u32_b32 %0, -1, %0" : "=v"(ln)); return ln; }
__device__ __forceinline__ void relaunder(Ctx& c) { const int ln = lane_id_volatile(); c.lane = ln; c.tid = c.wave * 64 + ln;
    size_t z_ = 0; asm volatile("" : "+s"(z_)); c.ws = c.ws0 + z_; int g_ = c.G, b_ = c.bid, wv_ = c.wave; asm volatile("" : "+s"(g_), "+s"(b_), "+s"(wv_)); c.G = g_; c.bid = b_; c.wave = wv_; }

template <class Map>
__device__ __forceinline__ void transpose_item(const float* W, int ldw, int K, bf16_t* WT, const float* rowscale, Map srcmap, int nblk, LAS float* scr, int item, int lane, float colscale = 1.f) {
    const int kb = item / nblk, nb = item % nblk, k0 = 64 * kb, n0 = 32 * nb;
    const int sc = srcmap(n0 + (lane & 31));
    const int cc = lane & 7;
    float rsc[8];
#pragma unroll
    for (int i = 0; i < 8; ++i) rsc[i] = rowscale ? rowscale[k0 + 8 * cc + i] * colscale : colscale;
    float v[32];
    const float* wp = W + (size_t)(k0 + (lane >> 5)) * ldw + (sc >= 0 ? sc : 0);
#pragma unroll
    for (int i = 0; i < 32; ++i) v[i] = wp[(size_t)(2 * i) * ldw];
    __builtin_amdgcn_sched_barrier(0);
#pragma unroll
    for (int i = 0; i < 32; ++i) scr[(2 * i + (lane >> 5)) * 33 + (lane & 31)] = (sc >= 0) ? v[i] : 0.f;
    LDS_WAIT(); asm volatile("" ::: "memory");
#pragma unroll
    for (int j = 0; j < 4; ++j) { const int n = (lane >> 3) + 8 * j; const LAS float* s = scr + (8 * cc) * 33 + n;
        u32x4 o; o.x = cvtpk(s[0 * 33] * rsc[0], s[1 * 33] * rsc[1]); o.y = cvtpk(s[2 * 33] * rsc[2], s[3 * 33] * rsc[3]); o.z = cvtpk(s[4 * 33] * rsc[4], s[5 * 33] * rsc[5]); o.w = cvtpk(s[6 * 33] * rsc[6], s[7 * 33] * rsc[7]);
        *(u32x4*)(WT + (size_t)(n0 + n) * K + k0 + 8 * cc) = o; }
    LDS_WAIT(); asm volatile("" ::: "memory");
}
struct MapId { int off; __device__ int operator()(int n) const { return n + off; } };
struct MapInproj { __device__ int operator()(int n) const { if (n < 1280) return n; if (n < 1696) return n + 24; if (n < 1720) return n - 416; if (n < 1728) return n + 1536; if (n < 3264) return n - 8; return -1; } };
struct MapUq { __device__ int operator()(int n) const { if (n < 512) return (n >> 6) * 96 + (n & 63); const int r = n - 512; return (r >> 5) * 96 + 64 + (r & 31); } };
struct MapPad128 { __device__ int operator()(int n) const { return n < 128 ? n : -1; } };
struct MapGU { __device__ int operator()(int n) const { return (n >> 8) * 128 + (n & 127); } };

__device__ __forceinline__ int rel_bucket_dev(int n) {
    if (n < 16) return n;
    const float lr = __logf((float)n / 16.f) / 2.0794415416798357f;
    int large = 16 + (int)(lr * 16.f);
    return large < 31 ? large : 31;
}

__device__ __forceinline__ void phase_prologue(const Ctx& c) {
    LAS float* scr = (LAS float*)(c.lds + c.wave * 16384);
    const int gw = c.bid * NWAVES + c.wave, NGW = c.G * NWAVES;
    constexpr int I_WIN = 16 * (P1W / 32), I_WM = 16 * 96, I_UQ = 4 * 24, I_UK = 2 * 16, I_UV = 2 * 16, I_WO = 8 * 32, I_WOUT = 16 * 32, I_C1 = 32 * 8;
    constexpr int PER_L = I_WIN + I_WM + I_UQ + I_UK + I_UV + 3 * I_WO + I_WOUT + 2 * I_C1;
    for (int it = gw; it < NL * PER_L; it += NGW) {
        const int l = it / PER_L; int r = it % PER_L;
        if (r < I_WIN) { const int n0_ = 32 * (r % (P1W / 32)); const float cs_ = (n0_ < 512 || (n0_ >= C_FQKV && n0_ < C_FQKV + 512)) ? QSCALE64 : 1.f;
            transpose_item(c.w_in() + (size_t)l * D * DIN, DIN, D, WSP(bf16_t, WS_WINT) + (size_t)l * P1W * D, c.norm_attn() + l * D, MapInproj{}, P1W / 32, scr, r, c.lane, cs_); continue; } r -= I_WIN;
        if (r < I_WM) { transpose_item(c.w_in() + (size_t)l * D * DIN, DIN, D, WSP(bf16_t, WS_WMT) + (size_t)l * 3072 * D, c.norm_attn() + l * D, MapId{3264}, 96, scr, r, c.lane); continue; } r -= I_WM;
        if (r < I_UQ) { transpose_item(c.mla_w_uq() + (size_t)l * 256 * 768, 768, 256, WSP(bf16_t, WS_WUQT) + (size_t)l * 768 * 256, c.mla_q_norm() + l * 256, MapUq{}, 24, scr, r, c.lane, QSCALE96); continue; } r -= I_UQ;
        if (r < I_UK) { transpose_item(c.mla_w_uk() + (size_t)l * 128 * 512, 512, 128, WSP(bf16_t, WS_WUKVT) + (size_t)l * 1024 * 128, c.mla_kv_norm() + l * 128, MapId{0}, 16, scr, r, c.lane); continue; } r -= I_UK;
        if (r < I_UV) { transpose_item(c.mla_w_uv() + (size_t)l * 128 * 512, 512, 128, WSP(bf16_t, WS_WUKVT) + (size_t)l * 1024 * 128 + 512 * 128, c.mla_kv_norm() + l * 128, MapId{0}, 16, scr, r, c.lane); continue; } r -= I_UV;
        if (r < I_WO) { transpose_item(c.w_o_nsa() + (size_t)l * 512 * 1024, 1024, 512, WSP(bf16_t, WS_WOT) + ((size_t)l * 3 + 0) * 1024 * 512, nullptr, MapId{0}, 32, scr, r, c.lane); continue; } r -= I_WO;
        if (r < I_WO) { transpose_item(c.w_o_mla() + (size_t)l * 512 * 1024, 1024, 512, WSP(bf16_t, WS_WOT) + ((size_t)l * 3 + 1) * 1024 * 512, nullptr, MapId{0}, 32, scr, r, c.lane); continue; } r -= I_WO;
        if (r < I_WO) { transpose_item(c.w_o_fox() + (size_t)l * 512 * 1024, 1024, 512, WSP(bf16_t, WS_WOT) + ((size_t)l * 3 + 2) * 1024 * 512, nullptr, MapId{0}, 32, scr, r, c.lane); continue; } r -= I_WO;
        if (r < I_WOUT) { transpose_item(c.w_out() + (size_t)l * D * D, D, D, WSP(bf16_t, WS_WOUTT) + (size_t)l * D * D, nullptr, MapId{0}, 32, scr, r, c.lane); continue; } r -= I_WOUT;
        { const int kv = r / I_C1; const float* w = (kv == 0 ? c.cmp_k_w1() : c.cmp_v_w1()) + (size_t)l * 2048 * 128;
          transpose_item(w, 128, 2048, WSP(bf16_t, WS_WC1T) + ((size_t)l * 2 + kv) * 256 * 2048, nullptr, MapPad128{}, 8, scr, r % I_C1, c.lane); }
    }
    { float* rc = WSP(float, WS_ROPE); float* rs = rc + (size_t)M * 16;
      for (int i = c.bid * NTHREADS + c.tid; i < M * 16; i += c.G * NTHREADS) { const int m = i >> 4, j = i & 15;
          const float inv = exp2f(-(float)j * 0.8304820237218407f);   const float ang = (float)c.pos()[m] * inv; double rev = (double)ang * 0.15915494309189535; rev -= floor(rev); const float fr_ = (float)rev; rc[i] = __builtin_amdgcn_cosf(fr_); rs[i] = __builtin_amdgcn_sinf(fr_); } }
    float* tab = WSP(float, WS_TAB);
    if (c.bid == 0) {
        const int l = c.tid >> 8, kv = (c.tid >> 7) & 1, j = c.tid & 127;
        const float* w1 = (kv == 0 ? c.cmp_k_w1() : c.cmp_v_w1()) + (size_t)l * 2048 * 128; const float* b1 = (kv == 0 ? c.cmp_k_b1() : c.cmp_v_b1()) + l * 128; const float* pe = c.cmp_pe() + l * 2048;
        float s = b1[j]; for (int k = 0; k < 2048; ++k) s += pe[k] * w1[(size_t)k * 128 + j];
        tab[c.tid] = s;
    }
    if (c.bid == 1 % c.G) {
        for (int i = c.tid; i < 8 * 129; i += NTHREADS) { const int h = i / 129, d = i % 129; tab[512 + h * 132 + d] = c.rel_bias()[rel_bucket_dev(d) * 8 + h] * LOG2E; }
    }
}

__device__ __forceinline__ void phase_norm(const Ctx& c, const float* src, const bf16_t* y0, const bf16_t* y1, float* rout, bf16_t* hout) {
    const int gw = c.bid * NWAVES + c.wave, NGW = c.G * NWAVES;
    for (int m = gw; m < M; m += NGW) {
        const f32x4* xr = (const f32x4*)(src + (size_t)m * D) + c.lane;
        f32x4 v[4]; float s = 0.f;
#pragma unroll
        for (int j = 0; j < 4; ++j) { v[j] = xr[64 * j];
            if (y0) { const u32x2 a = *((const u32x2*)(y0 + (size_t)m * D) + c.lane + 64 * j); const u32x2 b = *((const u32x2*)(y1 + (size_t)m * D) + c.lane + 64 * j);
                v[j].x += __uint_as_float(a.x << 16) + __uint_as_float(b.x << 16); v[j].y += __uint_as_float(a.x & 0xffff0000u) + __uint_as_float(b.x & 0xffff0000u);
                v[j].z += __uint_as_float(a.y << 16) + __uint_as_float(b.y << 16); v[j].w += __uint_as_float(a.y & 0xffff0000u) + __uint_as_float(b.y & 0xffff0000u); }
            s += (v[j].x * v[j].x + v[j].y * v[j].y) + (v[j].z * v[j].z + v[j].w * v[j].w); }
        const float rstd = rsqrtf(wave_sum(s) * (1.f / D) + EPS);
        if (rout) { f32x4* ro = (f32x4*)(rout + (size_t)m * D) + c.lane;
#pragma unroll
            for (int j = 0; j < 4; ++j) ro[64 * j] = v[j]; }
        u32x2* o8 = (u32x2*)(hout + (size_t)m * D) + c.lane;
#pragma unroll
        for (int j = 0; j < 4; ++j) { u32x2 w; w.x = pk2(v[j].x * rstd, v[j].y * rstd); w.y = pk2(v[j].z * rstd, v[j].w * rstd); o8[64 * j] = w; }
    }
}
__device__ __forceinline__ void phase_final(const Ctx& c) {
    const int gw = c.bid * NWAVES + c.wave, NGW = c.G * NWAVES;
    const float* src = WSP(float, WS_XA); const bf16_t* y0 = WSP(bf16_t, WS_Y); const bf16_t* y1 = y0 + (size_t)M * D;
    for (int m = gw; m < M; m += NGW) {
        const f32x4* xr = (const f32x4*)(src + (size_t)m * D) + c.lane;
        f32x4 v[4]; float s = 0.f;
#pragma unroll
        for (int j = 0; j < 4; ++j) { v[j] = xr[64 * j];
            const u32x2 a = *((const u32x2*)(y0 + (size_t)m * D) + c.lane + 64 * j); const u32x2 b = *((const u32x2*)(y1 + (size_t)m * D) + c.lane + 64 * j);
            v[j].x += __uint_as_float(a.x << 16) + __uint_as_float(b.x << 16); v[j].y += __uint_as_float(a.x & 0xffff0000u) + __uint_as_float(b.x & 0xffff0000u);
            v[j].z += __uint_as_float(a.y << 16) + __uint_as_float(b.y << 16); v[j].w += __uint_as_float(a.y & 0xffff0000u) + __uint_as_float(b.y & 0xffff0000u);
            s += (v[j].x * v[j].x + v[j].y * v[j].y) + (v[j].z * v[j].z + v[j].w * v[j].w); }
        const float rstd = rsqrtf(wave_sum(s) * (1.f / D) + EPS);
        f32x4* ro = (f32x4*)(c.out + (size_t)m * D) + c.lane;
#pragma unroll
        for (int j = 0; j < 4; ++j) { const f32x4 g = *((const f32x4*)c.norm_final() + c.lane + 64 * j); ro[64 * j] = v[j] * rstd * g; }
    }
}

constexpr size_t WS_LC = WS_LF, WS_CT = WS_CUM, WS_CP = WS_CUM + 64 * 1024;
__device__ __forceinline__ void phase_prep(const Ctx& c, int l, int cbid, int cG) {
    const bf16_t* P1 = WSP(bf16_t, WS_P1); float* rstd = WSP(float, WS_RSTD); bf16_t* KR = WSP(bf16_t, WS_KR); float* LC = WSP(float, WS_LC); float* CT = WSP(float, WS_CT);
    const float* rc = WSP(float, WS_ROPE); const float* rs = rc + (size_t)M * 16;
    float kmx0 = 0.f, kmx1 = 0.f;
    LAS unsigned* kml = (LAS unsigned*)(c.lds + 4096); LAS float* wt = (LAS float*)(c.lds + 4096 + 64);
    if (c.tid < 16) kml[c.tid] = 0u;
    __syncthreads();
    const float bf_ = (c.lane < 8) ? c.fox_b_f()[l * 8 + c.lane] : 0.f;
    for (int ch = cbid; ch < M / 64; ch += cG) {
        float run = 0.f, rv[8];
#pragma unroll
        for (int i = 0; i < 8; ++i) { const int m = ch * 64 + c.wave * 8 + i;
            const bf16_t* row = P1 + (size_t)m * P1W;
            const u32x2 a = *((const u32x2*)(row + C_CQ) + c.lane);
            const unsigned b = *((const unsigned*)(row + C_CKV) + c.lane);
            const u32x4 kq = *((const u32x4*)(row + C_FQKV + 512) + c.lane);
            const float x1 = (c.lane < 16) ? bf2f(row[C_KR + c.lane]) : 0.f, x2 = (c.lane < 16) ? bf2f(row[C_KR + 16 + c.lane]) : 0.f;
            const float cs = (c.lane < 16) ? rc[m * 16 + c.lane] : 0.f, sn = (c.lane < 16) ? rs[m * 16 + c.lane] : 0.f;
            const float ff = (c.lane < 8) ? bf2f(row[C_FF + c.lane]) : 0.f;
            float q0 = __uint_as_float(a.x << 16), q1 = __uint_as_float(a.x & 0xffff0000u), q2 = __uint_as_float(a.y << 16), q3 = __uint_as_float(a.y & 0xffff0000u);
            const float sq = wave_sum(q0 * q0 + q1 * q1 + q2 * q2 + q3 * q3);
            float k0 = __uint_as_float(b << 16), k1 = __uint_as_float(b & 0xffff0000u);
            const float sk = wave_sum(k0 * k0 + k1 * k1);
            if (c.lane == 0) { rstd[2 * m] = rsqrtf(sq * (1.f / 256.f) + EPS); rstd[2 * m + 1] = rsqrtf(sk * (1.f / 128.f) + EPS); }
            if (c.lane < 16) { KR[m * 32 + c.lane] = (bf16_t)f2bf(x1 * cs - x2 * sn); KR[m * 32 + 16 + c.lane] = (bf16_t)f2bf(x1 * sn + x2 * cs); }
            { const f32x4 a0 = unpk4((u32x2){kq.x, kq.y}), a1 = unpk4((u32x2){kq.z, kq.w});
              float ss = (a0.x * a0.x + a0.y * a0.y) + (a0.z * a0.z + a0.w * a0.w) + (a1.x * a1.x + a1.y * a1.y) + (a1.z * a1.z + a1.w * a1.w);
              ss += dpp_f<0xB1>(ss); ss += dpp_f<0x4E>(ss); ss += dpp_f<0x141>(ss);
              if (m < T) kmx0 = fmaxf(kmx0, ss); else kmx1 = fmaxf(kmx1, ss); }
            const float f = ff + bf_;
            const float ls = fminf(f, 0.f) - __logf(1.f + __expf(-fabsf(f)));
            run += ls; rv[i] = run; }
        if (c.lane < 8) wt[c.wave * 8 + c.lane] = run;
        __syncthreads();
        if (c.lane < 8) { float pre = 0.f; for (int w_ = 0; w_ < c.wave; ++w_) pre += wt[w_ * 8 + c.lane];
            const int m0 = ch * 64 + c.wave * 8, bb = m0 / T, t0 = m0 % T; float* lc = LC + ((size_t)bb * 8 + c.lane) * T + t0;
#pragma unroll
            for (int i = 0; i < 8; ++i) lc[i] = (pre + rv[i]) * LOG2E;
            if (c.wave == 7) CT[((size_t)bb * 8 + c.lane) * 128 + (t0 >> 6)] = (pre + run) * LOG2E; }
        __syncthreads();
    }
    if ((c.lane & 7) == 0) { atomicMax((unsigned*)(kml + (c.lane >> 3)), __float_as_uint(kmx0)); atomicMax((unsigned*)(kml + 8 + (c.lane >> 3)), __float_as_uint(kmx1)); }
    __syncthreads();
    if (c.tid < 16) atomicMax(WSP(unsigned, WS_CTL) + CW_KMAX + l * 16 + c.tid, kml[c.tid]);
}
__device__ __forceinline__ void phase_chunk_prefix(const Ctx& c) {
    LAS float* sh = (LAS float*)(c.lds + 8192);
    for (int s_ = c.bid; s_ < NB * 8; s_ += c.G) {
        if (c.tid < 128) sh[c.tid] = WSP(float, WS_CT)[(size_t)s_ * 128 + c.tid];
        __syncthreads();
        if (c.tid == 0) { float run = 0.f; float* cp = WSP(float, WS_CP) + (size_t)s_ * 129; for (int i = 0; i < 128; ++i) { cp[i] = run; run += sh[i]; } cp[128] = run; }
        __syncthreads();
    }
}
__device__ __forceinline__ void phase_cmp2(const Ctx& c, int l) {
    const float* SL = WSP(float, WS_SL); const float* bc1 = WSP(float, WS_TAB) + l * 256;
    LAS float* hl = (LAS float*)(c.lds + c.wave * 1024);
    for (int pr = c.bid * NWAVES + c.wave; pr < 2 * 2048; pr += c.G * NWAVES) {
        const int kv = pr >> 11, row = pr & 2047, d = c.lane;
        const float* w2 = (kv == 0 ? c.cmp_k_w2() : c.cmp_v_w2()) + (size_t)l * 128 * 64 + d;
        const float* s0 = SL + ((size_t)kv * 2048 + row) * 128; const float* s1 = s0 + (size_t)2 * 2048 * 128;
        const float a0 = s0[d], a1 = s0[d + 64], b0 = s1[d], b1 = s1[d + 64], c0 = bc1[kv * 128 + d], c1 = bc1[kv * 128 + d + 64];
        hl[d] = gelu_tanh(a0 + b0 + c0); hl[d + 64] = gelu_tanh(a1 + b1 + c1);
        LDS_WAIT(); asm volatile("" ::: "memory");
        float s = 0.f;
#pragma unroll
        for (int jb = 0; jb < 4; ++jb) { float wv[32];
#pragma unroll
            for (int i = 0; i < 32; ++i) wv[i] = w2[(size_t)(32 * jb + i) * 64];
            __builtin_amdgcn_sched_barrier(0);
#pragma unroll
            for (int i = 0; i < 32; ++i) s += hl[32 * jb + i] * wv[i]; }
        if ((row & 511) == 511) s = 0.f;
        (kv == 0 ? WSP(bf16_t, WS_KC) : WSP(bf16_t, WS_VC))[(size_t)row * 64 + d] = (bf16_t)f2bf(s);
        LDS_WAIT(); asm volatile("" ::: "memory");
    }
}
__device__ __forceinline__ u32x2 pk4(f32x4 v) { u32x2 w; w.x = cvtpk(v.x, v.y); w.y = cvtpk(v.z, v.w); return w; }
#define EPI_ARGS const f32x4 (&acc)[2][2][4][2], const pg8::Unit& u, int wr, int wc, int fr, int fq
#define EPI_LOOP _Pragma("unroll") for (int ai = 0; ai < 2; ++ai) _Pragma("unroll") for (int m = 0; m < 4; ++m) _Pragma("unroll") for (int bj = 0; bj < 2; ++bj) _Pragma("unroll") for (int n = 0; n < 2; ++n)

#define EPI_ROW(ai, m) (u.pm * 256 + (ai) * 128 + wr * 64 + (m) * 16 + fr)
#define EPI_COL(bj, n) (u.pn * 256 + (bj) * 128 + wc * 32 + (n) * 16 + fq * 4)
struct EpiStoreBf16 { bf16_t* O; int ldc; const float* rowscale; int rs_stride;
    __device__ __forceinline__ void operator()(EPI_ARGS) const {
        float rs[2][4];
#pragma unroll
        for (int ai = 0; ai < 2; ++ai)
#pragma unroll
            for (int m = 0; m < 4; ++m) rs[ai][m] = rowscale ? rowscale[(size_t)EPI_ROW(ai, m) * rs_stride] : 1.f;
        __builtin_amdgcn_sched_barrier(0);
        EPI_LOOP { const unsigned off = (unsigned)EPI_ROW(ai, m) * (unsigned)ldc + (unsigned)EPI_COL(bj, n); *(u32x2*)(O + off) = pk4(acc[ai][bj][m][n] * rs[ai][m]); } } };
struct EpiUqRope { bf16_t* QB; const float* rstd; const float* ropec; const float* ropes;
    __device__ __forceinline__ void operator()(EPI_ARGS) const {
#pragma unroll
        for (int ai = 0; ai < 2; ++ai) { float rs[4]; f32x4 cs4[4], sn4[4];
#pragma unroll
            for (int m = 0; m < 4; ++m) { const unsigned row = (unsigned)EPI_ROW(ai, m); rs[m] = rstd[(size_t)row * 2]; cs4[m] = *(const f32x4*)(ropec + row * 16u + fq * 4); sn4[m] = *(const f32x4*)(ropes + row * 16u + fq * 4); }
            __builtin_amdgcn_sched_barrier(0);
#pragma unroll
            for (int m = 0; m < 4; ++m)
#pragma unroll
                for (int bj = 0; bj < 2; ++bj) { const f32x4 x1 = acc[ai][bj][m][0] * rs[m], x2 = acc[ai][bj][m][1] * rs[m];
                    const f32x4 o1 = x1 * cs4[m] - x2 * sn4[m], o2 = x1 * sn4[m] + x2 * cs4[m];
                    const unsigned off = (unsigned)EPI_ROW(ai, m) * 768u + (unsigned)EPI_COL(bj, 0);
                    *(u32x2*)(QB + off) = pk4(o1); *(u32x2*)(QB + off + 16) = pk4(o2); }
            __builtin_amdgcn_sched_barrier(0); } } };
struct EpiGates { bf16_t* O; const float* bias;
    __device__ __forceinline__ void operator()(EPI_ARGS) const {
        f32x4 bv[2][2];
#pragma unroll
        for (int bj = 0; bj < 2; ++bj)
#pragma unroll
            for (int n = 0; n < 2; ++n) bv[bj][n] = *(const f32x4*)(bias + EPI_COL(bj, n));
        __builtin_amdgcn_sched_barrier(0);
        EPI_LOOP { f32x4 v = acc[ai][bj][m][n] + bv[bj][n];
            v.x = sigmoidf_(v.x); v.y = sigmoidf_(v.y); v.z = sigmoidf_(v.z); v.w = sigmoidf_(v.w); *(u32x2*)(O + (unsigned)EPI_ROW(ai, m) * 3072u + (unsigned)EPI_COL(bj, n)) = pk4(v); } } };
struct EpiCmpSlab { float* SL;
    __device__ __forceinline__ void operator()(EPI_ARGS) const {
        const int kv = u.pm >> 4, bg = (u.pm >> 2) & 3, half = (u.pm >> 1) & 1, ksp = u.pm & 1;
#pragma unroll
        for (int ai = 0; ai < 2; ++ai)
#pragma unroll
            for (int m = 0; m < 4; ++m)
#pragma unroll
                for (int n = 0; n < 2; ++n) { const int i = half * 256 + ai * 128 + wr * 64 + m * 16 + fr, cc = wc * 32 + n * 16 + fq * 4;
                    *(f32x4*)(SL + ((size_t)(ksp * 2 + kv) * 2048 + bg * 512 + i) * 128 + cc) = acc[ai][0][m][n]; } } };
struct EpiOutproj { bf16_t* MIX; const bf16_t* GATES; int br;
    __device__ __forceinline__ void operator()(EPI_ARGS) const {
#pragma unroll
        for (int ai = 0; ai < 2; ++ai)
#pragma unroll
          for (int mh = 0; mh < 2; ++mh) { u32x2 gw[2][2][2], mw[2][2][2];
#pragma unroll
            for (int m2 = 0; m2 < 2; ++m2)
#pragma unroll
                for (int bj = 0; bj < 2; ++bj)
#pragma unroll
                    for (int n = 0; n < 2; ++n) { const unsigned row = (unsigned)EPI_ROW(ai, 2 * mh + m2), col = (unsigned)EPI_COL(bj, n);
                        gw[m2][bj][n] = *(const u32x2*)(GATES + row * 3072u + (unsigned)br * 1024u + col); if (br > 0) mw[m2][bj][n] = *(const u32x2*)(MIX + row * 1024u + col); }
            __builtin_amdgcn_sched_barrier(0);
#pragma unroll
            for (int m2 = 0; m2 < 2; ++m2)
#pragma unroll
                for (int bj = 0; bj < 2; ++bj)
#pragma unroll
                    for (int n = 0; n < 2; ++n) { f32x4 v = acc[ai][bj][2 * mh + m2][n] * unpk4(gw[m2][bj][n]); if (br > 0) v = v + unpk4(mw[m2][bj][n]);
                        *(u32x2*)(MIX + (unsigned)EPI_ROW(ai, 2 * mh + m2) * 1024u + (unsigned)EPI_COL(bj, n)) = pk4(v); }
            __builtin_amdgcn_sched_barrier(0); } } };
struct EpiWout { const float* R; float* XA;
    __device__ __forceinline__ void operator()(EPI_ARGS) const {
#pragma unroll
        for (int ai = 0; ai < 2; ++ai)
#pragma unroll
          for (int mh = 0; mh < 2; ++mh) { f32x4 rv[2][2][2];
#pragma unroll
            for (int m2 = 0; m2 < 2; ++m2)
#pragma unroll
                for (int bj = 0; bj < 2; ++bj)
#pragma unroll
                    for (int n = 0; n < 2; ++n) rv[m2][bj][n] = *(const f32x4*)(R + (unsigned)EPI_ROW(ai, 2 * mh + m2) * 1024u + (unsigned)EPI_COL(bj, n));
            __builtin_amdgcn_sched_barrier(0);
#pragma unroll
            for (int m2 = 0; m2 < 2; ++m2)
#pragma unroll
                for (int bj = 0; bj < 2; ++bj)
#pragma unroll
                    for (int n = 0; n < 2; ++n) *(f32x4*)(XA + (unsigned)EPI_ROW(ai, 2 * mh + m2) * 1024u + (unsigned)EPI_COL(bj, n)) = rv[m2][bj][n] + acc[ai][bj][2 * mh + m2][n];
            __builtin_amdgcn_sched_barrier(0); } } };
struct EpiMoe1 { bf16_t* HID; const float* LW;
    __device__ __forceinline__ void operator()(EPI_ARGS) const {
        int aux_ = u.aux; asm volatile("" : "+s"(aux_));
        float w8[2][4];
#pragma unroll
        for (int ai = 0; ai < 2; ++ai)
#pragma unroll
            for (int m = 0; m < 4; ++m) w8[ai][m] = LW[(unsigned)(aux_ + ai * 128 + wr * 64 + m * 16 + fr)];
        __builtin_amdgcn_sched_barrier(0);
#pragma unroll
        for (int ai = 0; ai < 2; ++ai)
#pragma unroll
            for (int m = 0; m < 4; ++m) { const unsigned pos = (unsigned)(aux_ + ai * 128 + wr * 64 + m * 16 + fr); const float w = w8[ai][m];
#pragma unroll
                for (int n = 0; n < 2; ++n) { const f32x4 g = acc[ai][0][m][n], up = acc[ai][1][m][n]; f32x4 h;
                    h.x = g.x * sigmoidf_(g.x) * up.x * w; h.y = g.y * sigmoidf_(g.y) * up.y * w; h.z = g.z * sigmoidf_(g.z) * up.z * w; h.w = g.w * sigmoidf_(g.w) * up.w * w;
                    *(u32x2*)(HID + pos * 256u + (unsigned)(u.pn * 128 + wc * 32 + n * 16 + fq * 4)) = pk4(h); } } } };
struct EpiMoe2 { bf16_t* Y; const unsigned* LDST;
    __device__ __forceinline__ void operator()(EPI_ARGS) const {
        int aux_ = u.aux; asm volatile("" : "+s"(aux_));
        unsigned d8[2][4];
#pragma unroll
        for (int ai = 0; ai < 2; ++ai)
#pragma unroll
            for (int m = 0; m < 4; ++m) d8[ai][m] = LDST[(unsigned)(aux_ + ai * 128 + wr * 64 + m * 16 + fr)];
        __builtin_amdgcn_sched_barrier(0);
#pragma unroll
        for (int ai = 0; ai < 2; ++ai)
#pragma unroll
            for (int m = 0; m < 4; ++m) { const unsigned d0 = d8[ai][m];
                if (d0 != 0xFFFFFFFFu) { const unsigned off = d0 + (unsigned)(u.pn * 256 + wc * 32 + fq * 4);
#pragma unroll
                    for (int bj = 0; bj < 2; ++bj)
#pragma unroll
                        for (int n = 0; n < 2; ++n) *(u32x2*)(Y + off + bj * 128 + n * 16) = pk4(acc[ai][bj][m][n]); } } } };

struct CmpOrder { int G, c; const char* P1; const char* W;
    __device__ bool next(int i, pg8::Unit& u) const { const int L_ = i * G + c; if (L_ >= 32) return false; const int kv = L_ >> 4, b = (L_ >> 3) & 1, g = (L_ >> 2) & 1, half = (L_ >> 1) & 1, ks = L_ & 1;
        u.pm = L_; u.pn = 0; u.aux = 0; u.A = P1 + ((size_t)(b * T + 16 * 256 * half + 16 * ks) * P1W + C_NKV + (kv * 2 + g) * 64) * 2; u.B = W + ((size_t)kv * 256 * 2048 + (size_t)ks * 1024) * 2; return true; } };
struct MoeOrder { int G, c, nN; const LAS int* tab; const char* A; size_t a_rowbytes; const char* W; size_t w_expert, w_tile;
    __device__ bool next(int i, pg8::Unit& u) const { const int L_ = i * G + c; const int NT = __builtin_amdgcn_readfirstlane(tab[32]); if (L_ >= NT * nN) return false; const int rt = L_ / nN, pn = L_ % nN;
        int e = 0; while (__builtin_amdgcn_readfirstlane(tab[e + 1]) <= rt) ++e;
        const int off_e = __builtin_amdgcn_readfirstlane(tab[33 + e]), ts_e = __builtin_amdgcn_readfirstlane(tab[e]), cnt_e = __builtin_amdgcn_readfirstlane(tab[66 + e]);
        const int pos0 = off_e + 256 * (rt - ts_e); u.pn = pn; u.aux = pos0; u.pm = off_e + cnt_e;
        u.A = A + (size_t)pos0 * a_rowbytes; u.B = W + (size_t)e * w_expert + (size_t)pn * w_tile; return true; } };
__device__ __forceinline__ void moe_tables(const Ctx& c, int l, LAS int* tab) {
    if (c.tid == 0) { const unsigned* cnt = WSP(unsigned, WS_CTL) + CW_MOECNT + l * 64; int ts = 0, off = 0;
        for (int e = 0; e < 32; ++e) { const int n = (int)cnt[e]; tab[e] = ts; tab[33 + e] = off; tab[66 + e] = n; const int nt_ = (n + 255) >> 8; ts += nt_; off += nt_ * 256; }
        tab[32] = ts; tab[65] = off; }
    __syncthreads();
}

constexpr int LDS_RSM = LDS_MISC + 1024;
__device__ __forceinline__ void phase_router(const Ctx& c, int l, int dummy = 0) {
    const int gw = c.bid * NWAVES + c.wave, NGW = c.G * NWAVES, lane = c.lane;
    const float* XA = WSP(float, WS_XA); bf16_t* H2 = WSP(bf16_t, WS_H2); int* REC = WSP(int, dummy ? WS_HID : WS_REC); unsigned* cnt = WSP(unsigned, WS_CTL) + CW_MOECNT + (l + 2 * dummy) * 64;
    const float* g2 = c.norm_ffn() + l * D; const float* wg = c.moe_w_grp() + (size_t)l * D * 4; const float* wr_ = c.moe_w_router() + (size_t)l * D * 32;
    const float* bgp = c.moe_b_grp() + l * 4; const float* brp = c.moe_b_router() + l * 32;
    LAS f32x4* Tk = (LAS f32x4*)(c.lds + c.wave * 16384);
    LAS float* PG = (LAS float*)(c.lds + LDS_RSM + c.wave * 1792); LAS float* EL = PG + 256; LAS float* GL = EL + 128;
    LAS unsigned* cntL = (LAS unsigned*)(c.lds + LDS_MOETAB);
    if (c.tid < 32) cntL[c.tid] = 0u;
    __syncthreads();
    for (int task = gw; task < M / 4; task += NGW) {
        const int m0 = task * 4;
        f32x4 v[4][4]; float rs[4];
#pragma unroll
        for (int r = 0; r < 4; ++r) { const f32x4* xr = (const f32x4*)(XA + (size_t)(m0 + r) * D) + lane; float s = 0.f;
#pragma unroll
            for (int j = 0; j < 4; ++j) { v[r][j] = xr[64 * j]; s += (v[r][j].x * v[r][j].x + v[r][j].y * v[r][j].y) + (v[r][j].z * v[r][j].z + v[r][j].w * v[r][j].w); }
            rs[r] = rsqrtf(wave_sum(s) * (1.f / D) + EPS); }
#pragma unroll
        for (int j = 0; j < 4; ++j) { const f32x4 gg = *((const f32x4*)g2 + lane + 64 * j);
#pragma unroll
            for (int r = 0; r < 4; ++r) { v[r][j] = v[r][j] * rs[r]; *((u32x2*)(H2 + (size_t)(m0 + r) * D) + lane + 64 * j) = pk4(v[r][j]); v[r][j] = v[r][j] * gg; }
#pragma unroll
            for (int e = 0; e < 4; ++e) { f32x4 t4; t4.x = v[0][j][e]; t4.y = v[1][j][e]; t4.z = v[2][j][e]; t4.w = v[3][j][e]; Tk[4 * lane + 256 * j + e] = t4; } }
        LDS_WAIT(); asm volatile("" ::: "memory");
        { const int o = lane & 31, sh = lane >> 5; f32x4 acc = {0.f, 0.f, 0.f, 0.f}; const float* wp = wr_ + (size_t)(512 * sh) * 32 + o; const LAS f32x4* tp = Tk + 512 * sh;
#pragma unroll 1
          for (int kb = 0; kb < 512; kb += 32) { float w[32];
#pragma unroll
              for (int i = 0; i < 32; ++i) w[i] = wp[(size_t)(kb + i) * 32];
              __builtin_amdgcn_sched_barrier(0);
#pragma unroll
              for (int i = 0; i < 32; ++i) acc += tp[kb + i] * w[i]; }
          acc.x = half_sum(acc.x); acc.y = half_sum(acc.y); acc.z = half_sum(acc.z); acc.w = half_sum(acc.w);
          if (lane < 32) { const float bb = brp[o]; EL[0 * 32 + o] = acc.x + bb; EL[1 * 32 + o] = acc.y + bb; EL[2 * 32 + o] = acc.z + bb; EL[3 * 32 + o] = acc.w + bb; } }
        { const int og = lane & 3, s16 = lane >> 2; f32x4 acc = {0.f, 0.f, 0.f, 0.f}; const float* wp = wg + (size_t)(64 * s16) * 4 + og; const LAS f32x4* tp = Tk + 64 * s16;
#pragma unroll 1
          for (int kb = 0; kb < 64; kb += 32) { float w[32];
#pragma unroll
              for (int i = 0; i < 32; ++i) w[i] = wp[(size_t)(kb + i) * 4];
              __builtin_amdgcn_sched_barrier(0);
#pragma unroll
              for (int i = 0; i < 32; ++i) acc += tp[kb + i] * w[i]; }
          PG[(0 * 4 + og) * 16 + s16] = acc.x; PG[(1 * 4 + og) * 16 + s16] = acc.y; PG[(2 * 4 + og) * 16 + s16] = acc.z; PG[(3 * 4 + og) * 16 + s16] = acc.w; }
        LDS_WAIT(); asm volatile("" ::: "memory");
        if (lane < 16) { float s = 0.f;
#pragma unroll
            for (int q = 0; q < 16; ++q) s += PG[lane * 16 + q];
            GL[lane] = s + bgp[lane & 3]; }
        LDS_WAIT(); asm volatile("" ::: "memory");
        if (lane < 4) { const int r = lane;
            int gi = 0; float gm = GL[r * 4];
            for (int o = 1; o < 4; ++o) { const float x_ = GL[r * 4 + o]; if (x_ > gm) { gm = x_; gi = o; } }
            float gs = 0.f; for (int o = 0; o < 4; ++o) gs += __expf(GL[r * 4 + o] - gm);
            const float grp_top = 1.f / gs;
            int i1 = 0; float m1 = EL[r * 32 + gi * 8];
            for (int q = 1; q < 8; ++q) { const float x_ = EL[r * 32 + gi * 8 + q]; if (x_ > m1) { m1 = x_; i1 = q; } }
            int i2 = -1; float m2 = -3.0e38f;
            for (int q = 0; q < 8; ++q) { const float x_ = EL[r * 32 + gi * 8 + q]; if (q != i1 && x_ > m2) { m2 = x_; i2 = q; } }
            const float e2 = __expf(m2 - m1); const float w1 = grp_top / (1.f + e2), w2 = grp_top * e2 / (1.f + e2);
            const int ea = gi * 8 + i1, eb = gi * 8 + i2; const int ra = (int)atomicAdd((unsigned*)(cntL + ea), 1u), rb = (int)atomicAdd((unsigned*)(cntL + eb), 1u);
            int* rr = REC + (size_t)(m0 + r) * 8; rr[0] = ea; rr[1] = eb; rr[2] = ra; rr[3] = rb; rr[4] = __float_as_int(w1); rr[5] = __float_as_int(w2); rr[6] = c.bid; }
        LDS_WAIT(); asm volatile("" ::: "memory");
    }
    __syncthreads();
    if (c.tid < 32) { const unsigned n = cntL[c.tid]; (WSP(unsigned, WS_CTL) + CW_CNTB)[(dummy ? 8192 : 0) + c.bid * 32 + c.tid] = n; if (n) atomicAdd(cnt + c.tid, n); }
}
__device__ __forceinline__ void phase_place(const Ctx& c, int l) {
    LAS int* tab = (LAS int*)(c.lds + LDS_MOETAB);
    moe_tables(c, l, tab);
    int* LTOK = WSP(int, WS_LTOK); float* LW = WSP(float, WS_LW); unsigned* LDST = WSP(unsigned, WS_LSLOT); const int* REC = WSP(int, WS_REC);
    LAS int* BASE = (LAS int*)c.lds;
    if (c.tid < 32) { const unsigned* cb = WSP(unsigned, WS_CTL) + CW_CNTB + c.tid; int run = 0; for (int b_ = 0; b_ < c.G; ++b_) { BASE[b_ * 32 + c.tid] = run; run += (int)cb[b_ * 32]; } }
    __syncthreads();
    for (int m = c.bid * NTHREADS + c.tid; m < M; m += c.G * NTHREADS) { const int* r = REC + (size_t)m * 8;
        const int pa = tab[33 + r[0]] + BASE[r[6] * 32 + r[0]] + r[2], pb = tab[33 + r[1]] + BASE[r[6] * 32 + r[1]] + r[3];
        LTOK[pa] = m; LDST[pa] = (unsigned)m * 1024u; LW[pa] = __int_as_float(r[4]); LTOK[pb] = m; LDST[pb] = ((unsigned)M + (unsigned)m) * 1024u; LW[pb] = __int_as_float(r[5]); }
    for (int e = c.bid; e < 32; e += c.G) { const int lo = tab[33 + e] + tab[66 + e], hi2 = tab[33 + e + 1];
        for (int p = lo + c.tid; p < hi2; p += NTHREADS) { LTOK[p] = 0; LDST[p] = 0xFFFFFFFFu; LW[p] = 0.f; } }
    __syncthreads();
    LAS float* scr = (LAS float*)(c.lds + c.wave * 16384);
    const int gw = c.bid * NWAVES + c.wave, NGW = c.G * NWAVES;
    constexpr int I_GU = 16 * 16, I_DN = 4 * 32;
    for (int it = gw; it < 32 * (I_GU + I_DN); it += NGW) { const int e = it / (I_GU + I_DN); int r = it % (I_GU + I_DN);
        if (r < I_GU) { const int nb = r % 16; const bool up = ((nb * 32) & 255) >= 128;
            const float* w = (up ? c.moe_w_up() : c.moe_w_gate()) + ((size_t)l * 32 + e) * D * 256;
            transpose_item(w, 256, D, WSP(bf16_t, WS_WGU) + (size_t)e * 512 * D, c.norm_ffn() + l * D, MapGU{}, 16, scr, r, c.lane); }
        else { r -= I_GU; transpose_item(c.moe_w_down() + ((size_t)l * 32 + e) * 256 * D, D, 256, WSP(bf16_t, WS_WDT) + (size_t)e * D * 256, nullptr, MapId{0}, 32, scr, r, c.lane); } }
}

#ifndef ATT_FAST_FOX
#define ATT_FAST_FOX 1
#endif
#ifndef ATT_FAST_MLA
#define ATT_FAST_MLA 1
#endif
#ifndef ATT_FAST_NSA
#define ATT_FAST_NSA 1
#endif
namespace fa {
constexpr int KPITCH = 208, VPITCH = 192;
constexpr int KBUF = 64 * KPITCH, VBUF = 64 * VPITCH;
constexpr int L_K = 0, L_V = 2 * KBUF, L_CUM = L_V + 2 * VBUF, L_LUT = L_CUM + 512, L_PS = 57344, L_F = L_PS + 64 * 132 * 4, L_SEL = L_F + 64 * 132 * 4, L_UNI = L_SEL + 1024, L_TL = L_UNI + 16, L_TLN = L_TL + 128, L_UNIT = L_TLN + 16;
static_assert(L_LUT + 8 * 132 * 4 <= L_PS && L_UNIT + 64 <= 131072, "attention LDS map");
typedef short v4i16_t __attribute__((ext_vector_type(4)));
__device__ __forceinline__ float swap32_max(float v) { auto rr = __builtin_amdgcn_permlane32_swap(__float_as_uint(v), __float_as_uint(v), false, false); return fmaxf(__uint_as_float(rr[0]), __uint_as_float(rr[1])); }
__device__ __forceinline__ float swap32_sum(float v) { auto rr = __builtin_amdgcn_permlane32_swap(__float_as_uint(v), __float_as_uint(v), false, false); return __uint_as_float(rr[0]) + __uint_as_float(rr[1]); }
__device__ __forceinline__ float ex2(float x) { return __builtin_amdgcn_exp2f(x); }

struct KVSrc { const bf16_t* K; int kpitch; const bf16_t* K2; int k2pitch; const bf16_t* V; int vpitch; const float* cum; float cref; };
struct TileRegs { u32x4 k, k2, v; float cm; };
template <bool HAS_K2, bool HAS_CUM>
__device__ __forceinline__ void tile_load(TileRegs& R, const KVSrc& s, int kv0, int tid) {
    const int row = tid >> 3, ch = tid & 7;
    R.k = *(const u32x4*)(s.K + (size_t)(kv0 + row) * s.kpitch + ch * 8);
    R.v = *(const u32x4*)(s.V + (size_t)(kv0 + row) * s.vpitch + ch * 8);
    if constexpr (HAS_K2) { if (tid < 256) R.k2 = *(const u32x4*)(s.K2 + (size_t)(kv0 + (tid >> 2)) * s.k2pitch + (tid & 3) * 8); }
    if constexpr (HAS_CUM) { if (tid < 64) R.cm = s.cum[kv0 + tid]; }
}
template <bool HAS_K2, bool HAS_CUM>
__device__ __forceinline__ void tile_store(const TileRegs& R, LAS unsigned char* lds, int buf, int tid, float cref = 0.f, float cadd = 0.f) {
    const int row = tid >> 3, ch = tid & 7;
    *(LAS u32x4*)(lds + L_K + buf * KBUF + row * KPITCH + ch * 16) = R.k;
    if constexpr (HAS_K2) { if (tid < 256) *(LAS u32x4*)(lds + L_K + buf * KBUF + (tid >> 2) * KPITCH + 128 + (tid & 3) * 16) = R.k2; }
    *(LAS u32x4*)(lds + L_V + buf * VBUF + row * VPITCH + ch * 16) = R.v;
    if constexpr (HAS_CUM) { if (tid < 64) { const float x = cref - (R.cm + cadd); const unsigned hi_ = f2bf(x); const float xl = x - __uint_as_float(hi_ << 16); const unsigned lo_ = f2bf(xl);
            unsigned zz = 0u; asm volatile("" : "+v"(zz)); u32x4 w0; w0.x = hi_ | (lo_ << 16); w0.y = zz; w0.z = zz; w0.w = zz; u32x4 z0; z0.x = zz; z0.y = zz; z0.z = zz; z0.w = zz;
            *(LAS u32x4*)(lds + L_K + buf * KBUF + tid * KPITCH + 128) = w0; *(LAS u32x4*)(lds + L_K + buf * KBUF + tid * KPITCH + 144) = z0; } }
}
template <int NKS>
__device__ __forceinline__ void qk_tile(f32x16 (&st)[2], const LAS unsigned char* lds, int buf, const bf16x8 (&qf)[NKS], int r, int hh, float cval) {
    const LAS unsigned char* kp = lds + L_K + buf * KBUF + r * KPITCH + hh * 16;
    bf16x8 kf[2][NKS];
#pragma unroll
    for (int ks = 0; ks < NKS; ++ks)
#pragma unroll
        for (int rb = 0; rb < 2; ++rb) kf[rb][ks] = *(const LAS bf16x8*)(kp + rb * 32 * KPITCH + ks * 32);
    f32x16 cin;
#pragma unroll
    for (int i = 0; i < 16; ++i) cin[i] = cval;
    __builtin_amdgcn_sched_barrier(0);
    f32x16 a0 = __builtin_amdgcn_mfma_f32_32x32x16_bf16(kf[0][0], qf[0], cin, 0, 0, 0), a1 = __builtin_amdgcn_mfma_f32_32x32x16_bf16(kf[1][0], qf[0], cin, 0, 0, 0);
#pragma unroll
    for (int ks = 1; ks < NKS; ++ks) { a0 = __builtin_amdgcn_mfma_f32_32x32x16_bf16(kf[0][ks], qf[ks], a0, 0, 0, 0); a1 = __builtin_amdgcn_mfma_f32_32x32x16_bf16(kf[1][ks], qf[ks], a1, 0, 0, 0); }
    st[0] = a0; st[1] = a1;
}
__device__ __forceinline__ void pv_tile(f32x16 (&ot)[2], const LAS unsigned char* lds, int buf, const f32x16 (&p)[2], int lane) {
    const int i16 = lane & 15, blk = (lane >> 4) & 1, hh = lane >> 5;
    const LAS unsigned char* vb = lds + L_V + buf * VBUF + (4 * hh + (i16 >> 2)) * VPITCH + 32 * blk + 8 * (i16 & 3);
    v4i16_t lo[4][2], hi[4][2]; bf16x8 pf[4];
#pragma unroll
    for (int q = 0; q < 4; ++q)
#pragma unroll
        for (int db = 0; db < 2; ++db) { const LAS unsigned char* vp = vb + (16 * q) * VPITCH + 64 * db;
            lo[q][db] = __builtin_amdgcn_ds_read_tr16_b64_v4i16((LAS v4i16_t*)vp); hi[q][db] = __builtin_amdgcn_ds_read_tr16_b64_v4i16((LAS v4i16_t*)(vp + 8 * VPITCH)); }
#pragma unroll
    for (int q = 0; q < 4; ++q) { const int rb = q >> 1, s_ = q & 1;
        u32x4 pw; pw.x = cvtpk(p[rb][8 * s_ + 0], p[rb][8 * s_ + 1]); pw.y = cvtpk(p[rb][8 * s_ + 2], p[rb][8 * s_ + 3]); pw.z = cvtpk(p[rb][8 * s_ + 4], p[rb][8 * s_ + 5]); pw.w = cvtpk(p[rb][8 * s_ + 6], p[rb][8 * s_ + 7]);
        pf[q] = __builtin_bit_cast(bf16x8, pw); }
    __builtin_amdgcn_sched_barrier(0);
#pragma unroll
    for (int q = 0; q < 4; ++q)
#pragma unroll
        for (int db = 0; db < 2; ++db) { const bf16x8 vf = {lo[q][db][0], lo[q][db][1], lo[q][db][2], lo[q][db][3], hi[q][db][0], hi[q][db][1], hi[q][db][2], hi[q][db][3]};
            ot[db] = __builtin_amdgcn_mfma_f32_32x32x16_bf16(vf, pf[q], ot[db], 0, 0, 0); }
}
struct SmState { float m, l; };
constexpr float RESC_THR = 8.f;
__device__ __forceinline__ float sm_cval(const SmState& S) { return (S.m == -INFINITY) ? 0.f : -S.m; }
__device__ __forceinline__ float row_max32(const f32x16 (&st)[2]) {
    float mx = fmaxf(st[0][0], st[1][0]);
#pragma unroll
    for (int i = 1; i < 16; ++i) mx = fmaxf(fmaxf(mx, st[0][i]), st[1][i]);
    return swap32_max(mx);
}
typedef float f32x2v __attribute__((ext_vector_type(2)));
template <bool WITH_O>
__device__ __forceinline__ void sm_shift(f32x16 (&st)[2], SmState& S, f32x16 (&ot)[2], float mx) {
    const bool fresh = (S.m == -INFINITY);
    const bool up = fresh ? (mx > -INFINITY) : (mx > RESC_THR);
    if (__any(up)) {
        const float d = up ? mx : 0.f; const float alpha = fresh ? 1.f : ex2(-d);
        S.l *= alpha; S.m = up ? ((fresh ? 0.f : S.m) + d) : S.m;
#pragma unroll
        for (int rb = 0; rb < 2; ++rb)
#pragma unroll
            for (int i = 0; i < 16; ++i) st[rb][i] -= d;
        if constexpr (WITH_O) {
#pragma unroll
            for (int db = 0; db < 2; ++db)
#pragma unroll
                for (int i = 0; i < 16; ++i) ot[db][i] *= alpha; }
    }
}
__device__ __forceinline__ void sm_update(f32x16 (&st)[2], SmState& S, f32x16 (&ot)[2]) {
    sm_shift<true>(st, S, ot, row_max32(st));
    float sum = 0.f;
#pragma unroll
    for (int rb = 0; rb < 2; ++rb)
#pragma unroll
        for (int i = 0; i < 16; ++i) { const float p = ex2(st[rb][i]); st[rb][i] = p; sum += p; }
    S.l += sum;
}
__device__ __forceinline__ void sm_stats(f32x16 (&st)[2], SmState& S) {
    f32x16 dummy[2];
    sm_shift<false>(st, S, dummy, row_max32(st));
    float sum = 0.f;
#pragma unroll
    for (int rb = 0; rb < 2; ++rb)
#pragma unroll
        for (int i = 0; i < 16; ++i) sum += ex2(st[rb][i]);
    S.l += sum;
}
__device__ __forceinline__ void zero_acc(f32x16 (&a)[2]) {
#pragma unroll
    for (int db = 0; db < 2; ++db)
#pragma unroll
        for (int i = 0; i < 16; ++i) a[db][i] = 0.f;
}
__device__ __forceinline__ void store_ot(const f32x16 (&o)[2], float sc, bf16_t* orow, int hh) {
#pragma unroll
    for (int db = 0; db < 2; ++db)
#pragma unroll
        for (int a = 0; a < 4; ++a) { u32x2 w; w.x = cvtpk(o[db][4 * a + 0] * sc, o[db][4 * a + 1] * sc); w.y = cvtpk(o[db][4 * a + 2] * sc, o[db][4 * a + 3] * sc);
            *(u32x2*)(orow + 32 * db + 8 * a + 4 * hh) = w; }
}
#define FA_FOREACH_REG(CODE) _Pragma("unroll") for (int rb = 0; rb < 2; ++rb) _Pragma("unroll") for (int a = 0; a < 4; ++a) _Pragma("unroll") for (int e = 0; e < 4; ++e) { const int i = 4 * a + e; const int kc = 32 * rb + 8 * a + e; (void)kc; CODE }
#define FA_LAUNDER(x) asm volatile("" : "+v"(x))

template <bool IS_MLA>
__device__ __forceinline__ void dense_unit(const Ctx& c, int lyr, int b, int h, int qb) {
    constexpr int NKS = IS_MLA ? 6 : 5;
    const int tid = c.tid, lane = c.lane, r = lane & 31, hh = lane >> 5, w = c.wave;
    LAS unsigned char* lds = c.lds;
    const int q0 = qb * 256, qrow = q0 + 32 * w + r; const size_t mrow = (size_t)b * T + qrow;
    KVSrc src; bf16x8 qf[NKS]; bf16_t* orow;
    if constexpr (IS_MLA) {
        const bf16_t* QB = WSP(bf16_t, WS_QB); const bf16_t* KVB = WSP(bf16_t, WS_KVB);
        src.K = KVB + (size_t)b * T * 1024 + h * 64; src.kpitch = 1024; src.K2 = WSP(bf16_t, WS_KR) + (size_t)b * T * 32; src.k2pitch = 32; src.V = KVB + (size_t)b * T * 1024 + 512 + h * 64; src.vpitch = 1024; src.cum = nullptr; src.cref = 0.f;
#pragma unroll
        for (int ks = 0; ks < 4; ++ks) qf[ks] = *(const bf16x8*)(QB + mrow * 768 + h * 64 + 16 * ks + 8 * hh);
#pragma unroll
        for (int ks = 0; ks < 2; ++ks) qf[4 + ks] = *(const bf16x8*)(QB + mrow * 768 + 512 + h * 32 + 16 * ks + 8 * hh);
        orow = WSP(bf16_t, WS_OUTB) + mrow * 512 + h * 64;
    } else {
        const bf16_t* P1 = WSP(bf16_t, WS_P1);
        src.K = P1 + (size_t)b * T * P1W + C_FQKV + 512 + h * 64; src.kpitch = P1W; src.K2 = nullptr; src.k2pitch = 0; src.V = P1 + (size_t)b * T * P1W + C_FQKV + 1024 + h * 64; src.vpitch = P1W;
        src.cum = WSP(float, WS_LC) + ((size_t)b * 8 + h) * T;
        { LAS float* cps_ = (LAS float*)(lds + L_CUM); if (tid < 128) cps_[tid] = (WSP(float, WS_CP) + ((size_t)b * 8 + h) * 129)[1 + tid]; }
        src.cref = 0.f;
#pragma unroll
        for (int ks = 0; ks < 4; ++ks) qf[ks] = *(const bf16x8*)(P1 + mrow * P1W + C_FQKV + h * 64 + 16 * ks + 8 * hh);
        { unsigned one2 = hh ? 0u : 0x3F803F80u; asm volatile("" : "+v"(one2)); u32x4 aq; aq.x = one2; aq.y = 0u; aq.z = 0u; aq.w = 0u; qf[4] = __builtin_bit_cast(bf16x8, aq); }
        orow = WSP(bf16_t, WS_OUTC) + mrow * 512 + h * 64;
    }
    f32x16 st[2], ot[2]; zero_acc(ot); SmState S{-INFINITY, 0.f};
    const int nt = 4 * qb + 4;
    const int wlast = (q0 + 32 * w + 31) >> 6;
    constexpr float FOX_SKIP = 40.f;
    float qbound = 0.f, mmin_blk = -INFINITY; LAS float* MM = (LAS float*)(lds + L_UNIT + 16);
    if constexpr (!IS_MLA) {
        float ss = 0.f;
#pragma unroll
        for (int ks = 0; ks < 4; ++ks)
#pragma unroll
            for (int j = 0; j < 8; ++j) { const float x_ = bf2f((bf16_t)qf[ks][j]); ss += x_ * x_; }
        ss = swap32_sum(ss);
        const float km2 = __uint_as_float((WSP(unsigned, WS_CTL) + CW_KMAX)[lyr * 16 + b * 8 + h]);
        qbound = sqrtf(ss * km2) * 1.001f + 0.01f;
    }
    const LAS float* cps = (const LAS float*)(lds + L_CUM);
#define FOX_CP(t_) ((t_) == 0 ? 0.f : cps[(t_) - 1])
    TileRegs R;
    tile_load<IS_MLA, !IS_MLA>(R, src, 64 * (nt - 1), tid);
    if constexpr (!IS_MLA) { __syncthreads(); src.cref = src.cum[q0] + FOX_CP(4 * qb); }
    tile_store<IS_MLA, !IS_MLA>(R, lds, 0, tid, src.cref, IS_MLA ? 0.f : FOX_CP(nt - 1));
    if (nt > 1) tile_load<IS_MLA, !IS_MLA>(R, src, 64 * (nt - 2), tid);
    __syncthreads();
    for (int it = 0; it < nt; ++it) { const int t = nt - 1 - it, buf = it & 1, kv0 = 64 * t;
        if constexpr (!IS_MLA) { if (it >= 4 && (src.cref - cps[t]) < mmin_blk - FOX_SKIP) break; }
        if (t <= wlast) {
            qk_tile<NKS>(st, lds, buf, qf, r, hh, sm_cval(S));
            if (kv0 + 63 > q0 + 32 * w) { int lim = qrow - kv0 - 4 * hh; FA_LAUNDER(lim); FA_FOREACH_REG({ if (kc > lim) st[rb][i] = -INFINITY; }) }
            sm_update(st, S, ot);
            pv_tile(ot, lds, buf, st, lane);
        }
        if constexpr (!IS_MLA) { if (it == 3) { const float v_ = -wave_max(-(S.m - qbound)); if (lane == 0) MM[w] = v_; } }
        if (it + 1 < nt) { tile_store<IS_MLA, !IS_MLA>(R, lds, buf ^ 1, tid, src.cref, IS_MLA ? 0.f : FOX_CP(t - 1)); if (it + 2 < nt) tile_load<IS_MLA, !IS_MLA>(R, src, kv0 - 128, tid); }
        __syncthreads();
        if constexpr (!IS_MLA) { if (it == 3) { float mm_ = MM[0];
#pragma unroll
            for (int q_ = 1; q_ < 8; ++q_) mm_ = fminf(mm_, MM[q_]);
            mmin_blk = mm_; } }
    }
    const float lt = swap32_sum(S.l);
    store_ot(ot, 1.f / lt, orow, hh);
}

#define FA_STREAM(SRC, NT, TILE_EXPR, BODY) do { TileRegs R_; const int nt_ = (NT); \
    if (nt_ > 0) { { const int idx = 0; tile_load<false, false>(R_, SRC, 64 * (TILE_EXPR), tid); } tile_store<false, false>(R_, lds, 0, tid); \
      if (nt_ > 1) { const int idx = 1; tile_load<false, false>(R_, SRC, 64 * (TILE_EXPR), tid); } \
      __syncthreads(); \
      for (int it_ = 0; it_ < nt_; ++it_) { const int buf = it_ & 1; int tile; { const int idx = it_; tile = (TILE_EXPR); } \
          BODY \
          if (it_ + 1 < nt_) { tile_store<false, false>(R_, lds, buf ^ 1, tid); if (it_ + 2 < nt_) { const int idx = it_ + 2; tile_load<false, false>(R_, SRC, 64 * (TILE_EXPR), tid); } } \
          __syncthreads(); } } } while (0)

__device__ __forceinline__ void nsa_unit(const Ctx& c, int b, int g, int j) {
    const int tid = c.tid, lane = c.lane, r = lane & 31, hh = lane >> 5, w = c.wave;
    LAS unsigned char* lds = c.lds;
    const int t0 = 64 * j, tl = r >> 2, hp = r & 3, tokl = 8 * w + tl, tq = t0 + tokl, head = 4 * g + hp; const size_t mrow = (size_t)b * T + tq;
    const bf16_t* P1 = WSP(bf16_t, WS_P1);
    bf16x8 qf[4];
#pragma unroll
    for (int ks = 0; ks < 4; ++ks) qf[ks] = *(const bf16x8*)(P1 + mrow * P1W + C_NQ + head * 64 + 16 * ks + 8 * hh);
    const float gc = sigmoidf_(bf2f(P1[mrow * P1W + C_NG + head * 3 + 0])), gsl = sigmoidf_(bf2f(P1[mrow * P1W + C_NG + head * 3 + 1])), gwn = sigmoidf_(bf2f(P1[mrow * P1W + C_NG + head * 3 + 2]));
    const LAS float* lutL = (const LAS float*)(lds + L_LUT) + head * 132;
    LAS float* PS = (LAS float*)(lds + L_PS); LAS float* FM = (LAS float*)(lds + L_F); LAS unsigned* SEL = (LAS unsigned*)(lds + L_SEL); LAS unsigned* UNI = (LAS unsigned*)(lds + L_UNI);
    LAS unsigned char* TL = (LAS unsigned char*)(lds + L_TL); LAS int* TLN = (LAS int*)(lds + L_TLN);
    f32x16 st[2], ot[2], otot[2]; zero_acc(otot);
    for (int i = tid; i < 2 * 64 * 132; i += NTHREADS) PS[i] = 0.f;
    if (tid < 256) SEL[tid] = 0u; if (tid < 4) UNI[tid] = 0u;
    const float bfar = lutL[128];
    const int tmin = t0 + 8 * w;
    const int n_ok_max = ((t0 + 63 - 31) >> 4) + 1; const int nct = (n_ok_max + 63) >> 6;
    KVSrc srcc; srcc.K = WSP(bf16_t, WS_KC) + (size_t)(b * 2 + g) * 512 * 64; srcc.kpitch = 64; srcc.K2 = nullptr; srcc.k2pitch = 0; srcc.V = WSP(bf16_t, WS_VC) + (size_t)(b * 2 + g) * 512 * 64; srcc.vpitch = 64; srcc.cum = nullptr; srcc.cref = 0.f;
    SmState Sc{-INFINITY, 0.f};
    FA_STREAM(srcc, nct, idx, {
        const bool farc = (16 * (64 * tile + 63) + 31 + 128 <= tmin);
        qk_tile<4>(st, lds, buf, qf, r, hh, sm_cval(Sc) + (farc ? bfar : 0.f));
        if (!farc) { int db_ = tq - 31 - 1024 * tile - 64 * hh; FA_LAUNDER(db_); FA_FOREACH_REG({ const int dist = db_ - 16 * kc; const float s_ = st[rb][i] + lutL[dist < 0 ? 0 : (dist > 128 ? 128 : dist)]; st[rb][i] = dist < 0 ? -INFINITY : s_; }) }
        sm_stats(st, Sc); });
    { const float lt = swap32_sum(Sc.l); const float inv = lt > 0.f ? 1.f / lt : 0.f; const float msafe = (Sc.m == -INFINITY) ? 0.f : Sc.m;
      zero_acc(ot);
      FA_STREAM(srcc, nct, idx, {
        const bool farc = (16 * (64 * tile + 63) + 31 + 128 <= tmin);
        qk_tile<4>(st, lds, buf, qf, r, hh, (farc ? bfar : 0.f) - msafe);
        if (farc) { FA_FOREACH_REG({ st[rb][i] = ex2(st[rb][i]) * inv; }) }
        else { int db_ = tq - 31 - 1024 * tile - 64 * hh; FA_LAUNDER(db_); FA_FOREACH_REG({ const int dist = db_ - 16 * kc; const float s_ = st[rb][i] + lutL[dist < 0 ? 0 : (dist > 128 ? 128 : dist)]; st[rb][i] = dist < 0 ? 0.f : ex2(s_) * inv; }) }
_Pragma("unroll")
        for (int rb = 0; rb < 2; ++rb)
_Pragma("unroll")
            for (int a = 0; a < 4; ++a) { float q4[4];
_Pragma("unroll")
                for (int e = 0; e < 4; ++e) { float v = st[rb][4 * a + e]; v += dpp_f<0xB1>(v); v += dpp_f<0x4E>(v); q4[e] = v; }
                if (hp == 0) { const int G = 16 * tile + 8 * rb + 2 * a + hh; PS[tokl * 132 + G] = q4[0] + 2.f * (q4[1] + q4[2] + q4[3]); FM[tokl * 132 + G] = q4[0]; } }
        pv_tile(ot, lds, buf, st, lane); });
#pragma unroll
      for (int db = 0; db < 2; ++db)
#pragma unroll
          for (int i = 0; i < 16; ++i) otot[db][i] += gc * ot[db][i]; }
    if (j + 1 <= 16) { if (tid < 64) SEL[tid * 4] = (1u << (j + 1)) - 1u; if (tid == 0) UNI[0] = (1u << (j + 1)) - 1u; }
    else {
        for (int i = tid; i < 64 * 128; i += NTHREADS) { const int tk = i >> 7, G = i & 127; if (G >= 1 && G <= j - 2) PS[tk * 132 + G] += FM[tk * 132 + G + 1]; }
        __syncthreads();
        const int tk = tid >> 3, sub = tid & 7; unsigned bits[4] = {0u, 0u, 0u, 0u};
#pragma unroll 1
        for (int k = 0; k < 16; ++k) { const int G = sub + 8 * k;
            if (G >= 1 && G <= j - 2) { const float v = PS[tk * 132 + G]; int cnt = 0;
                for (int G2 = 1; G2 <= j - 2; ++G2) { const float v2 = PS[tk * 132 + G2]; cnt += (v2 > v || (v2 == v && G2 < G)) ? 1 : 0; }
                if (cnt < 13) { if (k < 4) bits[0] |= 1u << G; else if (k < 8) bits[1] |= 1u << (G - 32); else if (k < 12) bits[2] |= 1u << (G - 64); else bits[3] |= 1u << (G - 96); } } }
        if (sub == 0) { bits[0] |= 1u; { const int G = j; if (G < 32) bits[0] |= 1u << G; else if (G < 64) bits[1] |= 1u << (G - 32); else if (G < 96) bits[2] |= 1u << (G - 64); else bits[3] |= 1u << (G - 96); }
                        { const int G = j - 1; if (G < 32) bits[0] |= 1u << G; else if (G < 64) bits[1] |= 1u << (G - 32); else if (G < 96) bits[2] |= 1u << (G - 64); else bits[3] |= 1u << (G - 96); } }
#pragma unroll
        for (int q = 0; q < 4; ++q) if (bits[q]) { atomicOr((unsigned*)(SEL + tk * 4 + q), bits[q]); atomicOr((unsigned*)(UNI + q), bits[q]); }
    }
    __syncthreads();
    if (tid == 0) { int n = 0; for (int q = 0; q < 4; ++q) { unsigned m_ = UNI[q]; while (m_) { const int bpos = __builtin_ctz(m_); m_ &= m_ - 1u; TL[n++] = (unsigned char)(32 * q + bpos); } } TLN[0] = n; }
    __syncthreads();
    const unsigned msk0 = SEL[tokl * 4 + 0], msk1 = SEL[tokl * 4 + 1], msk2 = SEL[tokl * 4 + 2], msk3 = SEL[tokl * 4 + 3];
    const int nsel = __builtin_amdgcn_readfirstlane(TLN[0]);
    { KVSrc srcs; srcs.K = P1 + (size_t)b * T * P1W + C_NKV + ((1 * 2 + 0) * 2 + g) * 64; srcs.kpitch = P1W; srcs.K2 = nullptr; srcs.k2pitch = 0; srcs.V = P1 + (size_t)b * T * P1W + C_NKV + ((1 * 2 + 1) * 2 + g) * 64; srcs.vpitch = P1W; srcs.cum = nullptr; srcs.cref = 0.f;
      SmState Ss{-INFINITY, 0.f}; zero_acc(ot);
      FA_STREAM(srcs, nsel, (int)TL[idx], {
        const int wq = tile >> 5; const unsigned mw = wq == 0 ? msk0 : wq == 1 ? msk1 : wq == 2 ? msk2 : msk3; const bool mine = (mw >> (tile & 31)) & 1u;
        if (__any(mine)) {
            const bool fars = (64 * tile + 63 + 128 <= tmin);
            qk_tile<4>(st, lds, buf, qf, r, hh, mine ? sm_cval(Ss) + (fars ? bfar : 0.f) : -INFINITY);
            if (!fars) { int db_ = tq - 64 * tile - 4 * hh; FA_LAUNDER(db_); FA_FOREACH_REG({ const int dist = db_ - kc; const float s_ = st[rb][i] + lutL[dist < 0 ? 0 : (dist > 128 ? 128 : dist)]; st[rb][i] = (dist >= 0) ? s_ : -INFINITY; }) }
            sm_update(st, Ss, ot);
            pv_tile(ot, lds, buf, st, lane); } });
      const float lt = swap32_sum(Ss.l); const float sc = lt > 0.f ? gsl / lt : 0.f;
#pragma unroll
      for (int db = 0; db < 2; ++db)
#pragma unroll
          for (int i = 0; i < 16; ++i) otot[db][i] += sc * ot[db][i]; }
    { KVSrc srcw; srcw.K = P1 + (size_t)b * T * P1W + C_NKV + ((2 * 2 + 0) * 2 + g) * 64; srcw.kpitch = P1W; srcw.K2 = nullptr; srcw.k2pitch = 0; srcw.V = P1 + (size_t)b * T * P1W + C_NKV + ((2 * 2 + 1) * 2 + g) * 64; srcw.vpitch = P1W; srcw.cum = nullptr; srcw.cref = 0.f;
      const int jlo = j - 8 > 0 ? j - 8 : 0;
      SmState Sw{-INFINITY, 0.f}; zero_acc(ot);
      FA_STREAM(srcw, j - jlo + 1, jlo + idx, {
        qk_tile<4>(st, lds, buf, qf, r, hh, sm_cval(Sw));
        { int db_ = tq - 64 * tile - 4 * hh; FA_LAUNDER(db_); FA_FOREACH_REG({ const int dist = db_ - kc; const float s_ = st[rb][i] + lutL[dist < 0 ? 0 : (dist > 128 ? 128 : dist)]; st[rb][i] = (dist >= 0 && dist < 512) ? s_ : -INFINITY; }) }
        sm_update(st, Sw, ot);
        pv_tile(ot, lds, buf, st, lane); });
      const float lt = swap32_sum(Sw.l); const float sc = lt > 0.f ? gwn / lt : 0.f;
#pragma unroll
      for (int db = 0; db < 2; ++db)
#pragma unroll
          for (int i = 0; i < 16; ++i) otot[db][i] += sc * ot[db][i]; }
    store_ot(otot, 1.f, WSP(bf16_t, WS_OUTA) + mrow * 512 + head * 64, hh);
}
}

__device__ __forceinline__ int next_unit(const Ctx& c, unsigned* ctr) {
    LAS int* u = (LAS int*)(c.lds + fa::L_UNIT);
    __syncthreads();
    if (c.tid == 0) u[0] = (int)__hip_atomic_fetch_add(ctr, 1u, __ATOMIC_RELAXED, __HIP_MEMORY_SCOPE_AGENT);
    __syncthreads();
    return __builtin_amdgcn_readfirstlane(u[0]);
}
__device__ __forceinline__ void phase_att_fast(const Ctx& c0, int l) {
    Ctx c = c0;
    unsigned* ctr0 = WSP(unsigned, WS_CTL) + CW_QUEUE + 64 * 8 * l;
    { const float* lut = WSP(float, WS_TAB) + 512; LAS float* L_ = (LAS float*)(c.lds + fa::L_LUT); for (int i = c.tid; i < 8 * 132; i += NTHREADS) L_[i] = lut[i]; }
    const int myx = (int)(xb_xcc_id() & 7u);
    for (int qi = 0; qi < 8; ++qi) {
        const int x = (myx + qi) & 7;
        for (;;) {
            const int u = next_unit(c, ctr0 + 64 * x);
            if (u >= 192) break;
            relaunder(c);
            const int sidx = u >> 5, k = u & 31;
            if (sidx == 0 || sidx == 3) { const int p = 2 * x + (sidx == 3); if (ATT_FAST_MLA) fa::dense_unit<true>(c, l & 1, p >> 3, p & 7, 31 - k); }
            else if (sidx == 1 || sidx == 4) { const int p = 2 * x + (sidx == 4); if (ATT_FAST_FOX) fa::dense_unit<false>(c, l & 1, p >> 3, p & 7, 31 - k); }
            else { const int n = (sidx == 5 ? 32 : 0) + k, grp = x >> 1; if (ATT_FAST_NSA) fa::nsa_unit(c, grp >> 1, grp & 1, 127 - 2 * n - (x & 1)); }
        }
    }
}

struct Args { const void* in[32]; float* out; unsigned char* ws; int l_lo, l_hi; };
constexpr int PH_PER_LAYER = 15, K_FINAL = 1 + PH_PER_LAYER;
template <int KIND>
__global__ void __launch_bounds__(NTHREADS, 2) fwd_kernel(Args a) {
    extern __shared__ __attribute__((aligned(16))) unsigned char lds_raw[];
    Ctx c;
    c.out = a.out; c.ws = a.ws; c.ws0 = a.ws; c.lds = (LAS unsigned char*)lds_raw;
    c.tid = threadIdx.x; c.lane = c.tid & 63; c.wave = __builtin_amdgcn_readfirstlane(c.tid >> 6); c.G = gridDim.x; c.bid = blockIdx.x;
    if (c.tid < 4) ((LAS unsigned*)(c.lds + LDS_MISC))[c.tid] = 0u;
    if (c.tid < 32) { const unsigned long long pv = (unsigned long long)a.in[c.tid]; ((LAS unsigned*)(c.lds + LDS_INTAB))[2 * c.tid] = (unsigned)pv; ((LAS unsigned*)(c.lds + LDS_INTAB))[2 * c.tid + 1] = (unsigned)(pv >> 32); }
    __syncthreads();
    XcdBarrier bar; bar.bar = WSP(unsigned, WS_CTL) + CW_BAR; bar.x = 0; bar.st = nullptr;
    if constexpr (KIND < 0) bar = xcd_barrier_post(WSP(unsigned, WS_CTL) + CW_BAR, (volatile LAS unsigned*)(c.lds + LDS_MISC));
#define IN(k) ((KIND < 0 || KIND == (k)) && (relaunder(c), true))
#define REP(p) for (int rep_ = 0; rep_ < ((PROBE_DOUBLE == (p)) ? 2 : 1); ++rep_)
#define SEAM(k) do { if constexpr (KIND < 0) { unsigned* bb_ = bar.bar; asm volatile("" : "+s"(bb_)); bar.bar = bb_; xcd_barrier(bar); } } while (0)
    LAS unsigned char* ring = c.lds;

    if (IN(0)) REP(4) { phase_prologue(c); } SEAM(0);
    for (int l = a.l_lo; l < a.l_hi; ++l) {
        constexpr int pb = 1;
        const float* resid = (l == 0) ? c.x() : WSP(float, WS_XA);
        if (IN(pb + 0)) { if (l == 0) phase_norm(c, c.x(), nullptr, nullptr, nullptr, WSP(bf16_t, WS_H0));
                          else phase_norm(c, WSP(float, WS_XA), WSP(bf16_t, WS_Y), WSP(bf16_t, WS_Y) + (size_t)M * D, WSP(float, WS_XA), WSP(bf16_t, WS_H0));
#if PROBE_DOUBLE == 6
                          if (l == 0) phase_norm(c, c.x(), nullptr, nullptr, nullptr, WSP(bf16_t, WS_HG));
                          else phase_norm(c, WSP(float, WS_XA), WSP(bf16_t, WS_Y), WSP(bf16_t, WS_Y) + (size_t)M * D, WSP(float, WS_P1), WSP(bf16_t, WS_QB));
#endif
        } SEAM(pb + 0);
        if (IN(pb + 1)) REP(2) { pg8::Cfg g{(unsigned)(D * 2), 128u, (unsigned)(D * 2), D / 64, nullptr}; pg8::DenseOrder S; S.init(M / 256, P1W / 256, c.G, c.bid, WSP(bf16_t, WS_H0), (size_t)256 * D * 2, WSP(bf16_t, WS_WINT) + (size_t)l * P1W * D, (size_t)256 * D * 2);
            EpiStoreBf16 E{WSP(bf16_t, WS_P1), P1W, nullptr, 0}; pg8::gemm_phase<false>(ring, c.wave, g, S, E); } SEAM(pb + 1);
        if (IN(pb + 2)) {
            const bool split = c.G >= 64;
            if (!split || c.bid < c.G - 32) phase_prep(c, l, c.bid, split ? c.G - 32 : c.G);
            if (!split || c.bid >= c.G - 32) { pg8::Cfg g{(unsigned)(16 * P1W * 2), (unsigned)(P1W * 2), 4096u, 16, nullptr};
                CmpOrder S{split ? 32 : c.G, split ? c.bid - (c.G - 32) : c.bid, (const char*)WSP(bf16_t, WS_P1), (const char*)(WSP(bf16_t, WS_WC1T) + (size_t)l * 2 * 256 * 2048)};
                EpiCmpSlab E{WSP(float, WS_SL)}; pg8::gemm_phase<false>(ring, c.wave, g, S, E); }
        } SEAM(pb + 2);
        if (IN(pb + 3)) REP(2) {
            phase_cmp2(c, l); phase_chunk_prefix(c);
            { pg8::Cfg g{(unsigned)(P1W * 2), 128u, 512u, 4, nullptr}; pg8::DenseOrder S; S.init(M / 256, 2, c.G, c.bid, WSP(bf16_t, WS_P1) + C_CQ, (size_t)256 * P1W * 2, WSP(bf16_t, WS_WUQT) + (size_t)l * 768 * 256, (size_t)256 * 512);
              EpiStoreBf16 E{WSP(bf16_t, WS_QB), 768, WSP(float, WS_RSTD), 2}; pg8::gemm_phase<false>(ring, c.wave, g, S, E); }
            { pg8::Cfg g{(unsigned)(P1W * 2), 128u, 512u, 4, nullptr}; pg8::DenseOrder S; S.init(M / 256, 1, c.G, (c.bid + 128) % c.G, WSP(bf16_t, WS_P1) + C_CQ, (size_t)256 * P1W * 2, WSP(bf16_t, WS_WUQT) + (size_t)l * 768 * 256 + (size_t)512 * 256, (size_t)256 * 512);
              EpiUqRope E{WSP(bf16_t, WS_QB) + 512, WSP(float, WS_RSTD), WSP(float, WS_ROPE), WSP(float, WS_ROPE) + (size_t)M * 16}; pg8::gemm_phase<false>(ring, c.wave, g, S, E); }
            { pg8::Cfg g{(unsigned)(P1W * 2), 128u, 256u, 2, nullptr}; pg8::DenseOrder S; S.init(M / 256, 4, c.G, c.bid, WSP(bf16_t, WS_P1) + C_CKV, (size_t)256 * P1W * 2, WSP(bf16_t, WS_WUKVT) + (size_t)l * 1024 * 128, (size_t)256 * 256);
              EpiStoreBf16 E{WSP(bf16_t, WS_KVB), 1024, WSP(float, WS_RSTD) + 1, 2}; pg8::gemm_phase<false>(ring, c.wave, g, S, E); }
        } SEAM(pb + 3);
        if (IN(pb + 6)) { phase_att_fast(c, l);
#if PROBE_DOUBLE == 1
            phase_att_fast(c, l + 2);
#endif
        } SEAM(pb + 6);
        if (IN(pb + 7)) REP(5) { phase_norm(c, resid, nullptr, nullptr, nullptr, WSP(bf16_t, WS_HG)); } SEAM(pb + 7);
        if (IN(pb + 8)) REP(2) { pg8::Cfg g{(unsigned)(D * 2), 128u, (unsigned)(D * 2), D / 64, nullptr}; pg8::DenseOrder S; S.init(M / 256, 12, c.G, c.bid, WSP(bf16_t, WS_HG), (size_t)256 * D * 2, WSP(bf16_t, WS_WMT) + (size_t)l * 3072 * D, (size_t)256 * D * 2);
            EpiGates E{WSP(bf16_t, WS_GATES), c.b_merge() + l * 3072}; pg8::gemm_phase<false>(ring, c.wave, g, S, E); } SEAM(pb + 8);
        if (IN(pb + 9)) REP(2) {
#pragma unroll 1
            for (int br = 0; br < 3; ++br) { pg8::Cfg g{1024u, 128u, 1024u, 8, nullptr}; pg8::DenseOrder S;
                S.init(M / 256, 4, c.G, c.bid, WSP(bf16_t, br == 0 ? WS_OUTA : br == 1 ? WS_OUTB : WS_OUTC), (size_t)256 * 1024, WSP(bf16_t, WS_WOT) + ((size_t)l * 3 + br) * 1024 * 512, (size_t)256 * 1024);
                EpiOutproj E{WSP(bf16_t, WS_MIXED), WSP(bf16_t, WS_GATES), br}; pg8::gemm_phase<false>(ring, c.wave, g, S, E); }
        } SEAM(pb + 9);
        if (IN(pb + 10)) { pg8::Cfg g{(unsigned)(D * 2), 128u, (unsigned)(D * 2), D / 64, nullptr}; pg8::DenseOrder S; S.init(M / 256, 4, c.G, c.bid, WSP(bf16_t, WS_MIXED), (size_t)256 * D * 2, WSP(bf16_t, WS_WOUTT) + (size_t)l * D * D, (size_t)256 * D * 2);
            EpiWout E{resid, WSP(float, WS_XA)}; pg8::gemm_phase<false>(ring, c.wave, g, S, E);
#if PROBE_DOUBLE == 6
            { EpiWout E2{resid, (float*)(c.ws + PB + 32 * MiB)}; pg8::gemm_phase<false>(ring, c.wave, g, S, E2); }
#endif
        } SEAM(pb + 10);
        if (IN(pb + 11)) { phase_router(c, l);
#if PROBE_DOUBLE == 3
            phase_router(c, l, 1);
#endif
        } SEAM(pb + 11);
        if (IN(pb + 12)) REP(4) { phase_place(c, l); } SEAM(pb + 12);
        if (IN(pb + 13)) REP(2) { LAS int* tab = (LAS int*)(c.lds + LDS_MOETAB); moe_tables(c, l, tab);
            pg8::Cfg g{(unsigned)(D * 2), 128u, (unsigned)(D * 2), D / 64, WSP(int, WS_LTOK)}; MoeOrder S{c.G, c.bid, 2, tab, (const char*)WSP(bf16_t, WS_H2), 0, (const char*)WSP(bf16_t, WS_WGU), (size_t)512 * D * 2, (size_t)256 * D * 2};
            EpiMoe1 E{WSP(bf16_t, WS_HID), WSP(float, WS_LW)}; pg8::gemm_phase<true>(ring, c.wave, g, S, E); } SEAM(pb + 13);
        if (IN(pb + 14)) REP(2) { LAS int* tab = (LAS int*)(c.lds + LDS_MOETAB); moe_tables(c, l, tab);
            pg8::Cfg g{512u, 128u, 512u, 4, nullptr}; MoeOrder S{c.G, c.bid, 4, tab, (const char*)WSP(bf16_t, WS_HID), 512, (const char*)WSP(bf16_t, WS_WDT), (size_t)D * 256 * 2, (size_t)256 * 256 * 2};
            EpiMoe2 E{WSP(bf16_t, WS_Y), WSP(unsigned, WS_LSLOT)}; pg8::gemm_phase<false>(ring, c.wave, g, S, E); } SEAM(pb + 14);
    }
    if (IN(K_FINAL)) REP(6) { phase_final(c); }
#undef IN
#undef SEAM
}

template <int KIND> static bool prep_kernel() { return hipFuncSetAttribute((const void*)fwd_kernel<KIND>, hipFuncAttributeMaxDynamicSharedMemorySize, LDS_BYTES) == hipSuccess; }
template <int KIND> static void launch_kind(int grid, hipStream_t stream, Args a, int l) { a.l_lo = l; a.l_hi = l + 1; hipLaunchKernelGGL(fwd_kernel<KIND>, dim3(grid), dim3(NTHREADS), LDS_BYTES, stream, a); }
extern "C" void kernel_launch(void* const* d_in, const int* in_sizes, int n_in, void* d_out, int out_size, void* d_ws, size_t ws_size, hipStream_t stream) {
    static int grid = 0;
    if (grid == 0) {
        if (n_in != 32 || ws_size < WS_END) { fprintf(stderr, "kernel_launch: n_in %d ws %zu (need %zu)\n", n_in, ws_size, (size_t)WS_END); grid = -1; return; }
        int dev = 0, cus = 0;
        if (hipGetDevice(&dev) != hipSuccess || hipDeviceGetAttribute(&cus, hipDeviceAttributeMultiprocessorCount, dev) != hipSuccess) { grid = -1; return; }
        bool ok = true;
#if MK_ONE_LAUNCH
        ok = prep_kernel<-1>();
#else
        ok = prep_kernel<0>() && prep_kernel<1>() && prep_kernel<2>() && prep_kernel<3>() && prep_kernel<4>() && prep_kernel<5>() && prep_kernel<6>() && prep_kernel<7>() && prep_kernel<8>() && prep_kernel<9>()
          && prep_kernel<10>() && prep_kernel<11>() && prep_kernel<12>() && prep_kernel<13>() && prep_kernel<14>() && prep_kernel<15>() && prep_kernel<16>();
#endif
        if (!ok) { grid = -1; return; }
        (void)hipGetLastError();
        grid = cus;
    }
    if (grid < 0) return;
    (void)hipMemsetAsync((char*)d_ws + WS_CTL, 0, CTL_BYTES, stream);
    Args a{};
    for (int i = 0; i < 32; ++i) a.in[i] = d_in[i];
    a.out = (float*)d_out; a.ws = (unsigned char*)d_ws;
#if MK_ONE_LAUNCH
    a.l_lo = 0; a.l_hi = NL;
    hipLaunchKernelGGL(fwd_kernel<-1>, dim3(grid), dim3(NTHREADS), LDS_BYTES, stream, a);
#else
    launch_kind<0>(grid, stream, a, 0);
    for (int l = 0; l < NL; ++l) {
        launch_kind<1>(grid, stream, a, l); launch_kind<2>(grid, stream, a, l); launch_kind<3>(grid, stream, a, l); launch_kind<4>(grid, stream, a, l); launch_kind<5>(grid, stream, a, l);
        launch_kind<6>(grid, stream, a, l); launch_kind<7>(grid, stream, a, l); launch_kind<8>(grid, stream, a, l); launch_kind<9>(grid, stream, a, l); launch_kind<10>(grid, stream, a, l);
        launch_kind<11>(grid, stream, a, l); launch_kind<12>(grid, stream, a, l); launch_kind<13>(grid, stream, a, l); launch_kind<14>(grid, stream, a, l); launch_kind<15>(grid, stream, a, l);
    }
    launch_kind<16>(grid, stream, a, 0);
#endif
}
```

```cpp
#include <hip/hip_runtime.h>
#include <stdint.h>
#include <cstdio>

#ifndef PROBE_DOUBLE
#define PROBE_DOUBLE 0
#endif
#ifndef MK_ONE_LAUNCH
#define MK_ONE_LAUNCH 1
#endif

#define LAS __attribute__((address_space(3)))
typedef unsigned short bf16_t;
typedef short bf16x8 __attribute__((ext_vector_type(8)));
typedef float f32x4 __attribute__((ext_vector_type(4)));
typedef float f32x16 __attribute__((ext_vector_type(16)));
typedef unsigned u32x4 __attribute__((ext_vector_type(4)));
typedef unsigned u32x2 __attribute__((ext_vector_type(2)));

constexpr int NB = 2, T = 8192, D = 1024, M = NB * T, NL = 2;
constexpr int DIN = 6336;
constexpr int P1W = 3328;
constexpr int C_NQ = 0, C_NKV = 512, C_CQ = 1280, C_CKV = 1536, C_KR = 1664, C_NG = 1696, C_FF = 1720, C_FQKV = 1728;
constexpr int NEXP = 32, EDIM = 256;
constexpr float EPS = 1e-6f;
constexpr float LOG2E = 1.4426950408889634f;
constexpr float QSCALE64 = 0.125f * LOG2E, QSCALE96 = 0.10206207261596575f * LOG2E;
constexpr int NTHREADS = 512, NWAVES = 8;
constexpr int LDS_BYTES = 147456;
constexpr int MOE_MAXROWS = 40960;

constexpr size_t MiB = 1u << 20;
constexpr size_t WS_CTL = 0;
constexpr size_t CTL_BYTES = 1 * MiB;
constexpr int CW_BAR = 4096;
constexpr int CW_QUEUE = 16384;
constexpr int CW_MOECNT = 32768;
constexpr int CW_KMAX = 24576;
constexpr int CW_CNTB = 65536;
constexpr size_t CTL_LTOK = 512 * 1024;
constexpr size_t WS_WINT = 1 * MiB;
constexpr int NCAT = 6400;
constexpr size_t WS_WUQT = 26 * MiB;
constexpr size_t WS_WUKVT = 27 * MiB;
constexpr size_t WS_WOT = 28 * MiB;
constexpr size_t WS_WOUTT = 34 * MiB;
constexpr size_t WS_WC1T = 38 * MiB;
constexpr size_t WS_ROPE = 42 * MiB;
constexpr size_t WS_TAB = 44 * MiB;
constexpr size_t WS_XA = 45 * MiB;
constexpr size_t PB = 109 * MiB;
constexpr size_t WS_P1 = PB;
constexpr size_t WS_QB = PB + 104 * MiB;
constexpr size_t WS_KVB = PB + 128 * MiB;
constexpr size_t WS_H0 = PB + 128 * MiB;
constexpr size_t WS_GATES = PB + 160 * MiB;
constexpr size_t WS_SM = PB + 208 * MiB;
constexpr size_t WS_RSTD = WS_SM;
constexpr size_t WS_KR = WS_SM + 256 * 1024;
constexpr size_t WS_LF = WS_SM + 1280 * 1024;
constexpr size_t WS_CUM = WS_SM + 1792 * 1024;
constexpr size_t WS_SL = WS_SM + 2304 * 1024;
constexpr size_t WS_KC = WS_SM + 6400 * 1024;
constexpr size_t WS_VC = WS_SM + 6656 * 1024;
constexpr size_t WS_REC = WS_SM + 6912 * 1024;
constexpr size_t WS_LTOK = WS_SM + 7424 * 1024;
constexpr size_t WS_LW = WS_SM + 7616 * 1024;
constexpr size_t WS_LSLOT = WS_SM + 7808 * 1024;
static_assert(WS_LSLOT + MOE_MAXROWS * 4 <= WS_SM + 8 * MiB, "small region");
constexpr size_t WS_END = PB + 216 * MiB;
constexpr size_t WS_MIXED = PB + 128 * MiB;
constexpr size_t WS_Y = PB;
constexpr size_t WS_H2 = PB + 64 * MiB;
constexpr size_t WS_WGU = PB + 96 * MiB;
constexpr size_t WS_WDT = PB + 128 * MiB;
constexpr size_t WS_HID = PB + 144 * MiB;
static_assert(WS_Y + 64 * MiB <= WS_H0 && WS_HID + (size_t)MOE_MAXROWS * 512 <= WS_SM, "phase-region overlays");
static_assert(WS_END <= 332 * MiB, "workspace budget");

__device__ __forceinline__ float bf2f(bf16_t v) { return __uint_as_float((unsigned)v << 16); }
__device__ __forceinline__ unsigned f2bf(float f) { unsigned u = __float_as_uint(f); return (u + 0x7fffu + ((u >> 16) & 1u)) >> 16; }
__device__ __forceinline__ unsigned pk2(float lo, float hi) { return f2bf(lo) | (f2bf(hi) << 16); }
typedef float f32x2_t __attribute__((ext_vector_type(2))); typedef __bf16 bf16x2_t __attribute__((ext_vector_type(2)));
__device__ __forceinline__ unsigned cvtpk(float lo, float hi) { f32x2_t v = {lo, hi}; bf16x2_t b = __builtin_convertvector(v, bf16x2_t); return __builtin_bit_cast(unsigned, b); }
__device__ __forceinline__ f32x4 unpk4(u32x2 a) { f32x4 r; r.x = __uint_as_float(a.x << 16); r.y = __uint_as_float(a.x & 0xffff0000u); r.z = __uint_as_float(a.y << 16); r.w = __uint_as_float(a.y & 0xffff0000u); return r; }
template <int CTRL> __device__ __forceinline__ float dpp_f(float v) { return __int_as_float(__builtin_amdgcn_update_dpp(0, __float_as_int(v), CTRL, 0xf, 0xf, true)); }
__device__ __forceinline__ float wave_sum(float v) {
    v += dpp_f<0xB1>(v); v += dpp_f<0x4E>(v); v += dpp_f<0x141>(v); v += dpp_f<0x140>(v);
    const float a = __int_as_float(__builtin_amdgcn_readlane(__float_as_int(v), 0)), b = __int_as_float(__builtin_amdgcn_readlane(__float_as_int(v), 16));
    const float c2 = __int_as_float(__builtin_amdgcn_readlane(__float_as_int(v), 32)), d = __int_as_float(__builtin_amdgcn_readlane(__float_as_int(v), 48));
    return (a + b) + (c2 + d);
}
__device__ __forceinline__ float wave_max(float v) {
    v = fmaxf(v, dpp_f<0xB1>(v)); v = fmaxf(v, dpp_f<0x4E>(v)); v = fmaxf(v, dpp_f<0x141>(v)); v = fmaxf(v, dpp_f<0x140>(v));
    const float a = __int_as_float(__builtin_amdgcn_readlane(__float_as_int(v), 0)), b = __int_as_float(__builtin_amdgcn_readlane(__float_as_int(v), 16));
    const float c2 = __int_as_float(__builtin_amdgcn_readlane(__float_as_int(v), 32)), d = __int_as_float(__builtin_amdgcn_readlane(__float_as_int(v), 48));
    return fmaxf(fmaxf(a, b), fmaxf(c2, d));
}
__device__ __forceinline__ float half_sum(float v) { auto rr = __builtin_amdgcn_permlane32_swap(__float_as_uint(v), __float_as_uint(v), false, false); return __uint_as_float(rr[0]) + __uint_as_float(rr[1]); }
__device__ __forceinline__ float sigmoidf_(float x) { return 1.f / (1.f + __expf(-x)); }
__device__ __forceinline__ float gelu_tanh(float x) { const float u = 0.7978845608028654f * (x + 0.044715f * x * x * x); const float th = 1.f - 2.f / (1.f + __expf(2.f * u)); return 0.5f * x * (1.f + th); }
#define LDS_WAIT() asm volatile("s_waitcnt lgkmcnt(0)" ::: "memory")

#define XB_TMO      128
#define XB_XCNT(j)  (256  + 64 * (j))
#define XB_XSUB(j)  (1280 + 64 * (j))
#define XB_XGEN(j)  (2304 + 64 * (j))
#define XB_TOP      3328
#define XB_TOPGEN   3392
#define XCD_BAR_WORDS 3456
#define XB_SPIN_CAP (1u << 18)

__device__ __forceinline__ unsigned xb_ld(unsigned* p)              { return __hip_atomic_load(p, __ATOMIC_RELAXED, __HIP_MEMORY_SCOPE_AGENT); }
__device__ __forceinline__ unsigned xb_add(unsigned* p, unsigned v) { return __hip_atomic_fetch_add(p, v, __ATOMIC_RELAXED, __HIP_MEMORY_SCOPE_AGENT); }
__device__ __forceinline__ unsigned xb_xcc_id() { return (unsigned)__builtin_amdgcn_s_getreg((3 << 11) | 20) & 0xFu; }
#define XB_SPIN(cond, bar) do { unsigned _sp = 0; while (cond) { __builtin_amdgcn_s_sleep(1); \
    if ((++_sp & 255u) == 0u) { if (xb_ld(&(bar)[XB_TMO])) break; if (_sp > XB_SPIN_CAP) { atomicAdd(&(bar)[XB_TMO], 1u); break; } } } } while (0)

struct XcdBarrier { unsigned* bar; unsigned x; volatile LAS unsigned* st; };

__device__ __forceinline__ XcdBarrier xcd_barrier_post(unsigned* bar, volatile LAS unsigned* st) {
    XcdBarrier b; b.bar = bar; b.x = xb_xcc_id(); b.st = st;
    if (threadIdx.x == 0) (void)xb_add(&bar[XB_XCNT(b.x)], 1u);
    return b;
}
__device__ __forceinline__ void xcd_barrier_complete(unsigned* bar, unsigned x, unsigned& nloc, unsigned& nx) {
    const unsigned G = gridDim.x * gridDim.y * gridDim.z;
    unsigned sum, cnt, mine, sp = 0u;
    for (;;) {
        sum = 0u; cnt = 0u; mine = 0u;
#pragma unroll
        for (unsigned j = 0; j < 16; ++j) { const unsigned c = xb_ld(&bar[XB_XCNT(j)]); sum += c; cnt += (c > 0u) ? 1u : 0u; mine = (j == x) ? c : mine; }
        if (sum == G) break;
        __builtin_amdgcn_s_sleep(1);
        if ((++sp & 255u) == 0u) { if (xb_ld(&bar[XB_TMO])) break; if (sp > XB_SPIN_CAP) { atomicAdd(&bar[XB_TMO], 1u); break; } }
    }
    nloc = mine > 0u ? mine : 1u; nx = cnt > 0u ? cnt : 1u;
}
__device__ __forceinline__ void xcd_barrier(const XcdBarrier& b) {
    asm volatile("s_waitcnt vmcnt(0)" ::: "memory");
    __syncthreads();
    if (threadIdx.x == 0) {
        unsigned* bar = b.bar;
        __builtin_amdgcn_s_waitcnt(0);
        unsigned nloc = b.st[0], nx = b.st[1];
        if (nloc == 0u) { xcd_barrier_complete(bar, b.x, nloc, nx); b.st[0] = nloc; b.st[1] = nx; }
        const unsigned old = xb_add(&bar[XB_XSUB(b.x)], 1u);
        const unsigned gen = old / nloc;
        if (old + 1u == (gen + 1u) * nloc) {
            __builtin_amdgcn_fence(__ATOMIC_RELEASE, "agent");
            asm volatile("s_waitcnt vmcnt(0)" ::: "memory");
            const unsigned og = xb_add(&bar[XB_TOP], 1u);
            const unsigned tg = og / nx;
            if (og + 1u == (tg + 1u) * nx) xb_add(&bar[XB_TOPGEN], 1u);
            else XB_SPIN(xb_ld(&bar[XB_TOPGEN]) == tg, bar);
            __builtin_amdgcn_fence(__ATOMIC_ACQUIRE, "agent");
            xb_add(&bar[XB_XGEN(b.x)], 1u);
            asm volatile("s_waitcnt vmcnt(0)" ::: "memory");
        } else {
            XB_SPIN(xb_ld(&bar[XB_XGEN(b.x)]) == gen, bar);
            __builtin_amdgcn_fence(__ATOMIC_ACQUIRE, "agent");
            asm volatile("s_waitcnt vmcnt(0)" ::: "memory");
        }
    }
    __syncthreads();
}

namespace pg8 {
constexpr int BM = 256, BK = 64, HALF = 128, HTB = HALF * BK * 2, STAGE_BYTES = 8 * HTB;
__host__ __device__ __forceinline__ int lds_byte(int r, int c) { const int st = (r >> 4) * 2 + (c >> 5), rr = r & 15, cc = c & 31, ob = rr * 64 + cc * 2; return st * 1024 + (ob ^ (((ob >> 9) & 1) << 5)); }
__host__ __device__ __forceinline__ void stage_rc(int b, int& R, int& C) { const int st = b / 1024, sb = b % 1024, swz = sb ^ (((sb >> 9) & 1) << 5); R = (st >> 1) * 16 + swz / 64; C = (st & 1) * 32 + (swz % 64) / 2; }

struct Unit { int pm, pn; const char* A; const char* B; int aux; };
struct Cfg { unsigned lda; unsigned kstepA; unsigned ldb; int nt; const int* rowidx; };

struct DenseOrder {
    int nM, nN, nwg, G, c; const char* A; const char* B; size_t tstepA, tstepB;
    __device__ void init(int nM_, int nN_, int G_, int c_, const void* A_, size_t tstepA_, const void* B_, size_t tstepB_) { nM = nM_; nN = nN_; nwg = nM * nN; G = G_; c = c_; A = (const char*)A_; B = (const char*)B_; tstepA = tstepA_; tstepB = tstepB_; }
    __device__ bool next(int i, Unit& u) const {
        const long Lq = (long)i * G + c; if (Lq >= nwg) return false;
        int wgid = (int)Lq; { const int q = nwg / 8, r = nwg % 8, xcd = wgid % 8, off = wgid / 8; wgid = (xcd < r ? xcd * (q + 1) : r * (q + 1) + (xcd - r) * q) + off; }
        const int nig = 8 * nN, gid = wgid / nig, fm = gid * 8, gsz = (nM - fm) < 8 ? (nM - fm) : 8;
        u.pm = fm + ((wgid % nig) % gsz); u.pn = (wgid % nig) / gsz; u.A = A + (size_t)u.pm * tstepA; u.B = B + (size_t)u.pn * tstepB; u.aux = 0; return true;
    }
};

#define PG8_EPI_ROWCOL(row, col) const int row = u.pm * 256 + ai * 128 + wr * 64 + m * 16 + fr; const int col = u.pn * 256 + bj * 128 + wc * 32 + n * 16 + fq * 4;

template <bool INDEXED, class Epi, class Sched>
__device__ __forceinline__ void gemm_phase(LAS unsigned char* lds, int wid, const Cfg g, const Sched& S, const Epi& E) {
    int lane_; asm volatile("v_mbcnt_lo_u32_b32 %0, -1, 0\n\tv_mbcnt_hi_u32_b32 %0, -1, %0" : "=v"(lane_));
    const int lane = lane_, tid = wid * 64 + lane, wr = wid >> 2, wc = wid & 3, fr = lane & 15, fq = lane >> 4;
    const int nt = g.nt;
    int Rs[2], Cs[2]; unsigned voffB[2];
#pragma unroll
    for (int i = 0; i < 2; ++i) { stage_rc(tid * 16 + i * 8192, Rs[i], Cs[i]); voffB[i] = (unsigned)Rs[i] * g.ldb + (unsigned)Cs[i] * 2u; }
    const size_t kstepA = g.kstepA, kstepB = (size_t)(BK * 2);
    const size_t hstepB = (size_t)HALF * g.ldb;
    const unsigned ldsw = (unsigned)wid * 1024u;
    const int aoff = lds_byte(wr * 64 + fr, fq * 8), boff = lds_byte(wc * 32 + fr, fq * 8);
#define PG8_SA(b, h) (((b) * 2 + (h)) * HTB)
#define PG8_SB(b, h) ((4 + (b) * 2 + (h)) * HTB)
#define PG8_STAGE2(bufoff, gbase, v0, v1) do { const char* gb_ = (const char*)(gbase); asm volatile("" : "+s"(gb_)); \
        __builtin_amdgcn_global_load_lds((const unsigned*)(gb_ + (v0)), (LAS unsigned*)(lds + (bufoff) + ldsw), 16, 0, 0); \
        __builtin_amdgcn_global_load_lds((const unsigned*)(gb_ + (v1)), (LAS unsigned*)(lds + (bufoff) + ldsw + 8192), 16, 0, 0); } while (0)
#define PG8_STAGEB(bufoff, gbase) PG8_STAGE2(bufoff, gbase, voffB[0], voffB[1])
#define PG8_LDA(dst, b, h) do { _Pragma("unroll") for (int m = 0; m < 4; ++m) _Pragma("unroll") for (int k = 0; k < 2; ++k) dst[m][k] = *(const LAS bf16x8*)(lds + PG8_SA(b, h) + aoff + m * 2048 + k * 1024); } while (0)
#define PG8_LDB(dst, b, h) do { _Pragma("unroll") for (int n = 0; n < 2; ++n) _Pragma("unroll") for (int k = 0; k < 2; ++k) dst[n][k] = *(const LAS bf16x8*)(lds + PG8_SB(b, h) + boff + n * 2048 + k * 1024); } while (0)
#define PG8_MMA(ai, bj, At, Bt) do { __builtin_amdgcn_s_setprio(1); _Pragma("unroll") for (int m = 0; m < 4; ++m) _Pragma("unroll") for (int n = 0; n < 2; ++n) _Pragma("unroll") for (int k = 0; k < 2; ++k) \
        acc[ai][bj][m][n] = __builtin_amdgcn_mfma_f32_16x16x32_bf16(Bt[n][k], At[m][k], acc[ai][bj][m][n], 0, 0, 0); __builtin_amdgcn_s_setprio(0); } while (0)
#define PG8_WAIT_V(n) asm volatile("s_waitcnt vmcnt(" #n ")" ::: "memory")
#define PG8_WAIT_L(n) asm volatile("s_waitcnt lgkmcnt(" #n ")" ::: "memory")
#define PG8_BAR __builtin_amdgcn_s_barrier()
#define PG8_SCHED __builtin_amdgcn_sched_barrier(0)
    Unit cur, nxt; int ui = 0;
    if (!S.next(0, cur)) return;
    unsigned vAc[2][2], vAn[2][2];
#define PG8_SETVA(v, U) do { _Pragma("unroll") for (int h_ = 0; h_ < 2; ++h_) _Pragma("unroll") for (int i_ = 0; i_ < 2; ++i_) { \
        if constexpr (INDEXED) { const int r_ = g.rowidx[(U).aux + h_ * HALF + Rs[i_]]; v[h_][i_] = (unsigned)r_ * g.lda + (unsigned)Cs[i_] * 2u; } \
        else v[h_][i_] = (unsigned)(h_ * HALF + Rs[i_]) * g.lda + (unsigned)Cs[i_] * 2u; } } while (0)
    PG8_SETVA(vAc, cur);
    f32x4 acc[2][2][4][2];
#pragma unroll
    for (int a = 0; a < 2; ++a)
#pragma unroll
        for (int b = 0; b < 2; ++b)
#pragma unroll
            for (int m = 0; m < 4; ++m)
#pragma unroll
                for (int n = 0; n < 2; ++n) acc[a][b][m][n] = (f32x4){0.f, 0.f, 0.f, 0.f};
    bf16x8 At[4][2], B0[2][2], B1[2][2];
    const char* cA = cur.A; const char* cB = cur.B;
    PG8_STAGEB(PG8_SB(0, 0), cB); PG8_STAGEB(PG8_SB(0, 1), cB + hstepB); PG8_STAGE2(PG8_SA(0, 0), cA, vAc[0][0], vAc[0][1]); PG8_STAGE2(PG8_SA(0, 1), cA, vAc[1][0], vAc[1][1]);
    if (wr == 1) PG8_BAR;
    PG8_WAIT_V(2); PG8_BAR;
    PG8_STAGEB(PG8_SB(1, 0), cB + kstepB); PG8_STAGE2(PG8_SA(1, 0), cA + kstepA, vAc[0][0], vAc[0][1]); PG8_STAGEB(PG8_SB(1, 1), cB + hstepB + kstepB);
    PG8_WAIT_V(6); PG8_BAR;
    for (;;) {
        const bool has_next = S.next(ui + 1, nxt);
        const char* nA = has_next ? nxt.A : cA; const char* nB = has_next ? nxt.B : cB;
        if (has_next) { PG8_SETVA(vAn, nxt); } else {
#pragma unroll
            for (int h_ = 0; h_ < 2; ++h_)
#pragma unroll
                for (int i_ = 0; i_ < 2; ++i_) vAn[h_][i_] = vAc[h_][i_]; }
        for (int t = 0; t < nt; t += 2) {
            const bool last = (t == nt - 2);
            const char* a1 = cA + (size_t)(t + 1) * kstepA;
            const char* a2 = last ? nA : cA + (size_t)(t + 2) * kstepA; const char* b2 = last ? nB : cB + (size_t)(t + 2) * kstepB;
            const char* a3 = a2 + kstepA; const char* b3 = b2 + kstepB;
            const unsigned w00 = last ? vAn[0][0] : vAc[0][0], w01 = last ? vAn[0][1] : vAc[0][1], w10 = last ? vAn[1][0] : vAc[1][0], w11 = last ? vAn[1][1] : vAc[1][1];
            PG8_LDB(B0, 0, 0); PG8_LDB(B1, 0, 1); PG8_SCHED; PG8_LDA(At, 0, 0); PG8_STAGE2(PG8_SA(1, 1), a1, vAc[1][0], vAc[1][1]);
            PG8_WAIT_V(8); PG8_WAIT_L(0); PG8_BAR; PG8_MMA(0, 0, At, B0); PG8_MMA(0, 1, At, B1); PG8_BAR; PG8_SCHED;
            PG8_LDA(At, 0, 1); PG8_STAGEB(PG8_SB(0, 0), b2); PG8_STAGEB(PG8_SB(0, 1), b2 + hstepB); PG8_STAGE2(PG8_SA(0, 0), a2, w00, w01);
            PG8_WAIT_V(8); PG8_WAIT_L(0); PG8_BAR; PG8_MMA(1, 0, At, B0); PG8_MMA(1, 1, At, B1); PG8_BAR; PG8_SCHED;
            PG8_LDB(B0, 1, 0); PG8_LDB(B1, 1, 1); PG8_SCHED; PG8_LDA(At, 1, 0); PG8_STAGE2(PG8_SA(0, 1), a2, w10, w11);
            PG8_WAIT_V(8); PG8_WAIT_L(0); PG8_BAR; PG8_MMA(0, 0, At, B0); PG8_MMA(0, 1, At, B1); PG8_BAR; PG8_SCHED;
            PG8_LDA(At, 1, 1); PG8_STAGEB(PG8_SB(1, 0), b3); PG8_STAGEB(PG8_SB(1, 1), b3 + hstepB); PG8_STAGE2(PG8_SA(1, 0), a3, w00, w01);
            PG8_WAIT_V(8); PG8_WAIT_L(0); PG8_BAR; PG8_MMA(1, 0, At, B0); PG8_MMA(1, 1, At, B1); PG8_BAR; PG8_SCHED;
        }
        if (wr == 0) PG8_BAR;
        { int l2_; asm volatile("v_mbcnt_lo_u32_b32 %0, -1, 0\n\tv_mbcnt_hi_u32_b32 %0, -1, %0" : "=v"(l2_)); E(acc, cur, wr, wc, l2_ & 15, l2_ >> 4); }
        if (!has_next) break;
#pragma unroll
        for (int a = 0; a < 2; ++a)
#pragma unroll
            for (int b = 0; b < 2; ++b)
#pragma unroll
                for (int m = 0; m < 4; ++m)
#pragma unroll
                    for (int n = 0; n < 2; ++n) acc[a][b][m][n] = (f32x4){0.f, 0.f, 0.f, 0.f};
        cur = nxt; cA = nA; cB = nB; ++ui;
#pragma unroll
        for (int h_ = 0; h_ < 2; ++h_)
#pragma unroll
            for (int i_ = 0; i_ < 2; ++i_) vAc[h_][i_] = vAn[h_][i_];
        if (wr == 1) PG8_BAR;
    }
    PG8_WAIT_V(0);
    PG8_BAR;
#undef PG8_SA
#undef PG8_SB
#undef PG8_STAGE2
#undef PG8_STAGEB
#undef PG8_LDA
#undef PG8_LDB
#undef PG8_MMA
#undef PG8_WAIT_V
#undef PG8_WAIT_L
#undef PG8_BAR
#undef PG8_SCHED
#undef PG8_SETVA
}
}

constexpr int LDS_MISC = 131072;
constexpr int LDS_MOETAB = LDS_MISC + 64;
constexpr int LDS_INTAB = LDS_MISC + 512;
struct Ctx {
    float* out; unsigned char* ws; unsigned char* ws0;
    LAS unsigned char* lds;
    int tid, lane, wave, G, bid;
    __device__ __forceinline__ const void* inp(int i) const { const LAS unsigned* p = (const LAS unsigned*)(lds + LDS_INTAB) + 2 * i;
        const unsigned lo = (unsigned)__builtin_amdgcn_readfirstlane((int)p[0]), hi = (unsigned)__builtin_amdgcn_readfirstlane((int)p[1]); return (const void*)(const __attribute__((address_space(1))) char*)(((unsigned long long)hi << 32) | lo); }
    __device__ __forceinline__ const float* x() const { return (const float*)inp(0); }
    __device__ __forceinline__ const int* pos() const { return (const int*)inp(1); }
    __device__ __forceinline__ const float* rel_bias() const { return (const float*)inp(2); }
    __device__ __forceinline__ const float* norm_attn() const { return (const float*)inp(3); }
    __device__ __forceinline__ const float* w_in() const { return (const float*)inp(4); }
    __device__ __forceinline__ const float* b_merge() const { return (const float*)inp(5); }
    __device__ __forceinline__ const float* cmp_pe() const { return (const float*)inp(6); }
    __device__ __forceinline__ const float* cmp_k_w1() const { return (const float*)inp(7); }
    __device__ __forceinline__ const float* cmp_k_b1() const { return (const float*)inp(8); }
    __device__ __forceinline__ const float* cmp_k_w2() const { return (const float*)inp(9); }
    __device__ __forceinline__ const float* cmp_v_w1() const { return (const float*)inp(10); }
    __device__ __forceinline__ const float* cmp_v_b1() const { return (const float*)inp(11); }
    __device__ __forceinline__ const float* cmp_v_w2() const { return (const float*)inp(12); }
    __device__ __forceinline__ const float* mla_q_norm() const { return (const float*)inp(13); }
    __device__ __forceinline__ const float* mla_kv_norm() const { return (const float*)inp(14); }
    __device__ __forceinline__ const float* mla_w_uq() const { return (const float*)inp(15); }
    __device__ __forceinline__ const float* mla_w_uk() const { return (const float*)inp(16); }
    __device__ __forceinline__ const float* mla_w_uv() const { return (const float*)inp(17); }
    __device__ __forceinline__ const float* fox_b_f() const { return (const float*)inp(18); }
    __device__ __forceinline__ const float* w_o_nsa() const { return (const float*)inp(19); }
    __device__ __forceinline__ const float* w_o_mla() const { return (const float*)inp(20); }
    __device__ __forceinline__ const float* w_o_fox() const { return (const float*)inp(21); }
    __device__ __forceinline__ const float* w_out() const { return (const float*)inp(22); }
    __device__ __forceinline__ const float* norm_ffn() const { return (const float*)inp(23); }
    __device__ __forceinline__ const float* moe_w_grp() const { return (const float*)inp(24); }
    __device__ __forceinline__ const float* moe_b_grp() const { return (const float*)inp(25); }
    __device__ __forceinline__ const float* moe_w_router() const { return (const float*)inp(26); }
    __device__ __forceinline__ const float* moe_b_router() const { return (const float*)inp(27); }
    __device__ __forceinline__ const float* moe_w_gate() const { return (const float*)inp(28); }
    __device__ __forceinline__ const float* moe_w_up() const { return (const float*)inp(29); }
    __device__ __forceinline__ const float* moe_w_down() const { return (const float*)inp(30); }
    __device__ __forceinline__ const float* norm_final() const { return (const float*)inp(31); }
};
#define WSP(T_, off) ((T_*)(c.ws + (off)))
__device__ __forceinline__ int lane_id_volatile() { int ln; asm volatile("v_mbcnt_lo_u32_b32 %0, -1, 0\n\tv_mbcnt_hi_u32_b32 %0, -1, %0" : "=v"(ln)); return ln; }
__device__ __forceinline__ void relaunder(Ctx& c) { const int ln = lane_id_volatile(); c.lane = ln; c.tid = c.wave * 64 + ln;
    size_t z_ = 0; asm volatile("" : "+s"(z_)); c.ws = c.ws0 + z_; int g_ = c.G, b_ = c.bid, wv_ = c.wave; asm volatile("" : "+s"(g_), "+s"(b_), "+s"(wv_)); c.G = g_; c.bid = b_; c.wave = wv_; }

template <class Map>
__device__ __forceinline__ void transpose_item(const float* W, int ldw, int K, bf16_t* WT, const float* rowscale, Map srcmap, int nblk, LAS float* scr, int item, int lane, float colscale = 1.f) {
    const int kb = item / nblk, nb = item % nblk, k0 = 64 * kb, n0 = 32 * nb;
    const int sc = srcmap(n0 + (lane & 31));
    const int cc = lane & 7;
    float rsc[8];
#pragma unroll
    for (int i = 0; i < 8; ++i) rsc[i] = rowscale ? rowscale[k0 + 8 * cc + i] * colscale : colscale;
    float v[32];
    const float* wp = W + (size_t)(k0 + (lane >> 5)) * ldw + (sc >= 0 ? sc : 0);
#pragma unroll
    for (int i = 0; i < 32; ++i) v[i] = wp[(size_t)(2 * i) * ldw];
    __builtin_amdgcn_sched_barrier(0);
#pragma unroll
    for (int i = 0; i < 32; ++i) scr[(2 * i + (lane >> 5)) * 33 + (lane & 31)] = (sc >= 0) ? v[i] : 0.f;
    LDS_WAIT(); asm volatile("" ::: "memory");
#pragma unroll
    for (int j = 0; j < 4; ++j) { const int n = (lane >> 3) + 8 * j; const LAS float* s = scr + (8 * cc) * 33 + n;
        u32x4 o; o.x = cvtpk(s[0 * 33] * rsc[0], s[1 * 33] * rsc[1]); o.y = cvtpk(s[2 * 33] * rsc[2], s[3 * 33] * rsc[3]); o.z = cvtpk(s[4 * 33] * rsc[4], s[5 * 33] * rsc[5]); o.w = cvtpk(s[6 * 33] * rsc[6], s[7 * 33] * rsc[7]);
        *(u32x4*)(WT + (size_t)(n0 + n) * K + k0 + 8 * cc) = o; }
    LDS_WAIT(); asm volatile("" ::: "memory");
}
struct MapId { int off; __device__ int operator()(int n) const { return n + off; } };
struct MapInproj { __device__ int operator()(int n) const { if (n < 1280) return n; if (n < 1696) return n + 24; if (n < 1720) return n - 416; if (n < 1728) return n + 1536; if (n < 3264) return n - 8; return -1; } };
struct MapUq { __device__ int operator()(int n) const { if (n < 512) return (n >> 6) * 96 + (n & 63); const int r = n - 512; return (r >> 5) * 96 + 64 + (r & 31); } };
struct MapPad128 { __device__ int operator()(int n) const { return n < 128 ? n : -1; } };
struct MapGU { __device__ int operator()(int n) const { return (n >> 8) * 128 + (n & 127); } };

__device__ __forceinline__ int rel_bucket_dev(int n) {
    if (n < 16) return n;
    const float lr = __logf((float)n / 16.f) / 2.0794415416798357f;
    int large = 16 + (int)(lr * 16.f);
    return large < 31 ? large : 31;
}

__device__ __forceinline__ void phase_prologue(const Ctx& c) {
    LAS float* scr = (LAS float*)(c.lds + c.wave * 16384);
    const int gw = c.bid * NWAVES + c.wave, NGW = c.G * NWAVES;
    constexpr int I_WIN = 16 * (P1W / 32), I_WM = 16 * 96, I_UQ = 4 * 24, I_UK = 2 * 16, I_UV = 2 * 16, I_WO = 8 * 32, I_WOUT = 16 * 32, I_C1 = 32 * 8;
    constexpr int PER_L = I_WIN + I_WM + I_UQ + I_UK + I_UV + 3 * I_WO + I_WOUT + 2 * I_C1;
    for (int it = gw; it < NL * PER_L; it += NGW) {
        const int l = it / PER_L; int r = it % PER_L;
        if (r < I_WIN) { const int n0_ = 32 * (r % (P1W / 32)); const float cs_ = (n0_ < 512 || (n0_ >= C_FQKV && n0_ < C_FQKV + 512)) ? QSCALE64 : 1.f;
            transpose_item(c.w_in() + (size_t)l * D * DIN, DIN, D, WSP(bf16_t, WS_WINT) + (size_t)l * NCAT * D, c.norm_attn() + l * D, MapInproj{}, P1W / 32, scr, r, c.lane, cs_); continue; } r -= I_WIN;
        if (r < I_WM) { transpose_item(c.w_in() + (size_t)l * D * DIN, DIN, D, WSP(bf16_t, WS_WINT) + ((size_t)l * NCAT + P1W) * D, c.norm_attn() + l * D, MapId{3264}, 96, scr, r, c.lane); continue; } r -= I_WM;
        if (r < I_UQ) { transpose_item(c.mla_w_uq() + (size_t)l * 256 * 768, 768, 256, WSP(bf16_t, WS_WUQT) + (size_t)l * 768 * 256, c.mla_q_norm() + l * 256, MapUq{}, 24, scr, r, c.lane, QSCALE96); continue; } r -= I_UQ;
        if (r < I_UK) { transpose_item(c.mla_w_uk() + (size_t)l * 128 * 512, 512, 128, WSP(bf16_t, WS_WUKVT) + (size_t)l * 1024 * 128, c.mla_kv_norm() + l * 128, MapId{0}, 16, scr, r, c.lane); continue; } r -= I_UK;
        if (r < I_UV) { transpose_item(c.mla_w_uv() + (size_t)l * 128 * 512, 512, 128, WSP(bf16_t, WS_WUKVT) + (size_t)l * 1024 * 128 + 512 * 128, c.mla_kv_norm() + l * 128, MapId{0}, 16, scr, r, c.lane); continue; } r -= I_UV;
        if (r < I_WO) { transpose_item(c.w_o_nsa() + (size_t)l * 512 * 1024, 1024, 512, WSP(bf16_t, WS_WOT) + ((size_t)l * 3 + 0) * 1024 * 512, nullptr, MapId{0}, 32, scr, r, c.lane); continue; } r -= I_WO;
        if (r < I_WO) { transpose_item(c.w_o_mla() + (size_t)l * 512 * 1024, 1024, 512, WSP(bf16_t, WS_WOT) + ((size_t)l * 3 + 1) * 1024 * 512, nullptr, MapId{0}, 32, scr, r, c.lane); continue; } r -= I_WO;
        if (r < I_WO) { transpose_item(c.w_o_fox() + (size_t)l * 512 * 1024, 1024, 512, WSP(bf16_t, WS_WOT) + ((size_t)l * 3 + 2) * 1024 * 512, nullptr, MapId{0}, 32, scr, r, c.lane); continue; } r -= I_WO;
        if (r < I_WOUT) { transpose_item(c.w_out() + (size_t)l * D * D, D, D, WSP(bf16_t, WS_WOUTT) + (size_t)l * D * D, nullptr, MapId{0}, 32, scr, r, c.lane); continue; } r -= I_WOUT;
        { const int kv = r / I_C1; const float* w = (kv == 0 ? c.cmp_k_w1() : c.cmp_v_w1()) + (size_t)l * 2048 * 128;
          transpose_item(w, 128, 2048, WSP(bf16_t, WS_WC1T) + ((size_t)l * 2 + kv) * 256 * 2048, nullptr, MapPad128{}, 8, scr, r % I_C1, c.lane); }
    }
    { float* rc = WSP(float, WS_ROPE); float* rs = rc + (size_t)M * 16;
      for (int i = c.bid * NTHREADS + c.tid; i < M * 16; i += c.G * NTHREADS) { const int m = i >> 4, j = i & 15;
          const float inv = exp2f(-(float)j * 0.8304820237218407f);   const float ang = (float)c.pos()[m] * inv; double rev = (double)ang * 0.15915494309189535; rev -= floor(rev); const float fr_ = (float)rev; rc[i] = __builtin_amdgcn_cosf(fr_); rs[i] = __builtin_amdgcn_sinf(fr_); } }
    float* tab = WSP(float, WS_TAB);
    if (c.bid == 0) {
        const int l = c.tid >> 8, kv = (c.tid >> 7) & 1, j = c.tid & 127;
        const float* w1 = (kv == 0 ? c.cmp_k_w1() : c.cmp_v_w1()) + (size_t)l * 2048 * 128; const float* b1 = (kv == 0 ? c.cmp_k_b1() : c.cmp_v_b1()) + l * 128; const float* pe = c.cmp_pe() + l * 2048;
        float s = b1[j]; for (int k = 0; k < 2048; ++k) s += pe[k] * w1[(size_t)k * 128 + j];
        tab[c.tid] = s;
    }
    if (c.bid == 1 % c.G) {
        for (int i = c.tid; i < 8 * 129; i += NTHREADS) { const int h = i / 129, d = i % 129; tab[512 + h * 132 + d] = c.rel_bias()[rel_bucket_dev(d) * 8 + h] * LOG2E; }
    }
}

__device__ __forceinline__ void phase_norm(const Ctx& c, const float* src, const bf16_t* y0, const bf16_t* y1, float* rout, bf16_t* hout) {
    const int gw = c.bid * NWAVES + c.wave, NGW = c.G * NWAVES;
    for (int m = gw; m < M; m += NGW) {
        const f32x4* xr = (const f32x4*)(src + (size_t)m * D) + c.lane;
        f32x4 v[4]; float s = 0.f;
#pragma unroll
        for (int j = 0; j < 4; ++j) { v[j] = xr[64 * j];
            if (y0) { const u32x2 a = *((const u32x2*)(y0 + (size_t)m * D) + c.lane + 64 * j); const u32x2 b = *((const u32x2*)(y1 + (size_t)m * D) + c.lane + 64 * j);
                v[j].x += __uint_as_float(a.x << 16) + __uint_as_float(b.x << 16); v[j].y += __uint_as_float(a.x & 0xffff0000u) + __uint_as_float(b.x & 0xffff0000u);
                v[j].z += __uint_as_float(a.y << 16) + __uint_as_float(b.y << 16); v[j].w += __uint_as_float(a.y & 0xffff0000u) + __uint_as_float(b.y & 0xffff0000u); }
            s += (v[j].x * v[j].x + v[j].y * v[j].y) + (v[j].z * v[j].z + v[j].w * v[j].w); }
        const float rstd = rsqrtf(wave_sum(s) * (1.f / D) + EPS);
        if (rout) { f32x4* ro = (f32x4*)(rout + (size_t)m * D) + c.lane;
#pragma unroll
            for (int j = 0; j < 4; ++j) ro[64 * j] = v[j]; }
        u32x2* o8 = (u32x2*)(hout + (size_t)m * D) + c.lane;
#pragma unroll
        for (int j = 0; j < 4; ++j) { u32x2 w; w.x = pk2(v[j].x * rstd, v[j].y * rstd); w.y = pk2(v[j].z * rstd, v[j].w * rstd); o8[64 * j] = w; }
    }
}
__device__ __forceinline__ void phase_final(const Ctx& c) {
    const int gw = c.bid * NWAVES + c.wave, NGW = c.G * NWAVES;
    const float* src = WSP(float, WS_XA); const bf16_t* y0 = WSP(bf16_t, WS_Y); const bf16_t* y1 = y0 + (size_t)M * D;
    for (int m = gw; m < M; m += NGW) {
        const f32x4* xr = (const f32x4*)(src + (size_t)m * D) + c.lane;
        f32x4 v[4]; float s = 0.f;
#pragma unroll
        for (int j = 0; j < 4; ++j) { v[j] = xr[64 * j];
            const u32x2 a = *((const u32x2*)(y0 + (size_t)m * D) + c.lane + 64 * j); const u32x2 b = *((const u32x2*)(y1 + (size_t)m * D) + c.lane + 64 * j);
            v[j].x += __uint_as_float(a.x << 16) + __uint_as_float(b.x << 16); v[j].y += __uint_as_float(a.x & 0xffff0000u) + __uint_as_float(b.x & 0xffff0000u);
            v[j].z += __uint_as_float(a.y << 16) + __uint_as_float(b.y << 16); v[j].w += __uint_as_float(a.y & 0xffff0000u) + __uint_as_float(b.y & 0xffff0000u);
            s += (v[j].x * v[j].x + v[j].y * v[j].y) + (v[j].z * v[j].z + v[j].w * v[j].w); }
        const float rstd = rsqrtf(wave_sum(s) * (1.f / D) + EPS);
        f32x4* ro = (f32x4*)(c.out + (size_t)m * D) + c.lane;
#pragma unroll
        for (int j = 0; j < 4; ++j) { const f32x4 g = *((const f32x4*)c.norm_final() + c.lane + 64 * j); ro[64 * j] = v[j] * rstd * g; }
    }
}

constexpr size_t WS_LC = WS_LF, WS_CT = WS_CUM, WS_CP = WS_CUM + 64 * 1024;
__device__ __forceinline__ void phase_prep(const Ctx& c, int l, int cbid, int cG) {
    const bf16_t* P1 = WSP(bf16_t, WS_P1); float* rstd = WSP(float, WS_RSTD); bf16_t* KR = WSP(bf16_t, WS_KR); float* LC = WSP(float, WS_LC); float* CT = WSP(float, WS_CT);
    const float* rc = WSP(float, WS_ROPE); const float* rs = rc + (size_t)M * 16;
    float kmx0 = 0.f, kmx1 = 0.f;
    LAS unsigned* kml = (LAS unsigned*)(c.lds + 4096); LAS float* wt = (LAS float*)(c.lds + 4096 + 64);
    if (c.tid < 16) kml[c.tid] = 0u;
    __syncthreads();
    const float bf_ = (c.lane < 8) ? c.fox_b_f()[l * 8 + c.lane] : 0.f;
    for (int ch = cbid; ch < M / 64; ch += cG) {
        float run = 0.f, rv[8];
#pragma unroll
        for (int i = 0; i < 8; ++i) { const int m = ch * 64 + c.wave * 8 + i;
            const bf16_t* row = P1 + (size_t)m * P1W;
            const u32x2 a = *((const u32x2*)(row + C_CQ) + c.lane);
            const unsigned b = *((const unsigned*)(row + C_CKV) + c.lane);
            const u32x4 kq = *((const u32x4*)(row + C_FQKV + 512) + c.lane);
            const float x1 = (c.lane < 16) ? bf2f(row[C_KR + c.lane]) : 0.f, x2 = (c.lane < 16) ? bf2f(row[C_KR + 16 + c.lane]) : 0.f;
            const float cs = (c.lane < 16) ? rc[m * 16 + c.lane] : 0.f, sn = (c.lane < 16) ? rs[m * 16 + c.lane] : 0.f;
            const float ff = (c.lane < 8) ? bf2f(row[C_FF + c.lane]) : 0.f;
            float q0 = __uint_as_float(a.x << 16), q1 = __uint_as_float(a.x & 0xffff0000u), q2 = __uint_as_float(a.y << 16), q3 = __uint_as_float(a.y & 0xffff0000u);
            const float sq = wave_sum(q0 * q0 + q1 * q1 + q2 * q2 + q3 * q3);
            float k0 = __uint_as_float(b << 16), k1 = __uint_as_float(b & 0xffff0000u);
            const float sk = wave_sum(k0 * k0 + k1 * k1);
            if (c.lane == 0) { rstd[2 * m] = rsqrtf(sq * (1.f / 256.f) + EPS); rstd[2 * m + 1] = rsqrtf(sk * (1.f / 128.f) + EPS); }
            if (c.lane < 16) { KR[m * 32 + c.lane] = (bf16_t)f2bf(x1 * cs - x2 * sn); KR[m * 32 + 16 + c.lane] = (bf16_t)f2bf(x1 * sn + x2 * cs); }
            { const f32x4 a0 = unpk4((u32x2){kq.x, kq.y}), a1 = unpk4((u32x2){kq.z, kq.w});
              float ss = (a0.x * a0.x + a0.y * a0.y) + (a0.z * a0.z + a0.w * a0.w) + (a1.x * a1.x + a1.y * a1.y) + (a1.z * a1.z + a1.w * a1.w);
              ss += dpp_f<0xB1>(ss); ss += dpp_f<0x4E>(ss); ss += dpp_f<0x141>(ss);
              if (m < T) kmx0 = fmaxf(kmx0, ss); else kmx1 = fmaxf(kmx1, ss); }
            const float f = ff + bf_;
            const float ls = fminf(f, 0.f) - __logf(1.f + __expf(-fabsf(f)));
            run += ls; rv[i] = run; }
        if (c.lane < 8) wt[c.wave * 8 + c.lane] = run;
        __syncthreads();
        if (c.lane < 8) { float pre = 0.f; for (int w_ = 0; w_ < c.wave; ++w_) pre += wt[w_ * 8 + c.lane];
            const int m0 = ch * 64 + c.wave * 8, bb = m0 / T, t0 = m0 % T; float* lc = LC + ((size_t)bb * 8 + c.lane) * T + t0;
#pragma unroll
            for (int i = 0; i < 8; ++i) lc[i] = (pre + rv[i]) * LOG2E;
            if (c.wave == 7) CT[((size_t)bb * 8 + c.lane) * 128 + (t0 >> 6)] = (pre + run) * LOG2E; }
        __syncthreads();
    }
    if ((c.lane & 7) == 0) { atomicMax((unsigned*)(kml + (c.lane >> 3)), __float_as_uint(kmx0)); atomicMax((unsigned*)(kml + 8 + (c.lane >> 3)), __float_as_uint(kmx1)); }
    __syncthreads();
    if (c.tid < 16) atomicMax(WSP(unsigned, WS_CTL) + CW_KMAX + l * 16 + c.tid, kml[c.tid]);
}
__device__ __forceinline__ void phase_chunk_prefix(const Ctx& c) {
    LAS float* sh = (LAS float*)(c.lds + 8192);
    for (int s_ = c.bid; s_ < NB * 8; s_ += c.G) {
        if (c.tid < 128) sh[c.tid] = WSP(float, WS_CT)[(size_t)s_ * 128 + c.tid];
        __syncthreads();
        if (c.tid == 0) { float run = 0.f; float* cp = WSP(float, WS_CP) + (size_t)s_ * 129; for (int i = 0; i < 128; ++i) { cp[i] = run; run += sh[i]; } cp[128] = run; }
        __syncthreads();
    }
}
__device__ __forceinline__ void phase_cmp2(const Ctx& c, int l) {
    const float* SL = WSP(float, WS_SL); const float* bc1 = WSP(float, WS_TAB) + l * 256;
    LAS float* hl = (LAS float*)(c.lds + c.wave * 1024);
    for (int pr = c.bid * NWAVES + c.wave; pr < 2 * 2048; pr += c.G * NWAVES) {
        const int kv = pr >> 11, row = pr & 2047, d = c.lane;
        const float* w2 = (kv == 0 ? c.cmp_k_w2() : c.cmp_v_w2()) + (size_t)l * 128 * 64 + d;
        const float* s0 = SL + ((size_t)kv * 2048 + row) * 128; const float* s1 = s0 + (size_t)2 * 2048 * 128;
        const float a0 = s0[d], a1 = s0[d + 64], b0 = s1[d], b1 = s1[d + 64], c0 = bc1[kv * 128 + d], c1 = bc1[kv * 128 + d + 64];
        hl[d] = gelu_tanh(a0 + b0 + c0); hl[d + 64] = gelu_tanh(a1 + b1 + c1);
        LDS_WAIT(); asm volatile("" ::: "memory");
        float s = 0.f;
#pragma unroll
        for (int jb = 0; jb < 4; ++jb) { float wv[32];
#pragma unroll
            for (int i = 0; i < 32; ++i) wv[i] = w2[(size_t)(32 * jb + i) * 64];
            __builtin_amdgcn_sched_barrier(0);
#pragma unroll
            for (int i = 0; i < 32; ++i) s += hl[32 * jb + i] * wv[i]; }
        if ((row & 511) == 511) s = 0.f;
        (kv == 0 ? WSP(bf16_t, WS_KC) : WSP(bf16_t, WS_VC))[(size_t)row * 64 + d] = (bf16_t)f2bf(s);
        LDS_WAIT(); asm volatile("" ::: "memory");
    }
}
__device__ __forceinline__ u32x2 pk4(f32x4 v) { u32x2 w; w.x = cvtpk(v.x, v.y); w.y = cvtpk(v.z, v.w); return w; }
#define EPI_ARGS const f32x4 (&acc)[2][2][4][2], const pg8::Unit& u, int wr, int wc, int fr, int fq
#define EPI_LOOP _Pragma("unroll") for (int ai = 0; ai < 2; ++ai) _Pragma("unroll") for (int m = 0; m < 4; ++m) _Pragma("unroll") for (int bj = 0; bj < 2; ++bj) _Pragma("unroll") for (int n = 0; n < 2; ++n)

#define EPI_ROW(ai, m) (u.pm * 256 + (ai) * 128 + wr * 64 + (m) * 16 + fr)
#define EPI_COL(bj, n) (u.pn * 256 + (bj) * 128 + wc * 32 + (n) * 16 + fq * 4)
struct EpiStoreBf16 { bf16_t* O; int ldc; const float* rowscale; int rs_stride;
    __device__ __forceinline__ void operator()(EPI_ARGS) const {
        float rs[2][4];
#pragma unroll
        for (int ai = 0; ai < 2; ++ai)
#pragma unroll
            for (int m = 0; m < 4; ++m) rs[ai][m] = rowscale ? rowscale[(size_t)EPI_ROW(ai, m) * rs_stride] : 1.f;
        __builtin_amdgcn_sched_barrier(0);
        EPI_LOOP { const unsigned off = (unsigned)EPI_ROW(ai, m) * (unsigned)ldc + (unsigned)EPI_COL(bj, n); *(u32x2*)(O + off) = pk4(acc[ai][bj][m][n] * rs[ai][m]); } } };
struct EpiUqRope { bf16_t* QB; const float* rstd; const float* ropec; const float* ropes;
    __device__ __forceinline__ void operator()(EPI_ARGS) const {
#pragma unroll
        for (int ai = 0; ai < 2; ++ai) { float rs[4]; f32x4 cs4[4], sn4[4];
#pragma unroll
            for (int m = 0; m < 4; ++m) { const unsigned row = (unsigned)EPI_ROW(ai, m); rs[m] = rstd[(size_t)row * 2]; cs4[m] = *(const f32x4*)(ropec + row * 16u + fq * 4); sn4[m] = *(const f32x4*)(ropes + row * 16u + fq * 4); }
            __builtin_amdgcn_sched_barrier(0);
#pragma unroll
            for (int m = 0; m < 4; ++m)
#pragma unroll
                for (int bj = 0; bj < 2; ++bj) { const f32x4 x1 = acc[ai][bj][m][0] * rs[m], x2 = acc[ai][bj][m][1] * rs[m];
                    const f32x4 o1 = x1 * cs4[m] - x2 * sn4[m], o2 = x1 * sn4[m] + x2 * cs4[m];
                    const unsigned off = (unsigned)EPI_ROW(ai, m) * 768u + (unsigned)EPI_COL(bj, 0);
                    *(u32x2*)(QB + off) = pk4(o1); *(u32x2*)(QB + off + 16) = pk4(o2); }
            __builtin_amdgcn_sched_barrier(0); } } };
struct EpiInprojGates { bf16_t* P1o; unsigned char* G8; const float* bias;
    __device__ __forceinline__ void operator()(EPI_ARGS) const {
        if (u.pn < 13) { EPI_LOOP { *(u32x2*)(P1o + (unsigned)EPI_ROW(ai, m) * (unsigned)P1W + (unsigned)EPI_COL(bj, n)) = pk4(acc[ai][bj][m][n]); } }
        else { f32x4 bv[2][2];
#pragma unroll
            for (int bj = 0; bj < 2; ++bj)
#pragma unroll
                for (int n = 0; n < 2; ++n) bv[bj][n] = *(const f32x4*)(bias + (EPI_COL(bj, n) - P1W));
            __builtin_amdgcn_sched_barrier(0);
            EPI_LOOP { const f32x4 v = acc[ai][bj][m][n] + bv[bj][n];
                const unsigned q0_ = (unsigned)(sigmoidf_(v.x) * 255.f + 0.5f), q1_ = (unsigned)(sigmoidf_(v.y) * 255.f + 0.5f), q2_ = (unsigned)(sigmoidf_(v.z) * 255.f + 0.5f), q3_ = (unsigned)(sigmoidf_(v.w) * 255.f + 0.5f);
                *(unsigned*)(G8 + (size_t)EPI_ROW(ai, m) * 3072u + (unsigned)(EPI_COL(bj, n) - P1W)) = q0_ | (q1_ << 8) | (q2_ << 16) | (q3_ << 24); } } } };
struct EpiGates { bf16_t* O; const float* bias;
    __device__ __forceinline__ void operator()(EPI_ARGS) const {
        f32x4 bv[2][2];
#pragma unroll
        for (int bj = 0; bj < 2; ++bj)
#pragma unroll
            for (int n = 0; n < 2; ++n) bv[bj][n] = *(const f32x4*)(bias + EPI_COL(bj, n));
        __builtin_amdgcn_sched_barrier(0);
        EPI_LOOP { f32x4 v = acc[ai][bj][m][n] + bv[bj][n];
            v.x = sigmoidf_(v.x); v.y = sigmoidf_(v.y); v.z = sigmoidf_(v.z); v.w = sigmoidf_(v.w); *(u32x2*)(O + (unsigned)EPI_ROW(ai, m) * 3072u + (unsigned)EPI_COL(bj, n)) = pk4(v); } } };
struct EpiCmpSlab { float* SL;
    __device__ __forceinline__ void operator()(EPI_ARGS) const {
        const int kv = u.pm >> 4, bg = (u.pm >> 2) & 3, half = (u.pm >> 1) & 1, ksp = u.pm & 1;
#pragma unroll
        for (int ai = 0; ai < 2; ++ai)
#pragma unroll
            for (int m = 0; m < 4; ++m)
#pragma unroll
                for (int n = 0; n < 2; ++n) { const int i = half * 256 + ai * 128 + wr * 64 + m * 16 + fr, cc = wc * 32 + n * 16 + fq * 4;
                    *(f32x4*)(SL + ((size_t)(ksp * 2 + kv) * 2048 + bg * 512 + i) * 128 + cc) = acc[ai][0][m][n]; } } };
struct EpiOutproj { bf16_t* MIX; const unsigned char* G8; int br;
    __device__ __forceinline__ void operator()(EPI_ARGS) const {
#pragma unroll
        for (int ai = 0; ai < 2; ++ai)
#pragma unroll
          for (int mh = 0; mh < 2; ++mh) { unsigned gw[2][2][2]; u32x2 mw[2][2][2];
#pragma unroll
            for (int m2 = 0; m2 < 2; ++m2)
#pragma unroll
                for (int bj = 0; bj < 2; ++bj)
#pragma unroll
                    for (int n = 0; n < 2; ++n) { const unsigned row = (unsigned)EPI_ROW(ai, 2 * mh + m2), col = (unsigned)EPI_COL(bj, n);
                        gw[m2][bj][n] = *(const unsigned*)(G8 + (size_t)row * 3072u + (unsigned)br * 1024u + col); if (br > 0) mw[m2][bj][n] = *(const u32x2*)(MIX + row * 1024u + col); }
            __builtin_amdgcn_sched_barrier(0);
#pragma unroll
            for (int m2 = 0; m2 < 2; ++m2)
#pragma unroll
                for (int bj = 0; bj < 2; ++bj)
#pragma unroll
                    for (int n = 0; n < 2; ++n) { const unsigned g_ = gw[m2][bj][n]; f32x4 gf; gf.x = (float)(g_ & 255u); gf.y = (float)((g_ >> 8) & 255u); gf.z = (float)((g_ >> 16) & 255u); gf.w = (float)(g_ >> 24);
                        f32x4 v = acc[ai][bj][2 * mh + m2][n] * gf * (1.f / 255.f); if (br > 0) v = v + unpk4(mw[m2][bj][n]);
                        *(u32x2*)(MIX + (unsigned)EPI_ROW(ai, 2 * mh + m2) * 1024u + (unsigned)EPI_COL(bj, n)) = pk4(v); }
            __builtin_amdgcn_sched_barrier(0); } } };
struct EpiWout { const float* R; float* XA;
    __device__ __forceinline__ void operator()(EPI_ARGS) const {
#pragma unroll
        for (int ai = 0; ai < 2; ++ai)
#pragma unroll
          for (int mh = 0; mh < 2; ++mh) { f32x4 rv[2][2][2];
#pragma unroll
            for (int m2 = 0; m2 < 2; ++m2)
#pragma unroll
                for (int bj = 0; bj < 2; ++bj)
#pragma unroll
                    for (int n = 0; n < 2; ++n) rv[m2][bj][n] = *(const f32x4*)(R + (unsigned)EPI_ROW(ai, 2 * mh + m2) * 1024u + (unsigned)EPI_COL(bj, n));
            __builtin_amdgcn_sched_barrier(0);
#pragma unroll
            for (int m2 = 0; m2 < 2; ++m2)
#pragma unroll
                for (int bj = 0; bj < 2; ++bj)
#pragma unroll
                    for (int n = 0; n < 2; ++n) *(f32x4*)(XA + (unsigned)EPI_ROW(ai, 2 * mh + m2) * 1024u + (unsigned)EPI_COL(bj, n)) = rv[m2][bj][n] + acc[ai][bj][2 * mh + m2][n];
            __builtin_amdgcn_sched_barrier(0); } } };
struct EpiMoe1 { bf16_t* HID; const float* LW;
    __device__ __forceinline__ void operator()(EPI_ARGS) const {
        int aux_ = u.aux; asm volatile("" : "+s"(aux_));
        float w8[2][4];
#pragma unroll
        for (int ai = 0; ai < 2; ++ai)
#pragma unroll
            for (int m = 0; m < 4; ++m) w8[ai][m] = LW[(unsigned)(aux_ + ai * 128 + wr * 64 + m * 16 + fr)];
        __builtin_amdgcn_sched_barrier(0);
#pragma unroll
        for (int ai = 0; ai < 2; ++ai)
#pragma unroll
            for (int m = 0; m < 4; ++m) { const unsigned pos = (unsigned)(aux_ + ai * 128 + wr * 64 + m * 16 + fr); const float w = w8[ai][m];
#pragma unroll
                for (int n = 0; n < 2; ++n) { const f32x4 g = acc[ai][0][m][n], up = acc[ai][1][m][n]; f32x4 h;
                    h.x = g.x * sigmoidf_(g.x) * up.x * w; h.y = g.y * sigmoidf_(g.y) * up.y * w; h.z = g.z * sigmoidf_(g.z) * up.z * w; h.w = g.w * sigmoidf_(g.w) * up.w * w;
                    *(u32x2*)(HID + pos * 256u + (unsigned)(u.pn * 128 + wc * 32 + n * 16 + fq * 4)) = pk4(h); } } } };
struct EpiMoe2 { bf16_t* Y; const unsigned* LDST;
    __device__ __forceinline__ void operator()(EPI_ARGS) const {
        int aux_ = u.aux; asm volatile("" : "+s"(aux_));
        unsigned d8[2][4];
#pragma unroll
        for (int ai = 0; ai < 2; ++ai)
#pragma unroll
            for (int m = 0; m < 4; ++m) d8[ai][m] = LDST[(unsigned)(aux_ + ai * 128 + wr * 64 + m * 16 + fr)];
        __builtin_amdgcn_sched_barrier(0);
#pragma unroll
        for (int ai = 0; ai < 2; ++ai)
#pragma unroll
            for (int m = 0; m < 4; ++m) { const unsigned d0 = d8[ai][m];
                if (d0 != 0xFFFFFFFFu) { const unsigned off = d0 + (unsigned)(u.pn * 256 + wc * 32 + fq * 4);
#pragma unroll
                    for (int bj = 0; bj < 2; ++bj)
#pragma unroll
                        for (int n = 0; n < 2; ++n) *(u32x2*)(Y + off + bj * 128 + n * 16) = pk4(acc[ai][bj][m][n]); } } } };

struct CmpOrder { int G, c; const char* P1; const char* W;
    __device__ bool next(int i, pg8::Unit& u) const { const int L_ = i * G + c; if (L_ >= 32) return false; const int kv = L_ >> 4, b = (L_ >> 3) & 1, g = (L_ >> 2) & 1, half = (L_ >> 1) & 1, ks = L_ & 1;
        u.pm = L_; u.pn = 0; u.aux = 0; u.A = P1 + ((size_t)(b * T + 16 * 256 * half + 16 * ks) * P1W + C_NKV + (kv * 2 + g) * 64) * 2; u.B = W + ((size_t)kv * 256 * 2048 + (size_t)ks * 1024) * 2; return true; } };
struct MoeOrder { int G, c, nN; const LAS int* tab; const char* A; size_t a_rowbytes; const char* W; size_t w_expert, w_tile;
    __device__ bool next(int i, pg8::Unit& u) const { const int L_ = i * G + c; const int NT = __builtin_amdgcn_readfirstlane(tab[32]); if (L_ >= NT * nN) return false; const int rt = L_ / nN, pn = L_ % nN;
        int e = 0; while (__builtin_amdgcn_readfirstlane(tab[e + 1]) <= rt) ++e;
        const int off_e = __builtin_amdgcn_readfirstlane(tab[33 + e]), ts_e = __builtin_amdgcn_readfirstlane(tab[e]), cnt_e = __builtin_amdgcn_readfirstlane(tab[66 + e]);
        const int pos0 = off_e + 256 * (rt - ts_e); u.pn = pn; u.aux = pos0; u.pm = off_e + cnt_e;
        u.A = A + (size_t)pos0 * a_rowbytes; u.B = W + (size_t)e * w_expert + (size_t)pn * w_tile; return true; } };
__device__ __forceinline__ void moe_tables(const Ctx& c, int l, LAS int* tab) {
    if (c.tid == 0) { const unsigned* cnt = WSP(unsigned, WS_CTL) + CW_MOECNT + l * 64; int ts = 0, off = 0;
        for (int e = 0; e < 32; ++e) { const int n = (int)cnt[e]; tab[e] = ts; tab[33 + e] = off; tab[66 + e] = n; const int nt_ = (n + 255) >> 8; ts += nt_; off += nt_ * 256; }
        tab[32] = ts; tab[65] = off; }
    __syncthreads();
}

constexpr int LDS_RSM = LDS_MISC + 1024;
__device__ __forceinline__ void phase_router(const Ctx& c, int l, int dummy = 0) {
    const int gw = c.bid * NWAVES + c.wave, NGW = c.G * NWAVES, lane = c.lane;
    const float* XA = WSP(float, WS_XA); bf16_t* H2 = WSP(bf16_t, WS_H2); int* REC = WSP(int, dummy ? WS_HID : WS_REC); unsigned* cnt = WSP(unsigned, WS_CTL) + CW_MOECNT + (l + 2 * dummy) * 64;
    const float* g2 = c.norm_ffn() + l * D; const float* wg = c.moe_w_grp() + (size_t)l * D * 4; const float* wr_ = c.moe_w_router() + (size_t)l * D * 32;
    const float* bgp = c.moe_b_grp() + l * 4; const float* brp = c.moe_b_router() + l * 32;
    LAS f32x4* Tk = (LAS f32x4*)(c.lds + c.wave * 16384);
    LAS float* PG = (LAS float*)(c.lds + LDS_RSM + c.wave * 1792); LAS float* EL = PG + 256; LAS float* GL = EL + 128;
    LAS unsigned* cntL = (LAS unsigned*)(c.lds + LDS_MOETAB);
    if (c.tid < 32) cntL[c.tid] = 0u;
    __syncthreads();
    for (int task = gw; task < M / 4; task += NGW) {
        const int m0 = task * 4;
        f32x4 v[4][4]; float rs[4];
#pragma unroll
        for (int r = 0; r < 4; ++r) { const f32x4* xr = (const f32x4*)(XA + (size_t)(m0 + r) * D) + lane; float s = 0.f;
#pragma unroll
            for (int j = 0; j < 4; ++j) { v[r][j] = xr[64 * j]; s += (v[r][j].x * v[r][j].x + v[r][j].y * v[r][j].y) + (v[r][j].z * v[r][j].z + v[r][j].w * v[r][j].w); }
            rs[r] = rsqrtf(wave_sum(s) * (1.f / D) + EPS); }
#pragma unroll
        for (int j = 0; j < 4; ++j) { const f32x4 gg = *((const f32x4*)g2 + lane + 64 * j);
#pragma unroll
            for (int r = 0; r < 4; ++r) { v[r][j] = v[r][j] * rs[r]; *((u32x2*)(H2 + (size_t)(m0 + r) * D) + lane + 64 * j) = pk4(v[r][j]); v[r][j] = v[r][j] * gg; }
#pragma unroll
            for (int e = 0; e < 4; ++e) { f32x4 t4; t4.x = v[0][j][e]; t4.y = v[1][j][e]; t4.z = v[2][j][e]; t4.w = v[3][j][e]; Tk[4 * lane + 256 * j + e] = t4; } }
        LDS_WAIT(); asm volatile("" ::: "memory");
        { const int o = lane & 31, sh = lane >> 5; f32x4 acc = {0.f, 0.f, 0.f, 0.f}; const float* wp = wr_ + (size_t)(512 * sh) * 32 + o; const LAS f32x4* tp = Tk + 512 * sh;
#pragma unroll 1
          for (int kb = 0; kb < 512; kb += 32) { float w[32];
#pragma unroll
              for (int i = 0; i < 32; ++i) w[i] = wp[(size_t)(kb + i) * 32];
              __builtin_amdgcn_sched_barrier(0);
#pragma unroll
              for (int i = 0; i < 32; ++i) acc += tp[kb + i] * w[i]; }
          acc.x = half_sum(acc.x); acc.y = half_sum(acc.y); acc.z = half_sum(acc.z); acc.w = half_sum(acc.w);
          if (lane < 32) { const float bb = brp[o]; EL[0 * 32 + o] = acc.x + bb; EL[1 * 32 + o] = acc.y + bb; EL[2 * 32 + o] = acc.z + bb; EL[3 * 32 + o] = acc.w + bb; } }
        { const int og = lane & 3, s16 = lane >> 2; f32x4 acc = {0.f, 0.f, 0.f, 0.f}; const float* wp = wg + (size_t)(64 * s16) * 4 + og; const LAS f32x4* tp = Tk + 64 * s16;
#pragma unroll 1
          for (int kb = 0; kb < 64; kb += 32) { float w[32];
#pragma unroll
              for (int i = 0; i < 32; ++i) w[i] = wp[(size_t)(kb + i) * 4];
              __builtin_amdgcn_sched_barrier(0);
#pragma unroll
              for (int i = 0; i < 32; ++i) acc += tp[kb + i] * w[i]; }
          PG[(0 * 4 + og) * 16 + s16] = acc.x; PG[(1 * 4 + og) * 16 + s16] = acc.y; PG[(2 * 4 + og) * 16 + s16] = acc.z; PG[(3 * 4 + og) * 16 + s16] = acc.w; }
        LDS_WAIT(); asm volatile("" ::: "memory");
        if (lane < 16) { float s = 0.f;
#pragma unroll
            for (int q = 0; q < 16; ++q) s += PG[lane * 16 + q];
            GL[lane] = s + bgp[lane & 3]; }
        LDS_WAIT(); asm volatile("" ::: "memory");
        if (lane < 4) { const int r = lane;
            int gi = 0; float gm = GL[r * 4];
            for (int o = 1; o < 4; ++o) { const float x_ = GL[r * 4 + o]; if (x_ > gm) { gm = x_; gi = o; } }
            float gs = 0.f; for (int o = 0; o < 4; ++o) gs += __expf(GL[r * 4 + o] - gm);
            const float grp_top = 1.f / gs;
            int i1 = 0; float m1 = EL[r * 32 + gi * 8];
            for (int q = 1; q < 8; ++q) { const float x_ = EL[r * 32 + gi * 8 + q]; if (x_ > m1) { m1 = x_; i1 = q; } }
            int i2 = -1; float m2 = -3.0e38f;
            for (int q = 0; q < 8; ++q) { const float x_ = EL[r * 32 + gi * 8 + q]; if (q != i1 && x_ > m2) { m2 = x_; i2 = q; } }
            const float e2 = __expf(m2 - m1); const float w1 = grp_top / (1.f + e2), w2 = grp_top * e2 / (1.f + e2);
            const int ea = gi * 8 + i1, eb = gi * 8 + i2; const int ra = (int)atomicAdd((unsigned*)(cntL + ea), 1u), rb = (int)atomicAdd((unsigned*)(cntL + eb), 1u);
            int* rr = REC + (size_t)(m0 + r) * 8; rr[0] = ea; rr[1] = eb; rr[2] = ra; rr[3] = rb; rr[4] = __float_as_int(w1); rr[5] = __float_as_int(w2); rr[6] = c.bid; }
        LDS_WAIT(); asm volatile("" ::: "memory");
    }
    __syncthreads();
    if (c.tid < 32) { const unsigned n = cntL[c.tid]; (WSP(unsigned, WS_CTL) + CW_CNTB)[(dummy ? 8192 : 0) + c.bid * 32 + c.tid] = n; if (n) atomicAdd(cnt + c.tid, n); }
}
__device__ __forceinline__ void phase_place(const Ctx& c, int l) {
    LAS int* tab = (LAS int*)(c.lds + LDS_MOETAB);
    moe_tables(c, l, tab);
    int* LTOK = WSP(int, WS_LTOK); float* LW = WSP(float, WS_LW); unsigned* LDST = WSP(unsigned, WS_LSLOT); const int* REC = WSP(int, WS_REC);
    LAS int* BASE = (LAS int*)c.lds;
    if (c.tid < 32) { const unsigned* cb = WSP(unsigned, WS_CTL) + CW_CNTB + c.tid; int run = 0; for (int b_ = 0; b_ < c.G; ++b_) { BASE[b_ * 32 + c.tid] = run; run += (int)cb[b_ * 32]; } }
    __syncthreads();
    for (int m = c.bid * NTHREADS + c.tid; m < M; m += c.G * NTHREADS) { const int* r = REC + (size_t)m * 8;
        const int pa = tab[33 + r[0]] + BASE[r[6] * 32 + r[0]] + r[2], pb = tab[33 + r[1]] + BASE[r[6] * 32 + r[1]] + r[3];
        LTOK[pa] = m; LDST[pa] = (unsigned)m * 1024u; LW[pa] = __int_as_float(r[4]); LTOK[pb] = m; LDST[pb] = ((unsigned)M + (unsigned)m) * 1024u; LW[pb] = __int_as_float(r[5]); }
    for (int e = c.bid; e < 32; e += c.G) { const int lo = tab[33 + e] + tab[66 + e], hi2 = tab[33 + e + 1];
        for (int p = lo + c.tid; p < hi2; p += NTHREADS) { LTOK[p] = 0; LDST[p] = 0xFFFFFFFFu; LW[p] = 0.f; } }
    __syncthreads();
    LAS float* scr = (LAS float*)(c.lds + c.wave * 16384);
    const int gw = c.bid * NWAVES + c.wave, NGW = c.G * NWAVES;
    constexpr int I_GU = 16 * 16, I_DN = 4 * 32;
    for (int it = gw; it < 32 * (I_GU + I_DN); it += NGW) { const int e = it / (I_GU + I_DN); int r = it % (I_GU + I_DN);
        if (r < I_GU) { const int nb = r % 16; const bool up = ((nb * 32) & 255) >= 128;
            const float* w = (up ? c.moe_w_up() : c.moe_w_gate()) + ((size_t)l * 32 + e) * D * 256;
            transpose_item(w, 256, D, WSP(bf16_t, WS_WGU) + (size_t)e * 512 * D, c.norm_ffn() + l * D, MapGU{}, 16, scr, r, c.lane); }
        else { r -= I_GU; transpose_item(c.moe_w_down() + ((size_t)l * 32 + e) * 256 * D, D, 256, WSP(bf16_t, WS_WDT) + (size_t)e * D * 256, nullptr, MapId{0}, 32, scr, r, c.lane); } }
}

#ifndef ATT_FAST_FOX
#define ATT_FAST_FOX 1
#endif
#ifndef ATT_FAST_MLA
#define ATT_FAST_MLA 1
#endif
#ifndef ATT_FAST_NSA
#define ATT_FAST_NSA 1
#endif
namespace fa {
constexpr int KPITCH = 208, VPITCH = 192;
constexpr int KBUF = 64 * KPITCH, VBUF = 64 * VPITCH;
constexpr int L_K = 0, L_V = 2 * KBUF, L_CUM = L_V + 2 * VBUF, L_LUT = L_CUM + 512, L_PS = 57344, L_F = L_PS + 64 * 132 * 4, L_SEL = L_F + 64 * 132 * 4, L_UNI = L_SEL + 1024, L_TL = L_UNI + 16, L_TLN = L_TL + 128, L_UNIT = L_TLN + 16;
static_assert(L_LUT + 8 * 132 * 4 <= L_PS && L_UNIT + 64 <= 131072, "attention LDS map");
typedef short v4i16_t __attribute__((ext_vector_type(4)));
__device__ __forceinline__ float swap32_max(float v) { auto rr = __builtin_amdgcn_permlane32_swap(__float_as_uint(v), __float_as_uint(v), false, false); return fmaxf(__uint_as_float(rr[0]), __uint_as_float(rr[1])); }
__device__ __forceinline__ float swap32_sum(float v) { auto rr = __builtin_amdgcn_permlane32_swap(__float_as_uint(v), __float_as_uint(v), false, false); return __uint_as_float(rr[0]) + __uint_as_float(rr[1]); }
__device__ __forceinline__ float ex2(float x) { return __builtin_amdgcn_exp2f(x); }

struct KVSrc { const bf16_t* K; int kpitch; const bf16_t* K2; int k2pitch; const bf16_t* V; int vpitch; const float* cum; float cref; };
struct TileRegs { u32x4 k, k2, v; float cm; };
template <bool HAS_K2, bool HAS_CUM>
__device__ __forceinline__ void tile_load(TileRegs& R, const KVSrc& s, int kv0, int tid) {
    const int row = tid >> 3, ch = tid & 7;
    R.k = *(const u32x4*)(s.K + (size_t)(kv0 + row) * s.kpitch + ch * 8);
    R.v = *(const u32x4*)(s.V + (size_t)(kv0 + row) * s.vpitch + ch * 8);
    if constexpr (HAS_K2) { if (tid < 256) R.k2 = *(const u32x4*)(s.K2 + (size_t)(kv0 + (tid >> 2)) * s.k2pitch + (tid & 3) * 8); }
    if constexpr (HAS_CUM) { if (tid < 64) R.cm = s.cum[kv0 + tid]; }
}
template <bool HAS_K2, bool HAS_CUM>
__device__ __forceinline__ void tile_store(const TileRegs& R, LAS unsigned char* lds, int buf, int tid, float cref = 0.f, float cadd = 0.f) {
    const int row = tid >> 3, ch = tid & 7;
    *(LAS u32x4*)(lds + L_K + buf * KBUF + row * KPITCH + ch * 16) = R.k;
    if constexpr (HAS_K2) { if (tid < 256) *(LAS u32x4*)(lds + L_K + buf * KBUF + (tid >> 2) * KPITCH + 128 + (tid & 3) * 16) = R.k2; }
    *(LAS u32x4*)(lds + L_V + buf * VBUF + row * VPITCH + ch * 16) = R.v;
    if constexpr (HAS_CUM) { if (tid < 64) { const float x = cref - (R.cm + cadd); const unsigned hi_ = f2bf(x); const float xl = x - __uint_as_float(hi_ << 16); const unsigned lo_ = f2bf(xl);
            unsigned zz = 0u; asm volatile("" : "+v"(zz)); u32x4 w0; w0.x = hi_ | (lo_ << 16); w0.y = zz; w0.z = zz; w0.w = zz; u32x4 z0; z0.x = zz; z0.y = zz; z0.z = zz; z0.w = zz;
            *(LAS u32x4*)(lds + L_K + buf * KBUF + tid * KPITCH + 128) = w0; *(LAS u32x4*)(lds + L_K + buf * KBUF + tid * KPITCH + 144) = z0; } }
}
template <int NKS>
__device__ __forceinline__ void qk_tile(f32x16 (&st)[2], const LAS unsigned char* lds, int buf, const bf16x8 (&qf)[NKS], int r, int hh, float cval) {
    const LAS unsigned char* kp = lds + L_K + buf * KBUF + r * KPITCH + hh * 16;
    bf16x8 kf[2][NKS];
#pragma unroll
    for (int ks = 0; ks < NKS; ++ks)
#pragma unroll
        for (int rb = 0; rb < 2; ++rb) kf[rb][ks] = *(const LAS bf16x8*)(kp + rb * 32 * KPITCH + ks * 32);
    f32x16 cin;
#pragma unroll
    for (int i = 0; i < 16; ++i) cin[i] = cval;
    __builtin_amdgcn_sched_barrier(0);
    f32x16 a0 = __builtin_amdgcn_mfma_f32_32x32x16_bf16(kf[0][0], qf[0], cin, 0, 0, 0), a1 = __builtin_amdgcn_mfma_f32_32x32x16_bf16(kf[1][0], qf[0], cin, 0, 0, 0);
#pragma unroll
    for (int ks = 1; ks < NKS; ++ks) { a0 = __builtin_amdgcn_mfma_f32_32x32x16_bf16(kf[0][ks], qf[ks], a0, 0, 0, 0); a1 = __builtin_amdgcn_mfma_f32_32x32x16_bf16(kf[1][ks], qf[ks], a1, 0, 0, 0); }
    st[0] = a0; st[1] = a1;
}
__device__ __forceinline__ void pv_tile(f32x16 (&ot)[2], const LAS unsigned char* lds, int buf, const f32x16 (&p)[2], int lane) {
    const int i16 = lane & 15, blk = (lane >> 4) & 1, hh = lane >> 5;
    const LAS unsigned char* vb = lds + L_V + buf * VBUF + (4 * hh + (i16 >> 2)) * VPITCH + 32 * blk + 8 * (i16 & 3);
    v4i16_t lo[4][2], hi[4][2]; bf16x8 pf[4];
#pragma unroll
    for (int q = 0; q < 4; ++q)
#pragma unroll
        for (int db = 0; db < 2; ++db) { const LAS unsigned char* vp = vb + (16 * q) * VPITCH + 64 * db;
            lo[q][db] = __builtin_amdgcn_ds_read_tr16_b64_v4i16((LAS v4i16_t*)vp); hi[q][db] = __builtin_amdgcn_ds_read_tr16_b64_v4i16((LAS v4i16_t*)(vp + 8 * VPITCH)); }
#pragma unroll
    for (int q = 0; q < 4; ++q) { const int rb = q >> 1, s_ = q & 1;
        u32x4 pw; pw.x = cvtpk(p[rb][8 * s_ + 0], p[rb][8 * s_ + 1]); pw.y = cvtpk(p[rb][8 * s_ + 2], p[rb][8 * s_ + 3]); pw.z = cvtpk(p[rb][8 * s_ + 4], p[rb][8 * s_ + 5]); pw.w = cvtpk(p[rb][8 * s_ + 6], p[rb][8 * s_ + 7]);
        pf[q] = __builtin_bit_cast(bf16x8, pw); }
    __builtin_amdgcn_sched_barrier(0);
#pragma unroll
    for (int q = 0; q < 4; ++q)
#pragma unroll
        for (int db = 0; db < 2; ++db) { const bf16x8 vf = {lo[q][db][0], lo[q][db][1], lo[q][db][2], lo[q][db][3], hi[q][db][0], hi[q][db][1], hi[q][db][2], hi[q][db][3]};
            ot[db] = __builtin_amdgcn_mfma_f32_32x32x16_bf16(vf, pf[q], ot[db], 0, 0, 0); }
}
struct VFrags { v4i16_t lo[4][2], hi[4][2]; };
__device__ __forceinline__ void v_read(VFrags& F, const LAS unsigned char* lds, int buf, int lane) {
    const int i16 = lane & 15, blk = (lane >> 4) & 1, hh = lane >> 5;
    const LAS unsigned char* vb = lds + L_V + buf * VBUF + (4 * hh + (i16 >> 2)) * VPITCH + 32 * blk + 8 * (i16 & 3);
#pragma unroll
    for (int q = 0; q < 4; ++q)
#pragma unroll
        for (int db = 0; db < 2; ++db) { const LAS unsigned char* vp = vb + (16 * q) * VPITCH + 64 * db;
            F.lo[q][db] = __builtin_amdgcn_ds_read_tr16_b64_v4i16((LAS v4i16_t*)vp); F.hi[q][db] = __builtin_amdgcn_ds_read_tr16_b64_v4i16((LAS v4i16_t*)(vp + 8 * VPITCH)); }
}
__device__ __forceinline__ void pv_mma(f32x16 (&ot)[2], const VFrags& F, const f32x16 (&p)[2]) {
    bf16x8 pf[4];
#pragma unroll
    for (int q = 0; q < 4; ++q) { const int rb = q >> 1, s_ = q & 1;
        u32x4 pw; pw.x = cvtpk(p[rb][8 * s_ + 0], p[rb][8 * s_ + 1]); pw.y = cvtpk(p[rb][8 * s_ + 2], p[rb][8 * s_ + 3]); pw.z = cvtpk(p[rb][8 * s_ + 4], p[rb][8 * s_ + 5]); pw.w = cvtpk(p[rb][8 * s_ + 6], p[rb][8 * s_ + 7]);
        pf[q] = __builtin_bit_cast(bf16x8, pw); }
    __builtin_amdgcn_sched_barrier(0);
#pragma unroll
    for (int q = 0; q < 4; ++q)
#pragma unroll
        for (int db = 0; db < 2; ++db) { const bf16x8 vf = {F.lo[q][db][0], F.lo[q][db][1], F.lo[q][db][2], F.lo[q][db][3], F.hi[q][db][0], F.hi[q][db][1], F.hi[q][db][2], F.hi[q][db][3]};
            ot[db] = __builtin_amdgcn_mfma_f32_32x32x16_bf16(vf, pf[q], ot[db], 0, 0, 0); }
}
struct SmState { float m, l; };
constexpr float RESC_THR = 8.f;
__device__ __forceinline__ float sm_cval(const SmState& S) { return (S.m == -INFINITY) ? 0.f : -S.m; }
__device__ __forceinline__ float row_max32(const f32x16 (&st)[2]) {
    float mx = fmaxf(st[0][0], st[1][0]);
#pragma unroll
    for (int i = 1; i < 16; ++i) mx = fmaxf(fmaxf(mx, st[0][i]), st[1][i]);
    return swap32_max(mx);
}
typedef float f32x2v __attribute__((ext_vector_type(2)));
template <bool WITH_O>
__device__ __forceinline__ void sm_shift(f32x16 (&st)[2], SmState& S, f32x16 (&ot)[2], float mx) {
    const bool fresh = (S.m == -INFINITY);
    const bool up = fresh ? (mx > -INFINITY) : (mx > RESC_THR);
    if (__any(up)) {
        const float d = up ? mx : 0.f; const float alpha = fresh ? 1.f : ex2(-d);
        S.l *= alpha; S.m = up ? ((fresh ? 0.f : S.m) + d) : S.m;
#pragma unroll
        for (int rb = 0; rb < 2; ++rb)
#pragma unroll
            for (int i = 0; i < 16; ++i) st[rb][i] -= d;
        if constexpr (WITH_O) {
#pragma unroll
            for (int db = 0; db < 2; ++db)
#pragma unroll
                for (int i = 0; i < 16; ++i) ot[db][i] *= alpha; }
    }
}
__device__ __forceinline__ void sm_update(f32x16 (&st)[2], SmState& S, f32x16 (&ot)[2]) {
    sm_shift<true>(st, S, ot, row_max32(st));
    float sum = 0.f;
#pragma unroll
    for (int rb = 0; rb < 2; ++rb)
#pragma unroll
        for (int i = 0; i < 16; ++i) { const float p = ex2(st[rb][i]); st[rb][i] = p; sum += p; }
    S.l += sum;
}
__device__ __forceinline__ void sm_stats(f32x16 (&st)[2], SmState& S) {
    f32x16 dummy[2];
    sm_shift<false>(st, S, dummy, row_max32(st));
    float sum = 0.f;
#pragma unroll
    for (int rb = 0; rb < 2; ++rb)
#pragma unroll
        for (int i = 0; i < 16; ++i) sum += ex2(st[rb][i]);
    S.l += sum;
}
__device__ __forceinline__ void zero_acc(f32x16 (&a)[2]) {
#pragma unroll
    for (int db = 0; db < 2; ++db)
#pragma unroll
        for (int i = 0; i < 16; ++i) a[db][i] = 0.f;
}
__device__ __forceinline__ void store_ot(const f32x16 (&o)[2], float sc, bf16_t* orow, int hh) {
#pragma unroll
    for (int db = 0; db < 2; ++db)
#pragma unroll
        for (int a = 0; a < 4; ++a) { u32x2 w; w.x = cvtpk(o[db][4 * a + 0] * sc, o[db][4 * a + 1] * sc); w.y = cvtpk(o[db][4 * a + 2] * sc, o[db][4 * a + 3] * sc);
            *(u32x2*)(orow + 32 * db + 8 * a + 4 * hh) = w; }
}
#define FA_FOREACH_REG(CODE) _Pragma("unroll") for (int rb = 0; rb < 2; ++rb) _Pragma("unroll") for (int a = 0; a < 4; ++a) _Pragma("unroll") for (int e = 0; e < 4; ++e) { const int i = 4 * a + e; const int kc = 32 * rb + 8 * a + e; (void)kc; CODE }
#define FA_LAUNDER(x) asm volatile("" : "+v"(x))

template <bool IS_MLA>
__device__ __forceinline__ void dense_unit(const Ctx& c, int lyr, int b, int h, int qb) {
    constexpr int NKS = IS_MLA ? 6 : 5;
    const int tid = c.tid, lane = c.lane, r = lane & 31, hh = lane >> 5, w = c.wave;
    LAS unsigned char* lds = c.lds;
    const int q0 = qb * 256, qrow = q0 + 32 * w + r; const size_t mrow = (size_t)b * T + qrow;
    KVSrc src; bf16x8 qf[NKS]; bf16_t* orow;
    if constexpr (IS_MLA) {
        const bf16_t* QB = WSP(bf16_t, WS_QB); const bf16_t* KVB = WSP(bf16_t, WS_KVB);
        src.K = KVB + (size_t)b * T * 1024 + h * 64; src.kpitch = 1024; src.K2 = WSP(bf16_t, WS_KR) + (size_t)b * T * 32; src.k2pitch = 32; src.V = KVB + (size_t)b * T * 1024 + 512 + h * 64; src.vpitch = 1024; src.cum = nullptr; src.cref = 0.f;
#pragma unroll
        for (int ks = 0; ks < 4; ++ks) qf[ks] = *(const bf16x8*)(QB + mrow * 768 + h * 64 + 16 * ks + 8 * hh);
#pragma unroll
        for (int ks = 0; ks < 2; ++ks) qf[4 + ks] = *(const bf16x8*)(QB + mrow * 768 + 512 + h * 32 + 16 * ks + 8 * hh);
        orow = WSP(bf16_t, WS_QB) + mrow * 768 + h * 64;
    } else {
        const bf16_t* P1 = WSP(bf16_t, WS_P1);
        src.K = P1 + (size_t)b * T * P1W + C_FQKV + 512 + h * 64; src.kpitch = P1W; src.K2 = nullptr; src.k2pitch = 0; src.V = P1 + (size_t)b * T * P1W + C_FQKV + 1024 + h * 64; src.vpitch = P1W;
        src.cum = WSP(float, WS_LC) + ((size_t)b * 8 + h) * T;
        { LAS float* cps_ = (LAS float*)(lds + L_CUM); if (tid < 128) cps_[tid] = (WSP(float, WS_CP) + ((size_t)b * 8 + h) * 129)[1 + tid]; }
        src.cref = 0.f;
#pragma unroll
        for (int ks = 0; ks < 4; ++ks) qf[ks] = *(const bf16x8*)(P1 + mrow * P1W + C_FQKV + h * 64 + 16 * ks + 8 * hh);
        { unsigned one2 = hh ? 0u : 0x3F803F80u; asm volatile("" : "+v"(one2)); u32x4 aq; aq.x = one2; aq.y = 0u; aq.z = 0u; aq.w = 0u; qf[4] = __builtin_bit_cast(bf16x8, aq); }
        orow = WSP(bf16_t, WS_P1) + mrow * P1W + C_FQKV + h * 64;
    }
    f32x16 st[2], ot[2]; zero_acc(ot); SmState S{-INFINITY, 0.f};
    const int nt = 4 * qb + 4;
    const int wlast = (q0 + 32 * w + 31) >> 6;
    constexpr float FOX_SKIP = 40.f;
    float qbound = 0.f, mmin_blk = -INFINITY; LAS float* MM = (LAS float*)(lds + L_UNIT + 16);
    if constexpr (!IS_MLA) {
        float ss = 0.f;
#pragma unroll
        for (int ks = 0; ks < 4; ++ks)
#pragma unroll
            for (int j = 0; j < 8; ++j) { const float x_ = bf2f((bf16_t)qf[ks][j]); ss += x_ * x_; }
        ss = swap32_sum(ss);
        const float km2 = __uint_as_float((WSP(unsigned, WS_CTL) + CW_KMAX)[lyr * 16 + b * 8 + h]);
        qbound = sqrtf(ss * km2) * 1.001f + 0.01f;
    }
    const LAS float* cps = (const LAS float*)(lds + L_CUM);
#define FOX_CP(t_) ((t_) == 0 ? 0.f : cps[(t_) - 1])
    TileRegs R;
    tile_load<IS_MLA, !IS_MLA>(R, src, 64 * (nt - 1), tid);
    if constexpr (!IS_MLA) { __syncthreads(); src.cref = src.cum[q0] + FOX_CP(4 * qb); }
    tile_store<IS_MLA, !IS_MLA>(R, lds, 0, tid, src.cref, IS_MLA ? 0.f : FOX_CP(nt - 1));
    if (nt > 1) tile_load<IS_MLA, !IS_MLA>(R, src, 64 * (nt - 2), tid);
    __syncthreads();
    for (int it = 0; it < nt; ++it) { const int t = nt - 1 - it, buf = it & 1, kv0 = 64 * t;
        if constexpr (!IS_MLA) { if (it >= 4 && (src.cref - cps[t]) < mmin_blk - FOX_SKIP) break; }
        if (t <= wlast) {
            qk_tile<NKS>(st, lds, buf, qf, r, hh, sm_cval(S));
            if (kv0 + 63 > q0 + 32 * w) { int lim = qrow - kv0 - 4 * hh; FA_LAUNDER(lim); FA_FOREACH_REG({ if (kc > lim) st[rb][i] = -INFINITY; }) }
            VFrags VF; v_read(VF, lds, buf, lane);
            __builtin_amdgcn_sched_barrier(0);
            sm_update(st, S, ot);
            pv_mma(ot, VF, st);
        }
        if constexpr (!IS_MLA) { if (it == 3) { const float v_ = -wave_max(-(S.m - qbound)); if (lane == 0) MM[w] = v_; } }
        if (it + 1 < nt) { tile_store<IS_MLA, !IS_MLA>(R, lds, buf ^ 1, tid, src.cref, IS_MLA ? 0.f : FOX_CP(t - 1)); if (it + 2 < nt) tile_load<IS_MLA, !IS_MLA>(R, src, kv0 - 128, tid); }
        __syncthreads();
        if constexpr (!IS_MLA) { if (it == 3) { float mm_ = MM[0];
#pragma unroll
            for (int q_ = 1; q_ < 8; ++q_) mm_ = fminf(mm_, MM[q_]);
            mmin_blk = mm_; } }
    }
    const float lt = swap32_sum(S.l);
    store_ot(ot, 1.f / lt, orow, hh);
}

#define FA_STREAM(SRC, NT, TILE_EXPR, BODY) do { TileRegs R_; const int nt_ = (NT); \
    if (nt_ > 0) { { const int idx = 0; tile_load<false, false>(R_, SRC, 64 * (TILE_EXPR), tid); } tile_store<false, false>(R_, lds, 0, tid); \
      if (nt_ > 1) { const int idx = 1; tile_load<false, false>(R_, SRC, 64 * (TILE_EXPR), tid); } \
      __syncthreads(); \
      for (int it_ = 0; it_ < nt_; ++it_) { const int buf = it_ & 1; int tile; { const int idx = it_; tile = (TILE_EXPR); } \
          BODY \
          if (it_ + 1 < nt_) { tile_store<false, false>(R_, lds, buf ^ 1, tid); if (it_ + 2 < nt_) { const int idx = it_ + 2; tile_load<false, false>(R_, SRC, 64 * (TILE_EXPR), tid); } } \
          __syncthreads(); } } } while (0)

__device__ __forceinline__ void nsa_unit(const Ctx& c, int b, int g, int j) {
    const int tid = c.tid, lane = c.lane, r = lane & 31, hh = lane >> 5, w = c.wave;
    LAS unsigned char* lds = c.lds;
    const int t0 = 64 * j, tl = r >> 2, hp = r & 3, tokl = 8 * w + tl, tq = t0 + tokl, head = 4 * g + hp; const size_t mrow = (size_t)b * T + tq;
    const bf16_t* P1 = WSP(bf16_t, WS_P1);
    bf16x8 qf[4];
#pragma unroll
    for (int ks = 0; ks < 4; ++ks) qf[ks] = *(const bf16x8*)(P1 + mrow * P1W + C_NQ + head * 64 + 16 * ks + 8 * hh);
    const float gc = sigmoidf_(bf2f(P1[mrow * P1W + C_NG + head * 3 + 0])), gsl = sigmoidf_(bf2f(P1[mrow * P1W + C_NG + head * 3 + 1])), gwn = sigmoidf_(bf2f(P1[mrow * P1W + C_NG + head * 3 + 2]));
    const LAS float* lutL = (const LAS float*)(lds + L_LUT) + head * 132;
    LAS float* PS = (LAS float*)(lds + L_PS); LAS float* FM = (LAS float*)(lds + L_F); LAS unsigned* SEL = (LAS unsigned*)(lds + L_SEL); LAS unsigned* UNI = (LAS unsigned*)(lds + L_UNI);
    LAS unsigned char* TL = (LAS unsigned char*)(lds + L_TL); LAS int* TLN = (LAS int*)(lds + L_TLN);
    f32x16 st[2], ot[2], otot[2]; zero_acc(otot);
    for (int i = tid; i < 2 * 64 * 132; i += NTHREADS) PS[i] = 0.f;
    if (tid < 256) SEL[tid] = 0u; if (tid < 4) UNI[tid] = 0u;
    const float bfar = lutL[128];
    const int tmin = t0 + 8 * w;
    const int n_ok_max = ((t0 + 63 - 31) >> 4) + 1; const int nct = (n_ok_max + 63) >> 6;
    KVSrc srcc; srcc.K = WSP(bf16_t, WS_KC) + (size_t)(b * 2 + g) * 512 * 64; srcc.kpitch = 64; srcc.K2 = nullptr; srcc.k2pitch = 0; srcc.V = WSP(bf16_t, WS_VC) + (size_t)(b * 2 + g) * 512 * 64; srcc.vpitch = 64; srcc.cum = nullptr; srcc.cref = 0.f;
    SmState Sc{-INFINITY, 0.f};
    FA_STREAM(srcc, nct, idx, {
        const bool farc = (16 * (64 * tile + 63) + 31 + 128 <= tmin);
        qk_tile<4>(st, lds, buf, qf, r, hh, sm_cval(Sc) + (farc ? bfar : 0.f));
        if (!farc) { int db_ = tq - 31 - 1024 * tile - 64 * hh; FA_LAUNDER(db_); FA_FOREACH_REG({ const int dist = db_ - 16 * kc; const float s_ = st[rb][i] + lutL[dist < 0 ? 0 : (dist > 128 ? 128 : dist)]; st[rb][i] = dist < 0 ? -INFINITY : s_; }) }
        sm_stats(st, Sc); });
    { const float lt = swap32_sum(Sc.l); const float inv = lt > 0.f ? 1.f / lt : 0.f; const float msafe = (Sc.m == -INFINITY) ? 0.f : Sc.m;
      zero_acc(ot);
      FA_STREAM(srcc, nct, idx, {
        const bool farc = (16 * (64 * tile + 63) + 31 + 128 <= tmin);
        qk_tile<4>(st, lds, buf, qf, r, hh, (farc ? bfar : 0.f) - msafe);
        if (farc) { FA_FOREACH_REG({ st[rb][i] = ex2(st[rb][i]) * inv; }) }
        else { int db_ = tq - 31 - 1024 * tile - 64 * hh; FA_LAUNDER(db_); FA_FOREACH_REG({ const int dist = db_ - 16 * kc; const float s_ = st[rb][i] + lutL[dist < 0 ? 0 : (dist > 128 ? 128 : dist)]; st[rb][i] = dist < 0 ? 0.f : ex2(s_) * inv; }) }
_Pragma("unroll")
        for (int rb = 0; rb < 2; ++rb)
_Pragma("unroll")
            for (int a = 0; a < 4; ++a) { float q4[4];
_Pragma("unroll")
                for (int e = 0; e < 4; ++e) { float v = st[rb][4 * a + e]; v += dpp_f<0xB1>(v); v += dpp_f<0x4E>(v); q4[e] = v; }
                if (hp == 0) { const int G = 16 * tile + 8 * rb + 2 * a + hh; PS[tokl * 132 + G] = q4[0] + 2.f * (q4[1] + q4[2] + q4[3]); FM[tokl * 132 + G] = q4[0]; } }
        pv_tile(ot, lds, buf, st, lane); });
#pragma unroll
      for (int db = 0; db < 2; ++db)
#pragma unroll
          for (int i = 0; i < 16; ++i) otot[db][i] += gc * ot[db][i]; }
    if (j + 1 <= 16) { if (tid < 64) SEL[tid * 4] = (1u << (j + 1)) - 1u; if (tid == 0) UNI[0] = (1u << (j + 1)) - 1u; }
    else {
        for (int i = tid; i < 64 * 128; i += NTHREADS) { const int tk = i >> 7, G = i & 127; if (G >= 1 && G <= j - 2) PS[tk * 132 + G] += FM[tk * 132 + G + 1]; }
        __syncthreads();
        const int tk = tid >> 3, sub = tid & 7; unsigned bits[4] = {0u, 0u, 0u, 0u};
#pragma unroll 1
        for (int k = 0; k < 16; ++k) { const int G = sub + 8 * k;
            if (G >= 1 && G <= j - 2) { const float v = PS[tk * 132 + G]; int cnt = 0;
                for (int G2 = 1; G2 <= j - 2; ++G2) { const float v2 = PS[tk * 132 + G2]; cnt += (v2 > v || (v2 == v && G2 < G)) ? 1 : 0; }
                if (cnt < 13) { if (k < 4) bits[0] |= 1u << G; else if (k < 8) bits[1] |= 1u << (G - 32); else if (k < 12) bits[2] |= 1u << (G - 64); else bits[3] |= 1u << (G - 96); } } }
        if (sub == 0) { bits[0] |= 1u; { const int G = j; if (G < 32) bits[0] |= 1u << G; else if (G < 64) bits[1] |= 1u << (G - 32); else if (G < 96) bits[2] |= 1u << (G - 64); else bits[3] |= 1u << (G - 96); }
                        { const int G = j - 1; if (G < 32) bits[0] |= 1u << G; else if (G < 64) bits[1] |= 1u << (G - 32); else if (G < 96) bits[2] |= 1u << (G - 64); else bits[3] |= 1u << (G - 96); } }
#pragma unroll
        for (int q = 0; q < 4; ++q) if (bits[q]) { atomicOr((unsigned*)(SEL + tk * 4 + q), bits[q]); atomicOr((unsigned*)(UNI + q), bits[q]); }
    }
    __syncthreads();
    if (tid == 0) { int n = 0; for (int q = 0; q < 4; ++q) { unsigned m_ = UNI[q]; while (m_) { const int bpos = __builtin_ctz(m_); m_ &= m_ - 1u; TL[n++] = (unsigned char)(32 * q + bpos); } } TLN[0] = n; }
    __syncthreads();
    const unsigned msk0 = SEL[tokl * 4 + 0], msk1 = SEL[tokl * 4 + 1], msk2 = SEL[tokl * 4 + 2], msk3 = SEL[tokl * 4 + 3];
    const int nsel = __builtin_amdgcn_readfirstlane(TLN[0]);
    { KVSrc srcs; srcs.K = P1 + (size_t)b * T * P1W + C_NKV + ((1 * 2 + 0) * 2 + g) * 64; srcs.kpitch = P1W; srcs.K2 = nullptr; srcs.k2pitch = 0; srcs.V = P1 + (size_t)b * T * P1W + C_NKV + ((1 * 2 + 1) * 2 + g) * 64; srcs.vpitch = P1W; srcs.cum = nullptr; srcs.cref = 0.f;
      SmState Ss{-INFINITY, 0.f}; zero_acc(ot);
      FA_STREAM(srcs, nsel, (int)TL[idx], {
        const int wq = tile >> 5; const unsigned mw = wq == 0 ? msk0 : wq == 1 ? msk1 : wq == 2 ? msk2 : msk3; const bool mine = (mw >> (tile & 31)) & 1u;
        if (__any(mine)) {
            const bool fars = (64 * tile + 63 + 128 <= tmin);
            qk_tile<4>(st, lds, buf, qf, r, hh, mine ? sm_cval(Ss) + (fars ? bfar : 0.f) : -INFINITY);
            if (!fars) { int db_ = tq - 64 * tile - 4 * hh; FA_LAUNDER(db_); FA_FOREACH_REG({ const int dist = db_ - kc; const float s_ = st[rb][i] + lutL[dist < 0 ? 0 : (dist > 128 ? 128 : dist)]; st[rb][i] = (dist >= 0) ? s_ : -INFINITY; }) }
            VFrags VF; v_read(VF, lds, buf, lane); __builtin_amdgcn_sched_barrier(0);
            sm_update(st, Ss, ot);
            pv_mma(ot, VF, st); } });
      const float lt = swap32_sum(Ss.l); const float sc = lt > 0.f ? gsl / lt : 0.f;
#pragma unroll
      for (int db = 0; db < 2; ++db)
#pragma unroll
          for (int i = 0; i < 16; ++i) otot[db][i] += sc * ot[db][i]; }
    { KVSrc srcw; srcw.K = P1 + (size_t)b * T * P1W + C_NKV + ((2 * 2 + 0) * 2 + g) * 64; srcw.kpitch = P1W; srcw.K2 = nullptr; srcw.k2pitch = 0; srcw.V = P1 + (size_t)b * T * P1W + C_NKV + ((2 * 2 + 1) * 2 + g) * 64; srcw.vpitch = P1W; srcw.cum = nullptr; srcw.cref = 0.f;
      const int jlo = j - 8 > 0 ? j - 8 : 0;
      SmState Sw{-INFINITY, 0.f}; zero_acc(ot);
      FA_STREAM(srcw, j - jlo + 1, jlo + idx, {
        qk_tile<4>(st, lds, buf, qf, r, hh, sm_cval(Sw));
        { int db_ = tq - 64 * tile - 4 * hh; FA_LAUNDER(db_); FA_FOREACH_REG({ const int dist = db_ - kc; const float s_ = st[rb][i] + lutL[dist < 0 ? 0 : (dist > 128 ? 128 : dist)]; st[rb][i] = (dist >= 0 && dist < 512) ? s_ : -INFINITY; }) }
        VFrags VF; v_read(VF, lds, buf, lane); __builtin_amdgcn_sched_barrier(0);
        sm_update(st, Sw, ot);
        pv_mma(ot, VF, st); });
      const float lt = swap32_sum(Sw.l); const float sc = lt > 0.f ? gwn / lt : 0.f;
#pragma unroll
      for (int db = 0; db < 2; ++db)
#pragma unroll
          for (int i = 0; i < 16; ++i) otot[db][i] += sc * ot[db][i]; }
    store_ot(otot, 1.f, WSP(bf16_t, WS_P1) + mrow * P1W + C_NQ + head * 64, hh);
}
}

__device__ __forceinline__ int next_unit(const Ctx& c, unsigned* ctr) {
    LAS int* u = (LAS int*)(c.lds + fa::L_UNIT);
    __syncthreads();
    if (c.tid == 0) u[0] = (int)__hip_atomic_fetch_add(ctr, 1u, __ATOMIC_RELAXED, __HIP_MEMORY_SCOPE_AGENT);
    __syncthreads();
    return __builtin_amdgcn_readfirstlane(u[0]);
}
__device__ __forceinline__ void phase_att_fast(const Ctx& c0, int l) {
    Ctx c = c0;
    unsigned* ctr0 = WSP(unsigned, WS_CTL) + CW_QUEUE + 64 * 8 * l;
    { const float* lut = WSP(float, WS_TAB) + 512; LAS float* L_ = (LAS float*)(c.lds + fa::L_LUT); for (int i = c.tid; i < 8 * 132; i += NTHREADS) L_[i] = lut[i]; }
    const int myx = (int)(xb_xcc_id() & 7u);
    for (int qi = 0; qi < 8; ++qi) {
        const int x = (myx + qi) & 7;
        for (;;) {
            const int u = next_unit(c, ctr0 + 64 * x);
            if (u >= 192) break;
            relaunder(c);
            const int sidx = u >> 5, k = u & 31;
            if (sidx == 0 || sidx == 3) { const int p = 2 * x + (sidx == 3); if (ATT_FAST_MLA) fa::dense_unit<true>(c, l & 1, p >> 3, p & 7, 31 - k); }
            else if (sidx == 1 || sidx == 4) { const int p = 2 * x + (sidx == 4); if (ATT_FAST_FOX) fa::dense_unit<false>(c, l & 1, p >> 3, p & 7, 31 - k); }
            else { const int n = (sidx == 5 ? 32 : 0) + k, grp = x >> 1; if (ATT_FAST_NSA) fa::nsa_unit(c, grp >> 1, grp & 1, 127 - 2 * n - (x & 1)); }
        }
    }
}

struct Args { const void* in[32]; float* out; unsigned char* ws; int l_lo, l_hi; };
constexpr int PH_PER_LAYER = 15, K_FINAL = 1 + PH_PER_LAYER;
template <int KIND>
__global__ void __launch_bounds__(NTHREADS, 2) fwd_kernel(Args a) {
    extern __shared__ __attribute__((aligned(16))) unsigned char lds_raw[];
    Ctx c;
    c.out = a.out; c.ws = a.ws; c.ws0 = a.ws; c.lds = (LAS unsigned char*)lds_raw;
    c.tid = threadIdx.x; c.lane = c.tid & 63; c.wave = __builtin_amdgcn_readfirstlane(c.tid >> 6); c.G = gridDim.x; c.bid = blockIdx.x;
    if (c.tid < 4) ((LAS unsigned*)(c.lds + LDS_MISC))[c.tid] = 0u;
    if (c.tid < 32) { const unsigned long long pv = (unsigned long long)a.in[c.tid]; ((LAS unsigned*)(c.lds + LDS_INTAB))[2 * c.tid] = (unsigned)pv; ((LAS unsigned*)(c.lds + LDS_INTAB))[2 * c.tid + 1] = (unsigned)(pv >> 32); }
    __syncthreads();
    XcdBarrier bar; bar.bar = WSP(unsigned, WS_CTL) + CW_BAR; bar.x = 0; bar.st = nullptr;
    if constexpr (KIND < 0) bar = xcd_barrier_post(WSP(unsigned, WS_CTL) + CW_BAR, (volatile LAS unsigned*)(c.lds + LDS_MISC));
#define IN(k) ((KIND < 0 || KIND == (k)) && (relaunder(c), true))
#define REP(p) for (int rep_ = 0; rep_ < ((PROBE_DOUBLE == (p)) ? 2 : 1); ++rep_)
#define SEAM(k) do { if constexpr (KIND < 0) { unsigned* bb_ = bar.bar; asm volatile("" : "+s"(bb_)); bar.bar = bb_; xcd_barrier(bar); } } while (0)
    LAS unsigned char* ring = c.lds;

    if (IN(0)) REP(4) { phase_prologue(c); } SEAM(0);
    for (int l = a.l_lo; l < a.l_hi; ++l) {
        constexpr int pb = 1;
        const float* resid = (l == 0) ? c.x() : WSP(float, WS_XA);
        if (IN(pb + 0)) { if (l == 0) phase_norm(c, c.x(), nullptr, nullptr, nullptr, WSP(bf16_t, WS_H0));
                          else phase_norm(c, WSP(float, WS_XA), WSP(bf16_t, WS_Y), WSP(bf16_t, WS_Y) + (size_t)M * D, WSP(float, WS_XA), WSP(bf16_t, WS_H0));
        } SEAM(pb + 0);
        if (IN(pb + 1)) REP(2) { pg8::Cfg g{(unsigned)(D * 2), 128u, (unsigned)(D * 2), D / 64, nullptr}; pg8::DenseOrder S; S.init(M / 256, NCAT / 256, c.G, c.bid, WSP(bf16_t, WS_H0), (size_t)256 * D * 2, WSP(bf16_t, WS_WINT) + (size_t)l * NCAT * D, (size_t)256 * D * 2);
            EpiInprojGates E{WSP(bf16_t, WS_P1), WSP(unsigned char, WS_GATES), c.b_merge() + l * 3072}; pg8::gemm_phase<false>(ring, c.wave, g, S, E); } SEAM(pb + 1);
        if (IN(pb + 2)) {
            const bool split = c.G >= 64;
            if (!split || c.bid < c.G - 32) phase_prep(c, l, c.bid, split ? c.G - 32 : c.G);
            if (!split || c.bid >= c.G - 32) { pg8::Cfg g{(unsigned)(16 * P1W * 2), (unsigned)(P1W * 2), 4096u, 16, nullptr};
                CmpOrder S{split ? 32 : c.G, split ? c.bid - (c.G - 32) : c.bid, (const char*)WSP(bf16_t, WS_P1), (const char*)(WSP(bf16_t, WS_WC1T) + (size_t)l * 2 * 256 * 2048)};
                EpiCmpSlab E{WSP(float, WS_SL)}; pg8::gemm_phase<false>(ring, c.wave, g, S, E); }
        } SEAM(pb + 2);
        if (IN(pb + 3)) REP(2) {
            phase_cmp2(c, l); phase_chunk_prefix(c);
            { pg8::Cfg g{(unsigned)(P1W * 2), 128u, 512u, 4, nullptr}; pg8::DenseOrder S; S.init(M / 256, 2, c.G, c.bid, WSP(bf16_t, WS_P1) + C_CQ, (size_t)256 * P1W * 2, WSP(bf16_t, WS_WUQT) + (size_t)l * 768 * 256, (size_t)256 * 512);
              EpiStoreBf16 E{WSP(bf16_t, WS_QB), 768, WSP(float, WS_RSTD), 2}; pg8::gemm_phase<false>(ring, c.wave, g, S, E); }
            { pg8::Cfg g{(unsigned)(P1W * 2), 128u, 512u, 4, nullptr}; pg8::DenseOrder S; S.init(M / 256, 1, c.G, (c.bid + 128) % c.G, WSP(bf16_t, WS_P1) + C_CQ, (size_t)256 * P1W * 2, WSP(bf16_t, WS_WUQT) + (size_t)l * 768 * 256 + (size_t)512 * 256, (size_t)256 * 512);
              EpiUqRope E{WSP(bf16_t, WS_QB) + 512, WSP(float, WS_RSTD), WSP(float, WS_ROPE), WSP(float, WS_ROPE) + (size_t)M * 16}; pg8::gemm_phase<false>(ring, c.wave, g, S, E); }
            { pg8::Cfg g{(unsigned)(P1W * 2), 128u, 256u, 2, nullptr}; pg8::DenseOrder S; S.init(M / 256, 4, c.G, c.bid, WSP(bf16_t, WS_P1) + C_CKV, (size_t)256 * P1W * 2, WSP(bf16_t, WS_WUKVT) + (size_t)l * 1024 * 128, (size_t)256 * 256);
              EpiStoreBf16 E{WSP(bf16_t, WS_KVB), 1024, WSP(float, WS_RSTD) + 1, 2}; pg8::gemm_phase<false>(ring, c.wave, g, S, E); }
        } SEAM(pb + 3);
        if (IN(pb + 6)) { phase_att_fast(c, l);
#if PROBE_DOUBLE == 1
            phase_att_fast(c, l + 2);
#endif
        } SEAM(pb + 6);
        if (IN(pb + 9)) REP(2) {
#pragma unroll 1
            for (int br = 0; br < 3; ++br) { const unsigned lda_ = (br == 1) ? 768u * 2u : (unsigned)(P1W * 2);
                const bf16_t* ao = (br == 0) ? WSP(bf16_t, WS_P1) + C_NQ : (br == 1) ? WSP(bf16_t, WS_QB) : WSP(bf16_t, WS_P1) + C_FQKV;
                pg8::Cfg g{lda_, 128u, 1024u, 8, nullptr}; pg8::DenseOrder S;
                S.init(M / 256, 4, c.G, c.bid, ao, (size_t)256 * lda_, WSP(bf16_t, WS_WOT) + ((size_t)l * 3 + br) * 1024 * 512, (size_t)256 * 1024);
                EpiOutproj E{WSP(bf16_t, WS_MIXED), WSP(unsigned char, WS_GATES), br}; pg8::gemm_phase<false>(ring, c.wave, g, S, E); }
        } SEAM(pb + 9);
        if (IN(pb + 10)) { pg8::Cfg g{(unsigned)(D * 2), 128u, (unsigned)(D * 2), D / 64, nullptr}; pg8::DenseOrder S; S.init(M / 256, 4, c.G, c.bid, WSP(bf16_t, WS_MIXED), (size_t)256 * D * 2, WSP(bf16_t, WS_WOUTT) + (size_t)l * D * D, (size_t)256 * D * 2);
            EpiWout E{resid, WSP(float, WS_XA)}; pg8::gemm_phase<false>(ring, c.wave, g, S, E);
        } SEAM(pb + 10);
        if (IN(pb + 11)) { phase_router(c, l);
#if PROBE_DOUBLE == 3
            phase_router(c, l, 1);
#endif
        } SEAM(pb + 11);
        if (IN(pb + 12)) REP(4) { phase_place(c, l); } SEAM(pb + 12);
        if (IN(pb + 13)) REP(2) { LAS int* tab = (LAS int*)(c.lds + LDS_MOETAB); moe_tables(c, l, tab);
            pg8::Cfg g{(unsigned)(D * 2), 128u, (unsigned)(D * 2), D / 64, WSP(int, WS_LTOK)}; MoeOrder S{c.G, c.bid, 2, tab, (const char*)WSP(bf16_t, WS_H2), 0, (const char*)WSP(bf16_t, WS_WGU), (size_t)512 * D * 2, (size_t)256 * D * 2};
            EpiMoe1 E{WSP(bf16_t, WS_HID), WSP(float, WS_LW)}; pg8::gemm_phase<true>(ring, c.wave, g, S, E); } SEAM(pb + 13);
        if (IN(pb + 14)) REP(2) { LAS int* tab = (LAS int*)(c.lds + LDS_MOETAB); moe_tables(c, l, tab);
            pg8::Cfg g{512u, 128u, 512u, 4, nullptr}; MoeOrder S{c.G, c.bid, 4, tab, (const char*)WSP(bf16_t, WS_HID), 512, (const char*)WSP(bf16_t, WS_WDT), (size_t)D * 256 * 2, (size_t)256 * 256 * 2};
            EpiMoe2 E{WSP(bf16_t, WS_Y), WSP(unsigned, WS_LSLOT)}; pg8::gemm_phase<false>(ring, c.wave, g, S, E); } SEAM(pb + 14);
    }
    if (IN(K_FINAL)) REP(6) { phase_final(c); }
#undef IN
#undef SEAM
}

template <int KIND> static bool prep_kernel() { return hipFuncSetAttribute((const void*)fwd_kernel<KIND>, hipFuncAttributeMaxDynamicSharedMemorySize, LDS_BYTES) == hipSuccess; }
template <int KIND> static void launch_kind(int grid, hipStream_t stream, Args a, int l) { a.l_lo = l; a.l_hi = l + 1; hipLaunchKernelGGL(fwd_kernel<KIND>, dim3(grid), dim3(NTHREADS), LDS_BYTES, stream, a); }
extern "C" void kernel_launch(void* const* d_in, const int* in_sizes, int n_in, void* d_out, int out_size, void* d_ws, size_t ws_size, hipStream_t stream) {
    static int grid = 0;
    if (grid == 0) {
        if (n_in != 32 || ws_size < WS_END) { fprintf(stderr, "kernel_launch: n_in %d ws %zu (need %zu)\n", n_in, ws_size, (size_t)WS_END); grid = -1; return; }
        int dev = 0, cus = 0;
        if (hipGetDevice(&dev) != hipSuccess || hipDeviceGetAttribute(&cus, hipDeviceAttributeMultiprocessorCount, dev) != hipSuccess) { grid = -1; return; }
        bool ok = true;
#if MK_ONE_LAUNCH
        ok = prep_kernel<-1>();
#else
        ok = prep_kernel<0>() && prep_kernel<1>() && prep_kernel<2>() && prep_kernel<3>() && prep_kernel<4>() && prep_kernel<5>() && prep_kernel<6>() && prep_kernel<7>() && prep_kernel<8>() && prep_kernel<9>()
          && prep_kernel<10>() && prep_kernel<11>() && prep_kernel<12>() && prep_kernel<13>() && prep_kernel<14>() && prep_kernel<15>() && prep_kernel<16>();
#endif
        if (!ok) { grid = -1; return; }
        (void)hipGetLastError();
        grid = cus;
    }
    if (grid < 0) return;
    (void)hipMemsetAsync((char*)d_ws + WS_CTL, 0, CTL_BYTES, stream);
    Args a{};
    for (int i = 0; i < 32; ++i) a.in[i] = d_in[i];
    a.out = (float*)d_out; a.ws = (unsigned char*)d_ws;
#if MK_ONE_LAUNCH
    a.l_lo = 0; a.l_hi = NL;
    hipLaunchKernelGGL(fwd_kernel<-1>, dim3(grid), dim3(NTHREADS), LDS_BYTES, stream, a);
#else
    launch_kind<0>(grid, stream, a, 0);
    for (int l = 0; l < NL; ++l) {
        launch_kind<1>(grid, stream, a, l); launch_kind<2>(grid, stream, a, l); launch_kind<3>(grid, stream, a, l); launch_kind<4>(grid, stream, a, l); launch_kind<5>(grid, stream, a, l);
        launch_kind<6>(grid, stream, a, l); launch_kind<7>(grid, stream, a, l); launch_kind<8>(grid, stream, a, l); launch_kind<9>(grid, stream, a, l); launch_kind<10>(grid, stream, a, l);
        launch_kind<11>(grid, stream, a, l); launch_kind<12>(grid, stream, a, l); launch_kind<13>(grid, stream, a, l); launch_kind<14>(grid, stream, a, l); launch_kind<15>(grid, stream, a, l);
    }
    launch_kind<16>(grid, stream, a, 0);
#endif
}
```

```cpp
#include <hip/hip_runtime.h>
#include <stdint.h>
#include <cstdio>

#ifndef PROBE_DOUBLE
#define PROBE_DOUBLE 0
#endif
#ifndef MK_ONE_LAUNCH
#define MK_ONE_LAUNCH 1
#endif

#define LAS __attribute__((address_space(3)))
typedef unsigned short bf16_t;
typedef short bf16x8 __attribute__((ext_vector_type(8)));
typedef float f32x4 __attribute__((ext_vector_type(4)));
typedef float f32x16 __attribute__((ext_vector_type(16)));
typedef unsigned u32x4 __attribute__((ext_vector_type(4)));
typedef unsigned u32x2 __attribute__((ext_vector_type(2)));

constexpr int NB = 2, T = 8192, D = 1024, M = NB * T, NL = 2;
constexpr int DIN = 6336;
constexpr int P1W = 3328;
constexpr int C_NQ = 0, C_NKV = 512, C_CQ = 1280, C_CKV = 1536, C_KR = 1664, C_NG = 1696, C_FF = 1720, C_FQKV = 1728;
constexpr int NEXP = 32, EDIM = 256;
constexpr float EPS = 1e-6f;
constexpr float LOG2E = 1.4426950408889634f;
constexpr float QSCALE64 = 0.125f * LOG2E, QSCALE96 = 0.10206207261596575f * LOG2E;
constexpr int NTHREADS = 512, NWAVES = 8;
constexpr int LDS_BYTES = 147456;
constexpr int MOE_MAXROWS = 40960;

constexpr size_t MiB = 1u << 20;
constexpr size_t WS_CTL = 0;
constexpr size_t CTL_BYTES = 1 * MiB;
constexpr int CW_BAR = 4096;
constexpr int CW_QUEUE = 16384;
constexpr int CW_MOECNT = 32768;
constexpr int CW_KMAX = 24576;
constexpr int CW_CNTB = 65536;
constexpr size_t CTL_LTOK = 512 * 1024;
constexpr size_t WS_WINT = 1 * MiB;
constexpr int NCAT = 6400;
constexpr size_t WS_WUQT = 26 * MiB;
constexpr size_t WS_WUKVT = 27 * MiB;
constexpr size_t WS_WOT = 28 * MiB;
constexpr size_t WS_WOUTT = 34 * MiB;
constexpr size_t WS_WC1T = 38 * MiB;
constexpr size_t WS_ROPE = 42 * MiB;
constexpr size_t WS_TAB = 44 * MiB;
constexpr size_t WS_XA = 45 * MiB;
constexpr size_t PB = 109 * MiB;
constexpr size_t WS_P1 = PB;
constexpr size_t WS_QB = PB + 104 * MiB;
constexpr size_t WS_KVB = PB + 128 * MiB;
constexpr size_t WS_H0 = PB + 128 * MiB;
constexpr size_t WS_GATES = PB + 160 * MiB;
constexpr size_t WS_SM = PB + 208 * MiB;
constexpr size_t WS_RSTD = WS_SM;
constexpr size_t WS_KR = WS_SM + 256 * 1024;
constexpr size_t WS_LF = WS_SM + 1280 * 1024;
constexpr size_t WS_CUM = WS_SM + 1792 * 1024;
constexpr size_t WS_SL = WS_SM + 2304 * 1024;
constexpr size_t WS_KC = WS_SM + 6400 * 1024;
constexpr size_t WS_VC = WS_SM + 6656 * 1024;
constexpr size_t WS_REC = WS_SM + 6912 * 1024;
constexpr size_t WS_LTOK = WS_SM + 7424 * 1024;
constexpr size_t WS_LW = WS_SM + 7616 * 1024;
constexpr size_t WS_LSLOT = WS_SM + 7808 * 1024;
static_assert(WS_LSLOT + MOE_MAXROWS * 4 <= WS_SM + 8 * MiB, "small region");
constexpr size_t WS_END = PB + 216 * MiB;
constexpr size_t WS_MIXED = PB + 128 * MiB;
constexpr size_t WS_Y = PB;
constexpr size_t WS_H2 = PB + 64 * MiB;
constexpr size_t WS_WGU = PB + 96 * MiB;
constexpr size_t WS_WDT = PB + 128 * MiB;
constexpr size_t WS_HID = PB + 144 * MiB;
static_assert(WS_Y + 64 * MiB <= WS_H0 && WS_HID + (size_t)MOE_MAXROWS * 512 <= WS_SM, "phase-region overlays");
static_assert(WS_END <= 332 * MiB, "workspace budget");

__device__ __forceinline__ float bf2f(bf16_t v) { return __uint_as_float((unsigned)v << 16); }
__device__ __forceinline__ unsigned f2bf(float f) { unsigned u = __float_as_uint(f); return (u + 0x7fffu + ((u >> 16) & 1u)) >> 16; }
__device__ __forceinline__ unsigned pk2(float lo, float hi) { return f2bf(lo) | (f2bf(hi) << 16); }
typedef float f32x2_t __attribute__((ext_vector_type(2))); typedef __bf16 bf16x2_t __attribute__((ext_vector_type(2)));
__device__ __forceinline__ unsigned cvtpk(float lo, float hi) { f32x2_t v = {lo, hi}; bf16x2_t b = __builtin_convertvector(v, bf16x2_t); return __builtin_bit_cast(unsigned, b); }
__device__ __forceinline__ f32x4 unpk4(u32x2 a) { f32x4 r; r.x = __uint_as_float(a.x << 16); r.y = __uint_as_float(a.x & 0xffff0000u); r.z = __uint_as_float(a.y << 16); r.w = __uint_as_float(a.y & 0xffff0000u); return r; }
template <int CTRL> __device__ __forceinline__ float dpp_f(float v) { return __int_as_float(__builtin_amdgcn_update_dpp(0, __float_as_int(v), CTRL, 0xf, 0xf, true)); }
__device__ __forceinline__ float wave_sum(float v) {
    v += dpp_f<0xB1>(v); v += dpp_f<0x4E>(v); v += dpp_f<0x141>(v); v += dpp_f<0x140>(v);
    const float a = __int_as_float(__builtin_amdgcn_readlane(__float_as_int(v), 0)), b = __int_as_float(__builtin_amdgcn_readlane(__float_as_int(v), 16));
    const float c2 = __int_as_float(__builtin_amdgcn_readlane(__float_as_int(v), 32)), d = __int_as_float(__builtin_amdgcn_readlane(__float_as_int(v), 48));
    return (a + b) + (c2 + d);
}
__device__ __forceinline__ float wave_max(float v) {
    v = fmaxf(v, dpp_f<0xB1>(v)); v = fmaxf(v, dpp_f<0x4E>(v)); v = fmaxf(v, dpp_f<0x141>(v)); v = fmaxf(v, dpp_f<0x140>(v));
    const float a = __int_as_float(__builtin_amdgcn_readlane(__float_as_int(v), 0)), b = __int_as_float(__builtin_amdgcn_readlane(__float_as_int(v), 16));
    const float c2 = __int_as_float(__builtin_amdgcn_readlane(__float_as_int(v), 32)), d = __int_as_float(__builtin_amdgcn_readlane(__float_as_int(v), 48));
    return fmaxf(fmaxf(a, b), fmaxf(c2, d));
}
__device__ __forceinline__ float half_sum(float v) { auto rr = __builtin_amdgcn_permlane32_swap(__float_as_uint(v), __float_as_uint(v), false, false); return __uint_as_float(rr[0]) + __uint_as_float(rr[1]); }
__device__ __forceinline__ float sigmoidf_(float x) { return 1.f / (1.f + __expf(-x)); }
__device__ __forceinline__ float gelu_tanh(float x) { const float u = 0.7978845608028654f * (x + 0.044715f * x * x * x); const float th = 1.f - 2.f / (1.f + __expf(2.f * u)); return 0.5f * x * (1.f + th); }
#define LDS_WAIT() asm volatile("s_waitcnt lgkmcnt(0)" ::: "memory")

#define XB_TMO      128
#define XB_XCNT(j)  (256  + 64 * (j))
#define XB_XSUB(j)  (1280 + 64 * (j))
#define XB_XGEN(j)  (2304 + 64 * (j))
#define XB_TOP      3328
#define XB_TOPGEN   3392
#define XCD_BAR_WORDS 3456
#define XB_SPIN_CAP (1u << 18)

__device__ __forceinline__ unsigned xb_ld(unsigned* p)              { return __hip_atomic_load(p, __ATOMIC_RELAXED, __HIP_MEMORY_SCOPE_AGENT); }
__device__ __forceinline__ unsigned xb_add(unsigned* p, unsigned v) { return __hip_atomic_fetch_add(p, v, __ATOMIC_RELAXED, __HIP_MEMORY_SCOPE_AGENT); }
__device__ __forceinline__ unsigned xb_xcc_id() { return (unsigned)__builtin_amdgcn_s_getreg((3 << 11) | 20) & 0xFu; }
#define XB_SPIN(cond, bar) do { unsigned _sp = 0; while (cond) { __builtin_amdgcn_s_sleep(1); \
    if ((++_sp & 255u) == 0u) { if (xb_ld(&(bar)[XB_TMO])) break; if (_sp > XB_SPIN_CAP) { atomicAdd(&(bar)[XB_TMO], 1u); break; } } } } while (0)

struct XcdBarrier { unsigned* bar; unsigned x; volatile LAS unsigned* st; };

__device__ __forceinline__ XcdBarrier xcd_barrier_post(unsigned* bar, volatile LAS unsigned* st) {
    XcdBarrier b; b.bar = bar; b.x = xb_xcc_id(); b.st = st;
    if (threadIdx.x == 0) (void)xb_add(&bar[XB_XCNT(b.x)], 1u);
    return b;
}
__device__ __forceinline__ void xcd_barrier_complete(unsigned* bar, unsigned x, unsigned& nloc, unsigned& nx) {
    const unsigned G = gridDim.x * gridDim.y * gridDim.z;
    unsigned sum, cnt, mine, sp = 0u;
    for (;;) {
        sum = 0u; cnt = 0u; mine = 0u;
#pragma unroll
        for (unsigned j = 0; j < 16; ++j) { const unsigned c = xb_ld(&bar[XB_XCNT(j)]); sum += c; cnt += (c > 0u) ? 1u : 0u; mine = (j == x) ? c : mine; }
        if (sum == G) break;
        __builtin_amdgcn_s_sleep(1);
        if ((++sp & 255u) == 0u) { if (xb_ld(&bar[XB_TMO])) break; if (sp > XB_SPIN_CAP) { atomicAdd(&bar[XB_TMO], 1u); break; } }
    }
    nloc = mine > 0u ? mine : 1u; nx = cnt > 0u ? cnt : 1u;
}
__device__ __forceinline__ void xcd_barrier(const XcdBarrier& b) {
    asm volatile("s_waitcnt vmcnt(0)" ::: "memory");
    __syncthreads();
    if (threadIdx.x == 0) {
        unsigned* bar = b.bar;
        __builtin_amdgcn_s_waitcnt(0);
        unsigned nloc = b.st[0], nx = b.st[1];
        if (nloc == 0u) { xcd_barrier_complete(bar, b.x, nloc, nx); b.st[0] = nloc; b.st[1] = nx; }
        const unsigned old = xb_add(&bar[XB_XSUB(b.x)], 1u);
        const unsigned gen = old / nloc;
        if (old + 1u == (gen + 1u) * nloc) {
            __builtin_amdgcn_fence(__ATOMIC_RELEASE, "agent");
            asm volatile("s_waitcnt vmcnt(0)" ::: "memory");
            const unsigned og = xb_add(&bar[XB_TOP], 1u);
            const unsigned tg = og / nx;
            if (og + 1u == (tg + 1u) * nx) xb_add(&bar[XB_TOPGEN], 1u);
            else XB_SPIN(xb_ld(&bar[XB_TOPGEN]) == tg, bar);
            __builtin_amdgcn_fence(__ATOMIC_ACQUIRE, "agent");
            xb_add(&bar[XB_XGEN(b.x)], 1u);
            asm volatile("s_waitcnt vmcnt(0)" ::: "memory");
        } else {
            XB_SPIN(xb_ld(&bar[XB_XGEN(b.x)]) == gen, bar);
            __builtin_amdgcn_fence(__ATOMIC_ACQUIRE, "agent");
            asm volatile("s_waitcnt vmcnt(0)" ::: "memory");
        }
    }
    __syncthreads();
}

namespace pg8 {
constexpr int BM = 256, BK = 64, HALF = 128, HTB = HALF * BK * 2, STAGE_BYTES = 8 * HTB;
__host__ __device__ __forceinline__ int lds_byte(int r, int c) { const int st = (r >> 4) * 2 + (c >> 5), rr = r & 15, cc = c & 31, ob = rr * 64 + cc * 2; return st * 1024 + (ob ^ (((ob >> 9) & 1) << 5)); }
__host__ __device__ __forceinline__ void stage_rc(int b, int& R, int& C) { const int st = b / 1024, sb = b % 1024, swz = sb ^ (((sb >> 9) & 1) << 5); R = (st >> 1) * 16 + swz / 64; C = (st & 1) * 32 + (swz % 64) / 2; }

struct Unit { int pm, pn; const char* A; const char* B; int aux; unsigned lda; };
struct Cfg { unsigned lda; unsigned kstepA; unsigned ldb; int nt; const int* rowidx; };

struct DenseOrder {
    int nM, nN, nwg, G, c; const char* A; const char* B; size_t tstepA, tstepB;
    __device__ void init(int nM_, int nN_, int G_, int c_, const void* A_, size_t tstepA_, const void* B_, size_t tstepB_) { nM = nM_; nN = nN_; nwg = nM * nN; G = G_; c = c_; A = (const char*)A_; B = (const char*)B_; tstepA = tstepA_; tstepB = tstepB_; }
    __device__ bool next(int i, Unit& u) const {
        const long Lq = (long)i * G + c; if (Lq >= nwg) return false;
        int wgid = (int)Lq; { const int q = nwg / 8, r = nwg % 8, xcd = wgid % 8, off = wgid / 8; wgid = (xcd < r ? xcd * (q + 1) : r * (q + 1) + (xcd - r) * q) + off; }
        const int nig = 8 * nN, gid = wgid / nig, fm = gid * 8, gsz = (nM - fm) < 8 ? (nM - fm) : 8;
        u.pm = fm + ((wgid % nig) % gsz); u.pn = (wgid % nig) / gsz; u.A = A + (size_t)u.pm * tstepA; u.B = B + (size_t)u.pn * tstepB; u.aux = 0; u.lda = 0u; return true;
    }
};

#define PG8_EPI_ROWCOL(row, col) const int row = u.pm * 256 + ai * 128 + wr * 64 + m * 16 + fr; const int col = u.pn * 256 + bj * 128 + wc * 32 + n * 16 + fq * 4;

template <bool INDEXED, class Epi, class Sched>
__device__ __forceinline__ void gemm_phase(LAS unsigned char* lds, int wid, const Cfg g, const Sched& S, const Epi& E) {
    int lane_; asm volatile("v_mbcnt_lo_u32_b32 %0, -1, 0\n\tv_mbcnt_hi_u32_b32 %0, -1, %0" : "=v"(lane_));
    const int lane = lane_, tid = wid * 64 + lane, wr = wid >> 2, wc = wid & 3, fr = lane & 15, fq = lane >> 4;
    const int nt = g.nt;
    int Rs[2], Cs[2]; unsigned voffB[2];
#pragma unroll
    for (int i = 0; i < 2; ++i) { stage_rc(tid * 16 + i * 8192, Rs[i], Cs[i]); voffB[i] = (unsigned)Rs[i] * g.ldb + (unsigned)Cs[i] * 2u; }
    const size_t kstepA = g.kstepA, kstepB = (size_t)(BK * 2);
    const size_t hstepB = (size_t)HALF * g.ldb;
    const unsigned ldsw = (unsigned)wid * 1024u;
    const int aoff = lds_byte(wr * 64 + fr, fq * 8), boff = lds_byte(wc * 32 + fr, fq * 8);
#define PG8_SA(b, h) (((b) * 2 + (h)) * HTB)
#define PG8_SB(b, h) ((4 + (b) * 2 + (h)) * HTB)
#define PG8_STAGE2(bufoff, gbase, v0, v1) do { const char* gb_ = (const char*)(gbase); asm volatile("" : "+s"(gb_)); \
        __builtin_amdgcn_global_load_lds((const unsigned*)(gb_ + (v0)), (LAS unsigned*)(lds + (bufoff) + ldsw), 16, 0, 0); \
        __builtin_amdgcn_global_load_lds((const unsigned*)(gb_ + (v1)), (LAS unsigned*)(lds + (bufoff) + ldsw + 8192), 16, 0, 0); } while (0)
#define PG8_STAGEB(bufoff, gbase) PG8_STAGE2(bufoff, gbase, voffB[0], voffB[1])
#define PG8_LDA(dst, b, h) do { _Pragma("unroll") for (int m = 0; m < 4; ++m) _Pragma("unroll") for (int k = 0; k < 2; ++k) dst[m][k] = *(const LAS bf16x8*)(lds + PG8_SA(b, h) + aoff + m * 2048 + k * 1024); } while (0)
#define PG8_LDB(dst, b, h) do { _Pragma("unroll") for (int n = 0; n < 2; ++n) _Pragma("unroll") for (int k = 0; k < 2; ++k) dst[n][k] = *(const LAS bf16x8*)(lds + PG8_SB(b, h) + boff + n * 2048 + k * 1024); } while (0)
#define PG8_MMA(ai, bj, At, Bt) do { __builtin_amdgcn_s_setprio(1); _Pragma("unroll") for (int m = 0; m < 4; ++m) _Pragma("unroll") for (int n = 0; n < 2; ++n) _Pragma("unroll") for (int k = 0; k < 2; ++k) \
        acc[ai][bj][m][n] = __builtin_amdgcn_mfma_f32_16x16x32_bf16(Bt[n][k], At[m][k], acc[ai][bj][m][n], 0, 0, 0); __builtin_amdgcn_s_setprio(0); } while (0)
#define PG8_WAIT_V(n) asm volatile("s_waitcnt vmcnt(" #n ")" ::: "memory")
#define PG8_WAIT_L(n) asm volatile("s_waitcnt lgkmcnt(" #n ")" ::: "memory")
#define PG8_BAR __builtin_amdgcn_s_barrier()
#define PG8_SCHED __builtin_amdgcn_sched_barrier(0)
    Unit cur, nxt; int ui = 0;
    if (!S.next(0, cur)) return;
    unsigned vAc[2][2], vAn[2][2];
#define PG8_SETVA(v, U) do { _Pragma("unroll") for (int h_ = 0; h_ < 2; ++h_) _Pragma("unroll") for (int i_ = 0; i_ < 2; ++i_) { \
        if constexpr (INDEXED) { const int r_ = g.rowidx[(U).aux + h_ * HALF + Rs[i_]]; v[h_][i_] = (unsigned)r_ * g.lda + (unsigned)Cs[i_] * 2u; } \
        else v[h_][i_] = (unsigned)(h_ * HALF + Rs[i_]) * ((U).lda ? (U).lda : g.lda) + (unsigned)Cs[i_] * 2u; } } while (0)
    PG8_SETVA(vAc, cur);
    f32x4 acc[2][2][4][2];
#pragma unroll
    for (int a = 0; a < 2; ++a)
#pragma unroll
        for (int b = 0; b < 2; ++b)
#pragma unroll
            for (int m = 0; m < 4; ++m)
#pragma unroll
                for (int n = 0; n < 2; ++n) acc[a][b][m][n] = (f32x4){0.f, 0.f, 0.f, 0.f};
    bf16x8 At[4][2], B0[2][2], B1[2][2];
    const char* cA = cur.A; const char* cB = cur.B;
    PG8_STAGEB(PG8_SB(0, 0), cB); PG8_STAGEB(PG8_SB(0, 1), cB + hstepB); PG8_STAGE2(PG8_SA(0, 0), cA, vAc[0][0], vAc[0][1]); PG8_STAGE2(PG8_SA(0, 1), cA, vAc[1][0], vAc[1][1]);
    if (wr == 1) PG8_BAR;
    PG8_WAIT_V(2); PG8_BAR;
    PG8_STAGEB(PG8_SB(1, 0), cB + kstepB); PG8_STAGE2(PG8_SA(1, 0), cA + kstepA, vAc[0][0], vAc[0][1]); PG8_STAGEB(PG8_SB(1, 1), cB + hstepB + kstepB);
    PG8_WAIT_V(6); PG8_BAR;
    for (;;) {
        const bool has_next = S.next(ui + 1, nxt);
        const char* nA = has_next ? nxt.A : cA; const char* nB = has_next ? nxt.B : cB;
        if (has_next) { PG8_SETVA(vAn, nxt); } else {
#pragma unroll
            for (int h_ = 0; h_ < 2; ++h_)
#pragma unroll
                for (int i_ = 0; i_ < 2; ++i_) vAn[h_][i_] = vAc[h_][i_]; }
        for (int t = 0; t < nt; t += 2) {
            const bool last = (t == nt - 2);
            const char* a1 = cA + (size_t)(t + 1) * kstepA;
            const char* a2 = last ? nA : cA + (size_t)(t + 2) * kstepA; const char* b2 = last ? nB : cB + (size_t)(t + 2) * kstepB;
            const char* a3 = a2 + kstepA; const char* b3 = b2 + kstepB;
            const unsigned w00 = last ? vAn[0][0] : vAc[0][0], w01 = last ? vAn[0][1] : vAc[0][1], w10 = last ? vAn[1][0] : vAc[1][0], w11 = last ? vAn[1][1] : vAc[1][1];
            PG8_LDB(B0, 0, 0); PG8_LDB(B1, 0, 1); PG8_SCHED; PG8_LDA(At, 0, 0); PG8_STAGE2(PG8_SA(1, 1), a1, vAc[1][0], vAc[1][1]);
            PG8_WAIT_V(8); PG8_WAIT_L(0); PG8_BAR; PG8_MMA(0, 0, At, B0); PG8_MMA(0, 1, At, B1); PG8_BAR; PG8_SCHED;
            PG8_LDA(At, 0, 1); PG8_STAGEB(PG8_SB(0, 0), b2); PG8_STAGEB(PG8_SB(0, 1), b2 + hstepB); PG8_STAGE2(PG8_SA(0, 0), a2, w00, w01);
            PG8_WAIT_V(8); PG8_WAIT_L(0); PG8_BAR; PG8_MMA(1, 0, At, B0); PG8_MMA(1, 1, At, B1); PG8_BAR; PG8_SCHED;
            PG8_LDB(B0, 1, 0); PG8_LDB(B1, 1, 1); PG8_SCHED; PG8_LDA(At, 1, 0); PG8_STAGE2(PG8_SA(0, 1), a2, w10, w11);
            PG8_WAIT_V(8); PG8_WAIT_L(0); PG8_BAR; PG8_MMA(0, 0, At, B0); PG8_MMA(0, 1, At, B1); PG8_BAR; PG8_SCHED;
            PG8_LDA(At, 1, 1); PG8_STAGEB(PG8_SB(1, 0), b3); PG8_STAGEB(PG8_SB(1, 1), b3 + hstepB); PG8_STAGE2(PG8_SA(1, 0), a3, w00, w01);
            PG8_WAIT_V(8); PG8_WAIT_L(0); PG8_BAR; PG8_MMA(1, 0, At, B0); PG8_MMA(1, 1, At, B1); PG8_BAR; PG8_SCHED;
        }
        if (wr == 0) PG8_BAR;
        { int l2_; asm volatile("v_mbcnt_lo_u32_b32 %0, -1, 0\n\tv_mbcnt_hi_u32_b32 %0, -1, %0" : "=v"(l2_)); E(acc, cur, wr, wc, l2_ & 15, l2_ >> 4); }
        if (!has_next) break;
#pragma unroll
        for (int a = 0; a < 2; ++a)
#pragma unroll
            for (int b = 0; b < 2; ++b)
#pragma unroll
                for (int m = 0; m < 4; ++m)
#pragma unroll
                    for (int n = 0; n < 2; ++n) acc[a][b][m][n] = (f32x4){0.f, 0.f, 0.f, 0.f};
        cur = nxt; cA = nA; cB = nB; ++ui;
#pragma unroll
        for (int h_ = 0; h_ < 2; ++h_)
#pragma unroll
            for (int i_ = 0; i_ < 2; ++i_) vAc[h_][i_] = vAn[h_][i_];
        if (wr == 1) PG8_BAR;
    }
    PG8_WAIT_V(0);
    PG8_BAR;
#undef PG8_SA
#undef PG8_SB
#undef PG8_STAGE2
#undef PG8_STAGEB
#undef PG8_LDA
#undef PG8_LDB
#undef PG8_MMA
#undef PG8_WAIT_V
#undef PG8_WAIT_L
#undef PG8_BAR
#undef PG8_SCHED
#undef PG8_SETVA
}
}

constexpr int LDS_MISC = 131072;
constexpr int LDS_MOETAB = LDS_MISC + 64;
constexpr int LDS_INTAB = LDS_MISC + 512;
struct Ctx {
    float* out; unsigned char* ws; unsigned char* ws0;
    LAS unsigned char* lds;
    int tid, lane, wave, G, bid;
    __device__ __forceinline__ const void* inp(int i) const { const LAS unsigned* p = (const LAS unsigned*)(lds + LDS_INTAB) + 2 * i;
        const unsigned lo = (unsigned)__builtin_amdgcn_readfirstlane((int)p[0]), hi = (unsigned)__builtin_amdgcn_readfirstlane((int)p[1]); return (const void*)(const __attribute__((address_space(1))) char*)(((unsigned long long)hi << 32) | lo); }
    __device__ __forceinline__ const float* x() const { return (const float*)inp(0); }
    __device__ __forceinline__ const int* pos() const { return (const int*)inp(1); }
    __device__ __forceinline__ const float* rel_bias() const { return (const float*)inp(2); }
    __device__ __forceinline__ const float* norm_attn() const { return (const float*)inp(3); }
    __device__ __forceinline__ const float* w_in() const { return (const float*)inp(4); }
    __device__ __forceinline__ const float* b_merge() const { return (const float*)inp(5); }
    __device__ __forceinline__ const float* cmp_pe() const { return (const float*)inp(6); }
    __device__ __forceinline__ const float* cmp_k_w1() const { return (const float*)inp(7); }
    __device__ __forceinline__ const float* cmp_k_b1() const { return (const float*)inp(8); }
    __device__ __forceinline__ const float* cmp_k_w2() const { return (const float*)inp(9); }
    __device__ __forceinline__ const float* cmp_v_w1() const { return (const float*)inp(10); }
    __device__ __forceinline__ const float* cmp_v_b1() const { return (const float*)inp(11); }
    __device__ __forceinline__ const float* cmp_v_w2() const { return (const float*)inp(12); }
    __device__ __forceinline__ const float* mla_q_norm() const { return (const float*)inp(13); }
    __device__ __forceinline__ const float* mla_kv_norm() const { return (const float*)inp(14); }
    __device__ __forceinline__ const float* mla_w_uq() const { return (const float*)inp(15); }
    __device__ __forceinline__ const float* mla_w_uk() const { return (const float*)inp(16); }
    __device__ __forceinline__ const float* mla_w_uv() const { return (const float*)inp(17); }
    __device__ __forceinline__ const float* fox_b_f() const { return (const float*)inp(18); }
    __device__ __forceinline__ const float* w_o_nsa() const { return (const float*)inp(19); }
    __device__ __forceinline__ const float* w_o_mla() const { return (const float*)inp(20); }
    __device__ __forceinline__ const float* w_o_fox() const { return (const float*)inp(21); }
    __device__ __forceinline__ const float* w_out() const { return (const float*)inp(22); }
    __device__ __forceinline__ const float* norm_ffn() const { return (const float*)inp(23); }
    __device__ __forceinline__ const float* moe_w_grp() const { return (const float*)inp(24); }
    __device__ __forceinline__ const float* moe_b_grp() const { return (const float*)inp(25); }
    __device__ __forceinline__ const float* moe_w_router() const { return (const float*)inp(26); }
    __device__ __forceinline__ const float* moe_b_router() const { return (const float*)inp(27); }
    __device__ __forceinline__ const float* moe_w_gate() const { return (const float*)inp(28); }
    __device__ __forceinline__ const float* moe_w_up() const { return (const float*)inp(29); }
    __device__ __forceinline__ const float* moe_w_down() const { return (const float*)inp(30); }
    __device__ __forceinline__ const float* norm_final() const { return (const float*)inp(31); }
};
#define WSP(T_, off) ((T_*)(c.ws + (off)))
__device__ __forceinline__ int lane_id_volatile() { int ln; asm volatile("v_mbcnt_lo_u32_b32 %0, -1, 0\n\tv_mbcnt_hi_u32_b32 %0, -1, %0" : "=v"(ln)); return ln; }
__device__ __forceinline__ void relaunder(Ctx& c) { const int ln = lane_id_volatile(); c.lane = ln; c.tid = c.wave * 64 + ln;
    size_t z_ = 0; asm volatile("" : "+s"(z_)); c.ws = c.ws0 + z_; int g_ = c.G, b_ = c.bid, wv_ = c.wave; asm volatile("" : "+s"(g_), "+s"(b_), "+s"(wv_)); c.G = g_; c.bid = b_; c.wave = wv_; }

struct TItem { const float* wp; size_t ldw; bf16_t* wt; const float* rsp; float colscale; int K; bool pad; };
__device__ __forceinline__ TItem make_titem(const float* W, int ldw, int K, bf16_t* WT, const float* rowscale, int sc, int nblk, int item, int lane, float colscale) {
    const int kb = item / nblk, nb = item % nblk, k0 = 64 * kb, n0 = 32 * nb, cc = lane & 7;
    TItem t; t.wp = W + (size_t)(k0 + (lane >> 5)) * ldw + (sc >= 0 ? sc : 0); t.ldw = (size_t)ldw; t.wt = WT + (size_t)n0 * K + k0 + 8 * cc; t.rsp = rowscale ? rowscale + k0 + 8 * cc : nullptr; t.colscale = colscale; t.K = K; t.pad = sc < 0;
    return t;
}
__device__ __forceinline__ void t_load(const TItem& t, float (&v)[32], float (&rsc)[8]) {
#pragma unroll
    for (int i = 0; i < 32; ++i) v[i] = t.wp[(size_t)(2 * i) * t.ldw];
    if (t.rsp) { const f32x4 a = *(const f32x4*)t.rsp, b = *(const f32x4*)(t.rsp + 4); rsc[0] = a.x; rsc[1] = a.y; rsc[2] = a.z; rsc[3] = a.w; rsc[4] = b.x; rsc[5] = b.y; rsc[6] = b.z; rsc[7] = b.w; }
    else {
#pragma unroll
        for (int i = 0; i < 8; ++i) rsc[i] = 1.f; }
}
__device__ __forceinline__ void t_finish(const TItem& t, const float (&v)[32], const float (&rsc)[8], LAS float* scr, int lane) {
    const int cc = lane & 7;
#pragma unroll
    for (int i = 0; i < 32; ++i) scr[(2 * i + (lane >> 5)) * 33 + (lane & 31)] = t.pad ? 0.f : v[i];
    LDS_WAIT(); asm volatile("" ::: "memory");
#pragma unroll
    for (int j = 0; j < 4; ++j) { const int n = (lane >> 3) + 8 * j; const LAS float* s_ = scr + (8 * cc) * 33 + n; const float cs = t.colscale;
        u32x4 o; o.x = cvtpk(s_[0 * 33] * (rsc[0] * cs), s_[1 * 33] * (rsc[1] * cs)); o.y = cvtpk(s_[2 * 33] * (rsc[2] * cs), s_[3 * 33] * (rsc[3] * cs));
        o.z = cvtpk(s_[4 * 33] * (rsc[4] * cs), s_[5 * 33] * (rsc[5] * cs)); o.w = cvtpk(s_[6 * 33] * (rsc[6] * cs), s_[7 * 33] * (rsc[7] * cs));
        *(u32x4*)(t.wt + (size_t)n * t.K) = o; }
    LDS_WAIT(); asm volatile("" ::: "memory");
}
#define T_PIPELINE(N_ITEMS, MAKE) do { int it_ = gw;    if (it_ < (N_ITEMS)) { TItem A_ = MAKE(it_); float va_[32], ra_[8]; t_load(A_, va_, ra_); \
    for (;;) { const int itn_ = it_ + NGW; const bool hb_ = itn_ < (N_ITEMS); TItem B_; float vb_[32], rb_[8]; if (hb_) { B_ = MAKE(itn_); t_load(B_, vb_, rb_); } \
        __builtin_amdgcn_sched_barrier(0); t_finish(A_, va_, ra_, scr, c.lane); if (!hb_) break; \
        const int itn2_ = itn_ + NGW; const bool ha_ = itn2_ < (N_ITEMS); if (ha_) { A_ = MAKE(itn2_); t_load(A_, va_, ra_); } \
        __builtin_amdgcn_sched_barrier(0); t_finish(B_, vb_, rb_, scr, c.lane); if (!ha_) break; it_ = itn2_; } } } while (0)
#define T_SIMPLE(N_ITEMS, MAKE) do { for (int it_ = gw; it_ < (N_ITEMS); it_ += NGW) { TItem A_ = MAKE(it_); float va_[32], ra_[8]; t_load(A_, va_, ra_); __builtin_amdgcn_sched_barrier(0); t_finish(A_, va_, ra_, scr, c.lane); } } while (0)
struct MapId { int off; __device__ int operator()(int n) const { return n + off; } };
struct MapInproj { __device__ int operator()(int n) const { if (n < 1280) return n; if (n < 1696) return n + 24; if (n < 1720) return n - 416; if (n < 1728) return n + 1536; if (n < 3264) return n - 8; return -1; } };
struct MapUq { __device__ int operator()(int n) const { if (n < 512) return (n >> 6) * 96 + (n & 63); const int r = n - 512; return (r >> 5) * 96 + 64 + (r & 31); } };
struct MapPad128 { __device__ int operator()(int n) const { return n < 128 ? n : -1; } };
struct MapGU { __device__ int operator()(int n) const { return (n >> 8) * 128 + (n & 127); } };

__device__ __forceinline__ int rel_bucket_dev(int n) {
    if (n < 16) return n;
    const float lr = __logf((float)n / 16.f) / 2.0794415416798357f;
    int large = 16 + (int)(lr * 16.f);
    return large < 31 ? large : 31;
}

constexpr int PI_WIN = 16 * (P1W / 32), PI_WM = 16 * 96, PI_UQ = 4 * 24, PI_UK = 2 * 16, PI_UV = 2 * 16, PI_WO = 8 * 32, PI_WOUT = 16 * 32, PI_C1 = 32 * 8;
constexpr int PI_PER_L = PI_WIN + PI_WM + PI_UQ + PI_UK + PI_UV + 3 * PI_WO + PI_WOUT + 2 * PI_C1;
__device__ __forceinline__ TItem prologue_item(const Ctx& c, int it) {
    const int l = it / PI_PER_L; int r = it % PI_PER_L; const int ln = c.lane & 31;
    if (r < PI_WIN) { const int n0_ = 32 * (r % (P1W / 32)); const float cs_ = (n0_ < 512 || (n0_ >= C_FQKV && n0_ < C_FQKV + 512)) ? QSCALE64 : 1.f;
        return make_titem(c.w_in() + (size_t)l * D * DIN, DIN, D, WSP(bf16_t, WS_WINT) + (size_t)l * NCAT * D, c.norm_attn() + l * D, MapInproj{}(n0_ + ln), P1W / 32, r, c.lane, cs_); } r -= PI_WIN;
    if (r < PI_WM) return make_titem(c.w_in() + (size_t)l * D * DIN, DIN, D, WSP(bf16_t, WS_WINT) + ((size_t)l * NCAT + P1W) * D, c.norm_attn() + l * D, 3264 + 32 * (r % 96) + ln, 96, r, c.lane, 1.f); r -= PI_WM;
    if (r < PI_UQ) return make_titem(c.mla_w_uq() + (size_t)l * 256 * 768, 768, 256, WSP(bf16_t, WS_WUQT) + (size_t)l * 768 * 256, c.mla_q_norm() + l * 256, MapUq{}(32 * (r % 24) + ln), 24, r, c.lane, QSCALE96); r -= PI_UQ;
    if (r < PI_UK) return make_titem(c.mla_w_uk() + (size_t)l * 128 * 512, 512, 128, WSP(bf16_t, WS_WUKVT) + (size_t)l * 1024 * 128, c.mla_kv_norm() + l * 128, 32 * (r % 16) + ln, 16, r, c.lane, 1.f); r -= PI_UK;
    if (r < PI_UV) return make_titem(c.mla_w_uv() + (size_t)l * 128 * 512, 512, 128, WSP(bf16_t, WS_WUKVT) + (size_t)l * 1024 * 128 + 512 * 128, c.mla_kv_norm() + l * 128, 32 * (r % 16) + ln, 16, r, c.lane, 1.f); r -= PI_UV;
    if (r < 3 * PI_WO) { const int br = r / PI_WO, rr = r % PI_WO; return make_titem((const float*)c.inp(19 + br) + (size_t)l * 512 * 1024, 1024, 512, WSP(bf16_t, WS_WOT) + ((size_t)l * 3 + br) * 1024 * 512, nullptr, 32 * (rr % 32) + ln, 32, rr, c.lane, 1.f); } r -= 3 * PI_WO;
    if (r < PI_WOUT) return make_titem(c.w_out() + (size_t)l * D * D, D, D, WSP(bf16_t, WS_WOUTT) + (size_t)l * D * D, nullptr, 32 * (r % 32) + ln, 32, r, c.lane, 1.f); r -= PI_WOUT;
    { const int kv = r / PI_C1, rr = r % PI_C1; const int n_ = 32 * (rr % 8) + ln;
      return make_titem((const float*)c.inp(kv == 0 ? 7 : 10) + (size_t)l * 2048 * 128, 128, 2048, WSP(bf16_t, WS_WC1T) + ((size_t)l * 2 + kv) * 256 * 2048, nullptr, n_ < 128 ? n_ : -1, 8, rr, c.lane, 1.f); }
}
__device__ __forceinline__ void phase_prologue(const Ctx& c) {
    LAS float* scr = (LAS float*)(c.lds + c.wave * 16384);
    const int gw = c.bid * NWAVES + c.wave, NGW = c.G * NWAVES;
#define PRO_MAKE(i_) prologue_item(c, (i_))
    T_PIPELINE(PI_WIN + PI_WM, PRO_MAKE);
#undef PRO_MAKE
    { float* rc = WSP(float, WS_ROPE); float* rs = rc + (size_t)M * 16;
      for (int i = c.bid * NTHREADS + c.tid; i < M * 16; i += c.G * NTHREADS) { const int m = i >> 4, j = i & 15;
          const float inv = exp2f(-(float)j * 0.8304820237218407f);   const float ang = (float)c.pos()[m] * inv; double rev = (double)ang * 0.15915494309189535; rev -= floor(rev); const float fr_ = (float)rev; rc[i] = __builtin_amdgcn_cosf(fr_); rs[i] = __builtin_amdgcn_sinf(fr_); } }
    float* tab = WSP(float, WS_TAB);
    if (c.bid == 0) {
        const int l = c.tid >> 8, kv = (c.tid >> 7) & 1, j = c.tid & 127;
        const float* w1 = (kv == 0 ? c.cmp_k_w1() : c.cmp_v_w1()) + (size_t)l * 2048 * 128; const float* b1 = (kv == 0 ? c.cmp_k_b1() : c.cmp_v_b1()) + l * 128; const float* pe = c.cmp_pe() + l * 2048;
        float s = b1[j]; for (int k = 0; k < 2048; ++k) s += pe[k] * w1[(size_t)k * 128 + j];
        tab[c.tid] = s;
    }
    if (c.bid == 1 % c.G) {
        for (int i = c.tid; i < 8 * 129; i += NTHREADS) { const int h = i / 129, d = i % 129; tab[512 + h * 132 + d] = c.rel_bias()[rel_bucket_dev(d) * 8 + h] * LOG2E; }
    }
}

__device__ __forceinline__ void phase_norm(const Ctx& c, const float* src, const bf16_t* y0, const bf16_t* y1, float* rout, bf16_t* hout) {
    const int gw = c.bid * NWAVES + c.wave, NGW = c.G * NWAVES;
    for (int m = gw; m < M; m += NGW) {
        const f32x4* xr = (const f32x4*)(src + (size_t)m * D) + c.lane;
        f32x4 v[4]; float s = 0.f;
#pragma unroll
        for (int j = 0; j < 4; ++j) { v[j] = xr[64 * j];
            if (y0) { const u32x2 a = *((const u32x2*)(y0 + (size_t)m * D) + c.lane + 64 * j); const u32x2 b = *((const u32x2*)(y1 + (size_t)m * D) + c.lane + 64 * j);
                v[j].x += __uint_as_float(a.x << 16) + __uint_as_float(b.x << 16); v[j].y += __uint_as_float(a.x & 0xffff0000u) + __uint_as_float(b.x & 0xffff0000u);
                v[j].z += __uint_as_float(a.y << 16) + __uint_as_float(b.y << 16); v[j].w += __uint_as_float(a.y & 0xffff0000u) + __uint_as_float(b.y & 0xffff0000u); }
            s += (v[j].x * v[j].x + v[j].y * v[j].y) + (v[j].z * v[j].z + v[j].w * v[j].w); }
        const float rstd = rsqrtf(wave_sum(s) * (1.f / D) + EPS);
        if (rout) { f32x4* ro = (f32x4*)(rout + (size_t)m * D) + c.lane;
#pragma unroll
            for (int j = 0; j < 4; ++j) ro[64 * j] = v[j]; }
        u32x2* o8 = (u32x2*)(hout + (size_t)m * D) + c.lane;
#pragma unroll
        for (int j = 0; j < 4; ++j) { u32x2 w; w.x = pk2(v[j].x * rstd, v[j].y * rstd); w.y = pk2(v[j].z * rstd, v[j].w * rstd); o8[64 * j] = w; }
    }
}
__device__ __forceinline__ void phase_final(const Ctx& c) {
    const int gw = c.bid * NWAVES + c.wave, NGW = c.G * NWAVES;
    const float* src = WSP(float, WS_XA); const bf16_t* y0 = WSP(bf16_t, WS_Y); const bf16_t* y1 = y0 + (size_t)M * D;
    for (int m = gw; m < M; m += NGW) {
        const f32x4* xr = (const f32x4*)(src + (size_t)m * D) + c.lane;
        f32x4 v[4]; float s = 0.f;
#pragma unroll
        for (int j = 0; j < 4; ++j) { v[j] = xr[64 * j];
            const u32x2 a = *((const u32x2*)(y0 + (size_t)m * D) + c.lane + 64 * j); const u32x2 b = *((const u32x2*)(y1 + (size_t)m * D) + c.lane + 64 * j);
            v[j].x += __uint_as_float(a.x << 16) + __uint_as_float(b.x << 16); v[j].y += __uint_as_float(a.x & 0xffff0000u) + __uint_as_float(b.x & 0xffff0000u);
            v[j].z += __uint_as_float(a.y << 16) + __uint_as_float(b.y << 16); v[j].w += __uint_as_float(a.y & 0xffff0000u) + __uint_as_float(b.y & 0xffff0000u);
            s += (v[j].x * v[j].x + v[j].y * v[j].y) + (v[j].z * v[j].z + v[j].w * v[j].w); }
        const float rstd = rsqrtf(wave_sum(s) * (1.f / D) + EPS);
        f32x4* ro = (f32x4*)(c.out + (size_t)m * D) + c.lane;
#pragma unroll
        for (int j = 0; j < 4; ++j) { const f32x4 g = *((const f32x4*)c.norm_final() + c.lane + 64 * j); ro[64 * j] = v[j] * rstd * g; }
    }
}

constexpr size_t WS_LC = WS_LF, WS_CT = WS_CUM, WS_CP = WS_CUM + 64 * 1024;
__device__ __forceinline__ void phase_prep(const Ctx& c, int l, int cbid, int cG) {
    const bf16_t* P1 = WSP(bf16_t, WS_P1); float* rstd = WSP(float, WS_RSTD); bf16_t* KR = WSP(bf16_t, WS_KR); float* LC = WSP(float, WS_LC); float* CT = WSP(float, WS_CT);
    const float* rc = WSP(float, WS_ROPE); const float* rs = rc + (size_t)M * 16;
    float kmx0 = 0.f, kmx1 = 0.f;
    LAS unsigned* kml = (LAS unsigned*)(c.lds + 4096); LAS float* wt = (LAS float*)(c.lds + 4096 + 64);
    if (c.tid < 16) kml[c.tid] = 0u;
    __syncthreads();
    const float bf_ = (c.lane < 8) ? c.fox_b_f()[l * 8 + c.lane] : 0.f;
    for (int ch = cbid; ch < M / 64; ch += cG) {
        float run = 0.f, rv[8];
#pragma unroll
        for (int i = 0; i < 8; ++i) { const int m = ch * 64 + c.wave * 8 + i;
            const bf16_t* row = P1 + (size_t)m * P1W;
            const u32x2 a = *((const u32x2*)(row + C_CQ) + c.lane);
            const unsigned b = *((const unsigned*)(row + C_CKV) + c.lane);
            const u32x4 kq = *((const u32x4*)(row + C_FQKV + 512) + c.lane);
            const float x1 = (c.lane < 16) ? bf2f(row[C_KR + c.lane]) : 0.f, x2 = (c.lane < 16) ? bf2f(row[C_KR + 16 + c.lane]) : 0.f;
            const float cs = (c.lane < 16) ? rc[m * 16 + c.lane] : 0.f, sn = (c.lane < 16) ? rs[m * 16 + c.lane] : 0.f;
            const float ff = (c.lane < 8) ? bf2f(row[C_FF + c.lane]) : 0.f;
            float q0 = __uint_as_float(a.x << 16), q1 = __uint_as_float(a.x & 0xffff0000u), q2 = __uint_as_float(a.y << 16), q3 = __uint_as_float(a.y & 0xffff0000u);
            const float sq = wave_sum(q0 * q0 + q1 * q1 + q2 * q2 + q3 * q3);
            float k0 = __uint_as_float(b << 16), k1 = __uint_as_float(b & 0xffff0000u);
            const float sk = wave_sum(k0 * k0 + k1 * k1);
            if (c.lane == 0) { rstd[2 * m] = rsqrtf(sq * (1.f / 256.f) + EPS); rstd[2 * m + 1] = rsqrtf(sk * (1.f / 128.f) + EPS); }
            if (c.lane < 16) { KR[m * 32 + c.lane] = (bf16_t)f2bf(x1 * cs - x2 * sn); KR[m * 32 + 16 + c.lane] = (bf16_t)f2bf(x1 * sn + x2 * cs); }
            { const f32x4 a0 = unpk4((u32x2){kq.x, kq.y}), a1 = unpk4((u32x2){kq.z, kq.w});
              float ss = (a0.x * a0.x + a0.y * a0.y) + (a0.z * a0.z + a0.w * a0.w) + (a1.x * a1.x + a1.y * a1.y) + (a1.z * a1.z + a1.w * a1.w);
              ss += dpp_f<0xB1>(ss); ss += dpp_f<0x4E>(ss); ss += dpp_f<0x141>(ss);
              if (m < T) kmx0 = fmaxf(kmx0, ss); else kmx1 = fmaxf(kmx1, ss); }
            const float f = ff + bf_;
            const float ls = fminf(f, 0.f) - __logf(1.f + __expf(-fabsf(f)));
            run += ls; rv[i] = run; }
        if (c.lane < 8) wt[c.wave * 8 + c.lane] = run;
        __syncthreads();
        if (c.lane < 8) { float pre = 0.f; for (int w_ = 0; w_ < c.wave; ++w_) pre += wt[w_ * 8 + c.lane];
            const int m0 = ch * 64 + c.wave * 8, bb = m0 / T, t0 = m0 % T; float* lc = LC + ((size_t)bb * 8 + c.lane) * T + t0;
#pragma unroll
            for (int i = 0; i < 8; ++i) lc[i] = (pre + rv[i]) * LOG2E;
            if (c.wave == 7) CT[((size_t)bb * 8 + c.lane) * 128 + (t0 >> 6)] = (pre + run) * LOG2E; }
        __syncthreads();
    }
    if ((c.lane & 7) == 0) { atomicMax((unsigned*)(kml + (c.lane >> 3)), __float_as_uint(kmx0)); atomicMax((unsigned*)(kml + 8 + (c.lane >> 3)), __float_as_uint(kmx1)); }
    __syncthreads();
    if (c.tid < 16) atomicMax(WSP(unsigned, WS_CTL) + CW_KMAX + l * 16 + c.tid, kml[c.tid]);
}
__device__ __forceinline__ void phase_chunk_prefix(const Ctx& c) {
    LAS float* sh = (LAS float*)(c.lds + 8192);
    for (int s_ = c.bid; s_ < NB * 8; s_ += c.G) {
        if (c.tid < 128) sh[c.tid] = WSP(float, WS_CT)[(size_t)s_ * 128 + c.tid];
        __syncthreads();
        if (c.tid == 0) { float run = 0.f; float* cp = WSP(float, WS_CP) + (size_t)s_ * 129; for (int i = 0; i < 128; ++i) { cp[i] = run; run += sh[i]; } cp[128] = run; }
        __syncthreads();
    }
}
__device__ __forceinline__ void phase_cmp2(const Ctx& c, int l) {
    const float* SL = WSP(float, WS_SL); const float* bc1 = WSP(float, WS_TAB) + l * 256;
    LAS float* hl = (LAS float*)(c.lds + c.wave * 1024);
    for (int pr = c.bid * NWAVES + c.wave; pr < 2 * 2048; pr += c.G * NWAVES) {
        const int kv = pr >> 11, row = pr & 2047, d = c.lane;
        const float* w2 = (kv == 0 ? c.cmp_k_w2() : c.cmp_v_w2()) + (size_t)l * 128 * 64 + d;
        const float* s0 = SL + ((size_t)kv * 2048 + row) * 128; const float* s1 = s0 + (size_t)2 * 2048 * 128;
        const float a0 = s0[d], a1 = s0[d + 64], b0 = s1[d], b1 = s1[d + 64], c0 = bc1[kv * 128 + d], c1 = bc1[kv * 128 + d + 64];
        hl[d] = gelu_tanh(a0 + b0 + c0); hl[d + 64] = gelu_tanh(a1 + b1 + c1);
        LDS_WAIT(); asm volatile("" ::: "memory");
        float s = 0.f;
#pragma unroll
        for (int jb = 0; jb < 4; ++jb) { float wv[32];
#pragma unroll
            for (int i = 0; i < 32; ++i) wv[i] = w2[(size_t)(32 * jb + i) * 64];
            __builtin_amdgcn_sched_barrier(0);
#pragma unroll
            for (int i = 0; i < 32; ++i) s += hl[32 * jb + i] * wv[i]; }
        if ((row & 511) == 511) s = 0.f;
        (kv == 0 ? WSP(bf16_t, WS_KC) : WSP(bf16_t, WS_VC))[(size_t)row * 64 + d] = (bf16_t)f2bf(s);
        LDS_WAIT(); asm volatile("" ::: "memory");
    }
}
__device__ __forceinline__ u32x2 pk4(f32x4 v) { u32x2 w; w.x = cvtpk(v.x, v.y); w.y = cvtpk(v.z, v.w); return w; }
#define EPI_ARGS const f32x4 (&acc)[2][2][4][2], const pg8::Unit& u, int wr, int wc, int fr, int fq
#define EPI_LOOP _Pragma("unroll") for (int ai = 0; ai < 2; ++ai) _Pragma("unroll") for (int m = 0; m < 4; ++m) _Pragma("unroll") for (int bj = 0; bj < 2; ++bj) _Pragma("unroll") for (int n = 0; n < 2; ++n)

#define EPI_ROW(ai, m) (u.pm * 256 + (ai) * 128 + wr * 64 + (m) * 16 + fr)
#define EPI_COL(bj, n) (u.pn * 256 + (bj) * 128 + wc * 32 + (n) * 16 + fq * 4)
struct EpiStoreBf16 { bf16_t* O; int ldc; const float* rowscale; int rs_stride;
    __device__ __forceinline__ void operator()(EPI_ARGS) const {
        float rs[2][4];
#pragma unroll
        for (int ai = 0; ai < 2; ++ai)
#pragma unroll
            for (int m = 0; m < 4; ++m) rs[ai][m] = rowscale ? rowscale[(size_t)EPI_ROW(ai, m) * rs_stride] : 1.f;
        __builtin_amdgcn_sched_barrier(0);
        EPI_LOOP { const unsigned off = (unsigned)EPI_ROW(ai, m) * (unsigned)ldc + (unsigned)EPI_COL(bj, n); *(u32x2*)(O + off) = pk4(acc[ai][bj][m][n] * rs[ai][m]); } } };
struct EpiUqRope { bf16_t* QB; const float* rstd; const float* ropec; const float* ropes;
    __device__ __forceinline__ void operator()(EPI_ARGS) const {
#pragma unroll
        for (int ai = 0; ai < 2; ++ai) { float rs[4]; f32x4 cs4[4], sn4[4];
#pragma unroll
            for (int m = 0; m < 4; ++m) { const unsigned row = (unsigned)EPI_ROW(ai, m); rs[m] = rstd[(size_t)row * 2]; cs4[m] = *(const f32x4*)(ropec + row * 16u + fq * 4); sn4[m] = *(const f32x4*)(ropes + row * 16u + fq * 4); }
            __builtin_amdgcn_sched_barrier(0);
#pragma unroll
            for (int m = 0; m < 4; ++m)
#pragma unroll
                for (int bj = 0; bj < 2; ++bj) { const f32x4 x1 = acc[ai][bj][m][0] * rs[m], x2 = acc[ai][bj][m][1] * rs[m];
                    const f32x4 o1 = x1 * cs4[m] - x2 * sn4[m], o2 = x1 * sn4[m] + x2 * cs4[m];
                    const unsigned off = (unsigned)EPI_ROW(ai, m) * 768u + (unsigned)EPI_COL(bj, 0);
                    *(u32x2*)(QB + off) = pk4(o1); *(u32x2*)(QB + off + 16) = pk4(o2); }
            __builtin_amdgcn_sched_barrier(0); } } };
struct EpiInprojGates { bf16_t* P1o; unsigned char* G8; const float* bias;
    __device__ __forceinline__ void operator()(EPI_ARGS) const {
        if (u.pn < 13) { EPI_LOOP { *(u32x2*)(P1o + (unsigned)EPI_ROW(ai, m) * (unsigned)P1W + (unsigned)EPI_COL(bj, n)) = pk4(acc[ai][bj][m][n]); } }
        else { f32x4 bv[2][2];
#pragma unroll
            for (int bj = 0; bj < 2; ++bj)
#pragma unroll
                for (int n = 0; n < 2; ++n) bv[bj][n] = *(const f32x4*)(bias + (EPI_COL(bj, n) - P1W));
            __builtin_amdgcn_sched_barrier(0);
            EPI_LOOP { const f32x4 v = acc[ai][bj][m][n] + bv[bj][n];
                const unsigned q0_ = (unsigned)(sigmoidf_(v.x) * 255.f + 0.5f), q1_ = (unsigned)(sigmoidf_(v.y) * 255.f + 0.5f), q2_ = (unsigned)(sigmoidf_(v.z) * 255.f + 0.5f), q3_ = (unsigned)(sigmoidf_(v.w) * 255.f + 0.5f);
                *(unsigned*)(G8 + (size_t)EPI_ROW(ai, m) * 3072u + (unsigned)(EPI_COL(bj, n) - P1W)) = q0_ | (q1_ << 8) | (q2_ << 16) | (q3_ << 24); } } } };
struct EpiGates { bf16_t* O; const float* bias;
    __device__ __forceinline__ void operator()(EPI_ARGS) const {
        f32x4 bv[2][2];
#pragma unroll
        for (int bj = 0; bj < 2; ++bj)
#pragma unroll
            for (int n = 0; n < 2; ++n) bv[bj][n] = *(const f32x4*)(bias + EPI_COL(bj, n));
        __builtin_amdgcn_sched_barrier(0);
        EPI_LOOP { f32x4 v = acc[ai][bj][m][n] + bv[bj][n];
            v.x = sigmoidf_(v.x); v.y = sigmoidf_(v.y); v.z = sigmoidf_(v.z); v.w = sigmoidf_(v.w); *(u32x2*)(O + (unsigned)EPI_ROW(ai, m) * 3072u + (unsigned)EPI_COL(bj, n)) = pk4(v); } } };
struct EpiCmpSlab { float* SL;
    __device__ __forceinline__ void operator()(EPI_ARGS) const {
        const int kv = u.pm >> 4, bg = (u.pm >> 2) & 3, half = (u.pm >> 1) & 1, ksp = u.pm & 1;
#pragma unroll
        for (int ai = 0; ai < 2; ++ai)
#pragma unroll
            for (int m = 0; m < 4; ++m)
#pragma unroll
                for (int n = 0; n < 2; ++n) { const int i = half * 256 + ai * 128 + wr * 64 + m * 16 + fr, cc = wc * 32 + n * 16 + fq * 4;
                    *(f32x4*)(SL + ((size_t)(ksp * 2 + kv) * 2048 + bg * 512 + i) * 128 + cc) = acc[ai][0][m][n]; } } };
struct EpiOutproj { bf16_t* MIX; const unsigned char* G8;
    __device__ __forceinline__ void operator()(EPI_ARGS) const {
        const int br = u.aux;
#pragma unroll
        for (int ai = 0; ai < 2; ++ai)
#pragma unroll
          for (int mh = 0; mh < 2; ++mh) { unsigned gw[2][2][2]; u32x2 mw[2][2][2];
#pragma unroll
            for (int m2 = 0; m2 < 2; ++m2)
#pragma unroll
                for (int bj = 0; bj < 2; ++bj)
#pragma unroll
                    for (int n = 0; n < 2; ++n) { const unsigned row = (unsigned)EPI_ROW(ai, 2 * mh + m2), col = (unsigned)EPI_COL(bj, n);
                        gw[m2][bj][n] = *(const unsigned*)(G8 + (size_t)row * 3072u + (unsigned)br * 1024u + col); if (br > 0) mw[m2][bj][n] = *(const u32x2*)(MIX + row * 1024u + col); }
            __builtin_amdgcn_sched_barrier(0);
#pragma unroll
            for (int m2 = 0; m2 < 2; ++m2)
#pragma unroll
                for (int bj = 0; bj < 2; ++bj)
#pragma unroll
                    for (int n = 0; n < 2; ++n) { const unsigned g_ = gw[m2][bj][n]; f32x4 gf; gf.x = (float)(g_ & 255u); gf.y = (float)((g_ >> 8) & 255u); gf.z = (float)((g_ >> 16) & 255u); gf.w = (float)(g_ >> 24);
                        f32x4 v = acc[ai][bj][2 * mh + m2][n] * gf * (1.f / 255.f); if (br > 0) v = v + unpk4(mw[m2][bj][n]);
                        *(u32x2*)(MIX + (unsigned)EPI_ROW(ai, 2 * mh + m2) * 1024u + (unsigned)EPI_COL(bj, n)) = pk4(v); }
            __builtin_amdgcn_sched_barrier(0); } } };
struct EpiWout { const float* R; float* XA;
    __device__ __forceinline__ void operator()(EPI_ARGS) const {
#pragma unroll
        for (int ai = 0; ai < 2; ++ai)
#pragma unroll
          for (int mh = 0; mh < 2; ++mh) { f32x4 rv[2][2][2];
#pragma unroll
            for (int m2 = 0; m2 < 2; ++m2)
#pragma unroll
                for (int bj = 0; bj < 2; ++bj)
#pragma unroll
                    for (int n = 0; n < 2; ++n) rv[m2][bj][n] = *(const f32x4*)(R + (unsigned)EPI_ROW(ai, 2 * mh + m2) * 1024u + (unsigned)EPI_COL(bj, n));
            __builtin_amdgcn_sched_barrier(0);
#pragma unroll
            for (int m2 = 0; m2 < 2; ++m2)
#pragma unroll
                for (int bj = 0; bj < 2; ++bj)
#pragma unroll
                    for (int n = 0; n < 2; ++n) *(f32x4*)(XA + (unsigned)EPI_ROW(ai, 2 * mh + m2) * 1024u + (unsigned)EPI_COL(bj, n)) = rv[m2][bj][n] + acc[ai][bj][2 * mh + m2][n];
            __builtin_amdgcn_sched_barrier(0); } } };
struct EpiMoe1 { bf16_t* HID; const float* LW;
    __device__ __forceinline__ void operator()(EPI_ARGS) const {
        int aux_ = u.aux; asm volatile("" : "+s"(aux_));
        float w8[2][4];
#pragma unroll
        for (int ai = 0; ai < 2; ++ai)
#pragma unroll
            for (int m = 0; m < 4; ++m) w8[ai][m] = LW[(unsigned)(aux_ + ai * 128 + wr * 64 + m * 16 + fr)];
        __builtin_amdgcn_sched_barrier(0);
#pragma unroll
        for (int ai = 0; ai < 2; ++ai)
#pragma unroll
            for (int m = 0; m < 4; ++m) { const unsigned pos = (unsigned)(aux_ + ai * 128 + wr * 64 + m * 16 + fr); const float w = w8[ai][m];
#pragma unroll
                for (int n = 0; n < 2; ++n) { const f32x4 g = acc[ai][0][m][n], up = acc[ai][1][m][n]; f32x4 h;
                    h.x = g.x * sigmoidf_(g.x) * up.x * w; h.y = g.y * sigmoidf_(g.y) * up.y * w; h.z = g.z * sigmoidf_(g.z) * up.z * w; h.w = g.w * sigmoidf_(g.w) * up.w * w;
                    *(u32x2*)(HID + pos * 256u + (unsigned)(u.pn * 128 + wc * 32 + n * 16 + fq * 4)) = pk4(h); } } } };
struct EpiMoe2 { bf16_t* Y; const unsigned* LDST;
    __device__ __forceinline__ void operator()(EPI_ARGS) const {
        int aux_ = u.aux; asm volatile("" : "+s"(aux_));
        unsigned d8[2][4];
#pragma unroll
        for (int ai = 0; ai < 2; ++ai)
#pragma unroll
            for (int m = 0; m < 4; ++m) d8[ai][m] = LDST[(unsigned)(aux_ + ai * 128 + wr * 64 + m * 16 + fr)];
        __builtin_amdgcn_sched_barrier(0);
#pragma unroll
        for (int ai = 0; ai < 2; ++ai)
#pragma unroll
            for (int m = 0; m < 4; ++m) { const unsigned d0 = d8[ai][m];
                if (d0 != 0xFFFFFFFFu) { const unsigned off = d0 + (unsigned)(u.pn * 256 + wc * 32 + fq * 4);
#pragma unroll
                    for (int bj = 0; bj < 2; ++bj)
#pragma unroll
                        for (int n = 0; n < 2; ++n) *(u32x2*)(Y + off + bj * 128 + n * 16) = pk4(acc[ai][bj][m][n]); } } } };

struct OutprojOrder { int G, c; const char* base; long long off0, d1, d2; const char* W; unsigned lda0, lda1;
    __device__ bool next(int i, pg8::Unit& u) const { const int rnd = i / 3, br = i - 3 * rnd; const int tl = rnd * G + c; if (tl >= (M / 256) * 4) return false;
        u.pm = tl >> 2; u.pn = tl & 3; u.aux = br; const unsigned lda_ = lda0 + (unsigned)(br == 1) * (lda1 - lda0); u.lda = lda_;
        const unsigned long long pa_ = (unsigned long long)(base + off0 + (long long)(br == 1) * d1 + (long long)(br == 2) * d2 + (long long)u.pm * 256 * lda_), pb_ = (unsigned long long)(W + (size_t)br * 1024 * 1024 + (size_t)u.pn * 256 * 1024);
        u.A = (const char*)(const __attribute__((address_space(1))) char*)(((unsigned long long)(unsigned)__builtin_amdgcn_readfirstlane((int)(pa_ >> 32)) << 32) | (unsigned)__builtin_amdgcn_readfirstlane((int)pa_));
        u.B = (const char*)(const __attribute__((address_space(1))) char*)(((unsigned long long)(unsigned)__builtin_amdgcn_readfirstlane((int)(pb_ >> 32)) << 32) | (unsigned)__builtin_amdgcn_readfirstlane((int)pb_)); return true; } };
struct CmpOrder { int G, c; const char* P1; const char* W;
    __device__ bool next(int i, pg8::Unit& u) const { const int L_ = i * G + c; if (L_ >= 32) return false; const int kv = L_ >> 4, b = (L_ >> 3) & 1, g = (L_ >> 2) & 1, half = (L_ >> 1) & 1, ks = L_ & 1;
        u.pm = L_; u.pn = 0; u.aux = 0; u.lda = 0u; u.A = P1 + ((size_t)(b * T + 16 * 256 * half + 16 * ks) * P1W + C_NKV + (kv * 2 + g) * 64) * 2; u.B = W + ((size_t)kv * 256 * 2048 + (size_t)ks * 1024) * 2; return true; } };
struct MoeOrder { int G, c, nN; const LAS int* tab; const char* A; size_t a_rowbytes; const char* W; size_t w_expert, w_tile;
    __device__ bool next(int i, pg8::Unit& u) const { const int L_ = i * G + c; const int NT = __builtin_amdgcn_readfirstlane(tab[32]); if (L_ >= NT * nN) return false; const int rt = L_ / nN, pn = L_ % nN;
        int e = 0; while (__builtin_amdgcn_readfirstlane(tab[e + 1]) <= rt) ++e;
        const int off_e = __builtin_amdgcn_readfirstlane(tab[33 + e]), ts_e = __builtin_amdgcn_readfirstlane(tab[e]), cnt_e = __builtin_amdgcn_readfirstlane(tab[66 + e]);
        const int pos0 = off_e + 256 * (rt - ts_e); u.pn = pn; u.aux = pos0; u.pm = off_e + cnt_e; u.lda = 0u;
        u.A = A + (size_t)pos0 * a_rowbytes; u.B = W + (size_t)e * w_expert + (size_t)pn * w_tile; return true; } };
__device__ __forceinline__ void moe_tables(const Ctx& c, int l, LAS int* tab) {
    if (c.tid == 0) { const unsigned* cnt = WSP(unsigned, WS_CTL) + CW_MOECNT + l * 64; int ts = 0, off = 0;
        for (int e = 0; e < 32; ++e) { const int n = (int)cnt[e]; tab[e] = ts; tab[33 + e] = off; tab[66 + e] = n; const int nt_ = (n + 255) >> 8; ts += nt_; off += nt_ * 256; }
        tab[32] = ts; tab[65] = off; }
    __syncthreads();
}

constexpr int LDS_RSM = LDS_MISC + 1024;
__device__ __forceinline__ void phase_router(const Ctx& c, int l, int dummy = 0) {
    const int gw = c.bid * NWAVES + c.wave, NGW = c.G * NWAVES, lane = c.lane;
    const float* XA = WSP(float, WS_XA); bf16_t* H2 = WSP(bf16_t, WS_H2); int* REC = WSP(int, dummy ? WS_HID : WS_REC); unsigned* cnt = WSP(unsigned, WS_CTL) + CW_MOECNT + (l + 2 * dummy) * 64;
    const float* g2 = c.norm_ffn() + l * D; const float* wg = c.moe_w_grp() + (size_t)l * D * 4; const float* wr_ = c.moe_w_router() + (size_t)l * D * 32;
    const float* bgp = c.moe_b_grp() + l * 4; const float* brp = c.moe_b_router() + l * 32;
    LAS f32x4* Tk = (LAS f32x4*)(c.lds + c.wave * 16384);
    LAS float* PG = (LAS float*)(c.lds + LDS_RSM + c.wave * 1792); LAS float* EL = PG + 256; LAS float* GL = EL + 128;
    LAS unsigned* cntL = (LAS unsigned*)(c.lds + LDS_MOETAB);
    if (c.tid < 32) cntL[c.tid] = 0u;
    __syncthreads();
    for (int task = gw; task < M / 4; task += NGW) {
        const int m0 = task * 4;
        f32x4 v[4][4]; float rs[4];
#pragma unroll
        for (int r = 0; r < 4; ++r) { const f32x4* xr = (const f32x4*)(XA + (size_t)(m0 + r) * D) + lane; float s = 0.f;
#pragma unroll
            for (int j = 0; j < 4; ++j) { v[r][j] = xr[64 * j]; s += (v[r][j].x * v[r][j].x + v[r][j].y * v[r][j].y) + (v[r][j].z * v[r][j].z + v[r][j].w * v[r][j].w); }
            rs[r] = rsqrtf(wave_sum(s) * (1.f / D) + EPS); }
#pragma unroll
        for (int j = 0; j < 4; ++j) { const f32x4 gg = *((const f32x4*)g2 + lane + 64 * j);
#pragma unroll
            for (int r = 0; r < 4; ++r) { v[r][j] = v[r][j] * rs[r]; *((u32x2*)(H2 + (size_t)(m0 + r) * D) + lane + 64 * j) = pk4(v[r][j]); v[r][j] = v[r][j] * gg; }
#pragma unroll
            for (int e = 0; e < 4; ++e) { f32x4 t4; t4.x = v[0][j][e]; t4.y = v[1][j][e]; t4.z = v[2][j][e]; t4.w = v[3][j][e]; Tk[4 * lane + 256 * j + e] = t4; } }
        LDS_WAIT(); asm volatile("" ::: "memory");
        { const int og = lane & 3, s16 = lane >> 2; f32x4 acc = {0.f, 0.f, 0.f, 0.f}; const float* wp = wg + (size_t)(64 * s16) * 4 + og; const LAS f32x4* tp = Tk + 64 * s16;
#pragma unroll 1
          for (int kb = 0; kb < 64; kb += 32) { float w[32];
#pragma unroll
              for (int i = 0; i < 32; ++i) w[i] = wp[(size_t)(kb + i) * 4];
              __builtin_amdgcn_sched_barrier(0);
#pragma unroll
              for (int i = 0; i < 32; ++i) acc += tp[kb + i] * w[i]; }
          PG[(0 * 4 + og) * 16 + s16] = acc.x; PG[(1 * 4 + og) * 16 + s16] = acc.y; PG[(2 * 4 + og) * 16 + s16] = acc.z; PG[(3 * 4 + og) * 16 + s16] = acc.w; }
        { const int o4 = lane & 7, ksl = lane >> 3; f32x4 ac[4];
#pragma unroll
          for (int j = 0; j < 4; ++j) ac[j] = (f32x4){0.f, 0.f, 0.f, 0.f};
          const float* wp = wr_ + (size_t)(128 * ksl) * 32 + 4 * o4; const LAS f32x4* tp = Tk + 128 * ksl;
#pragma unroll 1
          for (int kb = 0; kb < 128; kb += 32) { f32x4 w[32];
#pragma unroll
              for (int i = 0; i < 32; ++i) w[i] = *(const f32x4*)(wp + (size_t)(kb + i) * 32);
              __builtin_amdgcn_sched_barrier(0);
#pragma unroll
              for (int i = 0; i < 32; ++i) { const f32x4 t4 = tp[kb + i]; ac[0] += t4 * w[i].x; ac[1] += t4 * w[i].y; ac[2] += t4 * w[i].z; ac[3] += t4 * w[i].w; } }
          LDS_WAIT(); asm volatile("" ::: "memory");
          LAS f32x4* Pp = (LAS f32x4*)Tk;
#pragma unroll
          for (int j = 0; j < 4; ++j) Pp[ksl * 32 + 4 * o4 + j] = ac[j];
          LDS_WAIT(); asm volatile("" ::: "memory");
          if (lane < 32) { f32x4 sm_ = Pp[lane];
#pragma unroll
              for (int q = 1; q < 8; ++q) sm_ += Pp[q * 32 + lane];
              const float bb = brp[lane]; EL[0 * 32 + lane] = sm_.x + bb; EL[1 * 32 + lane] = sm_.y + bb; EL[2 * 32 + lane] = sm_.z + bb; EL[3 * 32 + lane] = sm_.w + bb; } }
        LDS_WAIT(); asm volatile("" ::: "memory");
        if (lane < 16) { float s = 0.f;
#pragma unroll
            for (int q = 0; q < 16; ++q) s += PG[lane * 16 + q];
            GL[lane] = s + bgp[lane & 3]; }
        LDS_WAIT(); asm volatile("" ::: "memory");
        if (lane < 4) { const int r = lane;
            int gi = 0; float gm = GL[r * 4];
            for (int o = 1; o < 4; ++o) { const float x_ = GL[r * 4 + o]; if (x_ > gm) { gm = x_; gi = o; } }
            float gs = 0.f; for (int o = 0; o < 4; ++o) gs += __expf(GL[r * 4 + o] - gm);
            const float grp_top = 1.f / gs;
            int i1 = 0; float m1 = EL[r * 32 + gi * 8];
            for (int q = 1; q < 8; ++q) { const float x_ = EL[r * 32 + gi * 8 + q]; if (x_ > m1) { m1 = x_; i1 = q; } }
            int i2 = -1; float m2 = -3.0e38f;
            for (int q = 0; q < 8; ++q) { const float x_ = EL[r * 32 + gi * 8 + q]; if (q != i1 && x_ > m2) { m2 = x_; i2 = q; } }
            const float e2 = __expf(m2 - m1); const float w1 = grp_top / (1.f + e2), w2 = grp_top * e2 / (1.f + e2);
            const int ea = gi * 8 + i1, eb = gi * 8 + i2; const int ra = (int)atomicAdd((unsigned*)(cntL + ea), 1u), rb = (int)atomicAdd((unsigned*)(cntL + eb), 1u);
            int* rr = REC + (size_t)(m0 + r) * 8; rr[0] = ea; rr[1] = eb; rr[2] = ra; rr[3] = rb; rr[4] = __float_as_int(w1); rr[5] = __float_as_int(w2); rr[6] = c.bid; }
        LDS_WAIT(); asm volatile("" ::: "memory");
    }
    __syncthreads();
    if (c.tid < 32) { const unsigned n = cntL[c.tid]; (WSP(unsigned, WS_CTL) + CW_CNTB)[(dummy ? 8192 : 0) + c.bid * 32 + c.tid] = n; if (n) atomicAdd(cnt + c.tid, n); }
}
__device__ __forceinline__ TItem place_item_gu(const Ctx& c, int l, int it) {
    const int e = it >> 8, r = it & 255, ln = c.lane & 31; const int nb = r % 16; const bool up = ((nb * 32) & 255) >= 128;
    return make_titem((const float*)c.inp(up ? 29 : 28) + ((size_t)l * 32 + e) * D * 256, 256, D, WSP(bf16_t, WS_WGU) + (size_t)e * 512 * D, c.norm_ffn() + l * D, MapGU{}(32 * nb + ln), 16, r, c.lane, 1.f);
}
__device__ __forceinline__ TItem place_item_dn(const Ctx& c, int l, int it) {
    const int e = it >> 7, r = it & 127, ln = c.lane & 31;
    return make_titem(c.moe_w_down() + ((size_t)l * 32 + e) * 256 * D, D, 256, WSP(bf16_t, WS_WDT) + (size_t)e * D * 256, nullptr, 32 * (r % 32) + ln, 32, r, c.lane, 1.f);
}
__device__ __forceinline__ void phase_place(const Ctx& c, int l) {
    LAS int* tab = (LAS int*)(c.lds + LDS_MOETAB);
    moe_tables(c, l, tab);
    int* LTOK = WSP(int, WS_LTOK); float* LW = WSP(float, WS_LW); unsigned* LDST = WSP(unsigned, WS_LSLOT); const int* REC = WSP(int, WS_REC);
    LAS int* BASE = (LAS int*)c.lds;
    if (c.tid < 32) { const unsigned* cb = WSP(unsigned, WS_CTL) + CW_CNTB + c.tid; int run = 0; for (int b_ = 0; b_ < c.G; ++b_) { BASE[b_ * 32 + c.tid] = run; run += (int)cb[b_ * 32]; } }
    __syncthreads();
    for (int m = c.bid * NTHREADS + c.tid; m < M; m += c.G * NTHREADS) { const int* r = REC + (size_t)m * 8;
        const int pa = tab[33 + r[0]] + BASE[r[6] * 32 + r[0]] + r[2], pb = tab[33 + r[1]] + BASE[r[6] * 32 + r[1]] + r[3];
        LTOK[pa] = m; LDST[pa] = (unsigned)m * 1024u; LW[pa] = __int_as_float(r[4]); LTOK[pb] = m; LDST[pb] = ((unsigned)M + (unsigned)m) * 1024u; LW[pb] = __int_as_float(r[5]); }
    for (int e = c.bid; e < 32; e += c.G) { const int lo = tab[33 + e] + tab[66 + e], hi2 = tab[33 + e + 1];
        for (int p = lo + c.tid; p < hi2; p += NTHREADS) { LTOK[p] = 0; LDST[p] = 0xFFFFFFFFu; LW[p] = 0.f; } }
    __syncthreads();
    LAS float* scr = (LAS float*)(c.lds + c.wave * 16384);
    const int gw = c.bid * NWAVES + c.wave, NGW = c.G * NWAVES;
#define PLACE_MAKE(i_) place_item_gu(c, l, (i_))
    T_PIPELINE(32 * 256, PLACE_MAKE);
#undef PLACE_MAKE
}

#ifndef ATT_FAST_FOX
#define ATT_FAST_FOX 1
#endif
#ifndef ATT_FAST_MLA
#define ATT_FAST_MLA 1
#endif
#ifndef ATT_FAST_NSA
#define ATT_FAST_NSA 1
#endif
namespace fa {
constexpr int KPITCH = 208, VPITCH = 192;
constexpr int KBUF = 64 * KPITCH, VBUF = 64 * VPITCH;
constexpr int L_K = 0, L_V = 2 * KBUF, L_VD = 4 * KBUF, L_LUT = 131072 + 1024, L_CUM = L_LUT + 8 * 132 * 4, L_PS = 57344, L_F = L_PS + 64 * 132 * 4, L_SEL = L_F + 64 * 132 * 4, L_UNI = L_SEL + 1024, L_TL = L_UNI + 16, L_TLN = L_TL + 128, L_UNIT = L_TLN + 16;
static_assert(L_V + 2 * VBUF <= L_PS && L_VD + 4 * VBUF <= L_SEL && L_UNIT + 64 <= 131072 && L_CUM + 512 <= LDS_BYTES, "attention LDS map: NSA uses K/V slots 0,1 (V at L_V) + the importance tables; dense units use 4 K slots and 4 V slots at L_VD (over the tables, dead then)");
typedef short v4i16_t __attribute__((ext_vector_type(4)));
__device__ __forceinline__ float swap32_max(float v) { auto rr = __builtin_amdgcn_permlane32_swap(__float_as_uint(v), __float_as_uint(v), false, false); return fmaxf(__uint_as_float(rr[0]), __uint_as_float(rr[1])); }
__device__ __forceinline__ float swap32_sum(float v) { auto rr = __builtin_amdgcn_permlane32_swap(__float_as_uint(v), __float_as_uint(v), false, false); return __uint_as_float(rr[0]) + __uint_as_float(rr[1]); }
__device__ __forceinline__ float ex2(float x) { return __builtin_amdgcn_exp2f(x); }

struct KVSrc { const bf16_t* K; int kpitch; const bf16_t* K2; int k2pitch; const bf16_t* V; int vpitch; const float* cum; float cref; };
struct TileRegs { u32x4 k, k2, v; float cm; };
template <bool HAS_K2, bool HAS_CUM>
__device__ __forceinline__ void tile_load(TileRegs& R, const KVSrc& s, int kv0, int tid) {
    const int row = tid >> 3, ch = tid & 7;
    R.k = *(const u32x4*)(s.K + (size_t)(kv0 + row) * s.kpitch + ch * 8);
    R.v = *(const u32x4*)(s.V + (size_t)(kv0 + row) * s.vpitch + ch * 8);
    if constexpr (HAS_K2) { if (tid < 256) R.k2 = *(const u32x4*)(s.K2 + (size_t)(kv0 + (tid >> 2)) * s.k2pitch + (tid & 3) * 8); }
    if constexpr (HAS_CUM) { if (tid < 64) R.cm = s.cum[kv0 + tid]; }
}
template <bool HAS_K2, bool HAS_CUM>
__device__ __forceinline__ void tile_store(const TileRegs& R, LAS unsigned char* lds, int buf, int tid, float cref = 0.f, float cadd = 0.f, int vbase = L_V) {
    const int row = tid >> 3, ch = tid & 7;
    *(LAS u32x4*)(lds + L_K + buf * KBUF + row * KPITCH + ch * 16) = R.k;
    if constexpr (HAS_K2) { if (tid < 256) *(LAS u32x4*)(lds + L_K + buf * KBUF + (tid >> 2) * KPITCH + 128 + (tid & 3) * 16) = R.k2; }
    *(LAS u32x4*)(lds + vbase + buf * VBUF + row * VPITCH + ch * 16) = R.v;
    if constexpr (HAS_CUM) { if (tid < 64) { const float x = cref - (R.cm + cadd); const unsigned hi_ = f2bf(x); const float xl = x - __uint_as_float(hi_ << 16); const unsigned lo_ = f2bf(xl);
            unsigned zz = 0u; asm volatile("" : "+v"(zz)); u32x4 w0; w0.x = hi_ | (lo_ << 16); w0.y = zz; w0.z = zz; w0.w = zz; u32x4 z0; z0.x = zz; z0.y = zz; z0.z = zz; z0.w = zz;
            *(LAS u32x4*)(lds + L_K + buf * KBUF + tid * KPITCH + 128) = w0; *(LAS u32x4*)(lds + L_K + buf * KBUF + tid * KPITCH + 144) = z0; } }
}
template <int NKS>
__device__ __forceinline__ void qk_tile(f32x16 (&st)[2], const LAS unsigned char* lds, int buf, const bf16x8 (&qf)[NKS], int r, int hh, float cval) {
    const LAS unsigned char* kp = lds + L_K + buf * KBUF + r * KPITCH + hh * 16;
    bf16x8 kf[2][NKS];
#pragma unroll
    for (int ks = 0; ks < NKS; ++ks)
#pragma unroll
        for (int rb = 0; rb < 2; ++rb) kf[rb][ks] = *(const LAS bf16x8*)(kp + rb * 32 * KPITCH + ks * 32);
    f32x16 cin;
#pragma unroll
    for (int i = 0; i < 16; ++i) cin[i] = cval;
    __builtin_amdgcn_sched_barrier(0);
    f32x16 a0 = __builtin_amdgcn_mfma_f32_32x32x16_bf16(kf[0][0], qf[0], cin, 0, 0, 0), a1 = __builtin_amdgcn_mfma_f32_32x32x16_bf16(kf[1][0], qf[0], cin, 0, 0, 0);
#pragma unroll
    for (int ks = 1; ks < NKS; ++ks) { a0 = __builtin_amdgcn_mfma_f32_32x32x16_bf16(kf[0][ks], qf[ks], a0, 0, 0, 0); a1 = __builtin_amdgcn_mfma_f32_32x32x16_bf16(kf[1][ks], qf[ks], a1, 0, 0, 0); }
    st[0] = a0; st[1] = a1;
}
__device__ __forceinline__ void pv_tile(f32x16 (&ot)[2], const LAS unsigned char* lds, int buf, const f32x16 (&p)[2], int lane) {
    const int i16 = lane & 15, blk = (lane >> 4) & 1, hh = lane >> 5;
    const LAS unsigned char* vb = lds + L_V + buf * VBUF + (4 * hh + (i16 >> 2)) * VPITCH + 32 * blk + 8 * (i16 & 3);
    v4i16_t lo[4][2], hi[4][2]; bf16x8 pf[4];
#pragma unroll
    for (int q = 0; q < 4; ++q)
#pragma unroll
        for (int db = 0; db < 2; ++db) { const LAS unsigned char* vp = vb + (16 * q) * VPITCH + 64 * db;
            lo[q][db] = __builtin_amdgcn_ds_read_tr16_b64_v4i16((LAS v4i16_t*)vp); hi[q][db] = __builtin_amdgcn_ds_read_tr16_b64_v4i16((LAS v4i16_t*)(vp + 8 * VPITCH)); }
#pragma unroll
    for (int q = 0; q < 4; ++q) { const int rb = q >> 1, s_ = q & 1;
        u32x4 pw; pw.x = cvtpk(p[rb][8 * s_ + 0], p[rb][8 * s_ + 1]); pw.y = cvtpk(p[rb][8 * s_ + 2], p[rb][8 * s_ + 3]); pw.z = cvtpk(p[rb][8 * s_ + 4], p[rb][8 * s_ + 5]); pw.w = cvtpk(p[rb][8 * s_ + 6], p[rb][8 * s_ + 7]);
        pf[q] = __builtin_bit_cast(bf16x8, pw); }
    __builtin_amdgcn_sched_barrier(0);
#pragma unroll
    for (int q = 0; q < 4; ++q)
#pragma unroll
        for (int db = 0; db < 2; ++db) { const bf16x8 vf = {lo[q][db][0], lo[q][db][1], lo[q][db][2], lo[q][db][3], hi[q][db][0], hi[q][db][1], hi[q][db][2], hi[q][db][3]};
            ot[db] = __builtin_amdgcn_mfma_f32_32x32x16_bf16(vf, pf[q], ot[db], 0, 0, 0); }
}
struct VFrags { v4i16_t lo[4][2], hi[4][2]; };
__device__ __forceinline__ void v_read(VFrags& F, const LAS unsigned char* lds, int buf, int lane, int vbase = L_V) {
    const int i16 = lane & 15, blk = (lane >> 4) & 1, hh = lane >> 5;
    const LAS unsigned char* vb = lds + vbase + buf * VBUF + (4 * hh + (i16 >> 2)) * VPITCH + 32 * blk + 8 * (i16 & 3);
#pragma unroll
    for (int q = 0; q < 4; ++q)
#pragma unroll
        for (int db = 0; db < 2; ++db) { const LAS unsigned char* vp = vb + (16 * q) * VPITCH + 64 * db;
            F.lo[q][db] = __builtin_amdgcn_ds_read_tr16_b64_v4i16((LAS v4i16_t*)vp); F.hi[q][db] = __builtin_amdgcn_ds_read_tr16_b64_v4i16((LAS v4i16_t*)(vp + 8 * VPITCH)); }
}
__device__ __forceinline__ void pv_mma(f32x16 (&ot)[2], const VFrags& F, const f32x16 (&p)[2]) {
    bf16x8 pf[4];
#pragma unroll
    for (int q = 0; q < 4; ++q) { const int rb = q >> 1, s_ = q & 1;
        u32x4 pw; pw.x = cvtpk(p[rb][8 * s_ + 0], p[rb][8 * s_ + 1]); pw.y = cvtpk(p[rb][8 * s_ + 2], p[rb][8 * s_ + 3]); pw.z = cvtpk(p[rb][8 * s_ + 4], p[rb][8 * s_ + 5]); pw.w = cvtpk(p[rb][8 * s_ + 6], p[rb][8 * s_ + 7]);
        pf[q] = __builtin_bit_cast(bf16x8, pw); }
    __builtin_amdgcn_sched_barrier(0);
#pragma unroll
    for (int q = 0; q < 4; ++q)
#pragma unroll
        for (int db = 0; db < 2; ++db) { const bf16x8 vf = {F.lo[q][db][0], F.lo[q][db][1], F.lo[q][db][2], F.lo[q][db][3], F.hi[q][db][0], F.hi[q][db][1], F.hi[q][db][2], F.hi[q][db][3]};
            ot[db] = __builtin_amdgcn_mfma_f32_32x32x16_bf16(vf, pf[q], ot[db], 0, 0, 0); }
}
struct SmState { float m, l; };
constexpr float RESC_THR = 8.f;
__device__ __forceinline__ float sm_cval(const SmState& S) { return (S.m == -INFINITY) ? 0.f : -S.m; }
__device__ __forceinline__ float row_max32(const f32x16 (&st)[2]) {
    float mx = fmaxf(st[0][0], st[1][0]);
#pragma unroll
    for (int i = 1; i < 16; ++i) mx = fmaxf(fmaxf(mx, st[0][i]), st[1][i]);
    return swap32_max(mx);
}
typedef float f32x2v __attribute__((ext_vector_type(2)));
template <bool WITH_O>
__device__ __forceinline__ void sm_shift(f32x16 (&st)[2], SmState& S, f32x16 (&ot)[2], float mx) {
    const bool fresh = (S.m == -INFINITY);
    const bool up = fresh ? (mx > -INFINITY) : (mx > RESC_THR);
    if (__any(up)) {
        const float d = up ? mx : 0.f; const float alpha = fresh ? 1.f : ex2(-d);
        S.l *= alpha; S.m = up ? ((fresh ? 0.f : S.m) + d) : S.m;
#pragma unroll
        for (int rb = 0; rb < 2; ++rb)
#pragma unroll
            for (int i = 0; i < 16; ++i) st[rb][i] -= d;
        if constexpr (WITH_O) {
#pragma unroll
            for (int db = 0; db < 2; ++db)
#pragma unroll
                for (int i = 0; i < 16; ++i) ot[db][i] *= alpha; }
    }
}
__device__ __forceinline__ void sm_update(f32x16 (&st)[2], SmState& S, f32x16 (&ot)[2]) {
    sm_shift<true>(st, S, ot, row_max32(st));
    float sum = 0.f;
#pragma unroll
    for (int rb = 0; rb < 2; ++rb)
#pragma unroll
        for (int i = 0; i < 16; ++i) { const float p = ex2(st[rb][i]); st[rb][i] = p; sum += p; }
    S.l += sum;
}
__device__ __forceinline__ void sm_stats(f32x16 (&st)[2], SmState& S) {
    f32x16 dummy[2];
    sm_shift<false>(st, S, dummy, row_max32(st));
    float sum = 0.f;
#pragma unroll
    for (int rb = 0; rb < 2; ++rb)
#pragma unroll
        for (int i = 0; i < 16; ++i) sum += ex2(st[rb][i]);
    S.l += sum;
}
__device__ __forceinline__ void zero_acc(f32x16 (&a)[2]) {
#pragma unroll
    for (int db = 0; db < 2; ++db)
#pragma unroll
        for (int i = 0; i < 16; ++i) a[db][i] = 0.f;
}
__device__ __forceinline__ void store_ot(const f32x16 (&o)[2], float sc, bf16_t* orow, int hh) {
#pragma unroll
    for (int db = 0; db < 2; ++db)
#pragma unroll
        for (int a = 0; a < 4; ++a) { u32x2 w; w.x = cvtpk(o[db][4 * a + 0] * sc, o[db][4 * a + 1] * sc); w.y = cvtpk(o[db][4 * a + 2] * sc, o[db][4 * a + 3] * sc);
            *(u32x2*)(orow + 32 * db + 8 * a + 4 * hh) = w; }
}
#define FA_FOREACH_REG(CODE) _Pragma("unroll") for (int rb = 0; rb < 2; ++rb) _Pragma("unroll") for (int a = 0; a < 4; ++a) _Pragma("unroll") for (int e = 0; e < 4; ++e) { const int i = 4 * a + e; const int kc = 32 * rb + 8 * a + e; (void)kc; CODE }
#define FA_LAUNDER(x) asm volatile("" : "+v"(x))

template <bool IS_MLA>
__device__ __forceinline__ void dense_unit(const Ctx& c, int lyr, int b, int h, int qb) {
    constexpr int NKS = IS_MLA ? 6 : 5;
    const int tid = c.tid, lane = c.lane, r = lane & 31, hh = lane >> 5, w = c.wave;
    LAS unsigned char* lds = c.lds;
    const int q0 = qb * 256, qrow = q0 + 32 * w + r; const size_t mrow = (size_t)b * T + qrow;
    KVSrc src; bf16x8 qf[NKS]; bf16_t* orow;
    if constexpr (IS_MLA) {
        const bf16_t* QB = WSP(bf16_t, WS_QB); const bf16_t* KVB = WSP(bf16_t, WS_KVB);
        src.K = KVB + (size_t)b * T * 1024 + h * 64; src.kpitch = 1024; src.K2 = WSP(bf16_t, WS_KR) + (size_t)b * T * 32; src.k2pitch = 32; src.V = KVB + (size_t)b * T * 1024 + 512 + h * 64; src.vpitch = 1024; src.cum = nullptr; src.cref = 0.f;
#pragma unroll
        for (int ks = 0; ks < 4; ++ks) qf[ks] = *(const bf16x8*)(QB + mrow * 768 + h * 64 + 16 * ks + 8 * hh);
#pragma unroll
        for (int ks = 0; ks < 2; ++ks) qf[4 + ks] = *(const bf16x8*)(QB + mrow * 768 + 512 + h * 32 + 16 * ks + 8 * hh);
        orow = WSP(bf16_t, WS_QB) + mrow * 768 + h * 64;
    } else {
        const bf16_t* P1 = WSP(bf16_t, WS_P1);
        src.K = P1 + (size_t)b * T * P1W + C_FQKV + 512 + h * 64; src.kpitch = P1W; src.K2 = nullptr; src.k2pitch = 0; src.V = P1 + (size_t)b * T * P1W + C_FQKV + 1024 + h * 64; src.vpitch = P1W;
        src.cum = WSP(float, WS_LC) + ((size_t)b * 8 + h) * T;
        { LAS float* cps_ = (LAS float*)(lds + L_CUM); if (tid < 128) cps_[tid] = (WSP(float, WS_CP) + ((size_t)b * 8 + h) * 129)[1 + tid]; }
        src.cref = 0.f;
#pragma unroll
        for (int ks = 0; ks < 4; ++ks) qf[ks] = *(const bf16x8*)(P1 + mrow * P1W + C_FQKV + h * 64 + 16 * ks + 8 * hh);
        { unsigned one2 = hh ? 0u : 0x3F803F80u; asm volatile("" : "+v"(one2)); u32x4 aq; aq.x = one2; aq.y = 0u; aq.z = 0u; aq.w = 0u; qf[4] = __builtin_bit_cast(bf16x8, aq); }
        orow = WSP(bf16_t, WS_P1) + mrow * P1W + C_FQKV + h * 64;
    }
    f32x16 st[2], ot[2]; zero_acc(ot); SmState S{-INFINITY, 0.f};
    const int wlast = (q0 + 32 * w + 31) >> 6;
    constexpr float FOX_SKIP = 40.f;
    float qbound = 0.f, mmin_blk = -INFINITY; LAS float* MM = (LAS float*)(lds + L_UNIT + 16);
    if constexpr (!IS_MLA) {
        float ss = 0.f;
#pragma unroll
        for (int ks = 0; ks < 4; ++ks)
#pragma unroll
            for (int j = 0; j < 8; ++j) { const float x_ = bf2f((bf16_t)qf[ks][j]); ss += x_ * x_; }
        ss = swap32_sum(ss);
        const float km2 = __uint_as_float((WSP(unsigned, WS_CTL) + CW_KMAX)[lyr * 16 + b * 8 + h]);
        qbound = sqrtf(ss * km2) * 1.001f + 0.01f;
    }
    const LAS float* cps = (const LAS float*)(lds + L_CUM);
#define FOX_CP(t_) ((t_) == 0 ? 0.f : cps[(t_) - 1])
    const int nT = 2 * qb + 2;
    TileRegs Ra, Rb;
    tile_load<IS_MLA, !IS_MLA>(Ra, src, 128 * (nT - 1) + 64, tid); tile_load<IS_MLA, !IS_MLA>(Rb, src, 128 * (nT - 1), tid);
    if constexpr (!IS_MLA) { __syncthreads(); src.cref = src.cum[q0] + FOX_CP(4 * qb); }
    tile_store<IS_MLA, !IS_MLA>(Ra, lds, 0, tid, src.cref, IS_MLA ? 0.f : FOX_CP(2 * nT - 1), L_VD); tile_store<IS_MLA, !IS_MLA>(Rb, lds, 1, tid, src.cref, IS_MLA ? 0.f : FOX_CP(2 * nT - 2), L_VD);
    if (nT > 1) { tile_load<IS_MLA, !IS_MLA>(Ra, src, 128 * (nT - 2) + 64, tid); tile_load<IS_MLA, !IS_MLA>(Rb, src, 128 * (nT - 2), tid); }
    __syncthreads();
    for (int it = 0; it < nT; ++it) { const int Tt = nT - 1 - it, sb = 2 * (it & 1);
        if constexpr (!IS_MLA) { if (it >= 2 && (src.cref - cps[2 * Tt + 1]) < mmin_blk - FOX_SKIP) break; }
#pragma unroll
        for (int sub = 1; sub >= 0; --sub) { const int t = 2 * Tt + sub, buf = sb + (1 - sub), kv0 = 64 * t;
            if (t <= wlast) {
                qk_tile<NKS>(st, lds, buf, qf, r, hh, sm_cval(S));
                if (kv0 + 63 > q0 + 32 * w) { int lim = qrow - kv0 - 4 * hh; FA_LAUNDER(lim); FA_FOREACH_REG({ if (kc > lim) st[rb][i] = -INFINITY; }) }
                VFrags VF; v_read(VF, lds, buf, lane, L_VD);
                __builtin_amdgcn_sched_barrier(0);
                sm_update(st, S, ot);
                pv_mma(ot, VF, st);
            } }
        if constexpr (!IS_MLA) { if (it == 1) { const float v_ = -wave_max(-(S.m - qbound)); if (lane == 0) MM[w] = v_; } }
        if (it + 1 < nT) { tile_store<IS_MLA, !IS_MLA>(Ra, lds, sb ^ 2, tid, src.cref, IS_MLA ? 0.f : FOX_CP(2 * Tt - 1), L_VD); tile_store<IS_MLA, !IS_MLA>(Rb, lds, (sb ^ 2) + 1, tid, src.cref, IS_MLA ? 0.f : FOX_CP(2 * Tt - 2), L_VD);
            if (it + 2 < nT) { tile_load<IS_MLA, !IS_MLA>(Ra, src, 128 * (Tt - 2) + 64, tid); tile_load<IS_MLA, !IS_MLA>(Rb, src, 128 * (Tt - 2), tid); } }
        __syncthreads();
        if constexpr (!IS_MLA) { if (it == 1) { float mm_ = MM[0];
#pragma unroll
            for (int q_ = 1; q_ < 8; ++q_) mm_ = fminf(mm_, MM[q_]);
            mmin_blk = mm_; } }
    }
    const float lt = swap32_sum(S.l);
    store_ot(ot, 1.f / lt, orow, hh);
}

#define FA_STREAM(SRC, NT, TILE_EXPR, BODY) do { TileRegs R_; const int nt_ = (NT); \
    if (nt_ > 0) { { const int idx = 0; tile_load<false, false>(R_, SRC, 64 * (TILE_EXPR), tid); } tile_store<false, false>(R_, lds, 0, tid); \
      if (nt_ > 1) { const int idx = 1; tile_load<false, false>(R_, SRC, 64 * (TILE_EXPR), tid); } \
      __syncthreads(); \
      for (int it_ = 0; it_ < nt_; ++it_) { const int buf = it_ & 1; int tile; { const int idx = it_; tile = (TILE_EXPR); } \
          BODY \
          if (it_ + 1 < nt_) { tile_store<false, false>(R_, lds, buf ^ 1, tid); if (it_ + 2 < nt_) { const int idx = it_ + 2; tile_load<false, false>(R_, SRC, 64 * (TILE_EXPR), tid); } } \
          __syncthreads(); } } } while (0)

__device__ __forceinline__ void nsa_unit(const Ctx& c, int b, int g, int j) {
    const int tid = c.tid, lane = c.lane, r = lane & 31, hh = lane >> 5, w = c.wave;
    LAS unsigned char* lds = c.lds;
    const int t0 = 64 * j, tl = r >> 2, hp = r & 3, tokl = 8 * w + tl, tq = t0 + tokl, head = 4 * g + hp; const size_t mrow = (size_t)b * T + tq;
    const bf16_t* P1 = WSP(bf16_t, WS_P1);
    bf16x8 qf[4];
#pragma unroll
    for (int ks = 0; ks < 4; ++ks) qf[ks] = *(const bf16x8*)(P1 + mrow * P1W + C_NQ + head * 64 + 16 * ks + 8 * hh);
    const float gc = sigmoidf_(bf2f(P1[mrow * P1W + C_NG + head * 3 + 0])), gsl = sigmoidf_(bf2f(P1[mrow * P1W + C_NG + head * 3 + 1])), gwn = sigmoidf_(bf2f(P1[mrow * P1W + C_NG + head * 3 + 2]));
    const LAS float* lutL = (const LAS float*)(lds + L_LUT) + head * 132;
    LAS float* PS = (LAS float*)(lds + L_PS); LAS float* FM = (LAS float*)(lds + L_F); LAS unsigned* SEL = (LAS unsigned*)(lds + L_SEL); LAS unsigned* UNI = (LAS unsigned*)(lds + L_UNI);
    LAS unsigned char* TL = (LAS unsigned char*)(lds + L_TL); LAS int* TLN = (LAS int*)(lds + L_TLN);
    f32x16 st[2], ot[2], otot[2]; zero_acc(otot);
    for (int i = tid; i < 2 * 64 * 132; i += NTHREADS) PS[i] = 0.f;
    if (tid < 256) SEL[tid] = 0u; if (tid < 4) UNI[tid] = 0u;
    const float bfar = lutL[128];
    const int tmin = t0 + 8 * w;
    const int n_ok_max = ((t0 + 63 - 31) >> 4) + 1; const int nct = (n_ok_max + 63) >> 6;
    KVSrc srcc; srcc.K = WSP(bf16_t, WS_KC) + (size_t)(b * 2 + g) * 512 * 64; srcc.kpitch = 64; srcc.K2 = nullptr; srcc.k2pitch = 0; srcc.V = WSP(bf16_t, WS_VC) + (size_t)(b * 2 + g) * 512 * 64; srcc.vpitch = 64; srcc.cum = nullptr; srcc.cref = 0.f;
    SmState Sc{-INFINITY, 0.f};
    FA_STREAM(srcc, nct, idx, {
        const bool farc = (16 * (64 * tile + 63) + 31 + 128 <= tmin);
        qk_tile<4>(st, lds, buf, qf, r, hh, sm_cval(Sc) + (farc ? bfar : 0.f));
        if (!farc) { int db_ = tq - 31 - 1024 * tile - 64 * hh; FA_LAUNDER(db_); FA_FOREACH_REG({ const int dist = db_ - 16 * kc; const float s_ = st[rb][i] + lutL[dist < 0 ? 0 : (dist > 128 ? 128 : dist)]; st[rb][i] = dist < 0 ? -INFINITY : s_; }) }
        sm_stats(st, Sc); });
    { const float lt = swap32_sum(Sc.l); const float inv = lt > 0.f ? 1.f / lt : 0.f; const float msafe = (Sc.m == -INFINITY) ? 0.f : Sc.m;
      zero_acc(ot);
      FA_STREAM(srcc, nct, idx, {
        const bool farc = (16 * (64 * tile + 63) + 31 + 128 <= tmin);
        qk_tile<4>(st, lds, buf, qf, r, hh, (farc ? bfar : 0.f) - msafe);
        if (farc) { FA_FOREACH_REG({ st[rb][i] = ex2(st[rb][i]) * inv; }) }
        else { int db_ = tq - 31 - 1024 * tile - 64 * hh; FA_LAUNDER(db_); FA_FOREACH_REG({ const int dist = db_ - 16 * kc; const float s_ = st[rb][i] + lutL[dist < 0 ? 0 : (dist > 128 ? 128 : dist)]; st[rb][i] = dist < 0 ? 0.f : ex2(s_) * inv; }) }
_Pragma("unroll")
        for (int rb = 0; rb < 2; ++rb)
_Pragma("unroll")
            for (int a = 0; a < 4; ++a) { float q4[4];
_Pragma("unroll")
                for (int e = 0; e < 4; ++e) { float v = st[rb][4 * a + e]; v += dpp_f<0xB1>(v); v += dpp_f<0x4E>(v); q4[e] = v; }
                if (hp == 0) { const int G = 16 * tile + 8 * rb + 2 * a + hh; PS[tokl * 132 + G] = q4[0] + 2.f * (q4[1] + q4[2] + q4[3]); FM[tokl * 132 + G] = q4[0]; } }
        pv_tile(ot, lds, buf, st, lane); });
#pragma unroll
      for (int db = 0; db < 2; ++db)
#pragma unroll
          for (int i = 0; i < 16; ++i) otot[db][i] += gc * ot[db][i]; }
    if (j + 1 <= 16) { if (tid < 64) SEL[tid * 4] = (1u << (j + 1)) - 1u; if (tid == 0) UNI[0] = (1u << (j + 1)) - 1u; }
    else {
        for (int i = tid; i < 64 * 128; i += NTHREADS) { const int tk = i >> 7, G = i & 127; if (G >= 1 && G <= j - 2) PS[tk * 132 + G] += FM[tk * 132 + G + 1]; }
        __syncthreads();
        const int tk = tid >> 3, sub = tid & 7; unsigned bits[4] = {0u, 0u, 0u, 0u};
#pragma unroll 1
        for (int k = 0; k < 16; ++k) { const int G = sub + 8 * k;
            if (G >= 1 && G <= j - 2) { const float v = PS[tk * 132 + G]; int cnt = 0;
                for (int G2 = 1; G2 <= j - 2; ++G2) { const float v2 = PS[tk * 132 + G2]; cnt += (v2 > v || (v2 == v && G2 < G)) ? 1 : 0; }
                if (cnt < 13) { if (k < 4) bits[0] |= 1u << G; else if (k < 8) bits[1] |= 1u << (G - 32); else if (k < 12) bits[2] |= 1u << (G - 64); else bits[3] |= 1u << (G - 96); } } }
        if (sub == 0) { bits[0] |= 1u; { const int G = j; if (G < 32) bits[0] |= 1u << G; else if (G < 64) bits[1] |= 1u << (G - 32); else if (G < 96) bits[2] |= 1u << (G - 64); else bits[3] |= 1u << (G - 96); }
                        { const int G = j - 1; if (G < 32) bits[0] |= 1u << G; else if (G < 64) bits[1] |= 1u << (G - 32); else if (G < 96) bits[2] |= 1u << (G - 64); else bits[3] |= 1u << (G - 96); } }
#pragma unroll
        for (int q = 0; q < 4; ++q) if (bits[q]) { atomicOr((unsigned*)(SEL + tk * 4 + q), bits[q]); atomicOr((unsigned*)(UNI + q), bits[q]); }
    }
    __syncthreads();
    if (tid == 0) { int n = 0; for (int q = 0; q < 4; ++q) { unsigned m_ = UNI[q]; while (m_) { const int bpos = __builtin_ctz(m_); m_ &= m_ - 1u; TL[n++] = (unsigned char)(32 * q + bpos); } } TLN[0] = n; }
    __syncthreads();
    const unsigned msk0 = SEL[tokl * 4 + 0], msk1 = SEL[tokl * 4 + 1], msk2 = SEL[tokl * 4 + 2], msk3 = SEL[tokl * 4 + 3];
    const int nsel = __builtin_amdgcn_readfirstlane(TLN[0]);
    { KVSrc srcs; srcs.K = P1 + (size_t)b * T * P1W + C_NKV + ((1 * 2 + 0) * 2 + g) * 64; srcs.kpitch = P1W; srcs.K2 = nullptr; srcs.k2pitch = 0; srcs.V = P1 + (size_t)b * T * P1W + C_NKV + ((1 * 2 + 1) * 2 + g) * 64; srcs.vpitch = P1W; srcs.cum = nullptr; srcs.cref = 0.f;
      SmState Ss{-INFINITY, 0.f}; zero_acc(ot);
      FA_STREAM(srcs, nsel, (int)TL[idx], {
        const int wq = tile >> 5; const unsigned mw = wq == 0 ? msk0 : wq == 1 ? msk1 : wq == 2 ? msk2 : msk3; const bool mine = (mw >> (tile & 31)) & 1u;
        if (__any(mine)) {
            const bool fars = (64 * tile + 63 + 128 <= tmin);
            qk_tile<4>(st, lds, buf, qf, r, hh, mine ? sm_cval(Ss) + (fars ? bfar : 0.f) : -INFINITY);
            if (!fars) { int db_ = tq - 64 * tile - 4 * hh; FA_LAUNDER(db_); FA_FOREACH_REG({ const int dist = db_ - kc; const float s_ = st[rb][i] + lutL[dist < 0 ? 0 : (dist > 128 ? 128 : dist)]; st[rb][i] = (dist >= 0) ? s_ : -INFINITY; }) }
            VFrags VF; v_read(VF, lds, buf, lane); __builtin_amdgcn_sched_barrier(0);
            sm_update(st, Ss, ot);
            pv_mma(ot, VF, st); } });
      const float lt = swap32_sum(Ss.l); const float sc = lt > 0.f ? gsl / lt : 0.f;
#pragma unroll
      for (int db = 0; db < 2; ++db)
#pragma unroll
          for (int i = 0; i < 16; ++i) otot[db][i] += sc * ot[db][i]; }
    { KVSrc srcw; srcw.K = P1 + (size_t)b * T * P1W + C_NKV + ((2 * 2 + 0) * 2 + g) * 64; srcw.kpitch = P1W; srcw.K2 = nullptr; srcw.k2pitch = 0; srcw.V = P1 + (size_t)b * T * P1W + C_NKV + ((2 * 2 + 1) * 2 + g) * 64; srcw.vpitch = P1W; srcw.cum = nullptr; srcw.cref = 0.f;
      const int jlo = j - 8 > 0 ? j - 8 : 0;
      SmState Sw{-INFINITY, 0.f}; zero_acc(ot);
      FA_STREAM(srcw, j - jlo + 1, jlo + idx, {
        qk_tile<4>(st, lds, buf, qf, r, hh, sm_cval(Sw));
        { int db_ = tq - 64 * tile - 4 * hh; FA_LAUNDER(db_); FA_FOREACH_REG({ const int dist = db_ - kc; const float s_ = st[rb][i] + lutL[dist < 0 ? 0 : (dist > 128 ? 128 : dist)]; st[rb][i] = (dist >= 0 && dist < 512) ? s_ : -INFINITY; }) }
        VFrags VF; v_read(VF, lds, buf, lane); __builtin_amdgcn_sched_barrier(0);
        sm_update(st, Sw, ot);
        pv_mma(ot, VF, st); });
      const float lt = swap32_sum(Sw.l); const float sc = lt > 0.f ? gwn / lt : 0.f;
#pragma unroll
      for (int db = 0; db < 2; ++db)
#pragma unroll
          for (int i = 0; i < 16; ++i) otot[db][i] += sc * ot[db][i]; }
    store_ot(otot, 1.f, WSP(bf16_t, WS_P1) + mrow * P1W + C_NQ + head * 64, hh);
}
}

__device__ __forceinline__ int next_unit(const Ctx& c, unsigned* ctr) {
    LAS int* u = (LAS int*)(c.lds + fa::L_UNIT);
    __syncthreads();
    if (c.tid == 0) u[0] = (int)__hip_atomic_fetch_add(ctr, 1u, __ATOMIC_RELAXED, __HIP_MEMORY_SCOPE_AGENT);
    __syncthreads();
    return __builtin_amdgcn_readfirstlane(u[0]);
}
__device__ __forceinline__ void phase_att_fast(const Ctx& c0, int l) {
    Ctx c = c0;
    unsigned* ctr0 = WSP(unsigned, WS_CTL) + CW_QUEUE + 64 * 8 * l;
    { const float* lut = WSP(float, WS_TAB) + 512; LAS float* L_ = (LAS float*)(c.lds + fa::L_LUT); for (int i = c.tid; i < 8 * 132; i += NTHREADS) L_[i] = lut[i]; }
    const int myx = (int)(xb_xcc_id() & 7u);
    for (int qi = 0; qi < 8; ++qi) {
        const int x = (myx + qi) & 7;
        for (;;) {
            const int u = next_unit(c, ctr0 + 64 * x);
            if (u >= 192) break;
            relaunder(c);
            const int sidx = u >> 5, k = u & 31;
            if (sidx == 0 || sidx == 3) { const int p = 2 * x + (sidx == 3); if (ATT_FAST_MLA) fa::dense_unit<true>(c, l & 1, p >> 3, p & 7, 31 - k); }
            else if (sidx == 1 || sidx == 4) { const int p = 2 * x + (sidx == 4); if (ATT_FAST_FOX) fa::dense_unit<false>(c, l & 1, p >> 3, p & 7, 31 - k); }
            else { const int n = (sidx == 5 ? 32 : 0) + k, grp = x >> 1; if (ATT_FAST_NSA) fa::nsa_unit(c, grp >> 1, grp & 1, 127 - 2 * n - (x & 1)); }
        }
    }
}

struct Args { const void* in[32]; float* out; unsigned char* ws; int l_lo, l_hi; };
constexpr int PH_PER_LAYER = 15, K_FINAL = 1 + PH_PER_LAYER;
template <int KIND>
__global__ void __launch_bounds__(NTHREADS, 2) fwd_kernel(Args a) {
    extern __shared__ __attribute__((aligned(16))) unsigned char lds_raw[];
    Ctx c;
    c.out = a.out; c.ws = a.ws; c.ws0 = a.ws; c.lds = (LAS unsigned char*)lds_raw;
    c.tid = threadIdx.x; c.lane = c.tid & 63; c.wave = __builtin_amdgcn_readfirstlane(c.tid >> 6); c.G = gridDim.x; c.bid = blockIdx.x;
    if (c.tid < 4) ((LAS unsigned*)(c.lds + LDS_MISC))[c.tid] = 0u;
    if (c.tid < 32) { const unsigned long long pv = (unsigned long long)a.in[c.tid]; ((LAS unsigned*)(c.lds + LDS_INTAB))[2 * c.tid] = (unsigned)pv; ((LAS unsigned*)(c.lds + LDS_INTAB))[2 * c.tid + 1] = (unsigned)(pv >> 32); }
    __syncthreads();
    XcdBarrier bar; bar.bar = WSP(unsigned, WS_CTL) + CW_BAR; bar.x = 0; bar.st = nullptr;
    if constexpr (KIND < 0) bar = xcd_barrier_post(WSP(unsigned, WS_CTL) + CW_BAR, (volatile LAS unsigned*)(c.lds + LDS_MISC));
#define IN(k) ((KIND < 0 || KIND == (k)) && (relaunder(c), true))
#define REP(p) for (int rep_ = 0; rep_ < ((PROBE_DOUBLE == (p)) ? 2 : 1); ++rep_)
#define SEAM(k) do { if constexpr (KIND < 0) { unsigned* bb_ = bar.bar; asm volatile("" : "+s"(bb_)); bar.bar = bb_; xcd_barrier(bar); } } while (0)
    LAS unsigned char* ring = c.lds;

    if (IN(0)) REP(4) { phase_prologue(c); } SEAM(0);
    for (int l = a.l_lo; l < a.l_hi; ++l) {
        constexpr int pb = 1;
        const float* resid = (l == 0) ? c.x() : WSP(float, WS_XA);
        if (IN(pb + 0)) { if (l == 0) phase_norm(c, c.x(), nullptr, nullptr, nullptr, WSP(bf16_t, WS_H0));
                          else phase_norm(c, WSP(float, WS_XA), WSP(bf16_t, WS_Y), WSP(bf16_t, WS_Y) + (size_t)M * D, WSP(float, WS_XA), WSP(bf16_t, WS_H0));
        } SEAM(pb + 0);
        if (IN(pb + 1)) REP(2) { pg8::Cfg g{(unsigned)(D * 2), 128u, (unsigned)(D * 2), D / 64, nullptr}; pg8::DenseOrder S; S.init(M / 256, NCAT / 256, c.G, c.bid, WSP(bf16_t, WS_H0), (size_t)256 * D * 2, WSP(bf16_t, WS_WINT) + (size_t)l * NCAT * D, (size_t)256 * D * 2);
            EpiInprojGates E{WSP(bf16_t, WS_P1), WSP(unsigned char, WS_GATES), c.b_merge() + l * 3072}; pg8::gemm_phase<false>(ring, c.wave, g, S, E);
            if (l == 0) {
                int nfull = (M / 256) * (NCAT / 256) - 6 * c.G; if (nfull < 0 || nfull >= c.G) nfull = 0;
                relaunder(c);
                LAS float* scr = (LAS float*)(c.lds + c.wave * 16384); const int NGW = (c.G - nfull) * NWAVES; const int gw = (c.bid >= nfull) ? (c.bid - nfull) * NWAVES + c.wave : 0x3fffffff;
#define DEF_MAKE(i_) prologue_item(c, (PI_WIN + PI_WM) + (i_))
                T_SIMPLE(NL * PI_PER_L - (PI_WIN + PI_WM), DEF_MAKE);
#undef DEF_MAKE
            } } SEAM(pb + 1);
        if (IN(pb + 2)) {
            const bool split = c.G >= 64;
            if (!split || c.bid < c.G - 32) phase_prep(c, l, c.bid, split ? c.G - 32 : c.G);
            if (!split || c.bid >= c.G - 32) { pg8::Cfg g{(unsigned)(16 * P1W * 2), (unsigned)(P1W * 2), 4096u, 16, nullptr};
                CmpOrder S{split ? 32 : c.G, split ? c.bid - (c.G - 32) : c.bid, (const char*)WSP(bf16_t, WS_P1), (const char*)(WSP(bf16_t, WS_WC1T) + (size_t)l * 2 * 256 * 2048)};
                EpiCmpSlab E{WSP(float, WS_SL)}; pg8::gemm_phase<false>(ring, c.wave, g, S, E); }
        } SEAM(pb + 2);
        if (IN(pb + 3)) REP(2) {
            phase_cmp2(c, l); phase_chunk_prefix(c);
            { pg8::Cfg g{(unsigned)(P1W * 2), 128u, 512u, 4, nullptr}; pg8::DenseOrder S; S.init(M / 256, 2, c.G, c.bid, WSP(bf16_t, WS_P1) + C_CQ, (size_t)256 * P1W * 2, WSP(bf16_t, WS_WUQT) + (size_t)l * 768 * 256, (size_t)256 * 512);
              EpiStoreBf16 E{WSP(bf16_t, WS_QB), 768, WSP(float, WS_RSTD), 2}; pg8::gemm_phase<false>(ring, c.wave, g, S, E); }
            { pg8::Cfg g{(unsigned)(P1W * 2), 128u, 512u, 4, nullptr}; pg8::DenseOrder S; S.init(M / 256, 1, c.G, (c.bid + 128) % c.G, WSP(bf16_t, WS_P1) + C_CQ, (size_t)256 * P1W * 2, WSP(bf16_t, WS_WUQT) + (size_t)l * 768 * 256 + (size_t)512 * 256, (size_t)256 * 512);
              EpiUqRope E{WSP(bf16_t, WS_QB) + 512, WSP(float, WS_RSTD), WSP(float, WS_ROPE), WSP(float, WS_ROPE) + (size_t)M * 16}; pg8::gemm_phase<false>(ring, c.wave, g, S, E); }
            { pg8::Cfg g{(unsigned)(P1W * 2), 128u, 256u, 2, nullptr}; pg8::DenseOrder S; S.init(M / 256, 4, c.G, c.bid, WSP(bf16_t, WS_P1) + C_CKV, (size_t)256 * P1W * 2, WSP(bf16_t, WS_WUKVT) + (size_t)l * 1024 * 128, (size_t)256 * 256);
              EpiStoreBf16 E{WSP(bf16_t, WS_KVB), 1024, WSP(float, WS_RSTD) + 1, 2}; pg8::gemm_phase<false>(ring, c.wave, g, S, E); }
        } SEAM(pb + 3);
        if (IN(pb + 6)) { phase_att_fast(c, l);
#if PROBE_DOUBLE == 1
            phase_att_fast(c, l + 2);
#endif
        } SEAM(pb + 6);
        if (IN(pb + 9)) REP(2) {
            pg8::Cfg g{(unsigned)(P1W * 2), 128u, 1024u, 8, nullptr};
            OutprojOrder S{c.G, c.bid, (const char*)c.ws, (long long)(WS_P1 + C_NQ * 2), (long long)WS_QB - (long long)(WS_P1 + C_NQ * 2), (long long)(C_FQKV - C_NQ) * 2, (const char*)(WSP(bf16_t, WS_WOT) + (size_t)l * 3 * 1024 * 512), (unsigned)(P1W * 2), 768u * 2u};
            EpiOutproj E{WSP(bf16_t, WS_MIXED), WSP(unsigned char, WS_GATES)}; pg8::gemm_phase<false>(ring, c.wave, g, S, E);
        } SEAM(pb + 9);
        if (IN(pb + 10)) { pg8::Cfg g{(unsigned)(D * 2), 128u, (unsigned)(D * 2), D / 64, nullptr}; pg8::DenseOrder S; S.init(M / 256, 4, c.G, c.bid, WSP(bf16_t, WS_MIXED), (size_t)256 * D * 2, WSP(bf16_t, WS_WOUTT) + (size_t)l * D * D, (size_t)256 * D * 2);
            EpiWout E{resid, WSP(float, WS_XA)}; pg8::gemm_phase<false>(ring, c.wave, g, S, E);
        } SEAM(pb + 10);
        if (IN(pb + 11)) { phase_router(c, l);
#if PROBE_DOUBLE == 3
            phase_router(c, l, 1);
#endif
        } SEAM(pb + 11);
        if (IN(pb + 12)) REP(4) { phase_place(c, l); } SEAM(pb + 12);
        if (IN(pb + 13)) REP(2) { LAS int* tab = (LAS int*)(c.lds + LDS_MOETAB); moe_tables(c, l, tab);
            pg8::Cfg g{(unsigned)(D * 2), 128u, (unsigned)(D * 2), D / 64, WSP(int, WS_LTOK)}; MoeOrder S{c.G, c.bid, 2, tab, (const char*)WSP(bf16_t, WS_H2), 0, (const char*)WSP(bf16_t, WS_WGU), (size_t)512 * D * 2, (size_t)256 * D * 2};
            EpiMoe1 E{WSP(bf16_t, WS_HID), WSP(float, WS_LW)}; pg8::gemm_phase<true>(ring, c.wave, g, S, E);
            { const int nun = __builtin_amdgcn_readfirstlane(tab[32]) * 2; int n2 = nun - c.G; if (n2 < 0) n2 = 0; if (n2 >= c.G) n2 = 0;
              if (c.bid >= n2) { relaunder(c); LAS float* scr = (LAS float*)(c.lds + c.wave * 16384); const int gw = (c.bid - n2) * NWAVES + c.wave, NGW = (c.G - n2) * NWAVES;
#define DN_MAKE(i_) place_item_dn(c, l, (i_))
                  T_SIMPLE(32 * 128, DN_MAKE);
#undef DN_MAKE
              } }
        } SEAM(pb + 13);
        if (IN(pb + 14)) REP(2) { LAS int* tab = (LAS int*)(c.lds + LDS_MOETAB); moe_tables(c, l, tab);
            pg8::Cfg g{512u, 128u, 512u, 4, nullptr}; MoeOrder S{c.G, c.bid, 4, tab, (const char*)WSP(bf16_t, WS_HID), 512, (const char*)WSP(bf16_t, WS_WDT), (size_t)D * 256 * 2, (size_t)256 * 256 * 2};
            EpiMoe2 E{WSP(bf16_t, WS_Y), WSP(unsigned, WS_LSLOT)}; pg8::gemm_phase<false>(ring, c.wave, g, S, E); } SEAM(pb + 14);
    }
    if (IN(K_FINAL)) REP(6) { phase_final(c); }
#undef IN
#undef SEAM
}

template <int KIND> static bool prep_kernel() { return hipFuncSetAttribute((const void*)fwd_kernel<KIND>, hipFuncAttributeMaxDynamicSharedMemorySize, LDS_BYTES) == hipSuccess; }
template <int KIND> static void launch_kind(int grid, hipStream_t stream, Args a, int l) { a.l_lo = l; a.l_hi = l + 1; hipLaunchKernelGGL(fwd_kernel<KIND>, dim3(grid), dim3(NTHREADS), LDS_BYTES, stream, a); }
extern "C" void kernel_launch(void* const* d_in, const int* in_sizes, int n_in, void* d_out, int out_size, void* d_ws, size_t ws_size, hipStream_t stream) {
    static int grid = 0;
    if (grid == 0) {
        if (n_in != 32 || ws_size < WS_END) { fprintf(stderr, "kernel_launch: n_in %d ws %zu (need %zu)\n", n_in, ws_size, (size_t)WS_END); grid = -1; return; }
        int dev = 0, cus = 0;
        if (hipGetDevice(&dev) != hipSuccess || hipDeviceGetAttribute(&cus, hipDeviceAttributeMultiprocessorCount, dev) != hipSuccess) { grid = -1; return; }
        bool ok = true;
#if MK_ONE_LAUNCH
        ok = prep_kernel<-1>();
#else
        ok = prep_kernel<0>() && prep_kernel<1>() && prep_kernel<2>() && prep_kernel<3>() && prep_kernel<4>() && prep_kernel<5>() && prep_kernel<6>() && prep_kernel<7>() && prep_kernel<8>() && prep_kernel<9>()
          && prep_kernel<10>() && prep_kernel<11>() && prep_kernel<12>() && prep_kernel<13>() && prep_kernel<14>() && prep_kernel<15>() && prep_kernel<16>();
#endif
        if (!ok) { grid = -1; return; }
        (void)hipGetLastError();
        grid = cus;
    }
    if (grid < 0) return;
    (void)hipMemsetAsync((char*)d_ws + WS_CTL, 0, CTL_BYTES, stream);
    Args a{};
    for (int i = 0; i < 32; ++i) a.in[i] = d_in[i];
    a.out = (float*)d_out; a.ws = (unsigned char*)d_ws;
#if MK_ONE_LAUNCH
    a.l_lo = 0; a.l_hi = NL;
    hipLaunchKernelGGL(fwd_kernel<-1>, dim3(grid), dim3(NTHREADS), LDS_BYTES, stream, a);
#else
    launch_kind<0>(grid, stream, a, 0);
    for (int l = 0; l < NL; ++l) {
        launch_kind<1>(grid, stream, a, l); launch_kind<2>(grid, stream, a, l); launch_kind<3>(grid, stream, a, l); launch_kind<4>(grid, stream, a, l); launch_kind<5>(grid, stream, a, l);
        launch_kind<6>(grid, stream, a, l); launch_kind<7>(grid, stream, a, l); launch_kind<8>(grid, stream, a, l); launch_kind<9>(grid, stream, a, l); launch_kind<10>(grid, stream, a, l);
        launch_kind<11>(grid, stream, a, l); launch_kind<12>(grid, stream, a, l); launch_kind<13>(grid, stream, a, l); launch_kind<14>(grid, stream, a, l); launch_kind<15>(grid, stream, a, l);
    }
    launch_kind<16>(grid, stream, a, 0);
#endif
}
```

```cpp
#include <hip/hip_runtime.h>
#include <stdint.h>
#include <cstdio>

#ifndef PROBE_DOUBLE
#define PROBE_DOUBLE 0
#endif
#ifndef MK_ONE_LAUNCH
#define MK_ONE_LAUNCH 1
#endif

#define LAS __attribute__((address_space(3)))
typedef unsigned short bf16_t;
typedef short bf16x8 __attribute__((ext_vector_type(8)));
typedef float f32x4 __attribute__((ext_vector_type(4)));
typedef float f32x16 __attribute__((ext_vector_type(16)));
typedef unsigned u32x4 __attribute__((ext_vector_type(4)));
typedef unsigned u32x2 __attribute__((ext_vector_type(2)));

constexpr int NB = 2, T = 8192, D = 1024, M = NB * T, NL = 2;
constexpr int DIN = 6336;
constexpr int P1W = 3328;
constexpr int C_NQ = 0, C_NKV = 512, C_CQ = 1280, C_CKV = 1536, C_KR = 1664, C_NG = 1696, C_FF = 1720, C_FQKV = 1728;
constexpr int NEXP = 32, EDIM = 256;
constexpr float EPS = 1e-6f;
constexpr float LOG2E = 1.4426950408889634f;
constexpr float QSCALE64 = 0.125f * LOG2E, QSCALE96 = 0.10206207261596575f * LOG2E;
constexpr int NTHREADS = 512, NWAVES = 8;
constexpr int LDS_BYTES = 147456;
constexpr int MOE_MAXROWS = 40960;

constexpr size_t MiB = 1u << 20;
constexpr size_t WS_CTL = 0;
constexpr size_t CTL_BYTES = 1 * MiB;
constexpr int CW_BAR = 4096;
constexpr int CW_QUEUE = 16384;
constexpr int CW_MOECNT = 32768;
constexpr int CW_KMAX = 24576;
constexpr int CW_CNTB = 65536;
constexpr size_t CTL_LTOK = 512 * 1024;
constexpr size_t WS_WINT = 1 * MiB;
constexpr int NCAT = 6400;
constexpr size_t WS_WUQT = 26 * MiB;
constexpr size_t WS_WUKVT = 27 * MiB;
constexpr size_t WS_WOT = 28 * MiB;
constexpr size_t WS_WOUTT = 34 * MiB;
constexpr size_t WS_WC1T = 38 * MiB;
constexpr size_t WS_ROPE = 42 * MiB;
constexpr size_t WS_TAB = 44 * MiB;
constexpr size_t WS_XA = 45 * MiB;
constexpr size_t PB = 109 * MiB;
constexpr size_t WS_P1 = PB;
constexpr size_t WS_QB = PB + 104 * MiB;
constexpr size_t WS_KVB = PB + 128 * MiB;
constexpr size_t WS_H0 = PB + 128 * MiB;
constexpr size_t WS_GATES = PB + 160 * MiB;
constexpr size_t WS_SM = PB + 208 * MiB;
constexpr size_t WS_RSTD = WS_SM;
constexpr size_t WS_KR = WS_SM + 256 * 1024;
constexpr size_t WS_LF = WS_SM + 1280 * 1024;
constexpr size_t WS_CUM = WS_SM + 1792 * 1024;
constexpr size_t WS_SL = WS_SM + 2304 * 1024;
constexpr size_t WS_KC = WS_SM + 6400 * 1024;
constexpr size_t WS_VC = WS_SM + 6656 * 1024;
constexpr size_t WS_REC = WS_SM + 6912 * 1024;
constexpr size_t WS_LTOK = WS_SM + 7424 * 1024;
constexpr size_t WS_LW = WS_SM + 7616 * 1024;
constexpr size_t WS_LSLOT = WS_SM + 7808 * 1024;
static_assert(WS_LSLOT + MOE_MAXROWS * 4 <= WS_SM + 8 * MiB, "small region");
constexpr size_t WS_END = PB + 216 * MiB;
constexpr size_t WS_MIXED = PB + 128 * MiB;
constexpr size_t WS_Y = PB;
constexpr size_t WS_H2 = PB + 64 * MiB;
constexpr size_t WS_WGU = PB + 96 * MiB;
constexpr size_t WS_WDT = PB + 128 * MiB;
constexpr size_t WS_HID = PB + 144 * MiB;
static_assert(WS_Y + 64 * MiB <= WS_H0 && WS_HID + (size_t)MOE_MAXROWS * 512 <= WS_SM, "phase-region overlays");
static_assert(WS_END <= 332 * MiB, "workspace budget");

__device__ __forceinline__ float bf2f(bf16_t v) { return __uint_as_float((unsigned)v << 16); }
__device__ __forceinline__ unsigned f2bf(float f) { unsigned u = __float_as_uint(f); return (u + 0x7fffu + ((u >> 16) & 1u)) >> 16; }
__device__ __forceinline__ unsigned pk2(float lo, float hi) { return f2bf(lo) | (f2bf(hi) << 16); }
typedef float f32x2_t __attribute__((ext_vector_type(2))); typedef __bf16 bf16x2_t __attribute__((ext_vector_type(2)));
__device__ __forceinline__ unsigned cvtpk(float lo, float hi) { f32x2_t v = {lo, hi}; bf16x2_t b = __builtin_convertvector(v, bf16x2_t); return __builtin_bit_cast(unsigned, b); }
__device__ __forceinline__ f32x4 unpk4(u32x2 a) { f32x4 r; r.x = __uint_as_float(a.x << 16); r.y = __uint_as_float(a.x & 0xffff0000u); r.z = __uint_as_float(a.y << 16); r.w = __uint_as_float(a.y & 0xffff0000u); return r; }
template <int CTRL> __device__ __forceinline__ float dpp_f(float v) { return __int_as_float(__builtin_amdgcn_update_dpp(0, __float_as_int(v), CTRL, 0xf, 0xf, true)); }
__device__ __forceinline__ float wave_sum(float v) {
    v += dpp_f<0xB1>(v); v += dpp_f<0x4E>(v); v += dpp_f<0x141>(v); v += dpp_f<0x140>(v);
    const float a = __int_as_float(__builtin_amdgcn_readlane(__float_as_int(v), 0)), b = __int_as_float(__builtin_amdgcn_readlane(__float_as_int(v), 16));
    const float c2 = __int_as_float(__builtin_amdgcn_readlane(__float_as_int(v), 32)), d = __int_as_float(__builtin_amdgcn_readlane(__float_as_int(v), 48));
    return (a + b) + (c2 + d);
}
__device__ __forceinline__ float wave_max(float v) {
    v = fmaxf(v, dpp_f<0xB1>(v)); v = fmaxf(v, dpp_f<0x4E>(v)); v = fmaxf(v, dpp_f<0x141>(v)); v = fmaxf(v, dpp_f<0x140>(v));
    const float a = __int_as_float(__builtin_amdgcn_readlane(__float_as_int(v), 0)), b = __int_as_float(__builtin_amdgcn_readlane(__float_as_int(v), 16));
    const float c2 = __int_as_float(__builtin_amdgcn_readlane(__float_as_int(v), 32)), d = __int_as_float(__builtin_amdgcn_readlane(__float_as_int(v), 48));
    return fmaxf(fmaxf(a, b), fmaxf(c2, d));
}
__device__ __forceinline__ float half_sum(float v) { auto rr = __builtin_amdgcn_permlane32_swap(__float_as_uint(v), __float_as_uint(v), false, false); return __uint_as_float(rr[0]) + __uint_as_float(rr[1]); }
__device__ __forceinline__ float sigmoidf_(float x) { return 1.f / (1.f + __expf(-x)); }
__device__ __forceinline__ float gelu_tanh(float x) { const float u = 0.7978845608028654f * (x + 0.044715f * x * x * x); const float th = 1.f - 2.f / (1.f + __expf(2.f * u)); return 0.5f * x * (1.f + th); }
#define LDS_WAIT() asm volatile("s_waitcnt lgkmcnt(0)" ::: "memory")

#define XB_TMO      128
#define XB_XCNT(j)  (256  + 64 * (j))
#define XB_XSUB(j)  (1280 + 64 * (j))
#define XB_XGEN(j)  (2304 + 64 * (j))
#define XB_TOP      3328
#define XB_TOPGEN   3392
#define XCD_BAR_WORDS 3456
#define XB_SPIN_CAP (1u << 18)

__device__ __forceinline__ unsigned xb_ld(unsigned* p)              { return __hip_atomic_load(p, __ATOMIC_RELAXED, __HIP_MEMORY_SCOPE_AGENT); }
__device__ __forceinline__ unsigned xb_add(unsigned* p, unsigned v) { return __hip_atomic_fetch_add(p, v, __ATOMIC_RELAXED, __HIP_MEMORY_SCOPE_AGENT); }
__device__ __forceinline__ unsigned xb_xcc_id() { return (unsigned)__builtin_amdgcn_s_getreg((3 << 11) | 20) & 0xFu; }
#define XB_SPIN(cond, bar) do { unsigned _sp = 0; while (cond) { __builtin_amdgcn_s_sleep(1); \
    if ((++_sp & 255u) == 0u) { if (xb_ld(&(bar)[XB_TMO])) break; if (_sp > XB_SPIN_CAP) { atomicAdd(&(bar)[XB_TMO], 1u); break; } } } } while (0)

struct XcdBarrier { unsigned* bar; unsigned x; volatile LAS unsigned* st; };

__device__ __forceinline__ XcdBarrier xcd_barrier_post(unsigned* bar, volatile LAS unsigned* st) {
    XcdBarrier b; b.bar = bar; b.x = xb_xcc_id(); b.st = st;
    if (threadIdx.x == 0) (void)xb_add(&bar[XB_XCNT(b.x)], 1u);
    return b;
}
__device__ __forceinline__ void xcd_barrier_complete(unsigned* bar, unsigned x, unsigned& nloc, unsigned& nx) {
    const unsigned G = gridDim.x * gridDim.y * gridDim.z;
    unsigned sum, cnt, mine, sp = 0u;
    for (;;) {
        sum = 0u; cnt = 0u; mine = 0u;
#pragma unroll
        for (unsigned j = 0; j < 16; ++j) { const unsigned c = xb_ld(&bar[XB_XCNT(j)]); sum += c; cnt += (c > 0u) ? 1u : 0u; mine = (j == x) ? c : mine; }
        if (sum == G) break;
        __builtin_amdgcn_s_sleep(1);
        if ((++sp & 255u) == 0u) { if (xb_ld(&bar[XB_TMO])) break; if (sp > XB_SPIN_CAP) { atomicAdd(&bar[XB_TMO], 1u); break; } }
    }
    nloc = mine > 0u ? mine : 1u; nx = cnt > 0u ? cnt : 1u;
}
__device__ __forceinline__ void xcd_barrier(const XcdBarrier& b) {
    asm volatile("s_waitcnt vmcnt(0)" ::: "memory");
    __syncthreads();
    if (threadIdx.x == 0) {
        unsigned* bar = b.bar;
        __builtin_amdgcn_s_waitcnt(0);
        unsigned nloc = b.st[0], nx = b.st[1];
        if (nloc == 0u) { xcd_barrier_complete(bar, b.x, nloc, nx); b.st[0] = nloc; b.st[1] = nx; }
        const unsigned old = xb_add(&bar[XB_XSUB(b.x)], 1u);
        const unsigned gen = old / nloc;
        if (old + 1u == (gen + 1u) * nloc) {
            __builtin_amdgcn_fence(__ATOMIC_RELEASE, "agent");
            asm volatile("s_waitcnt vmcnt(0)" ::: "memory");
            const unsigned og = xb_add(&bar[XB_TOP], 1u);
            const unsigned tg = og / nx;
            if (og + 1u == (tg + 1u) * nx) xb_add(&bar[XB_TOPGEN], 1u);
            else XB_SPIN(xb_ld(&bar[XB_TOPGEN]) == tg, bar);
            __builtin_amdgcn_fence(__ATOMIC_ACQUIRE, "agent");
            xb_add(&bar[XB_XGEN(b.x)], 1u);
            asm volatile("s_waitcnt vmcnt(0)" ::: "memory");
        } else {
            XB_SPIN(xb_ld(&bar[XB_XGEN(b.x)]) == gen, bar);
            __builtin_amdgcn_fence(__ATOMIC_ACQUIRE, "agent");
            asm volatile("s_waitcnt vmcnt(0)" ::: "memory");
        }
    }
    __syncthreads();
}

namespace pg8 {
constexpr int BM = 256, BK = 64, HALF = 128, HTB = HALF * BK * 2, STAGE_BYTES = 8 * HTB;
__host__ __device__ __forceinline__ int lds_byte(int r, int c) { const int st = (r >> 4) * 2 + (c >> 5), rr = r & 15, cc = c & 31, ob = rr * 64 + cc * 2; return st * 1024 + (ob ^ (((ob >> 9) & 1) << 5)); }
__host__ __device__ __forceinline__ void stage_rc(int b, int& R, int& C) { const int st = b / 1024, sb = b % 1024, swz = sb ^ (((sb >> 9) & 1) << 5); R = (st >> 1) * 16 + swz / 64; C = (st & 1) * 32 + (swz % 64) / 2; }

struct Unit { int pm, pn; const char* A; const char* B; int aux; unsigned lda; };
struct Cfg { unsigned lda; unsigned kstepA; unsigned ldb; int nt; const int* rowidx; };

struct DenseOrder {
    int nM, nN, nwg, G, c; const char* A; const char* B; size_t tstepA, tstepB;
    __device__ void init(int nM_, int nN_, int G_, int c_, const void* A_, size_t tstepA_, const void* B_, size_t tstepB_) { nM = nM_; nN = nN_; nwg = nM * nN; G = G_; c = c_; A = (const char*)A_; B = (const char*)B_; tstepA = tstepA_; tstepB = tstepB_; }
    __device__ bool next(int i, Unit& u) const {
        const long Lq = (long)i * G + c; if (Lq >= nwg) return false;
        int wgid = (int)Lq; { const int q = nwg / 8, r = nwg % 8, xcd = wgid % 8, off = wgid / 8; wgid = (xcd < r ? xcd * (q + 1) : r * (q + 1) + (xcd - r) * q) + off; }
        const int nig = 8 * nN, gid = wgid / nig, fm = gid * 8, gsz = (nM - fm) < 8 ? (nM - fm) : 8;
        u.pm = fm + ((wgid % nig) % gsz); u.pn = (wgid % nig) / gsz; u.A = A + (size_t)u.pm * tstepA; u.B = B + (size_t)u.pn * tstepB; u.aux = 0; u.lda = 0u; return true;
    }
};

#define PG8_EPI_ROWCOL(row, col) const int row = u.pm * 256 + ai * 128 + wr * 64 + m * 16 + fr; const int col = u.pn * 256 + bj * 128 + wc * 32 + n * 16 + fq * 4;

template <bool INDEXED, class Epi, class Sched>
__device__ __forceinline__ void gemm_phase(LAS unsigned char* lds, int wid, const Cfg g, const Sched& S, const Epi& E) {
    int lane_; asm volatile("v_mbcnt_lo_u32_b32 %0, -1, 0\n\tv_mbcnt_hi_u32_b32 %0, -1, %0" : "=v"(lane_));
    const int lane = lane_, tid = wid * 64 + lane, wr = wid >> 2, wc = wid & 3, fr = lane & 15, fq = lane >> 4;
    const int nt = g.nt;
    int Rs[2], Cs[2]; unsigned voffB[2];
#pragma unroll
    for (int i = 0; i < 2; ++i) { stage_rc(tid * 16 + i * 8192, Rs[i], Cs[i]); voffB[i] = (unsigned)Rs[i] * g.ldb + (unsigned)Cs[i] * 2u; }
    const size_t kstepA = g.kstepA, kstepB = (size_t)(BK * 2);
    const size_t hstepB = (size_t)HALF * g.ldb;
    const unsigned ldsw = (unsigned)wid * 1024u;
    const int aoff = lds_byte(wr * 64 + fr, fq * 8), boff = lds_byte(wc * 32 + fr, fq * 8);
#define PG8_SA(b, h) (((b) * 2 + (h)) * HTB)
#define PG8_SB(b, h) ((4 + (b) * 2 + (h)) * HTB)
#define PG8_STAGE2(bufoff, gbase, v0, v1) do { const char* gb_ = (const char*)(gbase); asm volatile("" : "+s"(gb_)); \
        __builtin_amdgcn_global_load_lds((const unsigned*)(gb_ + (v0)), (LAS unsigned*)(lds + (bufoff) + ldsw), 16, 0, 0); \
        __builtin_amdgcn_global_load_lds((const unsigned*)(gb_ + (v1)), (LAS unsigned*)(lds + (bufoff) + ldsw + 8192), 16, 0, 0); } while (0)
#define PG8_STAGEB(bufoff, gbase) PG8_STAGE2(bufoff, gbase, voffB[0], voffB[1])
#define PG8_LDA(dst, b, h) do { _Pragma("unroll") for (int m = 0; m < 4; ++m) _Pragma("unroll") for (int k = 0; k < 2; ++k) dst[m][k] = *(const LAS bf16x8*)(lds + PG8_SA(b, h) + aoff + m * 2048 + k * 1024); } while (0)
#define PG8_LDB(dst, b, h) do { _Pragma("unroll") for (int n = 0; n < 2; ++n) _Pragma("unroll") for (int k = 0; k < 2; ++k) dst[n][k] = *(const LAS bf16x8*)(lds + PG8_SB(b, h) + boff + n * 2048 + k * 1024); } while (0)
#define PG8_MMA(ai, bj, At, Bt) do { __builtin_amdgcn_s_setprio(1); _Pragma("unroll") for (int m = 0; m < 4; ++m) _Pragma("unroll") for (int n = 0; n < 2; ++n) _Pragma("unroll") for (int k = 0; k < 2; ++k) \
        acc[ai][bj][m][n] = __builtin_amdgcn_mfma_f32_16x16x32_bf16(Bt[n][k], At[m][k], acc[ai][bj][m][n], 0, 0, 0); __builtin_amdgcn_s_setprio(0); } while (0)
#define PG8_WAIT_V(n) asm volatile("s_waitcnt vmcnt(" #n ")" ::: "memory")
#define PG8_WAIT_L(n) asm volatile("s_waitcnt lgkmcnt(" #n ")" ::: "memory")
#define PG8_BAR __builtin_amdgcn_s_barrier()
#define PG8_SCHED __builtin_amdgcn_sched_barrier(0)
    Unit cur, nxt; int ui = 0;
    if (!S.next(0, cur)) return;
    unsigned vAc[2][2], vAn[2][2];
#define PG8_SETVA(v, U) do { _Pragma("unroll") for (int h_ = 0; h_ < 2; ++h_) _Pragma("unroll") for (int i_ = 0; i_ < 2; ++i_) { \
        if constexpr (INDEXED) { const int r_ = g.rowidx[(U).aux + h_ * HALF + Rs[i_]]; v[h_][i_] = (unsigned)r_ * g.lda + (unsigned)Cs[i_] * 2u; } \
        else v[h_][i_] = (unsigned)(h_ * HALF + Rs[i_]) * ((U).lda ? (U).lda : g.lda) + (unsigned)Cs[i_] * 2u; } } while (0)
    PG8_SETVA(vAc, cur);
    f32x4 acc[2][2][4][2];
#pragma unroll
    for (int a = 0; a < 2; ++a)
#pragma unroll
        for (int b = 0; b < 2; ++b)
#pragma unroll
            for (int m = 0; m < 4; ++m)
#pragma unroll
                for (int n = 0; n < 2; ++n) acc[a][b][m][n] = (f32x4){0.f, 0.f, 0.f, 0.f};
    bf16x8 At[4][2], B0[2][2], B1[2][2];
    const char* cA = cur.A; const char* cB = cur.B;
    PG8_STAGEB(PG8_SB(0, 0), cB); PG8_STAGEB(PG8_SB(0, 1), cB + hstepB); PG8_STAGE2(PG8_SA(0, 0), cA, vAc[0][0], vAc[0][1]); PG8_STAGE2(PG8_SA(0, 1), cA, vAc[1][0], vAc[1][1]);
    if (wr == 1) PG8_BAR;
    PG8_WAIT_V(2); PG8_BAR;
    PG8_STAGEB(PG8_SB(1, 0), cB + kstepB); PG8_STAGE2(PG8_SA(1, 0), cA + kstepA, vAc[0][0], vAc[0][1]); PG8_STAGEB(PG8_SB(1, 1), cB + hstepB + kstepB);
    PG8_WAIT_V(6); PG8_BAR;
    for (;;) {
        const bool has_next = S.next(ui + 1, nxt);
        const char* nA = has_next ? nxt.A : cA; const char* nB = has_next ? nxt.B : cB;
        if (has_next) { PG8_SETVA(vAn, nxt); } else {
#pragma unroll
            for (int h_ = 0; h_ < 2; ++h_)
#pragma unroll
                for (int i_ = 0; i_ < 2; ++i_) vAn[h_][i_] = vAc[h_][i_]; }
        for (int t = 0; t < nt; t += 2) {
            const bool last = (t == nt - 2);
            const char* a1 = cA + (size_t)(t + 1) * kstepA;
            const char* a2 = last ? nA : cA + (size_t)(t + 2) * kstepA; const char* b2 = last ? nB : cB + (size_t)(t + 2) * kstepB;
            const char* a3 = a2 + kstepA; const char* b3 = b2 + kstepB;
            const unsigned w00 = last ? vAn[0][0] : vAc[0][0], w01 = last ? vAn[0][1] : vAc[0][1], w10 = last ? vAn[1][0] : vAc[1][0], w11 = last ? vAn[1][1] : vAc[1][1];
            PG8_LDB(B0, 0, 0); PG8_LDB(B1, 0, 1); PG8_SCHED; PG8_LDA(At, 0, 0); PG8_STAGE2(PG8_SA(1, 1), a1, vAc[1][0], vAc[1][1]);
            PG8_WAIT_V(8); PG8_WAIT_L(0); PG8_BAR; PG8_MMA(0, 0, At, B0); PG8_MMA(0, 1, At, B1); PG8_BAR; PG8_SCHED;
            PG8_LDA(At, 0, 1); PG8_STAGEB(PG8_SB(0, 0), b2); PG8_STAGEB(PG8_SB(0, 1), b2 + hstepB); PG8_STAGE2(PG8_SA(0, 0), a2, w00, w01);
            PG8_WAIT_V(8); PG8_WAIT_L(0); PG8_BAR; PG8_MMA(1, 0, At, B0); PG8_MMA(1, 1, At, B1); PG8_BAR; PG8_SCHED;
            PG8_LDB(B0, 1, 0); PG8_LDB(B1, 1, 1); PG8_SCHED; PG8_LDA(At, 1, 0); PG8_STAGE2(PG8_SA(0, 1), a2, w10, w11);
            PG8_WAIT_V(8); PG8_WAIT_L(0); PG8_BAR; PG8_MMA(0, 0, At, B0); PG8_MMA(0, 1, At, B1); PG8_BAR; PG8_SCHED;
            PG8_LDA(At, 1, 1); PG8_STAGEB(PG8_SB(1, 0), b3); PG8_STAGEB(PG8_SB(1, 1), b3 + hstepB); PG8_STAGE2(PG8_SA(1, 0), a3, w00, w01);
            PG8_WAIT_V(8); PG8_WAIT_L(0); PG8_BAR; PG8_MMA(1, 0, At, B0); PG8_MMA(1, 1, At, B1); PG8_BAR; PG8_SCHED;
        }
        if (wr == 0) PG8_BAR;
        { int l2_; asm volatile("v_mbcnt_lo_u32_b32 %0, -1, 0\n\tv_mbcnt_hi_u32_b32 %0, -1, %0" : "=v"(l2_)); E(acc, cur, wr, wc, l2_ & 15, l2_ >> 4); }
        if (!has_next) break;
#pragma unroll
        for (int a = 0; a < 2; ++a)
#pragma unroll
            for (int b = 0; b < 2; ++b)
#pragma unroll
                for (int m = 0; m < 4; ++m)
#pragma unroll
                    for (int n = 0; n < 2; ++n) acc[a][b][m][n] = (f32x4){0.f, 0.f, 0.f, 0.f};
        cur = nxt; cA = nA; cB = nB; ++ui;
#pragma unroll
        for (int h_ = 0; h_ < 2; ++h_)
#pragma unroll
            for (int i_ = 0; i_ < 2; ++i_) vAc[h_][i_] = vAn[h_][i_];
        if (wr == 1) PG8_BAR;
    }
    PG8_WAIT_V(0);
    PG8_BAR;
#undef PG8_SA
#undef PG8_SB
#undef PG8_STAGE2
#undef PG8_STAGEB
#undef PG8_LDA
#undef PG8_LDB
#undef PG8_MMA
#undef PG8_WAIT_V
#undef PG8_WAIT_L
#undef PG8_BAR
#undef PG8_SCHED
#undef PG8_SETVA
}
}

constexpr int LDS_MISC = 131072;
constexpr int LDS_MOETAB = LDS_MISC + 64;
constexpr int LDS_INTAB = LDS_MISC + 512;
struct Ctx {
    float* out; unsigned char* ws; unsigned char* ws0;
    LAS unsigned char* lds;
    int tid, lane, wave, G, bid;
    __device__ __forceinline__ const void* inp(int i) const { const LAS unsigned* p = (const LAS unsigned*)(lds + LDS_INTAB) + 2 * i;
        const unsigned lo = (unsigned)__builtin_amdgcn_readfirstlane((int)p[0]), hi = (unsigned)__builtin_amdgcn_readfirstlane((int)p[1]); return (const void*)(const __attribute__((address_space(1))) char*)(((unsigned long long)hi << 32) | lo); }
    __device__ __forceinline__ const float* x() const { return (const float*)inp(0); }
    __device__ __forceinline__ const int* pos() const { return (const int*)inp(1); }
    __device__ __forceinline__ const float* rel_bias() const { return (const float*)inp(2); }
    __device__ __forceinline__ const float* norm_attn() const { return (const float*)inp(3); }
    __device__ __forceinline__ const float* w_in() const { return (const float*)inp(4); }
    __device__ __forceinline__ const float* b_merge() const { return (const float*)inp(5); }
    __device__ __forceinline__ const float* cmp_pe() const { return (const float*)inp(6); }
    __device__ __forceinline__ const float* cmp_k_w1() const { return (const float*)inp(7); }
    __device__ __forceinline__ const float* cmp_k_b1() const { return (const float*)inp(8); }
    __device__ __forceinline__ const float* cmp_k_w2() const { return (const float*)inp(9); }
    __device__ __forceinline__ const float* cmp_v_w1() const { return (const float*)inp(10); }
    __device__ __forceinline__ const float* cmp_v_b1() const { return (const float*)inp(11); }
    __device__ __forceinline__ const float* cmp_v_w2() const { return (const float*)inp(12); }
    __device__ __forceinline__ const float* mla_q_norm() const { return (const float*)inp(13); }
    __device__ __forceinline__ const float* mla_kv_norm() const { return (const float*)inp(14); }
    __device__ __forceinline__ const float* mla_w_uq() const { return (const float*)inp(15); }
    __device__ __forceinline__ const float* mla_w_uk() const { return (const float*)inp(16); }
    __device__ __forceinline__ const float* mla_w_uv() const { return (const float*)inp(17); }
    __device__ __forceinline__ const float* fox_b_f() const { return (const float*)inp(18); }
    __device__ __forceinline__ const float* w_o_nsa() const { return (const float*)inp(19); }
    __device__ __forceinline__ const float* w_o_mla() const { return (const float*)inp(20); }
    __device__ __forceinline__ const float* w_o_fox() const { return (const float*)inp(21); }
    __device__ __forceinline__ const float* w_out() const { return (const float*)inp(22); }
    __device__ __forceinline__ const float* norm_ffn() const { return (const float*)inp(23); }
    __device__ __forceinline__ const float* moe_w_grp() const { return (const float*)inp(24); }
    __device__ __forceinline__ const float* moe_b_grp() const { return (const float*)inp(25); }
    __device__ __forceinline__ const float* moe_w_router() const { return (const float*)inp(26); }
    __device__ __forceinline__ const float* moe_b_router() const { return (const float*)inp(27); }
    __device__ __forceinline__ const float* moe_w_gate() const { return (const float*)inp(28); }
    __device__ __forceinline__ const float* moe_w_up() const { return (const float*)inp(29); }
    __device__ __forceinline__ const float* moe_w_down() const { return (const float*)inp(30); }
    __device__ __forceinline__ const float* norm_final() const { return (const float*)inp(31); }
};
#define WSP(T_, off) ((T_*)(c.ws + (off)))
__device__ __forceinline__ int lane_id_volatile() { int ln; asm volatile("v_mbcnt_lo_u32_b32 %0, -1, 0\n\tv_mbcnt_hi_u32_b32 %0, -1, %0" : "=v"(ln)); return ln; }
__device__ __forceinline__ void relaunder(Ctx& c) { const int ln = lane_id_volatile(); c.lane = ln; c.tid = c.wave * 64 + ln;
    size_t z_ = 0; asm volatile("" : "+s"(z_)); c.ws = c.ws0 + z_; int g_ = c.G, b_ = c.bid, wv_ = c.wave; asm volatile("" : "+s"(g_), "+s"(b_), "+s"(wv_)); c.G = g_; c.bid = b_; c.wave = wv_; }

struct TItem { const float* wp; size_t ldw; bf16_t* wt; const float* rsp; float colscale; int K; bool pad; };
__device__ __forceinline__ TItem make_titem(const float* W, int ldw, int K, bf16_t* WT, const float* rowscale, int sc, int nblk, int item, int lane, float colscale) {
    const int kb = item / nblk, nb = item % nblk, k0 = 64 * kb, n0 = 32 * nb, cc = lane & 7;
    TItem t; t.wp = W + (size_t)(k0 + (lane >> 5)) * ldw + (sc >= 0 ? sc : 0); t.ldw = (size_t)ldw; t.wt = WT + (size_t)n0 * K + k0 + 8 * cc; t.rsp = rowscale ? rowscale + k0 + 8 * cc : nullptr; t.colscale = colscale; t.K = K; t.pad = sc < 0;
    return t;
}
__device__ __forceinline__ void t_load(const TItem& t, float (&v)[32], float (&rsc)[8]) {
#pragma unroll
    for (int i = 0; i < 32; ++i) v[i] = t.wp[(size_t)(2 * i) * t.ldw];
    if (t.rsp) { const f32x4 a = *(const f32x4*)t.rsp, b = *(const f32x4*)(t.rsp + 4); rsc[0] = a.x; rsc[1] = a.y; rsc[2] = a.z; rsc[3] = a.w; rsc[4] = b.x; rsc[5] = b.y; rsc[6] = b.z; rsc[7] = b.w; }
    else {
#pragma unroll
        for (int i = 0; i < 8; ++i) rsc[i] = 1.f; }
}
__device__ __forceinline__ void t_finish(const TItem& t, const float (&v)[32], const float (&rsc)[8], LAS float* scr, int lane) {
    const int cc = lane & 7;
#pragma unroll
    for (int i = 0; i < 32; ++i) scr[(2 * i + (lane >> 5)) * 33 + (lane & 31)] = t.pad ? 0.f : v[i];
    LDS_WAIT(); asm volatile("" ::: "memory");
#pragma unroll
    for (int j = 0; j < 4; ++j) { const int n = (lane >> 3) + 8 * j; const LAS float* s_ = scr + (8 * cc) * 33 + n; const float cs = t.colscale;
        u32x4 o; o.x = cvtpk(s_[0 * 33] * (rsc[0] * cs), s_[1 * 33] * (rsc[1] * cs)); o.y = cvtpk(s_[2 * 33] * (rsc[2] * cs), s_[3 * 33] * (rsc[3] * cs));
        o.z = cvtpk(s_[4 * 33] * (rsc[4] * cs), s_[5 * 33] * (rsc[5] * cs)); o.w = cvtpk(s_[6 * 33] * (rsc[6] * cs), s_[7 * 33] * (rsc[7] * cs));
        *(u32x4*)(t.wt + (size_t)n * t.K) = o; }
    LDS_WAIT(); asm volatile("" ::: "memory");
}
#define T_PIPELINE(N_ITEMS, MAKE) do { int it_ = gw;    if (it_ < (N_ITEMS)) { TItem A_ = MAKE(it_); float va_[32], ra_[8]; t_load(A_, va_, ra_); \
    for (;;) { const int itn_ = it_ + NGW; const bool hb_ = itn_ < (N_ITEMS); TItem B_; float vb_[32], rb_[8]; if (hb_) { B_ = MAKE(itn_); t_load(B_, vb_, rb_); } \
        __builtin_amdgcn_sched_barrier(0); t_finish(A_, va_, ra_, scr, c.lane); if (!hb_) break; \
        const int itn2_ = itn_ + NGW; const bool ha_ = itn2_ < (N_ITEMS); if (ha_) { A_ = MAKE(itn2_); t_load(A_, va_, ra_); } \
        __builtin_amdgcn_sched_barrier(0); t_finish(B_, vb_, rb_, scr, c.lane); if (!ha_) break; it_ = itn2_; } } } while (0)
#define T_SIMPLE(N_ITEMS, MAKE) do { for (int it_ = gw; it_ < (N_ITEMS); it_ += NGW) { TItem A_ = MAKE(it_); float va_[32], ra_[8]; t_load(A_, va_, ra_); __builtin_amdgcn_sched_barrier(0); t_finish(A_, va_, ra_, scr, c.lane); } } while (0)
struct MapId { int off; __device__ int operator()(int n) const { return n + off; } };
struct MapInproj { __device__ int operator()(int n) const { if (n < 1280) return n; if (n < 1696) return n + 24; if (n < 1720) return n - 416; if (n < 1728) return n + 1536; if (n < 3264) return n - 8; return -1; } };
struct MapUq { __device__ int operator()(int n) const { if (n < 512) return (n >> 6) * 96 + (n & 63); const int r = n - 512; return (r >> 5) * 96 + 64 + (r & 31); } };
struct MapPad128 { __device__ int operator()(int n) const { return n < 128 ? n : -1; } };
struct MapGU { __device__ int operator()(int n) const { return (n >> 8) * 128 + (n & 127); } };

__device__ __forceinline__ int rel_bucket_dev(int n) {
    if (n < 16) return n;
    const float lr = __logf((float)n / 16.f) / 2.0794415416798357f;
    int large = 16 + (int)(lr * 16.f);
    return large < 31 ? large : 31;
}

constexpr int PI_WIN = 16 * (P1W / 32), PI_WM = 16 * 96, PI_UQ = 4 * 24, PI_UK = 2 * 16, PI_UV = 2 * 16, PI_WO = 8 * 32, PI_WOUT = 16 * 32, PI_C1 = 32 * 8;
constexpr int PI_PER_L = PI_WIN + PI_WM + PI_UQ + PI_UK + PI_UV + 3 * PI_WO + PI_WOUT + 2 * PI_C1;
__device__ __forceinline__ TItem prologue_item(const Ctx& c, int it) {
    const int l = it / PI_PER_L; int r = it % PI_PER_L; const int ln = c.lane & 31;
    if (r < PI_WIN) { const int n0_ = 32 * (r % (P1W / 32)); const float cs_ = (n0_ < 512 || (n0_ >= C_FQKV && n0_ < C_FQKV + 512)) ? QSCALE64 : 1.f;
        return make_titem(c.w_in() + (size_t)l * D * DIN, DIN, D, WSP(bf16_t, WS_WINT) + (size_t)l * NCAT * D, c.norm_attn() + l * D, MapInproj{}(n0_ + ln), P1W / 32, r, c.lane, cs_); } r -= PI_WIN;
    if (r < PI_WM) return make_titem(c.w_in() + (size_t)l * D * DIN, DIN, D, WSP(bf16_t, WS_WINT) + ((size_t)l * NCAT + P1W) * D, c.norm_attn() + l * D, 3264 + 32 * (r % 96) + ln, 96, r, c.lane, 1.f); r -= PI_WM;
    if (r < PI_UQ) return make_titem(c.mla_w_uq() + (size_t)l * 256 * 768, 768, 256, WSP(bf16_t, WS_WUQT) + (size_t)l * 768 * 256, c.mla_q_norm() + l * 256, MapUq{}(32 * (r % 24) + ln), 24, r, c.lane, QSCALE96); r -= PI_UQ;
    if (r < PI_UK) return make_titem(c.mla_w_uk() + (size_t)l * 128 * 512, 512, 128, WSP(bf16_t, WS_WUKVT) + (size_t)l * 1024 * 128, c.mla_kv_norm() + l * 128, 32 * (r % 16) + ln, 16, r, c.lane, 1.f); r -= PI_UK;
    if (r < PI_UV) return make_titem(c.mla_w_uv() + (size_t)l * 128 * 512, 512, 128, WSP(bf16_t, WS_WUKVT) + (size_t)l * 1024 * 128 + 512 * 128, c.mla_kv_norm() + l * 128, 32 * (r % 16) + ln, 16, r, c.lane, 1.f); r -= PI_UV;
    if (r < 3 * PI_WO) { const int br = r / PI_WO, rr = r % PI_WO; return make_titem((const float*)c.inp(19 + br) + (size_t)l * 512 * 1024, 1024, 512, WSP(bf16_t, WS_WOT) + ((size_t)l * 3 + br) * 1024 * 512, nullptr, 32 * (rr % 32) + ln, 32, rr, c.lane, 1.f); } r -= 3 * PI_WO;
    if (r < PI_WOUT) return make_titem(c.w_out() + (size_t)l * D * D, D, D, WSP(bf16_t, WS_WOUTT) + (size_t)l * D * D, nullptr, 32 * (r % 32) + ln, 32, r, c.lane, 1.f); r -= PI_WOUT;
    { const int kv = r / PI_C1, rr = r % PI_C1; const int n_ = 32 * (rr % 8) + ln;
      return make_titem((const float*)c.inp(kv == 0 ? 7 : 10) + (size_t)l * 2048 * 128, 128, 2048, WSP(bf16_t, WS_WC1T) + ((size_t)l * 2 + kv) * 256 * 2048, nullptr, n_ < 128 ? n_ : -1, 8, rr, c.lane, 1.f); }
}
__device__ __forceinline__ void phase_prologue(const Ctx& c) {
    LAS float* scr = (LAS float*)(c.lds + c.wave * 16384);
    const int gw = c.bid * NWAVES + c.wave, NGW = c.G * NWAVES;
#define PRO_MAKE(i_) prologue_item(c, (i_))
    T_PIPELINE(PI_WIN + PI_WM, PRO_MAKE);
#undef PRO_MAKE
    { float* rc = WSP(float, WS_ROPE); float* rs = rc + (size_t)M * 16;
      for (int i = c.bid * NTHREADS + c.tid; i < M * 16; i += c.G * NTHREADS) { const int m = i >> 4, j = i & 15;
          const float inv = exp2f(-(float)j * 0.8304820237218407f);   const float ang = (float)c.pos()[m] * inv; double rev = (double)ang * 0.15915494309189535; rev -= floor(rev); const float fr_ = (float)rev; rc[i] = __builtin_amdgcn_cosf(fr_); rs[i] = __builtin_amdgcn_sinf(fr_); } }
    float* tab = WSP(float, WS_TAB);
    for (int o = c.bid * NWAVES + c.wave; o < 512; o += c.G * NWAVES) {
        const int l = o >> 8, kv = (o >> 7) & 1, j = o & 127;
        const float* w1 = (const float*)c.inp(kv == 0 ? 7 : 10) + (size_t)l * 2048 * 128 + j; const float* pe = c.cmp_pe() + l * 2048;
        float wv[32], pv_[32];
#pragma unroll
        for (int i = 0; i < 32; ++i) { const int k = c.lane + 64 * i; wv[i] = w1[(size_t)k * 128]; pv_[i] = pe[k]; }
        float s_ = 0.f;
#pragma unroll
        for (int i = 0; i < 32; ++i) s_ += wv[i] * pv_[i];
        s_ = wave_sum(s_);
        if (c.lane == 0) tab[o] = s_ + ((const float*)c.inp(kv == 0 ? 8 : 11))[l * 128 + j];
    }
    if (c.bid == 1 % c.G) {
        for (int i = c.tid; i < 8 * 129; i += NTHREADS) { const int h = i / 129, d = i % 129; tab[512 + h * 132 + d] = c.rel_bias()[rel_bucket_dev(d) * 8 + h] * LOG2E; }
    }
}

__device__ __forceinline__ void phase_norm(const Ctx& c, const float* src, const bf16_t* y0, const bf16_t* y1, float* rout, bf16_t* hout) {
    const int gw = c.bid * NWAVES + c.wave, NGW = c.G * NWAVES;
    for (int m = gw; m < M; m += NGW) {
        const f32x4* xr = (const f32x4*)(src + (size_t)m * D) + c.lane;
        f32x4 v[4]; float s = 0.f;
#pragma unroll
        for (int j = 0; j < 4; ++j) { v[j] = xr[64 * j];
            if (y0) { const u32x2 a = *((const u32x2*)(y0 + (size_t)m * D) + c.lane + 64 * j); const u32x2 b = *((const u32x2*)(y1 + (size_t)m * D) + c.lane + 64 * j);
                v[j].x += __uint_as_float(a.x << 16) + __uint_as_float(b.x << 16); v[j].y += __uint_as_float(a.x & 0xffff0000u) + __uint_as_float(b.x & 0xffff0000u);
                v[j].z += __uint_as_float(a.y << 16) + __uint_as_float(b.y << 16); v[j].w += __uint_as_float(a.y & 0xffff0000u) + __uint_as_float(b.y & 0xffff0000u); }
            s += (v[j].x * v[j].x + v[j].y * v[j].y) + (v[j].z * v[j].z + v[j].w * v[j].w); }
        const float rstd = rsqrtf(wave_sum(s) * (1.f / D) + EPS);
        if (rout) { f32x4* ro = (f32x4*)(rout + (size_t)m * D) + c.lane;
#pragma unroll
            for (int j = 0; j < 4; ++j) ro[64 * j] = v[j]; }
        u32x2* o8 = (u32x2*)(hout + (size_t)m * D) + c.lane;
#pragma unroll
        for (int j = 0; j < 4; ++j) { u32x2 w; w.x = pk2(v[j].x * rstd, v[j].y * rstd); w.y = pk2(v[j].z * rstd, v[j].w * rstd); o8[64 * j] = w; }
    }
}
__device__ __forceinline__ void phase_final(const Ctx& c) {
    const int gw = c.bid * NWAVES + c.wave, NGW = c.G * NWAVES;
    const float* src = WSP(float, WS_XA); const bf16_t* y0 = WSP(bf16_t, WS_Y); const bf16_t* y1 = y0 + (size_t)M * D;
    for (int m = gw; m < M; m += NGW) {
        const f32x4* xr = (const f32x4*)(src + (size_t)m * D) + c.lane;
        f32x4 v[4]; float s = 0.f;
#pragma unroll
        for (int j = 0; j < 4; ++j) { v[j] = xr[64 * j];
            const u32x2 a = *((const u32x2*)(y0 + (size_t)m * D) + c.lane + 64 * j); const u32x2 b = *((const u32x2*)(y1 + (size_t)m * D) + c.lane + 64 * j);
            v[j].x += __uint_as_float(a.x << 16) + __uint_as_float(b.x << 16); v[j].y += __uint_as_float(a.x & 0xffff0000u) + __uint_as_float(b.x & 0xffff0000u);
            v[j].z += __uint_as_float(a.y << 16) + __uint_as_float(b.y << 16); v[j].w += __uint_as_float(a.y & 0xffff0000u) + __uint_as_float(b.y & 0xffff0000u);
            s += (v[j].x * v[j].x + v[j].y * v[j].y) + (v[j].z * v[j].z + v[j].w * v[j].w); }
        const float rstd = rsqrtf(wave_sum(s) * (1.f / D) + EPS);
        f32x4* ro = (f32x4*)(c.out + (size_t)m * D) + c.lane;
#pragma unroll
        for (int j = 0; j < 4; ++j) { const f32x4 g = *((const f32x4*)c.norm_final() + c.lane + 64 * j); ro[64 * j] = v[j] * rstd * g; }
    }
}

constexpr size_t WS_LC = WS_LF, WS_CT = WS_CUM, WS_CP = WS_CUM + 64 * 1024;
__device__ __forceinline__ void phase_prep(const Ctx& c, int l, int cbid, int cG) {
    const bf16_t* P1 = WSP(bf16_t, WS_P1); float* rstd = WSP(float, WS_RSTD); bf16_t* KR = WSP(bf16_t, WS_KR); float* LC = WSP(float, WS_LC); float* CT = WSP(float, WS_CT);
    const float* rc = WSP(float, WS_ROPE); const float* rs = rc + (size_t)M * 16;
    float kmx0 = 0.f, kmx1 = 0.f;
    LAS unsigned* kml = (LAS unsigned*)(c.lds + 4096); LAS float* wt = (LAS float*)(c.lds + 4096 + 64);
    if (c.tid < 16) kml[c.tid] = 0u;
    __syncthreads();
    const float bf_ = (c.lane < 8) ? c.fox_b_f()[l * 8 + c.lane] : 0.f;
    for (int ch = cbid; ch < M / 64; ch += cG) {
        float run = 0.f, rv[8];
#pragma unroll
        for (int i = 0; i < 8; ++i) { const int m = ch * 64 + c.wave * 8 + i;
            const bf16_t* row = P1 + (size_t)m * P1W;
            const u32x2 a = *((const u32x2*)(row + C_CQ) + c.lane);
            const unsigned b = *((const unsigned*)(row + C_CKV) + c.lane);
            const u32x4 kq = *((const u32x4*)(row + C_FQKV + 512) + c.lane);
            const float x1 = (c.lane < 16) ? bf2f(row[C_KR + c.lane]) : 0.f, x2 = (c.lane < 16) ? bf2f(row[C_KR + 16 + c.lane]) : 0.f;
            const float cs = (c.lane < 16) ? rc[m * 16 + c.lane] : 0.f, sn = (c.lane < 16) ? rs[m * 16 + c.lane] : 0.f;
            const float ff = (c.lane < 8) ? bf2f(row[C_FF + c.lane]) : 0.f;
            float q0 = __uint_as_float(a.x << 16), q1 = __uint_as_float(a.x & 0xffff0000u), q2 = __uint_as_float(a.y << 16), q3 = __uint_as_float(a.y & 0xffff0000u);
            const float sq = wave_sum(q0 * q0 + q1 * q1 + q2 * q2 + q3 * q3);
            float k0 = __uint_as_float(b << 16), k1 = __uint_as_float(b & 0xffff0000u);
            const float sk = wave_sum(k0 * k0 + k1 * k1);
            if (c.lane == 0) { rstd[2 * m] = rsqrtf(sq * (1.f / 256.f) + EPS); rstd[2 * m + 1] = rsqrtf(sk * (1.f / 128.f) + EPS); }
            if (c.lane < 16) { KR[m * 32 + c.lane] = (bf16_t)f2bf(x1 * cs - x2 * sn); KR[m * 32 + 16 + c.lane] = (bf16_t)f2bf(x1 * sn + x2 * cs); }
            { const f32x4 a0 = unpk4((u32x2){kq.x, kq.y}), a1 = unpk4((u32x2){kq.z, kq.w});
              float ss = (a0.x * a0.x + a0.y * a0.y) + (a0.z * a0.z + a0.w * a0.w) + (a1.x * a1.x + a1.y * a1.y) + (a1.z * a1.z + a1.w * a1.w);
              ss += dpp_f<0xB1>(ss); ss += dpp_f<0x4E>(ss); ss += dpp_f<0x141>(ss);
              if (m < T) kmx0 = fmaxf(kmx0, ss); else kmx1 = fmaxf(kmx1, ss); }
            const float f = ff + bf_;
            const float ls = fminf(f, 0.f) - __logf(1.f + __expf(-fabsf(f)));
            run += ls; rv[i] = run; }
        if (c.lane < 8) wt[c.wave * 8 + c.lane] = run;
        __syncthreads();
        if (c.lane < 8) { float pre = 0.f; for (int w_ = 0; w_ < c.wave; ++w_) pre += wt[w_ * 8 + c.lane];
            const int m0 = ch * 64 + c.wave * 8, bb = m0 / T, t0 = m0 % T; float* lc = LC + ((size_t)bb * 8 + c.lane) * T + t0;
#pragma unroll
            for (int i = 0; i < 8; ++i) lc[i] = (pre + rv[i]) * LOG2E;
            if (c.wave == 7) CT[((size_t)bb * 8 + c.lane) * 128 + (t0 >> 6)] = (pre + run) * LOG2E; }
        __syncthreads();
    }
    if ((c.lane & 7) == 0) { atomicMax((unsigned*)(kml + (c.lane >> 3)), __float_as_uint(kmx0)); atomicMax((unsigned*)(kml + 8 + (c.lane >> 3)), __float_as_uint(kmx1)); }
    __syncthreads();
    if (c.tid < 16) atomicMax(WSP(unsigned, WS_CTL) + CW_KMAX + l * 16 + c.tid, kml[c.tid]);
}
__device__ __forceinline__ void phase_chunk_prefix(const Ctx& c) {
    LAS float* sh = (LAS float*)(c.lds + 8192);
    for (int s_ = c.bid; s_ < NB * 8; s_ += c.G) {
        if (c.tid < 128) sh[c.tid] = WSP(float, WS_CT)[(size_t)s_ * 128 + c.tid];
        __syncthreads();
        if (c.tid == 0) { float run = 0.f; float* cp = WSP(float, WS_CP) + (size_t)s_ * 129; for (int i = 0; i < 128; ++i) { cp[i] = run; run += sh[i]; } cp[128] = run; }
        __syncthreads();
    }
}
__device__ __forceinline__ void phase_cmp2(const Ctx& c, int l) {
    const float* SL = WSP(float, WS_SL); const float* bc1 = WSP(float, WS_TAB) + l * 256;
    LAS float* hl = (LAS float*)(c.lds + c.wave * 1024);
    for (int pr = c.bid * NWAVES + c.wave; pr < 2 * 2048; pr += c.G * NWAVES) {
        const int kv = pr >> 11, row = pr & 2047, d = c.lane;
        const float* w2 = (kv == 0 ? c.cmp_k_w2() : c.cmp_v_w2()) + (size_t)l * 128 * 64 + d;
        const float* s0 = SL + ((size_t)kv * 2048 + row) * 128; const float* s1 = s0 + (size_t)2 * 2048 * 128;
        const float a0 = s0[d], a1 = s0[d + 64], b0 = s1[d], b1 = s1[d + 64], c0 = bc1[kv * 128 + d], c1 = bc1[kv * 128 + d + 64];
        hl[d] = gelu_tanh(a0 + b0 + c0); hl[d + 64] = gelu_tanh(a1 + b1 + c1);
        LDS_WAIT(); asm volatile("" ::: "memory");
        float s = 0.f;
#pragma unroll
        for (int jb = 0; jb < 4; ++jb) { float wv[32];
#pragma unroll
            for (int i = 0; i < 32; ++i) wv[i] = w2[(size_t)(32 * jb + i) * 64];
            __builtin_amdgcn_sched_barrier(0);
#pragma unroll
            for (int i = 0; i < 32; ++i) s += hl[32 * jb + i] * wv[i]; }
        if ((row & 511) == 511) s = 0.f;
        (kv == 0 ? WSP(bf16_t, WS_KC) : WSP(bf16_t, WS_VC))[(size_t)row * 64 + d] = (bf16_t)f2bf(s);
        LDS_WAIT(); asm volatile("" ::: "memory");
    }
}
__device__ __forceinline__ u32x2 pk4(f32x4 v) { u32x2 w; w.x = cvtpk(v.x, v.y); w.y = cvtpk(v.z, v.w); return w; }
#define EPI_ARGS const f32x4 (&acc)[2][2][4][2], const pg8::Unit& u, int wr, int wc, int fr, int fq
#define EPI_LOOP _Pragma("unroll") for (int ai = 0; ai < 2; ++ai) _Pragma("unroll") for (int m = 0; m < 4; ++m) _Pragma("unroll") for (int bj = 0; bj < 2; ++bj) _Pragma("unroll") for (int n = 0; n < 2; ++n)

#define EPI_ROW(ai, m) (u.pm * 256 + (ai) * 128 + wr * 64 + (m) * 16 + fr)
#define EPI_COL(bj, n) (u.pn * 256 + (bj) * 128 + wc * 32 + (n) * 16 + fq * 4)
struct EpiStoreBf16 { bf16_t* O; int ldc; const float* rowscale; int rs_stride;
    __device__ __forceinline__ void operator()(EPI_ARGS) const {
        float rs[2][4];
#pragma unroll
        for (int ai = 0; ai < 2; ++ai)
#pragma unroll
            for (int m = 0; m < 4; ++m) rs[ai][m] = rowscale ? rowscale[(size_t)EPI_ROW(ai, m) * rs_stride] : 1.f;
        __builtin_amdgcn_sched_barrier(0);
        EPI_LOOP { const unsigned off = (unsigned)EPI_ROW(ai, m) * (unsigned)ldc + (unsigned)EPI_COL(bj, n); *(u32x2*)(O + off) = pk4(acc[ai][bj][m][n] * rs[ai][m]); } } };
struct EpiUqRope { bf16_t* QB; const float* rstd; const float* ropec; const float* ropes;
    __device__ __forceinline__ void operator()(EPI_ARGS) const {
#pragma unroll
        for (int ai = 0; ai < 2; ++ai) { float rs[4]; f32x4 cs4[4], sn4[4];
#pragma unroll
            for (int m = 0; m < 4; ++m) { const unsigned row = (unsigned)EPI_ROW(ai, m); rs[m] = rstd[(size_t)row * 2]; cs4[m] = *(const f32x4*)(ropec + row * 16u + fq * 4); sn4[m] = *(const f32x4*)(ropes + row * 16u + fq * 4); }
            __builtin_amdgcn_sched_barrier(0);
#pragma unroll
            for (int m = 0; m < 4; ++m)
#pragma unroll
                for (int bj = 0; bj < 2; ++bj) { const f32x4 x1 = acc[ai][bj][m][0] * rs[m], x2 = acc[ai][bj][m][1] * rs[m];
                    const f32x4 o1 = x1 * cs4[m] - x2 * sn4[m], o2 = x1 * sn4[m] + x2 * cs4[m];
                    const unsigned off = (unsigned)EPI_ROW(ai, m) * 768u + (unsigned)EPI_COL(bj, 0);
                    *(u32x2*)(QB + off) = pk4(o1); *(u32x2*)(QB + off + 16) = pk4(o2); }
            __builtin_amdgcn_sched_barrier(0); } } };
struct EpiInprojGates { bf16_t* P1o; unsigned char* G8; const float* bias;
    __device__ __forceinline__ void operator()(EPI_ARGS) const {
        if (u.pn < 13) { EPI_LOOP { *(u32x2*)(P1o + (unsigned)EPI_ROW(ai, m) * (unsigned)P1W + (unsigned)EPI_COL(bj, n)) = pk4(acc[ai][bj][m][n]); } }
        else { f32x4 bv[2][2];
#pragma unroll
            for (int bj = 0; bj < 2; ++bj)
#pragma unroll
                for (int n = 0; n < 2; ++n) bv[bj][n] = *(const f32x4*)(bias + (EPI_COL(bj, n) - P1W));
            __builtin_amdgcn_sched_barrier(0);
            EPI_LOOP { const f32x4 v = acc[ai][bj][m][n] + bv[bj][n];
                const unsigned q0_ = (unsigned)(sigmoidf_(v.x) * 255.f + 0.5f), q1_ = (unsigned)(sigmoidf_(v.y) * 255.f + 0.5f), q2_ = (unsigned)(sigmoidf_(v.z) * 255.f + 0.5f), q3_ = (unsigned)(sigmoidf_(v.w) * 255.f + 0.5f);
                *(unsigned*)(G8 + (size_t)EPI_ROW(ai, m) * 3072u + (unsigned)(EPI_COL(bj, n) - P1W)) = q0_ | (q1_ << 8) | (q2_ << 16) | (q3_ << 24); } } } };
struct EpiGates { bf16_t* O; const float* bias;
    __device__ __forceinline__ void operator()(EPI_ARGS) const {
        f32x4 bv[2][2];
#pragma unroll
        for (int bj = 0; bj < 2; ++bj)
#pragma unroll
            for (int n = 0; n < 2; ++n) bv[bj][n] = *(const f32x4*)(bias + EPI_COL(bj, n));
        __builtin_amdgcn_sched_barrier(0);
        EPI_LOOP { f32x4 v = acc[ai][bj][m][n] + bv[bj][n];
            v.x = sigmoidf_(v.x); v.y = sigmoidf_(v.y); v.z = sigmoidf_(v.z); v.w = sigmoidf_(v.w); *(u32x2*)(O + (unsigned)EPI_ROW(ai, m) * 3072u + (unsigned)EPI_COL(bj, n)) = pk4(v); } } };
struct EpiCmpSlab { float* SL;
    __device__ __forceinline__ void operator()(EPI_ARGS) const {
        const int kv = u.pm >> 4, bg = (u.pm >> 2) & 3, half = (u.pm >> 1) & 1, ksp = u.pm & 1;
#pragma unroll
        for (int ai = 0; ai < 2; ++ai)
#pragma unroll
            for (int m = 0; m < 4; ++m)
#pragma unroll
                for (int n = 0; n < 2; ++n) { const int i = half * 256 + ai * 128 + wr * 64 + m * 16 + fr, cc = wc * 32 + n * 16 + fq * 4;
                    *(f32x4*)(SL + ((size_t)(ksp * 2 + kv) * 2048 + bg * 512 + i) * 128 + cc) = acc[ai][0][m][n]; } } };
struct EpiOutproj { bf16_t* MIX; const unsigned char* G8;
    __device__ __forceinline__ void operator()(EPI_ARGS) const {
        const int br = u.aux;
#pragma unroll
        for (int ai = 0; ai < 2; ++ai)
#pragma unroll
          for (int mh = 0; mh < 2; ++mh) { unsigned gw[2][2][2]; u32x2 mw[2][2][2];
#pragma unroll
            for (int m2 = 0; m2 < 2; ++m2)
#pragma unroll
                for (int bj = 0; bj < 2; ++bj)
#pragma unroll
                    for (int n = 0; n < 2; ++n) { const unsigned row = (unsigned)EPI_ROW(ai, 2 * mh + m2), col = (unsigned)EPI_COL(bj, n);
                        gw[m2][bj][n] = *(const unsigned*)(G8 + (size_t)row * 3072u + (unsigned)br * 1024u + col); if (br > 0) mw[m2][bj][n] = *(const u32x2*)(MIX + row * 1024u + col); }
            __builtin_amdgcn_sched_barrier(0);
#pragma unroll
            for (int m2 = 0; m2 < 2; ++m2)
#pragma unroll
                for (int bj = 0; bj < 2; ++bj)
#pragma unroll
                    for (int n = 0; n < 2; ++n) { const unsigned g_ = gw[m2][bj][n]; f32x4 gf; gf.x = (float)(g_ & 255u); gf.y = (float)((g_ >> 8) & 255u); gf.z = (float)((g_ >> 16) & 255u); gf.w = (float)(g_ >> 24);
                        f32x4 v = acc[ai][bj][2 * mh + m2][n] * gf * (1.f / 255.f); if (br > 0) v = v + unpk4(mw[m2][bj][n]);
                        *(u32x2*)(MIX + (unsigned)EPI_ROW(ai, 2 * mh + m2) * 1024u + (unsigned)EPI_COL(bj, n)) = pk4(v); }
            __builtin_amdgcn_sched_barrier(0); } } };
struct EpiWout { const float* R; float* XA;
    __device__ __forceinline__ void operator()(EPI_ARGS) const {
#pragma unroll
        for (int ai = 0; ai < 2; ++ai)
#pragma unroll
          for (int mh = 0; mh < 2; ++mh) { f32x4 rv[2][2][2];
#pragma unroll
            for (int m2 = 0; m2 < 2; ++m2)
#pragma unroll
                for (int bj = 0; bj < 2; ++bj)
#pragma unroll
                    for (int n = 0; n < 2; ++n) rv[m2][bj][n] = *(const f32x4*)(R + (unsigned)EPI_ROW(ai, 2 * mh + m2) * 1024u + (unsigned)EPI_COL(bj, n));
            __builtin_amdgcn_sched_barrier(0);
#pragma unroll
            for (int m2 = 0; m2 < 2; ++m2)
#pragma unroll
                for (int bj = 0; bj < 2; ++bj)
#pragma unroll
                    for (int n = 0; n < 2; ++n) *(f32x4*)(XA + (unsigned)EPI_ROW(ai, 2 * mh + m2) * 1024u + (unsigned)EPI_COL(bj, n)) = rv[m2][bj][n] + acc[ai][bj][2 * mh + m2][n];
            __builtin_amdgcn_sched_barrier(0); } } };
struct EpiMoe1 { bf16_t* HID; const float* LW;
    __device__ __forceinline__ void operator()(EPI_ARGS) const {
        int aux_ = u.aux; asm volatile("" : "+s"(aux_));
        float w8[2][4];
#pragma unroll
        for (int ai = 0; ai < 2; ++ai)
#pragma unroll
            for (int m = 0; m < 4; ++m) w8[ai][m] = LW[(unsigned)(aux_ + ai * 128 + wr * 64 + m * 16 + fr)];
        __builtin_amdgcn_sched_barrier(0);
#pragma unroll
        for (int ai = 0; ai < 2; ++ai)
#pragma unroll
            for (int m = 0; m < 4; ++m) { const unsigned pos = (unsigned)(aux_ + ai * 128 + wr * 64 + m * 16 + fr); const float w = w8[ai][m];
#pragma unroll
                for (int n = 0; n < 2; ++n) { const f32x4 g = acc[ai][0][m][n], up = acc[ai][1][m][n]; f32x4 h;
                    h.x = g.x * sigmoidf_(g.x) * up.x * w; h.y = g.y * sigmoidf_(g.y) * up.y * w; h.z = g.z * sigmoidf_(g.z) * up.z * w; h.w = g.w * sigmoidf_(g.w) * up.w * w;
                    *(u32x2*)(HID + pos * 256u + (unsigned)(u.pn * 128 + wc * 32 + n * 16 + fq * 4)) = pk4(h); } } } };
struct EpiMoe2 { bf16_t* Y; const unsigned* LDST;
    __device__ __forceinline__ void operator()(EPI_ARGS) const {
        int aux_ = u.aux; asm volatile("" : "+s"(aux_));
        unsigned d8[2][4];
#pragma unroll
        for (int ai = 0; ai < 2; ++ai)
#pragma unroll
            for (int m = 0; m < 4; ++m) d8[ai][m] = LDST[(unsigned)(aux_ + ai * 128 + wr * 64 + m * 16 + fr)];
        __builtin_amdgcn_sched_barrier(0);
#pragma unroll
        for (int ai = 0; ai < 2; ++ai)
#pragma unroll
            for (int m = 0; m < 4; ++m) { const unsigned d0 = d8[ai][m];
                if (d0 != 0xFFFFFFFFu) { const unsigned off = d0 + (unsigned)(u.pn * 256 + wc * 32 + fq * 4);
#pragma unroll
                    for (int bj = 0; bj < 2; ++bj)
#pragma unroll
                        for (int n = 0; n < 2; ++n) *(u32x2*)(Y + off + bj * 128 + n * 16) = pk4(acc[ai][bj][m][n]); } } } };

struct OutprojOrder { int G, c; const char* base; long long off0, d1, d2; const char* W; unsigned lda0, lda1;
    __device__ bool next(int i, pg8::Unit& u) const { const int rnd = i / 3, br = i - 3 * rnd; const int tl = rnd * G + c; if (tl >= (M / 256) * 4) return false;
        u.pm = tl >> 2; u.pn = tl & 3; u.aux = br; const unsigned lda_ = lda0 + (unsigned)(br == 1) * (lda1 - lda0); u.lda = lda_;
        const unsigned long long pa_ = (unsigned long long)(base + off0 + (long long)(br == 1) * d1 + (long long)(br == 2) * d2 + (long long)u.pm * 256 * lda_), pb_ = (unsigned long long)(W + (size_t)br * 1024 * 1024 + (size_t)u.pn * 256 * 1024);
        u.A = (const char*)(const __attribute__((address_space(1))) char*)(((unsigned long long)(unsigned)__builtin_amdgcn_readfirstlane((int)(pa_ >> 32)) << 32) | (unsigned)__builtin_amdgcn_readfirstlane((int)pa_));
        u.B = (const char*)(const __attribute__((address_space(1))) char*)(((unsigned long long)(unsigned)__builtin_amdgcn_readfirstlane((int)(pb_ >> 32)) << 32) | (unsigned)__builtin_amdgcn_readfirstlane((int)pb_)); return true; } };
struct CmpOrder { int G, c; const char* P1; const char* W;
    __device__ bool next(int i, pg8::Unit& u) const { const int L_ = i * G + c; if (L_ >= 32) return false; const int kv = L_ >> 4, b = (L_ >> 3) & 1, g = (L_ >> 2) & 1, half = (L_ >> 1) & 1, ks = L_ & 1;
        u.pm = L_; u.pn = 0; u.aux = 0; u.lda = 0u; u.A = P1 + ((size_t)(b * T + 16 * 256 * half + 16 * ks) * P1W + C_NKV + (kv * 2 + g) * 64) * 2; u.B = W + ((size_t)kv * 256 * 2048 + (size_t)ks * 1024) * 2; return true; } };
struct MoeOrder { int G, c, nN; const LAS int* tab; const char* A; size_t a_rowbytes; const char* W; size_t w_expert, w_tile;
    __device__ bool next(int i, pg8::Unit& u) const { const int L_ = i * G + c; const int NT = __builtin_amdgcn_readfirstlane(tab[32]); if (L_ >= NT * nN) return false; const int rt = L_ / nN, pn = L_ % nN;
        int e = 0; while (__builtin_amdgcn_readfirstlane(tab[e + 1]) <= rt) ++e;
        const int off_e = __builtin_amdgcn_readfirstlane(tab[33 + e]), ts_e = __builtin_amdgcn_readfirstlane(tab[e]), cnt_e = __builtin_amdgcn_readfirstlane(tab[66 + e]);
        const int pos0 = off_e + 256 * (rt - ts_e); u.pn = pn; u.aux = pos0; u.pm = off_e + cnt_e; u.lda = 0u;
        u.A = A + (size_t)pos0 * a_rowbytes; u.B = W + (size_t)e * w_expert + (size_t)pn * w_tile; return true; } };
__device__ __forceinline__ void moe_tables(const Ctx& c, int l, LAS int* tab) {
    if (c.tid < 32) tab[66 + c.tid] = (int)(WSP(unsigned, WS_CTL) + CW_MOECNT + l * 64)[c.tid];
    __syncthreads();
    if (c.tid == 0) { int ts = 0, off = 0;
        for (int e = 0; e < 32; ++e) { const int n = tab[66 + e]; tab[e] = ts; tab[33 + e] = off; const int nt_ = (n + 255) >> 8; ts += nt_; off += nt_ * 256; }
        tab[32] = ts; tab[65] = off; }
    __syncthreads();
}

constexpr int LDS_RSM = LDS_MISC + 1024;
__device__ __forceinline__ void phase_router(const Ctx& c, int l, int dummy = 0) {
    const int gw = c.bid * NWAVES + c.wave, NGW = c.G * NWAVES, lane = c.lane;
    const float* XA = WSP(float, WS_XA); bf16_t* H2 = WSP(bf16_t, WS_H2); int* REC = WSP(int, dummy ? WS_HID : WS_REC); unsigned* cnt = WSP(unsigned, WS_CTL) + CW_MOECNT + (l + 2 * dummy) * 64;
    const float* g2 = c.norm_ffn() + l * D; const float* wg = c.moe_w_grp() + (size_t)l * D * 4; const float* wr_ = c.moe_w_router() + (size_t)l * D * 32;
    const float* bgp = c.moe_b_grp() + l * 4; const float* brp = c.moe_b_router() + l * 32;
    LAS f32x4* Tk = (LAS f32x4*)(c.lds + c.wave * 16384);
    LAS float* PG = (LAS float*)(c.lds + LDS_RSM + c.wave * 1792); LAS float* EL = PG + 256; LAS float* GL = EL + 128;
    LAS unsigned* cntL = (LAS unsigned*)(c.lds + LDS_MOETAB);
    if (c.tid < 32) cntL[c.tid] = 0u;
    __syncthreads();
    for (int task = gw; task < M / 4; task += NGW) {
        const int m0 = task * 4;
        f32x4 v[4][4]; float rs[4];
#pragma unroll
        for (int r = 0; r < 4; ++r) { const f32x4* xr = (const f32x4*)(XA + (size_t)(m0 + r) * D) + lane; float s = 0.f;
#pragma unroll
            for (int j = 0; j < 4; ++j) { v[r][j] = xr[64 * j]; s += (v[r][j].x * v[r][j].x + v[r][j].y * v[r][j].y) + (v[r][j].z * v[r][j].z + v[r][j].w * v[r][j].w); }
            rs[r] = rsqrtf(wave_sum(s) * (1.f / D) + EPS); }
#pragma unroll
        for (int j = 0; j < 4; ++j) { const f32x4 gg = *((const f32x4*)g2 + lane + 64 * j);
#pragma unroll
            for (int r = 0; r < 4; ++r) { v[r][j] = v[r][j] * rs[r]; *((u32x2*)(H2 + (size_t)(m0 + r) * D) + lane + 64 * j) = pk4(v[r][j]); v[r][j] = v[r][j] * gg; }
#pragma unroll
            for (int e = 0; e < 4; ++e) { f32x4 t4; t4.x = v[0][j][e]; t4.y = v[1][j][e]; t4.z = v[2][j][e]; t4.w = v[3][j][e]; Tk[4 * lane + 256 * j + e] = t4; } }
        LDS_WAIT(); asm volatile("" ::: "memory");
        { const int og = lane & 3, s16 = lane >> 2; f32x4 acc = {0.f, 0.f, 0.f, 0.f}; const float* wp = wg + (size_t)(64 * s16) * 4 + og; const LAS f32x4* tp = Tk + 64 * s16;
#pragma unroll 1
          for (int kb = 0; kb < 64; kb += 32) { float w[32];
#pragma unroll
              for (int i = 0; i < 32; ++i) w[i] = wp[(size_t)(kb + i) * 4];
              __builtin_amdgcn_sched_barrier(0);
#pragma unroll
              for (int i = 0; i < 32; ++i) acc += tp[kb + i] * w[i]; }
          PG[(0 * 4 + og) * 16 + s16] = acc.x; PG[(1 * 4 + og) * 16 + s16] = acc.y; PG[(2 * 4 + og) * 16 + s16] = acc.z; PG[(3 * 4 + og) * 16 + s16] = acc.w; }
        { const int o4 = lane & 7, ksl = lane >> 3; f32x4 ac[4];
#pragma unroll
          for (int j = 0; j < 4; ++j) ac[j] = (f32x4){0.f, 0.f, 0.f, 0.f};
          const float* wp = wr_ + (size_t)(128 * ksl) * 32 + 4 * o4; const LAS f32x4* tp = Tk + 128 * ksl;
#pragma unroll 1
          for (int kb = 0; kb < 128; kb += 32) { f32x4 w[32];
#pragma unroll
              for (int i = 0; i < 32; ++i) w[i] = *(const f32x4*)(wp + (size_t)(kb + i) * 32);
              __builtin_amdgcn_sched_barrier(0);
#pragma unroll
              for (int i = 0; i < 32; ++i) { const f32x4 t4 = tp[kb + i]; ac[0] += t4 * w[i].x; ac[1] += t4 * w[i].y; ac[2] += t4 * w[i].z; ac[3] += t4 * w[i].w; } }
          LDS_WAIT(); asm volatile("" ::: "memory");
          LAS f32x4* Pp = (LAS f32x4*)Tk;
#pragma unroll
          for (int j = 0; j < 4; ++j) Pp[ksl * 32 + 4 * o4 + j] = ac[j];
          LDS_WAIT(); asm volatile("" ::: "memory");
          if (lane < 32) { f32x4 sm_ = Pp[lane];
#pragma unroll
              for (int q = 1; q < 8; ++q) sm_ += Pp[q * 32 + lane];
              const float bb = brp[lane]; EL[0 * 32 + lane] = sm_.x + bb; EL[1 * 32 + lane] = sm_.y + bb; EL[2 * 32 + lane] = sm_.z + bb; EL[3 * 32 + lane] = sm_.w + bb; } }
        LDS_WAIT(); asm volatile("" ::: "memory");
        if (lane < 16) { float s = 0.f;
#pragma unroll
            for (int q = 0; q < 16; ++q) s += PG[lane * 16 + q];
            GL[lane] = s + bgp[lane & 3]; }
        LDS_WAIT(); asm volatile("" ::: "memory");
        if (lane < 4) { const int r = lane;
            int gi = 0; float gm = GL[r * 4];
            for (int o = 1; o < 4; ++o) { const float x_ = GL[r * 4 + o]; if (x_ > gm) { gm = x_; gi = o; } }
            float gs = 0.f; for (int o = 0; o < 4; ++o) gs += __expf(GL[r * 4 + o] - gm);
            const float grp_top = 1.f / gs;
            int i1 = 0; float m1 = EL[r * 32 + gi * 8];
            for (int q = 1; q < 8; ++q) { const float x_ = EL[r * 32 + gi * 8 + q]; if (x_ > m1) { m1 = x_; i1 = q; } }
            int i2 = -1; float m2 = -3.0e38f;
            for (int q = 0; q < 8; ++q) { const float x_ = EL[r * 32 + gi * 8 + q]; if (q != i1 && x_ > m2) { m2 = x_; i2 = q; } }
            const float e2 = __expf(m2 - m1); const float w1 = grp_top / (1.f + e2), w2 = grp_top * e2 / (1.f + e2);
            const int ea = gi * 8 + i1, eb = gi * 8 + i2; const int ra = (int)atomicAdd((unsigned*)(cntL + ea), 1u), rb = (int)atomicAdd((unsigned*)(cntL + eb), 1u);
            int* rr = REC + (size_t)(m0 + r) * 8; rr[0] = ea; rr[1] = eb; rr[2] = ra; rr[3] = rb; rr[4] = __float_as_int(w1); rr[5] = __float_as_int(w2); rr[6] = c.bid; }
        LDS_WAIT(); asm volatile("" ::: "memory");
    }
    __syncthreads();
    if (c.tid < 32) { const unsigned n = cntL[c.tid]; (WSP(unsigned, WS_CTL) + CW_CNTB)[(dummy ? 8192 : 0) + c.bid * 32 + c.tid] = n; if (n) atomicAdd(cnt + c.tid, n); }
}
__device__ __forceinline__ TItem place_item_gu(const Ctx& c, int l, int it) {
    const int e = it >> 8, r = it & 255, ln = c.lane & 31; const int nb = r % 16; const bool up = ((nb * 32) & 255) >= 128;
    return make_titem((const float*)c.inp(up ? 29 : 28) + ((size_t)l * 32 + e) * D * 256, 256, D, WSP(bf16_t, WS_WGU) + (size_t)e * 512 * D, c.norm_ffn() + l * D, MapGU{}(32 * nb + ln), 16, r, c.lane, 1.f);
}
__device__ __forceinline__ TItem place_item_dn(const Ctx& c, int l, int it) {
    const int e = it >> 7, r = it & 127, ln = c.lane & 31;
    return make_titem(c.moe_w_down() + ((size_t)l * 32 + e) * 256 * D, D, 256, WSP(bf16_t, WS_WDT) + (size_t)e * D * 256, nullptr, 32 * (r % 32) + ln, 32, r, c.lane, 1.f);
}
__device__ __forceinline__ void phase_place(const Ctx& c, int l) {
    LAS int* tab = (LAS int*)(c.lds + LDS_MOETAB);
    moe_tables(c, l, tab);
    int* LTOK = WSP(int, WS_LTOK); float* LW = WSP(float, WS_LW); unsigned* LDST = WSP(unsigned, WS_LSLOT); const int* REC = WSP(int, WS_REC);
    LAS int* BASE = (LAS int*)c.lds;
    { const unsigned* cb = WSP(unsigned, WS_CTL) + CW_CNTB; for (int i = c.tid; i < c.G * 32; i += NTHREADS) BASE[i] = (int)cb[i]; }
    __syncthreads();
    if (c.tid < 32) { int run = 0; const int nb8 = c.G & ~7;
        for (int b0_ = 0; b0_ < nb8; b0_ += 8) { int v8[8];
#pragma unroll
            for (int q = 0; q < 8; ++q) v8[q] = BASE[(b0_ + q) * 32 + c.tid];
#pragma unroll
            for (int q = 0; q < 8; ++q) { BASE[(b0_ + q) * 32 + c.tid] = run; run += v8[q]; } }
        for (int b_ = nb8; b_ < c.G; ++b_) { const int v_ = BASE[b_ * 32 + c.tid]; BASE[b_ * 32 + c.tid] = run; run += v_; } }
    __syncthreads();
    for (int m = c.bid * NTHREADS + c.tid; m < M; m += c.G * NTHREADS) { const int* r = REC + (size_t)m * 8;
        const int pa = tab[33 + r[0]] + BASE[r[6] * 32 + r[0]] + r[2], pb = tab[33 + r[1]] + BASE[r[6] * 32 + r[1]] + r[3];
        LTOK[pa] = m; LDST[pa] = (unsigned)m * 1024u; LW[pa] = __int_as_float(r[4]); LTOK[pb] = m; LDST[pb] = ((unsigned)M + (unsigned)m) * 1024u; LW[pb] = __int_as_float(r[5]); }
    for (int e = c.bid; e < 32; e += c.G) { const int lo = tab[33 + e] + tab[66 + e], hi2 = tab[33 + e + 1];
        for (int p = lo + c.tid; p < hi2; p += NTHREADS) { LTOK[p] = 0; LDST[p] = 0xFFFFFFFFu; LW[p] = 0.f; } }
    __syncthreads();
    LAS float* scr = (LAS float*)(c.lds + c.wave * 16384);
    const int gw = c.bid * NWAVES + c.wave, NGW = c.G * NWAVES;
#define PLACE_MAKE(i_) place_item_gu(c, l, (i_))
    T_PIPELINE(32 * 256, PLACE_MAKE);
#undef PLACE_MAKE
}

#ifndef ATT_FAST_FOX
#define ATT_FAST_FOX 1
#endif
#ifndef ATT_FAST_MLA
#define ATT_FAST_MLA 1
#endif
#ifndef ATT_FAST_NSA
#define ATT_FAST_NSA 1
#endif
namespace fa {
constexpr int KPITCH = 208, VPITCH = 192;
constexpr int KBUF = 64 * KPITCH, VBUF = 64 * VPITCH;
constexpr int L_K = 0, L_V = 2 * KBUF, L_VD = 4 * KBUF, L_LUT = 131072 + 1024, L_CUM = L_LUT + 8 * 132 * 4, L_PS = 57344, L_F = L_PS + 64 * 132 * 4, L_SEL = L_F + 64 * 132 * 4, L_UNI = L_SEL + 1024, L_TL = L_UNI + 16, L_TLN = L_TL + 128, L_UNIT = L_TLN + 16;
static_assert(L_V + 2 * VBUF <= L_PS && L_VD + 4 * VBUF <= L_SEL && L_UNIT + 64 <= 131072 && L_CUM + 512 <= LDS_BYTES, "attention LDS map: NSA uses K/V slots 0,1 (V at L_V) + the importance tables; dense units use 4 K slots and 4 V slots at L_VD (over the tables, dead then)");
typedef short v4i16_t __attribute__((ext_vector_type(4)));
__device__ __forceinline__ float swap32_max(float v) { auto rr = __builtin_amdgcn_permlane32_swap(__float_as_uint(v), __float_as_uint(v), false, false); return fmaxf(__uint_as_float(rr[0]), __uint_as_float(rr[1])); }
__device__ __forceinline__ float swap32_sum(float v) { auto rr = __builtin_amdgcn_permlane32_swap(__float_as_uint(v), __float_as_uint(v), false, false); return __uint_as_float(rr[0]) + __uint_as_float(rr[1]); }
__device__ __forceinline__ float ex2(float x) { return __builtin_amdgcn_exp2f(x); }

struct KVSrc { const bf16_t* K; int kpitch; const bf16_t* K2; int k2pitch; const bf16_t* V; int vpitch; const float* cum; float cref; };
struct TileRegs { u32x4 k, k2, v; float cm; };
template <bool HAS_K2, bool HAS_CUM>
__device__ __forceinline__ void tile_load(TileRegs& R, const KVSrc& s, int kv0, int tid) {
    const int row = tid >> 3, ch = tid & 7;
    R.k = *(const u32x4*)(s.K + (size_t)(kv0 + row) * s.kpitch + ch * 8);
    R.v = *(const u32x4*)(s.V + (size_t)(kv0 + row) * s.vpitch + ch * 8);
    if constexpr (HAS_K2) { if (tid < 256) R.k2 = *(const u32x4*)(s.K2 + (size_t)(kv0 + (tid >> 2)) * s.k2pitch + (tid & 3) * 8); }
    if constexpr (HAS_CUM) { if (tid < 64) R.cm = s.cum[kv0 + tid]; }
}
template <bool HAS_K2, bool HAS_CUM>
__device__ __forceinline__ void tile_store(const TileRegs& R, LAS unsigned char* lds, int buf, int tid, float cref = 0.f, float cadd = 0.f, int vbase = L_V) {
    const int row = tid >> 3, ch = tid & 7;
    *(LAS u32x4*)(lds + L_K + buf * KBUF + row * KPITCH + ch * 16) = R.k;
    if constexpr (HAS_K2) { if (tid < 256) *(LAS u32x4*)(lds + L_K + buf * KBUF + (tid >> 2) * KPITCH + 128 + (tid & 3) * 16) = R.k2; }
    *(LAS u32x4*)(lds + vbase + buf * VBUF + row * VPITCH + ch * 16) = R.v;
    if constexpr (HAS_CUM) { if (tid < 64) { const float x = cref - (R.cm + cadd); const unsigned hi_ = f2bf(x); const float xl = x - __uint_as_float(hi_ << 16); const unsigned lo_ = f2bf(xl);
            unsigned zz = 0u; asm volatile("" : "+v"(zz)); u32x4 w0; w0.x = hi_ | (lo_ << 16); w0.y = zz; w0.z = zz; w0.w = zz; u32x4 z0; z0.x = zz; z0.y = zz; z0.z = zz; z0.w = zz;
            *(LAS u32x4*)(lds + L_K + buf * KBUF + tid * KPITCH + 128) = w0; *(LAS u32x4*)(lds + L_K + buf * KBUF + tid * KPITCH + 144) = z0; } }
}
template <int NKS>
__device__ __forceinline__ void qk_tile(f32x16 (&st)[2], const LAS unsigned char* lds, int buf, const bf16x8 (&qf)[NKS], int r, int hh, float cval) {
    const LAS unsigned char* kp = lds + L_K + buf * KBUF + r * KPITCH + hh * 16;
    bf16x8 kf[2][NKS];
#pragma unroll
    for (int ks = 0; ks < NKS; ++ks)
#pragma unroll
        for (int rb = 0; rb < 2; ++rb) kf[rb][ks] = *(const LAS bf16x8*)(kp + rb * 32 * KPITCH + ks * 32);
    f32x16 cin;
#pragma unroll
    for (int i = 0; i < 16; ++i) cin[i] = cval;
    __builtin_amdgcn_sched_barrier(0);
    f32x16 a0 = __builtin_amdgcn_mfma_f32_32x32x16_bf16(kf[0][0], qf[0], cin, 0, 0, 0), a1 = __builtin_amdgcn_mfma_f32_32x32x16_bf16(kf[1][0], qf[0], cin, 0, 0, 0);
#pragma unroll
    for (int ks = 1; ks < NKS; ++ks) { a0 = __builtin_amdgcn_mfma_f32_32x32x16_bf16(kf[0][ks], qf[ks], a0, 0, 0, 0); a1 = __builtin_amdgcn_mfma_f32_32x32x16_bf16(kf[1][ks], qf[ks], a1, 0, 0, 0); }
    st[0] = a0; st[1] = a1;
}
__device__ __forceinline__ void pv_tile(f32x16 (&ot)[2], const LAS unsigned char* lds, int buf, const f32x16 (&p)[2], int lane) {
    const int i16 = lane & 15, blk = (lane >> 4) & 1, hh = lane >> 5;
    const LAS unsigned char* vb = lds + L_V + buf * VBUF + (4 * hh + (i16 >> 2)) * VPITCH + 32 * blk + 8 * (i16 & 3);
    v4i16_t lo[4][2], hi[4][2]; bf16x8 pf[4];
#pragma unroll
    for (int q = 0; q < 4; ++q)
#pragma unroll
        for (int db = 0; db < 2; ++db) { const LAS unsigned char* vp = vb + (16 * q) * VPITCH + 64 * db;
            lo[q][db] = __builtin_amdgcn_ds_read_tr16_b64_v4i16((LAS v4i16_t*)vp); hi[q][db] = __builtin_amdgcn_ds_read_tr16_b64_v4i16((LAS v4i16_t*)(vp + 8 * VPITCH)); }
#pragma unroll
    for (int q = 0; q < 4; ++q) { const int rb = q >> 1, s_ = q & 1;
        u32x4 pw; pw.x = cvtpk(p[rb][8 * s_ + 0], p[rb][8 * s_ + 1]); pw.y = cvtpk(p[rb][8 * s_ + 2], p[rb][8 * s_ + 3]); pw.z = cvtpk(p[rb][8 * s_ + 4], p[rb][8 * s_ + 5]); pw.w = cvtpk(p[rb][8 * s_ + 6], p[rb][8 * s_ + 7]);
        pf[q] = __builtin_bit_cast(bf16x8, pw); }
    __builtin_amdgcn_sched_barrier(0);
#pragma unroll
    for (int q = 0; q < 4; ++q)
#pragma unroll
        for (int db = 0; db < 2; ++db) { const bf16x8 vf = {lo[q][db][0], lo[q][db][1], lo[q][db][2], lo[q][db][3], hi[q][db][0], hi[q][db][1], hi[q][db][2], hi[q][db][3]};
            ot[db] = __builtin_amdgcn_mfma_f32_32x32x16_bf16(vf, pf[q], ot[db], 0, 0, 0); }
}
struct VFrags { v4i16_t lo[4][2], hi[4][2]; };
__device__ __forceinline__ void v_read(VFrags& F, const LAS unsigned char* lds, int buf, int lane, int vbase = L_V) {
    const int i16 = lane & 15, blk = (lane >> 4) & 1, hh = lane >> 5;
    const LAS unsigned char* vb = lds + vbase + buf * VBUF + (4 * hh + (i16 >> 2)) * VPITCH + 32 * blk + 8 * (i16 & 3);
#pragma unroll
    for (int q = 0; q < 4; ++q)
#pragma unroll
        for (int db = 0; db < 2; ++db) { const LAS unsigned char* vp = vb + (16 * q) * VPITCH + 64 * db;
            F.lo[q][db] = __builtin_amdgcn_ds_read_tr16_b64_v4i16((LAS v4i16_t*)vp); F.hi[q][db] = __builtin_amdgcn_ds_read_tr16_b64_v4i16((LAS v4i16_t*)(vp + 8 * VPITCH)); }
}
__device__ __forceinline__ void pv_mma(f32x16 (&ot)[2], const VFrags& F, const f32x16 (&p)[2]) {
    bf16x8 pf[4];
#pragma unroll
    for (int q = 0; q < 4; ++q) { const int rb = q >> 1, s_ = q & 1;
        u32x4 pw; pw.x = cvtpk(p[rb][8 * s_ + 0], p[rb][8 * s_ + 1]); pw.y = cvtpk(p[rb][8 * s_ + 2], p[rb][8 * s_ + 3]); pw.z = cvtpk(p[rb][8 * s_ + 4], p[rb][8 * s_ + 5]); pw.w = cvtpk(p[rb][8 * s_ + 6], p[rb][8 * s_ + 7]);
        pf[q] = __builtin_bit_cast(bf16x8, pw); }
    __builtin_amdgcn_sched_barrier(0);
#pragma unroll
    for (int q = 0; q < 4; ++q)
#pragma unroll
        for (int db = 0; db < 2; ++db) { const bf16x8 vf = {F.lo[q][db][0], F.lo[q][db][1], F.lo[q][db][2], F.lo[q][db][3], F.hi[q][db][0], F.hi[q][db][1], F.hi[q][db][2], F.hi[q][db][3]};
            ot[db] = __builtin_amdgcn_mfma_f32_32x32x16_bf16(vf, pf[q], ot[db], 0, 0, 0); }
}
struct SmState { float m, l; };
constexpr float RESC_THR = 8.f;
__device__ __forceinline__ float sm_cval(const SmState& S) { return (S.m == -INFINITY) ? 0.f : -S.m; }
__device__ __forceinline__ float row_max32(const f32x16 (&st)[2]) {
    float mx = fmaxf(st[0][0], st[1][0]);
#pragma unroll
    for (int i = 1; i < 16; ++i) mx = fmaxf(fmaxf(mx, st[0][i]), st[1][i]);
    return swap32_max(mx);
}
typedef float f32x2v __attribute__((ext_vector_type(2)));
template <bool WITH_O>
__device__ __forceinline__ void sm_shift(f32x16 (&st)[2], SmState& S, f32x16 (&ot)[2], float mx) {
    const bool fresh = (S.m == -INFINITY);
    const bool up = fresh ? (mx > -INFINITY) : (mx > RESC_THR);
    if (__any(up)) {
        const float d = up ? mx : 0.f; const float alpha = fresh ? 1.f : ex2(-d);
        S.l *= alpha; S.m = up ? ((fresh ? 0.f : S.m) + d) : S.m;
#pragma unroll
        for (int rb = 0; rb < 2; ++rb)
#pragma unroll
            for (int i = 0; i < 16; ++i) st[rb][i] -= d;
        if constexpr (WITH_O) {
#pragma unroll
            for (int db = 0; db < 2; ++db)
#pragma unroll
                for (int i = 0; i < 16; ++i) ot[db][i] *= alpha; }
    }
}
__device__ __forceinline__ void sm_update(f32x16 (&st)[2], SmState& S, f32x16 (&ot)[2]) {
    sm_shift<true>(st, S, ot, row_max32(st));
    float sum = 0.f;
#pragma unroll
    for (int rb = 0; rb < 2; ++rb)
#pragma unroll
        for (int i = 0; i < 16; ++i) { const float p = ex2(st[rb][i]); st[rb][i] = p; sum += p; }
    S.l += sum;
}
__device__ __forceinline__ void sm_stats(f32x16 (&st)[2], SmState& S) {
    f32x16 dummy[2];
    sm_shift<false>(st, S, dummy, row_max32(st));
    float sum = 0.f;
#pragma unroll
    for (int rb = 0; rb < 2; ++rb)
#pragma unroll
        for (int i = 0; i < 16; ++i) sum += ex2(st[rb][i]);
    S.l += sum;
}
__device__ __forceinline__ void zero_acc(f32x16 (&a)[2]) {
#pragma unroll
    for (int db = 0; db < 2; ++db)
#pragma unroll
        for (int i = 0; i < 16; ++i) a[db][i] = 0.f;
}
__device__ __forceinline__ void store_ot(const f32x16 (&o)[2], float sc, bf16_t* orow, int hh) {
#pragma unroll
    for (int db = 0; db < 2; ++db)
#pragma unroll
        for (int a = 0; a < 4; ++a) { u32x2 w; w.x = cvtpk(o[db][4 * a + 0] * sc, o[db][4 * a + 1] * sc); w.y = cvtpk(o[db][4 * a + 2] * sc, o[db][4 * a + 3] * sc);
            *(u32x2*)(orow + 32 * db + 8 * a + 4 * hh) = w; }
}
#define FA_FOREACH_REG(CODE) _Pragma("unroll") for (int rb = 0; rb < 2; ++rb) _Pragma("unroll") for (int a = 0; a < 4; ++a) _Pragma("unroll") for (int e = 0; e < 4; ++e) { const int i = 4 * a + e; const int kc = 32 * rb + 8 * a + e; (void)kc; CODE }
#define FA_LAUNDER(x) asm volatile("" : "+v"(x))

template <bool IS_MLA>
__device__ __forceinline__ void dense_unit(const Ctx& c, int lyr, int b, int h, int qb) {
    constexpr int NKS = IS_MLA ? 6 : 5;
    const int tid = c.tid, lane = c.lane, r = lane & 31, hh = lane >> 5, w = c.wave;
    LAS unsigned char* lds = c.lds;
    const int q0 = qb * 256, qrow = q0 + 32 * w + r; const size_t mrow = (size_t)b * T + qrow;
    KVSrc src; bf16x8 qf[NKS]; bf16_t* orow;
    if constexpr (IS_MLA) {
        const bf16_t* QB = WSP(bf16_t, WS_QB); const bf16_t* KVB = WSP(bf16_t, WS_KVB);
        src.K = KVB + (size_t)b * T * 1024 + h * 64; src.kpitch = 1024; src.K2 = WSP(bf16_t, WS_KR) + (size_t)b * T * 32; src.k2pitch = 32; src.V = KVB + (size_t)b * T * 1024 + 512 + h * 64; src.vpitch = 1024; src.cum = nullptr; src.cref = 0.f;
#pragma unroll
        for (int ks = 0; ks < 4; ++ks) qf[ks] = *(const bf16x8*)(QB + mrow * 768 + h * 64 + 16 * ks + 8 * hh);
#pragma unroll
        for (int ks = 0; ks < 2; ++ks) qf[4 + ks] = *(const bf16x8*)(QB + mrow * 768 + 512 + h * 32 + 16 * ks + 8 * hh);
        orow = WSP(bf16_t, WS_QB) + mrow * 768 + h * 64;
    } else {
        const bf16_t* P1 = WSP(bf16_t, WS_P1);
        src.K = P1 + (size_t)b * T * P1W + C_FQKV + 512 + h * 64; src.kpitch = P1W; src.K2 = nullptr; src.k2pitch = 0; src.V = P1 + (size_t)b * T * P1W + C_FQKV + 1024 + h * 64; src.vpitch = P1W;
        src.cum = WSP(float, WS_LC) + ((size_t)b * 8 + h) * T;
        { LAS float* cps_ = (LAS float*)(lds + L_CUM); if (tid < 128) cps_[tid] = (WSP(float, WS_CP) + ((size_t)b * 8 + h) * 129)[1 + tid]; }
        src.cref = 0.f;
#pragma unroll
        for (int ks = 0; ks < 4; ++ks) qf[ks] = *(const bf16x8*)(P1 + mrow * P1W + C_FQKV + h * 64 + 16 * ks + 8 * hh);
        { unsigned one2 = hh ? 0u : 0x3F803F80u; asm volatile("" : "+v"(one2)); u32x4 aq; aq.x = one2; aq.y = 0u; aq.z = 0u; aq.w = 0u; qf[4] = __builtin_bit_cast(bf16x8, aq); }
        orow = WSP(bf16_t, WS_P1) + mrow * P1W + C_FQKV + h * 64;
    }
    f32x16 st[2], ot[2]; zero_acc(ot); SmState S{-INFINITY, 0.f};
    const int wlast = (q0 + 32 * w + 31) >> 6;
    constexpr float FOX_SKIP = 40.f;
    float qbound = 0.f, mmin_blk = -INFINITY; LAS float* MM = (LAS float*)(lds + L_UNIT + 16);
    if constexpr (!IS_MLA) {
        float ss = 0.f;
#pragma unroll
        for (int ks = 0; ks < 4; ++ks)
#pragma unroll
            for (int j = 0; j < 8; ++j) { const float x_ = bf2f((bf16_t)qf[ks][j]); ss += x_ * x_; }
        ss = swap32_sum(ss);
        const float km2 = __uint_as_float((WSP(unsigned, WS_CTL) + CW_KMAX)[lyr * 16 + b * 8 + h]);
        qbound = sqrtf(ss * km2) * 1.001f + 0.01f;
    }
    const LAS float* cps = (const LAS float*)(lds + L_CUM);
#define FOX_CP(t_) ((t_) == 0 ? 0.f : cps[(t_) - 1])
    const int nT = 2 * qb + 2;
    TileRegs Ra, Rb;
    tile_load<IS_MLA, !IS_MLA>(Ra, src, 128 * (nT - 1) + 64, tid); tile_load<IS_MLA, !IS_MLA>(Rb, src, 128 * (nT - 1), tid);
    if constexpr (!IS_MLA) { __syncthreads(); src.cref = src.cum[q0] + FOX_CP(4 * qb); }
    tile_store<IS_MLA, !IS_MLA>(Ra, lds, 0, tid, src.cref, IS_MLA ? 0.f : FOX_CP(2 * nT - 1), L_VD); tile_store<IS_MLA, !IS_MLA>(Rb, lds, 1, tid, src.cref, IS_MLA ? 0.f : FOX_CP(2 * nT - 2), L_VD);
    if (nT > 1) { tile_load<IS_MLA, !IS_MLA>(Ra, src, 128 * (nT - 2) + 64, tid); tile_load<IS_MLA, !IS_MLA>(Rb, src, 128 * (nT - 2), tid); }
    __syncthreads();
    for (int it = 0; it < nT; ++it) { const int Tt = nT - 1 - it, sb = 2 * (it & 1);
        if constexpr (!IS_MLA) { if (it >= 2 && (src.cref - cps[2 * Tt + 1]) < mmin_blk - FOX_SKIP) break; }
#pragma unroll
        for (int sub = 1; sub >= 0; --sub) { const int t = 2 * Tt + sub, buf = sb + (1 - sub), kv0 = 64 * t;
            if (t <= wlast) {
                qk_tile<NKS>(st, lds, buf, qf, r, hh, sm_cval(S));
                if (kv0 + 63 > q0 + 32 * w) { int lim = qrow - kv0 - 4 * hh; FA_LAUNDER(lim); FA_FOREACH_REG({ if (kc > lim) st[rb][i] = -INFINITY; }) }
                VFrags VF; v_read(VF, lds, buf, lane, L_VD);
                __builtin_amdgcn_sched_barrier(0);
                sm_update(st, S, ot);
                pv_mma(ot, VF, st);
            } }
        if constexpr (!IS_MLA) { if (it == 1) { const float v_ = -wave_max(-(S.m - qbound)); if (lane == 0) MM[w] = v_; } }
        if (it + 1 < nT) { tile_store<IS_MLA, !IS_MLA>(Ra, lds, sb ^ 2, tid, src.cref, IS_MLA ? 0.f : FOX_CP(2 * Tt - 1), L_VD); tile_store<IS_MLA, !IS_MLA>(Rb, lds, (sb ^ 2) + 1, tid, src.cref, IS_MLA ? 0.f : FOX_CP(2 * Tt - 2), L_VD);
            if (it + 2 < nT) { tile_load<IS_MLA, !IS_MLA>(Ra, src, 128 * (Tt - 2) + 64, tid); tile_load<IS_MLA, !IS_MLA>(Rb, src, 128 * (Tt - 2), tid); } }
        __syncthreads();
        if constexpr (!IS_MLA) { if (it == 1) { float mm_ = MM[0];
#pragma unroll
            for (int q_ = 1; q_ < 8; ++q_) mm_ = fminf(mm_, MM[q_]);
            mmin_blk = mm_; } }
    }
    const float lt = swap32_sum(S.l);
    store_ot(ot, 1.f / lt, orow, hh);
}

#define FA_STREAM(SRC, NT, TILE_EXPR, BODY) do { TileRegs R_; const int nt_ = (NT); \
    if (nt_ > 0) { { const int idx = 0; tile_load<false, false>(R_, SRC, 64 * (TILE_EXPR), tid); } tile_store<false, false>(R_, lds, 0, tid); \
      if (nt_ > 1) { const int idx = 1; tile_load<false, false>(R_, SRC, 64 * (TILE_EXPR), tid); } \
      __syncthreads(); \
      for (int it_ = 0; it_ < nt_; ++it_) { const int buf = it_ & 1; int tile; { const int idx = it_; tile = (TILE_EXPR); } \
          BODY \
          if (it_ + 1 < nt_) { tile_store<false, false>(R_, lds, buf ^ 1, tid); if (it_ + 2 < nt_) { const int idx = it_ + 2; tile_load<false, false>(R_, SRC, 64 * (TILE_EXPR), tid); } } \
          __syncthreads(); } } } while (0)

__device__ __forceinline__ void nsa_unit(const Ctx& c, int b, int g, int j) {
    const int tid = c.tid, lane = c.lane, r = lane & 31, hh = lane >> 5, w = c.wave;
    LAS unsigned char* lds = c.lds;
    const int t0 = 64 * j, tl = r >> 2, hp = r & 3, tokl = 8 * w + tl, tq = t0 + tokl, head = 4 * g + hp; const size_t mrow = (size_t)b * T + tq;
    const bf16_t* P1 = WSP(bf16_t, WS_P1);
    bf16x8 qf[4];
#pragma unroll
    for (int ks = 0; ks < 4; ++ks) qf[ks] = *(const bf16x8*)(P1 + mrow * P1W + C_NQ + head * 64 + 16 * ks + 8 * hh);
    const float gc = sigmoidf_(bf2f(P1[mrow * P1W + C_NG + head * 3 + 0])), gsl = sigmoidf_(bf2f(P1[mrow * P1W + C_NG + head * 3 + 1])), gwn = sigmoidf_(bf2f(P1[mrow * P1W + C_NG + head * 3 + 2]));
    const LAS float* lutL = (const LAS float*)(lds + L_LUT) + head * 132;
    LAS float* PS = (LAS float*)(lds + L_PS); LAS float* FM = (LAS float*)(lds + L_F); LAS unsigned* SEL = (LAS unsigned*)(lds + L_SEL); LAS unsigned* UNI = (LAS unsigned*)(lds + L_UNI);
    LAS unsigned char* TL = (LAS unsigned char*)(lds + L_TL); LAS int* TLN = (LAS int*)(lds + L_TLN);
    f32x16 st[2], ot[2], otot[2]; zero_acc(otot);
    { float zz_ = 0.f; asm volatile("" : "+v"(zz_)); const f32x4 z4 = {zz_, zz_, zz_, zz_}; for (int i = tid; i < 2 * 64 * 132 / 4; i += NTHREADS) ((LAS f32x4*)PS)[i] = z4; }
    if (tid < 256) SEL[tid] = 0u; if (tid < 4) UNI[tid] = 0u;
    const float bfar = lutL[128];
    const int tmin = t0 + 8 * w;
    const int n_ok_max = ((t0 + 63 - 31) >> 4) + 1; const int nct = (n_ok_max + 63) >> 6;
    KVSrc srcc; srcc.K = WSP(bf16_t, WS_KC) + (size_t)(b * 2 + g) * 512 * 64; srcc.kpitch = 64; srcc.K2 = nullptr; srcc.k2pitch = 0; srcc.V = WSP(bf16_t, WS_VC) + (size_t)(b * 2 + g) * 512 * 64; srcc.vpitch = 64; srcc.cum = nullptr; srcc.cref = 0.f;
    SmState Sc{-INFINITY, 0.f};
    FA_STREAM(srcc, nct, idx, {
        const bool farc = (16 * (64 * tile + 63) + 31 + 128 <= tmin);
        qk_tile<4>(st, lds, buf, qf, r, hh, sm_cval(Sc) + (farc ? bfar : 0.f));
        if (!farc) { int db_ = tq - 31 - 1024 * tile - 64 * hh; FA_LAUNDER(db_); FA_FOREACH_REG({ const int dist = db_ - 16 * kc; const float s_ = st[rb][i] + lutL[dist < 0 ? 0 : (dist > 128 ? 128 : dist)]; st[rb][i] = dist < 0 ? -INFINITY : s_; }) }
        sm_stats(st, Sc); });
    { const float lt = swap32_sum(Sc.l); const float inv = lt > 0.f ? 1.f / lt : 0.f; const float msafe = (Sc.m == -INFINITY) ? 0.f : Sc.m;
      zero_acc(ot);
      FA_STREAM(srcc, nct, idx, {
        const bool farc = (16 * (64 * tile + 63) + 31 + 128 <= tmin);
        qk_tile<4>(st, lds, buf, qf, r, hh, (farc ? bfar : 0.f) - msafe);
        if (farc) { FA_FOREACH_REG({ st[rb][i] = ex2(st[rb][i]) * inv; }) }
        else { int db_ = tq - 31 - 1024 * tile - 64 * hh; FA_LAUNDER(db_); FA_FOREACH_REG({ const int dist = db_ - 16 * kc; const float s_ = st[rb][i] + lutL[dist < 0 ? 0 : (dist > 128 ? 128 : dist)]; st[rb][i] = dist < 0 ? 0.f : ex2(s_) * inv; }) }
_Pragma("unroll")
        for (int rb = 0; rb < 2; ++rb)
_Pragma("unroll")
            for (int a = 0; a < 4; ++a) { float q4[4];
_Pragma("unroll")
                for (int e = 0; e < 4; ++e) { float v = st[rb][4 * a + e]; v += dpp_f<0xB1>(v); v += dpp_f<0x4E>(v); q4[e] = v; }
                if (hp == 0) { const int G = 16 * tile + 8 * rb + 2 * a + hh; PS[tokl * 132 + G] = q4[0] + 2.f * (q4[1] + q4[2] + q4[3]); FM[tokl * 132 + G] = q4[0]; } }
        pv_tile(ot, lds, buf, st, lane); });
#pragma unroll
      for (int db = 0; db < 2; ++db)
#pragma unroll
          for (int i = 0; i < 16; ++i) otot[db][i] += gc * ot[db][i]; }
    if (j + 1 <= 16) { if (tid < 64) SEL[tid * 4] = (1u << (j + 1)) - 1u; if (tid == 0) UNI[0] = (1u << (j + 1)) - 1u; }
    else {
        const int tk = tid >> 3, sub = tid & 7; unsigned bits[4] = {1u, 0u, 0u, 0u};
        float cv[16];
#pragma unroll
        for (int k = 0; k < 16; ++k) { const int G = sub + 8 * k; cv[k] = (G >= 1 && G <= j - 2) ? PS[tk * 132 + G] + FM[tk * 132 + G + 1] : -INFINITY; }
#pragma unroll 1
        for (int round = 0; round < 13; ++round) {
            float bv = cv[0]; int bk = 0;
#pragma unroll
            for (int k = 1; k < 16; ++k) { const bool gt = cv[k] > bv; bv = gt ? cv[k] : bv; bk = gt ? k : bk; }
            int bG = sub + 8 * bk;
#define ARGMAX_STEP(CTRL) { const float ov = dpp_f<CTRL>(bv); const int oG = __builtin_amdgcn_update_dpp(0, bG, CTRL, 0xf, 0xf, true); const bool take = (ov > bv) || (ov == bv && oG < bG); bv = take ? ov : bv; bG = take ? oG : bG; }
            ARGMAX_STEP(0xB1) ARGMAX_STEP(0x4E) ARGMAX_STEP(0x141)
#undef ARGMAX_STEP
            const int wk = bG >> 3; const bool own = (bG & 7) == sub;
#pragma unroll
            for (int k = 0; k < 16; ++k) cv[k] = (own && k == wk) ? -INFINITY : cv[k];
            { const unsigned bit_ = 1u << (bG & 31); const int wq_ = bG >> 5; bits[0] |= (wq_ == 0) ? bit_ : 0u; bits[1] |= (wq_ == 1) ? bit_ : 0u; bits[2] |= (wq_ == 2) ? bit_ : 0u; bits[3] |= (wq_ == 3) ? bit_ : 0u; }
        }
        { const int G = j; const unsigned bit_ = 1u << (G & 31); const int wq_ = G >> 5; bits[0] |= (wq_ == 0) ? bit_ : 0u; bits[1] |= (wq_ == 1) ? bit_ : 0u; bits[2] |= (wq_ == 2) ? bit_ : 0u; bits[3] |= (wq_ == 3) ? bit_ : 0u; }
        { const int G = j - 1; const unsigned bit_ = 1u << (G & 31); const int wq_ = G >> 5; bits[0] |= (wq_ == 0) ? bit_ : 0u; bits[1] |= (wq_ == 1) ? bit_ : 0u; bits[2] |= (wq_ == 2) ? bit_ : 0u; bits[3] |= (wq_ == 3) ? bit_ : 0u; }
        if (sub == 0) {
#pragma unroll
            for (int q = 0; q < 4; ++q) { SEL[tk * 4 + q] = bits[q]; if (bits[q]) atomicOr((unsigned*)(UNI + q), bits[q]); } }
    }
    __syncthreads();
    if (tid < 128) { const unsigned u0 = UNI[0], u1 = UNI[1], u2 = UNI[2], u3 = UNI[3]; const int wq_ = tid >> 5, bp = tid & 31;
        const unsigned mw_ = wq_ == 0 ? u0 : wq_ == 1 ? u1 : wq_ == 2 ? u2 : u3;
        if ((mw_ >> bp) & 1u) { const int pos = (wq_ > 0 ? __builtin_popcount(u0) : 0) + (wq_ > 1 ? __builtin_popcount(u1) : 0) + (wq_ > 2 ? __builtin_popcount(u2) : 0) + __builtin_popcount(mw_ & ((1u << bp) - 1u)); TL[pos] = (unsigned char)tid; }
        if (tid == 0) TLN[0] = __builtin_popcount(u0) + __builtin_popcount(u1) + __builtin_popcount(u2) + __builtin_popcount(u3); }
    __syncthreads();
    const unsigned msk0 = SEL[tokl * 4 + 0], msk1 = SEL[tokl * 4 + 1], msk2 = SEL[tokl * 4 + 2], msk3 = SEL[tokl * 4 + 3];
    const int nsel = __builtin_amdgcn_readfirstlane(TLN[0]);
    { KVSrc srcs; srcs.K = P1 + (size_t)b * T * P1W + C_NKV + ((1 * 2 + 0) * 2 + g) * 64; srcs.kpitch = P1W; srcs.K2 = nullptr; srcs.k2pitch = 0; srcs.V = P1 + (size_t)b * T * P1W + C_NKV + ((1 * 2 + 1) * 2 + g) * 64; srcs.vpitch = P1W; srcs.cum = nullptr; srcs.cref = 0.f;
      SmState Ss{-INFINITY, 0.f}; zero_acc(ot);
      FA_STREAM(srcs, nsel, (int)TL[idx], {
        const int wq = tile >> 5; const unsigned mw = wq == 0 ? msk0 : wq == 1 ? msk1 : wq == 2 ? msk2 : msk3; const bool mine = (mw >> (tile & 31)) & 1u;
        if (__any(mine)) {
            const bool fars = (64 * tile + 63 + 128 <= tmin);
            qk_tile<4>(st, lds, buf, qf, r, hh, mine ? sm_cval(Ss) + (fars ? bfar : 0.f) : -INFINITY);
            if (!fars) { int db_ = tq - 64 * tile - 4 * hh; FA_LAUNDER(db_); FA_FOREACH_REG({ const int dist = db_ - kc; const float s_ = st[rb][i] + lutL[dist < 0 ? 0 : (dist > 128 ? 128 : dist)]; st[rb][i] = (dist >= 0) ? s_ : -INFINITY; }) }
            VFrags VF; v_read(VF, lds, buf, lane); __builtin_amdgcn_sched_barrier(0);
            sm_update(st, Ss, ot);
            pv_mma(ot, VF, st); } });
      const float lt = swap32_sum(Ss.l); const float sc = lt > 0.f ? gsl / lt : 0.f;
#pragma unroll
      for (int db = 0; db < 2; ++db)
#pragma unroll
          for (int i = 0; i < 16; ++i) otot[db][i] += sc * ot[db][i]; }
    { KVSrc srcw; srcw.K = P1 + (size_t)b * T * P1W + C_NKV + ((2 * 2 + 0) * 2 + g) * 64; srcw.kpitch = P1W; srcw.K2 = nullptr; srcw.k2pitch = 0; srcw.V = P1 + (size_t)b * T * P1W + C_NKV + ((2 * 2 + 1) * 2 + g) * 64; srcw.vpitch = P1W; srcw.cum = nullptr; srcw.cref = 0.f;
      const int jlo = j - 8 > 0 ? j - 8 : 0;
      SmState Sw{-INFINITY, 0.f}; zero_acc(ot);
      FA_STREAM(srcw, j - jlo + 1, jlo + idx, {
        qk_tile<4>(st, lds, buf, qf, r, hh, sm_cval(Sw));
        { int db_ = tq - 64 * tile - 4 * hh; FA_LAUNDER(db_); FA_FOREACH_REG({ const int dist = db_ - kc; const float s_ = st[rb][i] + lutL[dist < 0 ? 0 : (dist > 128 ? 128 : dist)]; st[rb][i] = (dist >= 0 && dist < 512) ? s_ : -INFINITY; }) }
        VFrags VF; v_read(VF, lds, buf, lane); __builtin_amdgcn_sched_barrier(0);
        sm_update(st, Sw, ot);
        pv_mma(ot, VF, st); });
      const float lt = swap32_sum(Sw.l); const float sc = lt > 0.f ? gwn / lt : 0.f;
#pragma unroll
      for (int db = 0; db < 2; ++db)
#pragma unroll
          for (int i = 0; i < 16; ++i) otot[db][i] += sc * ot[db][i]; }
    store_ot(otot, 1.f, WSP(bf16_t, WS_P1) + mrow * P1W + C_NQ + head * 64, hh);
}
}

__device__ __forceinline__ int next_unit(const Ctx& c, unsigned* ctr) {
    LAS int* u = (LAS int*)(c.lds + fa::L_UNIT);
    __syncthreads();
    if (c.tid == 0) u[0] = (int)__hip_atomic_fetch_add(ctr, 1u, __ATOMIC_RELAXED, __HIP_MEMORY_SCOPE_AGENT);
    __syncthreads();
    return __builtin_amdgcn_readfirstlane(u[0]);
}
__device__ __forceinline__ void phase_att_fast(const Ctx& c0, int l) {
    Ctx c = c0;
    unsigned* ctr0 = WSP(unsigned, WS_CTL) + CW_QUEUE + 64 * 8 * l;
    { const float* lut = WSP(float, WS_TAB) + 512; LAS float* L_ = (LAS float*)(c.lds + fa::L_LUT); for (int i = c.tid; i < 8 * 132; i += NTHREADS) L_[i] = lut[i]; }
    const int myx = (int)(xb_xcc_id() & 7u);
    for (int qi = 0; qi < 8; ++qi) {
        const int x = (myx + qi) & 7;
        for (;;) {
            const int u = next_unit(c, ctr0 + 64 * x);
            if (u >= 192) break;
            relaunder(c);
            const int sidx = u >> 5, k = u & 31;
            if (sidx == 0 || sidx == 3) { const int p = 2 * x + (sidx == 3); if (ATT_FAST_MLA) fa::dense_unit<true>(c, l & 1, p >> 3, p & 7, 31 - k); }
            else if (sidx == 1 || sidx == 4) { const int p = 2 * x + (sidx == 4); if (ATT_FAST_FOX) fa::dense_unit<false>(c, l & 1, p >> 3, p & 7, 31 - k); }
            else { const int n = (sidx == 5 ? 32 : 0) + k, grp = x >> 1; if (ATT_FAST_NSA) fa::nsa_unit(c, grp >> 1, grp & 1, 127 - 2 * n - (x & 1)); }
        }
    }
}

struct Args { const void* in[32]; float* out; unsigned char* ws; int l_lo, l_hi; };
constexpr int PH_PER_LAYER = 15, K_FINAL = 1 + PH_PER_LAYER;
template <int KIND>
__global__ void __launch_bounds__(NTHREADS, 2) fwd_kernel(Args a) {
    extern __shared__ __attribute__((aligned(16))) unsigned char lds_raw[];
    Ctx c;
    c.out = a.out; c.ws = a.ws; c.ws0 = a.ws; c.lds = (LAS unsigned char*)lds_raw;
    c.tid = threadIdx.x; c.lane = c.tid & 63; c.wave = __builtin_amdgcn_readfirstlane(c.tid >> 6); c.G = gridDim.x; c.bid = blockIdx.x;
    if (c.tid < 4) ((LAS unsigned*)(c.lds + LDS_MISC))[c.tid] = 0u;
    if (c.tid < 32) { const unsigned long long pv = (unsigned long long)a.in[c.tid]; ((LAS unsigned*)(c.lds + LDS_INTAB))[2 * c.tid] = (unsigned)pv; ((LAS unsigned*)(c.lds + LDS_INTAB))[2 * c.tid + 1] = (unsigned)(pv >> 32); }
    __syncthreads();
    XcdBarrier bar; bar.bar = WSP(unsigned, WS_CTL) + CW_BAR; bar.x = 0; bar.st = nullptr;
    if constexpr (KIND < 0) bar = xcd_barrier_post(WSP(unsigned, WS_CTL) + CW_BAR, (volatile LAS unsigned*)(c.lds + LDS_MISC));
#define IN(k) ((KIND < 0 || KIND == (k)) && (relaunder(c), true))
#define REP(p) for (int rep_ = 0; rep_ < ((PROBE_DOUBLE == (p)) ? 2 : 1); ++rep_)
#define SEAM(k) do { if constexpr (KIND < 0) { unsigned* bb_ = bar.bar; asm volatile("" : "+s"(bb_)); bar.bar = bb_; xcd_barrier(bar); } } while (0)
    LAS unsigned char* ring = c.lds;

    if (IN(0)) REP(4) { phase_prologue(c); } SEAM(0);
    for (int l = a.l_lo; l < a.l_hi; ++l) {
        constexpr int pb = 1;
        const float* resid = (l == 0) ? c.x() : WSP(float, WS_XA);
        if (IN(pb + 0)) { if (l == 0) phase_norm(c, c.x(), nullptr, nullptr, nullptr, WSP(bf16_t, WS_H0));
                          else phase_norm(c, WSP(float, WS_XA), WSP(bf16_t, WS_Y), WSP(bf16_t, WS_Y) + (size_t)M * D, WSP(float, WS_XA), WSP(bf16_t, WS_H0));
        } SEAM(pb + 0);
        if (IN(pb + 1)) REP(2) { pg8::Cfg g{(unsigned)(D * 2), 128u, (unsigned)(D * 2), D / 64, nullptr}; pg8::DenseOrder S; S.init(M / 256, NCAT / 256, c.G, c.bid, WSP(bf16_t, WS_H0), (size_t)256 * D * 2, WSP(bf16_t, WS_WINT) + (size_t)l * NCAT * D, (size_t)256 * D * 2);
            EpiInprojGates E{WSP(bf16_t, WS_P1), WSP(unsigned char, WS_GATES), c.b_merge() + l * 3072}; pg8::gemm_phase<false>(ring, c.wave, g, S, E);
            if (l == 0) {
                int nfull = (M / 256) * (NCAT / 256) - 6 * c.G; if (nfull < 0 || nfull >= c.G) nfull = 0;
                relaunder(c);
                LAS float* scr = (LAS float*)(c.lds + c.wave * 16384); const int NGW = (c.G - nfull) * NWAVES; const int gw = (c.bid >= nfull) ? (c.bid - nfull) * NWAVES + c.wave : 0x3fffffff;
#define DEF_MAKE(i_) prologue_item(c, (PI_WIN + PI_WM) + (i_))
                T_SIMPLE(NL * PI_PER_L - (PI_WIN + PI_WM), DEF_MAKE);
#undef DEF_MAKE
            } } SEAM(pb + 1);
        if (IN(pb + 2)) {
            const bool split = c.G >= 64;
            if (!split || c.bid < c.G - 32) phase_prep(c, l, c.bid, split ? c.G - 32 : c.G);
            if (!split || c.bid >= c.G - 32) { pg8::Cfg g{(unsigned)(16 * P1W * 2), (unsigned)(P1W * 2), 4096u, 16, nullptr};
                CmpOrder S{split ? 32 : c.G, split ? c.bid - (c.G - 32) : c.bid, (const char*)WSP(bf16_t, WS_P1), (const char*)(WSP(bf16_t, WS_WC1T) + (size_t)l * 2 * 256 * 2048)};
                EpiCmpSlab E{WSP(float, WS_SL)}; pg8::gemm_phase<false>(ring, c.wave, g, S, E); }
        } SEAM(pb + 2);
        if (IN(pb + 3)) REP(2) {
            phase_cmp2(c, l); phase_chunk_prefix(c);
            { pg8::Cfg g{(unsigned)(P1W * 2), 128u, 512u, 4, nullptr}; pg8::DenseOrder S; S.init(M / 256, 2, c.G, c.bid, WSP(bf16_t, WS_P1) + C_CQ, (size_t)256 * P1W * 2, WSP(bf16_t, WS_WUQT) + (size_t)l * 768 * 256, (size_t)256 * 512);
              EpiStoreBf16 E{WSP(bf16_t, WS_QB), 768, WSP(float, WS_RSTD), 2}; pg8::gemm_phase<false>(ring, c.wave, g, S, E); }
            { pg8::Cfg g{(unsigned)(P1W * 2), 128u, 512u, 4, nullptr}; pg8::DenseOrder S; S.init(M / 256, 1, c.G, (c.bid + 128) % c.G, WSP(bf16_t, WS_P1) + C_CQ, (size_t)256 * P1W * 2, WSP(bf16_t, WS_WUQT) + (size_t)l * 768 * 256 + (size_t)512 * 256, (size_t)256 * 512);
              EpiUqRope E{WSP(bf16_t, WS_QB) + 512, WSP(float, WS_RSTD), WSP(float, WS_ROPE), WSP(float, WS_ROPE) + (size_t)M * 16}; pg8::gemm_phase<false>(ring, c.wave, g, S, E); }
            { pg8::Cfg g{(unsigned)(P1W * 2), 128u, 256u, 2, nullptr}; pg8::DenseOrder S; S.init(M / 256, 4, c.G, c.bid, WSP(bf16_t, WS_P1) + C_CKV, (size_t)256 * P1W * 2, WSP(bf16_t, WS_WUKVT) + (size_t)l * 1024 * 128, (size_t)256 * 256);
              EpiStoreBf16 E{WSP(bf16_t, WS_KVB), 1024, WSP(float, WS_RSTD) + 1, 2}; pg8::gemm_phase<false>(ring, c.wave, g, S, E); }
        } SEAM(pb + 3);
        if (IN(pb + 6)) { phase_att_fast(c, l);
#if PROBE_DOUBLE == 1
            phase_att_fast(c, l + 2);
#endif
        } SEAM(pb + 6);
        if (IN(pb + 9)) REP(2) {
            pg8::Cfg g{(unsigned)(P1W * 2), 128u, 1024u, 8, nullptr};
            OutprojOrder S{c.G, c.bid, (const char*)c.ws, (long long)(WS_P1 + C_NQ * 2), (long long)WS_QB - (long long)(WS_P1 + C_NQ * 2), (long long)(C_FQKV - C_NQ) * 2, (const char*)(WSP(bf16_t, WS_WOT) + (size_t)l * 3 * 1024 * 512), (unsigned)(P1W * 2), 768u * 2u};
            EpiOutproj E{WSP(bf16_t, WS_MIXED), WSP(unsigned char, WS_GATES)}; pg8::gemm_phase<false>(ring, c.wave, g, S, E);
        } SEAM(pb + 9);
        if (IN(pb + 10)) { pg8::Cfg g{(unsigned)(D * 2), 128u, (unsigned)(D * 2), D / 64, nullptr}; pg8::DenseOrder S; S.init(M / 256, 4, c.G, c.bid, WSP(bf16_t, WS_MIXED), (size_t)256 * D * 2, WSP(bf16_t, WS_WOUTT) + (size_t)l * D * D, (size_t)256 * D * 2);
            EpiWout E{resid, WSP(float, WS_XA)}; pg8::gemm_phase<false>(ring, c.wave, g, S, E);
        } SEAM(pb + 10);
        if (IN(pb + 11)) { phase_router(c, l);
#if PROBE_DOUBLE == 3
            phase_router(c, l, 1);
#endif
        } SEAM(pb + 11);
        if (IN(pb + 12)) REP(4) { phase_place(c, l); } SEAM(pb + 12);
        if (IN(pb + 13)) REP(2) { LAS int* tab = (LAS int*)(c.lds + LDS_MOETAB); moe_tables(c, l, tab);
            pg8::Cfg g{(unsigned)(D * 2), 128u, (unsigned)(D * 2), D / 64, WSP(int, WS_LTOK)}; MoeOrder S{c.G, c.bid, 2, tab, (const char*)WSP(bf16_t, WS_H2), 0, (const char*)WSP(bf16_t, WS_WGU), (size_t)512 * D * 2, (size_t)256 * D * 2};
            EpiMoe1 E{WSP(bf16_t, WS_HID), WSP(float, WS_LW)}; pg8::gemm_phase<true>(ring, c.wave, g, S, E);
            { const int nun = __builtin_amdgcn_readfirstlane(tab[32]) * 2; int n2 = nun - c.G; if (n2 < 0) n2 = 0; if (n2 >= c.G) n2 = 0;
              if (c.bid >= n2) { relaunder(c); LAS float* scr = (LAS float*)(c.lds + c.wave * 16384); const int gw = (c.bid - n2) * NWAVES + c.wave, NGW = (c.G - n2) * NWAVES;
#define DN_MAKE(i_) place_item_dn(c, l, (i_))
                  T_SIMPLE(32 * 128, DN_MAKE);
#undef DN_MAKE
              } }
        } SEAM(pb + 13);
        if (IN(pb + 14)) REP(2) { LAS int* tab = (LAS int*)(c.lds + LDS_MOETAB); moe_tables(c, l, tab);
            pg8::Cfg g{512u, 128u, 512u, 4, nullptr}; MoeOrder S{c.G, c.bid, 4, tab, (const char*)WSP(bf16_t, WS_HID), 512, (const char*)WSP(bf16_t, WS_WDT), (size_t)D * 256 * 2, (size_t)256 * 256 * 2};
            EpiMoe2 E{WSP(bf16_t, WS_Y), WSP(unsigned, WS_LSLOT)}; pg8::gemm_phase<false>(ring, c.wave, g, S, E); } SEAM(pb + 14);
    }
    if (IN(K_FINAL)) REP(6) { phase_final(c); }
#undef IN
#undef SEAM
}

template <int KIND> static bool prep_kernel() { return hipFuncSetAttribute((const void*)fwd_kernel<KIND>, hipFuncAttributeMaxDynamicSharedMemorySize, LDS_BYTES) == hipSuccess; }
template <int KIND> static void launch_kind(int grid, hipStream_t stream, Args a, int l) { a.l_lo = l; a.l_hi = l + 1; hipLaunchKernelGGL(fwd_kernel<KIND>, dim3(grid), dim3(NTHREADS), LDS_BYTES, stream, a); }
extern "C" void kernel_launch(void* const* d_in, const int* in_sizes, int n_in, void* d_out, int out_size, void* d_ws, size_t ws_size, hipStream_t stream) {
    static int grid = 0;
    if (grid == 0) {
        if (n_in != 32 || ws_size < WS_END) { fprintf(stderr, "kernel_launch: n_in %d ws %zu (need %zu)\n", n_in, ws_size, (size_t)WS_END); grid = -1; return; }
        int dev = 0, cus = 0;
        if (hipGetDevice(&dev) != hipSuccess || hipDeviceGetAttribute(&cus, hipDeviceAttributeMultiprocessorCount, dev) != hipSuccess) { grid = -1; return; }
        bool ok = true;
#if MK_ONE_LAUNCH
        ok = prep_kernel<-1>();
#else
        ok = prep_kernel<0>() && prep_kernel<1>() && prep_kernel<2>() && prep_kernel<3>() && prep_kernel<4>() && prep_kernel<5>() && prep_kernel<6>() && prep_kernel<7>() && prep_kernel<8>() && prep_kernel<9>()
          && prep_kernel<10>() && prep_kernel<11>() && prep_kernel<12>() && prep_kernel<13>() && prep_kernel<14>() && prep_kernel<15>() && prep_kernel<16>();
#endif
        if (!ok) { grid = -1; return; }
        (void)hipGetLastError();
        grid = cus;
    }
    if (grid < 0) return;
    (void)hipMemsetAsync((char*)d_ws + WS_CTL, 0, CTL_BYTES, stream);
    Args a{};
    for (int i = 0; i < 32; ++i) a.in[i] = d_in[i];
    a.out = (float*)d_out; a.ws = (unsigned char*)d_ws;
#if MK_ONE_LAUNCH
    a.l_lo = 0; a.l_hi = NL;
    hipLaunchKernelGGL(fwd_kernel<-1>, dim3(grid), dim3(NTHREADS), LDS_BYTES, stream, a);
#else
    launch_kind<0>(grid, stream, a, 0);
    for (int l = 0; l < NL; ++l) {
        launch_kind<1>(grid, stream, a, l); launch_kind<2>(grid, stream, a, l); launch_kind<3>(grid, stream, a, l); launch_kind<4>(grid, stream, a, l); launch_kind<5>(grid, stream, a, l);
        launch_kind<6>(grid, stream, a, l); launch_kind<7>(grid, stream, a, l); launch_kind<8>(grid, stream, a, l); launch_kind<9>(grid, stream, a, l); launch_kind<10>(grid, stream, a, l);
        launch_kind<11>(grid, stream, a, l); launch_kind<12>(grid, stream, a, l); launch_kind<13>(grid, stream, a, l); launch_kind<14>(grid, stream, a, l); launch_kind<15>(grid, stream, a, l);
    }
    launch_kind<16>(grid, stream, a, 0);
#endif
}
```

```cpp
#include <hip/hip_runtime.h>
#include <stdint.h>
#include <cstdio>

#ifndef PROBE_DOUBLE
#define PROBE_DOUBLE 0
#endif
#ifndef MK_ONE_LAUNCH
#define MK_ONE_LAUNCH 1
#endif

#define LAS __attribute__((address_space(3)))
typedef unsigned short bf16_t;
typedef short bf16x8 __attribute__((ext_vector_type(8)));
typedef float f32x4 __attribute__((ext_vector_type(4)));
typedef float f32x16 __attribute__((ext_vector_type(16)));
typedef unsigned u32x4 __attribute__((ext_vector_type(4)));
typedef unsigned u32x2 __attribute__((ext_vector_type(2)));

constexpr int NB = 2, T = 8192, D = 1024, M = NB * T, NL = 2;
constexpr int DIN = 6336;
constexpr int P1W = 3328;
constexpr int C_NQ = 0, C_NKV = 512, C_CQ = 1280, C_CKV = 1536, C_KR = 1664, C_NG = 1696, C_FF = 1720, C_FQKV = 1728;
constexpr int NEXP = 32, EDIM = 256;
constexpr float EPS = 1e-6f;
constexpr float LOG2E = 1.4426950408889634f;
constexpr float QSCALE64 = 0.125f * LOG2E, QSCALE96 = 0.10206207261596575f * LOG2E;
constexpr int NTHREADS = 512, NWAVES = 8;
constexpr int LDS_BYTES = 147456;
constexpr int MOE_MAXROWS = 40960;

constexpr size_t MiB = 1u << 20;
constexpr size_t WS_CTL = 0;
constexpr size_t CTL_BYTES = 1 * MiB;
constexpr int CW_BAR = 4096;
constexpr int CW_QUEUE = 16384;
constexpr int CW_MOECNT = 32768;
constexpr int CW_KMAX = 24576;
constexpr int CW_CNTB = 65536;
constexpr size_t CTL_LTOK = 512 * 1024;
constexpr size_t WS_WINT = 1 * MiB;
constexpr int NCAT = 6400;
constexpr size_t WS_WUQT = 26 * MiB;
constexpr size_t WS_WUKVT = 27 * MiB;
constexpr size_t WS_WOT = 28 * MiB;
constexpr size_t WS_WOUTT = 34 * MiB;
constexpr size_t WS_WC1T = 38 * MiB;
constexpr size_t WS_ROPE = 42 * MiB;
constexpr size_t WS_TAB = 44 * MiB;
constexpr size_t WS_XA = 45 * MiB;
constexpr size_t PB = 109 * MiB;
constexpr size_t WS_P1 = PB;
constexpr size_t WS_QB = PB + 104 * MiB;
constexpr size_t WS_KVB = PB + 128 * MiB;
constexpr size_t WS_H0 = PB + 128 * MiB;
constexpr size_t WS_GATES = PB + 160 * MiB;
constexpr size_t WS_SM = PB + 208 * MiB;
constexpr size_t WS_RSTD = WS_SM;
constexpr size_t WS_KR = WS_SM + 256 * 1024;
constexpr size_t WS_LF = WS_SM + 1280 * 1024;
constexpr size_t WS_CUM = WS_SM + 1792 * 1024;
constexpr size_t WS_SL = WS_SM + 2304 * 1024;
constexpr size_t WS_KC = WS_SM + 6400 * 1024;
constexpr size_t WS_VC = WS_SM + 6656 * 1024;
constexpr size_t WS_REC = WS_SM + 6912 * 1024;
constexpr size_t WS_LTOK = WS_SM + 7424 * 1024;
constexpr size_t WS_LW = WS_SM + 7616 * 1024;
constexpr size_t WS_LSLOT = WS_SM + 7808 * 1024;
static_assert(WS_LSLOT + MOE_MAXROWS * 4 <= WS_SM + 8 * MiB, "small region");
constexpr size_t WS_END = PB + 216 * MiB;
constexpr size_t WS_MIXED = PB + 128 * MiB;
constexpr size_t WS_Y = PB;
constexpr size_t WS_H2 = PB + 64 * MiB;
constexpr size_t WS_WGU = PB + 96 * MiB;
constexpr size_t WS_WDT = PB + 128 * MiB;
constexpr size_t WS_DELTA = PB + 168 * MiB;
constexpr size_t WS_HID = PB + 144 * MiB;
static_assert(WS_Y + 64 * MiB <= WS_H0 && WS_HID + (size_t)MOE_MAXROWS * 512 <= WS_SM, "phase-region overlays");
static_assert(WS_END <= 332 * MiB, "workspace budget");

__device__ __forceinline__ float bf2f(bf16_t v) { return __uint_as_float((unsigned)v << 16); }
__device__ __forceinline__ unsigned f2bf(float f) { unsigned u = __float_as_uint(f); return (u + 0x7fffu + ((u >> 16) & 1u)) >> 16; }
__device__ __forceinline__ unsigned pk2(float lo, float hi) { return f2bf(lo) | (f2bf(hi) << 16); }
typedef float f32x2_t __attribute__((ext_vector_type(2))); typedef __bf16 bf16x2_t __attribute__((ext_vector_type(2)));
__device__ __forceinline__ unsigned cvtpk(float lo, float hi) { f32x2_t v = {lo, hi}; bf16x2_t b = __builtin_convertvector(v, bf16x2_t); return __builtin_bit_cast(unsigned, b); }
__device__ __forceinline__ f32x4 unpk4(u32x2 a) { f32x4 r; r.x = __uint_as_float(a.x << 16); r.y = __uint_as_float(a.x & 0xffff0000u); r.z = __uint_as_float(a.y << 16); r.w = __uint_as_float(a.y & 0xffff0000u); return r; }
template <int CTRL> __device__ __forceinline__ float dpp_f(float v) { return __int_as_float(__builtin_amdgcn_update_dpp(0, __float_as_int(v), CTRL, 0xf, 0xf, true)); }
__device__ __forceinline__ float wave_sum(float v) {
    v += dpp_f<0xB1>(v); v += dpp_f<0x4E>(v); v += dpp_f<0x141>(v); v += dpp_f<0x140>(v);
    const float a = __int_as_float(__builtin_amdgcn_readlane(__float_as_int(v), 0)), b = __int_as_float(__builtin_amdgcn_readlane(__float_as_int(v), 16));
    const float c2 = __int_as_float(__builtin_amdgcn_readlane(__float_as_int(v), 32)), d = __int_as_float(__builtin_amdgcn_readlane(__float_as_int(v), 48));
    return (a + b) + (c2 + d);
}
__device__ __forceinline__ float wave_max(float v) {
    v = fmaxf(v, dpp_f<0xB1>(v)); v = fmaxf(v, dpp_f<0x4E>(v)); v = fmaxf(v, dpp_f<0x141>(v)); v = fmaxf(v, dpp_f<0x140>(v));
    const float a = __int_as_float(__builtin_amdgcn_readlane(__float_as_int(v), 0)), b = __int_as_float(__builtin_amdgcn_readlane(__float_as_int(v), 16));
    const float c2 = __int_as_float(__builtin_amdgcn_readlane(__float_as_int(v), 32)), d = __int_as_float(__builtin_amdgcn_readlane(__float_as_int(v), 48));
    return fmaxf(fmaxf(a, b), fmaxf(c2, d));
}
__device__ __forceinline__ float half_sum(float v) { auto rr = __builtin_amdgcn_permlane32_swap(__float_as_uint(v), __float_as_uint(v), false, false); return __uint_as_float(rr[0]) + __uint_as_float(rr[1]); }
__device__ __forceinline__ float sigmoidf_(float x) { return 1.f / (1.f + __expf(-x)); }
__device__ __forceinline__ float gelu_tanh(float x) { const float u = 0.7978845608028654f * (x + 0.044715f * x * x * x); const float th = 1.f - 2.f / (1.f + __expf(2.f * u)); return 0.5f * x * (1.f + th); }
#define LDS_WAIT() asm volatile("s_waitcnt lgkmcnt(0)" ::: "memory")

#define XB_TMO      128
#define XB_XCNT(j)  (256  + 64 * (j))
#define XB_XSUB(j)  (1280 + 64 * (j))
#define XB_XGEN(j)  (2304 + 64 * (j))
#define XB_TOP      3328
#define XB_TOPGEN   3392
#define XCD_BAR_WORDS 3456
#define XB_SPIN_CAP (1u << 18)

__device__ __forceinline__ unsigned xb_ld(unsigned* p)              { return __hip_atomic_load(p, __ATOMIC_RELAXED, __HIP_MEMORY_SCOPE_AGENT); }
__device__ __forceinline__ unsigned xb_add(unsigned* p, unsigned v) { return __hip_atomic_fetch_add(p, v, __ATOMIC_RELAXED, __HIP_MEMORY_SCOPE_AGENT); }
__device__ __forceinline__ unsigned xb_xcc_id() { return (unsigned)__builtin_amdgcn_s_getreg((3 << 11) | 20) & 0xFu; }
#define XB_SPIN(cond, bar) do { unsigned _sp = 0; while (cond) { __builtin_amdgcn_s_sleep(1); \
    if ((++_sp & 255u) == 0u) { if (xb_ld(&(bar)[XB_TMO])) break; if (_sp > XB_SPIN_CAP) { atomicAdd(&(bar)[XB_TMO], 1u); break; } } } } while (0)

struct XcdBarrier { unsigned* bar; unsigned x; volatile LAS unsigned* st; };

__device__ __forceinline__ XcdBarrier xcd_barrier_post(unsigned* bar, volatile LAS unsigned* st) {
    XcdBarrier b; b.bar = bar; b.x = xb_xcc_id(); b.st = st;
    if (threadIdx.x == 0) (void)xb_add(&bar[XB_XCNT(b.x)], 1u);
    return b;
}
__device__ __forceinline__ void xcd_barrier_complete(unsigned* bar, unsigned x, unsigned& nloc, unsigned& nx) {
    const unsigned G = gridDim.x * gridDim.y * gridDim.z;
    unsigned sum, cnt, mine, sp = 0u;
    for (;;) {
        sum = 0u; cnt = 0u; mine = 0u;
#pragma unroll
        for (unsigned j = 0; j < 16; ++j) { const unsigned c = xb_ld(&bar[XB_XCNT(j)]); sum += c; cnt += (c > 0u) ? 1u : 0u; mine = (j == x) ? c : mine; }
        if (sum == G) break;
        __builtin_amdgcn_s_sleep(1);
        if ((++sp & 255u) == 0u) { if (xb_ld(&bar[XB_TMO])) break; if (sp > XB_SPIN_CAP) { atomicAdd(&bar[XB_TMO], 1u); break; } }
    }
    nloc = mine > 0u ? mine : 1u; nx = cnt > 0u ? cnt : 1u;
}
__device__ __forceinline__ void xcd_barrier(const XcdBarrier& b) {
    asm volatile("s_waitcnt vmcnt(0)" ::: "memory");
    __syncthreads();
    if (threadIdx.x == 0) {
        unsigned* bar = b.bar;
        __builtin_amdgcn_s_waitcnt(0);
        unsigned nloc = b.st[0], nx = b.st[1];
        if (nloc == 0u) { xcd_barrier_complete(bar, b.x, nloc, nx); b.st[0] = nloc; b.st[1] = nx; }
        const unsigned old = xb_add(&bar[XB_XSUB(b.x)], 1u);
        const unsigned gen = old / nloc;
        if (old + 1u == (gen + 1u) * nloc) {
            __builtin_amdgcn_fence(__ATOMIC_RELEASE, "agent");
            asm volatile("s_waitcnt vmcnt(0)" ::: "memory");
            const unsigned og = xb_add(&bar[XB_TOP], 1u);
            const unsigned tg = og / nx;
            if (og + 1u == (tg + 1u) * nx) xb_add(&bar[XB_TOPGEN], 1u);
            else XB_SPIN(xb_ld(&bar[XB_TOPGEN]) == tg, bar);
            __builtin_amdgcn_fence(__ATOMIC_ACQUIRE, "agent");
            xb_add(&bar[XB_XGEN(b.x)], 1u);
            asm volatile("s_waitcnt vmcnt(0)" ::: "memory");
        } else {
            XB_SPIN(xb_ld(&bar[XB_XGEN(b.x)]) == gen, bar);
            __builtin_amdgcn_fence(__ATOMIC_ACQUIRE, "agent");
            asm volatile("s_waitcnt vmcnt(0)" ::: "memory");
        }
    }
    __syncthreads();
}

namespace pg8 {
constexpr int BM = 256, BK = 64, HALF = 128, HTB = HALF * BK * 2, STAGE_BYTES = 8 * HTB;
__host__ __device__ __forceinline__ int lds_byte(int r, int c) { const int st = (r >> 4) * 2 + (c >> 5), rr = r & 15, cc = c & 31, ob = rr * 64 + cc * 2; return st * 1024 + (ob ^ (((ob >> 9) & 1) << 5)); }
__host__ __device__ __forceinline__ void stage_rc(int b, int& R, int& C) { const int st = b / 1024, sb = b % 1024, swz = sb ^ (((sb >> 9) & 1) << 5); R = (st >> 1) * 16 + swz / 64; C = (st & 1) * 32 + (swz % 64) / 2; }

struct Unit { int pm, pn; const char* A; const char* B; int aux; unsigned lda; };
struct Cfg { unsigned lda; unsigned kstepA; unsigned ldb; int nt; const int* rowidx; };

struct DenseOrder {
    int nM, nN, nwg, G, c; const char* A; const char* B; size_t tstepA, tstepB;
    __device__ void init(int nM_, int nN_, int G_, int c_, const void* A_, size_t tstepA_, const void* B_, size_t tstepB_) { nM = nM_; nN = nN_; nwg = nM * nN; G = G_; c = c_; A = (const char*)A_; B = (const char*)B_; tstepA = tstepA_; tstepB = tstepB_; }
    __device__ bool next(int i, Unit& u) const {
        const long Lq = (long)i * G + c; if (Lq >= nwg) return false;
        int wgid = (int)Lq; { const int q = nwg / 8, r = nwg % 8, xcd = wgid % 8, off = wgid / 8; wgid = (xcd < r ? xcd * (q + 1) : r * (q + 1) + (xcd - r) * q) + off; }
        const int nig = 8 * nN, gid = wgid / nig, fm = gid * 8, gsz = (nM - fm) < 8 ? (nM - fm) : 8;
        u.pm = fm + ((wgid % nig) % gsz); u.pn = (wgid % nig) / gsz; u.A = A + (size_t)u.pm * tstepA; u.B = B + (size_t)u.pn * tstepB; u.aux = 0; u.lda = 0u; return true;
    }
};

#define PG8_EPI_ROWCOL(row, col) const int row = u.pm * 256 + ai * 128 + wr * 64 + m * 16 + fr; const int col = u.pn * 256 + bj * 128 + wc * 32 + n * 16 + fq * 4;

template <bool INDEXED, bool MHALF = false, class Epi, class Sched>
__device__ __forceinline__ void gemm_phase(LAS unsigned char* lds, int wid, const Cfg g, const Sched& S, const Epi& E) {
    int lane_; asm volatile("v_mbcnt_lo_u32_b32 %0, -1, 0\n\tv_mbcnt_hi_u32_b32 %0, -1, %0" : "=v"(lane_));
    const int lane = lane_, tid = wid * 64 + lane, wr = wid >> 2, wc = wid & 3, fr = lane & 15, fq = lane >> 4;
    const int nt = g.nt;
    int Rs[2], Cs[2]; unsigned voffB[2];
#pragma unroll
    for (int i = 0; i < 2; ++i) { stage_rc(tid * 16 + i * 8192, Rs[i], Cs[i]); voffB[i] = (unsigned)Rs[i] * g.ldb + (unsigned)Cs[i] * 2u; }
    const size_t kstepA = g.kstepA, kstepB = (size_t)(BK * 2);
    const size_t hstepB = (size_t)HALF * g.ldb;
    const unsigned ldsw = (unsigned)wid * 1024u;
    const int aoff = lds_byte(wr * 64 + fr, fq * 8), boff = lds_byte(wc * 32 + fr, fq * 8);
#define PG8_SA(b, h) (((b) * 2 + (h)) * HTB)
#define PG8_SB(b, h) ((4 + (b) * 2 + (h)) * HTB)
#define PG8_STAGE2(bufoff, gbase, v0, v1) do { const char* gb_ = (const char*)(gbase); asm volatile("" : "+s"(gb_)); \
        __builtin_amdgcn_global_load_lds((const unsigned*)(gb_ + (v0)), (LAS unsigned*)(lds + (bufoff) + ldsw), 16, 0, 0); \
        __builtin_amdgcn_global_load_lds((const unsigned*)(gb_ + (v1)), (LAS unsigned*)(lds + (bufoff) + ldsw + 8192), 16, 0, 0); } while (0)
#define PG8_STAGEB(bufoff, gbase) PG8_STAGE2(bufoff, gbase, voffB[0], voffB[1])
#define PG8_LDA(dst, b, h) do { _Pragma("unroll") for (int m = 0; m < 4; ++m) _Pragma("unroll") for (int k = 0; k < 2; ++k) dst[m][k] = *(const LAS bf16x8*)(lds + PG8_SA(b, h) + aoff + m * 2048 + k * 1024); } while (0)
#define PG8_LDB(dst, b, h) do { _Pragma("unroll") for (int n = 0; n < 2; ++n) _Pragma("unroll") for (int k = 0; k < 2; ++k) dst[n][k] = *(const LAS bf16x8*)(lds + PG8_SB(b, h) + boff + n * 2048 + k * 1024); } while (0)
#define PG8_MMA(ai, bj, At, Bt) do { __builtin_amdgcn_s_setprio(1); _Pragma("unroll") for (int m = 0; m < 4; ++m) _Pragma("unroll") for (int n = 0; n < 2; ++n) _Pragma("unroll") for (int k = 0; k < 2; ++k) \
        acc[ai][bj][m][n] = __builtin_amdgcn_mfma_f32_16x16x32_bf16(Bt[n][k], At[m][k], acc[ai][bj][m][n], 0, 0, 0); __builtin_amdgcn_s_setprio(0); } while (0)
#define PG8_WAIT_V(n) asm volatile("s_waitcnt vmcnt(" #n ")" ::: "memory")
#define PG8_WAIT_L(n) asm volatile("s_waitcnt lgkmcnt(" #n ")" ::: "memory")
#define PG8_BAR __builtin_amdgcn_s_barrier()
#define PG8_SCHED __builtin_amdgcn_sched_barrier(0)
    Unit cur, nxt; int ui = 0;
    if (!S.next(0, cur)) return;
    unsigned vAc[2][2], vAn[2][2];
#define PG8_SETVA(v, U) do { _Pragma("unroll") for (int h_ = 0; h_ < 2; ++h_) _Pragma("unroll") for (int i_ = 0; i_ < 2; ++i_) { \
        if constexpr (INDEXED) { const int r_ = g.rowidx[(U).aux + h_ * HALF + Rs[i_]]; v[h_][i_] = (unsigned)r_ * g.lda + (unsigned)Cs[i_] * 2u; } \
        else v[h_][i_] = (unsigned)(h_ * HALF + Rs[i_]) * ((U).lda ? (U).lda : g.lda) + (unsigned)Cs[i_] * 2u; } } while (0)
    PG8_SETVA(vAc, cur);
    f32x4 acc[2][2][4][2];
#pragma unroll
    for (int a = 0; a < 2; ++a)
#pragma unroll
        for (int b = 0; b < 2; ++b)
#pragma unroll
            for (int m = 0; m < 4; ++m)
#pragma unroll
                for (int n = 0; n < 2; ++n) acc[a][b][m][n] = (f32x4){0.f, 0.f, 0.f, 0.f};
    bf16x8 At[4][2], B0[2][2], B1[2][2];
    const char* cA = cur.A; const char* cB = cur.B;
    PG8_STAGEB(PG8_SB(0, 0), cB); PG8_STAGEB(PG8_SB(0, 1), cB + hstepB); PG8_STAGE2(PG8_SA(0, 0), cA, vAc[0][0], vAc[0][1]); if constexpr (!MHALF) PG8_STAGE2(PG8_SA(0, 1), cA, vAc[1][0], vAc[1][1]);
    if (wr == 1) PG8_BAR;
    if constexpr (MHALF) PG8_WAIT_V(0); else PG8_WAIT_V(2);
    PG8_BAR;
    PG8_STAGEB(PG8_SB(1, 0), cB + kstepB); PG8_STAGE2(PG8_SA(1, 0), cA + kstepA, vAc[0][0], vAc[0][1]); PG8_STAGEB(PG8_SB(1, 1), cB + hstepB + kstepB);
    PG8_WAIT_V(6); PG8_BAR;
    for (;;) {
        const bool has_next = S.next(ui + 1, nxt);
        const char* nA = has_next ? nxt.A : cA; const char* nB = has_next ? nxt.B : cB;
        if (has_next) { PG8_SETVA(vAn, nxt); } else {
#pragma unroll
            for (int h_ = 0; h_ < 2; ++h_)
#pragma unroll
                for (int i_ = 0; i_ < 2; ++i_) vAn[h_][i_] = vAc[h_][i_]; }
        for (int t = 0; t < nt; t += 2) {
            const bool last = (t == nt - 2);
            const char* a1 = cA + (size_t)(t + 1) * kstepA;
            const char* a2 = last ? nA : cA + (size_t)(t + 2) * kstepA; const char* b2 = last ? nB : cB + (size_t)(t + 2) * kstepB;
            const char* a3 = a2 + kstepA; const char* b3 = b2 + kstepB;
            const unsigned w00 = last ? vAn[0][0] : vAc[0][0], w01 = last ? vAn[0][1] : vAc[0][1], w10 = last ? vAn[1][0] : vAc[1][0], w11 = last ? vAn[1][1] : vAc[1][1];
            PG8_LDB(B0, 0, 0); PG8_LDB(B1, 0, 1); PG8_SCHED; PG8_LDA(At, 0, 0); if constexpr (!MHALF) PG8_STAGE2(PG8_SA(1, 1), a1, vAc[1][0], vAc[1][1]);
            if constexpr (MHALF) PG8_WAIT_V(6); else PG8_WAIT_V(8);
            PG8_WAIT_L(0); PG8_BAR; PG8_MMA(0, 0, At, B0); PG8_MMA(0, 1, At, B1); PG8_BAR; PG8_SCHED;
            if constexpr (!MHALF) PG8_LDA(At, 0, 1);
            PG8_STAGEB(PG8_SB(0, 0), b2); PG8_STAGEB(PG8_SB(0, 1), b2 + hstepB); PG8_STAGE2(PG8_SA(0, 0), a2, w00, w01);
            if constexpr (MHALF) PG8_WAIT_V(6); else PG8_WAIT_V(8);
            PG8_WAIT_L(0); PG8_BAR; if constexpr (!MHALF) { PG8_MMA(1, 0, At, B0); PG8_MMA(1, 1, At, B1); } PG8_BAR; PG8_SCHED;
            PG8_LDB(B0, 1, 0); PG8_LDB(B1, 1, 1); PG8_SCHED; PG8_LDA(At, 1, 0); if constexpr (!MHALF) PG8_STAGE2(PG8_SA(0, 1), a2, w10, w11);
            if constexpr (MHALF) PG8_WAIT_V(6); else PG8_WAIT_V(8);
            PG8_WAIT_L(0); PG8_BAR; PG8_MMA(0, 0, At, B0); PG8_MMA(0, 1, At, B1); PG8_BAR; PG8_SCHED;
            if constexpr (!MHALF) PG8_LDA(At, 1, 1);
            PG8_STAGEB(PG8_SB(1, 0), b3); PG8_STAGEB(PG8_SB(1, 1), b3 + hstepB); PG8_STAGE2(PG8_SA(1, 0), a3, w00, w01);
            if constexpr (MHALF) PG8_WAIT_V(6); else PG8_WAIT_V(8);
            PG8_WAIT_L(0); PG8_BAR; if constexpr (!MHALF) { PG8_MMA(1, 0, At, B0); PG8_MMA(1, 1, At, B1); } PG8_BAR; PG8_SCHED;
        }
        if (wr == 0) PG8_BAR;
        { int l2_; asm volatile("v_mbcnt_lo_u32_b32 %0, -1, 0\n\tv_mbcnt_hi_u32_b32 %0, -1, %0" : "=v"(l2_)); E(acc, cur, wr, wc, l2_ & 15, l2_ >> 4); }
        if (!has_next) break;
#pragma unroll
        for (int a = 0; a < (MHALF ? 1 : 2); ++a)
#pragma unroll
            for (int b = 0; b < 2; ++b)
#pragma unroll
                for (int m = 0; m < 4; ++m)
#pragma unroll
                    for (int n = 0; n < 2; ++n) acc[a][b][m][n] = (f32x4){0.f, 0.f, 0.f, 0.f};
        cur = nxt; cA = nA; cB = nB; ++ui;
#pragma unroll
        for (int h_ = 0; h_ < 2; ++h_)
#pragma unroll
            for (int i_ = 0; i_ < 2; ++i_) vAc[h_][i_] = vAn[h_][i_];
        if (wr == 1) PG8_BAR;
    }
    PG8_WAIT_V(0);
    PG8_BAR;
#undef PG8_SA
#undef PG8_SB
#undef PG8_STAGE2
#undef PG8_STAGEB
#undef PG8_LDA
#undef PG8_LDB
#undef PG8_MMA
#undef PG8_WAIT_V
#undef PG8_WAIT_L
#undef PG8_BAR
#undef PG8_SCHED
#undef PG8_SETVA
}
}

struct OneTileOrder { int pm, pn; const char* A; const char* B; size_t tstepA, tstepB;
    __device__ bool next(int i, pg8::Unit& u) const { if (i > 0) return false; u.pm = pm; u.pn = pn; u.A = A + (size_t)pm * tstepA; u.B = B + (size_t)pn * tstepB; u.aux = 0; u.lda = 0u; return true; } };
constexpr int LDS_MISC = 131072;
constexpr int LDS_MOETAB = LDS_MISC + 64;
constexpr int LDS_INTAB = LDS_MISC + 512;
struct Ctx {
    float* out; unsigned char* ws; unsigned char* ws0;
    LAS unsigned char* lds;
    int tid, lane, wave, G, bid;
    __device__ __forceinline__ const void* inp(int i) const { const LAS unsigned* p = (const LAS unsigned*)(lds + LDS_INTAB) + 2 * i;
        const unsigned lo = (unsigned)__builtin_amdgcn_readfirstlane((int)p[0]), hi = (unsigned)__builtin_amdgcn_readfirstlane((int)p[1]); return (const void*)(const __attribute__((address_space(1))) char*)(((unsigned long long)hi << 32) | lo); }
    __device__ __forceinline__ const float* x() const { return (const float*)inp(0); }
    __device__ __forceinline__ const int* pos() const { return (const int*)inp(1); }
    __device__ __forceinline__ const float* rel_bias() const { return (const float*)inp(2); }
    __device__ __forceinline__ const float* norm_attn() const { return (const float*)inp(3); }
    __device__ __forceinline__ const float* w_in() const { return (const float*)inp(4); }
    __device__ __forceinline__ const float* b_merge() const { return (const float*)inp(5); }
    __device__ __forceinline__ const float* cmp_pe() const { return (const float*)inp(6); }
    __device__ __forceinline__ const float* cmp_k_w1() const { return (const float*)inp(7); }
    __device__ __forceinline__ const float* cmp_k_b1() const { return (const float*)inp(8); }
    __device__ __forceinline__ const float* cmp_k_w2() const { return (const float*)inp(9); }
    __device__ __forceinline__ const float* cmp_v_w1() const { return (const float*)inp(10); }
    __device__ __forceinline__ const float* cmp_v_b1() const { return (const float*)inp(11); }
    __device__ __forceinline__ const float* cmp_v_w2() const { return (const float*)inp(12); }
    __device__ __forceinline__ const float* mla_q_norm() const { return (const float*)inp(13); }
    __device__ __forceinline__ const float* mla_kv_norm() const { return (const float*)inp(14); }
    __device__ __forceinline__ const float* mla_w_uq() const { return (const float*)inp(15); }
    __device__ __forceinline__ const float* mla_w_uk() const { return (const float*)inp(16); }
    __device__ __forceinline__ const float* mla_w_uv() const { return (const float*)inp(17); }
    __device__ __forceinline__ const float* fox_b_f() const { return (const float*)inp(18); }
    __device__ __forceinline__ const float* w_o_nsa() const { return (const float*)inp(19); }
    __device__ __forceinline__ const float* w_o_mla() const { return (const float*)inp(20); }
    __device__ __forceinline__ const float* w_o_fox() const { return (const float*)inp(21); }
    __device__ __forceinline__ const float* w_out() const { return (const float*)inp(22); }
    __device__ __forceinline__ const float* norm_ffn() const { return (const float*)inp(23); }
    __device__ __forceinline__ const float* moe_w_grp() const { return (const float*)inp(24); }
    __device__ __forceinline__ const float* moe_b_grp() const { return (const float*)inp(25); }
    __device__ __forceinline__ const float* moe_w_router() const { return (const float*)inp(26); }
    __device__ __forceinline__ const float* moe_b_router() const { return (const float*)inp(27); }
    __device__ __forceinline__ const float* moe_w_gate() const { return (const float*)inp(28); }
    __device__ __forceinline__ const float* moe_w_up() const { return (const float*)inp(29); }
    __device__ __forceinline__ const float* moe_w_down() const { return (const float*)inp(30); }
    __device__ __forceinline__ const float* norm_final() const { return (const float*)inp(31); }
};
#define WSP(T_, off) ((T_*)(c.ws + (off)))
__device__ __forceinline__ int lane_id_volatile() { int ln; asm volatile("v_mbcnt_lo_u32_b32 %0, -1, 0\n\tv_mbcnt_hi_u32_b32 %0, -1, %0" : "=v"(ln)); return ln; }
__device__ __forceinline__ void relaunder(Ctx& c) { const int ln = lane_id_volatile(); c.lane = ln; c.tid = c.wave * 64 + ln;
    size_t z_ = 0; asm volatile("" : "+s"(z_)); c.ws = c.ws0 + z_; int g_ = c.G, b_ = c.bid, wv_ = c.wave; asm volatile("" : "+s"(g_), "+s"(b_), "+s"(wv_)); c.G = g_; c.bid = b_; c.wave = wv_; }

struct TItem { const float* wp; size_t ldw; bf16_t* wt; const float* rsp; float colscale; int K; bool pad; };
__device__ __forceinline__ TItem make_titem(const float* W, int ldw, int K, bf16_t* WT, const float* rowscale, int sc, int nblk, int item, int lane, float colscale) {
    const int kb = item / nblk, nb = item % nblk, k0 = 64 * kb, n0 = 32 * nb, cc = lane & 7;
    TItem t; t.wp = W + (size_t)(k0 + (lane >> 5)) * ldw + (sc >= 0 ? sc : 0); t.ldw = (size_t)ldw; t.wt = WT + (size_t)n0 * K + k0 + 8 * cc; t.rsp = rowscale ? rowscale + k0 + 8 * cc : nullptr; t.colscale = colscale; t.K = K; t.pad = sc < 0;
    return t;
}
__device__ __forceinline__ void t_load(const TItem& t, float (&v)[32], float (&rsc)[8]) {
#pragma unroll
    for (int i = 0; i < 32; ++i) v[i] = t.wp[(size_t)(2 * i) * t.ldw];
    if (t.rsp) { const f32x4 a = *(const f32x4*)t.rsp, b = *(const f32x4*)(t.rsp + 4); rsc[0] = a.x; rsc[1] = a.y; rsc[2] = a.z; rsc[3] = a.w; rsc[4] = b.x; rsc[5] = b.y; rsc[6] = b.z; rsc[7] = b.w; }
    else {
#pragma unroll
        for (int i = 0; i < 8; ++i) rsc[i] = 1.f; }
}
__device__ __forceinline__ void t_finish(const TItem& t, const float (&v)[32], const float (&rsc)[8], LAS float* scr, int lane) {
    const int cc = lane & 7;
#pragma unroll
    for (int i = 0; i < 32; ++i) scr[(2 * i + (lane >> 5)) * 33 + (lane & 31)] = t.pad ? 0.f : v[i];
    LDS_WAIT(); asm volatile("" ::: "memory");
#pragma unroll
    for (int j = 0; j < 4; ++j) { const int n = (lane >> 3) + 8 * j; const LAS float* s_ = scr + (8 * cc) * 33 + n; const float cs = t.colscale;
        u32x4 o; o.x = cvtpk(s_[0 * 33] * (rsc[0] * cs), s_[1 * 33] * (rsc[1] * cs)); o.y = cvtpk(s_[2 * 33] * (rsc[2] * cs), s_[3 * 33] * (rsc[3] * cs));
        o.z = cvtpk(s_[4 * 33] * (rsc[4] * cs), s_[5 * 33] * (rsc[5] * cs)); o.w = cvtpk(s_[6 * 33] * (rsc[6] * cs), s_[7 * 33] * (rsc[7] * cs));
        *(u32x4*)(t.wt + (size_t)n * t.K) = o; }
    LDS_WAIT(); asm volatile("" ::: "memory");
}
#define T_PIPELINE(N_ITEMS, MAKE) do { int it_ = gw;    if (it_ < (N_ITEMS)) { TItem A_ = MAKE(it_); float va_[32], ra_[8]; t_load(A_, va_, ra_); \
    for (;;) { const int itn_ = it_ + NGW; const bool hb_ = itn_ < (N_ITEMS); TItem B_; float vb_[32], rb_[8]; if (hb_) { B_ = MAKE(itn_); t_load(B_, vb_, rb_); } \
        __builtin_amdgcn_sched_barrier(0); t_finish(A_, va_, ra_, scr, c.lane); if (!hb_) break; \
        const int itn2_ = itn_ + NGW; const bool ha_ = itn2_ < (N_ITEMS); if (ha_) { A_ = MAKE(itn2_); t_load(A_, va_, ra_); } \
        __builtin_amdgcn_sched_barrier(0); t_finish(B_, vb_, rb_, scr, c.lane); if (!ha_) break; it_ = itn2_; } } } while (0)
#define T_SIMPLE(N_ITEMS, MAKE) do { for (int it_ = gw; it_ < (N_ITEMS); it_ += NGW) { TItem A_ = MAKE(it_); float va_[32], ra_[8]; t_load(A_, va_, ra_); __builtin_amdgcn_sched_barrier(0); t_finish(A_, va_, ra_, scr, c.lane); } } while (0)
struct MapId { int off; __device__ int operator()(int n) const { return n + off; } };
struct MapInproj { __device__ int operator()(int n) const { if (n < 1280) return n; if (n < 1696) return n + 24; if (n < 1720) return n - 416; if (n < 1728) return n + 1536; if (n < 3264) return n - 8; return -1; } };
struct MapUq { __device__ int operator()(int n) const { if (n < 512) return (n >> 6) * 96 + (n & 63); const int r = n - 512; return (r >> 5) * 96 + 64 + (r & 31); } };
struct MapPad128 { __device__ int operator()(int n) const { return n < 128 ? n : -1; } };
struct MapGU { __device__ int operator()(int n) const { return (n >> 8) * 128 + (n & 127); } };

__device__ __forceinline__ int rel_bucket_dev(int n) {
    if (n < 16) return n;
    const float lr = __logf((float)n / 16.f) / 2.0794415416798357f;
    int large = 16 + (int)(lr * 16.f);
    return large < 31 ? large : 31;
}

constexpr int PI_WIN = 16 * (P1W / 32), PI_WM = 16 * 96, PI_UQ = 4 * 24, PI_UK = 2 * 16, PI_UV = 2 * 16, PI_WO = 8 * 32, PI_WOUT = 16 * 32, PI_C1 = 32 * 8;
constexpr int PI_PER_L = PI_WIN + PI_WM + PI_UQ + PI_UK + PI_UV + 3 * PI_WO + PI_WOUT + 2 * PI_C1;
constexpr int PO_UQ = PI_WIN + PI_WM, PO_WO = PO_UQ + PI_UQ + PI_UK + PI_UV, PO_C1 = PO_WO + 3 * PI_WO + PI_WOUT;
__device__ __forceinline__ TItem prologue_item(const Ctx& c, int it) {
    const int l = it / PI_PER_L; int r = it % PI_PER_L; const int ln = c.lane & 31;
    if (r < PI_WIN) { const int n0_ = 32 * (r % (P1W / 32)); const float cs_ = (n0_ < 512 || (n0_ >= C_FQKV && n0_ < C_FQKV + 512)) ? QSCALE64 : 1.f;
        return make_titem(c.w_in() + (size_t)l * D * DIN, DIN, D, WSP(bf16_t, WS_WINT) + (size_t)l * NCAT * D, c.norm_attn() + l * D, MapInproj{}(n0_ + ln), P1W / 32, r, c.lane, cs_); } r -= PI_WIN;
    if (r < PI_WM) return make_titem(c.w_in() + (size_t)l * D * DIN, DIN, D, WSP(bf16_t, WS_WINT) + ((size_t)l * NCAT + P1W) * D, c.norm_attn() + l * D, 3264 + 32 * (r % 96) + ln, 96, r, c.lane, 1.f); r -= PI_WM;
    if (r < PI_UQ) return make_titem(c.mla_w_uq() + (size_t)l * 256 * 768, 768, 256, WSP(bf16_t, WS_WUQT) + (size_t)l * 768 * 256, c.mla_q_norm() + l * 256, MapUq{}(32 * (r % 24) + ln), 24, r, c.lane, QSCALE96); r -= PI_UQ;
    if (r < PI_UK) return make_titem(c.mla_w_uk() + (size_t)l * 128 * 512, 512, 128, WSP(bf16_t, WS_WUKVT) + (size_t)l * 1024 * 128, c.mla_kv_norm() + l * 128, 32 * (r % 16) + ln, 16, r, c.lane, 1.f); r -= PI_UK;
    if (r < PI_UV) return make_titem(c.mla_w_uv() + (size_t)l * 128 * 512, 512, 128, WSP(bf16_t, WS_WUKVT) + (size_t)l * 1024 * 128 + 512 * 128, c.mla_kv_norm() + l * 128, 32 * (r % 16) + ln, 16, r, c.lane, 1.f); r -= PI_UV;
    if (r < 3 * PI_WO) { const int br = r / PI_WO, rr = r % PI_WO; return make_titem((const float*)c.inp(19 + br) + (size_t)l * 512 * 1024, 1024, 512, WSP(bf16_t, WS_WOT) + ((size_t)l * 3 + br) * 1024 * 512, nullptr, 32 * (rr % 32) + ln, 32, rr, c.lane, 1.f); } r -= 3 * PI_WO;
    if (r < PI_WOUT) return make_titem(c.w_out() + (size_t)l * D * D, D, D, WSP(bf16_t, WS_WOUTT) + (size_t)l * D * D, nullptr, 32 * (r % 32) + ln, 32, r, c.lane, 1.f); r -= PI_WOUT;
    { const int kv = r / PI_C1, rr = r % PI_C1; const int n_ = 32 * (rr % 8) + ln;
      return make_titem((const float*)c.inp(kv == 0 ? 7 : 10) + (size_t)l * 2048 * 128, 128, 2048, WSP(bf16_t, WS_WC1T) + ((size_t)l * 2 + kv) * 256 * 2048, nullptr, n_ < 128 ? n_ : -1, 8, rr, c.lane, 1.f); }
}
__device__ __forceinline__ void phase_prologue(const Ctx& c) {
    LAS float* scr = (LAS float*)(c.lds + c.wave * 16384);
    const int gw = c.bid * NWAVES + c.wave, NGW = c.G * NWAVES;
#define PRO_MAKE(i_) prologue_item(c, (i_))
    T_PIPELINE(PI_WIN + PI_WM, PRO_MAKE);
#undef PRO_MAKE
    { float* rc = WSP(float, WS_ROPE); float* rs = rc + (size_t)M * 16;
      for (int i = c.bid * NTHREADS + c.tid; i < M * 16; i += c.G * NTHREADS) { const int m = i >> 4, j = i & 15;
          const float inv = exp2f(-(float)j * 0.8304820237218407f);   const float ang = (float)c.pos()[m] * inv; double rev = (double)ang * 0.15915494309189535; rev -= floor(rev); const float fr_ = (float)rev; rc[i] = __builtin_amdgcn_cosf(fr_); rs[i] = __builtin_amdgcn_sinf(fr_); } }
    float* tab = WSP(float, WS_TAB);
    for (int o = c.bid * NWAVES + c.wave; o < 512; o += c.G * NWAVES) {
        const int l = o >> 8, kv = (o >> 7) & 1, j = o & 127;
        const float* w1 = (const float*)c.inp(kv == 0 ? 7 : 10) + (size_t)l * 2048 * 128 + j; const float* pe = c.cmp_pe() + l * 2048;
        float wv[32], pv_[32];
#pragma unroll
        for (int i = 0; i < 32; ++i) { const int k = c.lane + 64 * i; wv[i] = w1[(size_t)k * 128]; pv_[i] = pe[k]; }
        float s_ = 0.f;
#pragma unroll
        for (int i = 0; i < 32; ++i) s_ += wv[i] * pv_[i];
        s_ = wave_sum(s_);
        if (c.lane == 0) tab[o] = s_ + ((const float*)c.inp(kv == 0 ? 8 : 11))[l * 128 + j];
    }
    if (c.bid == 1 % c.G) {
        for (int i = c.tid; i < 8 * 129; i += NTHREADS) { const int h = i / 129, d = i % 129; tab[512 + h * 132 + d] = c.rel_bias()[rel_bucket_dev(d) * 8 + h] * LOG2E; }
    }
}

__device__ __forceinline__ void phase_norm(const Ctx& c, const float* src, const bf16_t* dl, const bf16_t* y0, const bf16_t* y1, float* rout, bf16_t* hout) {
    const int gw = c.bid * NWAVES + c.wave, NGW = c.G * NWAVES;
    for (int m = gw; m < M; m += NGW) {
        const f32x4* xr = (const f32x4*)(src + (size_t)m * D) + c.lane;
        f32x4 v[4]; float s = 0.f;
#pragma unroll
        for (int j = 0; j < 4; ++j) { v[j] = xr[64 * j];
            if (y0) { const u32x2 a = *((const u32x2*)(y0 + (size_t)m * D) + c.lane + 64 * j); const u32x2 b = *((const u32x2*)(y1 + (size_t)m * D) + c.lane + 64 * j); const u32x2 d = *((const u32x2*)(dl + (size_t)m * D) + c.lane + 64 * j);
                v[j].x += (__uint_as_float(a.x << 16) + __uint_as_float(b.x << 16)) + __uint_as_float(d.x << 16); v[j].y += (__uint_as_float(a.x & 0xffff0000u) + __uint_as_float(b.x & 0xffff0000u)) + __uint_as_float(d.x & 0xffff0000u);
                v[j].z += (__uint_as_float(a.y << 16) + __uint_as_float(b.y << 16)) + __uint_as_float(d.y << 16); v[j].w += (__uint_as_float(a.y & 0xffff0000u) + __uint_as_float(b.y & 0xffff0000u)) + __uint_as_float(d.y & 0xffff0000u); }
            s += (v[j].x * v[j].x + v[j].y * v[j].y) + (v[j].z * v[j].z + v[j].w * v[j].w); }
        const float rstd = rsqrtf(wave_sum(s) * (1.f / D) + EPS);
        if (rout) { f32x4* ro = (f32x4*)(rout + (size_t)m * D) + c.lane;
#pragma unroll
            for (int j = 0; j < 4; ++j) ro[64 * j] = v[j]; }
        u32x2* o8 = (u32x2*)(hout + (size_t)m * D) + c.lane;
#pragma unroll
        for (int j = 0; j < 4; ++j) { u32x2 w; w.x = pk2(v[j].x * rstd, v[j].y * rstd); w.y = pk2(v[j].z * rstd, v[j].w * rstd); o8[64 * j] = w; }
    }
}
__device__ __forceinline__ void phase_final(const Ctx& c) {
    const int gw = c.bid * NWAVES + c.wave, NGW = c.G * NWAVES;
    const float* src = WSP(float, WS_XA); const bf16_t* y0 = WSP(bf16_t, WS_Y); const bf16_t* y1 = y0 + (size_t)M * D; const bf16_t* dl = WSP(bf16_t, WS_DELTA);
    for (int m = gw; m < M; m += NGW) {
        const f32x4* xr = (const f32x4*)(src + (size_t)m * D) + c.lane;
        f32x4 v[4]; float s = 0.f;
#pragma unroll
        for (int j = 0; j < 4; ++j) { v[j] = xr[64 * j];
            const u32x2 a = *((const u32x2*)(y0 + (size_t)m * D) + c.lane + 64 * j); const u32x2 b = *((const u32x2*)(y1 + (size_t)m * D) + c.lane + 64 * j); const u32x2 d = *((const u32x2*)(dl + (size_t)m * D) + c.lane + 64 * j);
            v[j].x += (__uint_as_float(a.x << 16) + __uint_as_float(b.x << 16)) + __uint_as_float(d.x << 16); v[j].y += (__uint_as_float(a.x & 0xffff0000u) + __uint_as_float(b.x & 0xffff0000u)) + __uint_as_float(d.x & 0xffff0000u);
            v[j].z += (__uint_as_float(a.y << 16) + __uint_as_float(b.y << 16)) + __uint_as_float(d.y << 16); v[j].w += (__uint_as_float(a.y & 0xffff0000u) + __uint_as_float(b.y & 0xffff0000u)) + __uint_as_float(d.y & 0xffff0000u);
            s += (v[j].x * v[j].x + v[j].y * v[j].y) + (v[j].z * v[j].z + v[j].w * v[j].w); }
        const float rstd = rsqrtf(wave_sum(s) * (1.f / D) + EPS);
        f32x4* ro = (f32x4*)(c.out + (size_t)m * D) + c.lane;
#pragma unroll
        for (int j = 0; j < 4; ++j) { const f32x4 g = *((const f32x4*)c.norm_final() + c.lane + 64 * j); ro[64 * j] = v[j] * rstd * g; }
    }
}

constexpr size_t WS_LC = WS_LF, WS_CT = WS_CUM, WS_CP = WS_CUM + 64 * 1024;
__device__ __forceinline__ void phase_prep(const Ctx& c, int l, int cbid, int cG) {
    const bf16_t* P1 = WSP(bf16_t, WS_P1); float* rstd = WSP(float, WS_RSTD); bf16_t* KR = WSP(bf16_t, WS_KR); float* LC = WSP(float, WS_LC); float* CT = WSP(float, WS_CT);
    const float* rc = WSP(float, WS_ROPE); const float* rs = rc + (size_t)M * 16;
    float kmx0 = 0.f, kmx1 = 0.f;
    LAS unsigned* kml = (LAS unsigned*)(c.lds + 4096); LAS float* wt = (LAS float*)(c.lds + 4096 + 64);
    if (c.tid < 16) kml[c.tid] = 0u;
    __syncthreads();
    const float bf_ = (c.lane < 8) ? c.fox_b_f()[l * 8 + c.lane] : 0.f;
    for (int ch = cbid; ch < M / 64; ch += cG) {
        float run = 0.f, rv[8];
#pragma unroll
        for (int i = 0; i < 8; ++i) { const int m = ch * 64 + c.wave * 8 + i;
            const bf16_t* row = P1 + (size_t)m * P1W;
            const u32x2 a = *((const u32x2*)(row + C_CQ) + c.lane);
            const unsigned b = *((const unsigned*)(row + C_CKV) + c.lane);
            const u32x4 kq = *((const u32x4*)(row + C_FQKV + 512) + c.lane);
            const float x1 = (c.lane < 16) ? bf2f(row[C_KR + c.lane]) : 0.f, x2 = (c.lane < 16) ? bf2f(row[C_KR + 16 + c.lane]) : 0.f;
            const float cs = (c.lane < 16) ? rc[m * 16 + c.lane] : 0.f, sn = (c.lane < 16) ? rs[m * 16 + c.lane] : 0.f;
            const float ff = (c.lane < 8) ? bf2f(row[C_FF + c.lane]) : 0.f;
            float q0 = __uint_as_float(a.x << 16), q1 = __uint_as_float(a.x & 0xffff0000u), q2 = __uint_as_float(a.y << 16), q3 = __uint_as_float(a.y & 0xffff0000u);
            const float sq = wave_sum(q0 * q0 + q1 * q1 + q2 * q2 + q3 * q3);
            float k0 = __uint_as_float(b << 16), k1 = __uint_as_float(b & 0xffff0000u);
            const float sk = wave_sum(k0 * k0 + k1 * k1);
            if (c.lane == 0) { rstd[2 * m] = rsqrtf(sq * (1.f / 256.f) + EPS); rstd[2 * m + 1] = rsqrtf(sk * (1.f / 128.f) + EPS); }
            if (c.lane < 16) { KR[m * 32 + c.lane] = (bf16_t)f2bf(x1 * cs - x2 * sn); KR[m * 32 + 16 + c.lane] = (bf16_t)f2bf(x1 * sn + x2 * cs); }
            { const f32x4 a0 = unpk4((u32x2){kq.x, kq.y}), a1 = unpk4((u32x2){kq.z, kq.w});
              float ss = (a0.x * a0.x + a0.y * a0.y) + (a0.z * a0.z + a0.w * a0.w) + (a1.x * a1.x + a1.y * a1.y) + (a1.z * a1.z + a1.w * a1.w);
              ss += dpp_f<0xB1>(ss); ss += dpp_f<0x4E>(ss); ss += dpp_f<0x141>(ss);
              if (m < T) kmx0 = fmaxf(kmx0, ss); else kmx1 = fmaxf(kmx1, ss); }
            const float f = ff + bf_;
            const float ls = fminf(f, 0.f) - __logf(1.f + __expf(-fabsf(f)));
            run += ls; rv[i] = run; }
        if (c.lane < 8) wt[c.wave * 8 + c.lane] = run;
        __syncthreads();
        if (c.lane < 8) { float pre = 0.f; for (int w_ = 0; w_ < c.wave; ++w_) pre += wt[w_ * 8 + c.lane];
            const int m0 = ch * 64 + c.wave * 8, bb = m0 / T, t0 = m0 % T; float* lc = LC + ((size_t)bb * 8 + c.lane) * T + t0;
#pragma unroll
            for (int i = 0; i < 8; ++i) lc[i] = (pre + rv[i]) * LOG2E;
            if (c.wave == 7) CT[((size_t)bb * 8 + c.lane) * 128 + (t0 >> 6)] = (pre + run) * LOG2E; }
        __syncthreads();
    }
    if ((c.lane & 7) == 0) { atomicMax((unsigned*)(kml + (c.lane >> 3)), __float_as_uint(kmx0)); atomicMax((unsigned*)(kml + 8 + (c.lane >> 3)), __float_as_uint(kmx1)); }
    __syncthreads();
    if (c.tid < 16) atomicMax(WSP(unsigned, WS_CTL) + CW_KMAX + l * 16 + c.tid, kml[c.tid]);
}
__device__ __forceinline__ void phase_chunk_prefix(const Ctx& c) {
    LAS float* sh = (LAS float*)(c.lds + 8192);
    for (int s_ = (c.G >= NB * 8) ? c.bid - (c.G - NB * 8) : c.bid; s_ >= 0 && s_ < NB * 8; s_ += c.G) {
        if (c.tid < 128) sh[c.tid] = WSP(float, WS_CT)[(size_t)s_ * 128 + c.tid];
        __syncthreads();
        if (c.tid < 129) { float run = 0.f; for (int i = 0; i < c.tid; ++i) run += sh[i]; (WSP(float, WS_CP) + (size_t)s_ * 129)[c.tid] = run; }
        __syncthreads();
    }
}
__device__ __forceinline__ void phase_cmp2(const Ctx& c, int l) {
    const float* SL = WSP(float, WS_SL); const float* bc1 = WSP(float, WS_TAB) + l * 256;
    LAS float* hl = (LAS float*)(c.lds + c.wave * 1024);
    for (int pr = c.bid * NWAVES + c.wave; pr < 2 * 2048; pr += c.G * NWAVES) {
        const int kv = pr >> 11, row = pr & 2047, d = c.lane;
        const float* w2 = (kv == 0 ? c.cmp_k_w2() : c.cmp_v_w2()) + (size_t)l * 128 * 64 + d;
        const float* s0 = SL + ((size_t)kv * 2048 + row) * 128; const float* s1 = s0 + (size_t)2 * 2048 * 128;
        const float a0 = s0[d], a1 = s0[d + 64], b0 = s1[d], b1 = s1[d + 64], c0 = bc1[kv * 128 + d], c1 = bc1[kv * 128 + d + 64];
        hl[d] = gelu_tanh(a0 + b0 + c0); hl[d + 64] = gelu_tanh(a1 + b1 + c1);
        LDS_WAIT(); asm volatile("" ::: "memory");
        float s = 0.f;
#pragma unroll
        for (int jb = 0; jb < 4; ++jb) { float wv[32];
#pragma unroll
            for (int i = 0; i < 32; ++i) wv[i] = w2[(size_t)(32 * jb + i) * 64];
            __builtin_amdgcn_sched_barrier(0);
#pragma unroll
            for (int i = 0; i < 32; ++i) s += hl[32 * jb + i] * wv[i]; }
        if ((row & 511) == 511) s = 0.f;
        (kv == 0 ? WSP(bf16_t, WS_KC) : WSP(bf16_t, WS_VC))[(size_t)row * 64 + d] = (bf16_t)f2bf(s);
        LDS_WAIT(); asm volatile("" ::: "memory");
    }
}
__device__ __forceinline__ u32x2 pk4(f32x4 v) { u32x2 w; w.x = cvtpk(v.x, v.y); w.y = cvtpk(v.z, v.w); return w; }
#define EPI_ARGS const f32x4 (&acc)[2][2][4][2], const pg8::Unit& u, int wr, int wc, int fr, int fq
#define EPI_LOOP _Pragma("unroll") for (int ai = 0; ai < 2; ++ai) _Pragma("unroll") for (int m = 0; m < 4; ++m) _Pragma("unroll") for (int bj = 0; bj < 2; ++bj) _Pragma("unroll") for (int n = 0; n < 2; ++n)

#define EPI_ROW(ai, m) (u.pm * 256 + (ai) * 128 + wr * 64 + (m) * 16 + fr)
#define EPI_COL(bj, n) (u.pn * 256 + (bj) * 128 + wc * 32 + (n) * 16 + fq * 4)
#define EPI_COLW(bj) (u.pn * 256 + (bj) * 128 + wc * 32 + fq * 8)
__device__ __forceinline__ u32x4 widen4(u32x2 a, u32x2 b) {
    const auto p0 = __builtin_amdgcn_permlane32_swap(a.x, b.x, false, false), p1 = __builtin_amdgcn_permlane32_swap(a.y, b.y, false, false);
    const auto q0 = __builtin_amdgcn_permlane16_swap(p0[0], p0[1], false, false), q1 = __builtin_amdgcn_permlane16_swap(p1[0], p1[1], false, false);
    u32x4 w; w.x = q0[0]; w.y = q1[0]; w.z = q0[1]; w.w = q1[1]; return w; }
__device__ __forceinline__ void narrow4(u32x4 w, u32x2& a, u32x2& b) {
    const auto q0 = __builtin_amdgcn_permlane16_swap(w.x, w.z, false, false), q1 = __builtin_amdgcn_permlane16_swap(w.y, w.w, false, false);
    const auto p0 = __builtin_amdgcn_permlane32_swap(q0[0], q0[1], false, false), p1 = __builtin_amdgcn_permlane32_swap(q1[0], q1[1], false, false);
    a.x = p0[0]; a.y = p1[0]; b.x = p0[1]; b.y = p1[1]; }
__device__ __forceinline__ u32x2 widen2(unsigned a, unsigned b) {
    const auto p0 = __builtin_amdgcn_permlane32_swap(a, b, false, false); const auto q0 = __builtin_amdgcn_permlane16_swap(p0[0], p0[1], false, false);
    u32x2 w; w.x = q0[0]; w.y = q0[1]; return w; }
__device__ __forceinline__ void narrow2(u32x2 w, unsigned& a, unsigned& b) {
    const auto q0 = __builtin_amdgcn_permlane16_swap(w.x, w.y, false, false); const auto p0 = __builtin_amdgcn_permlane32_swap(q0[0], q0[1], false, false);
    a = p0[0]; b = p0[1]; }
#define EPI_LOOPW _Pragma("unroll") for (int ai = 0; ai < 2; ++ai) _Pragma("unroll") for (int m = 0; m < 4; ++m) _Pragma("unroll") for (int bj = 0; bj < 2; ++bj)
struct EpiStoreBf16 { bf16_t* O; int ldc; const float* rowscale; int rs_stride;
    __device__ __forceinline__ void operator()(EPI_ARGS) const {
        float rs[2][4];
#pragma unroll
        for (int ai = 0; ai < 2; ++ai)
#pragma unroll
            for (int m = 0; m < 4; ++m) rs[ai][m] = rowscale ? rowscale[(size_t)EPI_ROW(ai, m) * rs_stride] : 1.f;
        __builtin_amdgcn_sched_barrier(0);
        EPI_LOOPW { const unsigned off = (unsigned)EPI_ROW(ai, m) * (unsigned)ldc + (unsigned)EPI_COLW(bj); *(u32x4*)(O + off) = widen4(pk4(acc[ai][bj][m][0] * rs[ai][m]), pk4(acc[ai][bj][m][1] * rs[ai][m])); } } };
struct EpiUqRope { bf16_t* QB; const float* rstd; const float* ropec; const float* ropes;
    __device__ __forceinline__ void operator()(EPI_ARGS) const {
#pragma unroll
        for (int ai = 0; ai < 2; ++ai) { float rs[4]; f32x4 cs4[4], sn4[4];
#pragma unroll
            for (int m = 0; m < 4; ++m) { const unsigned row = (unsigned)EPI_ROW(ai, m); rs[m] = rstd[(size_t)row * 2]; cs4[m] = *(const f32x4*)(ropec + row * 16u + fq * 4); sn4[m] = *(const f32x4*)(ropes + row * 16u + fq * 4); }
            __builtin_amdgcn_sched_barrier(0);
#pragma unroll
            for (int m = 0; m < 4; ++m)
#pragma unroll
                for (int bj = 0; bj < 2; ++bj) { const f32x4 x1 = acc[ai][bj][m][0] * rs[m], x2 = acc[ai][bj][m][1] * rs[m];
                    const f32x4 o1 = x1 * cs4[m] - x2 * sn4[m], o2 = x1 * sn4[m] + x2 * cs4[m];
                    const unsigned off = (unsigned)EPI_ROW(ai, m) * 768u + (unsigned)EPI_COLW(bj);
                    *(u32x4*)(QB + off) = widen4(pk4(o1), pk4(o2)); }
            __builtin_amdgcn_sched_barrier(0); } } };
struct EpiInprojGates { bf16_t* P1o; unsigned char* G8; const float* bias;
    __device__ __forceinline__ void operator()(EPI_ARGS) const {
        if (u.pn < 13) { EPI_LOOPW { *(u32x4*)(P1o + (unsigned)EPI_ROW(ai, m) * (unsigned)P1W + (unsigned)EPI_COLW(bj)) = widen4(pk4(acc[ai][bj][m][0]), pk4(acc[ai][bj][m][1])); } }
        else { f32x4 bv[2][2];
#pragma unroll
            for (int bj = 0; bj < 2; ++bj)
#pragma unroll
                for (int n = 0; n < 2; ++n) bv[bj][n] = *(const f32x4*)(bias + (EPI_COL(bj, n) - P1W));
            __builtin_amdgcn_sched_barrier(0);
            u32x4* gt = (u32x4*)G8 + ((size_t)(u.pm * 12 + (u.pn - 13)) * 8 + (size_t)(wr * 4 + wc)) * 512 + (fq * 16 + fr);
_Pragma("unroll")
            for (int ai = 0; ai < 2; ++ai)
_Pragma("unroll")
                for (int m = 0; m < 4; ++m) { unsigned gq[2][2];
_Pragma("unroll")
                    for (int bj = 0; bj < 2; ++bj)
_Pragma("unroll")
                        for (int n = 0; n < 2; ++n) { const f32x4 v = acc[ai][bj][m][n] + bv[bj][n];
                            const unsigned q0_ = (unsigned)(sigmoidf_(v.x) * 255.f + 0.5f), q1_ = (unsigned)(sigmoidf_(v.y) * 255.f + 0.5f), q2_ = (unsigned)(sigmoidf_(v.z) * 255.f + 0.5f), q3_ = (unsigned)(sigmoidf_(v.w) * 255.f + 0.5f);
                            gq[bj][n] = q0_ | (q1_ << 8) | (q2_ << 16) | (q3_ << 24); }
                    u32x4 w4; w4.x = gq[0][0]; w4.y = gq[0][1]; w4.z = gq[1][0]; w4.w = gq[1][1]; gt[(ai * 4 + m) * 64] = w4; } } } };
struct EpiGates { bf16_t* O; const float* bias;
    __device__ __forceinline__ void operator()(EPI_ARGS) const {
        f32x4 bv[2][2];
#pragma unroll
        for (int bj = 0; bj < 2; ++bj)
#pragma unroll
            for (int n = 0; n < 2; ++n) bv[bj][n] = *(const f32x4*)(bias + EPI_COL(bj, n));
        __builtin_amdgcn_sched_barrier(0);
        EPI_LOOP { f32x4 v = acc[ai][bj][m][n] + bv[bj][n];
            v.x = sigmoidf_(v.x); v.y = sigmoidf_(v.y); v.z = sigmoidf_(v.z); v.w = sigmoidf_(v.w); *(u32x2*)(O + (unsigned)EPI_ROW(ai, m) * 3072u + (unsigned)EPI_COL(bj, n)) = pk4(v); } } };
struct EpiCmpSlab { float* SL;
    __device__ __forceinline__ void operator()(EPI_ARGS) const {
        const int kv = u.pm >> 4, bg = (u.pm >> 2) & 3, half = (u.pm >> 1) & 1, ksp = u.pm & 1;
#pragma unroll
        for (int ai = 0; ai < 2; ++ai)
#pragma unroll
            for (int m = 0; m < 4; ++m)
#pragma unroll
                for (int n = 0; n < 2; ++n) { const int i = half * 256 + ai * 128 + wr * 64 + m * 16 + fr, cc = wc * 32 + n * 16 + fq * 4;
                    *(f32x4*)(SL + ((size_t)(ksp * 2 + kv) * 2048 + bg * 512 + i) * 128 + cc) = acc[ai][0][m][n]; } } };
struct EpiOutproj { bf16_t* MIX; const unsigned char* G8;
    __device__ __forceinline__ void operator()(EPI_ARGS) const {
        const int br = u.aux;
#pragma unroll
        for (int ai = 0; ai < 2; ++ai)
#pragma unroll
          for (int mh = 0; mh < 2; ++mh) { u32x4 gw[2]; u32x4 mw[2][2];
            const u32x4* gt = (const u32x4*)G8 + ((size_t)(u.pm * 12 + br * 4 + u.pn) * 8 + (size_t)(wr * 4 + wc)) * 512 + (fq * 16 + fr);
#pragma unroll
            for (int m2 = 0; m2 < 2; ++m2) { gw[m2] = gt[(ai * 4 + 2 * mh + m2) * 64];
#pragma unroll
                for (int bj = 0; bj < 2; ++bj) { const unsigned row = (unsigned)EPI_ROW(ai, 2 * mh + m2), col = (unsigned)EPI_COLW(bj);
                    if (br > 0) mw[m2][bj] = *(const u32x4*)(MIX + row * 1024u + col); } }
            __builtin_amdgcn_sched_barrier(0);
#pragma unroll
            for (int m2 = 0; m2 < 2; ++m2)
#pragma unroll
                for (int bj = 0; bj < 2; ++bj) { unsigned g2[2]; g2[0] = bj ? gw[m2].z : gw[m2].x; g2[1] = bj ? gw[m2].w : gw[m2].y; u32x2 o2[2] = {{0u, 0u}, {0u, 0u}}; if (br > 0) narrow4(mw[m2][bj], o2[0], o2[1]); u32x2 r2[2];
#pragma unroll
                    for (int n = 0; n < 2; ++n) { const unsigned g_ = g2[n]; f32x4 gf; gf.x = (float)(g_ & 255u); gf.y = (float)((g_ >> 8) & 255u); gf.z = (float)((g_ >> 16) & 255u); gf.w = (float)(g_ >> 24);
                        f32x4 v = acc[ai][bj][2 * mh + m2][n] * gf * (1.f / 255.f); if (br > 0) v = v + unpk4(o2[n]); r2[n] = pk4(v); }
                    *(u32x4*)(MIX + (unsigned)EPI_ROW(ai, 2 * mh + m2) * 1024u + (unsigned)EPI_COLW(bj)) = widen4(r2[0], r2[1]); }
            __builtin_amdgcn_sched_barrier(0); } } };
struct EpiWout { const float* R; float* XA;
    __device__ __forceinline__ void operator()(EPI_ARGS) const {
#pragma unroll
        for (int ai = 0; ai < 2; ++ai)
#pragma unroll
          for (int mh = 0; mh < 2; ++mh) { f32x4 rv[2][2][2];
#pragma unroll
            for (int m2 = 0; m2 < 2; ++m2)
#pragma unroll
                for (int bj = 0; bj < 2; ++bj)
#pragma unroll
                    for (int n = 0; n < 2; ++n) rv[m2][bj][n] = *(const f32x4*)(R + (unsigned)EPI_ROW(ai, 2 * mh + m2) * 1024u + (unsigned)EPI_COL(bj, n));
            __builtin_amdgcn_sched_barrier(0);
#pragma unroll
            for (int m2 = 0; m2 < 2; ++m2)
#pragma unroll
                for (int bj = 0; bj < 2; ++bj)
#pragma unroll
                    for (int n = 0; n < 2; ++n) *(f32x4*)(XA + (unsigned)EPI_ROW(ai, 2 * mh + m2) * 1024u + (unsigned)EPI_COL(bj, n)) = rv[m2][bj][n] + acc[ai][bj][2 * mh + m2][n];
            __builtin_amdgcn_sched_barrier(0); } } };
struct EpiMoe1 { bf16_t* HID; const float* LW;
    __device__ __forceinline__ void operator()(EPI_ARGS) const {
        int aux_ = u.aux; asm volatile("" : "+s"(aux_));
        float w8[2][4];
#pragma unroll
        for (int ai = 0; ai < 2; ++ai)
#pragma unroll
            for (int m = 0; m < 4; ++m) w8[ai][m] = LW[(unsigned)(aux_ + ai * 128 + wr * 64 + m * 16 + fr)];
        __builtin_amdgcn_sched_barrier(0);
#pragma unroll
        for (int ai = 0; ai < 2; ++ai)
#pragma unroll
            for (int m = 0; m < 4; ++m) { const unsigned pos = (unsigned)(aux_ + ai * 128 + wr * 64 + m * 16 + fr); const float w = w8[ai][m];
                u32x2 h2[2];
#pragma unroll
                for (int n = 0; n < 2; ++n) { const f32x4 g = acc[ai][0][m][n], up = acc[ai][1][m][n]; f32x4 h;
                    h.x = g.x * sigmoidf_(g.x) * up.x * w; h.y = g.y * sigmoidf_(g.y) * up.y * w; h.z = g.z * sigmoidf_(g.z) * up.z * w; h.w = g.w * sigmoidf_(g.w) * up.w * w; h2[n] = pk4(h); }
                *(u32x4*)(HID + pos * 256u + (unsigned)(u.pn * 128 + wc * 32 + fq * 8)) = widen4(h2[0], h2[1]); } } };
struct EpiMoe2 { bf16_t* Y; const unsigned* LDST;
    __device__ __forceinline__ void operator()(EPI_ARGS) const {
        int aux_ = u.aux; asm volatile("" : "+s"(aux_));
        unsigned d8[2][4];
#pragma unroll
        for (int ai = 0; ai < 2; ++ai)
#pragma unroll
            for (int m = 0; m < 4; ++m) d8[ai][m] = LDST[(unsigned)(aux_ + ai * 128 + wr * 64 + m * 16 + fr)];
        __builtin_amdgcn_sched_barrier(0);
#pragma unroll
        for (int ai = 0; ai < 2; ++ai)
#pragma unroll
            for (int m = 0; m < 4; ++m) { const unsigned d0 = d8[ai][m];
                const u32x4 w0 = widen4(pk4(acc[ai][0][m][0]), pk4(acc[ai][0][m][1])), w1 = widen4(pk4(acc[ai][1][m][0]), pk4(acc[ai][1][m][1]));
                if (d0 != 0xFFFFFFFFu) { const unsigned off = d0 + (unsigned)(u.pn * 256 + wc * 32 + fq * 8); *(u32x4*)(Y + off) = w0; *(u32x4*)(Y + off + 128) = w1; } } } };

struct OutprojOrder { int G, c; const char* base; long long off0, d1, d2; const char* W; unsigned lda0, lda1;
    __device__ bool next(int i, pg8::Unit& u) const { const int rnd = i / 3, br = i - 3 * rnd; const int tl = rnd * G + c; if (tl >= (M / 256) * 4) return false;
        u.pm = tl >> 2; u.pn = tl & 3; u.aux = br; const unsigned lda_ = lda0 + (unsigned)(br == 1) * (lda1 - lda0); u.lda = lda_;
        const unsigned long long pa_ = (unsigned long long)(base + off0 + (long long)(br == 1) * d1 + (long long)(br == 2) * d2 + (long long)u.pm * 256 * lda_), pb_ = (unsigned long long)(W + (size_t)br * 1024 * 1024 + (size_t)u.pn * 256 * 1024);
        u.A = (const char*)(const __attribute__((address_space(1))) char*)(((unsigned long long)(unsigned)__builtin_amdgcn_readfirstlane((int)(pa_ >> 32)) << 32) | (unsigned)__builtin_amdgcn_readfirstlane((int)pa_));
        u.B = (const char*)(const __attribute__((address_space(1))) char*)(((unsigned long long)(unsigned)__builtin_amdgcn_readfirstlane((int)(pb_ >> 32)) << 32) | (unsigned)__builtin_amdgcn_readfirstlane((int)pb_)); return true; } };
struct OutprojOrderH { int G, c; const char* base; long long off0, d1, d2; const char* W; unsigned lda0, lda1;
    __device__ bool next(int i, pg8::Unit& u) const { const int rnd = i / 3, br = i - 3 * rnd; const int tl = rnd * G + c; if (tl >= (M / 128) * 4) return false;
        u.pm = tl >> 2; u.pn = tl & 3; u.aux = br; const unsigned lda_ = lda0 + (unsigned)(br == 1) * (lda1 - lda0); u.lda = lda_;
        const unsigned long long pa_ = (unsigned long long)(base + off0 + (long long)(br == 1) * d1 + (long long)(br == 2) * d2 + (long long)u.pm * 128 * lda_), pb_ = (unsigned long long)(W + (size_t)br * 1024 * 1024 + (size_t)u.pn * 256 * 1024);
        u.A = (const char*)(const __attribute__((address_space(1))) char*)(((unsigned long long)(unsigned)__builtin_amdgcn_readfirstlane((int)(pa_ >> 32)) << 32) | (unsigned)__builtin_amdgcn_readfirstlane((int)pa_));
        u.B = (const char*)(const __attribute__((address_space(1))) char*)(((unsigned long long)(unsigned)__builtin_amdgcn_readfirstlane((int)(pb_ >> 32)) << 32) | (unsigned)__builtin_amdgcn_readfirstlane((int)pb_)); return true; } };
struct EpiOutprojH { bf16_t* MIX; const unsigned char* G8;
    __device__ __forceinline__ void operator()(f32x4 (&acc)[2][2][4][2], const pg8::Unit& u, int wr, int wc, int fr, int fq) const {
        const int br = u.aux, half = u.pm & 1;
        const u32x4* gt = (const u32x4*)G8 + ((size_t)((u.pm >> 1) * 12 + br * 4 + u.pn) * 8 + (size_t)(wr * 4 + wc)) * 512 + (fq * 16 + fr);
        u32x4 gw[4];
#pragma unroll
        for (int m = 0; m < 4; ++m) gw[m] = gt[(half * 4 + m) * 64];
        __builtin_amdgcn_sched_barrier(0);
#pragma unroll
        for (int m = 0; m < 4; ++m)
#pragma unroll
            for (int bj = 0; bj < 2; ++bj)
#pragma unroll
                for (int n = 0; n < 2; ++n) { const unsigned g_ = bj ? (n ? gw[m].w : gw[m].z) : (n ? gw[m].y : gw[m].x);
                    f32x4 gf; gf.x = (float)(g_ & 255u); gf.y = (float)((g_ >> 8) & 255u); gf.z = (float)((g_ >> 16) & 255u); gf.w = (float)(g_ >> 24);
                    const f32x4 v = acc[0][bj][m][n] * gf * (1.f / 255.f);
                    if (br == 0) acc[1][bj][m][n] = v; else acc[1][bj][m][n] = acc[1][bj][m][n] + v; }
        if (br == 2) {
#pragma unroll
            for (int m = 0; m < 4; ++m)
#pragma unroll
                for (int bj = 0; bj < 2; ++bj) *(u32x4*)(MIX + (unsigned)(u.pm * 128 + wr * 64 + m * 16 + fr) * 1024u + (unsigned)(u.pn * 256 + bj * 128 + wc * 32 + fq * 8)) = widen4(pk4(acc[1][bj][m][0]), pk4(acc[1][bj][m][1])); }
    } };
struct CmpOrder { int G, c; const char* P1; const char* W;
    __device__ bool next(int i, pg8::Unit& u) const { const int L_ = i * G + c; if (L_ >= 32) return false; const int kv = L_ >> 4, b = (L_ >> 3) & 1, g = (L_ >> 2) & 1, half = (L_ >> 1) & 1, ks = L_ & 1;
        u.pm = L_; u.pn = 0; u.aux = 0; u.lda = 0u; u.A = P1 + ((size_t)(b * T + 16 * 256 * half + 16 * ks) * P1W + C_NKV + (kv * 2 + g) * 64) * 2; u.B = W + ((size_t)kv * 256 * 2048 + (size_t)ks * 1024) * 2; return true; } };
struct MoeOrder { int G, c, nN; const LAS int* tab; const char* A; size_t a_rowbytes; const char* W; size_t w_expert, w_tile;
    __device__ bool next(int i, pg8::Unit& u) const { const int L_ = i * G + c; const int NT = __builtin_amdgcn_readfirstlane(tab[32]); if (L_ >= NT * nN) return false; const int rt = L_ / nN, pn = L_ % nN;
        int e = 0; while (__builtin_amdgcn_readfirstlane(tab[e + 1]) <= rt) ++e;
        const int off_e = __builtin_amdgcn_readfirstlane(tab[33 + e]), ts_e = __builtin_amdgcn_readfirstlane(tab[e]), cnt_e = __builtin_amdgcn_readfirstlane(tab[66 + e]);
        const int pos0 = off_e + 256 * (rt - ts_e); u.pn = pn; u.aux = pos0; u.pm = off_e + cnt_e; u.lda = 0u;
        u.A = A + (size_t)pos0 * a_rowbytes; u.B = W + (size_t)e * w_expert + (size_t)pn * w_tile; return true; } };
__device__ __forceinline__ void moe_tables(const Ctx& c, int l, LAS int* tab) {
    if (c.tid < 32) tab[66 + c.tid] = (int)(WSP(unsigned, WS_CTL) + CW_MOECNT + l * 64)[c.tid];
    __syncthreads();
    if (c.tid == 0) { int ts = 0, off = 0;
        for (int e = 0; e < 32; ++e) { const int n = tab[66 + e]; tab[e] = ts; tab[33 + e] = off; const int nt_ = (n + 255) >> 8; ts += nt_; off += nt_ * 256; }
        tab[32] = ts; tab[65] = off; }
    __syncthreads();
}

constexpr int LDS_RSM = LDS_MISC + 1024;
constexpr int RT_XT = 0, RT_XTP = 516, RT_P = 32 * RT_XTP * 4, RT_PG = RT_P + 8 * 32 * 33 * 4, RT_EL = RT_PG + 8 * 32 * 4 * 4, RT_GL = RT_EL + 32 * 32 * 4;
static_assert(RT_GL + 32 * 4 * 4 <= 131072, "router LDS map");
__device__ __forceinline__ void phase_router(const Ctx& c, int l, const float* XA, int dummy = 0) {
    const int lane = c.lane, w = c.wave, tid = c.tid;
    const bf16_t* DL = WSP(bf16_t, WS_DELTA); bf16_t* H2 = WSP(bf16_t, WS_H2); int* REC = WSP(int, dummy ? WS_HID : WS_REC); unsigned* cnt = WSP(unsigned, WS_CTL) + CW_MOECNT + (l + 2 * dummy) * 64;
    const float* g2 = c.norm_ffn() + l * D; const float* wg = c.moe_w_grp() + (size_t)l * D * 4; const float* wr_ = c.moe_w_router() + (size_t)l * D * 32;
    const float* bgp = c.moe_b_grp() + l * 4; const float* brp = c.moe_b_router() + l * 32;
    LAS float* XT = (LAS float*)(c.lds + RT_XT); LAS float* P = (LAS float*)(c.lds + RT_P); LAS float* PG = (LAS float*)(c.lds + RT_PG); LAS float* EL = (LAS float*)(c.lds + RT_EL); LAS float* GL = (LAS float*)(c.lds + RT_GL);
    LAS unsigned* cntL = (LAS unsigned*)(c.lds + LDS_MOETAB);
    if (tid < 32) cntL[tid] = 0u;
    __syncthreads();
    const int rr_ = lane & 31, kk = lane >> 5;
    for (int st = c.bid; st < M / 32; st += c.G) {
        const int m0 = st * 32 + 4 * w;
        f32x4 v[4][4]; float rs[4];
#pragma unroll
        for (int r = 0; r < 4; ++r) { const f32x4* xr = (const f32x4*)(XA + (size_t)(m0 + r) * D) + lane; float s = 0.f;
#pragma unroll
            for (int j = 0; j < 4; ++j) { v[r][j] = xr[64 * j] + unpk4(*((const u32x2*)(DL + (size_t)(m0 + r) * D) + lane + 64 * j)); s += (v[r][j].x * v[r][j].x + v[r][j].y * v[r][j].y) + (v[r][j].z * v[r][j].z + v[r][j].w * v[r][j].w); }
            rs[r] = rsqrtf(wave_sum(s) * (1.f / D) + EPS); }
#pragma unroll
        for (int j = 0; j < 4; ++j) { const f32x4 gg = *((const f32x4*)g2 + lane + 64 * j);
#pragma unroll
            for (int r = 0; r < 4; ++r) { v[r][j] = v[r][j] * rs[r]; *((u32x2*)(H2 + (size_t)(m0 + r) * D) + lane + 64 * j) = pk4(v[r][j]); v[r][j] = v[r][j] * gg; } }
        f32x16 acc0, acc1;
#pragma unroll
        for (int i = 0; i < 16; ++i) { acc0[i] = 0.f; acc1[i] = 0.f; }
        float bw[2][8], bg[2][8];
#define RT_BLOAD(g_) { const int h_ = (g_) >> 2, cq_ = (g_) & 3; const float* wrp = wr_ + (size_t)(512 * h_ + 64 * w + 32 * kk) * 32 + rr_; const float* wgp = wg + (size_t)(512 * h_ + 64 * w + 32 * kk) * 4 + (rr_ & 3); asm volatile("" : "+v"(wrp), "+v"(wgp)); \
            _Pragma("unroll") for (int s_ = 0; s_ < 8; ++s_) { bw[(g_) & 1][s_] = wrp[(8 * cq_ + s_) * 32]; bg[(g_) & 1][s_] = wgp[(8 * cq_ + s_) * 4]; } }
        RT_BLOAD(0)
#pragma unroll
        for (int g = 0; g < 8; ++g) { const int h = g >> 2, cq = g & 3;
            if (cq == 0) {
                if (h) __syncthreads();
#pragma unroll
                for (int r = 0; r < 4; ++r)
#pragma unroll
                    for (int jj = 0; jj < 2; ++jj) *(LAS f32x4*)(XT + (4 * w + r) * RT_XTP + 4 * lane + 256 * jj) = v[r][2 * h + jj];
                __syncthreads(); }
            const f32x4 a0 = *(const LAS f32x4*)(XT + rr_ * RT_XTP + 64 * w + 32 * kk + 8 * cq), a1 = *(const LAS f32x4*)(XT + rr_ * RT_XTP + 64 * w + 32 * kk + 8 * cq + 4);
            if (g + 1 < 8) RT_BLOAD(g + 1)
            __builtin_amdgcn_sched_barrier(0);
#pragma unroll
            for (int s_ = 0; s_ < 8; ++s_) { const float a_ = s_ < 4 ? a0[s_ & 3] : a1[s_ & 3]; const float g_ = (rr_ < 4) ? bg[g & 1][s_] : 0.f;
                acc0 = __builtin_amdgcn_mfma_f32_32x32x2f32(a_, bw[g & 1][s_], acc0, 0, 0, 0); acc1 = __builtin_amdgcn_mfma_f32_32x32x2f32(a_, g_, acc1, 0, 0, 0); }
            __builtin_amdgcn_sched_barrier(0);
        }
#undef RT_BLOAD
#pragma unroll
        for (int i = 0; i < 16; ++i) { const int row = (i & 3) + 8 * (i >> 2) + 4 * kk; P[(w * 32 + row) * 33 + rr_] = acc0[i]; if (rr_ < 4) PG[(w * 32 + row) * 4 + rr_] = acc1[i]; }
        __syncthreads();
        { const int row = tid >> 4, e0 = 2 * (tid & 15); float s0 = 0.f, s1 = 0.f;
#pragma unroll
          for (int q = 0; q < 8; ++q) { s0 += P[(q * 32 + row) * 33 + e0]; s1 += P[(q * 32 + row) * 33 + e0 + 1]; }
          EL[row * 32 + e0] = s0 + brp[e0]; EL[row * 32 + e0 + 1] = s1 + brp[e0 + 1];
          if (tid < 128) { const int rg = tid >> 2, og = tid & 3; float sg = 0.f;
#pragma unroll
              for (int q = 0; q < 8; ++q) sg += PG[(q * 32 + rg) * 4 + og];
              GL[rg * 4 + og] = sg + bgp[og]; } }
        __syncthreads();
        if (tid < 32) { const int r = tid;
            int gi = 0; float gm = GL[r * 4];
            for (int o = 1; o < 4; ++o) { const float x_ = GL[r * 4 + o]; if (x_ > gm) { gm = x_; gi = o; } }
            float gs = 0.f; for (int o = 0; o < 4; ++o) gs += __expf(GL[r * 4 + o] - gm);
            const float grp_top = 1.f / gs;
            int i1 = 0; float m1 = EL[r * 32 + gi * 8];
            for (int q = 1; q < 8; ++q) { const float x_ = EL[r * 32 + gi * 8 + q]; if (x_ > m1) { m1 = x_; i1 = q; } }
            int i2 = -1; float m2 = -3.0e38f;
            for (int q = 0; q < 8; ++q) { const float x_ = EL[r * 32 + gi * 8 + q]; if (q != i1 && x_ > m2) { m2 = x_; i2 = q; } }
            const float e2 = __expf(m2 - m1); const float w1 = grp_top / (1.f + e2), w2 = grp_top * e2 / (1.f + e2);
            const int ea = gi * 8 + i1, eb = gi * 8 + i2; const int ra = (int)atomicAdd((unsigned*)(cntL + ea), 1u), rb = (int)atomicAdd((unsigned*)(cntL + eb), 1u);
            int* rr = REC + (size_t)(st * 32 + r) * 8; rr[0] = ea; rr[1] = eb; rr[2] = ra; rr[3] = rb; rr[4] = __float_as_int(w1); rr[5] = __float_as_int(w2); rr[6] = c.bid; }
        __syncthreads();
    }
    __syncthreads();
    if (c.tid < 32) { const unsigned n = cntL[c.tid]; (WSP(unsigned, WS_CTL) + CW_CNTB)[(dummy ? 8192 : 0) + c.bid * 32 + c.tid] = n; if (n) atomicAdd(cnt + c.tid, n); }
}
__device__ __forceinline__ TItem place_item_gu(const Ctx& c, int l, int it) {
    const int e = it >> 8, r = it & 255, ln = c.lane & 31; const int nb = r % 16; const bool up = ((nb * 32) & 255) >= 128;
    return make_titem((const float*)c.inp(up ? 29 : 28) + ((size_t)l * 32 + e) * D * 256, 256, D, WSP(bf16_t, WS_WGU) + (size_t)e * 512 * D, c.norm_ffn() + l * D, MapGU{}(32 * nb + ln), 16, r, c.lane, 1.f);
}
__device__ __forceinline__ TItem place_item_dn(const Ctx& c, int l, int it) {
    const int e = it >> 7, r = it & 127, ln = c.lane & 31;
    return make_titem(c.moe_w_down() + ((size_t)l * 32 + e) * 256 * D, D, 256, WSP(bf16_t, WS_WDT) + (size_t)e * D * 256, nullptr, 32 * (r % 32) + ln, 32, r, c.lane, 1.f);
}
__device__ __forceinline__ void phase_place(const Ctx& c, int l) {
    LAS int* tab = (LAS int*)(c.lds + LDS_MOETAB);
    moe_tables(c, l, tab);
    int* LTOK = WSP(int, WS_LTOK); float* LW = WSP(float, WS_LW); unsigned* LDST = WSP(unsigned, WS_LSLOT); const int* REC = WSP(int, WS_REC);
    LAS int* BASE = (LAS int*)c.lds;
    { const unsigned* cb = WSP(unsigned, WS_CTL) + CW_CNTB; for (int i = c.tid; i < c.G * 32; i += NTHREADS) BASE[i] = (int)cb[i]; }
    __syncthreads();
    if (c.tid < 32) { int run = 0; const int nb8 = c.G & ~7;
        for (int b0_ = 0; b0_ < nb8; b0_ += 8) { int v8[8];
#pragma unroll
            for (int q = 0; q < 8; ++q) v8[q] = BASE[(b0_ + q) * 32 + c.tid];
#pragma unroll
            for (int q = 0; q < 8; ++q) { BASE[(b0_ + q) * 32 + c.tid] = run; run += v8[q]; } }
        for (int b_ = nb8; b_ < c.G; ++b_) { const int v_ = BASE[b_ * 32 + c.tid]; BASE[b_ * 32 + c.tid] = run; run += v_; } }
    __syncthreads();
    for (int m = c.bid * NTHREADS + c.tid; m < M; m += c.G * NTHREADS) { const int* r = REC + (size_t)m * 8;
        const int pa = tab[33 + r[0]] + BASE[r[6] * 32 + r[0]] + r[2], pb = tab[33 + r[1]] + BASE[r[6] * 32 + r[1]] + r[3];
        LTOK[pa] = m; LDST[pa] = (unsigned)m * 1024u; LW[pa] = __int_as_float(r[4]); LTOK[pb] = m; LDST[pb] = ((unsigned)M + (unsigned)m) * 1024u; LW[pb] = __int_as_float(r[5]); }
    for (int e = c.bid; e < 32; e += c.G) { const int lo = tab[33 + e] + tab[66 + e], hi2 = tab[33 + e + 1];
        for (int p = lo + c.tid; p < hi2; p += NTHREADS) { LTOK[p] = 0; LDST[p] = 0xFFFFFFFFu; LW[p] = 0.f; } }
    __syncthreads();
    LAS float* scr = (LAS float*)(c.lds + c.wave * 16384);
    const int gw = c.bid * NWAVES + c.wave, NGW = c.G * NWAVES;
#define PLACE_MAKE(i_) place_item_gu(c, l, (i_))
    T_PIPELINE(32 * 256, PLACE_MAKE);
#undef PLACE_MAKE
}

#ifndef ATT_FAST_FOX
#define ATT_FAST_FOX 1
#endif
#ifndef ATT_FAST_MLA
#define ATT_FAST_MLA 1
#endif
#ifndef ATT_FAST_NSA
#define ATT_FAST_NSA 1
#endif
namespace fa {
constexpr int KPITCH = 208, VPITCH = 192;
constexpr int KBUF = 64 * KPITCH, VBUF = 64 * VPITCH;
constexpr int L_K = 0, L_V = 2 * KBUF, L_VD = 4 * KBUF, L_LUT = 131072 + 1024, L_CUM = L_LUT + 8 * 132 * 4, L_PS = 57344, L_F = L_PS + 64 * 132 * 4, L_SEL = L_F + 64 * 132 * 4, L_UNI = L_SEL + 1024, L_TL = L_UNI + 16, L_TLN = L_TL + 128, L_UNIT = L_TLN + 16;
static_assert(L_V + 2 * VBUF <= L_PS && L_VD + 4 * VBUF <= L_SEL && L_UNIT + 64 <= 131072 && L_CUM + 512 <= LDS_BYTES, "attention LDS map: NSA uses K/V slots 0,1 (V at L_V) + the importance tables; dense units use 4 K slots and 4 V slots at L_VD (over the tables, dead then)");
typedef short v4i16_t __attribute__((ext_vector_type(4)));
__device__ __forceinline__ float swap32_max(float v) { auto rr = __builtin_amdgcn_permlane32_swap(__float_as_uint(v), __float_as_uint(v), false, false); return fmaxf(__uint_as_float(rr[0]), __uint_as_float(rr[1])); }
__device__ __forceinline__ float swap32_sum(float v) { auto rr = __builtin_amdgcn_permlane32_swap(__float_as_uint(v), __float_as_uint(v), false, false); return __uint_as_float(rr[0]) + __uint_as_float(rr[1]); }
__device__ __forceinline__ float ex2(float x) { return __builtin_amdgcn_exp2f(x); }

struct KVSrc { const bf16_t* K; int kpitch; const bf16_t* K2; int k2pitch; const bf16_t* V; int vpitch; const float* cum; float cref; };
struct TileRegs { u32x4 k, k2, v; float cm; };
template <bool HAS_K2, bool HAS_CUM>
__device__ __forceinline__ void tile_load(TileRegs& R, const KVSrc& s, int kv0, int tid) {
    const int row = tid >> 3, ch = tid & 7;
    R.k = *(const u32x4*)(s.K + (size_t)(kv0 + row) * s.kpitch + ch * 8);
    R.v = *(const u32x4*)(s.V + (size_t)(kv0 + row) * s.vpitch + ch * 8);
    if constexpr (HAS_K2) { if (tid < 256) R.k2 = *(const u32x4*)(s.K2 + (size_t)(kv0 + (tid >> 2)) * s.k2pitch + (tid & 3) * 8); }
    if constexpr (HAS_CUM) { if (tid < 64) R.cm = s.cum[kv0 + tid]; }
}
template <bool HAS_K2, bool HAS_CUM>
__device__ __forceinline__ void tile_store(const TileRegs& R, LAS unsigned char* lds, int buf, int tid, float cref = 0.f, float cadd = 0.f, int vbase = L_V) {
    const int row = tid >> 3, ch = tid & 7;
    *(LAS u32x4*)(lds + L_K + buf * KBUF + row * KPITCH + ch * 16) = R.k;
    if constexpr (HAS_K2) { if (tid < 256) *(LAS u32x4*)(lds + L_K + buf * KBUF + (tid >> 2) * KPITCH + 128 + (tid & 3) * 16) = R.k2; }
    *(LAS u32x4*)(lds + vbase + buf * VBUF + row * VPITCH + ch * 16) = R.v;
    if constexpr (HAS_CUM) { if (tid < 64) { const float x = cref - (R.cm + cadd); const unsigned hi_ = f2bf(x); const float xl = x - __uint_as_float(hi_ << 16); const unsigned lo_ = f2bf(xl);
            unsigned zz = 0u; asm volatile("" : "+v"(zz)); u32x4 w0; w0.x = hi_ | (lo_ << 16); w0.y = zz; w0.z = zz; w0.w = zz; u32x4 z0; z0.x = zz; z0.y = zz; z0.z = zz; z0.w = zz;
            *(LAS u32x4*)(lds + L_K + buf * KBUF + tid * KPITCH + 128) = w0; *(LAS u32x4*)(lds + L_K + buf * KBUF + tid * KPITCH + 144) = z0; } }
}
template <int NKS>
__device__ __forceinline__ void qk_tile(f32x16 (&st)[2], const LAS unsigned char* lds, int buf, const bf16x8 (&qf)[NKS], int r, int hh, float cval) {
    const LAS unsigned char* kp = lds + L_K + buf * KBUF + r * KPITCH + hh * 16;
    bf16x8 kf[2][NKS];
#pragma unroll
    for (int ks = 0; ks < NKS; ++ks)
#pragma unroll
        for (int rb = 0; rb < 2; ++rb) kf[rb][ks] = *(const LAS bf16x8*)(kp + rb * 32 * KPITCH + ks * 32);
    f32x16 cin;
#pragma unroll
    for (int i = 0; i < 16; ++i) cin[i] = cval;
    __builtin_amdgcn_sched_barrier(0);
    f32x16 a0 = __builtin_amdgcn_mfma_f32_32x32x16_bf16(kf[0][0], qf[0], cin, 0, 0, 0), a1 = __builtin_amdgcn_mfma_f32_32x32x16_bf16(kf[1][0], qf[0], cin, 0, 0, 0);
#pragma unroll
    for (int ks = 1; ks < NKS; ++ks) { a0 = __builtin_amdgcn_mfma_f32_32x32x16_bf16(kf[0][ks], qf[ks], a0, 0, 0, 0); a1 = __builtin_amdgcn_mfma_f32_32x32x16_bf16(kf[1][ks], qf[ks], a1, 0, 0, 0); }
    st[0] = a0; st[1] = a1;
}
__device__ __forceinline__ void pv_tile(f32x16 (&ot)[2], const LAS unsigned char* lds, int buf, const f32x16 (&p)[2], int lane) {
    const int i16 = lane & 15, blk = (lane >> 4) & 1, hh = lane >> 5;
    const LAS unsigned char* vb = lds + L_V + buf * VBUF + (4 * hh + (i16 >> 2)) * VPITCH + 32 * blk + 8 * (i16 & 3);
    v4i16_t lo[4][2], hi[4][2]; bf16x8 pf[4];
#pragma unroll
    for (int q = 0; q < 4; ++q)
#pragma unroll
        for (int db = 0; db < 2; ++db) { const LAS unsigned char* vp = vb + (16 * q) * VPITCH + 64 * db;
            lo[q][db] = __builtin_amdgcn_ds_read_tr16_b64_v4i16((LAS v4i16_t*)vp); hi[q][db] = __builtin_amdgcn_ds_read_tr16_b64_v4i16((LAS v4i16_t*)(vp + 8 * VPITCH)); }
#pragma unroll
    for (int q = 0; q < 4; ++q) { const int rb = q >> 1, s_ = q & 1;
        u32x4 pw; pw.x = cvtpk(p[rb][8 * s_ + 0], p[rb][8 * s_ + 1]); pw.y = cvtpk(p[rb][8 * s_ + 2], p[rb][8 * s_ + 3]); pw.z = cvtpk(p[rb][8 * s_ + 4], p[rb][8 * s_ + 5]); pw.w = cvtpk(p[rb][8 * s_ + 6], p[rb][8 * s_ + 7]);
        pf[q] = __builtin_bit_cast(bf16x8, pw); }
    __builtin_amdgcn_sched_barrier(0);
#pragma unroll
    for (int q = 0; q < 4; ++q)
#pragma unroll
        for (int db = 0; db < 2; ++db) { const bf16x8 vf = {lo[q][db][0], lo[q][db][1], lo[q][db][2], lo[q][db][3], hi[q][db][0], hi[q][db][1], hi[q][db][2], hi[q][db][3]};
            ot[db] = __builtin_amdgcn_mfma_f32_32x32x16_bf16(vf, pf[q], ot[db], 0, 0, 0); }
}
struct VFrags { v4i16_t lo[4][2], hi[4][2]; };
__device__ __forceinline__ void v_read(VFrags& F, const LAS unsigned char* lds, int buf, int lane, int vbase = L_V) {
    const int i16 = lane & 15, blk = (lane >> 4) & 1, hh = lane >> 5;
    const LAS unsigned char* vb = lds + vbase + buf * VBUF + (4 * hh + (i16 >> 2)) * VPITCH + 32 * blk + 8 * (i16 & 3);
#pragma unroll
    for (int q = 0; q < 4; ++q)
#pragma unroll
        for (int db = 0; db < 2; ++db) { const LAS unsigned char* vp = vb + (16 * q) * VPITCH + 64 * db;
            F.lo[q][db] = __builtin_amdgcn_ds_read_tr16_b64_v4i16((LAS v4i16_t*)vp); F.hi[q][db] = __builtin_amdgcn_ds_read_tr16_b64_v4i16((LAS v4i16_t*)(vp + 8 * VPITCH)); }
}
__device__ __forceinline__ void pv_mma(f32x16 (&ot)[2], const VFrags& F, const f32x16 (&p)[2]) {
    bf16x8 pf[4];
#pragma unroll
    for (int q = 0; q < 4; ++q) { const int rb = q >> 1, s_ = q & 1;
        u32x4 pw; pw.x = cvtpk(p[rb][8 * s_ + 0], p[rb][8 * s_ + 1]); pw.y = cvtpk(p[rb][8 * s_ + 2], p[rb][8 * s_ + 3]); pw.z = cvtpk(p[rb][8 * s_ + 4], p[rb][8 * s_ + 5]); pw.w = cvtpk(p[rb][8 * s_ + 6], p[rb][8 * s_ + 7]);
        pf[q] = __builtin_bit_cast(bf16x8, pw); }
    __builtin_amdgcn_sched_barrier(0);
#pragma unroll
    for (int q = 0; q < 4; ++q)
#pragma unroll
        for (int db = 0; db < 2; ++db) { const bf16x8 vf = {F.lo[q][db][0], F.lo[q][db][1], F.lo[q][db][2], F.lo[q][db][3], F.hi[q][db][0], F.hi[q][db][1], F.hi[q][db][2], F.hi[q][db][3]};
            ot[db] = __builtin_amdgcn_mfma_f32_32x32x16_bf16(vf, pf[q], ot[db], 0, 0, 0); }
}
struct SmState { float m, l; };
constexpr float RESC_THR = 8.f;
__device__ __forceinline__ float sm_cval(const SmState& S) { return (S.m == -INFINITY) ? 0.f : -S.m; }
__device__ __forceinline__ float row_max32(const f32x16 (&st)[2]) {
    float mx = fmaxf(st[0][0], st[1][0]);
#pragma unroll
    for (int i = 1; i < 16; ++i) mx = fmaxf(fmaxf(mx, st[0][i]), st[1][i]);
    return swap32_max(mx);
}
typedef float f32x2v __attribute__((ext_vector_type(2)));
template <bool WITH_O>
__device__ __forceinline__ void sm_shift(f32x16 (&st)[2], SmState& S, f32x16 (&ot)[2], float mx) {
    const bool fresh = (S.m == -INFINITY);
    const bool up = fresh ? (mx > -INFINITY) : (mx > RESC_THR);
    if (__any(up)) {
        const float d = up ? mx : 0.f; const float alpha = fresh ? 1.f : ex2(-d);
        S.l *= alpha; S.m = up ? ((fresh ? 0.f : S.m) + d) : S.m;
#pragma unroll
        for (int rb = 0; rb < 2; ++rb)
#pragma unroll
            for (int i = 0; i < 16; ++i) st[rb][i] -= d;
        if constexpr (WITH_O) {
#pragma unroll
            for (int db = 0; db < 2; ++db)
#pragma unroll
                for (int i = 0; i < 16; ++i) ot[db][i] *= alpha; }
    }
}
__device__ __forceinline__ void sm_update(f32x16 (&st)[2], SmState& S, f32x16 (&ot)[2]) {
    sm_shift<true>(st, S, ot, row_max32(st));
    float sum = 0.f;
#pragma unroll
    for (int rb = 0; rb < 2; ++rb)
#pragma unroll
        for (int i = 0; i < 16; ++i) { const float p = ex2(st[rb][i]); st[rb][i] = p; sum += p; }
    S.l += sum;
}
__device__ __forceinline__ void sm_stats(f32x16 (&st)[2], SmState& S) {
    f32x16 dummy[2];
    sm_shift<false>(st, S, dummy, row_max32(st));
    float sum = 0.f;
#pragma unroll
    for (int rb = 0; rb < 2; ++rb)
#pragma unroll
        for (int i = 0; i < 16; ++i) sum += ex2(st[rb][i]);
    S.l += sum;
}
__device__ __forceinline__ void zero_acc(f32x16 (&a)[2]) {
#pragma unroll
    for (int db = 0; db < 2; ++db)
#pragma unroll
        for (int i = 0; i < 16; ++i) a[db][i] = 0.f;
}
__device__ __forceinline__ void store_ot(const f32x16 (&o)[2], float sc, bf16_t* orow, int hh) {
#pragma unroll
    for (int db = 0; db < 2; ++db)
#pragma unroll
        for (int a = 0; a < 4; ++a) { u32x2 w; w.x = cvtpk(o[db][4 * a + 0] * sc, o[db][4 * a + 1] * sc); w.y = cvtpk(o[db][4 * a + 2] * sc, o[db][4 * a + 3] * sc);
            *(u32x2*)(orow + 32 * db + 8 * a + 4 * hh) = w; }
}
#define FA_FOREACH_REG(CODE) _Pragma("unroll") for (int rb = 0; rb < 2; ++rb) _Pragma("unroll") for (int a = 0; a < 4; ++a) _Pragma("unroll") for (int e = 0; e < 4; ++e) { const int i = 4 * a + e; const int kc = 32 * rb + 8 * a + e; (void)kc; CODE }
#define FA_LAUNDER(x) asm volatile("" : "+v"(x))

#define SGB(mask_, n_) __builtin_amdgcn_sched_group_barrier(mask_, n_, 0)
__device__ __forceinline__ float sm_finish(const f32x16 (&sc)[2], bf16x8 (&pf)[4]) {
    float sum = 0.f;
#pragma unroll
    for (int q = 0; q < 4; ++q) { const int rb = q >> 1, s_ = q & 1; float p[8];
#pragma unroll
        for (int j = 0; j < 8; ++j) { p[j] = ex2(sc[rb][8 * s_ + j]); sum += p[j]; }
        u32x4 pw; pw.x = cvtpk(p[0], p[1]); pw.y = cvtpk(p[2], p[3]); pw.z = cvtpk(p[4], p[5]); pw.w = cvtpk(p[6], p[7]);
        asm volatile("" : "+v"(pw.x), "+v"(pw.y), "+v"(pw.z), "+v"(pw.w));
        pf[q] = __builtin_bit_cast(bf16x8, pw); }
    return sum;
}
__device__ __forceinline__ void pv_mma_pf(f32x16 (&ot)[2], const VFrags& F, const bf16x8 (&pf)[4]) {
#pragma unroll
    for (int q = 0; q < 4; ++q)
#pragma unroll
        for (int db = 0; db < 2; ++db) { const bf16x8 vf = {F.lo[q][db][0], F.lo[q][db][1], F.lo[q][db][2], F.lo[q][db][3], F.hi[q][db][0], F.hi[q][db][1], F.hi[q][db][2], F.hi[q][db][3]};
            ot[db] = __builtin_amdgcn_mfma_f32_32x32x16_bf16(vf, pf[q], ot[db], 0, 0, 0); }
}
template <int NKS>
__device__ __forceinline__ void dense_step(f32x16 (&sc)[2], f32x16 (&ot)[2], SmState& S, VFrags& VF, const LAS unsigned char* lds, int buf, const bf16x8 (&qf)[NKS], int r, int hh, int lane, bool diag, int lim) {
    const LAS unsigned char* kp = lds + L_K + buf * KBUF + r * KPITCH + hh * 16;
    const float cval = sm_cval(S);
    __builtin_amdgcn_sched_barrier(0);
    bf16x8 kf[2][NKS];
#pragma unroll
    for (int ks = 0; ks < NKS; ++ks)
#pragma unroll
        for (int rb = 0; rb < 2; ++rb) kf[rb][ks] = *(const LAS bf16x8*)(kp + rb * 32 * KPITCH + ks * 32);
    f32x16 cin;
#pragma unroll
    for (int i = 0; i < 16; ++i) cin[i] = cval;
    f32x16 sn[2];
    sn[0] = __builtin_amdgcn_mfma_f32_32x32x16_bf16(kf[0][0], qf[0], cin, 0, 0, 0); sn[1] = __builtin_amdgcn_mfma_f32_32x32x16_bf16(kf[1][0], qf[0], cin, 0, 0, 0);
#pragma unroll
    for (int ks = 1; ks < NKS; ++ks) { sn[0] = __builtin_amdgcn_mfma_f32_32x32x16_bf16(kf[0][ks], qf[ks], sn[0], 0, 0, 0); sn[1] = __builtin_amdgcn_mfma_f32_32x32x16_bf16(kf[1][ks], qf[ks], sn[1], 0, 0, 0); }
    bf16x8 pf[4];
    S.l += sm_finish(sc, pf);
    SGB(0x100, 4); SGB(0x2, 16); SGB(0x400, 3); SGB(0x2, 3);
#pragma unroll
    for (int g = 0; g < 2 * NKS; ++g) { SGB(0x8, 1); if (g < 2 * NKS - 4) SGB(0x100, 1); SGB(0x400, 3); SGB(0x2, 4); }
    __builtin_amdgcn_sched_barrier(0);
    if (diag) { FA_FOREACH_REG({ if (kc > lim) sn[rb][i] = -INFINITY; }) }
    pv_mma_pf(ot, VF, pf);
    const float mx = row_max32(sn);
#pragma unroll
    for (int g = 0; g < 8; ++g) { SGB(0x8, 1); SGB(0x2, 3); }
    __builtin_amdgcn_sched_barrier(0);
    sm_shift<true>(sn, S, ot, mx);
    v_read(VF, lds, buf, lane, L_VD);
    sc[0] = sn[0]; sc[1] = sn[1];
}

template <bool IS_MLA>
__device__ __forceinline__ void dense_unit(const Ctx& c, int lyr, int b, int h, int qb) {
    constexpr int NKS = IS_MLA ? 6 : 5;
    const int tid = c.tid, lane = c.lane, r = lane & 31, hh = lane >> 5, w = c.wave;
    LAS unsigned char* lds = c.lds;
    const int q0 = qb * 256, qrow = q0 + 32 * w + r; const size_t mrow = (size_t)b * T + qrow;
    KVSrc src; bf16x8 qf[NKS]; bf16_t* orow;
    if constexpr (IS_MLA) {
        const bf16_t* QB = WSP(bf16_t, WS_QB); const bf16_t* KVB = WSP(bf16_t, WS_KVB);
        src.K = KVB + (size_t)b * T * 1024 + h * 64; src.kpitch = 1024; src.K2 = WSP(bf16_t, WS_KR) + (size_t)b * T * 32; src.k2pitch = 32; src.V = KVB + (size_t)b * T * 1024 + 512 + h * 64; src.vpitch = 1024; src.cum = nullptr; src.cref = 0.f;
#pragma unroll
        for (int ks = 0; ks < 4; ++ks) qf[ks] = *(const bf16x8*)(QB + mrow * 768 + h * 64 + 16 * ks + 8 * hh);
#pragma unroll
        for (int ks = 0; ks < 2; ++ks) qf[4 + ks] = *(const bf16x8*)(QB + mrow * 768 + 512 + h * 32 + 16 * ks + 8 * hh);
        orow = WSP(bf16_t, WS_QB) + mrow * 768 + h * 64;
    } else {
        const bf16_t* P1 = WSP(bf16_t, WS_P1);
        src.K = P1 + (size_t)b * T * P1W + C_FQKV + 512 + h * 64; src.kpitch = P1W; src.K2 = nullptr; src.k2pitch = 0; src.V = P1 + (size_t)b * T * P1W + C_FQKV + 1024 + h * 64; src.vpitch = P1W;
        src.cum = WSP(float, WS_LC) + ((size_t)b * 8 + h) * T;
        { LAS float* cps_ = (LAS float*)(lds + L_CUM); if (tid < 128) cps_[tid] = (WSP(float, WS_CP) + ((size_t)b * 8 + h) * 129)[1 + tid]; }
        src.cref = 0.f;
#pragma unroll
        for (int ks = 0; ks < 4; ++ks) qf[ks] = *(const bf16x8*)(P1 + mrow * P1W + C_FQKV + h * 64 + 16 * ks + 8 * hh);
        { unsigned one2 = hh ? 0u : 0x3F803F80u; asm volatile("" : "+v"(one2)); u32x4 aq; aq.x = one2; aq.y = 0u; aq.z = 0u; aq.w = 0u; qf[4] = __builtin_bit_cast(bf16x8, aq); }
        orow = WSP(bf16_t, WS_P1) + mrow * P1W + C_FQKV + h * 64;
    }
    f32x16 sc[2], ot[2]; zero_acc(ot); SmState S{-INFINITY, 0.f};
#pragma unroll
    for (int i = 0; i < 16; ++i) { sc[0][i] = -INFINITY; sc[1][i] = -INFINITY; }
    VFrags VF;
#pragma unroll
    for (int q = 0; q < 4; ++q)
#pragma unroll
        for (int db = 0; db < 2; ++db) { VF.lo[q][db] = (v4i16_t){0, 0, 0, 0}; VF.hi[q][db] = (v4i16_t){0, 0, 0, 0}; }
    constexpr float FOX_SKIP = 40.f;
    float qbound = 0.f, mmin_blk = -INFINITY; LAS float* MM = (LAS float*)(lds + L_UNIT + 16);
    if constexpr (!IS_MLA) {
        float ss = 0.f;
#pragma unroll
        for (int ks = 0; ks < 4; ++ks)
#pragma unroll
            for (int j = 0; j < 8; ++j) { const float x_ = bf2f((bf16_t)qf[ks][j]); ss += x_ * x_; }
        ss = swap32_sum(ss);
        const float km2 = __uint_as_float((WSP(unsigned, WS_CTL) + CW_KMAX)[lyr * 16 + b * 8 + h]);
        qbound = sqrtf(ss * km2) * 1.001f + 0.01f;
    }
    const LAS float* cps = (const LAS float*)(lds + L_CUM);
#define FOX_CP(t_) ((t_) == 0 ? 0.f : cps[(t_) - 1])
    const int nT = 2 * qb + 2;
    TileRegs Ra, Rb;
    tile_load<IS_MLA, !IS_MLA>(Ra, src, 128 * (nT - 1) + 64, tid); tile_load<IS_MLA, !IS_MLA>(Rb, src, 128 * (nT - 1), tid);
    if constexpr (!IS_MLA) { __syncthreads(); src.cref = src.cum[q0] + FOX_CP(4 * qb); }
    tile_store<IS_MLA, !IS_MLA>(Ra, lds, 0, tid, src.cref, IS_MLA ? 0.f : FOX_CP(2 * nT - 1), L_VD); tile_store<IS_MLA, !IS_MLA>(Rb, lds, 1, tid, src.cref, IS_MLA ? 0.f : FOX_CP(2 * nT - 2), L_VD);
    if (nT > 1) { tile_load<IS_MLA, !IS_MLA>(Ra, src, 128 * (nT - 2) + 64, tid); tile_load<IS_MLA, !IS_MLA>(Rb, src, 128 * (nT - 2), tid); }
    __syncthreads();
    for (int it = 0; it < nT; ++it) { const int Tt = nT - 1 - it, sb = 2 * (it & 1);
        if constexpr (!IS_MLA) { if (it >= 2 && (src.cref - cps[2 * Tt + 1]) < mmin_blk - FOX_SKIP) break; }
#pragma unroll
        for (int sub = 1; sub >= 0; --sub) { const int t = 2 * Tt + sub, buf = sb + (1 - sub), kv0 = 64 * t;
            int lim = qrow - kv0 - 4 * hh; FA_LAUNDER(lim);
            dense_step<NKS>(sc, ot, S, VF, lds, buf, qf, r, hh, lane, kv0 + 63 > q0 + 32 * w, lim); (void)t; }
        if constexpr (!IS_MLA) { if (it == 1) { const float v_ = -wave_max(-(S.m - qbound)); if (lane == 0) MM[w] = v_; } }
        if (it + 1 < nT) { tile_store<IS_MLA, !IS_MLA>(Ra, lds, sb ^ 2, tid, src.cref, IS_MLA ? 0.f : FOX_CP(2 * Tt - 1), L_VD); tile_store<IS_MLA, !IS_MLA>(Rb, lds, (sb ^ 2) + 1, tid, src.cref, IS_MLA ? 0.f : FOX_CP(2 * Tt - 2), L_VD);
            if (it + 2 < nT) { tile_load<IS_MLA, !IS_MLA>(Ra, src, 128 * (Tt - 2) + 64, tid); tile_load<IS_MLA, !IS_MLA>(Rb, src, 128 * (Tt - 2), tid); } }
        __syncthreads();
        if constexpr (!IS_MLA) { if (it == 1) { float mm_ = MM[0];
#pragma unroll
            for (int q_ = 1; q_ < 8; ++q_) mm_ = fminf(mm_, MM[q_]);
            mmin_blk = mm_; } }
    }
    { bf16x8 pf[4]; S.l += sm_finish(sc, pf); pv_mma_pf(ot, VF, pf); }
    const float lt = swap32_sum(S.l);
    store_ot(ot, 1.f / lt, orow, hh);
}

#define FA_STREAM(SRC, NT, TILE_EXPR, BODY) do { TileRegs R_; const int nt_ = (NT); \
    if (nt_ > 0) { { const int idx = 0; tile_load<false, false>(R_, SRC, 64 * (TILE_EXPR), tid); } tile_store<false, false>(R_, lds, 0, tid); \
      if (nt_ > 1) { const int idx = 1; tile_load<false, false>(R_, SRC, 64 * (TILE_EXPR), tid); } \
      __syncthreads(); \
      for (int it_ = 0; it_ < nt_; ++it_) { const int buf = it_ & 1; int tile; { const int idx = it_; tile = (TILE_EXPR); } \
          BODY \
          if (it_ + 1 < nt_) { tile_store<false, false>(R_, lds, buf ^ 1, tid); if (it_ + 2 < nt_) { const int idx = it_ + 2; tile_load<false, false>(R_, SRC, 64 * (TILE_EXPR), tid); } } \
          __syncthreads(); } } } while (0)

__device__ __forceinline__ void nsa_unit(const Ctx& c, int b, int g, int j) {
    const int tid = c.tid, lane = c.lane, r = lane & 31, hh = lane >> 5, w = c.wave;
    LAS unsigned char* lds = c.lds;
    const int t0 = 64 * j, tl = r >> 2, hp = r & 3, tokl = 8 * w + tl, tq = t0 + tokl, head = 4 * g + hp; const size_t mrow = (size_t)b * T + tq;
    const bf16_t* P1 = WSP(bf16_t, WS_P1);
    bf16x8 qf[4];
#pragma unroll
    for (int ks = 0; ks < 4; ++ks) qf[ks] = *(const bf16x8*)(P1 + mrow * P1W + C_NQ + head * 64 + 16 * ks + 8 * hh);
    const float gc = sigmoidf_(bf2f(P1[mrow * P1W + C_NG + head * 3 + 0])), gsl = sigmoidf_(bf2f(P1[mrow * P1W + C_NG + head * 3 + 1])), gwn = sigmoidf_(bf2f(P1[mrow * P1W + C_NG + head * 3 + 2]));
    const LAS float* lutL = (const LAS float*)(lds + L_LUT) + head * 132;
    LAS float* PS = (LAS float*)(lds + L_PS); LAS float* FM = (LAS float*)(lds + L_F); LAS unsigned* SEL = (LAS unsigned*)(lds + L_SEL); LAS unsigned* UNI = (LAS unsigned*)(lds + L_UNI);
    LAS unsigned char* TL = (LAS unsigned char*)(lds + L_TL); LAS int* TLN = (LAS int*)(lds + L_TLN);
    f32x16 st[2], ot[2], otot[2]; zero_acc(otot);
    { float zz_ = 0.f; asm volatile("" : "+v"(zz_)); const f32x4 z4 = {zz_, zz_, zz_, zz_}; for (int i = tid; i < 2 * 64 * 132 / 4; i += NTHREADS) ((LAS f32x4*)PS)[i] = z4; }
    if (tid < 256) SEL[tid] = 0u; if (tid < 4) UNI[tid] = 0u;
    const float bfar = lutL[128];
    const int tmin = t0 + 8 * w;
    const int n_ok_max = ((t0 + 63 - 31) >> 4) + 1; const int nct = (n_ok_max + 63) >> 6;
    KVSrc srcc; srcc.K = WSP(bf16_t, WS_KC) + (size_t)(b * 2 + g) * 512 * 64; srcc.kpitch = 64; srcc.K2 = nullptr; srcc.k2pitch = 0; srcc.V = WSP(bf16_t, WS_VC) + (size_t)(b * 2 + g) * 512 * 64; srcc.vpitch = 64; srcc.cum = nullptr; srcc.cref = 0.f;
    SmState Sc{-INFINITY, 0.f};
    FA_STREAM(srcc, nct, idx, {
        const bool farc = (16 * (64 * tile + 63) + 31 + 128 <= tmin);
        qk_tile<4>(st, lds, buf, qf, r, hh, sm_cval(Sc) + (farc ? bfar : 0.f));
        if (!farc) { int db_ = tq - 31 - 1024 * tile - 64 * hh; FA_LAUNDER(db_); FA_FOREACH_REG({ const int dist = db_ - 16 * kc; const float s_ = st[rb][i] + lutL[dist < 0 ? 0 : (dist > 128 ? 128 : dist)]; st[rb][i] = dist < 0 ? -INFINITY : s_; }) }
        sm_stats(st, Sc); });
    { const float lt = swap32_sum(Sc.l); const float inv = lt > 0.f ? 1.f / lt : 0.f; const float msafe = (Sc.m == -INFINITY) ? 0.f : Sc.m;
      zero_acc(ot);
      FA_STREAM(srcc, nct, idx, {
        const bool farc = (16 * (64 * tile + 63) + 31 + 128 <= tmin);
        qk_tile<4>(st, lds, buf, qf, r, hh, (farc ? bfar : 0.f) - msafe);
        if (farc) { FA_FOREACH_REG({ st[rb][i] = ex2(st[rb][i]) * inv; }) }
        else { int db_ = tq - 31 - 1024 * tile - 64 * hh; FA_LAUNDER(db_); FA_FOREACH_REG({ const int dist = db_ - 16 * kc; const float s_ = st[rb][i] + lutL[dist < 0 ? 0 : (dist > 128 ? 128 : dist)]; st[rb][i] = dist < 0 ? 0.f : ex2(s_) * inv; }) }
_Pragma("unroll")
        for (int rb = 0; rb < 2; ++rb)
_Pragma("unroll")
            for (int a = 0; a < 4; ++a) { float q4[4];
_Pragma("unroll")
                for (int e = 0; e < 4; ++e) { float v = st[rb][4 * a + e]; v += dpp_f<0xB1>(v); v += dpp_f<0x4E>(v); q4[e] = v; }
                if (hp == 0) { const int G = 16 * tile + 8 * rb + 2 * a + hh; PS[tokl * 132 + G] = q4[0] + 2.f * (q4[1] + q4[2] + q4[3]); FM[tokl * 132 + G] = q4[0]; } }
        pv_tile(ot, lds, buf, st, lane); });
#pragma unroll
      for (int db = 0; db < 2; ++db)
#pragma unroll
          for (int i = 0; i < 16; ++i) otot[db][i] += gc * ot[db][i]; }
    if (j + 1 <= 16) { if (tid < 64) SEL[tid * 4] = (1u << (j + 1)) - 1u; if (tid == 0) UNI[0] = (1u << (j + 1)) - 1u; }
    else {
        const int tk = tid >> 3, sub = tid & 7; unsigned bits[4] = {1u, 0u, 0u, 0u};
        float cv[16];
#pragma unroll
        for (int k = 0; k < 16; ++k) { const int G = sub + 8 * k; cv[k] = (G >= 1 && G <= j - 2) ? PS[tk * 132 + G] + FM[tk * 132 + G + 1] : -INFINITY; }
#pragma unroll 1
        for (int round = 0; round < 13; ++round) {
            float bv = cv[0]; int bk = 0;
#pragma unroll
            for (int k = 1; k < 16; ++k) { const bool gt = cv[k] > bv; bv = gt ? cv[k] : bv; bk = gt ? k : bk; }
            int bG = sub + 8 * bk;
#define ARGMAX_STEP(CTRL) { const float ov = dpp_f<CTRL>(bv); const int oG = __builtin_amdgcn_update_dpp(0, bG, CTRL, 0xf, 0xf, true); const bool take = (ov > bv) || (ov == bv && oG < bG); bv = take ? ov : bv; bG = take ? oG : bG; }
            ARGMAX_STEP(0xB1) ARGMAX_STEP(0x4E) ARGMAX_STEP(0x141)
#undef ARGMAX_STEP
            const int wk = bG >> 3; const bool own = (bG & 7) == sub;
#pragma unroll
            for (int k = 0; k < 16; ++k) cv[k] = (own && k == wk) ? -INFINITY : cv[k];
            { const unsigned bit_ = 1u << (bG & 31); const int wq_ = bG >> 5; bits[0] |= (wq_ == 0) ? bit_ : 0u; bits[1] |= (wq_ == 1) ? bit_ : 0u; bits[2] |= (wq_ == 2) ? bit_ : 0u; bits[3] |= (wq_ == 3) ? bit_ : 0u; }
        }
        { const int G = j; const unsigned bit_ = 1u << (G & 31); const int wq_ = G >> 5; bits[0] |= (wq_ == 0) ? bit_ : 0u; bits[1] |= (wq_ == 1) ? bit_ : 0u; bits[2] |= (wq_ == 2) ? bit_ : 0u; bits[3] |= (wq_ == 3) ? bit_ : 0u; }
        { const int G = j - 1; const unsigned bit_ = 1u << (G & 31); const int wq_ = G >> 5; bits[0] |= (wq_ == 0) ? bit_ : 0u; bits[1] |= (wq_ == 1) ? bit_ : 0u; bits[2] |= (wq_ == 2) ? bit_ : 0u; bits[3] |= (wq_ == 3) ? bit_ : 0u; }
        if (sub == 0) {
#pragma unroll
            for (int q = 0; q < 4; ++q) { SEL[tk * 4 + q] = bits[q]; if (bits[q]) atomicOr((unsigned*)(UNI + q), bits[q]); } }
    }
    __syncthreads();
    if (tid < 128) { const unsigned u0 = UNI[0], u1 = UNI[1], u2 = UNI[2], u3 = UNI[3]; const int wq_ = tid >> 5, bp = tid & 31;
        const unsigned mw_ = wq_ == 0 ? u0 : wq_ == 1 ? u1 : wq_ == 2 ? u2 : u3;
        if ((mw_ >> bp) & 1u) { const int pos = (wq_ > 0 ? __builtin_popcount(u0) : 0) + (wq_ > 1 ? __builtin_popcount(u1) : 0) + (wq_ > 2 ? __builtin_popcount(u2) : 0) + __builtin_popcount(mw_ & ((1u << bp) - 1u)); TL[pos] = (unsigned char)tid; }
        if (tid == 0) TLN[0] = __builtin_popcount(u0) + __builtin_popcount(u1) + __builtin_popcount(u2) + __builtin_popcount(u3); }
    __syncthreads();
    const unsigned msk0 = SEL[tokl * 4 + 0], msk1 = SEL[tokl * 4 + 1], msk2 = SEL[tokl * 4 + 2], msk3 = SEL[tokl * 4 + 3];
    const int nsel = __builtin_amdgcn_readfirstlane(TLN[0]);
    { KVSrc srcs; srcs.K = P1 + (size_t)b * T * P1W + C_NKV + ((1 * 2 + 0) * 2 + g) * 64; srcs.kpitch = P1W; srcs.K2 = nullptr; srcs.k2pitch = 0; srcs.V = P1 + (size_t)b * T * P1W + C_NKV + ((1 * 2 + 1) * 2 + g) * 64; srcs.vpitch = P1W; srcs.cum = nullptr; srcs.cref = 0.f;
      SmState Ss{-INFINITY, 0.f}; zero_acc(ot);
      FA_STREAM(srcs, nsel, (int)TL[idx], {
        const int wq = tile >> 5; const unsigned mw = wq == 0 ? msk0 : wq == 1 ? msk1 : wq == 2 ? msk2 : msk3; const bool mine = (mw >> (tile & 31)) & 1u;
        if (__any(mine)) {
            const bool fars = (64 * tile + 63 + 128 <= tmin);
            qk_tile<4>(st, lds, buf, qf, r, hh, mine ? sm_cval(Ss) + (fars ? bfar : 0.f) : -INFINITY);
            if (!fars) { int db_ = tq - 64 * tile - 4 * hh; FA_LAUNDER(db_); FA_FOREACH_REG({ const int dist = db_ - kc; const float s_ = st[rb][i] + lutL[dist < 0 ? 0 : (dist > 128 ? 128 : dist)]; st[rb][i] = (dist >= 0) ? s_ : -INFINITY; }) }
            VFrags VF; v_read(VF, lds, buf, lane); __builtin_amdgcn_sched_barrier(0);
            sm_update(st, Ss, ot);
            pv_mma(ot, VF, st); } });
      const float lt = swap32_sum(Ss.l); const float sc = lt > 0.f ? gsl / lt : 0.f;
#pragma unroll
      for (int db = 0; db < 2; ++db)
#pragma unroll
          for (int i = 0; i < 16; ++i) otot[db][i] += sc * ot[db][i]; }
    { KVSrc srcw; srcw.K = P1 + (size_t)b * T * P1W + C_NKV + ((2 * 2 + 0) * 2 + g) * 64; srcw.kpitch = P1W; srcw.K2 = nullptr; srcw.k2pitch = 0; srcw.V = P1 + (size_t)b * T * P1W + C_NKV + ((2 * 2 + 1) * 2 + g) * 64; srcw.vpitch = P1W; srcw.cum = nullptr; srcw.cref = 0.f;
      const int jlo = j - 8 > 0 ? j - 8 : 0;
      SmState Sw{-INFINITY, 0.f}; zero_acc(ot);
      FA_STREAM(srcw, j - jlo + 1, jlo + idx, {
        qk_tile<4>(st, lds, buf, qf, r, hh, sm_cval(Sw));
        { int db_ = tq - 64 * tile - 4 * hh; FA_LAUNDER(db_); FA_FOREACH_REG({ const int dist = db_ - kc; const float s_ = st[rb][i] + lutL[dist < 0 ? 0 : (dist > 128 ? 128 : dist)]; st[rb][i] = (dist >= 0 && dist < 512) ? s_ : -INFINITY; }) }
        VFrags VF; v_read(VF, lds, buf, lane); __builtin_amdgcn_sched_barrier(0);
        sm_update(st, Sw, ot);
        pv_mma(ot, VF, st); });
      const float lt = swap32_sum(Sw.l); const float sc = lt > 0.f ? gwn / lt : 0.f;
#pragma unroll
      for (int db = 0; db < 2; ++db)
#pragma unroll
          for (int i = 0; i < 16; ++i) otot[db][i] += sc * ot[db][i]; }
    store_ot(otot, 1.f, WSP(bf16_t, WS_P1) + mrow * P1W + C_NQ + head * 64, hh);
}
}

__device__ __forceinline__ int next_unit(const Ctx& c, unsigned* ctr, int& seq) {
    LAS int* u = (LAS int*)(c.lds + fa::L_UNIT) + (seq & 1); ++seq;
    if (c.tid == 0) u[0] = (int)__hip_atomic_fetch_add(ctr, 1u, __ATOMIC_RELAXED, __HIP_MEMORY_SCOPE_AGENT);
    __syncthreads();
    return __builtin_amdgcn_readfirstlane(u[0]);
}
__device__ __forceinline__ void phase_att_fast(const Ctx& c0, int l) {
    Ctx c = c0;
    unsigned* ctr0 = WSP(unsigned, WS_CTL) + CW_QUEUE + 64 * 8 * l;
    { const float* lut = WSP(float, WS_TAB) + 512; LAS float* L_ = (LAS float*)(c.lds + fa::L_LUT); for (int i = c.tid; i < 8 * 132; i += NTHREADS) L_[i] = lut[i]; }
    const int myx = (int)(xb_xcc_id() & 7u);
    int seq = 0;
    for (int qi = 0; qi < 8; ++qi) {
        const int x = (myx + qi) & 7;
        for (;;) {
            const int u = next_unit(c, ctr0 + 64 * x, seq);
            if (u >= 192) break;
            relaunder(c);
            if (u < 48 || (u >= 112 && u < 128)) { const int uu = u < 48 ? u : u - 112; const int qb = (u < 48 ? 31 : 7) - (uu >> 1); const int p = 2 * x + (uu & 1); if (ATT_FAST_MLA) fa::dense_unit<true>(c, l & 1, p >> 3, p & 7, qb); }
            else if (u < 112) { const int n = u - 48, grp = x >> 1; if (ATT_FAST_NSA) fa::nsa_unit(c, grp >> 1, grp & 1, 127 - 2 * n - (x & 1)); }
            else { const int p = 2 * x + (u & 1); if (ATT_FAST_FOX) fa::dense_unit<false>(c, l & 1, p >> 3, p & 7, 31 - ((u - 128) >> 1)); }
        }
    }
}

struct Args { const void* in[32]; float* out; unsigned char* ws; int l_lo, l_hi; };
constexpr int PH_PER_LAYER = 15, K_FINAL = 1 + PH_PER_LAYER;
template <int KIND>
__global__ void __launch_bounds__(NTHREADS, 2) fwd_kernel(Args a) {
    extern __shared__ __attribute__((aligned(16))) unsigned char lds_raw[];
    Ctx c;
    c.out = a.out; c.ws = a.ws; c.ws0 = a.ws; c.lds = (LAS unsigned char*)lds_raw;
    c.tid = threadIdx.x; c.lane = c.tid & 63; c.wave = __builtin_amdgcn_readfirstlane(c.tid >> 6); c.G = gridDim.x; c.bid = blockIdx.x;
    if (c.tid < 4) ((LAS unsigned*)(c.lds + LDS_MISC))[c.tid] = 0u;
    if (c.tid < 32) { const unsigned long long pv = (unsigned long long)a.in[c.tid]; ((LAS unsigned*)(c.lds + LDS_INTAB))[2 * c.tid] = (unsigned)pv; ((LAS unsigned*)(c.lds + LDS_INTAB))[2 * c.tid + 1] = (unsigned)(pv >> 32); }
    __syncthreads();
    XcdBarrier bar; bar.bar = WSP(unsigned, WS_CTL) + CW_BAR; bar.x = 0; bar.st = nullptr;
    if constexpr (KIND < 0) bar = xcd_barrier_post(WSP(unsigned, WS_CTL) + CW_BAR, (volatile LAS unsigned*)(c.lds + LDS_MISC));
#define IN(k) ((KIND < 0 || KIND == (k)) && (relaunder(c), true))
#define REP(p) for (int rep_ = 0; rep_ < ((PROBE_DOUBLE == (p)) ? 2 : 1); ++rep_)
#define SEAM(k) do { if constexpr (KIND < 0) { unsigned* bb_ = bar.bar; asm volatile("" : "+s"(bb_)); bar.bar = bb_; xcd_barrier(bar); } } while (0)
    LAS unsigned char* ring = c.lds;

    if (IN(0)) REP(4) { phase_prologue(c); } SEAM(0);
    for (int l = a.l_lo; l < a.l_hi; ++l) {
        constexpr int pb = 1;
        const float* resid = (l == 0) ? c.x() : WSP(float, WS_XA);
        if (IN(pb + 0)) { if (l == 0) phase_norm(c, c.x(), nullptr, nullptr, nullptr, nullptr, WSP(bf16_t, WS_H0));
                          else phase_norm(c, l == 1 ? c.x() : WSP(float, WS_XA), WSP(bf16_t, WS_DELTA), WSP(bf16_t, WS_Y), WSP(bf16_t, WS_Y) + (size_t)M * D, WSP(float, WS_XA), WSP(bf16_t, WS_H0));
        } SEAM(pb + 0);
        if (IN(pb + 1)) REP(2) { pg8::Cfg g{(unsigned)(D * 2), 128u, (unsigned)(D * 2), D / 64, nullptr}; pg8::DenseOrder S; S.init(M / 256, (c.G >= 256 || (l == 1 && c.G >= 128)) ? NCAT / 256 - 1 : NCAT / 256, c.G, c.bid, WSP(bf16_t, WS_H0), (size_t)256 * D * 2, WSP(bf16_t, WS_WINT) + (size_t)l * NCAT * D, (size_t)256 * D * 2);
            EpiInprojGates E{WSP(bf16_t, WS_P1), WSP(unsigned char, WS_GATES), c.b_merge() + l * 3072}; pg8::gemm_phase<false>(ring, c.wave, g, S, E);
            if (l == 0 && c.G >= 256) {
                relaunder(c);
                LAS float* scr = (LAS float*)(c.lds + c.wave * 16384); const int NGW = c.G * NWAVES; const int gw = c.bid * NWAVES + c.wave;
#define URG_MAKE(i_) prologue_item(c, (i_) < (PO_WO - PO_UQ) ? PO_UQ + (i_) : PO_C1 + ((i_) - (PO_WO - PO_UQ)))
                T_SIMPLE((PO_WO - PO_UQ) + 2 * PI_C1, URG_MAKE);
#undef URG_MAKE
            } else if (l == 0) {
                int nfull = (M / 256) * (NCAT / 256) - 6 * c.G; if (nfull < 0 || nfull >= c.G) nfull = 0;
                relaunder(c);
                LAS float* scr = (LAS float*)(c.lds + c.wave * 16384); const int NGW = (c.G - nfull) * NWAVES; const int gw = (c.bid >= nfull) ? (c.bid - nfull) * NWAVES + c.wave : 0x3fffffff;
#define DEF_MAKE(i_) prologue_item(c, (PI_WIN + PI_WM) + (i_))
                T_SIMPLE(NL * PI_PER_L - (PI_WIN + PI_WM), DEF_MAKE);
#undef DEF_MAKE
            } } SEAM(pb + 1);
        if (IN(pb + 2)) {
            const bool split = c.G >= 64; const bool defer = (c.G >= 256 || (l == 1 && c.G >= 128));
            const int nprep = split ? c.G - 32 - (defer ? M / 256 : 0) : c.G;
            if (!split || c.bid < nprep) phase_prep(c, l, c.bid, nprep);
            else if (c.bid < c.G - 32) { pg8::Cfg g{(unsigned)(D * 2), 128u, (unsigned)(D * 2), D / 64, nullptr};
                OneTileOrder S{c.bid - nprep, NCAT / 256 - 1, (const char*)WSP(bf16_t, WS_H0), (const char*)(WSP(bf16_t, WS_WINT) + (size_t)l * NCAT * D), (size_t)256 * D * 2, (size_t)256 * D * 2};
                EpiInprojGates E{WSP(bf16_t, WS_P1), WSP(unsigned char, WS_GATES), c.b_merge() + l * 3072}; pg8::gemm_phase<false>(ring, c.wave, g, S, E); }
            if (!split || c.bid >= c.G - 32) { pg8::Cfg g{(unsigned)(16 * P1W * 2), (unsigned)(P1W * 2), 4096u, 16, nullptr};
                CmpOrder S{split ? 32 : c.G, split ? c.bid - (c.G - 32) : c.bid, (const char*)WSP(bf16_t, WS_P1), (const char*)(WSP(bf16_t, WS_WC1T) + (size_t)l * 2 * 256 * 2048)};
                EpiCmpSlab E{WSP(float, WS_SL)}; pg8::gemm_phase<false>(ring, c.wave, g, S, E); }
        } SEAM(pb + 2);
        if (IN(pb + 3)) REP(2) {
            phase_cmp2(c, l); phase_chunk_prefix(c);
            { pg8::Cfg g{(unsigned)(P1W * 2), 128u, 512u, 4, nullptr}; pg8::DenseOrder S; S.init(M / 256, 2, c.G, c.bid, WSP(bf16_t, WS_P1) + C_CQ, (size_t)256 * P1W * 2, WSP(bf16_t, WS_WUQT) + (size_t)l * 768 * 256, (size_t)256 * 512);
              EpiStoreBf16 E{WSP(bf16_t, WS_QB), 768, WSP(float, WS_RSTD), 2}; pg8::gemm_phase<false>(ring, c.wave, g, S, E); }
            { pg8::Cfg g{(unsigned)(P1W * 2), 128u, 512u, 4, nullptr}; pg8::DenseOrder S; S.init(M / 256, 1, c.G, (c.bid + 128) % c.G, WSP(bf16_t, WS_P1) + C_CQ, (size_t)256 * P1W * 2, WSP(bf16_t, WS_WUQT) + (size_t)l * 768 * 256 + (size_t)512 * 256, (size_t)256 * 512);
              EpiUqRope E{WSP(bf16_t, WS_QB) + 512, WSP(float, WS_RSTD), WSP(float, WS_ROPE), WSP(float, WS_ROPE) + (size_t)M * 16}; pg8::gemm_phase<false>(ring, c.wave, g, S, E); }
            { pg8::Cfg g{(unsigned)(P1W * 2), 128u, 256u, 2, nullptr}; pg8::DenseOrder S; S.init(M / 256, 4, c.G, c.bid, WSP(bf16_t, WS_P1) + C_CKV, (size_t)256 * P1W * 2, WSP(bf16_t, WS_WUKVT) + (size_t)l * 1024 * 128, (size_t)256 * 256);
              EpiStoreBf16 E{WSP(bf16_t, WS_KVB), 1024, WSP(float, WS_RSTD) + 1, 2}; pg8::gemm_phase<false>(ring, c.wave, g, S, E); }
            if (l == 0 && c.G >= 256 && c.bid >= 192) {
                relaunder(c); LAS float* scr = (LAS float*)(c.lds + c.wave * 16384); const int NGW = (c.G - 192) * NWAVES; const int gw = (c.bid - 192) * NWAVES + c.wave;
#define WO_MAKE(i_) prologue_item(c, PO_WO + (i_))
                T_SIMPLE(PO_C1 - PO_WO, WO_MAKE);
#undef WO_MAKE
            }
        } SEAM(pb + 3);
        if (IN(pb + 6)) { phase_att_fast(c, l);
#if PROBE_DOUBLE == 1
            phase_att_fast(c, l + 2);
#endif
        } SEAM(pb + 6);
        if (IN(pb + 9)) REP(2) {
            pg8::Cfg g{(unsigned)(P1W * 2), 128u, 1024u, 8, nullptr};
            OutprojOrderH S{c.G, c.bid, (const char*)c.ws, (long long)(WS_P1 + C_NQ * 2), (long long)WS_QB - (long long)(WS_P1 + C_NQ * 2), (long long)(C_FQKV - C_NQ) * 2, (const char*)(WSP(bf16_t, WS_WOT) + (size_t)l * 3 * 1024 * 512), (unsigned)(P1W * 2), 768u * 2u};
            EpiOutprojH E{WSP(bf16_t, WS_MIXED), WSP(unsigned char, WS_GATES)}; pg8::gemm_phase<false, true>(ring, c.wave, g, S, E);
        } SEAM(pb + 9);
        if (IN(pb + 10)) { pg8::Cfg g{(unsigned)(D * 2), 128u, (unsigned)(D * 2), D / 64, nullptr}; pg8::DenseOrder S; S.init(M / 256, 4, c.G, c.bid, WSP(bf16_t, WS_MIXED), (size_t)256 * D * 2, WSP(bf16_t, WS_WOUTT) + (size_t)l * D * D, (size_t)256 * D * 2);
            EpiStoreBf16 E{WSP(bf16_t, WS_DELTA), 1024, nullptr, 0}; pg8::gemm_phase<false>(ring, c.wave, g, S, E);
        } SEAM(pb + 10);
        if (IN(pb + 11)) { phase_router(c, l, resid);
#if PROBE_DOUBLE == 3
            phase_router(c, l, resid, 1);
#endif
        } SEAM(pb + 11);
        if (IN(pb + 12)) REP(4) { phase_place(c, l); } SEAM(pb + 12);
        if (IN(pb + 13)) REP(2) { LAS int* tab = (LAS int*)(c.lds + LDS_MOETAB); moe_tables(c, l, tab);
            pg8::Cfg g{(unsigned)(D * 2), 128u, (unsigned)(D * 2), D / 64, WSP(int, WS_LTOK)}; MoeOrder S{c.G, c.bid, 2, tab, (const char*)WSP(bf16_t, WS_H2), 0, (const char*)WSP(bf16_t, WS_WGU), (size_t)512 * D * 2, (size_t)256 * D * 2};
            EpiMoe1 E{WSP(bf16_t, WS_HID), WSP(float, WS_LW)}; pg8::gemm_phase<true>(ring, c.wave, g, S, E);
            { const int nun = __builtin_amdgcn_readfirstlane(tab[32]) * 2; int n2 = nun - c.G; if (n2 < 0) n2 = 0; if (n2 >= c.G) n2 = 0;
              if (c.bid >= n2) { relaunder(c); LAS float* scr = (LAS float*)(c.lds + c.wave * 16384); const int gw = (c.bid - n2) * NWAVES + c.wave, NGW = (c.G - n2) * NWAVES;
#define DN_MAKE(i_) place_item_dn(c, l, (i_))
                  T_SIMPLE(32 * 128, DN_MAKE);
#undef DN_MAKE
                  if (l == 0 && c.G >= 256) {
#define L1A_MAKE(i_) prologue_item(c, PI_PER_L + (i_))
                      T_SIMPLE(PO_UQ, L1A_MAKE);
#undef L1A_MAKE
                  }
              } }
        } SEAM(pb + 13);
        if (IN(pb + 14)) REP(2) { LAS int* tab = (LAS int*)(c.lds + LDS_MOETAB); moe_tables(c, l, tab);
            pg8::Cfg g{512u, 128u, 512u, 4, nullptr}; MoeOrder S{c.G, c.bid, 4, tab, (const char*)WSP(bf16_t, WS_HID), 512, (const char*)WSP(bf16_t, WS_WDT), (size_t)D * 256 * 2, (size_t)256 * 256 * 2};
            EpiMoe2 E{WSP(bf16_t, WS_Y), WSP(unsigned, WS_LSLOT)}; pg8::gemm_phase<false>(ring, c.wave, g, S, E);
            if (l == 0 && c.G >= 256) {
                int n3 = __builtin_amdgcn_readfirstlane(tab[32]) * 4 - 2 * c.G; if (n3 < 0 || n3 >= c.G) n3 = 0;
                if (c.bid >= n3) { relaunder(c); LAS float* scr = (LAS float*)(c.lds + c.wave * 16384); const int gw = (c.bid - n3) * NWAVES + c.wave, NGW = (c.G - n3) * NWAVES;
#define L1B_MAKE(i_) prologue_item(c, PI_PER_L + PO_UQ + (i_))
                    T_SIMPLE(PI_PER_L - PO_UQ, L1B_MAKE);
#undef L1B_MAKE
                } } } SEAM(pb + 14);
    }
    if (IN(K_FINAL)) REP(6) { phase_final(c); }
#undef IN
#undef SEAM
}

template <int KIND> static bool prep_kernel() { return hipFuncSetAttribute((const void*)fwd_kernel<KIND>, hipFuncAttributeMaxDynamicSharedMemorySize, LDS_BYTES) == hipSuccess; }
template <int KIND> static void launch_kind(int grid, hipStream_t stream, Args a, int l) { a.l_lo = l; a.l_hi = l + 1; hipLaunchKernelGGL(fwd_kernel<KIND>, dim3(grid), dim3(NTHREADS), LDS_BYTES, stream, a); }
extern "C" void kernel_launch(void* const* d_in, const int* in_sizes, int n_in, void* d_out, int out_size, void* d_ws, size_t ws_size, hipStream_t stream) {
    static int grid = 0;
    if (grid == 0) {
        if (n_in != 32 || ws_size < WS_END) { fprintf(stderr, "kernel_launch: n_in %d ws %zu (need %zu)\n", n_in, ws_size, (size_t)WS_END); grid = -1; return; }
        int dev = 0, cus = 0;
        if (hipGetDevice(&dev) != hipSuccess || hipDeviceGetAttribute(&cus, hipDeviceAttributeMultiprocessorCount, dev) != hipSuccess) { grid = -1; return; }
        bool ok = true;
#if MK_ONE_LAUNCH
        ok = prep_kernel<-1>();
#else
        ok = prep_kernel<0>() && prep_kernel<1>() && prep_kernel<2>() && prep_kernel<3>() && prep_kernel<4>() && prep_kernel<5>() && prep_kernel<6>() && prep_kernel<7>() && prep_kernel<8>() && prep_kernel<9>()
          && prep_kernel<10>() && prep_kernel<11>() && prep_kernel<12>() && prep_kernel<13>() && prep_kernel<14>() && prep_kernel<15>() && prep_kernel<16>();
#endif
        if (!ok) { grid = -1; return; }
        (void)hipGetLastError();
        grid = cus;
    }
    if (grid < 0) return;
    (void)hipMemsetAsync((char*)d_ws + WS_CTL, 0, CTL_BYTES, stream);
    Args a{};
    for (int i = 0; i < 32; ++i) a.in[i] = d_in[i];
    a.out = (float*)d_out; a.ws = (unsigned char*)d_ws;
#if MK_ONE_LAUNCH
    a.l_lo = 0; a.l_hi = NL;
    hipLaunchKernelGGL(fwd_kernel<-1>, dim3(grid), dim3(NTHREADS), LDS_BYTES, stream, a);
#else
    launch_kind<0>(grid, stream, a, 0);
    for (int l = 0; l < NL; ++l) {
        launch_kind<1>(grid, stream, a, l); launch_kind<2>(grid, stream, a, l); launch_kind<3>(grid, stream, a, l); launch_kind<4>(grid, stream, a, l); launch_kind<5>(grid, stream, a, l);
        launch_kind<6>(grid, stream, a, l); launch_kind<7>(grid, stream, a, l); launch_kind<8>(grid, stream, a, l); launch_kind<9>(grid, stream, a, l); launch_kind<10>(grid, stream, a, l);
        launch_kind<11>(grid, stream, a, l); launch_kind<12>(grid, stream, a, l); launch_kind<13>(grid, stream, a, l); launch_kind<14>(grid, stream, a, l); launch_kind<15>(grid, stream, a, l);
    }
    launch_kind<16>(grid, stream, a, 0);
#endif
}
```

```cpp
#include <hip/hip_runtime.h>
#include <stdint.h>
#include <cstdio>

#ifndef PROBE_DOUBLE
#define PROBE_DOUBLE 0
#endif
#ifndef MK_ONE_LAUNCH
#define MK_ONE_LAUNCH 1
#endif

#define LAS __attribute__((address_space(3)))
typedef unsigned short bf16_t;
typedef short bf16x8 __attribute__((ext_vector_type(8)));
typedef float f32x4 __attribute__((ext_vector_type(4)));
typedef float f32x16 __attribute__((ext_vector_type(16)));
typedef unsigned u32x4 __attribute__((ext_vector_type(4)));
typedef unsigned u32x2 __attribute__((ext_vector_type(2)));

constexpr int NB = 2, T = 8192, D = 1024, M = NB * T, NL = 2;
constexpr int DIN = 6336;
constexpr int P1W = 3328;
constexpr int C_NQ = 0, C_NKV = 512, C_CQ = 1280, C_CKV = 1536, C_KR = 1664, C_NG = 1696, C_FF = 1720, C_FQKV = 1728;
constexpr int NEXP = 32, EDIM = 256;
constexpr float EPS = 1e-6f;
constexpr float LOG2E = 1.4426950408889634f;
constexpr float QSCALE64 = 0.125f * LOG2E, QSCALE96 = 0.10206207261596575f * LOG2E;
constexpr int NTHREADS = 512, NWAVES = 8;
constexpr int LDS_BYTES = 147456;
constexpr int MOE_MAXROWS = 40960;

constexpr size_t MiB = 1u << 20;
constexpr size_t WS_CTL = 0;
constexpr size_t CTL_BYTES = 1 * MiB;
constexpr int CW_BAR = 4096;
constexpr int CW_QUEUE = 16384;
constexpr int CW_MOECNT = 32768;
constexpr int CW_KMAX = 24576;
constexpr int CW_CNTB = 65536;
constexpr size_t CTL_LTOK = 512 * 1024;
constexpr size_t WS_WINT = 1 * MiB;
constexpr int NCAT = 6400;
constexpr size_t WS_WUQT = 26 * MiB;
constexpr size_t WS_WUKVT = 27 * MiB;
constexpr size_t WS_WOT = 28 * MiB;
constexpr size_t WS_WOUTT = 34 * MiB;
constexpr size_t WS_WC1T = 38 * MiB;
constexpr size_t WS_ROPE = 42 * MiB;
constexpr size_t WS_TAB = 44 * MiB;
static_assert(NL == 2, "the bf16 residual copy is written once, by layer 1's first norm");
constexpr size_t WS_RS2 = 45 * MiB + 32 * MiB;
constexpr size_t WS_XA = 45 * MiB;
constexpr size_t PB = 109 * MiB;
constexpr size_t WS_P1 = PB;
constexpr size_t WS_QB = PB + 104 * MiB;
constexpr size_t WS_KVB = PB + 128 * MiB;
constexpr size_t WS_H0 = PB + 128 * MiB;
constexpr size_t WS_GATES = PB + 160 * MiB;
constexpr size_t WS_SM = PB + 208 * MiB;
constexpr size_t WS_RSTD = WS_SM;
constexpr size_t WS_KR = WS_SM + 256 * 1024;
constexpr size_t WS_LF = WS_SM + 1280 * 1024;
constexpr size_t WS_CUM = WS_SM + 1792 * 1024;
constexpr size_t WS_SL = WS_SM + 2304 * 1024;
constexpr size_t WS_KC = WS_SM + 6400 * 1024;
constexpr size_t WS_VC = WS_SM + 6656 * 1024;
constexpr size_t WS_REC = WS_SM + 6912 * 1024;
constexpr size_t WS_LTOK = WS_SM + 7424 * 1024;
constexpr size_t WS_LW = WS_SM + 7616 * 1024;
constexpr size_t WS_LSLOT = WS_SM + 7808 * 1024;
static_assert(WS_LSLOT + MOE_MAXROWS * 4 <= WS_SM + 8 * MiB, "small region");
constexpr size_t WS_END = PB + 216 * MiB;
constexpr size_t WS_MIXED = PB + 128 * MiB;
constexpr size_t WS_Y = PB;
constexpr size_t WS_H2 = PB + 64 * MiB;
constexpr size_t WS_WGU = PB + 96 * MiB;
constexpr size_t WS_WDT = PB + 128 * MiB;
constexpr size_t WS_DELTA = PB + 168 * MiB;
constexpr size_t WS_HID = PB + 144 * MiB;
static_assert(WS_Y + 64 * MiB <= WS_H0 && WS_HID + (size_t)MOE_MAXROWS * 512 <= WS_SM, "phase-region overlays");
static_assert(WS_END <= 332 * MiB, "workspace budget");

__device__ __forceinline__ float bf2f(bf16_t v) { return __uint_as_float((unsigned)v << 16); }
__device__ __forceinline__ unsigned f2bf(float f) { unsigned u = __float_as_uint(f); return (u + 0x7fffu + ((u >> 16) & 1u)) >> 16; }
__device__ __forceinline__ unsigned pk2(float lo, float hi) { return f2bf(lo) | (f2bf(hi) << 16); }
typedef float f32x2_t __attribute__((ext_vector_type(2))); typedef __bf16 bf16x2_t __attribute__((ext_vector_type(2)));
__device__ __forceinline__ unsigned cvtpk(float lo, float hi) { f32x2_t v = {lo, hi}; bf16x2_t b = __builtin_convertvector(v, bf16x2_t); return __builtin_bit_cast(unsigned, b); }
__device__ __forceinline__ f32x4 unpk4(u32x2 a) { f32x4 r; r.x = __uint_as_float(a.x << 16); r.y = __uint_as_float(a.x & 0xffff0000u); r.z = __uint_as_float(a.y << 16); r.w = __uint_as_float(a.y & 0xffff0000u); return r; }
template <int CTRL> __device__ __forceinline__ float dpp_f(float v) { return __int_as_float(__builtin_amdgcn_update_dpp(0, __float_as_int(v), CTRL, 0xf, 0xf, true)); }
__device__ __forceinline__ float wave_sum(float v) {
    v += dpp_f<0xB1>(v); v += dpp_f<0x4E>(v); v += dpp_f<0x141>(v); v += dpp_f<0x140>(v);
    const float a = __int_as_float(__builtin_amdgcn_readlane(__float_as_int(v), 0)), b = __int_as_float(__builtin_amdgcn_readlane(__float_as_int(v), 16));
    const float c2 = __int_as_float(__builtin_amdgcn_readlane(__float_as_int(v), 32)), d = __int_as_float(__builtin_amdgcn_readlane(__float_as_int(v), 48));
    return (a + b) + (c2 + d);
}
__device__ __forceinline__ float wave_max(float v) {
    v = fmaxf(v, dpp_f<0xB1>(v)); v = fmaxf(v, dpp_f<0x4E>(v)); v = fmaxf(v, dpp_f<0x141>(v)); v = fmaxf(v, dpp_f<0x140>(v));
    const float a = __int_as_float(__builtin_amdgcn_readlane(__float_as_int(v), 0)), b = __int_as_float(__builtin_amdgcn_readlane(__float_as_int(v), 16));
    const float c2 = __int_as_float(__builtin_amdgcn_readlane(__float_as_int(v), 32)), d = __int_as_float(__builtin_amdgcn_readlane(__float_as_int(v), 48));
    return fmaxf(fmaxf(a, b), fmaxf(c2, d));
}
__device__ __forceinline__ float half_sum(float v) { auto rr = __builtin_amdgcn_permlane32_swap(__float_as_uint(v), __float_as_uint(v), false, false); return __uint_as_float(rr[0]) + __uint_as_float(rr[1]); }
__device__ __forceinline__ float sigmoidf_(float x) { return __builtin_amdgcn_rcpf(1.f + __expf(-x)); }
__device__ __forceinline__ float gelu_tanh(float x) { const float u = 0.7978845608028654f * (x + 0.044715f * x * x * x); const float th = 1.f - 2.f * __builtin_amdgcn_rcpf(1.f + __expf(2.f * u)); return 0.5f * x * (1.f + th); }
#define LDS_WAIT() asm volatile("s_waitcnt lgkmcnt(0)" ::: "memory")

#define XB_TMO      128
#define XB_XCNT(j)  (256  + 64 * (j))
#define XB_XSUB(j)  (1280 + 64 * (j))
#define XB_XGEN(j)  (2304 + 64 * (j))
#define XB_TOP      3328
#define XB_TOPGEN   3392
#define XCD_BAR_WORDS 3456
#define XB_SPIN_CAP (1u << 18)

__device__ __forceinline__ unsigned xb_ld(unsigned* p)              { return __hip_atomic_load(p, __ATOMIC_RELAXED, __HIP_MEMORY_SCOPE_AGENT); }
__device__ __forceinline__ unsigned xb_add(unsigned* p, unsigned v) { return __hip_atomic_fetch_add(p, v, __ATOMIC_RELAXED, __HIP_MEMORY_SCOPE_AGENT); }
__device__ __forceinline__ unsigned xb_xcc_id() { return (unsigned)__builtin_amdgcn_s_getreg((3 << 11) | 20) & 0xFu; }
#define XB_SPIN(cond, bar) do { unsigned _sp = 0; while (cond) { __builtin_amdgcn_s_sleep(1); \
    if ((++_sp & 255u) == 0u) { if (xb_ld(&(bar)[XB_TMO])) break; if (_sp > XB_SPIN_CAP) { atomicAdd(&(bar)[XB_TMO], 1u); break; } } } } while (0)

struct XcdBarrier { unsigned* bar; unsigned x; volatile LAS unsigned* st; };

__device__ __forceinline__ XcdBarrier xcd_barrier_post(unsigned* bar, volatile LAS unsigned* st) {
    XcdBarrier b; b.bar = bar; b.x = xb_xcc_id(); b.st = st;
    if (threadIdx.x == 0) (void)xb_add(&bar[XB_XCNT(b.x)], 1u);
    return b;
}
__device__ __forceinline__ void xcd_barrier_complete(unsigned* bar, unsigned x, unsigned& nloc, unsigned& nx) {
    const unsigned G = gridDim.x * gridDim.y * gridDim.z;
    unsigned sum, cnt, mine, sp = 0u;
    for (;;) {
        sum = 0u; cnt = 0u; mine = 0u;
#pragma unroll
        for (unsigned j = 0; j < 16; ++j) { const unsigned c = xb_ld(&bar[XB_XCNT(j)]); sum += c; cnt += (c > 0u) ? 1u : 0u; mine = (j == x) ? c : mine; }
        if (sum == G) break;
        __builtin_amdgcn_s_sleep(1);
        if ((++sp & 255u) == 0u) { if (xb_ld(&bar[XB_TMO])) break; if (sp > XB_SPIN_CAP) { atomicAdd(&bar[XB_TMO], 1u); break; } }
    }
    nloc = mine > 0u ? mine : 1u; nx = cnt > 0u ? cnt : 1u;
}
__device__ __forceinline__ void xcd_barrier(const XcdBarrier& b) {
    asm volatile("s_waitcnt vmcnt(0)" ::: "memory");
    __syncthreads();
    if (threadIdx.x == 0) {
        unsigned* bar = b.bar;
        __builtin_amdgcn_s_waitcnt(0);
        unsigned nloc = b.st[0], nx = b.st[1];
        if (nloc == 0u) { xcd_barrier_complete(bar, b.x, nloc, nx); b.st[0] = nloc; b.st[1] = nx; }
        const unsigned old = xb_add(&bar[XB_XSUB(b.x)], 1u);
        const unsigned gen = old / nloc;
        if (old + 1u == (gen + 1u) * nloc) {
            __builtin_amdgcn_fence(__ATOMIC_RELEASE, "agent");
            asm volatile("s_waitcnt vmcnt(0)" ::: "memory");
            const unsigned og = xb_add(&bar[XB_TOP], 1u);
            const unsigned tg = og / nx;
            if (og + 1u == (tg + 1u) * nx) xb_add(&bar[XB_TOPGEN], 1u);
            else XB_SPIN(xb_ld(&bar[XB_TOPGEN]) == tg, bar);
            __builtin_amdgcn_fence(__ATOMIC_ACQUIRE, "agent");
            xb_add(&bar[XB_XGEN(b.x)], 1u);
            asm volatile("s_waitcnt vmcnt(0)" ::: "memory");
        } else {
            XB_SPIN(xb_ld(&bar[XB_XGEN(b.x)]) == gen, bar);
            __builtin_amdgcn_fence(__ATOMIC_ACQUIRE, "agent");
            asm volatile("s_waitcnt vmcnt(0)" ::: "memory");
        }
    }
    __syncthreads();
}

namespace pg8 {
constexpr int BM = 256, BK = 64, HALF = 128, HTB = HALF * BK * 2, STAGE_BYTES = 8 * HTB;
__host__ __device__ __forceinline__ int lds_byte(int r, int c) { const int st = (r >> 4) * 2 + (c >> 5), rr = r & 15, cc = c & 31, ob = rr * 64 + cc * 2; return st * 1024 + (ob ^ (((ob >> 9) & 1) << 5)); }
__host__ __device__ __forceinline__ void stage_rc(int b, int& R, int& C) { const int st = b / 1024, sb = b % 1024, swz = sb ^ (((sb >> 9) & 1) << 5); R = (st >> 1) * 16 + swz / 64; C = (st & 1) * 32 + (swz % 64) / 2; }

struct Unit { int pm, pn; const char* A; const char* B; int aux; unsigned lda; };
struct Cfg { unsigned lda; unsigned kstepA; unsigned ldb; int nt; const int* rowidx; };

struct DenseOrder {
    int nM, nN, nwg, G, c; const char* A; const char* B; size_t tstepA, tstepB;
    __device__ void init(int nM_, int nN_, int G_, int c_, const void* A_, size_t tstepA_, const void* B_, size_t tstepB_) { nM = nM_; nN = nN_; nwg = nM * nN; G = G_; c = c_; A = (const char*)A_; B = (const char*)B_; tstepA = tstepA_; tstepB = tstepB_; }
    __device__ bool next(int i, Unit& u) const {
        const long Lq = (long)i * G + c; if (Lq >= nwg) return false;
        int wgid = (int)Lq; { const int q = nwg / 8, r = nwg % 8, xcd = wgid % 8, off = wgid / 8; wgid = (xcd < r ? xcd * (q + 1) : r * (q + 1) + (xcd - r) * q) + off; }
        const int nig = 8 * nN, gid = wgid / nig, fm = gid * 8, gsz = (nM - fm) < 8 ? (nM - fm) : 8;
        u.pm = fm + ((wgid % nig) % gsz); u.pn = (wgid % nig) / gsz; u.A = A + (size_t)u.pm * tstepA; u.B = B + (size_t)u.pn * tstepB; u.aux = 0; u.lda = 0u; return true;
    }
};

#define PG8_EPI_ROWCOL(row, col) const int row = u.pm * 256 + ai * 128 + wr * 64 + m * 16 + fr; const int col = u.pn * 256 + bj * 128 + wc * 32 + n * 16 + fq * 4;

template <bool INDEXED, bool MHALF = false, class Epi, class Sched>
__device__ __forceinline__ void gemm_phase(LAS unsigned char* lds, int wid, const Cfg g, const Sched& S, const Epi& E) {
    int lane_; asm volatile("v_mbcnt_lo_u32_b32 %0, -1, 0\n\tv_mbcnt_hi_u32_b32 %0, -1, %0" : "=v"(lane_));
    const int lane = lane_, tid = wid * 64 + lane, wr = wid >> 2, wc = wid & 3, fr = lane & 15, fq = lane >> 4;
    const int nt = g.nt;
    int Rs[2], Cs[2]; unsigned voffB[2];
#pragma unroll
    for (int i = 0; i < 2; ++i) { stage_rc(tid * 16 + i * 8192, Rs[i], Cs[i]); voffB[i] = (unsigned)Rs[i] * g.ldb + (unsigned)Cs[i] * 2u; }
    const size_t kstepA = g.kstepA, kstepB = (size_t)(BK * 2);
    const size_t hstepB = (size_t)HALF * g.ldb;
    const unsigned ldsw = (unsigned)wid * 1024u;
    const int aoff = lds_byte(wr * 64 + fr, fq * 8), boff = lds_byte(wc * 32 + fr, fq * 8);
#define PG8_SA(b, h) (((b) * 2 + (h)) * HTB)
#define PG8_SB(b, h) ((4 + (b) * 2 + (h)) * HTB)
#define PG8_STAGE2(bufoff, gbase, v0, v1) do { const char* gb_ = (const char*)(gbase); asm volatile("" : "+s"(gb_)); \
        __builtin_amdgcn_global_load_lds((const unsigned*)(gb_ + (v0)), (LAS unsigned*)(lds + (bufoff) + ldsw), 16, 0, 0); \
        __builtin_amdgcn_global_load_lds((const unsigned*)(gb_ + (v1)), (LAS unsigned*)(lds + (bufoff) + ldsw + 8192), 16, 0, 0); } while (0)
#define PG8_STAGEB(bufoff, gbase) PG8_STAGE2(bufoff, gbase, voffB[0], voffB[1])
#define PG8_LDA(dst, b, h) do { _Pragma("unroll") for (int m = 0; m < 4; ++m) _Pragma("unroll") for (int k = 0; k < 2; ++k) dst[m][k] = *(const LAS bf16x8*)(lds + PG8_SA(b, h) + aoff + m * 2048 + k * 1024); } while (0)
#define PG8_LDB(dst, b, h) do { _Pragma("unroll") for (int n = 0; n < 2; ++n) _Pragma("unroll") for (int k = 0; k < 2; ++k) dst[n][k] = *(const LAS bf16x8*)(lds + PG8_SB(b, h) + boff + n * 2048 + k * 1024); } while (0)
#define PG8_MMA(ai, bj, At, Bt) do { __builtin_amdgcn_s_setprio(1); _Pragma("unroll") for (int m = 0; m < 4; ++m) _Pragma("unroll") for (int n = 0; n < 2; ++n) _Pragma("unroll") for (int k = 0; k < 2; ++k) \
        acc[ai][bj][m][n] = __builtin_amdgcn_mfma_f32_16x16x32_bf16(Bt[n][k], At[m][k], acc[ai][bj][m][n], 0, 0, 0); __builtin_amdgcn_s_setprio(0); } while (0)
#define PG8_WAIT_V(n) asm volatile("s_waitcnt vmcnt(" #n ")" ::: "memory")
#define PG8_WAIT_L(n) asm volatile("s_waitcnt lgkmcnt(" #n ")" ::: "memory")
#define PG8_BAR __builtin_amdgcn_s_barrier()
#define PG8_SCHED __builtin_amdgcn_sched_barrier(0)
    Unit cur, nxt; int ui = 0;
    if (!S.next(0, cur)) return;
    unsigned vAc[2][2], vAn[2][2];
#define PG8_SETVA(v, U) do { _Pragma("unroll") for (int h_ = 0; h_ < (MHALF ? 1 : 2); ++h_) _Pragma("unroll") for (int i_ = 0; i_ < 2; ++i_) { \
        if constexpr (INDEXED) { const int r_ = g.rowidx[(U).aux + h_ * HALF + Rs[i_]]; v[h_][i_] = (unsigned)r_ * g.lda + (unsigned)Cs[i_] * 2u; } \
        else v[h_][i_] = (unsigned)(h_ * HALF + Rs[i_]) * ((U).lda ? (U).lda : g.lda) + (unsigned)Cs[i_] * 2u; } } while (0)
    PG8_SETVA(vAc, cur);
    f32x4 acc[2][2][4][2];
#pragma unroll
    for (int a = 0; a < 2; ++a)
#pragma unroll
        for (int b = 0; b < 2; ++b)
#pragma unroll
            for (int m = 0; m < 4; ++m)
#pragma unroll
                for (int n = 0; n < 2; ++n) acc[a][b][m][n] = (f32x4){0.f, 0.f, 0.f, 0.f};
    bf16x8 At[4][2], B0[2][2], B1[2][2];
    const char* cA = cur.A; const char* cB = cur.B;
    PG8_STAGEB(PG8_SB(0, 0), cB); PG8_STAGEB(PG8_SB(0, 1), cB + hstepB); PG8_STAGE2(PG8_SA(0, 0), cA, vAc[0][0], vAc[0][1]); if constexpr (!MHALF) PG8_STAGE2(PG8_SA(0, 1), cA, vAc[1][0], vAc[1][1]);
    if (wr == 1) PG8_BAR;
    if constexpr (MHALF) PG8_WAIT_V(0); else PG8_WAIT_V(2);
    PG8_BAR;
    PG8_STAGEB(PG8_SB(1, 0), cB + kstepB); PG8_STAGE2(PG8_SA(1, 0), cA + kstepA, vAc[0][0], vAc[0][1]); PG8_STAGEB(PG8_SB(1, 1), cB + hstepB + kstepB);
    PG8_WAIT_V(6); PG8_BAR;
    for (;;) {
        const bool has_next = S.next(ui + 1, nxt);
        const char* nA = has_next ? nxt.A : cA; const char* nB = has_next ? nxt.B : cB;
        if (has_next) { PG8_SETVA(vAn, nxt); } else {
#pragma unroll
            for (int h_ = 0; h_ < 2; ++h_)
#pragma unroll
                for (int i_ = 0; i_ < 2; ++i_) vAn[h_][i_] = vAc[h_][i_]; }
        for (int t = 0; t < nt; t += 2) {
            const bool last = (t == nt - 2);
            const char* a1 = cA + (size_t)(t + 1) * kstepA;
            const char* a2 = last ? nA : cA + (size_t)(t + 2) * kstepA; const char* b2 = last ? nB : cB + (size_t)(t + 2) * kstepB;
            const char* a3 = a2 + kstepA; const char* b3 = b2 + kstepB;
            const unsigned w00 = last ? vAn[0][0] : vAc[0][0], w01 = last ? vAn[0][1] : vAc[0][1], w10 = last ? vAn[1][0] : vAc[1][0], w11 = last ? vAn[1][1] : vAc[1][1];
            PG8_LDB(B0, 0, 0); PG8_LDB(B1, 0, 1); PG8_SCHED; PG8_LDA(At, 0, 0); if constexpr (!MHALF) PG8_STAGE2(PG8_SA(1, 1), a1, vAc[1][0], vAc[1][1]);
            if constexpr (MHALF) PG8_WAIT_V(6); else PG8_WAIT_V(8);
            PG8_WAIT_L(0); PG8_BAR; PG8_MMA(0, 0, At, B0); PG8_MMA(0, 1, At, B1); PG8_BAR; PG8_SCHED;
            if constexpr (!MHALF) PG8_LDA(At, 0, 1);
            PG8_STAGEB(PG8_SB(0, 0), b2); PG8_STAGEB(PG8_SB(0, 1), b2 + hstepB); PG8_STAGE2(PG8_SA(0, 0), a2, w00, w01);
            if constexpr (MHALF) PG8_WAIT_V(6); else PG8_WAIT_V(8);
            PG8_WAIT_L(0); PG8_BAR; if constexpr (!MHALF) { PG8_MMA(1, 0, At, B0); PG8_MMA(1, 1, At, B1); } PG8_BAR; PG8_SCHED;
            PG8_LDB(B0, 1, 0); PG8_LDB(B1, 1, 1); PG8_SCHED; PG8_LDA(At, 1, 0); if constexpr (!MHALF) PG8_STAGE2(PG8_SA(0, 1), a2, w10, w11);
            if constexpr (MHALF) PG8_WAIT_V(6); else PG8_WAIT_V(8);
            PG8_WAIT_L(0); PG8_BAR; PG8_MMA(0, 0, At, B0); PG8_MMA(0, 1, At, B1); PG8_BAR; PG8_SCHED;
            if constexpr (!MHALF) PG8_LDA(At, 1, 1);
            PG8_STAGEB(PG8_SB(1, 0), b3); PG8_STAGEB(PG8_SB(1, 1), b3 + hstepB); PG8_STAGE2(PG8_SA(1, 0), a3, w00, w01);
            if constexpr (MHALF) PG8_WAIT_V(6); else PG8_WAIT_V(8);
            PG8_WAIT_L(0); PG8_BAR; if constexpr (!MHALF) { PG8_MMA(1, 0, At, B0); PG8_MMA(1, 1, At, B1); } PG8_BAR; PG8_SCHED;
        }
        if (wr == 0) PG8_BAR;
        { int l2_; asm volatile("v_mbcnt_lo_u32_b32 %0, -1, 0\n\tv_mbcnt_hi_u32_b32 %0, -1, %0" : "=v"(l2_)); E(acc, cur, wr, wc, l2_ & 15, l2_ >> 4); }
        if (!has_next) break;
#pragma unroll
        for (int a = 0; a < (MHALF ? 1 : 2); ++a)
#pragma unroll
            for (int b = 0; b < 2; ++b)
#pragma unroll
                for (int m = 0; m < 4; ++m)
#pragma unroll
                    for (int n = 0; n < 2; ++n) acc[a][b][m][n] = (f32x4){0.f, 0.f, 0.f, 0.f};
        cur = nxt; cA = nA; cB = nB; ++ui;
#pragma unroll
        for (int h_ = 0; h_ < 2; ++h_)
#pragma unroll
            for (int i_ = 0; i_ < 2; ++i_) vAc[h_][i_] = vAn[h_][i_];
        if (wr == 1) PG8_BAR;
    }
    PG8_WAIT_V(0);
    PG8_BAR;
#undef PG8_SA
#undef PG8_SB
#undef PG8_STAGE2
#undef PG8_STAGEB
#undef PG8_LDA
#undef PG8_LDB
#undef PG8_MMA
#undef PG8_WAIT_V
#undef PG8_WAIT_L
#undef PG8_BAR
#undef PG8_SCHED
#undef PG8_SETVA
}
}

struct OneTileOrder { int pm, pn; const char* A; const char* B; size_t tstepA, tstepB;
    __device__ bool next(int i, pg8::Unit& u) const { if (i > 0) return false; u.pm = pm; u.pn = pn; u.A = A + (size_t)pm * tstepA; u.B = B + (size_t)pn * tstepB; u.aux = 0; u.lda = 0u; return true; } };
constexpr int LDS_MISC = 131072;
constexpr int LDS_MOETAB = LDS_MISC + 64;
constexpr int LDS_INTAB = LDS_MISC + 512;
struct Ctx {
    float* out; unsigned char* ws; unsigned char* ws0;
    LAS unsigned char* lds;
    int tid, lane, wave, G, bid;
    __device__ __forceinline__ const void* inp(int i) const { const LAS unsigned* p = (const LAS unsigned*)(lds + LDS_INTAB) + 2 * i;
        const unsigned lo = (unsigned)__builtin_amdgcn_readfirstlane((int)p[0]), hi = (unsigned)__builtin_amdgcn_readfirstlane((int)p[1]); return (const void*)(const __attribute__((address_space(1))) char*)(((unsigned long long)hi << 32) | lo); }
    __device__ __forceinline__ const float* x() const { return (const float*)inp(0); }
    __device__ __forceinline__ const int* pos() const { return (const int*)inp(1); }
    __device__ __forceinline__ const float* rel_bias() const { return (const float*)inp(2); }
    __device__ __forceinline__ const float* norm_attn() const { return (const float*)inp(3); }
    __device__ __forceinline__ const float* w_in() const { return (const float*)inp(4); }
    __device__ __forceinline__ const float* b_merge() const { return (const float*)inp(5); }
    __device__ __forceinline__ const float* cmp_pe() const { return (const float*)inp(6); }
    __device__ __forceinline__ const float* cmp_k_w1() const { return (const float*)inp(7); }
    __device__ __forceinline__ const float* cmp_k_b1() const { return (const float*)inp(8); }
    __device__ __forceinline__ const float* cmp_k_w2() const { return (const float*)inp(9); }
    __device__ __forceinline__ const float* cmp_v_w1() const { return (const float*)inp(10); }
    __device__ __forceinline__ const float* cmp_v_b1() const { return (const float*)inp(11); }
    __device__ __forceinline__ const float* cmp_v_w2() const { return (const float*)inp(12); }
    __device__ __forceinline__ const float* mla_q_norm() const { return (const float*)inp(13); }
    __device__ __forceinline__ const float* mla_kv_norm() const { return (const float*)inp(14); }
    __device__ __forceinline__ const float* mla_w_uq() const { return (const float*)inp(15); }
    __device__ __forceinline__ const float* mla_w_uk() const { return (const float*)inp(16); }
    __device__ __forceinline__ const float* mla_w_uv() const { return (const float*)inp(17); }
    __device__ __forceinline__ const float* fox_b_f() const { return (const float*)inp(18); }
    __device__ __forceinline__ const float* w_o_nsa() const { return (const float*)inp(19); }
    __device__ __forceinline__ const float* w_o_mla() const { return (const float*)inp(20); }
    __device__ __forceinline__ const float* w_o_fox() const { return (const float*)inp(21); }
    __device__ __forceinline__ const float* w_out() const { return (const float*)inp(22); }
    __device__ __forceinline__ const float* norm_ffn() const { return (const float*)inp(23); }
    __device__ __forceinline__ const float* moe_w_grp() const { return (const float*)inp(24); }
    __device__ __forceinline__ const float* moe_b_grp() const { return (const float*)inp(25); }
    __device__ __forceinline__ const float* moe_w_router() const { return (const float*)inp(26); }
    __device__ __forceinline__ const float* moe_b_router() const { return (const float*)inp(27); }
    __device__ __forceinline__ const float* moe_w_gate() const { return (const float*)inp(28); }
    __device__ __forceinline__ const float* moe_w_up() const { return (const float*)inp(29); }
    __device__ __forceinline__ const float* moe_w_down() const { return (const float*)inp(30); }
    __device__ __forceinline__ const float* norm_final() const { return (const float*)inp(31); }
};
#define WSP(T_, off) ((T_*)(c.ws + (off)))
__device__ __forceinline__ int lane_id_volatile() { int ln; asm volatile("v_mbcnt_lo_u32_b32 %0, -1, 0\n\tv_mbcnt_hi_u32_b32 %0, -1, %0" : "=v"(ln)); return ln; }
__device__ __forceinline__ void relaunder(Ctx& c) { const int ln = lane_id_volatile(); c.lane = ln; c.tid = c.wave * 64 + ln;
    size_t z_ = 0; asm volatile("" : "+s"(z_)); c.ws = c.ws0 + z_; int g_ = c.G, b_ = c.bid, wv_ = c.wave; asm volatile("" : "+s"(g_), "+s"(b_), "+s"(wv_)); c.G = g_; c.bid = b_; c.wave = wv_; }

struct TItem { const float* wp; size_t ldw; bf16_t* wt; const float* rsp; float colscale; int K; bool pad; };
__device__ __forceinline__ TItem make_titem(const float* W, int ldw, int K, bf16_t* WT, const float* rowscale, int sc, int nblk, int item, int lane, float colscale) {
    const int kb = item / nblk, nb = item % nblk, k0 = 64 * kb, n0 = 32 * nb, cc = lane & 7;
    TItem t; t.wp = W + (size_t)(k0 + (lane >> 5)) * ldw + (sc >= 0 ? sc : 0); t.ldw = (size_t)ldw; t.wt = WT + (size_t)n0 * K + k0 + 8 * cc; t.rsp = rowscale ? rowscale + k0 + 8 * cc : nullptr; t.colscale = colscale; t.K = K; t.pad = sc < 0;
    return t;
}
__device__ __forceinline__ void t_load(const TItem& t, float (&v)[32], float (&rsc)[8]) {
#pragma unroll
    for (int i = 0; i < 32; ++i) v[i] = __builtin_nontemporal_load(t.wp + (size_t)(2 * i) * t.ldw);
    if (t.rsp) { const f32x4 a = *(const f32x4*)t.rsp, b = *(const f32x4*)(t.rsp + 4); rsc[0] = a.x; rsc[1] = a.y; rsc[2] = a.z; rsc[3] = a.w; rsc[4] = b.x; rsc[5] = b.y; rsc[6] = b.z; rsc[7] = b.w; }
    else { float one_ = 1.f; asm volatile("" : "+v"(one_));
#pragma unroll
        for (int i = 0; i < 8; ++i) rsc[i] = one_; }
}
__device__ __forceinline__ void t_finish(const TItem& t, const float (&v)[32], const float (&rsc)[8], LAS float* scr, int lane) {
    const int cc = lane & 7;
#pragma unroll
    for (int i = 0; i < 32; ++i) scr[(2 * i + (lane >> 5)) * 33 + (lane & 31)] = t.pad ? 0.f : v[i];
    LDS_WAIT(); asm volatile("" ::: "memory");
#pragma unroll
    for (int j = 0; j < 4; ++j) { const int n = (lane >> 3) + 8 * j; const LAS float* s_ = scr + (8 * cc) * 33 + n; const float cs = t.colscale;
        u32x4 o; o.x = cvtpk(s_[0 * 33] * (rsc[0] * cs), s_[1 * 33] * (rsc[1] * cs)); o.y = cvtpk(s_[2 * 33] * (rsc[2] * cs), s_[3 * 33] * (rsc[3] * cs));
        o.z = cvtpk(s_[4 * 33] * (rsc[4] * cs), s_[5 * 33] * (rsc[5] * cs)); o.w = cvtpk(s_[6 * 33] * (rsc[6] * cs), s_[7 * 33] * (rsc[7] * cs));
        *(u32x4*)(t.wt + (size_t)n * t.K) = o; }
    LDS_WAIT(); asm volatile("" ::: "memory");
}
#define T_PIPELINE(N_ITEMS, MAKE) do { int it_ = gw;    if (it_ < (N_ITEMS)) { TItem A_ = MAKE(it_); float va_[32], ra_[8]; t_load(A_, va_, ra_); \
    for (;;) { const int itn_ = it_ + NGW; const bool hb_ = itn_ < (N_ITEMS); TItem B_; float vb_[32], rb_[8]; if (hb_) { B_ = MAKE(itn_); t_load(B_, vb_, rb_); } \
        __builtin_amdgcn_sched_barrier(0); t_finish(A_, va_, ra_, scr, c.lane); if (!hb_) break; \
        const int itn2_ = itn_ + NGW; const bool ha_ = itn2_ < (N_ITEMS); if (ha_) { A_ = MAKE(itn2_); t_load(A_, va_, ra_); } \
        __builtin_amdgcn_sched_barrier(0); t_finish(B_, vb_, rb_, scr, c.lane); if (!ha_) break; it_ = itn2_; } } } while (0)
#define T_SIMPLE(N_ITEMS, MAKE) do { for (int it_ = gw; it_ < (N_ITEMS); it_ += NGW) { TItem A_ = MAKE(it_); float va_[32], ra_[8]; t_load(A_, va_, ra_); __builtin_amdgcn_sched_barrier(0); t_finish(A_, va_, ra_, scr, c.lane); } } while (0)
struct MapId { int off; __device__ int operator()(int n) const { return n + off; } };
struct MapInproj { __device__ int operator()(int n) const { if (n < 1280) return n; if (n < 1696) return n + 24; if (n < 1720) return n - 416; if (n < 1728) return n + 1536; if (n < 3264) return n - 8; return -1; } };
struct MapUq { __device__ int operator()(int n) const { if (n < 512) return (n >> 6) * 96 + (n & 63); const int r = n - 512; return (r >> 5) * 96 + 64 + (r & 31); } };
struct MapPad128 { __device__ int operator()(int n) const { return n < 128 ? n : -1; } };
struct MapGU { __device__ int operator()(int n) const { return (n >> 8) * 128 + (n & 127); } };

__device__ __forceinline__ int rel_bucket_dev(int n) {
    if (n < 16) return n;
    const float lr = __logf((float)n / 16.f) / 2.0794415416798357f;
    int large = 16 + (int)(lr * 16.f);
    return large < 31 ? large : 31;
}

constexpr int PI_WIN = 16 * (P1W / 32), PI_WM = 16 * 96, PI_UQ = 4 * 24, PI_UK = 2 * 16, PI_UV = 2 * 16, PI_WO = 8 * 32, PI_WOUT = 16 * 32, PI_C1 = 32 * 8;
constexpr int PI_PER_L = PI_WIN + PI_WM + PI_UQ + PI_UK + PI_UV + 3 * PI_WO + PI_WOUT + 2 * PI_C1;
constexpr int PO_UQ = PI_WIN + PI_WM, PO_WO = PO_UQ + PI_UQ + PI_UK + PI_UV, PO_C1 = PO_WO + 3 * PI_WO + PI_WOUT;
__device__ __forceinline__ TItem prologue_item(const Ctx& c, int it) {
    const int l = it / PI_PER_L; int r = it % PI_PER_L; const int ln = c.lane & 31;
    if (r < PI_WIN) { const int n0_ = 32 * (r % (P1W / 32)); const float cs_ = (n0_ < 512 || (n0_ >= C_FQKV && n0_ < C_FQKV + 512)) ? QSCALE64 : 1.f;
        return make_titem(c.w_in() + (size_t)l * D * DIN, DIN, D, WSP(bf16_t, WS_WINT) + (size_t)l * NCAT * D, c.norm_attn() + l * D, MapInproj{}(n0_ + ln), P1W / 32, r, c.lane, cs_); } r -= PI_WIN;
    if (r < PI_WM) return make_titem(c.w_in() + (size_t)l * D * DIN, DIN, D, WSP(bf16_t, WS_WINT) + ((size_t)l * NCAT + P1W) * D, c.norm_attn() + l * D, 3264 + 32 * (r % 96) + ln, 96, r, c.lane, 1.f); r -= PI_WM;
    if (r < PI_UQ) return make_titem(c.mla_w_uq() + (size_t)l * 256 * 768, 768, 256, WSP(bf16_t, WS_WUQT) + (size_t)l * 768 * 256, c.mla_q_norm() + l * 256, MapUq{}(32 * (r % 24) + ln), 24, r, c.lane, QSCALE96); r -= PI_UQ;
    if (r < PI_UK) return make_titem(c.mla_w_uk() + (size_t)l * 128 * 512, 512, 128, WSP(bf16_t, WS_WUKVT) + (size_t)l * 1024 * 128, c.mla_kv_norm() + l * 128, 32 * (r % 16) + ln, 16, r, c.lane, 1.f); r -= PI_UK;
    if (r < PI_UV) return make_titem(c.mla_w_uv() + (size_t)l * 128 * 512, 512, 128, WSP(bf16_t, WS_WUKVT) + (size_t)l * 1024 * 128 + 512 * 128, c.mla_kv_norm() + l * 128, 32 * (r % 16) + ln, 16, r, c.lane, 1.f); r -= PI_UV;
    if (r < 3 * PI_WO) { const int br = r / PI_WO, rr = r % PI_WO; return make_titem((const float*)c.inp(19 + br) + (size_t)l * 512 * 1024, 1024, 512, WSP(bf16_t, WS_WOT) + ((size_t)l * 3 + br) * 1024 * 512, nullptr, 32 * (rr % 32) + ln, 32, rr, c.lane, 1.f); } r -= 3 * PI_WO;
    if (r < PI_WOUT) return make_titem(c.w_out() + (size_t)l * D * D, D, D, WSP(bf16_t, WS_WOUTT) + (size_t)l * D * D, nullptr, 32 * (r % 32) + ln, 32, r, c.lane, 1.f); r -= PI_WOUT;
    { const int kv = r / PI_C1, rr = r % PI_C1; const int n_ = 32 * (rr % 8) + ln;
      return make_titem((const float*)c.inp(kv == 0 ? 7 : 10) + (size_t)l * 2048 * 128, 128, 2048, WSP(bf16_t, WS_WC1T) + ((size_t)l * 2 + kv) * 256 * 2048, nullptr, n_ < 128 ? n_ : -1, 8, rr, c.lane, 1.f); }
}
__device__ __forceinline__ void phase_prologue(const Ctx& c) {
    LAS float* scr = (LAS float*)(c.lds + c.wave * 16384);
    const int gw = c.bid * NWAVES + c.wave, NGW = c.G * NWAVES;
#define PRO_MAKE(i_) prologue_item(c, (i_))
    T_PIPELINE(PI_WIN + PI_WM, PRO_MAKE);
#undef PRO_MAKE
    { float* rc = WSP(float, WS_ROPE); float* rs = rc + (size_t)M * 16;
      for (int i = c.bid * NTHREADS + c.tid; i < M * 16; i += c.G * NTHREADS) { const int m = i >> 4, j = i & 15;
          const float inv = exp2f(-(float)j * 0.8304820237218407f);   const float ang = (float)c.pos()[m] * inv; double rev = (double)ang * 0.15915494309189535; rev -= floor(rev); const float fr_ = (float)rev; rc[i] = __builtin_amdgcn_cosf(fr_); rs[i] = __builtin_amdgcn_sinf(fr_); } }
    float* tab = WSP(float, WS_TAB);
    for (int o = c.bid * NWAVES + c.wave; o < 512; o += c.G * NWAVES) {
        const int l = o >> 8, kv = (o >> 7) & 1, j = o & 127;
        const float* w1 = (const float*)c.inp(kv == 0 ? 7 : 10) + (size_t)l * 2048 * 128 + j; const float* pe = c.cmp_pe() + l * 2048;
        float wv[32], pv_[32];
#pragma unroll
        for (int i = 0; i < 32; ++i) { const int k = c.lane + 64 * i; wv[i] = w1[(size_t)k * 128]; pv_[i] = pe[k]; }
        float s_ = 0.f;
#pragma unroll
        for (int i = 0; i < 32; ++i) s_ += wv[i] * pv_[i];
        s_ = wave_sum(s_);
        if (c.lane == 0) tab[o] = s_ + ((const float*)c.inp(kv == 0 ? 8 : 11))[l * 128 + j];
    }
    if (c.bid == 1 % c.G) {
        for (int i = c.tid; i < 8 * 129; i += NTHREADS) { const int h = i / 129, d = i % 129; tab[512 + h * 132 + d] = c.rel_bias()[rel_bucket_dev(d) * 8 + h] * LOG2E; }
    }
}

__device__ __forceinline__ void phase_norm(const Ctx& c, const float* src, const bf16_t* dl, const bf16_t* y0, const bf16_t* y1, float* rout, bf16_t* hout) {
    const int gw = c.bid * NWAVES + c.wave, NGW = c.G * NWAVES;
    for (int m = gw; m < M; m += NGW) {
        const f32x4* xr = (const f32x4*)(src + (size_t)m * D) + c.lane;
        f32x4 v[4]; float s = 0.f;
#pragma unroll
        for (int j = 0; j < 4; ++j) { v[j] = __builtin_nontemporal_load(xr + 64 * j);
            if (y0) { const u32x2 a = *((const u32x2*)(y0 + (size_t)m * D) + c.lane + 64 * j); const u32x2 b = *((const u32x2*)(y1 + (size_t)m * D) + c.lane + 64 * j); const u32x2 d = *((const u32x2*)(dl + (size_t)m * D) + c.lane + 64 * j);
                v[j].x += (__uint_as_float(a.x << 16) + __uint_as_float(b.x << 16)) + __uint_as_float(d.x << 16); v[j].y += (__uint_as_float(a.x & 0xffff0000u) + __uint_as_float(b.x & 0xffff0000u)) + __uint_as_float(d.x & 0xffff0000u);
                v[j].z += (__uint_as_float(a.y << 16) + __uint_as_float(b.y << 16)) + __uint_as_float(d.y << 16); v[j].w += (__uint_as_float(a.y & 0xffff0000u) + __uint_as_float(b.y & 0xffff0000u)) + __uint_as_float(d.y & 0xffff0000u); }
            s += (v[j].x * v[j].x + v[j].y * v[j].y) + (v[j].z * v[j].z + v[j].w * v[j].w); }
        const float rstd = rsqrtf(wave_sum(s) * (1.f / D) + EPS);
        if (rout) { u32x2* ro = (u32x2*)((bf16_t*)rout + (size_t)m * D) + c.lane;
#pragma unroll
            for (int j = 0; j < 4; ++j) { u32x2 w; w.x = pk2(v[j].x, v[j].y); w.y = pk2(v[j].z, v[j].w); ro[64 * j] = w; } }
        u32x2* o8 = (u32x2*)(hout + (size_t)m * D) + c.lane;
#pragma unroll
        for (int j = 0; j < 4; ++j) { u32x2 w; w.x = pk2(v[j].x * rstd, v[j].y * rstd); w.y = pk2(v[j].z * rstd, v[j].w * rstd); o8[64 * j] = w; }
    }
}
__device__ __forceinline__ void phase_norm_h2(const Ctx& c, bf16_t* rout, bf16_t* hout) {
    const int gw = c.bid * NWAVES + c.wave, NGW = c.G * NWAVES;
    const bf16_t* h2 = WSP(bf16_t, WS_H2); const float* rs2 = WSP(float, WS_RS2); const bf16_t* y0 = WSP(bf16_t, WS_Y); const bf16_t* y1 = y0 + (size_t)M * D;
    for (int m = gw; m < M; m += NGW) {
        const float inv = rs2[m];
        u32x2 hq[4], aq[4], bq[4];
#pragma unroll
        for (int j = 0; j < 4; ++j) { hq[j] = __builtin_nontemporal_load((const u32x2*)(h2 + (size_t)m * D) + c.lane + 64 * j); aq[j] = __builtin_nontemporal_load((const u32x2*)(y0 + (size_t)m * D) + c.lane + 64 * j); bq[j] = __builtin_nontemporal_load((const u32x2*)(y1 + (size_t)m * D) + c.lane + 64 * j); }
        f32x4 v[4]; float s = 0.f;
#pragma unroll
        for (int j = 0; j < 4; ++j) { v[j] = unpk4(hq[j]) * inv + (unpk4(aq[j]) + unpk4(bq[j])); s += (v[j].x * v[j].x + v[j].y * v[j].y) + (v[j].z * v[j].z + v[j].w * v[j].w); }
        const float rstd = rsqrtf(wave_sum(s) * (1.f / D) + EPS);
        u32x2* ro = (u32x2*)(rout + (size_t)m * D) + c.lane; u32x2* o8 = (u32x2*)(hout + (size_t)m * D) + c.lane;
#pragma unroll
        for (int j = 0; j < 4; ++j) { u32x2 w; w.x = pk2(v[j].x, v[j].y); w.y = pk2(v[j].z, v[j].w); ro[64 * j] = w; }
#pragma unroll
        for (int j = 0; j < 4; ++j) { u32x2 w; w.x = pk2(v[j].x * rstd, v[j].y * rstd); w.y = pk2(v[j].z * rstd, v[j].w * rstd); o8[64 * j] = w; }
    }
}
__device__ __forceinline__ void phase_final(const Ctx& c) {
    const int gw = c.bid * NWAVES + c.wave, NGW = c.G * NWAVES;
    const bf16_t* h2 = WSP(bf16_t, WS_H2); const float* rs2 = WSP(float, WS_RS2); const bf16_t* y0 = WSP(bf16_t, WS_Y); const bf16_t* y1 = y0 + (size_t)M * D;
    f32x4 g4[4];
#pragma unroll
    for (int j = 0; j < 4; ++j) g4[j] = *((const f32x4*)c.norm_final() + c.lane + 64 * j);
    for (int m = gw; m < M; m += NGW) {
        const float inv = rs2[m];
        u32x2 hq[4], aq[4], bq[4];
#pragma unroll
        for (int j = 0; j < 4; ++j) { hq[j] = __builtin_nontemporal_load((const u32x2*)(h2 + (size_t)m * D) + c.lane + 64 * j); aq[j] = __builtin_nontemporal_load((const u32x2*)(y0 + (size_t)m * D) + c.lane + 64 * j); bq[j] = __builtin_nontemporal_load((const u32x2*)(y1 + (size_t)m * D) + c.lane + 64 * j); }
        f32x4 v[4]; float s = 0.f;
#pragma unroll
        for (int j = 0; j < 4; ++j) { v[j] = unpk4(hq[j]) * inv + (unpk4(aq[j]) + unpk4(bq[j])); s += (v[j].x * v[j].x + v[j].y * v[j].y) + (v[j].z * v[j].z + v[j].w * v[j].w); }
        const float rstd = rsqrtf(wave_sum(s) * (1.f / D) + EPS);
        f32x4* ro = (f32x4*)(c.out + (size_t)m * D) + c.lane;
#pragma unroll
        for (int j = 0; j < 4; ++j) ro[64 * j] = v[j] * rstd * g4[j];
    }
}

constexpr size_t WS_LC = WS_LF, WS_CT = WS_CUM, WS_CP = WS_CUM + 64 * 1024;
__device__ __forceinline__ void phase_prep(const Ctx& c, int l, int cbid, int cG) {
    const bf16_t* P1 = WSP(bf16_t, WS_P1); float* rstd = WSP(float, WS_RSTD); bf16_t* KR = WSP(bf16_t, WS_KR); float* LC = WSP(float, WS_LC); float* CT = WSP(float, WS_CT);
    const float* rc = WSP(float, WS_ROPE); const float* rs = rc + (size_t)M * 16;
    float kmx0 = 0.f, kmx1 = 0.f;
    LAS unsigned* kml = (LAS unsigned*)(c.lds + 4096); LAS float* wt = (LAS float*)(c.lds + 4096 + 64);
    if (c.tid < 16) kml[c.tid] = 0u;
    __syncthreads();
    const float bf_ = (c.lane < 8) ? c.fox_b_f()[l * 8 + c.lane] : 0.f;
    for (int ch = cbid; ch < M / 64; ch += cG) {
        float run = 0.f, rv[8];
#pragma unroll
        for (int i = 0; i < 8; ++i) { const int m = ch * 64 + c.wave * 8 + i;
            const bf16_t* row = P1 + (size_t)m * P1W;
            const u32x2 a = *((const u32x2*)(row + C_CQ) + c.lane);
            const unsigned b = *((const unsigned*)(row + C_CKV) + c.lane);
            const u32x4 kq = *((const u32x4*)(row + C_FQKV + 512) + c.lane);
            const int l16 = c.lane & 15, l8 = c.lane & 7;
            const float x1r = bf2f(row[C_KR + l16]), x2r = bf2f(row[C_KR + 16 + l16]), csr = rc[m * 16 + l16], snr = rs[m * 16 + l16], ffr = bf2f(row[C_FF + l8]);
            const float x1 = (c.lane < 16) ? x1r : 0.f, x2 = (c.lane < 16) ? x2r : 0.f, cs = (c.lane < 16) ? csr : 0.f, sn = (c.lane < 16) ? snr : 0.f, ff = (c.lane < 8) ? ffr : 0.f;
            float q0 = __uint_as_float(a.x << 16), q1 = __uint_as_float(a.x & 0xffff0000u), q2 = __uint_as_float(a.y << 16), q3 = __uint_as_float(a.y & 0xffff0000u);
            const float sq = wave_sum(q0 * q0 + q1 * q1 + q2 * q2 + q3 * q3);
            float k0 = __uint_as_float(b << 16), k1 = __uint_as_float(b & 0xffff0000u);
            const float sk = wave_sum(k0 * k0 + k1 * k1);
            if (c.lane == 0) { rstd[2 * m] = rsqrtf(sq * (1.f / 256.f) + EPS); rstd[2 * m + 1] = rsqrtf(sk * (1.f / 128.f) + EPS); }
            if (c.lane < 16) { KR[m * 32 + c.lane] = (bf16_t)f2bf(x1 * cs - x2 * sn); KR[m * 32 + 16 + c.lane] = (bf16_t)f2bf(x1 * sn + x2 * cs); }
            { const f32x4 a0 = unpk4((u32x2){kq.x, kq.y}), a1 = unpk4((u32x2){kq.z, kq.w});
              float ss = (a0.x * a0.x + a0.y * a0.y) + (a0.z * a0.z + a0.w * a0.w) + (a1.x * a1.x + a1.y * a1.y) + (a1.z * a1.z + a1.w * a1.w);
              ss += dpp_f<0xB1>(ss); ss += dpp_f<0x4E>(ss); ss += dpp_f<0x141>(ss);
              if (m < T) kmx0 = fmaxf(kmx0, ss); else kmx1 = fmaxf(kmx1, ss); }
            const float f = ff + bf_;
            const float ls = fminf(f, 0.f) - __logf(1.f + __expf(-fabsf(f)));
            run += ls; rv[i] = run; }
        if (c.lane < 8) wt[c.wave * 8 + c.lane] = run;
        __syncthreads();
        if (c.lane < 8) { float pre = 0.f; for (int w_ = 0; w_ < c.wave; ++w_) pre += wt[w_ * 8 + c.lane];
            const int m0 = ch * 64 + c.wave * 8, bb = m0 / T, t0 = m0 % T; float* lc = LC + ((size_t)bb * 8 + c.lane) * T + t0;
#pragma unroll
            for (int i = 0; i < 8; ++i) lc[i] = (pre + rv[i]) * LOG2E;
            if (c.wave == 7) CT[((size_t)bb * 8 + c.lane) * 128 + (t0 >> 6)] = (pre + run) * LOG2E; }
        __syncthreads();
    }
    if ((c.lane & 7) == 0) { atomicMax((unsigned*)(kml + (c.lane >> 3)), __float_as_uint(kmx0)); atomicMax((unsigned*)(kml + 8 + (c.lane >> 3)), __float_as_uint(kmx1)); }
    __syncthreads();
    if (c.tid < 16) atomicMax(WSP(unsigned, WS_CTL) + CW_KMAX + l * 16 + c.tid, kml[c.tid]);
}
__device__ __forceinline__ void phase_chunk_prefix(const Ctx& c) {
    LAS float* sh = (LAS float*)(c.lds + 8192);
    for (int s_ = (c.G >= NB * 8) ? c.bid - (c.G - NB * 8) : c.bid; s_ >= 0 && s_ < NB * 8; s_ += c.G) {
        if (c.tid < 128) sh[c.tid] = WSP(float, WS_CT)[(size_t)s_ * 128 + c.tid];
        __syncthreads();
        if (c.tid < 129) { float run = 0.f; for (int i = 0; i < c.tid; ++i) run += sh[i]; (WSP(float, WS_CP) + (size_t)s_ * 129)[c.tid] = run; }
        __syncthreads();
    }
}
__device__ __forceinline__ void phase_cmp2(const Ctx& c, int l) {
    const float* SL = WSP(float, WS_SL); const float* bc1 = WSP(float, WS_TAB) + l * 256;
    LAS float* hl = (LAS float*)(c.lds + c.wave * 1024);
    for (int pr = c.bid * NWAVES + c.wave; pr < 2 * 2048; pr += c.G * NWAVES) {
        const int kv = pr >> 11, row = pr & 2047, d = c.lane;
        const float* w2 = (kv == 0 ? c.cmp_k_w2() : c.cmp_v_w2()) + (size_t)l * 128 * 64 + d;
        const float* s0 = SL + ((size_t)kv * 2048 + row) * 128; const float* s1 = s0 + (size_t)2 * 2048 * 128;
        const float a0 = s0[d], a1 = s0[d + 64], b0 = s1[d], b1 = s1[d + 64], c0 = bc1[kv * 128 + d], c1 = bc1[kv * 128 + d + 64];
        hl[d] = gelu_tanh(a0 + b0 + c0); hl[d + 64] = gelu_tanh(a1 + b1 + c1);
        LDS_WAIT(); asm volatile("" ::: "memory");
        float s = 0.f;
#pragma unroll
        for (int jb = 0; jb < 4; ++jb) { float wv[32];
#pragma unroll
            for (int i = 0; i < 32; ++i) wv[i] = w2[(size_t)(32 * jb + i) * 64];
            __builtin_amdgcn_sched_barrier(0);
#pragma unroll
            for (int i = 0; i < 32; ++i) s += hl[32 * jb + i] * wv[i]; }
        if ((row & 511) == 511) s = 0.f;
        (kv == 0 ? WSP(bf16_t, WS_KC) : WSP(bf16_t, WS_VC))[(size_t)row * 64 + d] = (bf16_t)f2bf(s);
        LDS_WAIT(); asm volatile("" ::: "memory");
    }
}
__device__ __forceinline__ u32x2 pk4(f32x4 v) { u32x2 w; w.x = cvtpk(v.x, v.y); w.y = cvtpk(v.z, v.w); return w; }
#define EPI_ARGS const f32x4 (&acc)[2][2][4][2], const pg8::Unit& u, int wr, int wc, int fr, int fq
#define EPI_LOOP _Pragma("unroll") for (int ai = 0; ai < 2; ++ai) _Pragma("unroll") for (int m = 0; m < 4; ++m) _Pragma("unroll") for (int bj = 0; bj < 2; ++bj) _Pragma("unroll") for (int n = 0; n < 2; ++n)

#define EPI_ROW(ai, m) (u.pm * 256 + (ai) * 128 + wr * 64 + (m) * 16 + fr)
#define EPI_COL(bj, n) (u.pn * 256 + (bj) * 128 + wc * 32 + (n) * 16 + fq * 4)
#define EPI_COLW(bj) (u.pn * 256 + (bj) * 128 + wc * 32 + fq * 8)
__device__ __forceinline__ u32x4 widen4(u32x2 a, u32x2 b) {
    const auto p0 = __builtin_amdgcn_permlane32_swap(a.x, b.x, false, false), p1 = __builtin_amdgcn_permlane32_swap(a.y, b.y, false, false);
    const auto q0 = __builtin_amdgcn_permlane16_swap(p0[0], p0[1], false, false), q1 = __builtin_amdgcn_permlane16_swap(p1[0], p1[1], false, false);
    u32x4 w; w.x = q0[0]; w.y = q1[0]; w.z = q0[1]; w.w = q1[1]; return w; }
__device__ __forceinline__ void narrow4(u32x4 w, u32x2& a, u32x2& b) {
    const auto q0 = __builtin_amdgcn_permlane16_swap(w.x, w.z, false, false), q1 = __builtin_amdgcn_permlane16_swap(w.y, w.w, false, false);
    const auto p0 = __builtin_amdgcn_permlane32_swap(q0[0], q0[1], false, false), p1 = __builtin_amdgcn_permlane32_swap(q1[0], q1[1], false, false);
    a.x = p0[0]; a.y = p1[0]; b.x = p0[1]; b.y = p1[1]; }
__device__ __forceinline__ u32x2 widen2(unsigned a, unsigned b) {
    const auto p0 = __builtin_amdgcn_permlane32_swap(a, b, false, false); const auto q0 = __builtin_amdgcn_permlane16_swap(p0[0], p0[1], false, false);
    u32x2 w; w.x = q0[0]; w.y = q0[1]; return w; }
__device__ __forceinline__ void narrow2(u32x2 w, unsigned& a, unsigned& b) {
    const auto q0 = __builtin_amdgcn_permlane16_swap(w.x, w.y, false, false); const auto p0 = __builtin_amdgcn_permlane32_swap(q0[0], q0[1], false, false);
    a = p0[0]; b = p0[1]; }
#define EPI_LOOPW _Pragma("unroll") for (int ai = 0; ai < 2; ++ai) _Pragma("unroll") for (int m = 0; m < 4; ++m) _Pragma("unroll") for (int bj = 0; bj < 2; ++bj)
struct EpiStoreBf16 { bf16_t* O; int ldc; const float* rowscale; int rs_stride;
    __device__ __forceinline__ void operator()(EPI_ARGS) const {
        float rs[2][4];
#pragma unroll
        for (int ai = 0; ai < 2; ++ai)
#pragma unroll
            for (int m = 0; m < 4; ++m) rs[ai][m] = rowscale ? rowscale[(size_t)EPI_ROW(ai, m) * rs_stride] : 1.f;
        __builtin_amdgcn_sched_barrier(0);
        EPI_LOOPW { const unsigned off = (unsigned)EPI_ROW(ai, m) * (unsigned)ldc + (unsigned)EPI_COLW(bj); *(u32x4*)(O + off) = widen4(pk4(acc[ai][bj][m][0] * rs[ai][m]), pk4(acc[ai][bj][m][1] * rs[ai][m])); } } };
struct EpiUqRope { bf16_t* QB; const float* rstd; const float* ropec; const float* ropes;
    __device__ __forceinline__ void operator()(EPI_ARGS) const {
#pragma unroll
        for (int ai = 0; ai < 2; ++ai) { float rs[4]; f32x4 cs4[4], sn4[4];
#pragma unroll
            for (int m = 0; m < 4; ++m) { const unsigned row = (unsigned)EPI_ROW(ai, m); rs[m] = rstd[(size_t)row * 2]; cs4[m] = *(const f32x4*)(ropec + row * 16u + fq * 4); sn4[m] = *(const f32x4*)(ropes + row * 16u + fq * 4); }
            __builtin_amdgcn_sched_barrier(0);
#pragma unroll
            for (int m = 0; m < 4; ++m)
#pragma unroll
                for (int bj = 0; bj < 2; ++bj) { const f32x4 x1 = acc[ai][bj][m][0] * rs[m], x2 = acc[ai][bj][m][1] * rs[m];
                    const f32x4 o1 = x1 * cs4[m] - x2 * sn4[m], o2 = x1 * sn4[m] + x2 * cs4[m];
                    const unsigned off = (unsigned)EPI_ROW(ai, m) * 768u + (unsigned)EPI_COLW(bj);
                    *(u32x4*)(QB + off) = widen4(pk4(o1), pk4(o2)); }
            __builtin_amdgcn_sched_barrier(0); } } };
struct EpiInprojGates { bf16_t* P1o; unsigned char* G8; const float* bias;
    __device__ __forceinline__ void operator()(EPI_ARGS) const {
        if (u.pn < 13) { EPI_LOOPW { *(u32x4*)(P1o + (unsigned)EPI_ROW(ai, m) * (unsigned)P1W + (unsigned)EPI_COLW(bj)) = widen4(pk4(acc[ai][bj][m][0]), pk4(acc[ai][bj][m][1])); } }
        else { f32x4 bv[2][2];
#pragma unroll
            for (int bj = 0; bj < 2; ++bj)
#pragma unroll
                for (int n = 0; n < 2; ++n) bv[bj][n] = *(const f32x4*)(bias + (EPI_COL(bj, n) - P1W));
            __builtin_amdgcn_sched_barrier(0);
            u32x4* gt = (u32x4*)G8 + ((size_t)(u.pm * 12 + (u.pn - 13)) * 8 + (size_t)(wr * 4 + wc)) * 512 + (fq * 16 + fr);
_Pragma("unroll")
            for (int ai = 0; ai < 2; ++ai)
_Pragma("unroll")
                for (int m = 0; m < 4; ++m) { unsigned gq[2][2];
_Pragma("unroll")
                    for (int bj = 0; bj < 2; ++bj)
_Pragma("unroll")
                        for (int n = 0; n < 2; ++n) { const f32x4 v = acc[ai][bj][m][n] + bv[bj][n];
                            const unsigned q0_ = (unsigned)(sigmoidf_(v.x) * 255.f + 0.5f), q1_ = (unsigned)(sigmoidf_(v.y) * 255.f + 0.5f), q2_ = (unsigned)(sigmoidf_(v.z) * 255.f + 0.5f), q3_ = (unsigned)(sigmoidf_(v.w) * 255.f + 0.5f);
                            gq[bj][n] = q0_ | (q1_ << 8) | (q2_ << 16) | (q3_ << 24); }
                    u32x4 w4; w4.x = gq[0][0]; w4.y = gq[0][1]; w4.z = gq[1][0]; w4.w = gq[1][1]; gt[(ai * 4 + m) * 64] = w4; } } } };
struct EpiGates { bf16_t* O; const float* bias;
    __device__ __forceinline__ void operator()(EPI_ARGS) const {
        f32x4 bv[2][2];
#pragma unroll
        for (int bj = 0; bj < 2; ++bj)
#pragma unroll
            for (int n = 0; n < 2; ++n) bv[bj][n] = *(const f32x4*)(bias + EPI_COL(bj, n));
        __builtin_amdgcn_sched_barrier(0);
        EPI_LOOP { f32x4 v = acc[ai][bj][m][n] + bv[bj][n];
            v.x = sigmoidf_(v.x); v.y = sigmoidf_(v.y); v.z = sigmoidf_(v.z); v.w = sigmoidf_(v.w); *(u32x2*)(O + (unsigned)EPI_ROW(ai, m) * 3072u + (unsigned)EPI_COL(bj, n)) = pk4(v); } } };
struct EpiCmpSlab { float* SL;
    __device__ __forceinline__ void operator()(EPI_ARGS) const {
        const int kv = u.pm >> 4, bg = (u.pm >> 2) & 3, half = (u.pm >> 1) & 1, ksp = u.pm & 1;
#pragma unroll
        for (int ai = 0; ai < 2; ++ai)
#pragma unroll
            for (int m = 0; m < 4; ++m)
#pragma unroll
                for (int n = 0; n < 2; ++n) { const int i = half * 256 + ai * 128 + wr * 64 + m * 16 + fr, cc = wc * 32 + n * 16 + fq * 4;
                    *(f32x4*)(SL + ((size_t)(ksp * 2 + kv) * 2048 + bg * 512 + i) * 128 + cc) = acc[ai][0][m][n]; } } };
struct EpiOutproj { bf16_t* MIX; const unsigned char* G8;
    __device__ __forceinline__ void operator()(EPI_ARGS) const {
        const int br = u.aux;
#pragma unroll
        for (int ai = 0; ai < 2; ++ai)
#pragma unroll
          for (int mh = 0; mh < 2; ++mh) { u32x4 gw[2]; u32x4 mw[2][2];
            const u32x4* gt = (const u32x4*)G8 + ((size_t)(u.pm * 12 + br * 4 + u.pn) * 8 + (size_t)(wr * 4 + wc)) * 512 + (fq * 16 + fr);
#pragma unroll
            for (int m2 = 0; m2 < 2; ++m2) { gw[m2] = gt[(ai * 4 + 2 * mh + m2) * 64];
#pragma unroll
                for (int bj = 0; bj < 2; ++bj) { const unsigned row = (unsigned)EPI_ROW(ai, 2 * mh + m2), col = (unsigned)EPI_COLW(bj);
                    if (br > 0) mw[m2][bj] = *(const u32x4*)(MIX + row * 1024u + col); } }
            __builtin_amdgcn_sched_barrier(0);
#pragma unroll
            for (int m2 = 0; m2 < 2; ++m2)
#pragma unroll
                for (int bj = 0; bj < 2; ++bj) { unsigned g2[2]; g2[0] = bj ? gw[m2].z : gw[m2].x; g2[1] = bj ? gw[m2].w : gw[m2].y; u32x2 o2[2] = {{0u, 0u}, {0u, 0u}}; if (br > 0) narrow4(mw[m2][bj], o2[0], o2[1]); u32x2 r2[2];
#pragma unroll
                    for (int n = 0; n < 2; ++n) { const unsigned g_ = g2[n]; f32x4 gf; gf.x = (float)(g_ & 255u); gf.y = (float)((g_ >> 8) & 255u); gf.z = (float)((g_ >> 16) & 255u); gf.w = (float)(g_ >> 24);
                        f32x4 v = acc[ai][bj][2 * mh + m2][n] * gf * (1.f / 255.f); if (br > 0) v = v + unpk4(o2[n]); r2[n] = pk4(v); }
                    *(u32x4*)(MIX + (unsigned)EPI_ROW(ai, 2 * mh + m2) * 1024u + (unsigned)EPI_COLW(bj)) = widen4(r2[0], r2[1]); }
            __builtin_amdgcn_sched_barrier(0); } } };
struct EpiWout { const float* R; float* XA;
    __device__ __forceinline__ void operator()(EPI_ARGS) const {
#pragma unroll
        for (int ai = 0; ai < 2; ++ai)
#pragma unroll
          for (int mh = 0; mh < 2; ++mh) { f32x4 rv[2][2][2];
#pragma unroll
            for (int m2 = 0; m2 < 2; ++m2)
#pragma unroll
                for (int bj = 0; bj < 2; ++bj)
#pragma unroll
                    for (int n = 0; n < 2; ++n) rv[m2][bj][n] = *(const f32x4*)(R + (unsigned)EPI_ROW(ai, 2 * mh + m2) * 1024u + (unsigned)EPI_COL(bj, n));
            __builtin_amdgcn_sched_barrier(0);
#pragma unroll
            for (int m2 = 0; m2 < 2; ++m2)
#pragma unroll
                for (int bj = 0; bj < 2; ++bj)
#pragma unroll
                    for (int n = 0; n < 2; ++n) *(f32x4*)(XA + (unsigned)EPI_ROW(ai, 2 * mh + m2) * 1024u + (unsigned)EPI_COL(bj, n)) = rv[m2][bj][n] + acc[ai][bj][2 * mh + m2][n];
            __builtin_amdgcn_sched_barrier(0); } } };
template <int NAI>
struct EpiMoe1T { bf16_t* HID; const float* LW;
    __device__ __forceinline__ void operator()(EPI_ARGS) const {
        int aux_ = u.aux; asm volatile("" : "+s"(aux_));
        float w8[2][4];
#pragma unroll
        for (int ai = 0; ai < NAI; ++ai)
#pragma unroll
            for (int m = 0; m < 4; ++m) w8[ai][m] = LW[(unsigned)(aux_ + ai * 128 + wr * 64 + m * 16 + fr)];
        __builtin_amdgcn_sched_barrier(0);
#pragma unroll
        for (int ai = 0; ai < NAI; ++ai)
#pragma unroll
            for (int m = 0; m < 4; ++m) { const unsigned pos = (unsigned)(aux_ + ai * 128 + wr * 64 + m * 16 + fr); const float w = w8[ai][m];
                u32x2 h2[2];
#pragma unroll
                for (int n = 0; n < 2; ++n) { const f32x4 g = acc[ai][0][m][n], up = acc[ai][1][m][n]; f32x4 h;
                    h.x = g.x * sigmoidf_(g.x) * up.x * w; h.y = g.y * sigmoidf_(g.y) * up.y * w; h.z = g.z * sigmoidf_(g.z) * up.z * w; h.w = g.w * sigmoidf_(g.w) * up.w * w; h2[n] = pk4(h); }
                *(u32x4*)(HID + pos * 256u + (unsigned)(u.pn * 128 + wc * 32 + fq * 8)) = widen4(h2[0], h2[1]); } } };
typedef EpiMoe1T<2> EpiMoe1; typedef EpiMoe1T<1> EpiMoe1H;
struct EpiMoe2 { bf16_t* Y; const unsigned* LDST;
    __device__ __forceinline__ void operator()(EPI_ARGS) const {
        int aux_ = u.aux; asm volatile("" : "+s"(aux_));
        unsigned d8[2][4];
#pragma unroll
        for (int ai = 0; ai < 2; ++ai)
#pragma unroll
            for (int m = 0; m < 4; ++m) d8[ai][m] = LDST[(unsigned)(aux_ + ai * 128 + wr * 64 + m * 16 + fr)];
        __builtin_amdgcn_sched_barrier(0);
#pragma unroll
        for (int ai = 0; ai < 2; ++ai)
#pragma unroll
            for (int m = 0; m < 4; ++m) { const unsigned d0 = d8[ai][m];
                const u32x4 w0 = widen4(pk4(acc[ai][0][m][0]), pk4(acc[ai][0][m][1])), w1 = widen4(pk4(acc[ai][1][m][0]), pk4(acc[ai][1][m][1]));
                if (d0 != 0xFFFFFFFFu) { const unsigned off = d0 + (unsigned)(u.pn * 256 + wc * 32 + fq * 8); *(u32x4*)(Y + off) = w0; *(u32x4*)(Y + off + 128) = w1; } } } };

struct OutprojOrder { int G, c; const char* base; long long off0, d1, d2; const char* W; unsigned lda0, lda1;
    __device__ bool next(int i, pg8::Unit& u) const { const int rnd = i / 3, br = i - 3 * rnd; const int tl = rnd * G + c; if (tl >= (M / 256) * 4) return false;
        u.pm = tl >> 2; u.pn = tl & 3; u.aux = br; const unsigned lda_ = lda0 + (unsigned)(br == 1) * (lda1 - lda0); u.lda = lda_;
        const unsigned long long pa_ = (unsigned long long)(base + off0 + (long long)(br == 1) * d1 + (long long)(br == 2) * d2 + (long long)u.pm * 256 * lda_), pb_ = (unsigned long long)(W + (size_t)br * 1024 * 1024 + (size_t)u.pn * 256 * 1024);
        u.A = (const char*)(const __attribute__((address_space(1))) char*)(((unsigned long long)(unsigned)__builtin_amdgcn_readfirstlane((int)(pa_ >> 32)) << 32) | (unsigned)__builtin_amdgcn_readfirstlane((int)pa_));
        u.B = (const char*)(const __attribute__((address_space(1))) char*)(((unsigned long long)(unsigned)__builtin_amdgcn_readfirstlane((int)(pb_ >> 32)) << 32) | (unsigned)__builtin_amdgcn_readfirstlane((int)pb_)); return true; } };
struct OutprojOrderH { int G, c; const char* base; long long off0, d1, d2; const char* W; unsigned lda0, lda1;
    __device__ bool next(int i, pg8::Unit& u) const { const int rnd = i / 3, br = i - 3 * rnd; int tl = rnd * G + c; if (tl >= (M / 128) * 4) return false;
        if ((G & 7) == 0 && 2 * G == (M / 128) * 4) { const int per = G >> 3; tl = (((rnd * per + (c >> 3)) >> 2) * 8 + (c & 7)) * 4 + ((rnd * per + (c >> 3)) & 3); }
        u.pm = tl >> 2; u.pn = tl & 3; u.aux = br; const unsigned lda_ = lda0 + (unsigned)(br == 1) * (lda1 - lda0); u.lda = lda_;
        const unsigned long long pa_ = (unsigned long long)(base + off0 + (long long)(br == 1) * d1 + (long long)(br == 2) * d2 + (long long)u.pm * 128 * lda_), pb_ = (unsigned long long)(W + (size_t)br * 1024 * 1024 + (size_t)u.pn * 256 * 1024);
        u.A = (const char*)(const __attribute__((address_space(1))) char*)(((unsigned long long)(unsigned)__builtin_amdgcn_readfirstlane((int)(pa_ >> 32)) << 32) | (unsigned)__builtin_amdgcn_readfirstlane((int)pa_));
        u.B = (const char*)(const __attribute__((address_space(1))) char*)(((unsigned long long)(unsigned)__builtin_amdgcn_readfirstlane((int)(pb_ >> 32)) << 32) | (unsigned)__builtin_amdgcn_readfirstlane((int)pb_)); return true; } };
struct EpiOutprojH { bf16_t* MIX; const unsigned char* G8;
    __device__ __forceinline__ void operator()(f32x4 (&acc)[2][2][4][2], const pg8::Unit& u, int wr, int wc, int fr, int fq) const {
        const int br = u.aux, half = u.pm & 1;
        const u32x4* gt = (const u32x4*)G8 + ((size_t)((u.pm >> 1) * 12 + br * 4 + u.pn) * 8 + (size_t)(wr * 4 + wc)) * 512 + (fq * 16 + fr);
        u32x4 gw[4];
#pragma unroll
        for (int m = 0; m < 4; ++m) gw[m] = gt[(half * 4 + m) * 64];
        __builtin_amdgcn_sched_barrier(0);
#pragma unroll
        for (int m = 0; m < 4; ++m)
#pragma unroll
            for (int bj = 0; bj < 2; ++bj)
#pragma unroll
                for (int n = 0; n < 2; ++n) { const unsigned g_ = bj ? (n ? gw[m].w : gw[m].z) : (n ? gw[m].y : gw[m].x);
                    f32x4 gf; gf.x = (float)(g_ & 255u); gf.y = (float)((g_ >> 8) & 255u); gf.z = (float)((g_ >> 16) & 255u); gf.w = (float)(g_ >> 24);
                    const f32x4 v = acc[0][bj][m][n] * gf * (1.f / 255.f);
                    if (br == 0) acc[1][bj][m][n] = v; else acc[1][bj][m][n] = acc[1][bj][m][n] + v; }
        if (br == 2) {
#pragma unroll
            for (int m = 0; m < 4; ++m)
#pragma unroll
                for (int bj = 0; bj < 2; ++bj) *(u32x4*)(MIX + (unsigned)(u.pm * 128 + wr * 64 + m * 16 + fr) * 1024u + (unsigned)(u.pn * 256 + bj * 128 + wc * 32 + fq * 8)) = widen4(pk4(acc[1][bj][m][0]), pk4(acc[1][bj][m][1])); }
    } };
struct CmpOrder { int G, c; const char* P1; const char* W;
    __device__ bool next(int i, pg8::Unit& u) const { const int L_ = i * G + c; if (L_ >= 32) return false; const int kv = L_ >> 4, b = (L_ >> 3) & 1, g = (L_ >> 2) & 1, half = (L_ >> 1) & 1, ks = L_ & 1;
        u.pm = L_; u.pn = 0; u.aux = 0; u.lda = 0u; u.A = P1 + ((size_t)(b * T + 16 * 256 * half + 16 * ks) * P1W + C_NKV + (kv * 2 + g) * 64) * 2; u.B = W + ((size_t)kv * 256 * 2048 + (size_t)ks * 1024) * 2; return true; } };
struct MoeOrder { int G, c, nN; const LAS int* tab; const char* A; size_t a_rowbytes; const char* W; size_t w_expert, w_tile; int imax;
    __device__ bool next(int i, pg8::Unit& u) const { if (i >= imax) return false; const int L_ = i * G + c; const int NT = __builtin_amdgcn_readfirstlane(tab[32]); if (L_ >= NT * nN) return false; const int rt = L_ / nN, pn = L_ % nN;
        int e = 0; while (__builtin_amdgcn_readfirstlane(tab[e + 1]) <= rt) ++e;
        const int off_e = __builtin_amdgcn_readfirstlane(tab[33 + e]), ts_e = __builtin_amdgcn_readfirstlane(tab[e]), cnt_e = __builtin_amdgcn_readfirstlane(tab[66 + e]);
        const int pos0 = off_e + 256 * (rt - ts_e); u.pn = pn; u.aux = pos0; u.pm = off_e + cnt_e; u.lda = 0u;
        u.A = A + (size_t)pos0 * a_rowbytes; u.B = W + (size_t)e * w_expert + (size_t)pn * w_tile; return true; } };
struct MoeOrderH { int G, c; const LAS int* tab; const char* A; const char* W; size_t w_expert, w_tile;
    __device__ bool next(int i, pg8::Unit& u) const { const int hL = i * G + c; const int NT = __builtin_amdgcn_readfirstlane(tab[32]); const int L_ = G + (hL >> 1), half = hL & 1; if (L_ >= NT * 2) return false; const int rt = L_ >> 1, pn = L_ & 1;
        int e = 0; while (__builtin_amdgcn_readfirstlane(tab[e + 1]) <= rt) ++e;
        const int off_e = __builtin_amdgcn_readfirstlane(tab[33 + e]), ts_e = __builtin_amdgcn_readfirstlane(tab[e]), cnt_e = __builtin_amdgcn_readfirstlane(tab[66 + e]);
        const int pos0 = off_e + 256 * (rt - ts_e) + 128 * half; u.pn = pn; u.aux = pos0; u.pm = off_e + cnt_e; u.lda = 0u;
        u.A = A; u.B = W + (size_t)e * w_expert + (size_t)pn * w_tile; return true; } };
__device__ __forceinline__ void moe_tables(const Ctx& c, int l, LAS int* tab) {
    if (c.tid < 32) { const unsigned* cp = WSP(unsigned, WS_CTL) + CW_MOECNT + l * 64;
        int ts = 0, tot = 0, mine = 0;
#pragma unroll
        for (int q = 0; q < 32; ++q) { const int e_ = (q + c.tid) & 31; const int n = (int)cp[e_]; const int nt_ = (n + 255) >> 8; ts += (e_ < c.tid) ? nt_ : 0; tot += nt_; if (q == 0) mine = n; }
        tab[66 + c.tid] = mine; tab[c.tid] = ts; tab[33 + c.tid] = ts * 256; if (c.tid == 0) { tab[32] = tot; tab[65] = tot * 256; } }
    __syncthreads();
}

constexpr int LDS_RSM = LDS_MISC + 1024;
constexpr int RT_XT = 0, RT_XTP = 516, RT_P = 32 * RT_XTP * 4, RT_PG = RT_P + 8 * 32 * 33 * 4, RT_EL = RT_PG + 8 * 32 * 4 * 4, RT_GL = RT_EL + 32 * 32 * 4;
static_assert(RT_GL + 32 * 4 * 4 <= 131072, "router LDS map");
template <bool BF>
__device__ __forceinline__ void phase_router(const Ctx& c, int l, const float* XA, int dummy = 0) {
    const int lane = c.lane, w = c.wave, tid = c.tid;
    const bf16_t* DL = WSP(bf16_t, WS_DELTA); bf16_t* H2 = WSP(bf16_t, WS_H2); int* REC = WSP(int, dummy ? WS_HID : WS_REC); unsigned* cnt = WSP(unsigned, WS_CTL) + CW_MOECNT + (l + 2 * dummy) * 64;
    const float* g2 = c.norm_ffn() + l * D; const float* wg = c.moe_w_grp() + (size_t)l * D * 4; const float* wr_ = c.moe_w_router() + (size_t)l * D * 32;
    const float* bgp = c.moe_b_grp() + l * 4; const float* brp = c.moe_b_router() + l * 32;
    LAS float* XT = (LAS float*)(c.lds + RT_XT); LAS float* P = (LAS float*)(c.lds + RT_P); LAS float* PG = (LAS float*)(c.lds + RT_PG); LAS float* EL = (LAS float*)(c.lds + RT_EL); LAS float* GL = (LAS float*)(c.lds + RT_GL);
    LAS unsigned* cntL = (LAS unsigned*)(c.lds + LDS_MOETAB);
    if (tid < 32) cntL[tid] = 0u;
    __syncthreads();
    const int rr_ = lane & 31, kk = lane >> 5;
    f32x4 v[4][4]; u32x2 dq[4][4], hq[4][4]; f32x4 gg[4]; float bw[2][8], bg[2][8];
    const float br0_ = brp[2 * (tid & 15)], br1_ = brp[2 * (tid & 15) + 1], bg0_ = bgp[tid & 3];
#pragma unroll
    for (int j = 0; j < 4; ++j) gg[j] = *((const f32x4*)g2 + lane + 64 * j);
#define RT_BLOAD(g_) { const int h_ = (g_) >> 2, cq_ = (g_) & 3; const __attribute__((address_space(1))) float* wrp = (const __attribute__((address_space(1))) float*)(wr_ + (size_t)(512 * h_ + 64 * w + 32 * kk) * 32 + rr_); const __attribute__((address_space(1))) float* wgp = (const __attribute__((address_space(1))) float*)(wg + (size_t)(512 * h_ + 64 * w + 32 * kk) * 4 + (rr_ & 3)); asm volatile("" : "+v"(wrp), "+v"(wgp));     \
            _Pragma("unroll") for (int s_ = 0; s_ < 8; ++s_) { bw[(g_) & 1][s_] = wrp[(8 * cq_ + s_) * 32]; bg[(g_) & 1][s_] = wgp[(8 * cq_ + s_) * 4]; } }
#define RT_ROWS(st_) { const int mn_ = (st_) * 32 + 4 * w; _Pragma("unroll") for (int r = 0; r < 4; ++r) { const f32x4* xr = (const f32x4*)(XA + (size_t)(mn_ + r) * D) + lane; const u32x2* hr = (const u32x2*)((const bf16_t*)XA + (size_t)(mn_ + r) * D) + lane; const u32x2* dr = (const u32x2*)(DL + (size_t)(mn_ + r) * D) + lane; \
            _Pragma("unroll") for (int j = 0; j < 4; ++j) { if (BF) hq[r][j] = hr[64 * j]; else v[r][j] = xr[64 * j]; dq[r][j] = dr[64 * j]; } } }
    if (c.bid < M / 32) { RT_ROWS(c.bid) RT_BLOAD(0) }
    for (int st = c.bid; st < M / 32; st += c.G) {
        const int m0 = st * 32 + 4 * w; const bool more = st + c.G < M / 32;
        float rs[4];
        {
          __builtin_amdgcn_sched_barrier(0);
#pragma unroll
          for (int r = 0; r < 4; ++r) { float s = 0.f;
#pragma unroll
              for (int j = 0; j < 4; ++j) { if (BF) v[r][j] = unpk4(hq[r][j]) + unpk4(dq[r][j]); else v[r][j] = v[r][j] + unpk4(dq[r][j]); s += (v[r][j].x * v[r][j].x + v[r][j].y * v[r][j].y) + (v[r][j].z * v[r][j].z + v[r][j].w * v[r][j].w); }
              rs[r] = rsqrtf(wave_sum(s) * (1.f / D) + EPS); if (lane == 0) WSP(float, WS_RS2)[m0 + r] = __builtin_amdgcn_rcpf(rs[r]); } }
#pragma unroll
        for (int j = 0; j < 4; ++j) {
#pragma unroll
            for (int r = 0; r < 4; ++r) { v[r][j] = v[r][j] * rs[r]; *((u32x2*)(H2 + (size_t)(m0 + r) * D) + lane + 64 * j) = pk4(v[r][j]); v[r][j] = v[r][j] * gg[j]; } }
        f32x16 acc0; f32x4 accg;
#pragma unroll
        for (int i = 0; i < 16; ++i) acc0[i] = 0.f;
        accg.x = 0.f; accg.y = 0.f; accg.z = 0.f; accg.w = 0.f;
#pragma unroll
        for (int g = 0; g < 8; ++g) { const int h = g >> 2, cq = g & 3;
            if (cq == 0) {
                if (h) __syncthreads();
#pragma unroll
                for (int r = 0; r < 4; ++r)
#pragma unroll
                    for (int jj = 0; jj < 2; ++jj) *(LAS f32x4*)(XT + (4 * w + r) * RT_XTP + 4 * lane + 256 * jj) = v[r][2 * h + jj];
                __syncthreads(); }
            const f32x4 a0 = *(const LAS f32x4*)(XT + rr_ * RT_XTP + 64 * w + 32 * kk + 8 * cq), a1 = *(const LAS f32x4*)(XT + rr_ * RT_XTP + 64 * w + 32 * kk + 8 * cq + 4);
            if (g + 1 < 8) RT_BLOAD(g + 1)
            if (g == 6) { const int stn_ = more ? st + c.G : 0; RT_ROWS(stn_) }
            __builtin_amdgcn_sched_barrier(0);
#pragma unroll
            for (int s_ = 0; s_ < 8; ++s_) { const float a_ = s_ < 4 ? a0[s_ & 3] : a1[s_ & 3];
                acc0 = __builtin_amdgcn_mfma_f32_32x32x2f32(a_, bw[g & 1][s_], acc0, 0, 0, 0); accg = __builtin_amdgcn_mfma_f32_4x4x1f32(a_, bg[g & 1][s_], accg, 0, 0, 0); }
            __builtin_amdgcn_sched_barrier(0);
        }
        RT_BLOAD(0)
#pragma unroll
        for (int i = 0; i < 16; ++i) { const int row = (i & 3) + 8 * (i >> 2) + 4 * kk; P[(w * 32 + row) * 33 + rr_] = acc0[i]; }
#pragma unroll
        for (int i = 0; i < 4; ++i) { const auto sw_ = __builtin_amdgcn_permlane32_swap(__float_as_uint(accg[i]), __float_as_uint(accg[i]), false, false); const float t_ = __uint_as_float(sw_[0]) + __uint_as_float(sw_[1]);
            if (lane < 32) PG[(w * 32 + 4 * (lane >> 2) + i) * 4 + (lane & 3)] = t_; }
        __syncthreads();
        { const int row = tid >> 4, e0 = 2 * (tid & 15); float s0 = 0.f, s1 = 0.f;
#pragma unroll
          for (int q = 0; q < 8; ++q) { s0 += P[(q * 32 + row) * 33 + e0]; s1 += P[(q * 32 + row) * 33 + e0 + 1]; }
          EL[row * 32 + e0] = s0 + br0_; EL[row * 32 + e0 + 1] = s1 + br1_;
          if (tid < 128) { const int rg = tid >> 2, og = tid & 3; float sg = 0.f;
#pragma unroll
              for (int q = 0; q < 8; ++q) sg += PG[(q * 32 + rg) * 4 + og];
              GL[rg * 4 + og] = sg + bg0_; } }
        __syncthreads();
        if (tid < 32) { const int r = tid;
            int gi = 0; float gm = GL[r * 4];
            for (int o = 1; o < 4; ++o) { const float x_ = GL[r * 4 + o]; if (x_ > gm) { gm = x_; gi = o; } }
            float gs = 0.f; for (int o = 0; o < 4; ++o) gs += __expf(GL[r * 4 + o] - gm);
            const float grp_top = 1.f / gs;
            int i1 = 0; float m1 = EL[r * 32 + gi * 8];
            for (int q = 1; q < 8; ++q) { const float x_ = EL[r * 32 + gi * 8 + q]; if (x_ > m1) { m1 = x_; i1 = q; } }
            int i2 = -1; float m2 = -3.0e38f;
            for (int q = 0; q < 8; ++q) { const float x_ = EL[r * 32 + gi * 8 + q]; if (q != i1 && x_ > m2) { m2 = x_; i2 = q; } }
            const float e2 = __expf(m2 - m1); const float w1 = grp_top / (1.f + e2), w2 = grp_top * e2 / (1.f + e2);
            const int ea = gi * 8 + i1, eb = gi * 8 + i2; const int ra = (int)atomicAdd((unsigned*)(cntL + ea), 1u), rb = (int)atomicAdd((unsigned*)(cntL + eb), 1u);
            int* rr = REC + (size_t)(st * 32 + r) * 8; rr[0] = ea; rr[1] = eb; rr[2] = ra; rr[3] = rb; rr[4] = __float_as_int(w1); rr[5] = __float_as_int(w2); rr[6] = c.bid; }
    }
#undef RT_BLOAD
#undef RT_ROWS
    __syncthreads();
    if (c.tid < 32) { const unsigned n = cntL[c.tid]; (WSP(unsigned, WS_CTL) + CW_CNTB)[(dummy ? 8192 : 0) + c.bid * 32 + c.tid] = n; if (n) atomicAdd(cnt + c.tid, n); }
}
__device__ __forceinline__ TItem place_item_gu(const Ctx& c, int l, int it) {
    const int e = it >> 8, r = it & 255, ln = c.lane & 31; const int nb = r % 16; const bool up = ((nb * 32) & 255) >= 128;
    return make_titem((const float*)c.inp(up ? 29 : 28) + ((size_t)l * 32 + e) * D * 256, 256, D, WSP(bf16_t, WS_WGU) + (size_t)e * 512 * D, c.norm_ffn() + l * D, MapGU{}(32 * nb + ln), 16, r, c.lane, 1.f);
}
__device__ __forceinline__ TItem place_item_dn(const Ctx& c, int l, int it) {
    const int e = it >> 7, r = it & 127, ln = c.lane & 31;
    return make_titem(c.moe_w_down() + ((size_t)l * 32 + e) * 256 * D, D, 256, WSP(bf16_t, WS_WDT) + (size_t)e * D * 256, nullptr, 32 * (r % 32) + ln, 32, r, c.lane, 1.f);
}
__device__ __forceinline__ void phase_place(const Ctx& c, int l) {
    LAS int* tab = (LAS int*)(c.lds + LDS_MOETAB);
    moe_tables(c, l, tab);
    int* LTOK = WSP(int, WS_LTOK); float* LW = WSP(float, WS_LW); unsigned* LDST = WSP(unsigned, WS_LSLOT); const int* REC = WSP(int, WS_REC);
    LAS int* BASE = (LAS int*)c.lds;
    { const unsigned* cb = WSP(unsigned, WS_CTL) + CW_CNTB;
      for (int i0 = c.tid; i0 < c.G * 32; i0 += 16 * NTHREADS) { unsigned v16[16];
#pragma unroll
          for (int q = 0; q < 16; ++q) { const int i = i0 + q * NTHREADS; v16[q] = cb[i < c.G * 32 ? i : c.tid]; }
          __builtin_amdgcn_sched_barrier(0);
#pragma unroll
          for (int q = 0; q < 16; ++q) { const int i = i0 + q * NTHREADS; if (i < c.G * 32) BASE[i] = (int)v16[q]; } } }
    __syncthreads();
    { const int e = c.tid & 31, sg = c.tid >> 5; const int per = (c.G + 15) >> 4; const int b0_ = sg * per, b1_ = (b0_ + per < c.G) ? b0_ + per : c.G;
      LAS int* SEG = BASE + c.G * 32;
      int ssum = 0, b_ = b0_;
      for (; b_ + 8 <= b1_; b_ += 8) { int v8[8];
#pragma unroll
          for (int q = 0; q < 8; ++q) v8[q] = BASE[(b_ + q) * 32 + e];
#pragma unroll
          for (int q = 0; q < 8; ++q) ssum += v8[q]; }
      for (; b_ < b1_; ++b_) ssum += BASE[b_ * 32 + e];
      SEG[sg * 32 + e] = ssum;
      __syncthreads();
      int run = 0;
#pragma unroll
      for (int q = 0; q < 16; ++q) { const int t_ = SEG[q * 32 + e]; run += (q < sg) ? t_ : 0; }
      b_ = b0_;
      for (; b_ + 8 <= b1_; b_ += 8) { int v8[8];
#pragma unroll
          for (int q = 0; q < 8; ++q) v8[q] = BASE[(b_ + q) * 32 + e];
#pragma unroll
          for (int q = 0; q < 8; ++q) { BASE[(b_ + q) * 32 + e] = run; run += v8[q]; } }
      for (; b_ < b1_; ++b_) { const int v_ = BASE[b_ * 32 + e]; BASE[b_ * 32 + e] = run; run += v_; } }
    __syncthreads();
    for (int m = c.bid * NTHREADS + c.tid; m < M; m += c.G * NTHREADS) { const int* r = REC + (size_t)m * 8;
        const int pa = tab[33 + r[0]] + BASE[r[6] * 32 + r[0]] + r[2], pb = tab[33 + r[1]] + BASE[r[6] * 32 + r[1]] + r[3];
        LTOK[pa] = m; LDST[pa] = (unsigned)m * 1024u; LW[pa] = __int_as_float(r[4]); LTOK[pb] = m; LDST[pb] = ((unsigned)M + (unsigned)m) * 1024u; LW[pb] = __int_as_float(r[5]); }
    for (int e = c.bid; e < 32; e += c.G) { const int lo = tab[33 + e] + tab[66 + e], hi2 = tab[33 + e + 1];
        for (int p = lo + c.tid; p < hi2; p += NTHREADS) { LTOK[p] = 0; LDST[p] = 0xFFFFFFFFu; LW[p] = 0.f; } }
    __syncthreads();
    LAS float* scr = (LAS float*)(c.lds + c.wave * 16384);
    const int gw = c.bid * NWAVES + c.wave, NGW = c.G * NWAVES;
#define PLACE_MAKE(i_) place_item_gu(c, l, (i_))
    T_PIPELINE(32 * 256, PLACE_MAKE);
#undef PLACE_MAKE
}

#ifndef ATT_FAST_FOX
#define ATT_FAST_FOX 1
#endif
#ifndef ATT_FAST_MLA
#define ATT_FAST_MLA 1
#endif
#ifndef ATT_FAST_NSA
#define ATT_FAST_NSA 1
#endif
namespace fa {
constexpr int KPITCH = 208, VPITCH = 192;
constexpr int KBUF = 64 * KPITCH, VBUF = 64 * VPITCH;
constexpr int L_K = 0, L_V = 2 * KBUF, L_VD = 4 * KBUF, L_LUT = 131072 + 1024, L_CUM = L_LUT + 8 * 132 * 4, L_PS = 57344, L_F = L_PS + 64 * 132 * 4, L_SEL = L_F + 64 * 132 * 4, L_UNI = L_SEL + 1024, L_TL = L_UNI + 16, L_TLN = L_TL + 128, L_UNIT = L_TLN + 16;
static_assert(L_V + 2 * VBUF <= L_PS && L_VD + 4 * VBUF <= L_SEL && L_UNIT + 64 <= 131072 && L_CUM + 512 <= LDS_BYTES, "attention LDS map: NSA uses K/V slots 0,1 (V at L_V) + the importance tables; dense units use 4 K slots and 4 V slots at L_VD (over the tables, dead then)");
typedef short v4i16_t __attribute__((ext_vector_type(4)));
__device__ __forceinline__ float swap32_max(float v) { auto rr = __builtin_amdgcn_permlane32_swap(__float_as_uint(v), __float_as_uint(v), false, false); return fmaxf(__uint_as_float(rr[0]), __uint_as_float(rr[1])); }
__device__ __forceinline__ float swap32_sum(float v) { auto rr = __builtin_amdgcn_permlane32_swap(__float_as_uint(v), __float_as_uint(v), false, false); return __uint_as_float(rr[0]) + __uint_as_float(rr[1]); }
__device__ __forceinline__ float ex2(float x) { return __builtin_amdgcn_exp2f(x); }

struct KVSrc { const bf16_t* K; int kpitch; const bf16_t* K2; int k2pitch; const bf16_t* V; int vpitch; const float* cum; float cref; };
struct TileRegs { u32x4 k, k2, v; float cm; };
template <bool HAS_K2, bool HAS_CUM>
__device__ __forceinline__ void tile_load(TileRegs& R, const KVSrc& s, int kv0, int tid) {
    const int row = tid >> 3, ch = tid & 7;
    R.k = *(const u32x4*)(s.K + (size_t)(kv0 + row) * s.kpitch + ch * 8);
    R.v = *(const u32x4*)(s.V + (size_t)(kv0 + row) * s.vpitch + ch * 8);
    if constexpr (HAS_K2) { if (tid < 256) R.k2 = *(const u32x4*)(s.K2 + (size_t)(kv0 + (tid >> 2)) * s.k2pitch + (tid & 3) * 8); }
    if constexpr (HAS_CUM) { if (tid < 64) R.cm = s.cum[kv0 + tid]; }
}
template <bool HAS_K2, bool HAS_CUM>
__device__ __forceinline__ void tile_store(const TileRegs& R, LAS unsigned char* lds, int buf, int tid, float cref = 0.f, float cadd = 0.f, int vbase = L_V) {
    const int row = tid >> 3, ch = tid & 7;
    *(LAS u32x4*)(lds + L_K + buf * KBUF + row * KPITCH + ch * 16) = R.k;
    if constexpr (HAS_K2) { if (tid < 256) *(LAS u32x4*)(lds + L_K + buf * KBUF + (tid >> 2) * KPITCH + 128 + (tid & 3) * 16) = R.k2; }
    *(LAS u32x4*)(lds + vbase + buf * VBUF + row * VPITCH + ch * 16) = R.v;
    if constexpr (HAS_CUM) { if (tid < 64) { const float x = cref - (R.cm + cadd); const unsigned hi_ = f2bf(x); const float xl = x - __uint_as_float(hi_ << 16); const unsigned lo_ = f2bf(xl);
            unsigned zz = 0u; asm volatile("" : "+v"(zz)); u32x4 w0; w0.x = hi_ | (lo_ << 16); w0.y = zz; w0.z = zz; w0.w = zz; u32x4 z0; z0.x = zz; z0.y = zz; z0.z = zz; z0.w = zz;
            *(LAS u32x4*)(lds + L_K + buf * KBUF + tid * KPITCH + 128) = w0; *(LAS u32x4*)(lds + L_K + buf * KBUF + tid * KPITCH + 144) = z0; } }
}
template <int NKS>
__device__ __forceinline__ void qk_tile(f32x16 (&st)[2], const LAS unsigned char* lds, int buf, const bf16x8 (&qf)[NKS], int r, int hh, float cval) {
    const LAS unsigned char* kp = lds + L_K + buf * KBUF + r * KPITCH + hh * 16;
    bf16x8 kf[2][NKS];
#pragma unroll
    for (int ks = 0; ks < NKS; ++ks)
#pragma unroll
        for (int rb = 0; rb < 2; ++rb) kf[rb][ks] = *(const LAS bf16x8*)(kp + rb * 32 * KPITCH + ks * 32);
    f32x16 cin;
#pragma unroll
    for (int i = 0; i < 16; ++i) cin[i] = cval;
    __builtin_amdgcn_sched_barrier(0);
    f32x16 a0 = __builtin_amdgcn_mfma_f32_32x32x16_bf16(kf[0][0], qf[0], cin, 0, 0, 0), a1 = __builtin_amdgcn_mfma_f32_32x32x16_bf16(kf[1][0], qf[0], cin, 0, 0, 0);
#pragma unroll
    for (int ks = 1; ks < NKS; ++ks) { a0 = __builtin_amdgcn_mfma_f32_32x32x16_bf16(kf[0][ks], qf[ks], a0, 0, 0, 0); a1 = __builtin_amdgcn_mfma_f32_32x32x16_bf16(kf[1][ks], qf[ks], a1, 0, 0, 0); }
    st[0] = a0; st[1] = a1;
}
__device__ __forceinline__ void pv_tile(f32x16 (&ot)[2], const LAS unsigned char* lds, int buf, const f32x16 (&p)[2], int lane) {
    const int i16 = lane & 15, blk = (lane >> 4) & 1, hh = lane >> 5;
    const LAS unsigned char* vb = lds + L_V + buf * VBUF + (4 * hh + (i16 >> 2)) * VPITCH + 32 * blk + 8 * (i16 & 3);
    v4i16_t lo[4][2], hi[4][2]; bf16x8 pf[4];
#pragma unroll
    for (int q = 0; q < 4; ++q)
#pragma unroll
        for (int db = 0; db < 2; ++db) { const LAS unsigned char* vp = vb + (16 * q) * VPITCH + 64 * db;
            lo[q][db] = __builtin_amdgcn_ds_read_tr16_b64_v4i16((LAS v4i16_t*)vp); hi[q][db] = __builtin_amdgcn_ds_read_tr16_b64_v4i16((LAS v4i16_t*)(vp + 8 * VPITCH)); }
#pragma unroll
    for (int q = 0; q < 4; ++q) { const int rb = q >> 1, s_ = q & 1;
        u32x4 pw; pw.x = cvtpk(p[rb][8 * s_ + 0], p[rb][8 * s_ + 1]); pw.y = cvtpk(p[rb][8 * s_ + 2], p[rb][8 * s_ + 3]); pw.z = cvtpk(p[rb][8 * s_ + 4], p[rb][8 * s_ + 5]); pw.w = cvtpk(p[rb][8 * s_ + 6], p[rb][8 * s_ + 7]);
        pf[q] = __builtin_bit_cast(bf16x8, pw); }
    __builtin_amdgcn_sched_barrier(0);
#pragma unroll
    for (int q = 0; q < 4; ++q)
#pragma unroll
        for (int db = 0; db < 2; ++db) { const bf16x8 vf = {lo[q][db][0], lo[q][db][1], lo[q][db][2], lo[q][db][3], hi[q][db][0], hi[q][db][1], hi[q][db][2], hi[q][db][3]};
            ot[db] = __builtin_amdgcn_mfma_f32_32x32x16_bf16(vf, pf[q], ot[db], 0, 0, 0); }
}
struct VFrags { v4i16_t lo[4][2], hi[4][2]; };
__device__ __forceinline__ void v_read(VFrags& F, const LAS unsigned char* lds, int buf, int lane, int vbase = L_V) {
    const int i16 = lane & 15, blk = (lane >> 4) & 1, hh = lane >> 5;
    const LAS unsigned char* vb = lds + vbase + buf * VBUF + (4 * hh + (i16 >> 2)) * VPITCH + 32 * blk + 8 * (i16 & 3);
#pragma unroll
    for (int q = 0; q < 4; ++q)
#pragma unroll
        for (int db = 0; db < 2; ++db) { const LAS unsigned char* vp = vb + (16 * q) * VPITCH + 64 * db;
            F.lo[q][db] = __builtin_amdgcn_ds_read_tr16_b64_v4i16((LAS v4i16_t*)vp); F.hi[q][db] = __builtin_amdgcn_ds_read_tr16_b64_v4i16((LAS v4i16_t*)(vp + 8 * VPITCH)); }
}
__device__ __forceinline__ void pv_mma(f32x16 (&ot)[2], const VFrags& F, const f32x16 (&p)[2]) {
    bf16x8 pf[4];
#pragma unroll
    for (int q = 0; q < 4; ++q) { const int rb = q >> 1, s_ = q & 1;
        u32x4 pw; pw.x = cvtpk(p[rb][8 * s_ + 0], p[rb][8 * s_ + 1]); pw.y = cvtpk(p[rb][8 * s_ + 2], p[rb][8 * s_ + 3]); pw.z = cvtpk(p[rb][8 * s_ + 4], p[rb][8 * s_ + 5]); pw.w = cvtpk(p[rb][8 * s_ + 6], p[rb][8 * s_ + 7]);
        pf[q] = __builtin_bit_cast(bf16x8, pw); }
    __builtin_amdgcn_sched_barrier(0);
#pragma unroll
    for (int q = 0; q < 4; ++q)
#pragma unroll
        for (int db = 0; db < 2; ++db) { const bf16x8 vf = {F.lo[q][db][0], F.lo[q][db][1], F.lo[q][db][2], F.lo[q][db][3], F.hi[q][db][0], F.hi[q][db][1], F.hi[q][db][2], F.hi[q][db][3]};
            ot[db] = __builtin_amdgcn_mfma_f32_32x32x16_bf16(vf, pf[q], ot[db], 0, 0, 0); }
}
struct SmState { float m, l; };
constexpr float RESC_THR = 8.f;
__device__ __forceinline__ float sm_cval(const SmState& S) { return (S.m == -INFINITY) ? 0.f : -S.m; }
__device__ __forceinline__ float row_max32(const f32x16 (&st)[2]) {
    float mx = fmaxf(st[0][0], st[1][0]);
#pragma unroll
    for (int i = 1; i < 16; ++i) mx = fmaxf(fmaxf(mx, st[0][i]), st[1][i]);
    return swap32_max(mx);
}
typedef float f32x2v __attribute__((ext_vector_type(2)));
template <bool WITH_O>
__device__ __forceinline__ void sm_shift(f32x16 (&st)[2], SmState& S, f32x16 (&ot)[2], float mx) {
    const bool fresh = (S.m == -INFINITY);
    const bool up = fresh ? (mx > -INFINITY) : (mx > RESC_THR);
    if (__any(up)) {
        const float d = up ? mx : 0.f; const float alpha = fresh ? 1.f : ex2(-d);
        S.l *= alpha; S.m = up ? ((fresh ? 0.f : S.m) + d) : S.m;
#pragma unroll
        for (int rb = 0; rb < 2; ++rb)
#pragma unroll
            for (int i = 0; i < 16; ++i) st[rb][i] -= d;
        if constexpr (WITH_O) {
#pragma unroll
            for (int db = 0; db < 2; ++db)
#pragma unroll
                for (int i = 0; i < 16; ++i) ot[db][i] *= alpha; }
    }
}
__device__ __forceinline__ void sm_update(f32x16 (&st)[2], SmState& S, f32x16 (&ot)[2]) {
    sm_shift<true>(st, S, ot, row_max32(st));
    float sum = 0.f;
#pragma unroll
    for (int rb = 0; rb < 2; ++rb)
#pragma unroll
        for (int i = 0; i < 16; ++i) { const float p = ex2(st[rb][i]); st[rb][i] = p; sum += p; }
    S.l += sum;
}
__device__ __forceinline__ void sm_stats(f32x16 (&st)[2], SmState& S) {
    f32x16 dummy[2];
    sm_shift<false>(st, S, dummy, row_max32(st));
    float sum = 0.f;
#pragma unroll
    for (int rb = 0; rb < 2; ++rb)
#pragma unroll
        for (int i = 0; i < 16; ++i) sum += ex2(st[rb][i]);
    S.l += sum;
}
__device__ __forceinline__ void zero_acc(f32x16 (&a)[2]) {
#pragma unroll
    for (int db = 0; db < 2; ++db)
#pragma unroll
        for (int i = 0; i < 16; ++i) a[db][i] = 0.f;
}
__device__ __forceinline__ void store_ot(const f32x16 (&o)[2], float sc, bf16_t* orow, int hh) {
#pragma unroll
    for (int db = 0; db < 2; ++db)
#pragma unroll
        for (int a = 0; a < 4; ++a) { u32x2 w; w.x = cvtpk(o[db][4 * a + 0] * sc, o[db][4 * a + 1] * sc); w.y = cvtpk(o[db][4 * a + 2] * sc, o[db][4 * a + 3] * sc);
            *(u32x2*)(orow + 32 * db + 8 * a + 4 * hh) = w; }
}
#define FA_FOREACH_REG(CODE) _Pragma("unroll") for (int rb = 0; rb < 2; ++rb) _Pragma("unroll") for (int a = 0; a < 4; ++a) _Pragma("unroll") for (int e = 0; e < 4; ++e) { const int i = 4 * a + e; const int kc = 32 * rb + 8 * a + e; (void)kc; CODE }
#define FA_LAUNDER(x) asm volatile("" : "+v"(x))

#define SGB(mask_, n_) __builtin_amdgcn_sched_group_barrier(mask_, n_, 0)
__device__ __forceinline__ float sm_finish(const f32x16 (&sc)[2], bf16x8 (&pf)[4]) {
    float sum = 0.f;
#pragma unroll
    for (int q = 0; q < 4; ++q) { const int rb = q >> 1, s_ = q & 1; float p[8];
#pragma unroll
        for (int j = 0; j < 8; ++j) { p[j] = ex2(sc[rb][8 * s_ + j]); sum += p[j]; }
        u32x4 pw; pw.x = cvtpk(p[0], p[1]); pw.y = cvtpk(p[2], p[3]); pw.z = cvtpk(p[4], p[5]); pw.w = cvtpk(p[6], p[7]);
        asm volatile("" : "+v"(pw.x), "+v"(pw.y), "+v"(pw.z), "+v"(pw.w));
        pf[q] = __builtin_bit_cast(bf16x8, pw); }
    return sum;
}
__device__ __forceinline__ void pv_mma_pf(f32x16 (&ot)[2], const VFrags& F, const bf16x8 (&pf)[4]) {
#pragma unroll
    for (int q = 0; q < 4; ++q)
#pragma unroll
        for (int db = 0; db < 2; ++db) { const bf16x8 vf = {F.lo[q][db][0], F.lo[q][db][1], F.lo[q][db][2], F.lo[q][db][3], F.hi[q][db][0], F.hi[q][db][1], F.hi[q][db][2], F.hi[q][db][3]};
            ot[db] = __builtin_amdgcn_mfma_f32_32x32x16_bf16(vf, pf[q], ot[db], 0, 0, 0); }
}
template <int NKS>
__device__ __forceinline__ void dense_step(f32x16 (&sc)[2], f32x16 (&ot)[2], SmState& S, VFrags& VF, const LAS unsigned char* lds, int buf, const bf16x8 (&qf)[NKS], int r, int hh, int lane, bool diag, int lim) {
    const LAS unsigned char* kp = lds + L_K + buf * KBUF + r * KPITCH + hh * 16;
    const float cval = sm_cval(S);
    __builtin_amdgcn_sched_barrier(0);
    bf16x8 kf[2][NKS];
#pragma unroll
    for (int ks = 0; ks < NKS; ++ks)
#pragma unroll
        for (int rb = 0; rb < 2; ++rb) kf[rb][ks] = *(const LAS bf16x8*)(kp + rb * 32 * KPITCH + ks * 32);
    f32x16 cin;
#pragma unroll
    for (int i = 0; i < 16; ++i) cin[i] = cval;
    f32x16 sn[2];
    sn[0] = __builtin_amdgcn_mfma_f32_32x32x16_bf16(kf[0][0], qf[0], cin, 0, 0, 0); sn[1] = __builtin_amdgcn_mfma_f32_32x32x16_bf16(kf[1][0], qf[0], cin, 0, 0, 0);
#pragma unroll
    for (int ks = 1; ks < NKS; ++ks) { sn[0] = __builtin_amdgcn_mfma_f32_32x32x16_bf16(kf[0][ks], qf[ks], sn[0], 0, 0, 0); sn[1] = __builtin_amdgcn_mfma_f32_32x32x16_bf16(kf[1][ks], qf[ks], sn[1], 0, 0, 0); }
    bf16x8 pf[4];
    S.l += sm_finish(sc, pf);
    SGB(0x100, 4); SGB(0x2, 16); SGB(0x400, 3); SGB(0x2, 3);
#pragma unroll
    for (int g = 0; g < 2 * NKS; ++g) { SGB(0x8, 1); if (g < 2 * NKS - 4) SGB(0x100, 1); SGB(0x400, 3); SGB(0x2, 4); }
    __builtin_amdgcn_sched_barrier(0);
    if (diag) { FA_FOREACH_REG({ int l_ = lim; asm volatile("" : "+v"(l_)); sn[rb][i] = (kc > l_) ? -INFINITY : sn[rb][i]; }) }
    pv_mma_pf(ot, VF, pf);
    const float mx = row_max32(sn);
#pragma unroll
    for (int g = 0; g < 8; ++g) { SGB(0x8, 1); SGB(0x2, 3); }
    __builtin_amdgcn_sched_barrier(0);
    sm_shift<true>(sn, S, ot, mx);
    v_read(VF, lds, buf, lane, L_VD);
    sc[0] = sn[0]; sc[1] = sn[1];
}

template <bool IS_MLA>
__device__ __forceinline__ void dense_unit(const Ctx& c, int lyr, int b, int h, int qb) {
    constexpr int NKS = IS_MLA ? 6 : 5;
    const int tid = c.tid, lane = c.lane, r = lane & 31, hh = lane >> 5, w = c.wave;
    LAS unsigned char* lds = c.lds;
    const int q0 = qb * 256, qrow = q0 + 32 * w + r; const size_t mrow = (size_t)b * T + qrow;
    KVSrc src; bf16x8 qf[NKS]; bf16_t* orow;
    if constexpr (IS_MLA) {
        const bf16_t* QB = WSP(bf16_t, WS_QB); const bf16_t* KVB = WSP(bf16_t, WS_KVB);
        src.K = KVB + (size_t)b * T * 1024 + h * 64; src.kpitch = 1024; src.K2 = WSP(bf16_t, WS_KR) + (size_t)b * T * 32; src.k2pitch = 32; src.V = KVB + (size_t)b * T * 1024 + 512 + h * 64; src.vpitch = 1024; src.cum = nullptr; src.cref = 0.f;
#pragma unroll
        for (int ks = 0; ks < 4; ++ks) qf[ks] = *(const bf16x8*)(QB + mrow * 768 + h * 64 + 16 * ks + 8 * hh);
#pragma unroll
        for (int ks = 0; ks < 2; ++ks) qf[4 + ks] = *(const bf16x8*)(QB + mrow * 768 + 512 + h * 32 + 16 * ks + 8 * hh);
        orow = WSP(bf16_t, WS_QB) + mrow * 768 + h * 64;
    } else {
        const bf16_t* P1 = WSP(bf16_t, WS_P1);
        src.K = P1 + (size_t)b * T * P1W + C_FQKV + 512 + h * 64; src.kpitch = P1W; src.K2 = nullptr; src.k2pitch = 0; src.V = P1 + (size_t)b * T * P1W + C_FQKV + 1024 + h * 64; src.vpitch = P1W;
        src.cum = WSP(float, WS_LC) + ((size_t)b * 8 + h) * T;
        { LAS float* cps_ = (LAS float*)(lds + L_CUM); if (tid < 128) cps_[tid] = (WSP(float, WS_CP) + ((size_t)b * 8 + h) * 129)[1 + tid]; }
        src.cref = 0.f;
#pragma unroll
        for (int ks = 0; ks < 4; ++ks) qf[ks] = *(const bf16x8*)(P1 + mrow * P1W + C_FQKV + h * 64 + 16 * ks + 8 * hh);
        { unsigned one2 = hh ? 0u : 0x3F803F80u; asm volatile("" : "+v"(one2)); u32x4 aq; aq.x = one2; aq.y = 0u; aq.z = 0u; aq.w = 0u; qf[4] = __builtin_bit_cast(bf16x8, aq); }
        orow = WSP(bf16_t, WS_P1) + mrow * P1W + C_FQKV + h * 64;
    }
    f32x16 sc[2], ot[2]; zero_acc(ot); SmState S{-INFINITY, 0.f};
#pragma unroll
    for (int i = 0; i < 16; ++i) { sc[0][i] = -INFINITY; sc[1][i] = -INFINITY; }
    VFrags VF;
#pragma unroll
    for (int q = 0; q < 4; ++q)
#pragma unroll
        for (int db = 0; db < 2; ++db) { VF.lo[q][db] = (v4i16_t){0, 0, 0, 0}; VF.hi[q][db] = (v4i16_t){0, 0, 0, 0}; }
    constexpr float FOX_SKIP = 40.f;
    float qbound = 0.f, mmin_blk = -INFINITY; LAS float* MM = (LAS float*)(lds + L_UNIT + 16);
    if constexpr (!IS_MLA) {
        float ss = 0.f;
#pragma unroll
        for (int ks = 0; ks < 4; ++ks)
#pragma unroll
            for (int j = 0; j < 8; ++j) { const float x_ = bf2f((bf16_t)qf[ks][j]); ss += x_ * x_; }
        ss = swap32_sum(ss);
        const float km2 = __uint_as_float((WSP(unsigned, WS_CTL) + CW_KMAX)[lyr * 16 + b * 8 + h]);
        qbound = sqrtf(ss * km2) * 1.001f + 0.01f;
    }
    const LAS float* cps = (const LAS float*)(lds + L_CUM);
#define FOX_CP(t_) ((t_) == 0 ? 0.f : cps[(t_) - 1])
    const int nT = 2 * qb + 2;
    TileRegs Ra, Rb;
    tile_load<IS_MLA, !IS_MLA>(Ra, src, 128 * (nT - 1) + 64, tid); tile_load<IS_MLA, !IS_MLA>(Rb, src, 128 * (nT - 1), tid);
    if constexpr (!IS_MLA) { __syncthreads(); src.cref = src.cum[q0] + FOX_CP(4 * qb); }
    tile_store<IS_MLA, !IS_MLA>(Ra, lds, 0, tid, src.cref, IS_MLA ? 0.f : FOX_CP(2 * nT - 1), L_VD); tile_store<IS_MLA, !IS_MLA>(Rb, lds, 1, tid, src.cref, IS_MLA ? 0.f : FOX_CP(2 * nT - 2), L_VD);
    if (nT > 1) { tile_load<IS_MLA, !IS_MLA>(Ra, src, 128 * (nT - 2) + 64, tid); tile_load<IS_MLA, !IS_MLA>(Rb, src, 128 * (nT - 2), tid); }
    __syncthreads();
    for (int it = 0; it < nT; ++it) { const int Tt = nT - 1 - it, sb = 2 * (it & 1);
        if constexpr (!IS_MLA) { if (it >= 2 && (src.cref - cps[2 * Tt + 1]) < mmin_blk - FOX_SKIP) break; }
#pragma unroll
        for (int sub = 1; sub >= 0; --sub) { const int t = 2 * Tt + sub, buf = sb + (1 - sub), kv0 = 64 * t;
            int lim = qrow - kv0 - 4 * hh; FA_LAUNDER(lim);
            dense_step<NKS>(sc, ot, S, VF, lds, buf, qf, r, hh, lane, kv0 + 63 > q0 + 32 * w, lim); (void)t; }
        if constexpr (!IS_MLA) { if (it == 1) { const float v_ = -wave_max(-(S.m - qbound)); if (lane == 0) MM[w] = v_; } }
        if (it + 1 < nT) { tile_store<IS_MLA, !IS_MLA>(Ra, lds, sb ^ 2, tid, src.cref, IS_MLA ? 0.f : FOX_CP(2 * Tt - 1), L_VD); tile_store<IS_MLA, !IS_MLA>(Rb, lds, (sb ^ 2) + 1, tid, src.cref, IS_MLA ? 0.f : FOX_CP(2 * Tt - 2), L_VD);
            if (it + 2 < nT) { tile_load<IS_MLA, !IS_MLA>(Ra, src, 128 * (Tt - 2) + 64, tid); tile_load<IS_MLA, !IS_MLA>(Rb, src, 128 * (Tt - 2), tid); } }
        __syncthreads();
        if constexpr (!IS_MLA) { if (it == 1) { float mm_ = MM[0];
#pragma unroll
            for (int q_ = 1; q_ < 8; ++q_) mm_ = fminf(mm_, MM[q_]);
            mmin_blk = mm_; } }
    }
    { bf16x8 pf[4]; S.l += sm_finish(sc, pf); pv_mma_pf(ot, VF, pf); }
    const float lt = swap32_sum(S.l);
    store_ot(ot, 1.f / lt, orow, hh);
}

#define FA_STREAM(SRC, NT, TILE_EXPR, BODY) do { TileRegs R_; const int nt_ = (NT); \
    if (nt_ > 0) { { const int idx = 0; tile_load<false, false>(R_, SRC, 64 * (TILE_EXPR), tid); } tile_store<false, false>(R_, lds, 0, tid); \
      if (nt_ > 1) { const int idx = 1; tile_load<false, false>(R_, SRC, 64 * (TILE_EXPR), tid); } \
      __syncthreads(); \
      for (int it_ = 0; it_ < nt_; ++it_) { const int buf = it_ & 1; int tile; { const int idx = it_; tile = (TILE_EXPR); } \
          BODY \
          if (it_ + 1 < nt_) { tile_store<false, false>(R_, lds, buf ^ 1, tid); if (it_ + 2 < nt_) { const int idx = it_ + 2; tile_load<false, false>(R_, SRC, 64 * (TILE_EXPR), tid); } } \
          __syncthreads(); } } } while (0)

__device__ __forceinline__ void nsa_unit(const Ctx& c, int b, int g, int j) {
    const int tid = c.tid, lane = c.lane, r = lane & 31, hh = lane >> 5, w = c.wave;
    LAS unsigned char* lds = c.lds;
    const int t0 = 64 * j, tl = r >> 2, hp = r & 3, tokl = 8 * w + tl, tq = t0 + tokl, head = 4 * g + hp; const size_t mrow = (size_t)b * T + tq;
    const bf16_t* P1 = WSP(bf16_t, WS_P1);
    bf16x8 qf[4];
#pragma unroll
    for (int ks = 0; ks < 4; ++ks) qf[ks] = *(const bf16x8*)(P1 + mrow * P1W + C_NQ + head * 64 + 16 * ks + 8 * hh);
    const float gc = sigmoidf_(bf2f(P1[mrow * P1W + C_NG + head * 3 + 0])), gsl = sigmoidf_(bf2f(P1[mrow * P1W + C_NG + head * 3 + 1])), gwn = sigmoidf_(bf2f(P1[mrow * P1W + C_NG + head * 3 + 2]));
    const LAS float* lutL = (const LAS float*)(lds + L_LUT) + head * 132;
    LAS float* PS = (LAS float*)(lds + L_PS); LAS float* FM = (LAS float*)(lds + L_F); LAS unsigned* SEL = (LAS unsigned*)(lds + L_SEL); LAS unsigned* UNI = (LAS unsigned*)(lds + L_UNI);
    LAS unsigned char* TL = (LAS unsigned char*)(lds + L_TL); LAS int* TLN = (LAS int*)(lds + L_TLN);
    f32x16 st[2], ot[2], otot[2]; zero_acc(otot);
    { float zz_ = 0.f; asm volatile("" : "+v"(zz_)); const f32x4 z4 = {zz_, zz_, zz_, zz_}; for (int i = tid; i < 2 * 64 * 132 / 4; i += NTHREADS) ((LAS f32x4*)PS)[i] = z4; }
    if (tid < 256) SEL[tid] = 0u; if (tid < 4) UNI[tid] = 0u;
    const float bfar = lutL[128];
    const int tmin = t0 + 8 * w;
    const int n_ok_max = ((t0 + 63 - 31) >> 4) + 1; const int nct = (n_ok_max + 63) >> 6;
    KVSrc srcc; srcc.K = WSP(bf16_t, WS_KC) + (size_t)(b * 2 + g) * 512 * 64; srcc.kpitch = 64; srcc.K2 = nullptr; srcc.k2pitch = 0; srcc.V = WSP(bf16_t, WS_VC) + (size_t)(b * 2 + g) * 512 * 64; srcc.vpitch = 64; srcc.cum = nullptr; srcc.cref = 0.f;
    SmState Sc{-INFINITY, 0.f};
    FA_STREAM(srcc, nct, idx, {
        const bool farc = (16 * (64 * tile + 63) + 31 + 128 <= tmin);
        qk_tile<4>(st, lds, buf, qf, r, hh, sm_cval(Sc) + (farc ? bfar : 0.f));
        if (!farc) { int db_ = tq - 31 - 1024 * tile - 64 * hh; FA_LAUNDER(db_); FA_FOREACH_REG({ const int dist = db_ - 16 * kc; const float s_ = st[rb][i] + lutL[dist < 0 ? 0 : (dist > 128 ? 128 : dist)]; st[rb][i] = dist < 0 ? -INFINITY : s_; }) }
        sm_stats(st, Sc); });
    { const float lt = swap32_sum(Sc.l); const float inv = lt > 0.f ? 1.f / lt : 0.f; const float msafe = (Sc.m == -INFINITY) ? 0.f : Sc.m;
      zero_acc(ot);
      FA_STREAM(srcc, nct, idx, {
        const bool farc = (16 * (64 * tile + 63) + 31 + 128 <= tmin);
        qk_tile<4>(st, lds, buf, qf, r, hh, (farc ? bfar : 0.f) - msafe);
        if (farc) { FA_FOREACH_REG({ st[rb][i] = ex2(st[rb][i]) * inv; }) }
        else { int db_ = tq - 31 - 1024 * tile - 64 * hh; FA_LAUNDER(db_); float lb_[2][16];
            FA_FOREACH_REG({ const int dist = db_ - 16 * kc; lb_[rb][i] = lutL[dist < 0 ? 0 : (dist > 128 ? 128 : dist)]; })
            __builtin_amdgcn_sched_barrier(0);
            FA_FOREACH_REG({ const int dist = db_ - 16 * kc; float e_ = ex2(st[rb][i] + lb_[rb][i]) * inv; asm volatile("" : "+v"(e_)); st[rb][i] = dist < 0 ? 0.f : e_; }) }
_Pragma("unroll")
        for (int rb = 0; rb < 2; ++rb)
_Pragma("unroll")
            for (int a = 0; a < 4; ++a) { float q4[4];
_Pragma("unroll")
                for (int e = 0; e < 4; ++e) { float v = st[rb][4 * a + e]; v += dpp_f<0xB1>(v); v += dpp_f<0x4E>(v); q4[e] = v; }
                if (hp == 0) { const int G = 16 * tile + 8 * rb + 2 * a + hh; PS[tokl * 132 + G] = q4[0] + 2.f * (q4[1] + q4[2] + q4[3]); FM[tokl * 132 + G] = q4[0]; } }
        pv_tile(ot, lds, buf, st, lane); });
#pragma unroll
      for (int db = 0; db < 2; ++db)
#pragma unroll
          for (int i = 0; i < 16; ++i) otot[db][i] += gc * ot[db][i]; }
    if (j + 1 <= 16) { if (tid < 64) SEL[tid * 4] = (1u << (j + 1)) - 1u; if (tid == 0) UNI[0] = (1u << (j + 1)) - 1u; }
    else {
        const int tk = tid >> 3, sub = tid & 7; unsigned bits[4] = {1u, 0u, 0u, 0u};
        float cv[16];
#pragma unroll
        for (int k = 0; k < 16; ++k) { const int G = sub + 8 * k; cv[k] = PS[tk * 132 + G] + FM[tk * 132 + G + 1]; }
        asm volatile("" : "+v"(cv[0]), "+v"(cv[1]), "+v"(cv[2]), "+v"(cv[3]), "+v"(cv[4]), "+v"(cv[5]), "+v"(cv[6]), "+v"(cv[7]), "+v"(cv[8]), "+v"(cv[9]), "+v"(cv[10]), "+v"(cv[11]), "+v"(cv[12]), "+v"(cv[13]), "+v"(cv[14]), "+v"(cv[15]));
#pragma unroll
        for (int k = 0; k < 16; ++k) { const int G = sub + 8 * k; cv[k] = (G >= 1 && G <= j - 2) ? cv[k] : -INFINITY; }
#pragma unroll 1
        for (int round = 0; round < 13; ++round) {
            float bv = cv[0]; int bk = 0;
#pragma unroll
            for (int k = 1; k < 16; ++k) { const bool gt = cv[k] > bv; bv = gt ? cv[k] : bv; bk = gt ? k : bk; }
            int bG = sub + 8 * bk;
#define ARGMAX_STEP(CTRL) { const float ov = dpp_f<CTRL>(bv); const int oG = __builtin_amdgcn_update_dpp(0, bG, CTRL, 0xf, 0xf, true); const bool take = (ov > bv) || (ov == bv && oG < bG); bv = take ? ov : bv; bG = take ? oG : bG; }
            ARGMAX_STEP(0xB1) ARGMAX_STEP(0x4E) ARGMAX_STEP(0x141)
#undef ARGMAX_STEP
            const int wk = bG >> 3; const bool own = (bG & 7) == sub;
#pragma unroll
            for (int k = 0; k < 16; ++k) cv[k] = (own && k == wk) ? -INFINITY : cv[k];
            { const unsigned bit_ = 1u << (bG & 31); const int wq_ = bG >> 5; bits[0] |= (wq_ == 0) ? bit_ : 0u; bits[1] |= (wq_ == 1) ? bit_ : 0u; bits[2] |= (wq_ == 2) ? bit_ : 0u; bits[3] |= (wq_ == 3) ? bit_ : 0u; }
        }
        { const int G = j; const unsigned bit_ = 1u << (G & 31); const int wq_ = G >> 5; bits[0] |= (wq_ == 0) ? bit_ : 0u; bits[1] |= (wq_ == 1) ? bit_ : 0u; bits[2] |= (wq_ == 2) ? bit_ : 0u; bits[3] |= (wq_ == 3) ? bit_ : 0u; }
        { const int G = j - 1; const unsigned bit_ = 1u << (G & 31); const int wq_ = G >> 5; bits[0] |= (wq_ == 0) ? bit_ : 0u; bits[1] |= (wq_ == 1) ? bit_ : 0u; bits[2] |= (wq_ == 2) ? bit_ : 0u; bits[3] |= (wq_ == 3) ? bit_ : 0u; }
        if (sub == 0) {
#pragma unroll
            for (int q = 0; q < 4; ++q) { SEL[tk * 4 + q] = bits[q]; if (bits[q]) atomicOr((unsigned*)(UNI + q), bits[q]); } }
    }
    __syncthreads();
    if (tid < 128) { const unsigned u0 = UNI[0], u1 = UNI[1], u2 = UNI[2], u3 = UNI[3]; const int wq_ = tid >> 5, bp = tid & 31;
        const unsigned mw_ = wq_ == 0 ? u0 : wq_ == 1 ? u1 : wq_ == 2 ? u2 : u3;
        if ((mw_ >> bp) & 1u) { const int pos = (wq_ > 0 ? __builtin_popcount(u0) : 0) + (wq_ > 1 ? __builtin_popcount(u1) : 0) + (wq_ > 2 ? __builtin_popcount(u2) : 0) + __builtin_popcount(mw_ & ((1u << bp) - 1u)); TL[pos] = (unsigned char)tid; }
        if (tid == 0) TLN[0] = __builtin_popcount(u0) + __builtin_popcount(u1) + __builtin_popcount(u2) + __builtin_popcount(u3); }
    __syncthreads();
    const unsigned msk0 = SEL[tokl * 4 + 0], msk1 = SEL[tokl * 4 + 1], msk2 = SEL[tokl * 4 + 2], msk3 = SEL[tokl * 4 + 3];
    const int nsel = __builtin_amdgcn_readfirstlane(TLN[0]);
    { KVSrc srcs; srcs.K = P1 + (size_t)b * T * P1W + C_NKV + ((1 * 2 + 0) * 2 + g) * 64; srcs.kpitch = P1W; srcs.K2 = nullptr; srcs.k2pitch = 0; srcs.V = P1 + (size_t)b * T * P1W + C_NKV + ((1 * 2 + 1) * 2 + g) * 64; srcs.vpitch = P1W; srcs.cum = nullptr; srcs.cref = 0.f;
      SmState Ss{-INFINITY, 0.f}; zero_acc(ot);
      FA_STREAM(srcs, nsel, (int)TL[idx], {
        const int wq = tile >> 5; const unsigned mw = wq == 0 ? msk0 : wq == 1 ? msk1 : wq == 2 ? msk2 : msk3; const bool mine = (mw >> (tile & 31)) & 1u;
        if (__any(mine)) {
            const bool fars = (64 * tile + 63 + 128 <= tmin);
            qk_tile<4>(st, lds, buf, qf, r, hh, mine ? sm_cval(Ss) + (fars ? bfar : 0.f) : -INFINITY);
            if (!fars) { int db_ = tq - 64 * tile - 4 * hh; FA_LAUNDER(db_); FA_FOREACH_REG({ const int dist = db_ - kc; const float s_ = st[rb][i] + lutL[dist < 0 ? 0 : (dist > 128 ? 128 : dist)]; st[rb][i] = (dist >= 0) ? s_ : -INFINITY; }) }
            VFrags VF; v_read(VF, lds, buf, lane); __builtin_amdgcn_sched_barrier(0);
            sm_update(st, Ss, ot);
            pv_mma(ot, VF, st); } });
      const float lt = swap32_sum(Ss.l); const float sc = lt > 0.f ? gsl / lt : 0.f;
#pragma unroll
      for (int db = 0; db < 2; ++db)
#pragma unroll
          for (int i = 0; i < 16; ++i) otot[db][i] += sc * ot[db][i]; }
    { KVSrc srcw; srcw.K = P1 + (size_t)b * T * P1W + C_NKV + ((2 * 2 + 0) * 2 + g) * 64; srcw.kpitch = P1W; srcw.K2 = nullptr; srcw.k2pitch = 0; srcw.V = P1 + (size_t)b * T * P1W + C_NKV + ((2 * 2 + 1) * 2 + g) * 64; srcw.vpitch = P1W; srcw.cum = nullptr; srcw.cref = 0.f;
      const int jlo = j - 8 > 0 ? j - 8 : 0;
      SmState Sw{-INFINITY, 0.f}; zero_acc(ot);
      FA_STREAM(srcw, j - jlo + 1, jlo + idx, {
        qk_tile<4>(st, lds, buf, qf, r, hh, sm_cval(Sw));
        { int db_ = tq - 64 * tile - 4 * hh; FA_LAUNDER(db_); FA_FOREACH_REG({ const int dist = db_ - kc; const float s_ = st[rb][i] + lutL[dist < 0 ? 0 : (dist > 128 ? 128 : dist)]; st[rb][i] = (dist >= 0 && dist < 512) ? s_ : -INFINITY; }) }
        VFrags VF; v_read(VF, lds, buf, lane); __builtin_amdgcn_sched_barrier(0);
        sm_update(st, Sw, ot);
        pv_mma(ot, VF, st); });
      const float lt = swap32_sum(Sw.l); const float sc = lt > 0.f ? gwn / lt : 0.f;
#pragma unroll
      for (int db = 0; db < 2; ++db)
#pragma unroll
          for (int i = 0; i < 16; ++i) otot[db][i] += sc * ot[db][i]; }
    store_ot(otot, 1.f, WSP(bf16_t, WS_P1) + mrow * P1W + C_NQ + head * 64, hh);
}
}

__device__ __forceinline__ int next_unit(const Ctx& c, unsigned* ctr, int& seq) {
    LAS int* u = (LAS int*)(c.lds + fa::L_UNIT) + (seq & 1); ++seq;
    if (c.tid == 0) u[0] = (int)__hip_atomic_fetch_add(ctr, 1u, __ATOMIC_RELAXED, __HIP_MEMORY_SCOPE_AGENT);
    __syncthreads();
    return __builtin_amdgcn_readfirstlane(u[0]);
}
__device__ __forceinline__ void phase_att_fast(const Ctx& c0, int l) {
    Ctx c = c0;
    unsigned* ctr0 = WSP(unsigned, WS_CTL) + CW_QUEUE + 64 * 8 * l;
    { const float* lut = WSP(float, WS_TAB) + 512; LAS float* L_ = (LAS float*)(c.lds + fa::L_LUT); float t3[3];
#pragma unroll
      for (int q = 0; q < 3; ++q) { const int i = c.tid + q * NTHREADS; t3[q] = lut[i < 8 * 132 ? i : 0]; }
      __builtin_amdgcn_sched_barrier(0);
#pragma unroll
      for (int q = 0; q < 3; ++q) { const int i = c.tid + q * NTHREADS; if (i < 8 * 132) L_[i] = t3[q]; } }
    const int myx = (int)(xb_xcc_id() & 7u);
    int seq = 0;
    for (int qi = 0; qi < 8; ++qi) {
        const int x = (myx + qi) & 7;
        for (;;) {
            const int u = next_unit(c, ctr0 + 64 * x, seq);
            if (u >= 192) break;
            relaunder(c);
            if (u < 48 || (u >= 112 && u < 128)) { const int uu = u < 48 ? u : u - 112; const int qb = (u < 48 ? 31 : 7) - (uu >> 1); const int p = 2 * x + (uu & 1); if (ATT_FAST_MLA) fa::dense_unit<true>(c, l & 1, p >> 3, p & 7, qb); }
            else if (u < 112) { const int n = u - 48, grp = x >> 1; if (ATT_FAST_NSA) fa::nsa_unit(c, grp >> 1, grp & 1, 127 - 2 * n - (x & 1)); }
            else { const int p = 2 * x + (u & 1); if (ATT_FAST_FOX) fa::dense_unit<false>(c, l & 1, p >> 3, p & 7, 31 - ((u - 128) >> 1)); }
        }
    }
}

struct Args { const void* in[32]; float* out; unsigned char* ws; int l_lo, l_hi; };
constexpr int PH_PER_LAYER = 15, K_FINAL = 1 + PH_PER_LAYER;
template <int KIND>
__global__ void __launch_bounds__(NTHREADS, 2) fwd_kernel(Args a) {
    extern __shared__ __attribute__((aligned(16))) unsigned char lds_raw[];
    Ctx c;
    c.out = a.out; c.ws = a.ws; c.ws0 = a.ws; c.lds = (LAS unsigned char*)lds_raw;
    c.tid = threadIdx.x; c.lane = c.tid & 63; c.wave = __builtin_amdgcn_readfirstlane(c.tid >> 6); c.G = gridDim.x; c.bid = blockIdx.x;
    if (c.tid < 4) ((LAS unsigned*)(c.lds + LDS_MISC))[c.tid] = 0u;
    if (c.tid < 32) { const unsigned long long pv = (unsigned long long)a.in[c.tid]; ((LAS unsigned*)(c.lds + LDS_INTAB))[2 * c.tid] = (unsigned)pv; ((LAS unsigned*)(c.lds + LDS_INTAB))[2 * c.tid + 1] = (unsigned)(pv >> 32); }
    __syncthreads();
    XcdBarrier bar; bar.bar = WSP(unsigned, WS_CTL) + CW_BAR; bar.x = 0; bar.st = nullptr;
    if constexpr (KIND < 0) bar = xcd_barrier_post(WSP(unsigned, WS_CTL) + CW_BAR, (volatile LAS unsigned*)(c.lds + LDS_MISC));
#define IN(k) ((KIND < 0 || KIND == (k)) && (relaunder(c), true))
#define REP(p) for (int rep_ = 0; rep_ < ((PROBE_DOUBLE == (p)) ? 2 : 1); ++rep_)
#define SEAM(k) do { if constexpr (KIND < 0) { unsigned* bb_ = bar.bar; asm volatile("" : "+s"(bb_)); bar.bar = bb_; xcd_barrier(bar); } } while (0)
    LAS unsigned char* ring = c.lds;

    if (IN(0)) REP(4) { phase_prologue(c); }
    for (int l = a.l_lo; l < a.l_hi; ++l) {
        constexpr int pb = 1;
        const float* resid = (l == 0) ? c.x() : WSP(float, WS_XA);
        if (IN(pb + 0)) { if (l == 0) phase_norm(c, c.x(), nullptr, nullptr, nullptr, nullptr, WSP(bf16_t, WS_H0));
                          else phase_norm_h2(c, WSP(bf16_t, WS_XA), WSP(bf16_t, WS_H0));
        } SEAM(pb + 0);
        if (IN(pb + 1)) REP(2) { pg8::Cfg g{(unsigned)(D * 2), 128u, (unsigned)(D * 2), D / 64, nullptr}; pg8::DenseOrder S; S.init(M / 256, (c.G >= 256 || (l == 1 && c.G >= 128)) ? NCAT / 256 - 1 : NCAT / 256, c.G, c.bid, WSP(bf16_t, WS_H0), (size_t)256 * D * 2, WSP(bf16_t, WS_WINT) + (size_t)l * NCAT * D, (size_t)256 * D * 2);
            EpiInprojGates E{WSP(bf16_t, WS_P1), WSP(unsigned char, WS_GATES), c.b_merge() + l * 3072}; pg8::gemm_phase<false>(ring, c.wave, g, S, E);
            if (l == 0 && c.G >= 256) {
                relaunder(c);
                LAS float* scr = (LAS float*)(c.lds + c.wave * 16384); const int NGW = c.G * NWAVES; const int gw = c.bid * NWAVES + c.wave;
#define URG_MAKE(i_) prologue_item(c, (i_) < (PO_WO - PO_UQ) ? PO_UQ + (i_) : PO_C1 + ((i_) - (PO_WO - PO_UQ)))
                T_SIMPLE((PO_WO - PO_UQ) + 2 * PI_C1, URG_MAKE);
#undef URG_MAKE
            } else if (l == 0) {
                int nfull = (M / 256) * (NCAT / 256) - 6 * c.G; if (nfull < 0 || nfull >= c.G) nfull = 0;
                relaunder(c);
                LAS float* scr = (LAS float*)(c.lds + c.wave * 16384); const int NGW = (c.G - nfull) * NWAVES; const int gw = (c.bid >= nfull) ? (c.bid - nfull) * NWAVES + c.wave : 0x3fffffff;
#define DEF_MAKE(i_) prologue_item(c, (PI_WIN + PI_WM) + (i_))
                T_SIMPLE(NL * PI_PER_L - (PI_WIN + PI_WM), DEF_MAKE);
#undef DEF_MAKE
            } } SEAM(pb + 1);
        if (IN(pb + 2)) {
            const bool split = c.G >= 64; const bool defer = (c.G >= 256 || (l == 1 && c.G >= 128));
            const int nprep = split ? c.G - 32 - (defer ? M / 256 : 0) : c.G;
            if (!split || c.bid < nprep) phase_prep(c, l, c.bid, nprep);
            else if (c.bid < c.G - 32) { pg8::Cfg g{(unsigned)(D * 2), 128u, (unsigned)(D * 2), D / 64, nullptr};
                OneTileOrder S{c.bid - nprep, NCAT / 256 - 1, (const char*)WSP(bf16_t, WS_H0), (const char*)(WSP(bf16_t, WS_WINT) + (size_t)l * NCAT * D), (size_t)256 * D * 2, (size_t)256 * D * 2};
                EpiInprojGates E{WSP(bf16_t, WS_P1), WSP(unsigned char, WS_GATES), c.b_merge() + l * 3072}; pg8::gemm_phase<false>(ring, c.wave, g, S, E); }
            if (!split || c.bid >= c.G - 32) { pg8::Cfg g{(unsigned)(16 * P1W * 2), (unsigned)(P1W * 2), 4096u, 16, nullptr};
                CmpOrder S{split ? 32 : c.G, split ? c.bid - (c.G - 32) : c.bid, (const char*)WSP(bf16_t, WS_P1), (const char*)(WSP(bf16_t, WS_WC1T) + (size_t)l * 2 * 256 * 2048)};
                EpiCmpSlab E{WSP(float, WS_SL)}; pg8::gemm_phase<false>(ring, c.wave, g, S, E); }
        } SEAM(pb + 2);
        if (IN(pb + 3)) REP(2) {
            phase_cmp2(c, l); phase_chunk_prefix(c);
            { pg8::Cfg g{(unsigned)(P1W * 2), 128u, 512u, 4, nullptr}; pg8::DenseOrder S; S.init(M / 256, 2, c.G, c.bid, WSP(bf16_t, WS_P1) + C_CQ, (size_t)256 * P1W * 2, WSP(bf16_t, WS_WUQT) + (size_t)l * 768 * 256, (size_t)256 * 512);
              EpiStoreBf16 E{WSP(bf16_t, WS_QB), 768, WSP(float, WS_RSTD), 2}; pg8::gemm_phase<false>(ring, c.wave, g, S, E); }
            { pg8::Cfg g{(unsigned)(P1W * 2), 128u, 512u, 4, nullptr}; pg8::DenseOrder S; S.init(M / 256, 1, c.G, (c.bid + 128) % c.G, WSP(bf16_t, WS_P1) + C_CQ, (size_t)256 * P1W * 2, WSP(bf16_t, WS_WUQT) + (size_t)l * 768 * 256 + (size_t)512 * 256, (size_t)256 * 512);
              EpiUqRope E{WSP(bf16_t, WS_QB) + 512, WSP(float, WS_RSTD), WSP(float, WS_ROPE), WSP(float, WS_ROPE) + (size_t)M * 16}; pg8::gemm_phase<false>(ring, c.wave, g, S, E); }
            { pg8::Cfg g{(unsigned)(P1W * 2), 128u, 256u, 2, nullptr}; pg8::DenseOrder S; S.init(M / 256, 4, c.G, c.bid, WSP(bf16_t, WS_P1) + C_CKV, (size_t)256 * P1W * 2, WSP(bf16_t, WS_WUKVT) + (size_t)l * 1024 * 128, (size_t)256 * 256);
              EpiStoreBf16 E{WSP(bf16_t, WS_KVB), 1024, WSP(float, WS_RSTD) + 1, 2}; pg8::gemm_phase<false>(ring, c.wave, g, S, E); }
            if (l == 0 && c.G >= 256 && c.bid >= 192) {
                relaunder(c); LAS float* scr = (LAS float*)(c.lds + c.wave * 16384); const int NGW = (c.G - 192) * NWAVES; const int gw = (c.bid - 192) * NWAVES + c.wave;
#define WO_MAKE(i_) prologue_item(c, PO_WO + (i_))
                T_SIMPLE(PO_C1 - PO_WO, WO_MAKE);
#undef WO_MAKE
            }
        } SEAM(pb + 3);
        if (IN(pb + 6)) { phase_att_fast(c, l);
#if PROBE_DOUBLE == 1
            phase_att_fast(c, l + 2);
#endif
        } SEAM(pb + 6);
        if (IN(pb + 9)) REP(2) {
            pg8::Cfg g{(unsigned)(P1W * 2), 128u, 1024u, 8, nullptr};
            OutprojOrderH S{c.G, c.bid, (const char*)c.ws, (long long)(WS_P1 + C_NQ * 2), (long long)WS_QB - (long long)(WS_P1 + C_NQ * 2), (long long)(C_FQKV - C_NQ) * 2, (const char*)(WSP(bf16_t, WS_WOT) + (size_t)l * 3 * 1024 * 512), (unsigned)(P1W * 2), 768u * 2u};
            EpiOutprojH E{WSP(bf16_t, WS_MIXED), WSP(unsigned char, WS_GATES)}; pg8::gemm_phase<false, true>(ring, c.wave, g, S, E);
        } SEAM(pb + 9);
        if (IN(pb + 10)) { pg8::Cfg g{(unsigned)(D * 2), 128u, (unsigned)(D * 2), D / 64, nullptr}; pg8::DenseOrder S; S.init(M / 256, 4, c.G, c.bid, WSP(bf16_t, WS_MIXED), (size_t)256 * D * 2, WSP(bf16_t, WS_WOUTT) + (size_t)l * D * D, (size_t)256 * D * 2);
            EpiStoreBf16 E{WSP(bf16_t, WS_DELTA), 1024, nullptr, 0}; pg8::gemm_phase<false>(ring, c.wave, g, S, E);
        } SEAM(pb + 10);
        if (IN(pb + 11)) { if (l == 0) phase_router<false>(c, l, resid); else phase_router<true>(c, l, resid);
#if PROBE_DOUBLE == 3
            if (l == 0) phase_router<false>(c, l, resid, 1); else phase_router<true>(c, l, resid, 1);
#endif
        } SEAM(pb + 11);
        if (IN(pb + 12)) REP(4) { phase_place(c, l); } SEAM(pb + 12);
        if (IN(pb + 13)) REP(2) { LAS int* tab = (LAS int*)(c.lds + LDS_MOETAB); moe_tables(c, l, tab);
            pg8::Cfg g{(unsigned)(D * 2), 128u, (unsigned)(D * 2), D / 64, WSP(int, WS_LTOK)}; MoeOrder S{c.G, c.bid, 2, tab, (const char*)WSP(bf16_t, WS_H2), 0, (const char*)WSP(bf16_t, WS_WGU), (size_t)512 * D * 2, (size_t)256 * D * 2, 1};
            EpiMoe1 E{WSP(bf16_t, WS_HID), WSP(float, WS_LW)}; pg8::gemm_phase<true>(ring, c.wave, g, S, E);
            { MoeOrderH SH{c.G, c.bid, tab, (const char*)WSP(bf16_t, WS_H2), (const char*)WSP(bf16_t, WS_WGU), (size_t)512 * D * 2, (size_t)256 * D * 2}; EpiMoe1H EH{WSP(bf16_t, WS_HID), WSP(float, WS_LW)};
              pg8::gemm_phase<true, true>(ring, c.wave, g, SH, EH); }
            { const int nun = __builtin_amdgcn_readfirstlane(tab[32]) * 2; int n2 = 2 * (nun - c.G); if (n2 < 0) n2 = 0; if (n2 >= c.G) n2 = 0;
              if (c.bid >= n2) { relaunder(c); LAS float* scr = (LAS float*)(c.lds + c.wave * 16384); const int gw = (c.bid - n2) * NWAVES + c.wave, NGW = (c.G - n2) * NWAVES;
#define DN_MAKE(i_) place_item_dn(c, l, (i_))
                  T_SIMPLE(32 * 128, DN_MAKE);
#undef DN_MAKE
                  if (l == 0 && c.G >= 256) {
#define L1A_MAKE(i_) prologue_item(c, PI_PER_L + (i_))
                      T_SIMPLE(PO_UQ, L1A_MAKE);
#undef L1A_MAKE
                  }
              } }
        } SEAM(pb + 13);
        if (IN(pb + 14)) REP(2) { LAS int* tab = (LAS int*)(c.lds + LDS_MOETAB); moe_tables(c, l, tab);
            pg8::Cfg g{512u, 128u, 512u, 4, nullptr}; MoeOrder S{c.G, c.bid, 4, tab, (const char*)WSP(bf16_t, WS_HID), 512, (const char*)WSP(bf16_t, WS_WDT), (size_t)D * 256 * 2, (size_t)256 * 256 * 2, 1 << 20};
            EpiMoe2 E{WSP(bf16_t, WS_Y), WSP(unsigned, WS_LSLOT)}; pg8::gemm_phase<false>(ring, c.wave, g, S, E);
            if (l == 0 && c.G >= 256) {
                int n3 = __builtin_amdgcn_readfirstlane(tab[32]) * 4 - 2 * c.G; if (n3 < 0 || n3 >= c.G) n3 = 0;
                if (c.bid >= n3) { relaunder(c); LAS float* scr = (LAS float*)(c.lds + c.wave * 16384); const int gw = (c.bid - n3) * NWAVES + c.wave, NGW = (c.G - n3) * NWAVES;
#define L1B_MAKE(i_) prologue_item(c, PI_PER_L + PO_UQ + (i_))
                    T_SIMPLE(PI_PER_L - PO_UQ, L1B_MAKE);
#undef L1B_MAKE
                } } } SEAM(pb + 14);
    }
    if (IN(K_FINAL)) REP(6) { phase_final(c); }
#undef IN
#undef SEAM
}

template <int KIND> static bool prep_kernel() { return hipFuncSetAttribute((const void*)fwd_kernel<KIND>, hipFuncAttributeMaxDynamicSharedMemorySize, LDS_BYTES) == hipSuccess; }
template <int KIND> static void launch_kind(int grid, hipStream_t stream, Args a, int l) { a.l_lo = l; a.l_hi = l + 1; hipLaunchKernelGGL(fwd_kernel<KIND>, dim3(grid), dim3(NTHREADS), LDS_BYTES, stream, a); }
extern "C" void kernel_launch(void* const* d_in, const int* in_sizes, int n_in, void* d_out, int out_size, void* d_ws, size_t ws_size, hipStream_t stream) {
    static int grid = 0;
    if (grid == 0) {
        if (n_in != 32 || ws_size < WS_END) { fprintf(stderr, "kernel_launch: n_in %d ws %zu (need %zu)\n", n_in, ws_size, (size_t)WS_END); grid = -1; return; }
        int dev = 0, cus = 0;
        if (hipGetDevice(&dev) != hipSuccess || hipDeviceGetAttribute(&cus, hipDeviceAttributeMultiprocessorCount, dev) != hipSuccess) { grid = -1; return; }
        bool ok = true;
#if MK_ONE_LAUNCH
        ok = prep_kernel<-1>();
#else
        ok = prep_kernel<0>() && prep_kernel<1>() && prep_kernel<2>() && prep_kernel<3>() && prep_kernel<4>() && prep_kernel<5>() && prep_kernel<6>() && prep_kernel<7>() && prep_kernel<8>() && prep_kernel<9>()
          && prep_kernel<10>() && prep_kernel<11>() && prep_kernel<12>() && prep_kernel<13>() && prep_kernel<14>() && prep_kernel<15>() && prep_kernel<16>();
#endif
        if (!ok) { grid = -1; return; }
        (void)hipGetLastError();
        grid = cus;
    }
    if (grid < 0) return;
    (void)hipMemsetAsync((char*)d_ws + WS_CTL, 0, CTL_BYTES, stream);
    Args a{};
    for (int i = 0; i < 32; ++i) a.in[i] = d_in[i];
    a.out = (float*)d_out; a.ws = (unsigned char*)d_ws;
#if MK_ONE_LAUNCH
    a.l_lo = 0; a.l_hi = NL;
    hipLaunchKernelGGL(fwd_kernel<-1>, dim3(grid), dim3(NTHREADS), LDS_BYTES, stream, a);
#else
    launch_kind<0>(grid, stream, a, 0);
    for (int l = 0; l < NL; ++l) {
        launch_kind<1>(grid, stream, a, l); launch_kind<2>(grid, stream, a, l); launch_kind<3>(grid, stream, a, l); launch_kind<4>(grid, stream, a, l); launch_kind<5>(grid, stream, a, l);
        launch_kind<6>(grid, stream, a, l); launch_kind<7>(grid, stream, a, l); launch_kind<8>(grid, stream, a, l); launch_kind<9>(grid, stream, a, l); launch_kind<10>(grid, stream, a, l);
        launch_kind<11>(grid, stream, a, l); launch_kind<12>(grid, stream, a, l); launch_kind<13>(grid, stream, a, l); launch_kind<14>(grid, stream, a, l); launch_kind<15>(grid, stream, a, l);
    }
    launch_kind<16>(grid, stream, a, 0);
#endif
}
```
